# Optimizing an MI355X kernel written in HIP

```python
import math
import jax, jax.numpy as jnp
from jax import lax
import numpy as np

D_MODEL = 1024
BATCH = 8
SEQ = 2048
DEPTH = 1

N_META = 16
N_HEADS = 8
HEAD_DIM = 64
ATTN_WIDTH = N_HEADS * HEAD_DIM
IDX_HEADS = 8
IDX_DIM = 64
TOPK_MAX = 256
Q_BLOCK = 64
CONV_CH = 512
CONV_WIDTH = 31
N_BUCKETS = 32
MAX_DISTANCE = 128
N_EXPERTS = 32
TOP_K_EXPERTS = 4
D_FF = 1024
SWIGLU_LIMIT = 7.0
SWIGLU_ALPHA = 1.702
EPS = 1e-6
IDX_SCALE = (IDX_DIM ** -0.5) * (IDX_HEADS ** -0.5)

COL_Q = ATTN_WIDTH
COL_K = ATTN_WIDTH
COL_V = ATTN_WIDTH
COL_IQ = IDX_HEADS * IDX_DIM
COL_IK = IDX_DIM
COL_IW = IDX_HEADS
COL_GLU = 2 * CONV_CH
COL_GATE = 2 * D_MODEL
SPLIT_POINTS = (COL_Q,
                COL_Q + COL_K,
                COL_Q + COL_K + COL_V,
                COL_Q + COL_K + COL_V + COL_IQ,
                COL_Q + COL_K + COL_V + COL_IQ + COL_IK,
                COL_Q + COL_K + COL_V + COL_IQ + COL_IK + COL_IW,
                COL_Q + COL_K + COL_V + COL_IQ + COL_IK + COL_IW + COL_GLU)
IN_COLS = COL_Q + COL_K + COL_V + COL_IQ + COL_IK + COL_IW + COL_GLU + COL_GATE

kernel_name = "hybrid_dsa_conformer_moe_block"


def rmsnorm(x, g):
    xf = x.astype(jnp.float32)
    y = xf * lax.rsqrt(jnp.mean(xf * xf, axis=-1, keepdims=True) + EPS)
    return (y * g.astype(jnp.float32)).astype(x.dtype)


def t5_bucket(n):
    max_exact = N_BUCKETS // 2
    nf = jnp.maximum(n, 1).astype(jnp.float32)
    large = max_exact + (jnp.log(nf / max_exact) / math.log(MAX_DISTANCE / max_exact)
                         * (N_BUCKETS - max_exact)).astype(jnp.int32)
    large = jnp.minimum(large, N_BUCKETS - 1)
    return jnp.where(n < max_exact, n, large)


def sparse_attention(q, k, v, iq, ik, iw, rel_bias, topk):
    B, T = q.shape[0], q.shape[1]
    nb = -(-T // Q_BLOCK)
    Tp = nb * Q_BLOCK

    def to_blocks(a):
        a = jnp.pad(a, [(0, 0), (0, Tp - T)] + [(0, 0)] * (a.ndim - 2))
        return jnp.moveaxis(a.reshape((B, nb, Q_BLOCK) + a.shape[2:]), 1, 0)

    key_pos = jnp.arange(T, dtype=jnp.int32)
    starts = jnp.arange(nb, dtype=jnp.int32) * Q_BLOCK
    gather = jax.vmap(lambda kb, ib: kb[ib])

    def block(args):
        qb, iqb, iwb, start = args
        qpos = start + jnp.arange(Q_BLOCK, dtype=jnp.int32)
        s = jnp.einsum('bqhd,bsd->bqhs', iqb, ik).astype(jnp.float32)
        score = jnp.einsum('bqh,bqhs->bqs', iwb.astype(jnp.float32), jax.nn.relu(s)) * IDX_SCALE
        causal = key_pos[None, :] <= qpos[:, None]
        score = jnp.where(causal[None], score, -jnp.inf)
        _, sel = lax.top_k(score, topk)
        k_sel = gather(k, sel)
        v_sel = gather(v, sel)
        logits = jnp.einsum('bqhd,bqkhd->bhqk', qb, k_sel).astype(jnp.float32) * (HEAD_DIM ** -0.5)
        dist = qpos[None, :, None] - sel
        bias = rel_bias[t5_bucket(jnp.maximum(dist, 0))]
        logits = logits + jnp.moveaxis(bias, 3, 1).astype(jnp.float32)
        logits = jnp.where((dist >= 0)[:, None], logits, -jnp.inf)
        p = jax.nn.softmax(logits, axis=-1).astype(v.dtype)
        return jnp.einsum('bhqk,bqkhd->bqhd', p, v_sel)

    out = lax.map(block, (to_blocks(q), to_blocks(iq), to_blocks(iw), starts))
    out = jnp.moveaxis(out, 0, 1).reshape(B, Tp, N_HEADS * HEAD_DIM)
    return out[:, :T]


def conformer_conv(u, conv_w, conv_b, ln_g, ln_b, w_conv_out):
    a, g = jnp.split(u, 2, axis=-1)
    y = a * jax.nn.sigmoid(g)
    y = lax.conv_general_dilated(y, conv_w[:, None, :].astype(y.dtype), window_strides=(1,),
                                 padding=[(CONV_WIDTH - 1, 0)],
                                 dimension_numbers=('NWC', 'WIO', 'NWC'),
                                 feature_group_count=CONV_CH) + conv_b
    yf = y.astype(jnp.float32)
    mu = jnp.mean(yf, axis=-1, keepdims=True)
    var = jnp.mean(jnp.square(yf - mu), axis=-1, keepdims=True)
    yf = (yf - mu) * lax.rsqrt(var + EPS) * ln_g.astype(jnp.float32) + ln_b.astype(jnp.float32)
    y = jax.nn.silu(yf).astype(u.dtype)
    return y @ w_conv_out


def moe_ffn(h, w_router, b_router, w_ug, b_ug, w_down, b_down):
    B, T, D = h.shape
    hf = h.reshape(B * T, D)
    logits = (hf @ w_router + b_router).astype(jnp.float32)
    vals, idx = lax.top_k(logits, TOP_K_EXPERTS)
    gates = jax.nn.softmax(vals, axis=-1)
    combine = jnp.sum(jax.nn.one_hot(idx, N_EXPERTS, dtype=jnp.float32) * gates[..., None], axis=1)

    def expert(acc, params):
        wug, bug, wd, bd, c = params
        ug = hf @ wug + bug
        gate = jnp.minimum(ug[:, :D_FF], SWIGLU_LIMIT)
        up = jnp.clip(ug[:, D_FF:], -SWIGLU_LIMIT, SWIGLU_LIMIT)
        act = (up + 1.0) * gate * jax.nn.sigmoid(SWIGLU_ALPHA * gate)
        y = act @ wd + bd
        return acc + c[:, None].astype(y.dtype) * y, None

    acc, _ = lax.scan(expert, jnp.zeros_like(hf), (w_ug, b_ug, w_down, b_down, combine.T))
    return acc.reshape(B, T, D)


def setup_inputs(seed: int = 0) -> dict:
    key = jax.random.key(seed)
    ks = jax.random.split(key, 24)
    f32 = jnp.float32
    nrm = lambda k, shape, s: jax.random.normal(k, shape, f32) * s
    return {
        "x": nrm(ks[0], (BATCH, SEQ, D_MODEL), 1.0),
        "meta_tokens": nrm(ks[1], (N_META, D_MODEL), 1.0),
        "rel_bias": nrm(ks[2], (N_BUCKETS, N_HEADS), 0.5),
        "norm_mix": 1.0 + nrm(ks[3], (DEPTH, D_MODEL), 0.02),
        "w_in": nrm(ks[4], (DEPTH, D_MODEL, IN_COLS), D_MODEL ** -0.5),
        "b_gate": nrm(ks[5], (DEPTH, 2 * D_MODEL), 0.1),
        "w_attn_out": nrm(ks[6], (DEPTH, ATTN_WIDTH, D_MODEL), ATTN_WIDTH ** -0.5),
        "conv_w": nrm(ks[7], (DEPTH, CONV_WIDTH, CONV_CH), CONV_WIDTH ** -0.5),
        "conv_b": nrm(ks[8], (DEPTH, CONV_CH), 0.01),
        "conv_ln_g": 1.0 + nrm(ks[9], (DEPTH, CONV_CH), 0.02),
        "conv_ln_b": nrm(ks[10], (DEPTH, CONV_CH), 0.01),
        "w_conv_out": nrm(ks[11], (DEPTH, CONV_CH, D_MODEL), CONV_CH ** -0.5),
        "w_out": nrm(ks[12], (DEPTH, D_MODEL, D_MODEL), D_MODEL ** -0.5),
        "norm_ffn": 1.0 + nrm(ks[13], (DEPTH, D_MODEL), 0.02),
        "w_router": nrm(ks[14], (DEPTH, D_MODEL, N_EXPERTS), D_MODEL ** -0.5),
        "b_router": nrm(ks[15], (DEPTH, N_EXPERTS), 0.01),
        "w_up_gate": nrm(ks[16], (DEPTH, N_EXPERTS, D_MODEL, 2 * D_FF), D_MODEL ** -0.5),
        "b_up_gate": nrm(ks[17], (DEPTH, N_EXPERTS, 2 * D_FF), 0.01),
        "w_down": nrm(ks[18], (DEPTH, N_EXPERTS, D_FF, D_MODEL), D_FF ** -0.5),
        "b_down": nrm(ks[19], (DEPTH, N_EXPERTS, D_MODEL), 0.01),
        "norm_final": 1.0 + nrm(ks[20], (D_MODEL,), 0.02),
    }


def reference(x, meta_tokens, rel_bias, norm_mix, w_in, b_gate, w_attn_out, conv_w, conv_b,
              conv_ln_g, conv_ln_b, w_conv_out, w_out, norm_ffn, w_router, b_router,
              w_up_gate, b_up_gate, w_down, b_down, norm_final):
    B, S, D = x.shape
    topk = min(TOPK_MAX, S // 4)
    meta = jnp.broadcast_to(meta_tokens[None].astype(x.dtype), (B, N_META, D))
    h = jnp.concatenate([meta, x], axis=1)
    T = h.shape[1]
    for l in range(DEPTH):
        hn = rmsnorm(h, norm_mix[l])
        proj = hn @ w_in[l]
        q, k, v, iq, ik, iw, glu_in, gate_in = jnp.split(proj, SPLIT_POINTS, axis=-1)
        q = q.reshape(B, T, N_HEADS, HEAD_DIM)
        k = k.reshape(B, T, N_HEADS, HEAD_DIM)
        v = v.reshape(B, T, N_HEADS, HEAD_DIM)
        iq = iq.reshape(B, T, IDX_HEADS, IDX_DIM)
        y_a = sparse_attention(q, k, v, iq, ik, iw, rel_bias, topk) @ w_attn_out[l]
        y_b = conformer_conv(glu_in, conv_w[l], conv_b[l], conv_ln_g[l], conv_ln_b[l], w_conv_out[l])
        g_a, g_b = jnp.split(jax.nn.sigmoid(gate_in + b_gate[l]), 2, axis=-1)
        h = h + (g_a * y_a + g_b * y_b) @ w_out[l]
        h = h + moe_ffn(rmsnorm(h, norm_ffn[l]), w_router[l], b_router[l], w_up_gate[l],
                        b_up_gate[l], w_down[l], b_down[l])
    return rmsnorm(h, norm_final)[:, N_META:]
```

```cpp
#include <hip/hip_runtime.h>
#include <cstdio>
#include <cstdint>

#ifndef MK_N_LAUNCHES
#define MK_N_LAUNCHES 1
#endif

constexpr int NB = 8, SEQ = 2048, NMETA = 16, TT = SEQ + NMETA  , DM = 1024, NTOK = NB * SEQ  , NALL = NB * TT  ;
constexpr int AW = 512, NH = 8, HD = 64, IDXD = 64, CC = 512, CW = 31, NE = 32, DFF = 1024, TOPK = 256;
constexpr int INCOLS = 5192, TP = 2176  , VOFF = 48  , MSTR = 68  ;
constexpr float EPS = 1e-6f, LOG2E = 1.4426950408889634f;
constexpr float QSCALE = 0.125f * LOG2E;
constexpr int MAXTILES = 296;
constexpr int SC_Q = 0, SC_K = 512, SC_V = 1024, SC_IQ = 1536, SC_IK = 2048, SC_IW = 2112, SC_GLU = 2120, SC_GATE = 3144;
constexpr int WR_GLU = 2048, WR_GATE = 3072, WR_IK = 5120, WR_IW = 5184, WIN_ROWS = 5376;

constexpr size_t MiB = 1u << 20;
constexpr size_t al4k(size_t x) { return (x + 4095) & ~(size_t)4095; }
constexpr size_t WS_CTL = 0, CTL_ZERO_BYTES = 1 * MiB;
constexpr size_t WS_WIN = 1 * MiB;
constexpr size_t WS_WAO = WS_WIN + al4k((size_t)WIN_ROWS * DM * 2);
constexpr size_t WS_WCO = WS_WAO + al4k((size_t)DM * AW * 2);
constexpr size_t WS_WOUT = WS_WCO + al4k((size_t)DM * CC * 2);
constexpr size_t WS_WUG = WS_WOUT + al4k((size_t)DM * DM * 2);
constexpr size_t WS_WD = WS_WUG + al4k((size_t)NE * 2 * DFF * DM * 2);
constexpr size_t WS_XN = WS_WD + al4k((size_t)NE * DM * DFF * 2);
constexpr size_t WS_XNM = WS_XN + al4k((size_t)NTOK * DM * 2);
constexpr size_t WS_Q = WS_XNM + al4k((size_t)NMETA * DM * 2);
constexpr size_t WS_IQ = WS_Q + al4k((size_t)NTOK * AW * 2);
constexpr size_t WS_KB = WS_IQ + al4k((size_t)NTOK * AW * 2);
constexpr size_t WS_VT = WS_KB + al4k((size_t)(NALL + 64) * AW * 2);
constexpr size_t WS_IK = WS_VT + al4k((size_t)NB * AW * TP * 2);
constexpr size_t WS_IW = WS_IK + al4k((size_t)(NALL + 64) * IDXD * 2);
constexpr size_t WS_GLU = WS_IW + al4k((size_t)NTOK * 8 * 4);
constexpr size_t WS_GA = WS_GLU + al4k((size_t)NALL * CC * 2);
constexpr size_t WS_GB = WS_GA + al4k((size_t)NTOK * DM * 2);
constexpr size_t WS_MASK = WS_GB + al4k((size_t)NTOK * DM * 2);
constexpr size_t WS_AO = WS_MASK + al4k((size_t)NTOK * MSTR * 4);
constexpr size_t WS_CO = WS_AO + al4k((size_t)NTOK * AW * 2);
constexpr size_t WS_MG = WS_CO + al4k((size_t)NTOK * CC * 2);
constexpr size_t WS_TE = WS_MG + al4k((size_t)NTOK * DM * 2);
constexpr size_t WS_TP = WS_TE + al4k((size_t)NTOK * 4 * 4);
constexpr size_t WS_LIST = WS_TP + al4k((size_t)NTOK * 4 * 4);
constexpr size_t WS_LG = WS_LIST + al4k((size_t)NE * NTOK * 4);
constexpr size_t WS_ACT = WS_LG + al4k((size_t)NE * NTOK * 4);
constexpr size_t WS_YP = WS_ACT + al4k((size_t)MAXTILES * 256 * DFF * 2);
constexpr size_t WS_END = WS_YP + al4k((size_t)MAXTILES * 256 * DM * 2);
static_assert(WS_END < ((size_t)1 << 32), "32-bit byte offsets into d_ws");
constexpr int CW_TMO = 0, CW_CODE = 1, CW_BAR = 4096, CW_ECNT = 16384;

constexpr int RING_BYTES = 131072;
constexpr int LDSX_OFF = RING_BYTES;
constexpr int MISC_OFF = RING_BYTES + 8192;
constexpr int LDS_BYTES = 147456;
constexpr int NWAVES = 8, NTHREADS = 512;

#define GAS __attribute__((address_space(1)))
#define LAS __attribute__((address_space(3)))
typedef unsigned short bf16_t;
typedef short bf16x8 __attribute__((ext_vector_type(8)));
typedef short s16x4 __attribute__((ext_vector_type(4)));
typedef float f32x4 __attribute__((ext_vector_type(4)));
typedef float f32x16 __attribute__((ext_vector_type(16)));
typedef unsigned u32x4 __attribute__((ext_vector_type(4)));
typedef unsigned u32x2 __attribute__((ext_vector_type(2)));
typedef GAS unsigned gu32;
#define RLX_AGENT __ATOMIC_RELAXED, __HIP_MEMORY_SCOPE_AGENT
#define LDS_WAIT() asm volatile("s_waitcnt lgkmcnt(0)" ::: "memory")
#define VM_WAIT() asm volatile("s_waitcnt vmcnt(0)" ::: "memory")

__device__ __forceinline__ unsigned cvt_pk_bf16(float lo, float hi) { unsigned r; asm volatile("v_cvt_pk_bf16_f32 %0, %1, %2" : "=v"(r) : "v"(lo), "v"(hi)); return r; }
__device__ __forceinline__ float bf2f(unsigned short b) { return __uint_as_float((unsigned)b << 16); }
__device__ __forceinline__ float bflo(unsigned w) { return __uint_as_float(w << 16); }
__device__ __forceinline__ float bfhi(unsigned w) { return __uint_as_float(w & 0xffff0000u); }
__device__ __forceinline__ float sigmoidf_(float x) { return 1.0f / (1.0f + __expf(-x)); }
__device__ __forceinline__ float wave_sum(float v) {
#pragma unroll
    for (int o = 1; o < 64; o <<= 1) v += __shfl_xor(v, o);
    return v;
}

namespace pg8 {
constexpr int BM = 256, BK = 64, HALF = 128, HTB = HALF * BK * 2, STAGE_BYTES = 8 * HTB;
__host__ __device__ __forceinline__ int lds_byte(int r, int c) { const int st = (r >> 4) * 2 + (c >> 5), rr = r & 15, cc = c & 31, ob = rr * 64 + cc * 2; return st * 1024 + (ob ^ (((ob >> 9) & 1) << 5)); }
__host__ __device__ __forceinline__ void stage_rc(int b, int& R, int& C) { const int st = b / 1024, sb = b % 1024, swz = sb ^ (((sb >> 9) & 1) << 5); R = (st >> 1) * 16 + swz / 64; C = (st & 1) * 32 + (swz % 64) / 2; }

struct Unit { int pm, pn, z; };

template <class Epi, class Sched>
__device__ __forceinline__ void gemm_phase(LAS unsigned char* lds, const int K, const Sched& S, const Epi& E) {
    const int tid = threadIdx.x, wid = __builtin_amdgcn_readfirstlane(tid >> 6), lane = tid & 63, wr = wid >> 2, wc = wid & 3, fr = lane & 15, fq = lane >> 4;
    const int nt = K / BK;
    unsigned voffB[2];
#pragma unroll
    for (int i = 0; i < 2; ++i) { int R_, C_; stage_rc(tid * 16 + i * 8192, R_, C_); voffB[i] = (unsigned)(R_ * K + C_) * 2u; }
    const size_t kstep = (size_t)(BK * 2);
    const size_t hstep = (size_t)HALF * K * 2;
    const unsigned ldsw = (unsigned)wid * 1024u;
    const int aoff = lds_byte(wr * 64 + fr, fq * 8), boff = lds_byte(wc * 32 + fr, fq * 8);
    const char* const abase = S.a_base();
#define PG8_SA(b, h) (((b) * 2 + (h)) * HTB)
#define PG8_SB(b, h) ((4 + (b) * 2 + (h)) * HTB)
#define PG8_STAGE(bufoff, gbase, voff) do { _Pragma("unroll") for (int _i = 0; _i < 2; ++_i) \
        __builtin_amdgcn_global_load_lds((const unsigned*)((const char*)(gbase) + (voff)[_i]), (LAS unsigned*)(lds + (bufoff) + ldsw + _i * 8192), 16, 0, 0); } while (0)
#define PG8_LDA(dst, b, h) do { _Pragma("unroll") for (int m = 0; m < 4; ++m) _Pragma("unroll") for (int k = 0; k < 2; ++k) dst[m][k] = *(const LAS bf16x8*)(lds + PG8_SA(b, h) + aoff + m * 2048 + k * 1024); } while (0)
#define PG8_LDB(dst, b, h) do { _Pragma("unroll") for (int n = 0; n < 2; ++n) _Pragma("unroll") for (int k = 0; k < 2; ++k) dst[n][k] = *(const LAS bf16x8*)(lds + PG8_SB(b, h) + boff + n * 2048 + k * 1024); } while (0)
#define PG8_MMA(ai, bj, At, Bt) do { __builtin_amdgcn_s_setprio(1); _Pragma("unroll") for (int m = 0; m < 4; ++m) _Pragma("unroll") for (int n = 0; n < 2; ++n) _Pragma("unroll") for (int k = 0; k < 2; ++k) \
        acc[ai][bj][m][n] = __builtin_amdgcn_mfma_f32_16x16x32_bf16(Bt[n][k], At[m][k], acc[ai][bj][m][n], 0, 0, 0); __builtin_amdgcn_s_setprio(0); } while (0)
#define PG8_WAIT_V(n) asm volatile("s_waitcnt vmcnt(" #n ")" ::: "memory")
#define PG8_WAIT_L(n) asm volatile("s_waitcnt lgkmcnt(" #n ")" ::: "memory")
#define PG8_BAR __builtin_amdgcn_s_barrier()
#define PG8_SCHED __builtin_amdgcn_sched_barrier(0)
    Unit cur, nxt; int ui = 0;
    if (!S.next(0, cur)) return;
    f32x4 acc[2][2][4][2];
#pragma unroll
    for (int a = 0; a < 2; ++a)
#pragma unroll
        for (int b = 0; b < 2; ++b)
#pragma unroll
            for (int m = 0; m < 4; ++m)
#pragma unroll
                for (int n = 0; n < 2; ++n) acc[a][b][m][n] = (f32x4){0.f, 0.f, 0.f, 0.f};
    bf16x8 At[4][2], B0[2][2], B1[2][2];
    unsigned ca[2][2], na[2][2];
    S.a_offs(cur, tid, ca);
    const char* cB = S.b_base(cur);
    PG8_STAGE(PG8_SB(0, 0), cB, voffB); PG8_STAGE(PG8_SB(0, 1), cB + hstep, voffB); PG8_STAGE(PG8_SA(0, 0), abase, ca[0]); PG8_STAGE(PG8_SA(0, 1), abase, ca[1]);
    if (wr == 1) PG8_BAR;
    PG8_WAIT_V(2); PG8_BAR;
    PG8_STAGE(PG8_SB(1, 0), cB + kstep, voffB); PG8_STAGE(PG8_SA(1, 0), abase + kstep, ca[0]); PG8_STAGE(PG8_SB(1, 1), cB + hstep + kstep, voffB);
    PG8_WAIT_V(6); PG8_BAR;
    for (;;) {
        const bool has_next = S.next(ui + 1, nxt);
        const char* nB = cB;
#pragma unroll
        for (int h = 0; h < 2; ++h)
#pragma unroll
            for (int i = 0; i < 2; ++i) na[h][i] = ca[h][i];
        if (has_next) { S.a_offs(nxt, tid, na); nB = S.b_base(nxt); }
        for (int t = 0; t < nt; t += 2) {
            const bool last = (t == nt - 2);
            const char* a1 = abase + (size_t)(t + 1) * kstep;
            const char* a2 = last ? abase : abase + (size_t)(t + 2) * kstep; const char* b2 = last ? nB : cB + (size_t)(t + 2) * kstep;
            const char* a3 = a2 + kstep; const char* b3 = b2 + kstep;
            PG8_LDB(B0, 0, 0); PG8_LDB(B1, 0, 1); PG8_SCHED; PG8_LDA(At, 0, 0); PG8_STAGE(PG8_SA(1, 1), a1, ca[1]);
            PG8_WAIT_V(8); PG8_WAIT_L(0); PG8_BAR; PG8_MMA(0, 0, At, B0); PG8_MMA(0, 1, At, B1); PG8_BAR; PG8_SCHED;
            if (last) {
#pragma unroll
                for (int h = 0; h < 2; ++h)
#pragma unroll
                    for (int i = 0; i < 2; ++i) ca[h][i] = na[h][i];
            }
            PG8_LDA(At, 0, 1); PG8_STAGE(PG8_SB(0, 0), b2, voffB); PG8_STAGE(PG8_SB(0, 1), b2 + hstep, voffB); PG8_STAGE(PG8_SA(0, 0), a2, ca[0]);
            PG8_WAIT_V(8); PG8_WAIT_L(0); PG8_BAR; PG8_MMA(1, 0, At, B0); PG8_MMA(1, 1, At, B1); PG8_BAR; PG8_SCHED;
            PG8_LDB(B0, 1, 0); PG8_LDB(B1, 1, 1); PG8_SCHED; PG8_LDA(At, 1, 0); PG8_STAGE(PG8_SA(0, 1), a2, ca[1]);
            PG8_WAIT_V(8); PG8_WAIT_L(0); PG8_BAR; PG8_MMA(0, 0, At, B0); PG8_MMA(0, 1, At, B1); PG8_BAR; PG8_SCHED;
            PG8_LDA(At, 1, 1); PG8_STAGE(PG8_SB(1, 0), b3, voffB); PG8_STAGE(PG8_SB(1, 1), b3 + hstep, voffB); PG8_STAGE(PG8_SA(1, 0), a3, ca[0]);
            PG8_WAIT_V(8); PG8_WAIT_L(0); PG8_BAR; PG8_MMA(1, 0, At, B0); PG8_MMA(1, 1, At, B1); PG8_BAR; PG8_SCHED;
        }
        if (wr == 0) PG8_BAR;
        E(acc, cur, wr, wc, fr, fq);
        if (!has_next) break;
#pragma unroll
        for (int a = 0; a < 2; ++a)
#pragma unroll
            for (int b = 0; b < 2; ++b)
#pragma unroll
                for (int m = 0; m < 4; ++m)
#pragma unroll
                    for (int n = 0; n < 2; ++n) acc[a][b][m][n] = (f32x4){0.f, 0.f, 0.f, 0.f};
        cur = nxt; cB = nB; ++ui;
        if (wr == 1) PG8_BAR;
    }
    PG8_WAIT_V(0);
    PG8_BAR;
#undef PG8_SA
#undef PG8_SB
#undef PG8_STAGE
#undef PG8_LDA
#undef PG8_LDB
#undef PG8_MMA
#undef PG8_WAIT_V
#undef PG8_WAIT_L
#undef PG8_BAR
#undef PG8_SCHED
}
}

#define XB_TMO      128
#define XB_XCNT(j)  (256  + 64 * (j))
#define XB_XSUB(j)  (1280 + 64 * (j))
#define XB_XGEN(j)  (2304 + 64 * (j))
#define XB_TOP      3328
#define XB_TOPGEN   3392
#define XCD_BAR_WORDS 3456
#define XB_SPIN_CAP (1u << 18)
__device__ __forceinline__ unsigned xb_ld(unsigned* p)              { return __hip_atomic_load(p, __ATOMIC_RELAXED, __HIP_MEMORY_SCOPE_AGENT); }
__device__ __forceinline__ unsigned xb_add(unsigned* p, unsigned v) { return __hip_atomic_fetch_add(p, v, __ATOMIC_RELAXED, __HIP_MEMORY_SCOPE_AGENT); }
__device__ __forceinline__ unsigned xb_xcc_id() { return (unsigned)__builtin_amdgcn_s_getreg((3 << 11) | 20) & 0xFu; }
#define XB_SPIN(cond, bar) do { unsigned _sp = 0; while (cond) { __builtin_amdgcn_s_sleep(1); \
    if ((++_sp & 255u) == 0u) { if (xb_ld(&(bar)[XB_TMO])) break; if (_sp > XB_SPIN_CAP) { atomicAdd(&(bar)[XB_TMO], 1u); break; } } } } while (0)
struct XcdBarrier { unsigned* bar; unsigned x; volatile LAS unsigned* st; };
__device__ __forceinline__ XcdBarrier xcd_barrier_post(unsigned* bar, volatile LAS unsigned* st) {
    XcdBarrier b; b.bar = bar; b.x = xb_xcc_id(); b.st = st;
    if (threadIdx.x == 0) (void)xb_add(&bar[XB_XCNT(b.x)], 1u);
    return b;
}
__device__ __forceinline__ void xcd_barrier_complete(unsigned* bar, unsigned x, unsigned& nloc, unsigned& nx) {
    const unsigned G = gridDim.x * gridDim.y * gridDim.z;
    unsigned sum, cnt, mine, sp = 0u;
    for (;;) {
        sum = 0u; cnt = 0u; mine = 0u;
#pragma unroll
        for (unsigned j = 0; j < 16; ++j) { const unsigned c = xb_ld(&bar[XB_XCNT(j)]); sum += c; cnt += (c > 0u) ? 1u : 0u; mine = (j == x) ? c : mine; }
        if (sum == G) break;
        __builtin_amdgcn_s_sleep(1);
        if ((++sp & 255u) == 0u) { if (xb_ld(&bar[XB_TMO])) break; if (sp > XB_SPIN_CAP) { atomicAdd(&bar[XB_TMO], 1u); break; } }
    }
    nloc = mine > 0u ? mine : 1u; nx = cnt > 0u ? cnt : 1u;
}
__device__ __forceinline__ void xcd_barrier(const XcdBarrier& b) {
    asm volatile("s_waitcnt vmcnt(0)" ::: "memory");
    __syncthreads();
    if (threadIdx.x == 0) {
        unsigned* bar = b.bar;
        __builtin_amdgcn_s_waitcnt(0);
        unsigned nloc = b.st[0], nx = b.st[1];
        if (nloc == 0u) { xcd_barrier_complete(bar, b.x, nloc, nx); b.st[0] = nloc; b.st[1] = nx; }
        const unsigned old = xb_add(&bar[XB_XSUB(b.x)], 1u);
        const unsigned gen = old / nloc;
        if (old + 1u == (gen + 1u) * nloc) {
            __builtin_amdgcn_fence(__ATOMIC_RELEASE, "agent");
            asm volatile("s_waitcnt vmcnt(0)" ::: "memory");
            const unsigned og = xb_add(&bar[XB_TOP], 1u);
            const unsigned tg = og / nx;
            if (og + 1u == (tg + 1u) * nx) xb_add(&bar[XB_TOPGEN], 1u);
            else XB_SPIN(xb_ld(&bar[XB_TOPGEN]) == tg, bar);
            __builtin_amdgcn_fence(__ATOMIC_ACQUIRE, "agent");
            xb_add(&bar[XB_XGEN(b.x)], 1u);
            asm volatile("s_waitcnt vmcnt(0)" ::: "memory");
        } else {
            XB_SPIN(xb_ld(&bar[XB_XGEN(b.x)]) == gen, bar);
            __builtin_amdgcn_fence(__ATOMIC_ACQUIRE, "agent");
            asm volatile("s_waitcnt vmcnt(0)" ::: "memory");
        }
    }
    __syncthreads();
}

struct Args {
    const float* in[21];
    float* out; unsigned char* ws;
    int ph_lo, ph_hi;
};
enum { I_X = 0, I_META, I_RELB, I_NMIX, I_WIN, I_BGATE, I_WAO, I_CONVW, I_CONVB, I_LNG, I_LNB, I_WCO, I_WOUT, I_NFFN, I_WR, I_BR, I_WUG, I_BUG, I_WD, I_BD, I_NFIN };

struct Frame {
    LAS unsigned char* lds;
    unsigned char* ws;
    int tid, lane, wave;
    int G, bid;
};
template <class T> __device__ __forceinline__ T* wsp(unsigned char* ws, size_t off) { return (T*)(ws + off); }

__device__ __forceinline__ void p0_tile64(const float* __restrict__ src, int ldn, int sc, int k0, bf16_t* __restrict__ dst, int ldk, int dr, LAS float* scr, int lane) {
    const int n4 = (lane & 15) * 4, kr = lane >> 4;
    f32x4 v[16];
#pragma unroll
    for (int i = 0; i < 16; ++i) v[i] = *(const f32x4*)(src + (size_t)(k0 + 4 * i + kr) * ldn + sc + n4);
#pragma unroll
    for (int i = 0; i < 16; ++i) { LAS float* p = scr + (4 * i + kr) * 65 + n4; p[0] = v[i][0]; p[1] = v[i][1]; p[2] = v[i][2]; p[3] = v[i][3]; }
    LDS_WAIT(); asm volatile("" ::: "memory");
    const int c = lane & 7;
#pragma unroll
    for (int j = 0; j < 8; ++j) { const int n = (lane >> 3) + 8 * j; const LAS float* s = scr + (8 * c) * 65 + n;
        u32x4 o; o.x = cvt_pk_bf16(s[0 * 65], s[1 * 65]); o.y = cvt_pk_bf16(s[2 * 65], s[3 * 65]); o.z = cvt_pk_bf16(s[4 * 65], s[5 * 65]); o.w = cvt_pk_bf16(s[6 * 65], s[7 * 65]);
        *(u32x4*)(dst + (size_t)(dr + n) * ldk + k0 + 8 * c) = o; }
    LDS_WAIT(); asm volatile("" ::: "memory");
}
__device__ __forceinline__ void rms_row_to_bf16(const float* __restrict__ xrow, const float* __restrict__ g, bf16_t* __restrict__ orow, int lane) {
    const f32x4* xr = (const f32x4*)xrow + lane; const f32x4* gr = (const f32x4*)g + lane;
    f32x4 v[4]; float s = 0.f;
#pragma unroll
    for (int j = 0; j < 4; ++j) { v[j] = xr[64 * j]; s += (v[j].x * v[j].x + v[j].y * v[j].y) + (v[j].z * v[j].z + v[j].w * v[j].w); }
    const float r = 1.0f / sqrtf(wave_sum(s) * (1.f / DM) + EPS);
    unsigned long long* o8 = (unsigned long long*)orow + lane;
#pragma unroll
    for (int j = 0; j < 4; ++j) { const f32x4 gg = gr[64 * j];
        o8[64 * j] = (unsigned long long)cvt_pk_bf16(v[j].x * r * gg.x, v[j].y * r * gg.y) | ((unsigned long long)cvt_pk_bf16(v[j].z * r * gg.z, v[j].w * r * gg.w) << 32); }
}
__device__ __forceinline__ void p0_prologue(Frame& F, const Args& a) {
    LAS float* scr = (LAS float*)(F.lds + F.wave * 16896);
    const int gw = F.bid * NWAVES + F.wave, NGW = F.G * NWAVES;
    unsigned char* ws = F.ws;
    constexpr int T_IN = 81 * 16, T_AO = 16 * 8, T_CO = 16 * 8, T_OUT = 16 * 16, T_SMALL = T_IN + T_AO + T_CO + T_OUT;
    constexpr int T_UG = NE * 32 * 16, T_D = NE * 16 * 16;
    for (int it = gw; it < T_SMALL + T_UG + T_D; it += NGW) {
        int r = it;
        if (r < T_IN) { const int g = r / 16, kb = r % 16; const int dr = g * 64; int sc;
            if (dr < WR_GLU) sc = dr;
            else if (dr < WR_GATE) { const int q = dr - WR_GLU, tile = q >> 8, hf = (q >> 7) & 1, w = q & 127; sc = SC_GLU + 512 * hf + 128 * tile + w; }
            else if (dr < WR_IK) sc = SC_GATE + (dr - WR_GATE);
            else sc = SC_IK + (dr - WR_IK);
            p0_tile64(a.in[I_WIN], INCOLS, sc, kb * 64, wsp<bf16_t>(ws, WS_WIN), DM, dr, scr, F.lane); continue; }
        r -= T_IN;
        if (r < T_AO) { const int g = r / 8, kb = r % 8; p0_tile64(a.in[I_WAO], DM, g * 64, kb * 64, wsp<bf16_t>(ws, WS_WAO), AW, g * 64, scr, F.lane); continue; }
        r -= T_AO;
        if (r < T_CO) { const int g = r / 8, kb = r % 8; p0_tile64(a.in[I_WCO], DM, g * 64, kb * 64, wsp<bf16_t>(ws, WS_WCO), CC, g * 64, scr, F.lane); continue; }
        r -= T_CO;
        if (r < T_OUT) { const int g = r / 16, kb = r % 16; p0_tile64(a.in[I_WOUT], DM, g * 64, kb * 64, wsp<bf16_t>(ws, WS_WOUT), DM, g * 64, scr, F.lane); continue; }
        r -= T_OUT;
        if (r < T_UG) { const int e = r / 512, q = r % 512, g = q / 16, kb = q % 16; const int dr = g * 64, tile = dr >> 8, hf = (dr >> 7) & 1, w = dr & 127;
            p0_tile64(a.in[I_WUG] + (size_t)e * DM * 2 * DFF, 2 * DFF, DFF * hf + 128 * tile + w, kb * 64, wsp<bf16_t>(ws, WS_WUG) + (size_t)e * 2 * DFF * DM, DM, dr, scr, F.lane); continue; }
        r -= T_UG;
        { const int e = r / 256, q = r % 256, g = q / 16, kb = q % 16;
            p0_tile64(a.in[I_WD] + (size_t)e * DFF * DM, DM, g * 64, kb * 64, wsp<bf16_t>(ws, WS_WD) + (size_t)e * DM * DFF, DFF, g * 64, scr, F.lane); }
    }
    { const int gt = F.bid * NTHREADS + F.tid;
      if (gt < 8 * DM / 2) { const int n = gt >> 9, k = (gt & 511) * 2; const float v0 = a.in[I_WIN][(size_t)k * INCOLS + SC_IW + n], v1 = a.in[I_WIN][(size_t)(k + 1) * INCOLS + SC_IW + n];
          *(unsigned*)(wsp<bf16_t>(ws, WS_WIN) + (size_t)(WR_IW + n) * DM + k) = cvt_pk_bf16(v0, v1); } }
    for (int m = gw; m < NTOK + NMETA; m += NGW) {
        if (m < NTOK) rms_row_to_bf16(a.in[I_X] + (size_t)m * DM, a.in[I_NMIX], wsp<bf16_t>(ws, WS_XN) + (size_t)m * DM, F.lane);
        else rms_row_to_bf16(a.in[I_META] + (size_t)(m - NTOK) * DM, a.in[I_NMIX], wsp<bf16_t>(ws, WS_XNM) + (size_t)(m - NTOK) * DM, F.lane);
    }
}

struct PlainSched {
    const char* ws; unsigned a_off, b_off; int K, nM, nN, nwg, G, c;
    __device__ __forceinline__ void init(const unsigned char* ws_, size_t a, size_t b, int M, int N, int K_, int G_, int c_) { ws = (const char*)ws_; a_off = (unsigned)a; b_off = (unsigned)b; K = K_; nM = M / 256; nN = N / 256; nwg = nM * nN; G = G_; c = c_; }
    __device__ __forceinline__ bool next(int i, pg8::Unit& u) const {
        const long L = (long)i * G + c; if (L >= nwg) return false;
        int wgid = (int)L; { const int q = nwg / 8, r = nwg % 8, xcd = wgid % 8, off = wgid / 8; wgid = (xcd < r ? xcd * (q + 1) : r * (q + 1) + (xcd - r) * q) + off; }
        const int nig = 8 * nN, gid = wgid / nig, fm = gid * 8, gsz = (nM - fm) < 8 ? (nM - fm) : 8;
        u.pm = fm + ((wgid % nig) % gsz); u.pn = (wgid % nig) / gsz; u.z = 0; return true;
    }
    __device__ __forceinline__ const char* a_base() const { return ws; }
    __device__ __forceinline__ void a_offs(const pg8::Unit& u, int tid, unsigned (&o)[2][2]) const {
        int R[2], C[2]; pg8::stage_rc(tid * 16, R[0], C[0]); pg8::stage_rc(tid * 16 + 8192, R[1], C[1]);
#pragma unroll
        for (int h = 0; h < 2; ++h)
#pragma unroll
            for (int i = 0; i < 2; ++i) o[h][i] = a_off + (unsigned)(((u.pm * 256 + h * 128 + R[i]) * K + C[i]) * 2);
    }
    __device__ __forceinline__ const char* b_base(const pg8::Unit& u) const { return ws + b_off + (size_t)u.pn * 256 * K * 2; }
};
struct MergeSched {
    const char* ws; int G, c;
    __device__ __forceinline__ bool next(int i, pg8::Unit& u) const {
        const int t = c + (i >> 1) * G;
        if (t >= 256) return false;
        u.pm = (t & 7) + 8 * (t >> 5); u.pn = (t >> 3) & 3; u.z = i & 1; return true;
    }
    __device__ __forceinline__ const char* a_base() const { return ws; }
    __device__ __forceinline__ void a_offs(const pg8::Unit& u, int tid, unsigned (&o)[2][2]) const {
        int R[2], C[2]; pg8::stage_rc(tid * 16, R[0], C[0]); pg8::stage_rc(tid * 16 + 8192, R[1], C[1]);
        const unsigned base = (unsigned)(u.z ? WS_CO : WS_AO);
#pragma unroll
        for (int h = 0; h < 2; ++h)
#pragma unroll
            for (int i = 0; i < 2; ++i) o[h][i] = base + (unsigned)(((u.pm * 256 + h * 128 + R[i]) * 512 + C[i]) * 2);
    }
    __device__ __forceinline__ const char* b_base(const pg8::Unit& u) const { return ws + (u.z ? WS_WCO : WS_WAO) + (size_t)u.pn * 256 * 512 * 2; }
};
struct MoeTables { const LAS int* cnt; const LAS int* tbase; };
template <int NC, bool GATHER>
struct MoeSched {
    const char* ws; MoeTables T; int G, c, total;
    __device__ __forceinline__ bool next(int i, pg8::Unit& u) const {
        const long L = (long)i * G + c; if (L >= total) return false;
        int wgid = (int)L; { const int q = total / 8, r = total % 8, xcd = wgid % 8, off = wgid / 8; wgid = (xcd < r ? xcd * (q + 1) : r * (q + 1) + (xcd - r) * q) + off; }
        int e = 0;
        for (int j = 1; j < NE; ++j) e += (wgid >= T.tbase[j] * NC) ? 1 : 0;
        const int loc = wgid - T.tbase[e] * NC, nt_e = T.tbase[e + 1] - T.tbase[e];
        u.z = e; u.pm = loc % nt_e; u.pn = loc / nt_e; return true;
    }
    __device__ __forceinline__ const char* a_base() const { return ws; }
    __device__ __forceinline__ void a_offs(const pg8::Unit& u, int tid, unsigned (&o)[2][2]) const {
        int R[2], C[2]; pg8::stage_rc(tid * 16, R[0], C[0]); pg8::stage_rc(tid * 16 + 8192, R[1], C[1]);
        if (GATHER) {
            const int* list = (const int*)(ws + WS_LIST) + (size_t)u.z * NTOK; const int n = T.cnt[u.z];
#pragma unroll
            for (int h = 0; h < 2; ++h)
#pragma unroll
                for (int i = 0; i < 2; ++i) { const int p = u.pm * 256 + h * 128 + R[i]; const int tok = (p < n) ? list[p] : 0; o[h][i] = (unsigned)WS_XN + (unsigned)((tok * DM + C[i]) * 2); }
        } else {
            const int row0 = (T.tbase[u.z] + u.pm) * 256;
#pragma unroll
            for (int h = 0; h < 2; ++h)
#pragma unroll
                for (int i = 0; i < 2; ++i) o[h][i] = (unsigned)WS_ACT + (unsigned)(((row0 + h * 128 + R[i]) * DFF + C[i]) * 2);
        }
    }
    __device__ __forceinline__ const char* b_base(const pg8::Unit& u) const {
        if (GATHER) return ws + WS_WUG + ((size_t)u.z * 2 * DFF + (size_t)u.pn * 256) * DM * 2;
        else return ws + WS_WD + ((size_t)u.z * DM + (size_t)u.pn * 256) * DFF * 2;
    }
};

#define EPI_ROWS(ai, m) for (int ai = 0; ai < 2; ++ai) _Pragma("unroll") for (int m = 0; m < 4; ++m)
#define EPI_COLS(bj, n) for (int bj = 0; bj < 2; ++bj) _Pragma("unroll") for (int n = 0; n < 2; ++n)
__device__ __forceinline__ void st_bf16x4(bf16_t* p, f32x4 v) { u32x2 w; w.x = cvt_pk_bf16(v[0], v[1]); w.y = cvt_pk_bf16(v[2], v[3]); *(u32x2*)p = w; }

struct EpiInProj {
    unsigned char* ws; const float* bgate;
    __device__ __forceinline__ void operator()(const f32x4 (&acc)[2][2][4][2], const pg8::Unit& u, int wr, int wc, int fr, int fq) const {
        const int pn = u.pn, row0 = u.pm * 256 + wr * 64 + fr, col0 = wc * 32 + 4 * fq;
        const int bidx = u.pm >> 3;
        const int rowk0 = row0 + NMETA * (bidx + 1);
        if (pn < 2 || (pn >= 6 && pn < 8)) {
            bf16_t* O = wsp<bf16_t>(ws, pn < 2 ? WS_Q : WS_IQ); const int cb = (pn & 1) * 256; const float sc = pn < 2 ? QSCALE : 1.0f;
#pragma unroll
            EPI_ROWS(ai, m) { bf16_t* rp = O + (size_t)(row0 + ai * 128 + m * 16) * AW + cb + col0;
#pragma unroll
                EPI_COLS(bj, n) st_bf16x4(rp + bj * 128 + n * 16, acc[ai][bj][m][n] * sc); }
        } else if (pn < 4) {
            bf16_t* O = wsp<bf16_t>(ws, WS_KB); const int cb = (pn & 1) * 256;
#pragma unroll
            EPI_ROWS(ai, m) { bf16_t* rp = O + (size_t)(rowk0 + ai * 128 + m * 16) * AW + cb + col0;
#pragma unroll
                EPI_COLS(bj, n) st_bf16x4(rp + bj * 128 + n * 16, acc[ai][bj][m][n]); }
        } else if (pn < 6) {
            bf16_t* O = wsp<bf16_t>(ws, WS_VT) + (size_t)bidx * AW * TP; const int cb = (pn & 1) * 256;
            const int t0 = (row0 & (SEQ - 1)) + NMETA + VOFF;
#pragma unroll
            EPI_ROWS(ai, m) { const int t = t0 + ai * 128 + m * 16;
#pragma unroll
                EPI_COLS(bj, n) { const f32x4 v = acc[ai][bj][m][n]; bf16_t* cp = O + (size_t)(cb + col0 + bj * 128 + n * 16) * TP + (t & ~1);
                    const float p0 = __shfl_xor(v[0], 1), p1 = __shfl_xor(v[1], 1), p2 = __shfl_xor(v[2], 1), p3 = __shfl_xor(v[3], 1);
                    if ((fr & 1) == 0) { *(unsigned*)(cp) = cvt_pk_bf16(v[0], p0); *(unsigned*)(cp + TP) = cvt_pk_bf16(v[1], p1); }
                    else { *(unsigned*)(cp + 2 * TP) = cvt_pk_bf16(p2, v[2]); *(unsigned*)(cp + 3 * TP) = cvt_pk_bf16(p3, v[3]); } } }
        } else if (pn < 12) {
            bf16_t* O = wsp<bf16_t>(ws, WS_GLU); const int cb = (pn - 8) * 128;
#pragma unroll
            EPI_ROWS(ai, m) { bf16_t* rp = O + (size_t)(rowk0 + ai * 128 + m * 16) * CC + cb + col0;
#pragma unroll
                for (int n = 0; n < 2; ++n) { const f32x4 av = acc[ai][0][m][n], gv = acc[ai][1][m][n]; f32x4 y;
#pragma unroll
                    for (int j = 0; j < 4; ++j) y[j] = av[j] * sigmoidf_(gv[j]);
                    st_bf16x4(rp + n * 16, y); } }
        } else {
            const int gt = pn - 12; bf16_t* O = wsp<bf16_t>(ws, gt < 4 ? WS_GA : WS_GB); const int cb = (gt & 3) * 256; const float* bp = bgate + gt * 256 + col0;
            f32x4 bv[2][2];
#pragma unroll
            EPI_COLS(bj, n) bv[bj][n] = *(const f32x4*)(bp + bj * 128 + n * 16);
#pragma unroll
            EPI_ROWS(ai, m) { bf16_t* rp = O + (size_t)(row0 + ai * 128 + m * 16) * DM + cb + col0;
#pragma unroll
                EPI_COLS(bj, n) { const f32x4 x = acc[ai][bj][m][n] + bv[bj][n]; f32x4 y;
#pragma unroll
                    for (int j = 0; j < 4; ++j) y[j] = sigmoidf_(x[j]);
                    st_bf16x4(rp + bj * 128 + n * 16, y); } }
        }
    }
};
struct EpiMerge {
    unsigned char* ws;
    __device__ __forceinline__ void operator()(const f32x4 (&acc)[2][2][4][2], const pg8::Unit& u, int wr, int wc, int fr, int fq) const {
        const int row0 = u.pm * 256 + wr * 64 + fr, col0 = u.pn * 256 + wc * 32 + 4 * fq;
        const bf16_t* Gt = wsp<bf16_t>(ws, u.z ? WS_GB : WS_GA); bf16_t* O = wsp<bf16_t>(ws, WS_MG);
#pragma unroll
        EPI_ROWS(ai, m) { const size_t ro = (size_t)(row0 + ai * 128 + m * 16) * DM + col0;
#pragma unroll
            EPI_COLS(bj, n) { const size_t o = ro + bj * 128 + n * 16; const u32x2 g = *(const u32x2*)(Gt + o); const f32x4 a = acc[ai][bj][m][n];
                f32x4 y = (f32x4){bflo(g.x) * a[0], bfhi(g.x) * a[1], bflo(g.y) * a[2], bfhi(g.y) * a[3]};
                if (u.z) { const u32x2 p = *(const u32x2*)(O + o); y[0] += bflo(p.x); y[1] += bfhi(p.x); y[2] += bflo(p.y); y[3] += bfhi(p.y); }
                st_bf16x4(O + o, y); } }
    }
};
struct EpiResid {
    const float* x; float* out;
    __device__ __forceinline__ void operator()(const f32x4 (&acc)[2][2][4][2], const pg8::Unit& u, int wr, int wc, int fr, int fq) const {
        const int row0 = u.pm * 256 + wr * 64 + fr, col0 = u.pn * 256 + wc * 32 + 4 * fq;
#pragma unroll
        EPI_ROWS(ai, m) { const size_t ro = (size_t)(row0 + ai * 128 + m * 16) * DM + col0;
#pragma unroll
            EPI_COLS(bj, n) { const size_t o = ro + bj * 128 + n * 16; *(f32x4*)(out + o) = *(const f32x4*)(x + o) + acc[ai][bj][m][n]; } }
    }
};
struct EpiSwiglu {
    unsigned char* ws; const float* bug; MoeTables T;
    __device__ __forceinline__ void operator()(const f32x4 (&acc)[2][2][4][2], const pg8::Unit& u, int wr, int wc, int fr, int fq) const {
        const int e = u.z, n_e = T.cnt[e], rloc0 = u.pm * 256 + wr * 64 + fr, row0 = T.tbase[e] * 256 + rloc0, col0 = u.pn * 128 + wc * 32 + 4 * fq;
        const float* bp = bug + (size_t)e * 2 * DFF + col0; bf16_t* O = wsp<bf16_t>(ws, WS_ACT);
        f32x4 bg[2], bu[2];
#pragma unroll
        for (int n = 0; n < 2; ++n) { bg[n] = *(const f32x4*)(bp + n * 16); bu[n] = *(const f32x4*)(bp + DFF + n * 16); }
#pragma unroll
        EPI_ROWS(ai, m) { const int rl = rloc0 + ai * 128 + m * 16; if (rl < n_e) { bf16_t* rp = O + (size_t)(row0 + ai * 128 + m * 16) * DFF + col0;
#pragma unroll
                for (int n = 0; n < 2; ++n) { const f32x4 gv = acc[ai][0][m][n] + bg[n], uv = acc[ai][1][m][n] + bu[n]; f32x4 y;
#pragma unroll
                    for (int j = 0; j < 4; ++j) { const float g = fminf(gv[j], 7.0f), up = fminf(fmaxf(uv[j], -7.0f), 7.0f); y[j] = (up + 1.0f) * g * sigmoidf_(1.702f * g); }
                    st_bf16x4(rp + n * 16, y); } } }
    }
};
struct EpiDown {
    unsigned char* ws; const float* bd; MoeTables T;
    __device__ __forceinline__ void operator()(const f32x4 (&acc)[2][2][4][2], const pg8::Unit& u, int wr, int wc, int fr, int fq) const {
        const int e = u.z, n_e = T.cnt[e], rloc0 = u.pm * 256 + wr * 64 + fr, row0 = T.tbase[e] * 256 + rloc0, col0 = u.pn * 256 + wc * 32 + 4 * fq;
        const float* bp = bd + (size_t)e * DM + col0; bf16_t* O = wsp<bf16_t>(ws, WS_YP); const float* lg = wsp<float>(ws, WS_LG) + (size_t)e * NTOK;
        f32x4 bv[2][2];
#pragma unroll
        EPI_COLS(bj, n) bv[bj][n] = *(const f32x4*)(bp + bj * 128 + n * 16);
#pragma unroll
        EPI_ROWS(ai, m) { const int rl = rloc0 + ai * 128 + m * 16; if (rl < n_e) { const float gt = lg[rl]; bf16_t* rp = O + (size_t)(row0 + ai * 128 + m * 16) * DM + col0;
#pragma unroll
                EPI_COLS(bj, n) st_bf16x4(rp + bj * 128 + n * 16, (acc[ai][bj][m][n] + bv[bj][n]) * gt); } }
    }
};

template <int NT>
__device__ __forceinline__ void wave_mm16(const bf16_t* __restrict__ A, int lda, const bf16_t* const (&Bt)[NT], int K, int lane, f32x4 (&acc)[NT]) {
    const bf16_t* ap = A + (size_t)(lane & 15) * lda + 8 * (lane >> 4);
    const bf16_t* bp[NT];
#pragma unroll
    for (int t = 0; t < NT; ++t) { bp[t] = Bt[t] + (size_t)(lane & 15) * K + 8 * (lane >> 4); acc[t] = (f32x4){0.f, 0.f, 0.f, 0.f}; }
#pragma unroll 4
    for (int k0 = 0; k0 < K; k0 += 32) {
        const bf16x8 a = *(const bf16x8*)(ap + k0);
#pragma unroll
        for (int t = 0; t < NT; ++t) { const bf16x8 b = *(const bf16x8*)(bp[t] + k0); acc[t] = __builtin_amdgcn_mfma_f32_16x16x32_bf16(b, a, acc[t], 0, 0, 0); }
    }
}
__device__ __forceinline__ void p1_thin(Frame& F) {
    unsigned char* ws = F.ws;
    const bf16_t* WIN = wsp<bf16_t>(ws, WS_WIN); const bf16_t* XN = wsp<bf16_t>(ws, WS_XN); const bf16_t* XNM = wsp<bf16_t>(ws, WS_XNM);
    bf16_t* KB = wsp<bf16_t>(ws, WS_KB); bf16_t* VT = wsp<bf16_t>(ws, WS_VT); bf16_t* IK = wsp<bf16_t>(ws, WS_IK); bf16_t* GLU = wsp<bf16_t>(ws, WS_GLU); float* IW = wsp<float>(ws, WS_IW);
    const int gw = F.bid * NWAVES + F.wave, NGW = F.G * NWAVES, lane = F.lane, tk = lane & 15, nq = lane >> 4;
    for (int task = gw; task < 2048; task += NGW) {
        const int tg = task >> 1, hf = task & 1, m = tg * 16 + tk, rowk = m + NMETA * ((m >> 11) + 1);
        const bf16_t* A = XN + (size_t)tg * 16 * DM;
        if (hf == 0) {
            const bf16_t* const Bt[3] = {WIN + (size_t)(WR_IK) * DM, WIN + (size_t)(WR_IK + 16) * DM, WIN + (size_t)(WR_IK + 32) * DM}; f32x4 acc[3];
            wave_mm16<3>(A, DM, Bt, DM, lane, acc);
#pragma unroll
            for (int t = 0; t < 3; ++t) st_bf16x4(IK + (size_t)rowk * IDXD + 16 * t + 4 * nq, acc[t]);
        } else {
            const bf16_t* const Bt[2] = {WIN + (size_t)(WR_IK + 48) * DM, WIN + (size_t)(WR_IW) * DM}; f32x4 acc[2];
            wave_mm16<2>(A, DM, Bt, DM, lane, acc);
            st_bf16x4(IK + (size_t)rowk * IDXD + 48 + 4 * nq, acc[0]);
            if (nq < 2) *(f32x4*)(IW + (size_t)m * 8 + 4 * nq) = acc[1];
        }
    }
    for (int task = gw; task < 100; task += NGW) {
        if (task < 32) {
            const bf16_t* const Bt[1] = {WIN + (size_t)(SC_K + 16 * task) * DM}; f32x4 acc[1]; wave_mm16<1>(XNM, DM, Bt, DM, lane, acc);
            for (int b = 0; b < NB; ++b) st_bf16x4(KB + (size_t)(b * TT + tk) * AW + 16 * task + 4 * nq, acc[0]);
        } else if (task < 64) {
            const int t = task - 32; const bf16_t* const Bt[1] = {WIN + (size_t)(SC_V + 16 * t) * DM}; f32x4 acc[1]; wave_mm16<1>(XNM, DM, Bt, DM, lane, acc);
            const float p0 = __shfl_xor(acc[0][0], 1), p1 = __shfl_xor(acc[0][1], 1), p2 = __shfl_xor(acc[0][2], 1), p3 = __shfl_xor(acc[0][3], 1);
            const unsigned wa = (tk & 1) ? cvt_pk_bf16(p2, acc[0][2]) : cvt_pk_bf16(acc[0][0], p0), wb = (tk & 1) ? cvt_pk_bf16(p3, acc[0][3]) : cvt_pk_bf16(acc[0][1], p1);
            for (int b = 0; b < NB; ++b) { bf16_t* cp = VT + ((size_t)b * AW + 16 * t + 4 * nq + 2 * (tk & 1)) * TP + VOFF + (tk & ~1);
                *(unsigned*)cp = wa; *(unsigned*)(cp + TP) = wb; }
        } else if (task < 68) {
            const int t = task - 64; const bf16_t* const Bt[1] = {WIN + (size_t)(WR_IK + 16 * t) * DM}; f32x4 acc[1]; wave_mm16<1>(XNM, DM, Bt, DM, lane, acc);
            for (int b = 0; b < NB; ++b) st_bf16x4(IK + (size_t)(b * TT + tk) * IDXD + 16 * t + 4 * nq, acc[0]);
        } else {
            const int c16 = task - 68; const int ar = WR_GLU + 256 * (c16 >> 3) + 16 * (c16 & 7);
            const bf16_t* const Bt[2] = {WIN + (size_t)ar * DM, WIN + (size_t)(ar + 128) * DM}; f32x4 acc[2]; wave_mm16<2>(XNM, DM, Bt, DM, lane, acc);
            f32x4 y;
#pragma unroll
            for (int j = 0; j < 4; ++j) y[j] = acc[0][j] * sigmoidf_(acc[1][j]);
            for (int b = 0; b < NB; ++b) st_bf16x4(GLU + (size_t)(b * TT + tk) * CC + 16 * c16 + 4 * nq, y);
        }
    }
}

__device__ __forceinline__ void p2_conv(Frame& F, const Args& a) {
    unsigned char* ws = F.ws;
    LAS unsigned char* xs = F.lds;
    LAS float* wl = (LAS float*)(F.lds + 63488);
    const bf16_t* GLU = wsp<bf16_t>(ws, WS_GLU); bf16_t* CO = wsp<bf16_t>(ws, WS_CO);
    const float* cw = a.in[I_CONVW];
    for (int idx = F.tid; idx < CW * 128; idx += NTHREADS) { const int tap = idx >> 7, c4 = idx & 127; const f32x4 v = *(const f32x4*)(cw + tap * CC + 4 * c4); *(LAS f32x4*)(wl + tap * 512 + (c4 & 1) * 256 + (c4 >> 1) * 4) = v; }
    const int lane = F.lane, c0 = 8 * lane;
    float cb[8], lg[8], lb[8];
#pragma unroll
    for (int i = 0; i < 8; ++i) { cb[i] = a.in[I_CONVB][c0 + i]; lg[i] = a.in[I_LNG][c0 + i]; lb[i] = a.in[I_LNB][c0 + i]; }
    for (int tile = F.bid; tile < NTOK / 32; tile += F.G) {
        const int b = tile >> 6, s0 = (tile & 63) * 32, p0 = NMETA + s0;
        __syncthreads();
        for (int idx = F.tid; idx < 62 * 64; idx += NTHREADS) { const int r = idx >> 6, ch = idx & 63, p = p0 - 30 + r; u32x4 v = (u32x4){0u, 0u, 0u, 0u};
            if (p >= 0) v = *(const u32x4*)(GLU + (size_t)(b * TT + p) * CC + ch * 8);
            *(LAS u32x4*)(xs + r * 1024 + ch * 16) = v; }
        __syncthreads();
        const int i0 = 4 * F.wave;
        float acc[4][8];
#pragma unroll
        for (int t = 0; t < 4; ++t)
#pragma unroll
            for (int i = 0; i < 8; ++i) acc[t][i] = 0.f;
        f32x4 wr_[4][2];
#pragma unroll
        for (int j = 0; j < 34; ++j) {
            const u32x4 xv = *(const LAS u32x4*)(xs + (i0 + j) * 1024 + lane * 16);
            const float x[8] = {bflo(xv.x), bfhi(xv.x), bflo(xv.y), bfhi(xv.y), bflo(xv.z), bfhi(xv.z), bflo(xv.w), bfhi(xv.w)};
            if (j <= 30) { wr_[j & 3][0] = *(const LAS f32x4*)(wl + j * 512 + lane * 4); wr_[j & 3][1] = *(const LAS f32x4*)(wl + j * 512 + 256 + lane * 4); }
#pragma unroll
            for (int t = 0; t < 4; ++t) { const int tap = j - t; if (tap >= 0 && tap <= 30) {
#pragma unroll
                    for (int i = 0; i < 4; ++i) { acc[t][i] += wr_[tap & 3][0][i] * x[i]; acc[t][4 + i] += wr_[tap & 3][1][i] * x[4 + i]; } } }
        }
#pragma unroll
        for (int t = 0; t < 4; ++t) {
            float s = 0.f;
#pragma unroll
            for (int i = 0; i < 8; ++i) { acc[t][i] += cb[i]; s += acc[t][i]; }
            const float mean = wave_sum(s) * (1.f / CC); float q = 0.f;
#pragma unroll
            for (int i = 0; i < 8; ++i) { acc[t][i] -= mean; q += acc[t][i] * acc[t][i]; }
            const float rstd = 1.0f / sqrtf(wave_sum(q) * (1.f / CC) + EPS);
            float y[8];
#pragma unroll
            for (int i = 0; i < 8; ++i) { const float z = acc[t][i] * rstd * lg[i] + lb[i]; y[i] = z * sigmoidf_(z); }
            u32x4 o; o.x = cvt_pk_bf16(y[0], y[1]); o.y = cvt_pk_bf16(y[2], y[3]); o.z = cvt_pk_bf16(y[4], y[5]); o.w = cvt_pk_bf16(y[6], y[7]);
            *(u32x4*)(CO + (size_t)(b * SEQ + s0 + i0 + t) * CC + c0) = o;
        }
    }
    __syncthreads();
}

constexpr int ROWP = 2080, NJ = 33;
__device__ __forceinline__ unsigned f2ord(float f) { const unsigned b = __float_as_uint(f); return b ^ ((b >> 31) ? 0xffffffffu : 0x80000000u); }
__device__ __forceinline__ int wave_isum(int v) {
#pragma unroll
    for (int o = 1; o < 64; o <<= 1) v += __shfl_xor(v, o);
    return v;
}
__device__ __forceinline__ void p2_indexer_unit(Frame& F, int b, int q16) {
    unsigned char* ws = F.ws;
    const bf16_t* IQ = wsp<bf16_t>(ws, WS_IQ); const bf16_t* IK = wsp<bf16_t>(ws, WS_IK); const float* IW = wsp<float>(ws, WS_IW); unsigned* MASK = wsp<unsigned>(ws, WS_MASK);
    LAS unsigned* SU = (LAS unsigned*)F.lds;
    const int lane = F.lane, c = lane & 31, hi = lane >> 5, w = F.wave;
    const int nwblk = (q16 >> 1) + 2;
    {
        const int qg = w & 3, par = w >> 2, tok0 = b * SEQ + 16 * q16 + 4 * qg;
        bf16x8 af[4];
        { const bf16_t* ap = IQ + (size_t)(tok0 + (c >> 3)) * AW + (c & 7) * IDXD + 8 * hi;
#pragma unroll
          for (int ks = 0; ks < 4; ++ks) af[ks] = *(const bf16x8*)(ap + 16 * ks); }
        f32x4 wq[4];
#pragma unroll
        for (int q = 0; q < 4; ++q) wq[q] = *(const f32x4*)(IW + (size_t)(tok0 + q) * 8 + 4 * hi);
        int rel[2];
#pragma unroll
        for (int p = 0; p < 2; ++p) rel[p] = NMETA + 16 * q16 + 4 * qg + p + 2 * hi - c;
        const bf16_t* kp = IK + (size_t)(b * TT + c) * IDXD + 8 * hi;
        LAS unsigned* srow = SU + (4 * qg + 2 * hi) * ROWP + c;
        for (int blk = par; blk < nwblk; blk += 2) {
            bf16x8 bfr[4];
#pragma unroll
            for (int ks = 0; ks < 4; ++ks) bfr[ks] = *(const bf16x8*)(kp + (size_t)blk * 32 * IDXD + 16 * ks);
            f32x16 acc = {};
#pragma unroll
            for (int ks = 0; ks < 4; ++ks) acc = __builtin_amdgcn_mfma_f32_32x32x16_bf16(af[ks], bfr[ks], acc, 0, 0, 0);
            float full[4];
#pragma unroll
            for (int q = 0; q < 4; ++q) { float s = 0.f;
#pragma unroll
                for (int i = 0; i < 4; ++i) s += wq[q][i] * fmaxf(acc[4 * q + i], 0.f);
                full[q] = s + __shfl_xor(s, 32); }
#pragma unroll
            for (int p = 0; p < 2; ++p) { const float sc = hi ? full[p + 2] : full[p]; srow[p * ROWP + 32 * blk] = (32 * blk <= rel[p]) ? f2ord(sc) : 0u; }
        }
    }
    __syncthreads();
    {
        const int nj = (nwblk + 1) >> 1, klim = 32 * nwblk;
        unsigned U[NJ][2];
#pragma unroll
        for (int j = 0; j < NJ; ++j) {
            if (j < nj) { const int key = 64 * j + lane;
#pragma unroll
                for (int p = 0; p < 2; ++p) U[j][p] = (key < klim) ? SU[(2 * w + p) * ROWP + key] : 0u; }
            else { U[j][0] = 0u; U[j][1] = 0u; }
        }
        const int tokb = b * SEQ + 16 * q16 + 2 * w;
        unsigned lo[2], hb[2], thr[2], veq[2]; int chi[2], need[2]; bool done[2];
#pragma unroll
        for (int p = 0; p < 2; ++p) { lo[p] = 1u; hb[p] = 0xffffffffu; chi[p] = 0; need[p] = 0; veq[p] = 0u; thr[p] = 1u; done[p] = (NMETA + 16 * q16 + 2 * w + p + 1 <= TOPK); }
        for (int it = 0; it < 34; ++it) {
            if (done[0] && done[1]) break;
            unsigned mid[2]; int cnt[2];
#pragma unroll
            for (int p = 0; p < 2; ++p) { mid[p] = lo[p] + ((hb[p] - lo[p]) >> 1); cnt[p] = 0; }
#pragma unroll
            for (int j = 0; j < NJ; ++j) if (j < nj) {
#pragma unroll
                for (int p = 0; p < 2; ++p) cnt[p] += (U[j][p] >= mid[p]) ? 1 : 0; }
#pragma unroll
            for (int p = 0; p < 2; ++p) {
                const int ct = wave_isum(cnt[p]);
                if (!done[p]) {
                    if (ct == TOPK) { done[p] = true; thr[p] = mid[p]; need[p] = 0; }
                    else if (ct > TOPK) lo[p] = mid[p];
                    else { hb[p] = mid[p]; chi[p] = ct; }
                    if (!done[p] && hb[p] - lo[p] == 1u) { done[p] = true; thr[p] = hb[p]; veq[p] = lo[p]; need[p] = TOPK - chi[p]; }
                }
            }
        }
#pragma unroll
        for (int p = 0; p < 2; ++p) {
            int run = 0;
            unsigned long long* mrow = (unsigned long long*)(MASK + (size_t)(tokb + p) * MSTR);
#pragma unroll
            for (int j = 0; j < NJ; ++j) if (j < nj) {
                const unsigned u = U[j][p];
                const bool eq = (need[p] > 0) && (u == veq[p]);
                const unsigned long long em = __ballot(eq);
                const int rank = run + (int)__builtin_amdgcn_mbcnt_hi((unsigned)(em >> 32), __builtin_amdgcn_mbcnt_lo((unsigned)em, 0u));
                const bool take = (u >= thr[p]) || (eq && rank < need[p]);
                run += __popcll(em);
                const unsigned long long sm = __ballot(take);
                if (lane == 0) mrow[j] = sm;
            }
        }
    }
    __syncthreads();
}
__device__ __forceinline__ void p2_indexer(Frame& F) {
    for (int i = F.bid; i < 256; i += F.G) { const int b = i >> 5, j = 2 * (i & 31);
        p2_indexer_unit(F, b, j); p2_indexer_unit(F, b, 127 - j); p2_indexer_unit(F, b, j + 1); p2_indexer_unit(F, b, 126 - j); }
}

__device__ const unsigned char T5B[128] = {0, 1, 2, 3, 4, 5, 6, 7, 8, 9, 10, 11, 12, 13, 14, 15, 16, 16, 16, 17, 17, 18, 18, 18, 19, 19, 19, 20, 20, 20, 20, 21, 21, 21, 21, 22, 22, 22, 22, 22, 23, 23, 23, 23, 23, 23, 24, 24, 24, 24, 24, 24, 25, 25, 25, 25, 25, 25, 25, 26, 26, 26, 26, 26, 26, 26, 26, 27, 27, 27, 27, 27, 27, 27, 27, 27, 27, 28, 28, 28, 28, 28, 28, 28, 28, 28, 28, 29, 29, 29, 29, 29, 29, 29, 29, 29, 29, 29, 29, 30, 30, 30, 30, 30, 30, 30, 30, 30, 30, 30, 30, 30, 30, 31, 31, 31, 31, 31, 31, 31, 31, 31, 31, 31, 31, 31, 31, 31};
constexpr int TBS = 132;
__device__ __forceinline__ int crow(int r, int hi) { return (r & 3) + 8 * (r >> 2) + 4 * hi; }
__device__ __forceinline__ void p3_attn_unit(Frame& F, int b, int qb, const LAS float* tb, LAS float* sc) {
    unsigned char* ws = F.ws;
    const bf16_t* Q = wsp<bf16_t>(ws, WS_Q); const bf16_t* KB = wsp<bf16_t>(ws, WS_KB); const bf16_t* VT = wsp<bf16_t>(ws, WS_VT); const unsigned* MASK = wsp<unsigned>(ws, WS_MASK); bf16_t* AO = wsp<bf16_t>(ws, WS_AO);
    const int lane = F.lane, c = lane & 31, hi = lane >> 5, h = F.wave;
    const int tokq = b * SEQ + 32 * qb + c, posq = NMETA + 32 * qb + c;
    bf16x8 qf[4];
#pragma unroll
    for (int ks = 0; ks < 4; ++ks) qf[ks] = *(const bf16x8*)(Q + (size_t)tokq * AW + h * HD + 16 * ks + 8 * hi);
    const unsigned* mrow = MASK + (size_t)tokq * MSTR;
    const LAS float* tbh = tb + h * TBS;
    const float NEG = -INFINITY;
    float m_run = NEG, l = 0.f; f32x16 O0 = {}, O1 = {};
    const bf16_t* kbase = KB + (size_t)(b * TT + c) * AW + h * HD + 8 * hi;
    const bf16_t* vbase = VT + ((size_t)b * AW + h * HD + c) * TP + VOFF + 4 * hi;
    for (int kb = 0; kb <= qb + 1; ++kb) {
        bf16x8 kf[4];
#pragma unroll
        for (int ks = 0; ks < 4; ++ks) kf[ks] = *(const bf16x8*)(kbase + (size_t)kb * 32 * AW + 16 * ks);
        const unsigned mw = mrow[kb];
        s16x4 vlo[2][2], vhi[2][2];
#pragma unroll
        for (int s2 = 0; s2 < 2; ++s2)
#pragma unroll
            for (int db = 0; db < 2; ++db) { const bf16_t* vp = vbase + (size_t)db * 32 * TP + 32 * kb + 16 * s2; vlo[s2][db] = *(const s16x4*)vp; vhi[s2][db] = *(const s16x4*)(vp + 8); }
        f32x16 S = {};
#pragma unroll
        for (int ks = 0; ks < 4; ++ks) S = __builtin_amdgcn_mfma_f32_32x32x16_bf16(kf[ks], qf[ks], S, 0, 0, 0);
        const bool far = (qb - kb >= 5);
        const float bfar = tbh[128];
        const int dbase = posq - 32 * kb;
        float tmax = NEG;
#pragma unroll
        for (int r = 0; r < 16; ++r) { const int kvl = crow(r, hi);
            float bias = bfar;
            if (!far) { int d = dbase - kvl; d = d < 0 ? 0 : (d > 128 ? 128 : d); bias = tbh[d]; }
            const float s = ((mw >> kvl) & 1u) ? S[r] + bias : NEG;
            S[r] = s; tmax = fmaxf(tmax, s); }
        tmax = fmaxf(tmax, __shfl_xor(tmax, 32));
        const float m_new = fmaxf(m_run, tmax), m_use = (m_new == NEG) ? 0.f : m_new;
        const float alpha = __builtin_amdgcn_exp2f(m_run - m_use);
        float ps = 0.f;
#pragma unroll
        for (int r = 0; r < 16; ++r) { S[r] = __builtin_amdgcn_exp2f(S[r] - m_use); ps += S[r]; }
        l = l * alpha + ps; m_run = m_new;
        if (hi == 0) sc[c] = alpha;
        LDS_WAIT(); asm volatile("" ::: "memory");
#pragma unroll
        for (int r = 0; r < 16; ++r) { const float f = sc[crow(r, hi)]; O0[r] *= f; O1[r] *= f; }
        LDS_WAIT(); asm volatile("" ::: "memory");
#pragma unroll
        for (int s2 = 0; s2 < 2; ++s2) {
            u32x4 pw; pw.x = cvt_pk_bf16(S[8 * s2 + 0], S[8 * s2 + 1]); pw.y = cvt_pk_bf16(S[8 * s2 + 2], S[8 * s2 + 3]); pw.z = cvt_pk_bf16(S[8 * s2 + 4], S[8 * s2 + 5]); pw.w = cvt_pk_bf16(S[8 * s2 + 6], S[8 * s2 + 7]);
            const bf16x8 pf = __builtin_bit_cast(bf16x8, pw);
            const bf16x8 v0 = (bf16x8){vlo[s2][0][0], vlo[s2][0][1], vlo[s2][0][2], vlo[s2][0][3], vhi[s2][0][0], vhi[s2][0][1], vhi[s2][0][2], vhi[s2][0][3]};
            const bf16x8 v1 = (bf16x8){vlo[s2][1][0], vlo[s2][1][1], vlo[s2][1][2], vlo[s2][1][3], vhi[s2][1][0], vhi[s2][1][1], vhi[s2][1][2], vhi[s2][1][3]};
            O0 = __builtin_amdgcn_mfma_f32_32x32x16_bf16(pf, v0, O0, 0, 0, 0);
            O1 = __builtin_amdgcn_mfma_f32_32x32x16_bf16(pf, v1, O1, 0, 0, 0);
        }
    }
    const float lt = l + __shfl_xor(l, 32);
    if (hi == 0) sc[c] = 1.0f / lt;
    LDS_WAIT(); asm volatile("" ::: "memory");
    bf16_t* ob = AO + (size_t)(b * SEQ + 32 * qb) * AW + h * HD + c;
#pragma unroll
    for (int r = 0; r < 16; ++r) { const int qr = crow(r, hi); const float f = sc[qr];
        const float a0 = O0[r] * f, a1 = O1[r] * f, b0 = __shfl_xor(a0, 1), b1 = __shfl_xor(a1, 1);
        if ((c & 1) == 0) { *(unsigned*)(ob + (size_t)qr * AW) = cvt_pk_bf16(a0, b0); *(unsigned*)(ob + (size_t)qr * AW + 32) = cvt_pk_bf16(a1, b1); } }
    LDS_WAIT(); asm volatile("" ::: "memory");
}
__device__ __forceinline__ void p3_attn(Frame& F, const Args& a) {
    LAS float* tb = (LAS float*)F.lds;
    LAS float* sc = (LAS float*)(F.lds + 8192) + F.wave * 32;
    __syncthreads();
    for (int idx = F.tid; idx < NH * 129; idx += NTHREADS) { const int h = idx / 129, d = idx % 129; const int bk = d < 128 ? (int)T5B[d] : 31; tb[h * TBS + d] = a.in[I_RELB][bk * NH + h] * LOG2E; }
    __syncthreads();
    for (int i = F.bid; i < 256; i += F.G) { const int b = i >> 5, j = i & 31; p3_attn_unit(F, b, j, tb, sc); p3_attn_unit(F, b, 63 - j, tb, sc); }
    __syncthreads();
}

__device__ __forceinline__ void p6_router(Frame& F, const Args& a) {
    unsigned char* ws = F.ws;
    const float* H1 = a.out; bf16_t* HN = wsp<bf16_t>(ws, WS_XN);
    const float* gf = a.in[I_NFFN]; const float* wrt = a.in[I_WR]; const float* brt = a.in[I_BR];
    int* TE = wsp<int>(ws, WS_TE); int* TPs = wsp<int>(ws, WS_TP); int* LIST = wsp<int>(ws, WS_LIST); float* LG = wsp<float>(ws, WS_LG);
    unsigned* ecnt = wsp<unsigned>(ws, WS_CTL) + CW_ECNT;
    LAS float* rinv = (LAS float*)F.lds;
    LAS float* part = (LAS float*)(F.lds + 1024);
    LAS int* lcnt = (LAS int*)(F.lds + 1024 + 8 * 64 * 33 * 4);
    LAS int* lbase = lcnt + 32;
    const int lane = F.lane, w = F.wave;
    for (int tb = F.bid; tb < NTOK / 64; tb += F.G) {
        const int t0 = tb * 64;
        __syncthreads();
        if (F.tid < 32) lcnt[F.tid] = 0;
        for (int i = 0; i < 8; ++i) {
            const int t = t0 + 8 * w + i; const f32x4* xr = (const f32x4*)(H1 + (size_t)t * DM) + lane; const f32x4* gr = (const f32x4*)gf + lane;
            f32x4 v[4]; float s = 0.f;
#pragma unroll
            for (int j = 0; j < 4; ++j) { v[j] = xr[64 * j]; s += (v[j].x * v[j].x + v[j].y * v[j].y) + (v[j].z * v[j].z + v[j].w * v[j].w); }
            const float r = 1.0f / sqrtf(wave_sum(s) * (1.f / DM) + EPS);
            if (lane == 0) rinv[8 * w + i] = r;
            unsigned long long* o8 = (unsigned long long*)(HN + (size_t)t * DM) + lane;
#pragma unroll
            for (int j = 0; j < 4; ++j) { const f32x4 gg = gr[64 * j];
                o8[64 * j] = (unsigned long long)cvt_pk_bf16(v[j].x * r * gg.x, v[j].y * r * gg.y) | ((unsigned long long)cvt_pk_bf16(v[j].z * r * gg.z, v[j].w * r * gg.w) << 32); }
        }
        __syncthreads();
        {
            const float r = rinv[lane]; const float* xr = H1 + (size_t)(t0 + lane) * DM + 128 * w;
            float acc[NE];
#pragma unroll
            for (int e = 0; e < NE; ++e) acc[e] = 0.f;
            for (int k4 = 0; k4 < 32; ++k4) {
                const f32x4 xv = *(const f32x4*)(xr + 4 * k4);
#pragma unroll
                for (int kk = 0; kk < 4; ++kk) { const int k = 128 * w + 4 * k4 + kk; const float hn = xv[kk] * r * gf[k]; const float* wrow = wrt + (size_t)k * NE;
#pragma unroll
                    for (int e = 0; e < NE; ++e) acc[e] += hn * wrow[e]; }
            }
#pragma unroll
            for (int e = 0; e < NE; ++e) part[(w * 64 + lane) * 33 + e] = acc[e];
        }
        __syncthreads();
        if (w == 0) {
            float lg[NE];
#pragma unroll
            for (int e = 0; e < NE; ++e) { float s = brt[e];
#pragma unroll
                for (int ww = 0; ww < 8; ++ww) s += part[(ww * 64 + lane) * 33 + e];
                lg[e] = s; }
            int sel[4]; float val[4];
#pragma unroll
            for (int j = 0; j < 4; ++j) { float best = -INFINITY; int bi = 0;
#pragma unroll
                for (int e = 0; e < NE; ++e) { const bool tk = lg[e] > best; best = tk ? lg[e] : best; bi = tk ? e : bi; }
                sel[j] = bi; val[j] = best;
#pragma unroll
                for (int e = 0; e < NE; ++e) lg[e] = (e == bi) ? -INFINITY : lg[e]; }
            float den = 0.f, ex[4];
#pragma unroll
            for (int j = 0; j < 4; ++j) { ex[j] = __expf(val[j] - val[0]); den += ex[j]; }
            int slot[4];
#pragma unroll
            for (int j = 0; j < 4; ++j) slot[j] = __hip_atomic_fetch_add(&lcnt[sel[j]], 1, __ATOMIC_RELAXED, __HIP_MEMORY_SCOPE_WORKGROUP);
            LDS_WAIT();
            if (lane < 32) { const int n = lcnt[lane]; lbase[lane] = n ? (int)__hip_atomic_fetch_add(ecnt + 64 * lane, (unsigned)n, RLX_AGENT) : 0; }
            LDS_WAIT(); asm volatile("" ::: "memory");
            const int t = t0 + lane;
#pragma unroll
            for (int j = 0; j < 4; ++j) { const int e = sel[j], pos = lbase[e] + slot[j]; const float g = ex[j] / den;
                TE[t * 4 + j] = e; TPs[t * 4 + j] = pos; LIST[(size_t)e * NTOK + pos] = t; LG[(size_t)e * NTOK + pos] = g; }
        }
    }
    __syncthreads();
}
__device__ __forceinline__ void moe_tables(Frame& F, LAS int* cnt, LAS int* tbase) {
    const unsigned* ecnt = wsp<unsigned>(F.ws, WS_CTL) + CW_ECNT;
    __syncthreads();
    if (F.tid < NE) cnt[F.tid] = (int)__hip_atomic_load(ecnt + 64 * F.tid, RLX_AGENT);
    __syncthreads();
    if (F.tid == 0) { int s = 0; for (int e = 0; e < NE; ++e) { tbase[e] = s; s += (cnt[e] + 255) >> 8; } tbase[NE] = s; }
    __syncthreads();
}

__device__ __forceinline__ void p9_final(Frame& F, const Args& a, const LAS int* tbase) {
    unsigned char* ws = F.ws;
    float* H1 = a.out; const bf16_t* YP = wsp<bf16_t>(ws, WS_YP); const int* TE = wsp<int>(ws, WS_TE); const int* TPs = wsp<int>(ws, WS_TP); const float* gf = a.in[I_NFIN];
    const int gw = F.bid * NWAVES + F.wave, NGW = F.G * NWAVES, lane = F.lane;
    for (int t = gw; t < NTOK; t += NGW) {
        f32x4* xr = (f32x4*)(H1 + (size_t)t * DM) + lane; const f32x4* gr = (const f32x4*)gf + lane;
        f32x4 v[4];
#pragma unroll
        for (int j = 0; j < 4; ++j) v[j] = xr[64 * j];
#pragma unroll
        for (int jj = 0; jj < 4; ++jj) { const int e = TE[t * 4 + jj], pos = TPs[t * 4 + jj]; const u32x2* yr = (const u32x2*)(YP + (size_t)(tbase[e] * 256 + pos) * DM) + lane;
#pragma unroll
            for (int j = 0; j < 4; ++j) { const u32x2 y = yr[64 * j]; v[j].x += bflo(y.x); v[j].y += bfhi(y.x); v[j].z += bflo(y.y); v[j].w += bfhi(y.y); } }
        float s = 0.f;
#pragma unroll
        for (int j = 0; j < 4; ++j) s += (v[j].x * v[j].x + v[j].y * v[j].y) + (v[j].z * v[j].z + v[j].w * v[j].w);
        const float r = 1.0f / sqrtf(wave_sum(s) * (1.f / DM) + EPS);
#pragma unroll
        for (int j = 0; j < 4; ++j) { const f32x4 gg = gr[64 * j]; xr[64 * j] = (f32x4){v[j].x * r * gg.x, v[j].y * r * gg.y, v[j].z * r * gg.z, v[j].w * r * gg.w}; }
    }
}

constexpr int N_PHASES = 10;
__global__ void __launch_bounds__(NTHREADS, 2) fwd_kernel(Args args) {
    extern __shared__ __attribute__((aligned(16))) unsigned char lds_raw[];
    Frame F;
    F.lds = (LAS unsigned char*)lds_raw; F.ws = args.ws;
    F.tid = threadIdx.x; F.lane = F.tid & 63; F.wave = __builtin_amdgcn_readfirstlane(F.tid >> 6);
    F.G = gridDim.x; F.bid = blockIdx.x;
    volatile LAS unsigned* MISC = (volatile LAS unsigned*)(F.lds + MISC_OFF);
    if (F.tid < 32) MISC[F.tid] = 0u;
    __syncthreads();
    unsigned* ctl = wsp<unsigned>(args.ws, WS_CTL);
    const int lo = args.ph_lo, hi = args.ph_hi;
    const bool multi = (hi - lo) > 1;
    XcdBarrier bar; bar.bar = ctl + CW_BAR; bar.x = 0; bar.st = nullptr;
    if (multi) bar = xcd_barrier_post(ctl + CW_BAR, MISC + 8);
#ifndef PHASE_MASK
#define PHASE_MASK 0x3ff
#endif
#define IN(k) (((PHASE_MASK >> (k)) & 1) && lo <= (k) && (k) < hi)
#define SEAM(k) do { if (IN(k) && IN((k) + 1)) xcd_barrier(bar); } while (0)
    LAS int* l_cnt = (LAS int*)(F.lds + LDSX_OFF); LAS int* l_tbase = l_cnt + 64;
    const MoeTables MT{l_cnt, l_tbase};

    if (IN(0)) { p0_prologue(F, args); } SEAM(0);
    if (IN(1)) {
        PlainSched S; S.init(args.ws, WS_XN, WS_WIN, NTOK, 5120, DM, F.G, F.bid);
        EpiInProj E{args.ws, args.in[I_BGATE]};
        pg8::gemm_phase<EpiInProj, PlainSched>(F.lds, DM, S, E);
        p1_thin(F);
    } SEAM(1);
    if (IN(2)) {
#ifndef DBG_NO_CONV
        p2_conv(F, args);
#endif
#ifndef DBG_NO_IDX
        p2_indexer(F);
#endif
    } SEAM(2);
    if (IN(3)) { p3_attn(F, args); } SEAM(3);
    if (IN(4)) {
        MergeSched S{(const char*)args.ws, F.G, F.bid}; EpiMerge E{args.ws};
        pg8::gemm_phase<EpiMerge, MergeSched>(F.lds, 512, S, E);
    } SEAM(4);
    if (IN(5)) {
        PlainSched S; S.init(args.ws, WS_MG, WS_WOUT, NTOK, DM, DM, F.G, F.bid);
        EpiResid E{args.in[I_X], args.out};
        pg8::gemm_phase<EpiResid, PlainSched>(F.lds, DM, S, E);
    } SEAM(5);
    if (IN(6)) { p6_router(F, args); } SEAM(6);
    if (IN(7)) {
        moe_tables(F, l_cnt, l_tbase);
        MoeSched<8, true> S{(const char*)args.ws, MT, F.G, F.bid, l_tbase[NE] * 8};
        EpiSwiglu E{args.ws, args.in[I_BUG], MT};
        pg8::gemm_phase<EpiSwiglu, MoeSched<8, true>>(F.lds, DM, S, E);
    } SEAM(7);
    if (IN(8)) {
        moe_tables(F, l_cnt, l_tbase);
        MoeSched<4, false> S{(const char*)args.ws, MT, F.G, F.bid, l_tbase[NE] * 4};
        EpiDown E{args.ws, args.in[I_BD], MT};
        pg8::gemm_phase<EpiDown, MoeSched<4, false>>(F.lds, DFF, S, E);
    } SEAM(8);
    if (IN(9)) { moe_tables(F, l_cnt, l_tbase); p9_final(F, args, l_tbase); }
#undef IN
#undef SEAM
}

#ifdef DBG_HASH_OFF
__global__ void dbg_hash(const unsigned* __restrict__ buf, size_t nwords, unsigned* acc) {
    unsigned h = 0u;
    for (size_t i = (size_t)blockIdx.x * blockDim.x + threadIdx.x; i < nwords; i += (size_t)gridDim.x * blockDim.x) h += (buf[i] ^ (unsigned)(i * 2654435761u)) * 2246822519u + (unsigned)i;
#pragma unroll
    for (int o = 1; o < 64; o <<= 1) h += __shfl_xor(h, o);
    if ((threadIdx.x & 63) == 0) atomicAdd(acc, h);
}
__global__ void dbg_fill(float* out, size_t n, const unsigned* acc) {
    const unsigned h = *acc; const float v = (float)((h >> 7) & 0xffffu) * (1.0f / 4096.0f) + 1.0f;
    for (size_t i = (size_t)blockIdx.x * blockDim.x + threadIdx.x; i < n; i += (size_t)gridDim.x * blockDim.x) out[i] = v;
}
#endif

extern "C" void kernel_launch(void* const* d_in, const int* in_sizes, int n_in, void* d_out, int out_size, void* d_ws, size_t ws_size, hipStream_t stream) {
    static int grid = 0;
    if (grid == 0) {
        if (n_in != 21 || out_size != NTOK * DM || ws_size < WS_END) { fprintf(stderr, "kernel_launch: unexpected shapes (n_in %d, out %d, ws %zu < %zu)\n", n_in, out_size, ws_size, (size_t)WS_END); grid = -1; return; }
        int dev = 0, cus = 0, per_cu = 0;
        if (hipGetDevice(&dev) != hipSuccess || hipDeviceGetAttribute(&cus, hipDeviceAttributeMultiprocessorCount, dev) != hipSuccess) { grid = -1; return; }
        if (hipFuncSetAttribute((const void*)fwd_kernel, hipFuncAttributeMaxDynamicSharedMemorySize, LDS_BYTES) != hipSuccess) { fprintf(stderr, "kernel_launch: hipFuncSetAttribute failed\n"); grid = -1; return; }
        if (hipOccupancyMaxActiveBlocksPerMultiprocessor(&per_cu, (const void*)fwd_kernel, NTHREADS, LDS_BYTES) != hipSuccess || per_cu < 1) { fprintf(stderr, "kernel_launch: occupancy query says %d\n", per_cu); }
        (void)hipGetLastError();
        grid = cus;
    }
    if (grid < 0) return;
    (void)hipMemsetAsync((char*)d_ws + WS_CTL, 0, CTL_ZERO_BYTES, stream);
    Args a{};
    for (int i = 0; i < 21; ++i) a.in[i] = (const float*)d_in[i];
    a.out = (float*)d_out; a.ws = (unsigned char*)d_ws;
#if MK_N_LAUNCHES == 1
    a.ph_lo = 0; a.ph_hi = N_PHASES;
    hipLaunchKernelGGL(fwd_kernel, dim3(grid), dim3(NTHREADS), LDS_BYTES, stream, a);
#else
#ifndef DBG_LAST_PHASE
#define DBG_LAST_PHASE (N_PHASES - 1)
#endif
    for (int p = 0; p <= DBG_LAST_PHASE; ++p) { a.ph_lo = p; a.ph_hi = p + 1; hipLaunchKernelGGL(fwd_kernel, dim3(grid), dim3(NTHREADS), LDS_BYTES, stream, a); }
#ifdef DBG_HASH_OFF
    { const unsigned* hb = DBG_HASH_OFF == 0 ? (const unsigned*)d_out : (const unsigned*)((char*)d_ws + DBG_HASH_OFF);
      hipLaunchKernelGGL(dbg_hash, dim3(1024), dim3(256), 0, stream, hb, (size_t)(DBG_HASH_BYTES) / 4, (unsigned*)d_ws + 2);
      hipLaunchKernelGGL(dbg_fill, dim3(1024), dim3(256), 0, stream, (float*)d_out, (size_t)NTOK * DM, (const unsigned*)d_ws + 2); }
#endif
#endif
}
```

```cpp
#include <hip/hip_runtime.h>
#include <cstdio>
#include <cstdint>

#ifndef MK_N_LAUNCHES
#define MK_N_LAUNCHES 1
#endif

constexpr int NB = 8, SEQ = 2048, NMETA = 16, TT = SEQ + NMETA  , DM = 1024, NTOK = NB * SEQ  , NALL = NB * TT  ;
constexpr int AW = 512, NH = 8, HD = 64, IDXD = 64, CC = 512, CW = 31, NE = 32, DFF = 1024, TOPK = 256;
constexpr int INCOLS = 5192, TP = 2176  , VOFF = 48  , MSTR = 68  ;
constexpr float EPS = 1e-6f, LOG2E = 1.4426950408889634f;
constexpr float QSCALE = 0.125f * LOG2E;
constexpr int MAXTILES = 296;
constexpr int SC_Q = 0, SC_K = 512, SC_V = 1024, SC_IQ = 1536, SC_IK = 2048, SC_IW = 2112, SC_GLU = 2120, SC_GATE = 3144;
constexpr int WR_GLU = 2048, WR_GATE = 3072, WR_IK = 5120, WR_IW = 5184, WIN_ROWS = 5376;

constexpr size_t MiB = 1u << 20;
constexpr size_t al4k(size_t x) { return (x + 4095) & ~(size_t)4095; }
constexpr size_t WS_CTL = 0, CTL_ZERO_BYTES = 1 * MiB;
constexpr size_t WS_WIN = 1 * MiB;
constexpr size_t WS_WAO = WS_WIN + al4k((size_t)WIN_ROWS * DM * 2);
constexpr size_t WS_WCO = WS_WAO + al4k((size_t)DM * AW * 2);
constexpr size_t WS_WOUT = WS_WCO + al4k((size_t)DM * CC * 2);
constexpr size_t WS_WUG = WS_WOUT + al4k((size_t)DM * DM * 2);
constexpr size_t WS_WD = WS_WUG + al4k((size_t)NE * 2 * DFF * DM * 2);
constexpr size_t WS_XN = WS_WD + al4k((size_t)NE * DM * DFF * 2);
constexpr size_t WS_XNM = WS_XN + al4k((size_t)NTOK * DM * 2);
constexpr size_t WS_Q = WS_XNM + al4k((size_t)NMETA * DM * 2);
constexpr size_t WS_IQ = WS_Q + al4k((size_t)NTOK * AW * 2);
constexpr size_t WS_KB = WS_IQ + al4k((size_t)NTOK * AW * 2);
constexpr size_t WS_VT = WS_KB + al4k((size_t)(NALL + 64) * AW * 2);
constexpr size_t WS_IK = WS_VT + al4k((size_t)NB * AW * TP * 2);
constexpr size_t WS_IW = WS_IK + al4k((size_t)(NALL + 64) * IDXD * 2);
constexpr size_t WS_GLU = WS_IW + al4k((size_t)NTOK * 8 * 4);
constexpr size_t WS_GA = WS_GLU + al4k((size_t)NALL * CC * 2);
constexpr size_t WS_GB = WS_GA + al4k((size_t)NTOK * DM * 2);
constexpr size_t WS_MASK = WS_GB + al4k((size_t)NTOK * DM * 2);
constexpr size_t WS_AO = WS_MASK + al4k((size_t)NTOK * MSTR * 4);
constexpr size_t WS_CO = WS_AO + al4k((size_t)NTOK * AW * 2);
constexpr size_t WS_MG = WS_CO + al4k((size_t)NTOK * CC * 2);
constexpr size_t WS_TE = WS_MG + al4k((size_t)NTOK * DM * 2);
constexpr size_t WS_TP = WS_TE + al4k((size_t)NTOK * 4 * 4);
constexpr size_t WS_LIST = WS_TP + al4k((size_t)NTOK * 4 * 4);
constexpr size_t WS_LG = WS_LIST + al4k((size_t)NE * NTOK * 4);
constexpr size_t WS_ACT = WS_LG + al4k((size_t)NE * NTOK * 4);
constexpr size_t WS_YP = WS_ACT + al4k((size_t)MAXTILES * 256 * DFF * 2);
constexpr size_t WS_END = WS_YP + al4k((size_t)MAXTILES * 256 * DM * 2);
static_assert(WS_END < ((size_t)1 << 32), "32-bit byte offsets into d_ws");
constexpr int CW_TMO = 0, CW_CODE = 1, CW_BAR = 4096, CW_ECNT = 16384;

constexpr int RING_BYTES = 131072;
constexpr int LDSX_OFF = RING_BYTES;
constexpr int MISC_OFF = RING_BYTES + 8192;
constexpr int LDS_BYTES = 147456;
constexpr int NWAVES = 8, NTHREADS = 512;

#define GAS __attribute__((address_space(1)))
#define LAS __attribute__((address_space(3)))
typedef unsigned short bf16_t;
typedef short bf16x8 __attribute__((ext_vector_type(8)));
typedef short s16x4 __attribute__((ext_vector_type(4)));
typedef float f32x4 __attribute__((ext_vector_type(4)));
typedef float f32x16 __attribute__((ext_vector_type(16)));
typedef unsigned u32x4 __attribute__((ext_vector_type(4)));
typedef unsigned u32x2 __attribute__((ext_vector_type(2)));
typedef GAS unsigned gu32;
#define RLX_AGENT __ATOMIC_RELAXED, __HIP_MEMORY_SCOPE_AGENT
#define LDS_WAIT() asm volatile("s_waitcnt lgkmcnt(0)" ::: "memory")
#define VM_WAIT() asm volatile("s_waitcnt vmcnt(0)" ::: "memory")

typedef float f32x2_t __attribute__((ext_vector_type(2))); typedef __bf16 bf16x2_t __attribute__((ext_vector_type(2)));
__device__ __forceinline__ unsigned cvt_pk_bf16(float lo, float hi) { const f32x2_t v = {lo, hi}; const bf16x2_t b = __builtin_convertvector(v, bf16x2_t); return __builtin_bit_cast(unsigned, b); }
__device__ __forceinline__ float bf2f(unsigned short b) { return __uint_as_float((unsigned)b << 16); }
__device__ __forceinline__ float bflo(unsigned w) { return __uint_as_float(w << 16); }
__device__ __forceinline__ float bfhi(unsigned w) { return __uint_as_float(w & 0xffff0000u); }
__device__ __forceinline__ float sigmoidf_(float x) { return __builtin_amdgcn_rcpf(1.0f + __builtin_amdgcn_exp2f(-LOG2E * x)); }
__device__ __forceinline__ float wave_sum(float v) {
#pragma unroll
    for (int o = 1; o < 64; o <<= 1) v += __shfl_xor(v, o);
    return v;
}

namespace pg8 {
constexpr int BM = 256, BK = 64, HALF = 128, HTB = HALF * BK * 2, STAGE_BYTES = 8 * HTB;
__host__ __device__ __forceinline__ int lds_byte(int r, int c) { const int st = (r >> 4) * 2 + (c >> 5), rr = r & 15, cc = c & 31, ob = rr * 64 + cc * 2; return st * 1024 + (ob ^ (((ob >> 9) & 1) << 5)); }
__host__ __device__ __forceinline__ void stage_rc(int b, int& R, int& C) { const int st = b / 1024, sb = b % 1024, swz = sb ^ (((sb >> 9) & 1) << 5); R = (st >> 1) * 16 + swz / 64; C = (st & 1) * 32 + (swz % 64) / 2; }

struct Unit { int pm, pn, z; };

template <class Epi, class Sched>
__device__ __forceinline__ void gemm_phase(LAS unsigned char* lds, const int K, const Sched& S, const Epi& E) {
    const int tid = threadIdx.x, wid = __builtin_amdgcn_readfirstlane(tid >> 6), lane = tid & 63, wr = wid >> 2, wc = wid & 3, fr = lane & 15, fq = lane >> 4;
    const int nt = K / BK;
    unsigned voffB[2];
#pragma unroll
    for (int i = 0; i < 2; ++i) { int R_, C_; stage_rc(tid * 16 + i * 8192, R_, C_); voffB[i] = (unsigned)(R_ * K + C_) * 2u; }
    const size_t kstep = (size_t)(BK * 2);
    const size_t hstep = (size_t)HALF * K * 2;
    const unsigned ldsw = (unsigned)wid * 1024u;
    const int aoff = lds_byte(wr * 64 + fr, fq * 8), boff = lds_byte(wc * 32 + fr, fq * 8);
    const char* const abase = S.a_base();
#define PG8_SA(b, h) (((b) * 2 + (h)) * HTB)
#define PG8_SB(b, h) ((4 + (b) * 2 + (h)) * HTB)
#define PG8_STAGE(bufoff, gbase, voff) do { _Pragma("unroll") for (int _i = 0; _i < 2; ++_i) \
        __builtin_amdgcn_global_load_lds((const unsigned*)((const char*)(gbase) + (voff)[_i]), (LAS unsigned*)(lds + (bufoff) + ldsw + _i * 8192), 16, 0, 0); } while (0)
#define PG8_LDA(dst, b, h) do { _Pragma("unroll") for (int m = 0; m < 4; ++m) _Pragma("unroll") for (int k = 0; k < 2; ++k) dst[m][k] = *(const LAS bf16x8*)(lds + PG8_SA(b, h) + aoff + m * 2048 + k * 1024); } while (0)
#define PG8_LDB(dst, b, h) do { _Pragma("unroll") for (int n = 0; n < 2; ++n) _Pragma("unroll") for (int k = 0; k < 2; ++k) dst[n][k] = *(const LAS bf16x8*)(lds + PG8_SB(b, h) + boff + n * 2048 + k * 1024); } while (0)
#define PG8_MMA(ai, bj, At, Bt) do { __builtin_amdgcn_s_setprio(1); _Pragma("unroll") for (int m = 0; m < 4; ++m) _Pragma("unroll") for (int n = 0; n < 2; ++n) _Pragma("unroll") for (int k = 0; k < 2; ++k) \
        acc[ai][bj][m][n] = __builtin_amdgcn_mfma_f32_16x16x32_bf16(Bt[n][k], At[m][k], acc[ai][bj][m][n], 0, 0, 0); __builtin_amdgcn_s_setprio(0); } while (0)
#define PG8_WAIT_V(n) asm volatile("s_waitcnt vmcnt(" #n ")" ::: "memory")
#define PG8_WAIT_L(n) asm volatile("s_waitcnt lgkmcnt(" #n ")" ::: "memory")
#define PG8_BAR __builtin_amdgcn_s_barrier()
#define PG8_SCHED __builtin_amdgcn_sched_barrier(0)
    Unit cur, nxt; int ui = 0;
    if (!S.next(0, cur)) return;
    f32x4 acc[2][2][4][2];
#pragma unroll
    for (int a = 0; a < 2; ++a)
#pragma unroll
        for (int b = 0; b < 2; ++b)
#pragma unroll
            for (int m = 0; m < 4; ++m)
#pragma unroll
                for (int n = 0; n < 2; ++n) acc[a][b][m][n] = (f32x4){0.f, 0.f, 0.f, 0.f};
    bf16x8 At[4][2], B0[2][2], B1[2][2];
    unsigned ca[2][2], na[2][2];
    S.a_offs(cur, tid, ca);
    const char* cB = S.b_base(cur);
    PG8_STAGE(PG8_SB(0, 0), cB, voffB); PG8_STAGE(PG8_SB(0, 1), cB + hstep, voffB); PG8_STAGE(PG8_SA(0, 0), abase, ca[0]); PG8_STAGE(PG8_SA(0, 1), abase, ca[1]);
    if (wr == 1) PG8_BAR;
    PG8_WAIT_V(2); PG8_BAR;
    PG8_STAGE(PG8_SB(1, 0), cB + kstep, voffB); PG8_STAGE(PG8_SA(1, 0), abase + kstep, ca[0]); PG8_STAGE(PG8_SB(1, 1), cB + hstep + kstep, voffB);
    PG8_WAIT_V(6); PG8_BAR;
    for (;;) {
        const bool has_next = S.next(ui + 1, nxt);
        const char* nB = cB;
#pragma unroll
        for (int h = 0; h < 2; ++h)
#pragma unroll
            for (int i = 0; i < 2; ++i) na[h][i] = ca[h][i];
        if (has_next) { S.a_offs(nxt, tid, na); nB = S.b_base(nxt); }
        for (int t = 0; t < nt; t += 2) {
            const bool last = (t == nt - 2);
            const char* a1 = abase + (size_t)(t + 1) * kstep;
            const char* a2 = last ? abase : abase + (size_t)(t + 2) * kstep; const char* b2 = last ? nB : cB + (size_t)(t + 2) * kstep;
            const char* a3 = a2 + kstep; const char* b3 = b2 + kstep;
            PG8_LDB(B0, 0, 0); PG8_LDB(B1, 0, 1); PG8_SCHED; PG8_LDA(At, 0, 0); PG8_STAGE(PG8_SA(1, 1), a1, ca[1]);
            PG8_WAIT_V(8); PG8_WAIT_L(0); PG8_BAR; PG8_MMA(0, 0, At, B0); PG8_MMA(0, 1, At, B1); PG8_BAR; PG8_SCHED;
            if (last) {
#pragma unroll
                for (int h = 0; h < 2; ++h)
#pragma unroll
                    for (int i = 0; i < 2; ++i) ca[h][i] = na[h][i];
            }
            PG8_LDA(At, 0, 1); PG8_STAGE(PG8_SB(0, 0), b2, voffB); PG8_STAGE(PG8_SB(0, 1), b2 + hstep, voffB); PG8_STAGE(PG8_SA(0, 0), a2, ca[0]);
            PG8_WAIT_V(8); PG8_WAIT_L(0); PG8_BAR; PG8_MMA(1, 0, At, B0); PG8_MMA(1, 1, At, B1); PG8_BAR; PG8_SCHED;
            PG8_LDB(B0, 1, 0); PG8_LDB(B1, 1, 1); PG8_SCHED; PG8_LDA(At, 1, 0); PG8_STAGE(PG8_SA(0, 1), a2, ca[1]);
            PG8_WAIT_V(8); PG8_WAIT_L(0); PG8_BAR; PG8_MMA(0, 0, At, B0); PG8_MMA(0, 1, At, B1); PG8_BAR; PG8_SCHED;
            PG8_LDA(At, 1, 1); PG8_STAGE(PG8_SB(1, 0), b3, voffB); PG8_STAGE(PG8_SB(1, 1), b3 + hstep, voffB); PG8_STAGE(PG8_SA(1, 0), a3, ca[0]);
            PG8_WAIT_V(8); PG8_WAIT_L(0); PG8_BAR; PG8_MMA(1, 0, At, B0); PG8_MMA(1, 1, At, B1); PG8_BAR; PG8_SCHED;
        }
        if (wr == 0) PG8_BAR;
        { int tz = tid; asm volatile("" : "+v"(tz));
          const int l2 = tz & 63, w2 = __builtin_amdgcn_readfirstlane(tz >> 6); E(acc, cur, w2 >> 2, w2 & 3, l2 & 15, l2 >> 4); }
        if (!has_next) break;
#pragma unroll
        for (int a = 0; a < 2; ++a)
#pragma unroll
            for (int b = 0; b < 2; ++b)
#pragma unroll
                for (int m = 0; m < 4; ++m)
#pragma unroll
                    for (int n = 0; n < 2; ++n) acc[a][b][m][n] = (f32x4){0.f, 0.f, 0.f, 0.f};
        cur = nxt; cB = nB; ++ui;
        if (wr == 1) PG8_BAR;
    }
    PG8_WAIT_V(0);
    PG8_BAR;
#undef PG8_SA
#undef PG8_SB
#undef PG8_STAGE
#undef PG8_LDA
#undef PG8_LDB
#undef PG8_MMA
#undef PG8_WAIT_V
#undef PG8_WAIT_L
#undef PG8_BAR
#undef PG8_SCHED
}
}

#define XB_TMO      128
#define XB_XCNT(j)  (256  + 64 * (j))
#define XB_XSUB(j)  (1280 + 64 * (j))
#define XB_XGEN(j)  (2304 + 64 * (j))
#define XB_TOP      3328
#define XB_TOPGEN   3392
#define XCD_BAR_WORDS 3456
#define XB_SPIN_CAP (1u << 18)
__device__ __forceinline__ unsigned xb_ld(unsigned* p)              { return __hip_atomic_load(p, __ATOMIC_RELAXED, __HIP_MEMORY_SCOPE_AGENT); }
__device__ __forceinline__ unsigned xb_add(unsigned* p, unsigned v) { return __hip_atomic_fetch_add(p, v, __ATOMIC_RELAXED, __HIP_MEMORY_SCOPE_AGENT); }
__device__ __forceinline__ unsigned xb_xcc_id() { return (unsigned)__builtin_amdgcn_s_getreg((3 << 11) | 20) & 0xFu; }
#define XB_SPIN(cond, bar) do { unsigned _sp = 0; while (cond) { __builtin_amdgcn_s_sleep(1); \
    if ((++_sp & 255u) == 0u) { if (xb_ld(&(bar)[XB_TMO])) break; if (_sp > XB_SPIN_CAP) { atomicAdd(&(bar)[XB_TMO], 1u); break; } } } } while (0)
struct XcdBarrier { unsigned* bar; unsigned x; volatile LAS unsigned* st; };
__device__ __forceinline__ XcdBarrier xcd_barrier_post(unsigned* bar, volatile LAS unsigned* st) {
    XcdBarrier b; b.bar = bar; b.x = xb_xcc_id(); b.st = st;
    if (threadIdx.x == 0) (void)xb_add(&bar[XB_XCNT(b.x)], 1u);
    return b;
}
__device__ __forceinline__ void xcd_barrier_complete(unsigned* bar, unsigned x, unsigned& nloc, unsigned& nx) {
    const unsigned G = gridDim.x * gridDim.y * gridDim.z;
    unsigned sum, cnt, mine, sp = 0u;
    for (;;) {
        sum = 0u; cnt = 0u; mine = 0u;
#pragma unroll
        for (unsigned j = 0; j < 16; ++j) { const unsigned c = xb_ld(&bar[XB_XCNT(j)]); sum += c; cnt += (c > 0u) ? 1u : 0u; mine = (j == x) ? c : mine; }
        if (sum == G) break;
        __builtin_amdgcn_s_sleep(1);
        if ((++sp & 255u) == 0u) { if (xb_ld(&bar[XB_TMO])) break; if (sp > XB_SPIN_CAP) { atomicAdd(&bar[XB_TMO], 1u); break; } }
    }
    nloc = mine > 0u ? mine : 1u; nx = cnt > 0u ? cnt : 1u;
}
__device__ __forceinline__ void xcd_barrier(const XcdBarrier& b) {
    asm volatile("s_waitcnt vmcnt(0)" ::: "memory");
    __syncthreads();
    if (threadIdx.x == 0) {
        unsigned* bar = b.bar;
        __builtin_amdgcn_s_waitcnt(0);
        unsigned nloc = b.st[0], nx = b.st[1];
        if (nloc == 0u) { xcd_barrier_complete(bar, b.x, nloc, nx); b.st[0] = nloc; b.st[1] = nx; }
        const unsigned old = xb_add(&bar[XB_XSUB(b.x)], 1u);
        const unsigned gen = old / nloc;
        if (old + 1u == (gen + 1u) * nloc) {
            __builtin_amdgcn_fence(__ATOMIC_RELEASE, "agent");
            asm volatile("s_waitcnt vmcnt(0)" ::: "memory");
            const unsigned og = xb_add(&bar[XB_TOP], 1u);
            const unsigned tg = og / nx;
            if (og + 1u == (tg + 1u) * nx) xb_add(&bar[XB_TOPGEN], 1u);
            else XB_SPIN(xb_ld(&bar[XB_TOPGEN]) == tg, bar);
            __builtin_amdgcn_fence(__ATOMIC_ACQUIRE, "agent");
            xb_add(&bar[XB_XGEN(b.x)], 1u);
            asm volatile("s_waitcnt vmcnt(0)" ::: "memory");
        } else {
            XB_SPIN(xb_ld(&bar[XB_XGEN(b.x)]) == gen, bar);
            __builtin_amdgcn_fence(__ATOMIC_ACQUIRE, "agent");
            asm volatile("s_waitcnt vmcnt(0)" ::: "memory");
        }
    }
    __syncthreads();
}

struct Args {
    const float* in[21];
    float* out; unsigned char* ws;
    int ph_lo, ph_hi;
};
enum { I_X = 0, I_META, I_RELB, I_NMIX, I_WIN, I_BGATE, I_WAO, I_CONVW, I_CONVB, I_LNG, I_LNB, I_WCO, I_WOUT, I_NFFN, I_WR, I_BR, I_WUG, I_BUG, I_WD, I_BD, I_NFIN };

struct Frame {
    LAS unsigned char* lds;
    unsigned char* ws;
    int tid, lane, wave;
    int G, bid;
};
template <class T> __device__ __forceinline__ T* wsp(unsigned char* ws, size_t off) { return (T*)(ws + off); }

__device__ __forceinline__ void p0_tile64(const float* __restrict__ src, int ldn, int sc, int k0, bf16_t* __restrict__ dst, int ldk, int dr, LAS float* scr, int lane) {
    const int n4 = (lane & 15) * 4, kr = lane >> 4;
    f32x4 v[16];
#pragma unroll
    for (int i = 0; i < 16; ++i) v[i] = *(const f32x4*)(src + (size_t)(k0 + 4 * i + kr) * ldn + sc + n4);
#pragma unroll
    for (int i = 0; i < 16; ++i) { LAS float* p = scr + (4 * i + kr) * 65 + n4; p[0] = v[i][0]; p[1] = v[i][1]; p[2] = v[i][2]; p[3] = v[i][3]; }
    LDS_WAIT(); asm volatile("" ::: "memory");
    const int c = lane & 7;
#pragma unroll
    for (int j = 0; j < 8; ++j) { const int n = (lane >> 3) + 8 * j; const LAS float* s = scr + (8 * c) * 65 + n;
        u32x4 o; o.x = cvt_pk_bf16(s[0 * 65], s[1 * 65]); o.y = cvt_pk_bf16(s[2 * 65], s[3 * 65]); o.z = cvt_pk_bf16(s[4 * 65], s[5 * 65]); o.w = cvt_pk_bf16(s[6 * 65], s[7 * 65]);
        *(u32x4*)(dst + (size_t)(dr + n) * ldk + k0 + 8 * c) = o; }
    LDS_WAIT(); asm volatile("" ::: "memory");
}
__device__ __forceinline__ void rms_row_to_bf16(const float* __restrict__ xrow, const float* __restrict__ g, bf16_t* __restrict__ orow, int lane) {
    const f32x4* xr = (const f32x4*)xrow + lane; const f32x4* gr = (const f32x4*)g + lane;
    f32x4 v[4]; float s = 0.f;
#pragma unroll
    for (int j = 0; j < 4; ++j) { v[j] = xr[64 * j]; s += (v[j].x * v[j].x + v[j].y * v[j].y) + (v[j].z * v[j].z + v[j].w * v[j].w); }
    const float r = 1.0f / sqrtf(wave_sum(s) * (1.f / DM) + EPS);
    unsigned long long* o8 = (unsigned long long*)orow + lane;
#pragma unroll
    for (int j = 0; j < 4; ++j) { const f32x4 gg = gr[64 * j];
        o8[64 * j] = (unsigned long long)cvt_pk_bf16(v[j].x * r * gg.x, v[j].y * r * gg.y) | ((unsigned long long)cvt_pk_bf16(v[j].z * r * gg.z, v[j].w * r * gg.w) << 32); }
}
__device__ __forceinline__ void p0_prologue(Frame& F, const Args& a) {
    LAS float* scr = (LAS float*)(F.lds + F.wave * 16896);
    const int gw = F.bid * NWAVES + F.wave, NGW = F.G * NWAVES;
    unsigned char* ws = F.ws;
    constexpr int T_IN = 81 * 16, T_AO = 16 * 8, T_CO = 16 * 8, T_OUT = 16 * 16, T_SMALL = T_IN + T_AO + T_CO + T_OUT;
    constexpr int T_UG = NE * 32 * 16, T_D = NE * 16 * 16;
    for (int it = gw; it < T_SMALL + T_UG + T_D; it += NGW) {
        int r = it;
        if (r < T_IN) { const int g = r / 16, kb = r % 16; const int dr = g * 64; int sc;
            if (dr < WR_GLU) sc = dr;
            else if (dr < WR_GATE) { const int q = dr - WR_GLU, tile = q >> 8, hf = (q >> 7) & 1, w = q & 127; sc = SC_GLU + 512 * hf + 128 * tile + w; }
            else if (dr < WR_IK) sc = SC_GATE + (dr - WR_GATE);
            else sc = SC_IK + (dr - WR_IK);
            p0_tile64(a.in[I_WIN], INCOLS, sc, kb * 64, wsp<bf16_t>(ws, WS_WIN), DM, dr, scr, F.lane); continue; }
        r -= T_IN;
        if (r < T_AO) { const int g = r / 8, kb = r % 8; p0_tile64(a.in[I_WAO], DM, g * 64, kb * 64, wsp<bf16_t>(ws, WS_WAO), AW, g * 64, scr, F.lane); continue; }
        r -= T_AO;
        if (r < T_CO) { const int g = r / 8, kb = r % 8; p0_tile64(a.in[I_WCO], DM, g * 64, kb * 64, wsp<bf16_t>(ws, WS_WCO), CC, g * 64, scr, F.lane); continue; }
        r -= T_CO;
        if (r < T_OUT) { const int g = r / 16, kb = r % 16; p0_tile64(a.in[I_WOUT], DM, g * 64, kb * 64, wsp<bf16_t>(ws, WS_WOUT), DM, g * 64, scr, F.lane); continue; }
        r -= T_OUT;
        if (r < T_UG) { const int e = r / 512, q = r % 512, g = q / 16, kb = q % 16; const int dr = g * 64, tile = dr >> 8, hf = (dr >> 7) & 1, w = dr & 127;
            p0_tile64(a.in[I_WUG] + (size_t)e * DM * 2 * DFF, 2 * DFF, DFF * hf + 128 * tile + w, kb * 64, wsp<bf16_t>(ws, WS_WUG) + (size_t)e * 2 * DFF * DM, DM, dr, scr, F.lane); continue; }
        r -= T_UG;
        { const int e = r / 256, q = r % 256, g = q / 16, kb = q % 16;
            p0_tile64(a.in[I_WD] + (size_t)e * DFF * DM, DM, g * 64, kb * 64, wsp<bf16_t>(ws, WS_WD) + (size_t)e * DM * DFF, DFF, g * 64, scr, F.lane); }
    }
    { const int gt = F.bid * NTHREADS + F.tid;
      if (gt < 8 * DM / 2) { const int n = gt >> 9, k = (gt & 511) * 2; const float v0 = a.in[I_WIN][(size_t)k * INCOLS + SC_IW + n], v1 = a.in[I_WIN][(size_t)(k + 1) * INCOLS + SC_IW + n];
          *(unsigned*)(wsp<bf16_t>(ws, WS_WIN) + (size_t)(WR_IW + n) * DM + k) = cvt_pk_bf16(v0, v1); } }
    for (int m = gw; m < NTOK + NMETA; m += NGW) {
        if (m < NTOK) rms_row_to_bf16(a.in[I_X] + (size_t)m * DM, a.in[I_NMIX], wsp<bf16_t>(ws, WS_XN) + (size_t)m * DM, F.lane);
        else rms_row_to_bf16(a.in[I_META] + (size_t)(m - NTOK) * DM, a.in[I_NMIX], wsp<bf16_t>(ws, WS_XNM) + (size_t)(m - NTOK) * DM, F.lane);
    }
}

struct PlainSched {
    const char* ws; unsigned a_off, b_off; int K, nM, nN, nwg, G, c;
    __device__ __forceinline__ void init(const unsigned char* ws_, size_t a, size_t b, int M, int N, int K_, int G_, int c_) { ws = (const char*)ws_; a_off = (unsigned)a; b_off = (unsigned)b; K = K_; nM = M / 256; nN = N / 256; nwg = nM * nN; G = G_; c = c_; }
    __device__ __forceinline__ bool next(int i, pg8::Unit& u) const {
        const long L = (long)i * G + c; if (L >= nwg) return false;
        int wgid = (int)L; { const int q = nwg / 8, r = nwg % 8, xcd = wgid % 8, off = wgid / 8; wgid = (xcd < r ? xcd * (q + 1) : r * (q + 1) + (xcd - r) * q) + off; }
        const int nig = 8 * nN, gid = wgid / nig, fm = gid * 8, gsz = (nM - fm) < 8 ? (nM - fm) : 8;
        u.pm = fm + ((wgid % nig) % gsz); u.pn = (wgid % nig) / gsz; u.z = 0; return true;
    }
    __device__ __forceinline__ const char* a_base() const { return ws; }
    __device__ __forceinline__ void a_offs(const pg8::Unit& u, int tid, unsigned (&o)[2][2]) const {
        int R[2], C[2]; pg8::stage_rc(tid * 16, R[0], C[0]); pg8::stage_rc(tid * 16 + 8192, R[1], C[1]);
#pragma unroll
        for (int h = 0; h < 2; ++h)
#pragma unroll
            for (int i = 0; i < 2; ++i) o[h][i] = a_off + (unsigned)(((u.pm * 256 + h * 128 + R[i]) * K + C[i]) * 2);
    }
    __device__ __forceinline__ const char* b_base(const pg8::Unit& u) const { return ws + b_off + (size_t)u.pn * 256 * K * 2; }
};
struct MergeSched {
    const char* ws; int G, c;
    __device__ __forceinline__ bool next(int i, pg8::Unit& u) const {
        const int t = c + (i >> 1) * G;
        if (t >= 256) return false;
        u.pm = (t & 7) + 8 * (t >> 5); u.pn = (t >> 3) & 3; u.z = i & 1; return true;
    }
    __device__ __forceinline__ const char* a_base() const { return ws; }
    __device__ __forceinline__ void a_offs(const pg8::Unit& u, int tid, unsigned (&o)[2][2]) const {
        int R[2], C[2]; pg8::stage_rc(tid * 16, R[0], C[0]); pg8::stage_rc(tid * 16 + 8192, R[1], C[1]);
        const unsigned base = (unsigned)(u.z ? WS_CO : WS_AO);
#pragma unroll
        for (int h = 0; h < 2; ++h)
#pragma unroll
            for (int i = 0; i < 2; ++i) o[h][i] = base + (unsigned)(((u.pm * 256 + h * 128 + R[i]) * 512 + C[i]) * 2);
    }
    __device__ __forceinline__ const char* b_base(const pg8::Unit& u) const { return ws + (u.z ? WS_WCO : WS_WAO) + (size_t)u.pn * 256 * 512 * 2; }
};
struct MoeTables { const LAS int* cnt; const LAS int* tbase; };
template <int NC, bool GATHER>
struct MoeSched {
    const char* ws; MoeTables T; int G, c, total;
    __device__ __forceinline__ bool next(int i, pg8::Unit& u) const {
        const long L = (long)i * G + c; if (L >= total) return false;
        int wgid = (int)L; { const int q = total / 8, r = total % 8, xcd = wgid % 8, off = wgid / 8; wgid = (xcd < r ? xcd * (q + 1) : r * (q + 1) + (xcd - r) * q) + off; }
        int e = 0;
        for (int j = 1; j < NE; ++j) e += (wgid >= __builtin_amdgcn_readfirstlane(T.tbase[j]) * NC) ? 1 : 0;
        e = __builtin_amdgcn_readfirstlane(e);
        const int tb0 = __builtin_amdgcn_readfirstlane(T.tbase[e]), tb1 = __builtin_amdgcn_readfirstlane(T.tbase[e + 1]);
        const int loc = wgid - tb0 * NC, nt_e = tb1 - tb0;
        u.z = e; u.pm = loc % nt_e; u.pn = loc / nt_e; return true;
    }
    __device__ __forceinline__ const char* a_base() const { return ws; }
    __device__ __forceinline__ void a_offs(const pg8::Unit& u, int tid, unsigned (&o)[2][2]) const {
        int R[2], C[2]; pg8::stage_rc(tid * 16, R[0], C[0]); pg8::stage_rc(tid * 16 + 8192, R[1], C[1]);
        if (GATHER) {
            const int* list = (const int*)(ws + WS_LIST) + (size_t)u.z * NTOK; const int n = __builtin_amdgcn_readfirstlane(T.cnt[u.z]);
#pragma unroll
            for (int h = 0; h < 2; ++h)
#pragma unroll
                for (int i = 0; i < 2; ++i) { const int p = u.pm * 256 + h * 128 + R[i]; const int tok = (p < n) ? list[p] : 0; o[h][i] = (unsigned)WS_XN + (unsigned)((tok * DM + C[i]) * 2); }
        } else {
            const int row0 = (__builtin_amdgcn_readfirstlane(T.tbase[u.z]) + u.pm) * 256;
#pragma unroll
            for (int h = 0; h < 2; ++h)
#pragma unroll
                for (int i = 0; i < 2; ++i) o[h][i] = (unsigned)WS_ACT + (unsigned)(((row0 + h * 128 + R[i]) * DFF + C[i]) * 2);
        }
    }
    __device__ __forceinline__ const char* b_base(const pg8::Unit& u) const {
        if (GATHER) return ws + WS_WUG + ((size_t)u.z * 2 * DFF + (size_t)u.pn * 256) * DM * 2;
        else return ws + WS_WD + ((size_t)u.z * DM + (size_t)u.pn * 256) * DFF * 2;
    }
};

#define EPI_ROWS(ai, m) for (int ai = 0; ai < 2; ++ai) _Pragma("unroll") for (int m = 0; m < 4; ++m)
#define EPI_COLS(bj, n) for (int bj = 0; bj < 2; ++bj) _Pragma("unroll") for (int n = 0; n < 2; ++n)
__device__ __forceinline__ void st_bf16x4(bf16_t* p, f32x4 v) { u32x2 w; w.x = cvt_pk_bf16(v[0], v[1]); w.y = cvt_pk_bf16(v[2], v[3]); *(u32x2*)p = w; }

struct EpiInProj {
    unsigned char* ws; const float* bgate;
    __device__ __forceinline__ void operator()(const f32x4 (&acc)[2][2][4][2], const pg8::Unit& u, int wr, int wc, int fr, int fq) const {
        const int pn = u.pn, row0 = u.pm * 256 + wr * 64 + fr, col0 = wc * 32 + 4 * fq;
        const int bidx = u.pm >> 3;
        const int rowk0 = row0 + NMETA * (bidx + 1);
        if (pn < 2 || (pn >= 6 && pn < 8)) {
            bf16_t* O = wsp<bf16_t>(ws, pn < 2 ? WS_Q : WS_IQ); const int cb = (pn & 1) * 256; const float sc = pn < 2 ? QSCALE : 1.0f;
#pragma unroll
            EPI_ROWS(ai, m) { bf16_t* rp = O + (size_t)(row0 + ai * 128 + m * 16) * AW + cb + col0;
#pragma unroll
                EPI_COLS(bj, n) st_bf16x4(rp + bj * 128 + n * 16, acc[ai][bj][m][n] * sc); }
        } else if (pn < 4) {
            bf16_t* O = wsp<bf16_t>(ws, WS_KB); const int cb = (pn & 1) * 256;
#pragma unroll
            EPI_ROWS(ai, m) { bf16_t* rp = O + (size_t)(rowk0 + ai * 128 + m * 16) * AW + cb + col0;
#pragma unroll
                EPI_COLS(bj, n) st_bf16x4(rp + bj * 128 + n * 16, acc[ai][bj][m][n]); }
        } else if (pn < 6) {
            bf16_t* O = wsp<bf16_t>(ws, WS_VT) + (size_t)bidx * AW * TP; const int cb = (pn & 1) * 256;
            const int t0 = (row0 & (SEQ - 1)) + NMETA + VOFF;
#pragma unroll
            EPI_ROWS(ai, m) { const int t = t0 + ai * 128 + m * 16;
#pragma unroll
                EPI_COLS(bj, n) { const f32x4 v = acc[ai][bj][m][n]; bf16_t* cp = O + (size_t)(cb + col0 + bj * 128 + n * 16) * TP + (t & ~1);
                    const float p0 = __shfl_xor(v[0], 1), p1 = __shfl_xor(v[1], 1), p2 = __shfl_xor(v[2], 1), p3 = __shfl_xor(v[3], 1);
                    if ((fr & 1) == 0) { *(unsigned*)(cp) = cvt_pk_bf16(v[0], p0); *(unsigned*)(cp + TP) = cvt_pk_bf16(v[1], p1); }
                    else { *(unsigned*)(cp + 2 * TP) = cvt_pk_bf16(p2, v[2]); *(unsigned*)(cp + 3 * TP) = cvt_pk_bf16(p3, v[3]); } } }
        } else if (pn < 12) {
            bf16_t* O = wsp<bf16_t>(ws, WS_GLU); const int cb = (pn - 8) * 128;
#pragma unroll
            EPI_ROWS(ai, m) { bf16_t* rp = O + (size_t)(rowk0 + ai * 128 + m * 16) * CC + cb + col0;
#pragma unroll
                for (int n = 0; n < 2; ++n) { const f32x4 av = acc[ai][0][m][n], gv = acc[ai][1][m][n]; f32x4 y;
#pragma unroll
                    for (int j = 0; j < 4; ++j) y[j] = av[j] * sigmoidf_(gv[j]);
                    st_bf16x4(rp + n * 16, y); } }
        } else {
            const int gt = pn - 12; bf16_t* O = wsp<bf16_t>(ws, gt < 4 ? WS_GA : WS_GB); const int cb = (gt & 3) * 256; const float* bp = bgate + gt * 256 + col0;
            f32x4 bv[2][2];
#pragma unroll
            EPI_COLS(bj, n) bv[bj][n] = *(const f32x4*)(bp + bj * 128 + n * 16);
#pragma unroll
            EPI_ROWS(ai, m) { bf16_t* rp = O + (size_t)(row0 + ai * 128 + m * 16) * DM + cb + col0;
#pragma unroll
                EPI_COLS(bj, n) { const f32x4 x = acc[ai][bj][m][n] + bv[bj][n]; f32x4 y;
#pragma unroll
                    for (int j = 0; j < 4; ++j) y[j] = sigmoidf_(x[j]);
                    st_bf16x4(rp + bj * 128 + n * 16, y); } }
        }
    }
};
struct EpiMerge {
    unsigned char* ws;
    __device__ __forceinline__ void operator()(const f32x4 (&acc)[2][2][4][2], const pg8::Unit& u, int wr, int wc, int fr, int fq) const {
        const int row0 = u.pm * 256 + wr * 64 + fr, col0 = u.pn * 256 + wc * 32 + 4 * fq;
        const bf16_t* Gt = wsp<bf16_t>(ws, u.z ? WS_GB : WS_GA); bf16_t* O = wsp<bf16_t>(ws, WS_MG);
#pragma unroll
        EPI_ROWS(ai, m) { const size_t ro = (size_t)(row0 + ai * 128 + m * 16) * DM + col0;
#pragma unroll
            EPI_COLS(bj, n) { const size_t o = ro + bj * 128 + n * 16; const u32x2 g = *(const u32x2*)(Gt + o); const f32x4 a = acc[ai][bj][m][n];
                f32x4 y = (f32x4){bflo(g.x) * a[0], bfhi(g.x) * a[1], bflo(g.y) * a[2], bfhi(g.y) * a[3]};
                if (u.z) { const u32x2 p = *(const u32x2*)(O + o); y[0] += bflo(p.x); y[1] += bfhi(p.x); y[2] += bflo(p.y); y[3] += bfhi(p.y); }
                st_bf16x4(O + o, y); } }
    }
};
struct EpiResid {
    const float* x; float* out;
    __device__ __forceinline__ void operator()(const f32x4 (&acc)[2][2][4][2], const pg8::Unit& u, int wr, int wc, int fr, int fq) const {
        const int row0 = u.pm * 256 + wr * 64 + fr, col0 = u.pn * 256 + wc * 32 + 4 * fq;
#pragma unroll
        EPI_ROWS(ai, m) { const size_t ro = (size_t)(row0 + ai * 128 + m * 16) * DM + col0;
#pragma unroll
            EPI_COLS(bj, n) { const size_t o = ro + bj * 128 + n * 16; *(f32x4*)(out + o) = *(const f32x4*)(x + o) + acc[ai][bj][m][n]; } }
    }
};
struct EpiSwiglu {
    unsigned char* ws; const float* bug; MoeTables T;
    __device__ __forceinline__ void operator()(const f32x4 (&acc)[2][2][4][2], const pg8::Unit& u, int wr, int wc, int fr, int fq) const {
        const int e = u.z, n_e = __builtin_amdgcn_readfirstlane(T.cnt[e]), rloc0 = u.pm * 256 + wr * 64 + fr, row0 = __builtin_amdgcn_readfirstlane(T.tbase[e]) * 256 + rloc0, col0 = u.pn * 128 + wc * 32 + 4 * fq;
        const float* bp = bug + (size_t)e * 2 * DFF + col0; bf16_t* O = wsp<bf16_t>(ws, WS_ACT);
        f32x4 bg[2], bu[2];
#pragma unroll
        for (int n = 0; n < 2; ++n) { bg[n] = *(const f32x4*)(bp + n * 16); bu[n] = *(const f32x4*)(bp + DFF + n * 16); }
#pragma unroll
        EPI_ROWS(ai, m) { const int rl = rloc0 + ai * 128 + m * 16; if (rl < n_e) { bf16_t* rp = O + (size_t)(row0 + ai * 128 + m * 16) * DFF + col0;
#pragma unroll
                for (int n = 0; n < 2; ++n) { const f32x4 gv = acc[ai][0][m][n] + bg[n], uv = acc[ai][1][m][n] + bu[n]; f32x4 y;
#pragma unroll
                    for (int j = 0; j < 4; ++j) { const float g = fminf(gv[j], 7.0f), up = fminf(fmaxf(uv[j], -7.0f), 7.0f); y[j] = (up + 1.0f) * g * sigmoidf_(1.702f * g); }
                    st_bf16x4(rp + n * 16, y); } } }
    }
};
struct EpiDown {
    unsigned char* ws; const float* bd; MoeTables T;
    __device__ __forceinline__ void operator()(const f32x4 (&acc)[2][2][4][2], const pg8::Unit& u, int wr, int wc, int fr, int fq) const {
        const int e = u.z, n_e = __builtin_amdgcn_readfirstlane(T.cnt[e]), rloc0 = u.pm * 256 + wr * 64 + fr, row0 = __builtin_amdgcn_readfirstlane(T.tbase[e]) * 256 + rloc0, col0 = u.pn * 256 + wc * 32 + 4 * fq;
        const float* bp = bd + (size_t)e * DM + col0; bf16_t* O = wsp<bf16_t>(ws, WS_YP); const float* lg = wsp<float>(ws, WS_LG) + (size_t)e * NTOK;
        f32x4 bv[2][2];
#pragma unroll
        EPI_COLS(bj, n) bv[bj][n] = *(const f32x4*)(bp + bj * 128 + n * 16);
#pragma unroll
        EPI_ROWS(ai, m) { const int rl = rloc0 + ai * 128 + m * 16; if (rl < n_e) { const float gt = lg[rl]; bf16_t* rp = O + (size_t)(row0 + ai * 128 + m * 16) * DM + col0;
#pragma unroll
                EPI_COLS(bj, n) st_bf16x4(rp + bj * 128 + n * 16, (acc[ai][bj][m][n] + bv[bj][n]) * gt); } }
    }
};

template <int NT>
__device__ __forceinline__ void wave_mm16(const bf16_t* __restrict__ A, int lda, const bf16_t* const (&Bt)[NT], int K, int lane, f32x4 (&acc)[NT]) {
    const bf16_t* ap = A + (size_t)(lane & 15) * lda + 8 * (lane >> 4);
    const bf16_t* bp[NT];
#pragma unroll
    for (int t = 0; t < NT; ++t) { bp[t] = Bt[t] + (size_t)(lane & 15) * K + 8 * (lane >> 4); acc[t] = (f32x4){0.f, 0.f, 0.f, 0.f}; }
#pragma unroll 4
    for (int k0 = 0; k0 < K; k0 += 32) {
        const bf16x8 a = *(const bf16x8*)(ap + k0);
#pragma unroll
        for (int t = 0; t < NT; ++t) { const bf16x8 b = *(const bf16x8*)(bp[t] + k0); acc[t] = __builtin_amdgcn_mfma_f32_16x16x32_bf16(b, a, acc[t], 0, 0, 0); }
    }
}
__device__ __forceinline__ void p1_thin(Frame& F) {
    unsigned char* ws = F.ws;
    const bf16_t* WIN = wsp<bf16_t>(ws, WS_WIN); const bf16_t* XN = wsp<bf16_t>(ws, WS_XN); const bf16_t* XNM = wsp<bf16_t>(ws, WS_XNM);
    bf16_t* KB = wsp<bf16_t>(ws, WS_KB); bf16_t* VT = wsp<bf16_t>(ws, WS_VT); bf16_t* IK = wsp<bf16_t>(ws, WS_IK); bf16_t* GLU = wsp<bf16_t>(ws, WS_GLU); float* IW = wsp<float>(ws, WS_IW);
    const int gw = F.bid * NWAVES + F.wave, NGW = F.G * NWAVES, lane = F.lane, tk = lane & 15, nq = lane >> 4;
    for (int task = gw; task < 2048; task += NGW) {
        const int tg = task >> 1, hf = task & 1, m = tg * 16 + tk, rowk = m + NMETA * ((m >> 11) + 1);
        const bf16_t* A = XN + (size_t)tg * 16 * DM;
        if (hf == 0) {
            const bf16_t* const Bt[3] = {WIN + (size_t)(WR_IK) * DM, WIN + (size_t)(WR_IK + 16) * DM, WIN + (size_t)(WR_IK + 32) * DM}; f32x4 acc[3];
            wave_mm16<3>(A, DM, Bt, DM, lane, acc);
#pragma unroll
            for (int t = 0; t < 3; ++t) st_bf16x4(IK + (size_t)rowk * IDXD + 16 * t + 4 * nq, acc[t]);
        } else {
            const bf16_t* const Bt[2] = {WIN + (size_t)(WR_IK + 48) * DM, WIN + (size_t)(WR_IW) * DM}; f32x4 acc[2];
            wave_mm16<2>(A, DM, Bt, DM, lane, acc);
            st_bf16x4(IK + (size_t)rowk * IDXD + 48 + 4 * nq, acc[0]);
            if (nq < 2) *(f32x4*)(IW + (size_t)m * 8 + 4 * nq) = acc[1];
        }
    }
    for (int task = gw; task < 100; task += NGW) {
        if (task < 32) {
            const bf16_t* const Bt[1] = {WIN + (size_t)(SC_K + 16 * task) * DM}; f32x4 acc[1]; wave_mm16<1>(XNM, DM, Bt, DM, lane, acc);
            for (int b = 0; b < NB; ++b) st_bf16x4(KB + (size_t)(b * TT + tk) * AW + 16 * task + 4 * nq, acc[0]);
        } else if (task < 64) {
            const int t = task - 32; const bf16_t* const Bt[1] = {WIN + (size_t)(SC_V + 16 * t) * DM}; f32x4 acc[1]; wave_mm16<1>(XNM, DM, Bt, DM, lane, acc);
            const float p0 = __shfl_xor(acc[0][0], 1), p1 = __shfl_xor(acc[0][1], 1), p2 = __shfl_xor(acc[0][2], 1), p3 = __shfl_xor(acc[0][3], 1);
            const unsigned wa = (tk & 1) ? cvt_pk_bf16(p2, acc[0][2]) : cvt_pk_bf16(acc[0][0], p0), wb = (tk & 1) ? cvt_pk_bf16(p3, acc[0][3]) : cvt_pk_bf16(acc[0][1], p1);
            for (int b = 0; b < NB; ++b) { bf16_t* cp = VT + ((size_t)b * AW + 16 * t + 4 * nq + 2 * (tk & 1)) * TP + VOFF + (tk & ~1);
                *(unsigned*)cp = wa; *(unsigned*)(cp + TP) = wb; }
        } else if (task < 68) {
            const int t = task - 64; const bf16_t* const Bt[1] = {WIN + (size_t)(WR_IK + 16 * t) * DM}; f32x4 acc[1]; wave_mm16<1>(XNM, DM, Bt, DM, lane, acc);
            for (int b = 0; b < NB; ++b) st_bf16x4(IK + (size_t)(b * TT + tk) * IDXD + 16 * t + 4 * nq, acc[0]);
        } else {
            const int c16 = task - 68; const int ar = WR_GLU + 256 * (c16 >> 3) + 16 * (c16 & 7);
            const bf16_t* const Bt[2] = {WIN + (size_t)ar * DM, WIN + (size_t)(ar + 128) * DM}; f32x4 acc[2]; wave_mm16<2>(XNM, DM, Bt, DM, lane, acc);
            f32x4 y;
#pragma unroll
            for (int j = 0; j < 4; ++j) y[j] = acc[0][j] * sigmoidf_(acc[1][j]);
            for (int b = 0; b < NB; ++b) st_bf16x4(GLU + (size_t)(b * TT + tk) * CC + 16 * c16 + 4 * nq, y);
        }
    }
}

__device__ __forceinline__ void p2_conv(Frame& F, const Args& a) {
    unsigned char* ws = F.ws;
    LAS unsigned char* xs = F.lds;
    LAS float* wl = (LAS float*)(F.lds + 63488);
    const bf16_t* GLU = wsp<bf16_t>(ws, WS_GLU); bf16_t* CO = wsp<bf16_t>(ws, WS_CO);
    const float* cw = a.in[I_CONVW];
    for (int idx = F.tid; idx < CW * 128; idx += NTHREADS) { const int tap = idx >> 7, c4 = idx & 127; const f32x4 v = *(const f32x4*)(cw + tap * CC + 4 * c4); *(LAS f32x4*)(wl + tap * 512 + (c4 & 1) * 256 + (c4 >> 1) * 4) = v; }
    const int lane = F.lane, c0 = 8 * lane;
    for (int tile = F.bid; tile < NTOK / 32; tile += F.G) {
        const int b = tile >> 6, s0 = (tile & 63) * 32, p0 = NMETA + s0;
        __syncthreads();
        for (int idx = F.tid; idx < 62 * 64; idx += NTHREADS) { const int r = idx >> 6, ch = idx & 63, p = p0 - 30 + r; u32x4 v = (u32x4){0u, 0u, 0u, 0u};
            if (p >= 0) v = *(const u32x4*)(GLU + (size_t)(b * TT + p) * CC + ch * 8);
            *(LAS u32x4*)(xs + r * 1024 + ch * 16) = v; }
        __syncthreads();
        const int i0 = 4 * F.wave;
        float acc[4][8];
#pragma unroll
        for (int t = 0; t < 4; ++t)
#pragma unroll
            for (int i = 0; i < 8; ++i) acc[t][i] = 0.f;
        const LAS float* wlb = wl + lane * 4; asm volatile("" : "+v"(wlb));
        const LAS unsigned char* xsb = xs + i0 * 1024 + lane * 16; asm volatile("" : "+v"(xsb));
#pragma unroll 1
        for (int tap = 0; tap < CW; ++tap) {
            const f32x4 w0 = *(const LAS f32x4*)(wlb + tap * 512), w1 = *(const LAS f32x4*)(wlb + tap * 512 + 256);
#pragma unroll
            for (int t = 0; t < 4; ++t) {
                const u32x4 xv = *(const LAS u32x4*)(xsb + (tap + t) * 1024);
                acc[t][0] += w0[0] * bflo(xv.x); acc[t][1] += w0[1] * bfhi(xv.x); acc[t][2] += w0[2] * bflo(xv.y); acc[t][3] += w0[3] * bfhi(xv.y);
                acc[t][4] += w1[0] * bflo(xv.z); acc[t][5] += w1[1] * bfhi(xv.z); acc[t][6] += w1[2] * bflo(xv.w); acc[t][7] += w1[3] * bfhi(xv.w);
            }
        }
        float cb[8], lg[8], lb[8];
        { const f32x4* p0 = (const f32x4*)(a.in[I_CONVB] + c0); const f32x4* p1 = (const f32x4*)(a.in[I_LNG] + c0); const f32x4* p2 = (const f32x4*)(a.in[I_LNB] + c0);
#pragma unroll
          for (int hh = 0; hh < 2; ++hh) { const f32x4 u0 = p0[hh], u1 = p1[hh], u2 = p2[hh];
#pragma unroll
              for (int i = 0; i < 4; ++i) { cb[4 * hh + i] = u0[i]; lg[4 * hh + i] = u1[i]; lb[4 * hh + i] = u2[i]; } } }
#pragma unroll
        for (int t = 0; t < 4; ++t) {
            float s = 0.f;
#pragma unroll
            for (int i = 0; i < 8; ++i) { acc[t][i] += cb[i]; s += acc[t][i]; }
            const float mean = wave_sum(s) * (1.f / CC); float q = 0.f;
#pragma unroll
            for (int i = 0; i < 8; ++i) { acc[t][i] -= mean; q += acc[t][i] * acc[t][i]; }
            const float rstd = 1.0f / sqrtf(wave_sum(q) * (1.f / CC) + EPS);
            float y[8];
#pragma unroll
            for (int i = 0; i < 8; ++i) { const float z = acc[t][i] * rstd * lg[i] + lb[i]; y[i] = z * sigmoidf_(z); }
            u32x4 o; o.x = cvt_pk_bf16(y[0], y[1]); o.y = cvt_pk_bf16(y[2], y[3]); o.z = cvt_pk_bf16(y[4], y[5]); o.w = cvt_pk_bf16(y[6], y[7]);
            *(u32x4*)(CO + (size_t)(b * SEQ + s0 + i0 + t) * CC + c0) = o;
        }
    }
    __syncthreads();
}

constexpr int ROWP = 2080, NJ = 33;
__device__ __forceinline__ unsigned f2ord(float f) { const unsigned b = __float_as_uint(f); return b ^ ((b >> 31) ? 0xffffffffu : 0x80000000u); }
__device__ __forceinline__ int wave_isum(int v) {
#pragma unroll
    for (int o = 1; o < 64; o <<= 1) v += __shfl_xor(v, o);
    return v;
}
__device__ __forceinline__ void p2_indexer_unit(Frame& F, int b, int q16) {
    unsigned char* ws = F.ws;
    const bf16_t* IQ = wsp<bf16_t>(ws, WS_IQ); const bf16_t* IK = wsp<bf16_t>(ws, WS_IK); const float* IW = wsp<float>(ws, WS_IW); unsigned* MASK = wsp<unsigned>(ws, WS_MASK);
    LAS unsigned* SU = (LAS unsigned*)F.lds;
    const int lane = F.lane, c = lane & 31, hi = lane >> 5, w = F.wave;
    const int nwblk = (q16 >> 1) + 2;
    {
        const int qg = w & 3, par = w >> 2, tok0 = b * SEQ + 16 * q16 + 4 * qg;
        bf16x8 af[4];
        { const bf16_t* ap = IQ + (size_t)(tok0 + (c >> 3)) * AW + (c & 7) * IDXD + 8 * hi;
#pragma unroll
          for (int ks = 0; ks < 4; ++ks) af[ks] = *(const bf16x8*)(ap + 16 * ks); }
        f32x4 wq[4];
#pragma unroll
        for (int q = 0; q < 4; ++q) wq[q] = *(const f32x4*)(IW + (size_t)(tok0 + q) * 8 + 4 * hi);
        int rel[2];
#pragma unroll
        for (int p = 0; p < 2; ++p) rel[p] = NMETA + 16 * q16 + 4 * qg + p + 2 * hi - c;
        const bf16_t* kp = IK + (size_t)(b * TT + c) * IDXD + 8 * hi;
        LAS unsigned* srow = SU + (4 * qg + 2 * hi) * ROWP + c;
        bf16x8 bfr[4], bnx[4];
#pragma unroll
        for (int ks = 0; ks < 4; ++ks) { bfr[ks] = *(const bf16x8*)(kp + (size_t)par * 32 * IDXD + 16 * ks); bnx[ks] = bfr[ks]; }
        for (int blk = par; blk < nwblk; blk += 2) {
            if (blk + 2 < nwblk) {
#pragma unroll
                for (int ks = 0; ks < 4; ++ks) bnx[ks] = *(const bf16x8*)(kp + (size_t)(blk + 2) * 32 * IDXD + 16 * ks); }
            f32x16 acc = {};
#pragma unroll
            for (int ks = 0; ks < 4; ++ks) acc = __builtin_amdgcn_mfma_f32_32x32x16_bf16(af[ks], bfr[ks], acc, 0, 0, 0);
            float full[4];
#pragma unroll
            for (int q = 0; q < 4; ++q) { float s = 0.f;
#pragma unroll
                for (int i = 0; i < 4; ++i) s += wq[q][i] * fmaxf(acc[4 * q + i], 0.f);
                full[q] = s + __shfl_xor(s, 32); }
#pragma unroll
            for (int p = 0; p < 2; ++p) { const float sc = hi ? full[p + 2] : full[p]; srow[p * ROWP + 32 * blk] = (32 * blk <= rel[p]) ? f2ord(sc) : 0u; }
#pragma unroll
            for (int ks = 0; ks < 4; ++ks) bfr[ks] = bnx[ks];
        }
    }
    __syncthreads();
    {
        const int nj = (nwblk + 1) >> 1, klim = 32 * nwblk;
        unsigned U[NJ][2];
#pragma unroll
        for (int j = 0; j < NJ; ++j) {
            if (j < nj) { const int key = 64 * j + lane;
#pragma unroll
                for (int p = 0; p < 2; ++p) U[j][p] = (key < klim) ? SU[(2 * w + p) * ROWP + key] : 0u; }
            else { U[j][0] = 0u; U[j][1] = 0u; }
        }
        const int tokb = b * SEQ + 16 * q16 + 2 * w;
        unsigned lo[2], hb[2], thr[2], veq[2]; int chi[2], need[2]; bool done[2];
#pragma unroll
        for (int p = 0; p < 2; ++p) { lo[p] = 1u; hb[p] = 0xffffffffu; chi[p] = 0; need[p] = 0; veq[p] = 0u; thr[p] = 1u; done[p] = (NMETA + 16 * q16 + 2 * w + p + 1 <= TOPK); }
        for (int it = 0; it < 34; ++it) {
            if (done[0] && done[1]) break;
            unsigned mid[2]; int cnt[2];
#pragma unroll
            for (int p = 0; p < 2; ++p) { mid[p] = lo[p] + ((hb[p] - lo[p]) >> 1); cnt[p] = 0; }
#pragma unroll
            for (int j = 0; j < NJ; ++j) if (j < nj) {
#pragma unroll
                for (int p = 0; p < 2; ++p) cnt[p] += __popcll(__ballot(U[j][p] >= mid[p])); }
#pragma unroll
            for (int p = 0; p < 2; ++p) {
                const int ct = cnt[p];
                if (!done[p]) {
                    if (ct == TOPK) { done[p] = true; thr[p] = mid[p]; need[p] = 0; }
                    else if (ct > TOPK) lo[p] = mid[p];
                    else { hb[p] = mid[p]; chi[p] = ct; }
                    if (!done[p] && hb[p] - lo[p] == 1u) { done[p] = true; thr[p] = hb[p]; veq[p] = lo[p]; need[p] = TOPK - chi[p]; }
                }
            }
        }
#pragma unroll
        for (int p = 0; p < 2; ++p) {
            int run = 0;
            unsigned long long* mrow = (unsigned long long*)(MASK + (size_t)(tokb + p) * MSTR);
#pragma unroll
            for (int j = 0; j < NJ; ++j) if (j < nj) {
                const unsigned u = U[j][p];
                const bool eq = (need[p] > 0) && (u == veq[p]);
                const unsigned long long em = __ballot(eq);
                const int rank = run + (int)__builtin_amdgcn_mbcnt_hi((unsigned)(em >> 32), __builtin_amdgcn_mbcnt_lo((unsigned)em, 0u));
                const bool take = (u >= thr[p]) || (eq && rank < need[p]);
                run += __popcll(em);
                const unsigned long long sm = __ballot(take);
                if (lane == 0) mrow[j] = sm;
            }
        }
    }
    __syncthreads();
}
__device__ __forceinline__ void p2_indexer(Frame& F) {
    for (int i = F.bid; i < 256; i += F.G) { const int b = i >> 5, j = 2 * (i & 31);
        p2_indexer_unit(F, b, j); p2_indexer_unit(F, b, 127 - j); p2_indexer_unit(F, b, j + 1); p2_indexer_unit(F, b, 126 - j); }
}

__device__ const unsigned char T5B[128] = {0, 1, 2, 3, 4, 5, 6, 7, 8, 9, 10, 11, 12, 13, 14, 15, 16, 16, 16, 17, 17, 18, 18, 18, 19, 19, 19, 20, 20, 20, 20, 21, 21, 21, 21, 22, 22, 22, 22, 22, 23, 23, 23, 23, 23, 23, 24, 24, 24, 24, 24, 24, 25, 25, 25, 25, 25, 25, 25, 26, 26, 26, 26, 26, 26, 26, 26, 27, 27, 27, 27, 27, 27, 27, 27, 27, 27, 28, 28, 28, 28, 28, 28, 28, 28, 28, 28, 29, 29, 29, 29, 29, 29, 29, 29, 29, 29, 29, 29, 30, 30, 30, 30, 30, 30, 30, 30, 30, 30, 30, 30, 30, 30, 31, 31, 31, 31, 31, 31, 31, 31, 31, 31, 31, 31, 31, 31, 31};
constexpr int TBS = 132;
__device__ __forceinline__ int crow(int r, int hi) { return (r & 3) + 8 * (r >> 2) + 4 * hi; }
__device__ __forceinline__ void p3_attn_unit(Frame& F, int b, int qb, const LAS float* tb, LAS float* sc) {
    unsigned char* ws = F.ws;
    const bf16_t* Q = wsp<bf16_t>(ws, WS_Q); const bf16_t* KB = wsp<bf16_t>(ws, WS_KB); const bf16_t* VT = wsp<bf16_t>(ws, WS_VT); const unsigned* MASK = wsp<unsigned>(ws, WS_MASK); bf16_t* AO = wsp<bf16_t>(ws, WS_AO);
    const int lane = F.lane, c = lane & 31, hi = lane >> 5, h = F.wave;
    const int tokq = b * SEQ + 32 * qb + c, posq = NMETA + 32 * qb + c;
    bf16x8 qf[4];
#pragma unroll
    for (int ks = 0; ks < 4; ++ks) qf[ks] = *(const bf16x8*)(Q + (size_t)tokq * AW + h * HD + 16 * ks + 8 * hi);
    const unsigned* mrow = MASK + (size_t)tokq * MSTR;
    const LAS float* tbh = tb + h * TBS;
    const float NEG = -INFINITY;
    float m_run = NEG, l = 0.f; f32x16 O0 = {}, O1 = {};
    const bf16_t* kbase = KB + (size_t)(b * TT + c) * AW + h * HD + 8 * hi;
    const bf16_t* vbase = VT + ((size_t)b * AW + h * HD + c) * TP + VOFF + 4 * hi;
    for (int kb = 0; kb <= qb + 1; ++kb) {
        bf16x8 kf[4];
#pragma unroll
        for (int ks = 0; ks < 4; ++ks) kf[ks] = *(const bf16x8*)(kbase + (size_t)kb * 32 * AW + 16 * ks);
        const unsigned mw = mrow[kb];
        s16x4 vlo[2][2], vhi[2][2];
#pragma unroll
        for (int s2 = 0; s2 < 2; ++s2)
#pragma unroll
            for (int db = 0; db < 2; ++db) { const bf16_t* vp = vbase + (size_t)db * 32 * TP + 32 * kb + 16 * s2; vlo[s2][db] = *(const s16x4*)vp; vhi[s2][db] = *(const s16x4*)(vp + 8); }
        f32x16 S = {};
#pragma unroll
        for (int ks = 0; ks < 4; ++ks) S = __builtin_amdgcn_mfma_f32_32x32x16_bf16(kf[ks], qf[ks], S, 0, 0, 0);
        const bool far = (qb - kb >= 5);
        const float bfar = tbh[128];
        const int dbase = posq - 32 * kb;
        float tmax = NEG;
#pragma unroll
        for (int r = 0; r < 16; ++r) { const int kvl = crow(r, hi);
            float bias = bfar;
            if (!far) { int d = dbase - kvl; d = d < 0 ? 0 : (d > 128 ? 128 : d); bias = tbh[d]; }
            const float s = ((mw >> kvl) & 1u) ? S[r] + bias : NEG;
            S[r] = s; tmax = fmaxf(tmax, s); }
        tmax = fmaxf(tmax, __shfl_xor(tmax, 32));
        const float m_new = fmaxf(m_run, tmax), m_use = (m_new == NEG) ? 0.f : m_new;
        const float alpha = __builtin_amdgcn_exp2f(m_run - m_use);
        float ps = 0.f;
#pragma unroll
        for (int r = 0; r < 16; ++r) { S[r] = __builtin_amdgcn_exp2f(S[r] - m_use); ps += S[r]; }
        l = l * alpha + ps; m_run = m_new;
        if (hi == 0) sc[c] = alpha;
        LDS_WAIT(); asm volatile("" ::: "memory");
#pragma unroll
        for (int r = 0; r < 16; ++r) { const float f = sc[crow(r, hi)]; O0[r] *= f; O1[r] *= f; }
        LDS_WAIT(); asm volatile("" ::: "memory");
#pragma unroll
        for (int s2 = 0; s2 < 2; ++s2) {
            u32x4 pw; pw.x = cvt_pk_bf16(S[8 * s2 + 0], S[8 * s2 + 1]); pw.y = cvt_pk_bf16(S[8 * s2 + 2], S[8 * s2 + 3]); pw.z = cvt_pk_bf16(S[8 * s2 + 4], S[8 * s2 + 5]); pw.w = cvt_pk_bf16(S[8 * s2 + 6], S[8 * s2 + 7]);
            const bf16x8 pf = __builtin_bit_cast(bf16x8, pw);
            const bf16x8 v0 = (bf16x8){vlo[s2][0][0], vlo[s2][0][1], vlo[s2][0][2], vlo[s2][0][3], vhi[s2][0][0], vhi[s2][0][1], vhi[s2][0][2], vhi[s2][0][3]};
            const bf16x8 v1 = (bf16x8){vlo[s2][1][0], vlo[s2][1][1], vlo[s2][1][2], vlo[s2][1][3], vhi[s2][1][0], vhi[s2][1][1], vhi[s2][1][2], vhi[s2][1][3]};
            O0 = __builtin_amdgcn_mfma_f32_32x32x16_bf16(pf, v0, O0, 0, 0, 0);
            O1 = __builtin_amdgcn_mfma_f32_32x32x16_bf16(pf, v1, O1, 0, 0, 0);
        }
    }
    const float lt = l + __shfl_xor(l, 32);
    if (hi == 0) sc[c] = 1.0f / lt;
    LDS_WAIT(); asm volatile("" ::: "memory");
    bf16_t* ob = AO + (size_t)(b * SEQ + 32 * qb) * AW + h * HD + c;
#pragma unroll
    for (int r = 0; r < 16; ++r) { const int qr = crow(r, hi); const float f = sc[qr];
        const float a0 = O0[r] * f, a1 = O1[r] * f, b0 = __shfl_xor(a0, 1), b1 = __shfl_xor(a1, 1);
        if ((c & 1) == 0) { *(unsigned*)(ob + (size_t)qr * AW) = cvt_pk_bf16(a0, b0); *(unsigned*)(ob + (size_t)qr * AW + 32) = cvt_pk_bf16(a1, b1); } }
    LDS_WAIT(); asm volatile("" ::: "memory");
}
__device__ __forceinline__ void p3_attn(Frame& F, const Args& a) {
    LAS float* tb = (LAS float*)F.lds;
    LAS float* sc = (LAS float*)(F.lds + 8192) + F.wave * 32;
    __syncthreads();
    for (int idx = F.tid; idx < NH * 129; idx += NTHREADS) { const int h = idx / 129, d = idx % 129; const int bk = d < 128 ? (int)T5B[d] : 31; tb[h * TBS + d] = a.in[I_RELB][bk * NH + h] * LOG2E; }
    __syncthreads();
    for (int i = F.bid; i < 256; i += F.G) { const int b = i >> 5, j = i & 31; p3_attn_unit(F, b, j, tb, sc); p3_attn_unit(F, b, 63 - j, tb, sc); }
    __syncthreads();
}

__device__ __forceinline__ void p6_router(Frame& F, const Args& a) {
    unsigned char* ws = F.ws;
    const float* H1 = a.out; bf16_t* HN = wsp<bf16_t>(ws, WS_XN);
    const float* gf = a.in[I_NFFN]; const float* wrt = a.in[I_WR]; const float* brt = a.in[I_BR];
    int* TE = wsp<int>(ws, WS_TE); int* TPs = wsp<int>(ws, WS_TP); int* LIST = wsp<int>(ws, WS_LIST); float* LG = wsp<float>(ws, WS_LG);
    unsigned* ecnt = wsp<unsigned>(ws, WS_CTL) + CW_ECNT;
    LAS float* rinv = (LAS float*)F.lds;
    LAS float* part = (LAS float*)(F.lds + 1024);
    LAS int* lcnt = (LAS int*)(F.lds + 1024 + 8 * 64 * 33 * 4);
    LAS int* lbase = lcnt + 32;
    const int lane = F.lane, w = F.wave;
    for (int tb = F.bid; tb < NTOK / 64; tb += F.G) {
        const int t0 = tb * 64;
        __syncthreads();
        if (F.tid < 32) lcnt[F.tid] = 0;
        for (int i = 0; i < 8; ++i) {
            const int t = t0 + 8 * w + i; const f32x4* xr = (const f32x4*)(H1 + (size_t)t * DM) + lane; const f32x4* gr = (const f32x4*)gf + lane;
            f32x4 v[4]; float s = 0.f;
#pragma unroll
            for (int j = 0; j < 4; ++j) { v[j] = xr[64 * j]; s += (v[j].x * v[j].x + v[j].y * v[j].y) + (v[j].z * v[j].z + v[j].w * v[j].w); }
            const float r = 1.0f / sqrtf(wave_sum(s) * (1.f / DM) + EPS);
            if (lane == 0) rinv[8 * w + i] = r;
            unsigned long long* o8 = (unsigned long long*)(HN + (size_t)t * DM) + lane;
#pragma unroll
            for (int j = 0; j < 4; ++j) { const f32x4 gg = gr[64 * j];
                o8[64 * j] = (unsigned long long)cvt_pk_bf16(v[j].x * r * gg.x, v[j].y * r * gg.y) | ((unsigned long long)cvt_pk_bf16(v[j].z * r * gg.z, v[j].w * r * gg.w) << 32); }
        }
        __syncthreads();
        {
            const float r = rinv[lane]; const float* xr = H1 + (size_t)(t0 + lane) * DM + 128 * w;
            float acc[NE];
#pragma unroll
            for (int e = 0; e < NE; ++e) acc[e] = 0.f;
            for (int k4 = 0; k4 < 32; ++k4) {
                const f32x4 xv = *(const f32x4*)(xr + 4 * k4);
#pragma unroll
                for (int kk = 0; kk < 4; ++kk) { const int k = 128 * w + 4 * k4 + kk; const float hn = xv[kk] * r * gf[k]; const float* wrow = wrt + (size_t)k * NE;
#pragma unroll
                    for (int e = 0; e < NE; ++e) acc[e] += hn * wrow[e]; }
            }
#pragma unroll
            for (int e = 0; e < NE; ++e) part[(w * 64 + lane) * 33 + e] = acc[e];
        }
        __syncthreads();
        if (w == 0) {
            float lg[NE];
#pragma unroll
            for (int e = 0; e < NE; ++e) { float s = brt[e];
#pragma unroll
                for (int ww = 0; ww < 8; ++ww) s += part[(ww * 64 + lane) * 33 + e];
                lg[e] = s; }
            int sel[4]; float val[4];
#pragma unroll
            for (int j = 0; j < 4; ++j) { float best = -INFINITY; int bi = 0;
#pragma unroll
                for (int e = 0; e < NE; ++e) { const bool tk = lg[e] > best; best = tk ? lg[e] : best; bi = tk ? e : bi; }
                sel[j] = bi; val[j] = best;
#pragma unroll
                for (int e = 0; e < NE; ++e) lg[e] = (e == bi) ? -INFINITY : lg[e]; }
            float den = 0.f, ex[4];
#pragma unroll
            for (int j = 0; j < 4; ++j) { ex[j] = __expf(val[j] - val[0]); den += ex[j]; }
            int slot[4];
#pragma unroll
            for (int j = 0; j < 4; ++j) slot[j] = __hip_atomic_fetch_add(&lcnt[sel[j]], 1, __ATOMIC_RELAXED, __HIP_MEMORY_SCOPE_WORKGROUP);
            LDS_WAIT();
            if (lane < 32) { const int n = lcnt[lane]; lbase[lane] = n ? (int)__hip_atomic_fetch_add(ecnt + 64 * lane, (unsigned)n, RLX_AGENT) : 0; }
            LDS_WAIT(); asm volatile("" ::: "memory");
            const int t = t0 + lane;
#pragma unroll
            for (int j = 0; j < 4; ++j) { const int e = sel[j], pos = lbase[e] + slot[j]; const float g = ex[j] / den;
                TE[t * 4 + j] = e; TPs[t * 4 + j] = pos; LIST[(size_t)e * NTOK + pos] = t; LG[(size_t)e * NTOK + pos] = g; }
        }
    }
    __syncthreads();
}
__device__ __forceinline__ void moe_tables(Frame& F, LAS int* cnt, LAS int* tbase) {
    const unsigned* ecnt = wsp<unsigned>(F.ws, WS_CTL) + CW_ECNT;
    __syncthreads();
    if (F.tid < NE) cnt[F.tid] = (int)__hip_atomic_load(ecnt + 64 * F.tid, RLX_AGENT);
    __syncthreads();
    if (F.tid == 0) { int s = 0; for (int e = 0; e < NE; ++e) { tbase[e] = s; s += (cnt[e] + 255) >> 8; } tbase[NE] = s; }
    __syncthreads();
}

__device__ __forceinline__ void p9_final(Frame& F, const Args& a, const LAS int* tbase) {
    unsigned char* ws = F.ws;
    float* H1 = a.out; const bf16_t* YP = wsp<bf16_t>(ws, WS_YP); const int* TE = wsp<int>(ws, WS_TE); const int* TPs = wsp<int>(ws, WS_TP); const float* gf = a.in[I_NFIN];
    const int gw = F.bid * NWAVES + F.wave, NGW = F.G * NWAVES, lane = F.lane;
    const f32x4* gr = (const f32x4*)gf + lane;
    f32x4 gg[4];
#pragma unroll
    for (int j = 0; j < 4; ++j) gg[j] = gr[64 * j];
    for (int base = 0; base < NTOK; base += 8 * NGW) {
        int myrow = 0;
        { const int i = lane >> 2, j = lane & 3, t = base + gw + NGW * i; if (lane < 32 && t < NTOK) { const int e = TE[t * 4 + j], pos = TPs[t * 4 + j]; myrow = tbase[e] * 256 + pos; } }
        f32x4 va[4], vb[4]; u32x2 ya[4][4], yb[4][4];
#define P9_LOAD(i, V, Y) do { const int t_ = base + gw + NGW * (i); if (t_ < NTOK) { const f32x4* xr_ = (const f32x4*)(H1 + (size_t)t_ * DM) + lane; \
            _Pragma("unroll") for (int j_ = 0; j_ < 4; ++j_) V[j_] = xr_[64 * j_]; \
            _Pragma("unroll") for (int q_ = 0; q_ < 4; ++q_) { const int row_ = __builtin_amdgcn_readlane(myrow, 4 * (i) + q_); const u32x2* yr_ = (const u32x2*)(YP + (size_t)row_ * DM) + lane; \
                _Pragma("unroll") for (int j_ = 0; j_ < 4; ++j_) Y[q_][j_] = yr_[64 * j_]; } } } while (0)
#define P9_PROC(i, V, Y) do { const int t_ = base + gw + NGW * (i); if (t_ < NTOK) { \
            _Pragma("unroll") for (int q_ = 0; q_ < 4; ++q_) _Pragma("unroll") for (int j_ = 0; j_ < 4; ++j_) { const u32x2 y_ = Y[q_][j_]; V[j_].x += bflo(y_.x); V[j_].y += bfhi(y_.x); V[j_].z += bflo(y_.y); V[j_].w += bfhi(y_.y); } \
            float s_ = 0.f; _Pragma("unroll") for (int j_ = 0; j_ < 4; ++j_) s_ += (V[j_].x * V[j_].x + V[j_].y * V[j_].y) + (V[j_].z * V[j_].z + V[j_].w * V[j_].w); \
            const float r_ = 1.0f / sqrtf(wave_sum(s_) * (1.f / DM) + EPS); f32x4* xo_ = (f32x4*)(H1 + (size_t)t_ * DM) + lane; \
            _Pragma("unroll") for (int j_ = 0; j_ < 4; ++j_) xo_[64 * j_] = (f32x4){V[j_].x * r_ * gg[j_].x, V[j_].y * r_ * gg[j_].y, V[j_].z * r_ * gg[j_].z, V[j_].w * r_ * gg[j_].w}; } } while (0)
        P9_LOAD(0, va, ya);
#pragma unroll
        for (int i = 0; i < 8; i += 2) {
            P9_LOAD(i + 1, vb, yb);
            P9_PROC(i, va, ya);
            if (i + 2 < 8) P9_LOAD(i + 2, va, ya);
            P9_PROC(i + 1, vb, yb);
        }
#undef P9_LOAD
#undef P9_PROC
    }
}

constexpr int N_PHASES = 10;
__global__ void __launch_bounds__(NTHREADS, 2) fwd_kernel(Args args) {
    extern __shared__ __attribute__((aligned(16))) unsigned char lds_raw[];
    Frame F;
    F.lds = (LAS unsigned char*)lds_raw; F.ws = args.ws;
    F.tid = threadIdx.x; F.lane = F.tid & 63; F.wave = __builtin_amdgcn_readfirstlane(F.tid >> 6);
    F.G = gridDim.x; F.bid = blockIdx.x;
    volatile LAS unsigned* MISC = (volatile LAS unsigned*)(F.lds + MISC_OFF);
    if (F.tid < 32) MISC[F.tid] = 0u;
    __syncthreads();
    unsigned* ctl = wsp<unsigned>(args.ws, WS_CTL);
    const int lo = args.ph_lo, hi = args.ph_hi;
    const bool multi = (hi - lo) > 1;
    XcdBarrier bar; bar.bar = ctl + CW_BAR; bar.x = 0; bar.st = nullptr;
    if (multi) bar = xcd_barrier_post(ctl + CW_BAR, MISC + 8);
#ifndef PHASE_MASK
#define PHASE_MASK 0x3ff
#endif
#define IN(k) (((PHASE_MASK >> (k)) & 1) && lo <= (k) && (k) < hi)
#define SEAM(k) do { if (IN(k) && IN((k) + 1)) xcd_barrier(bar); } while (0)
    LAS int* l_cnt = (LAS int*)(F.lds + LDSX_OFF); LAS int* l_tbase = l_cnt + 64;
    const MoeTables MT{l_cnt, l_tbase};

    if (IN(0)) { p0_prologue(F, args); } SEAM(0);
    if (IN(1)) {
        PlainSched S; S.init(args.ws, WS_XN, WS_WIN, NTOK, 5120, DM, F.G, F.bid);
        EpiInProj E{args.ws, args.in[I_BGATE]};
        pg8::gemm_phase<EpiInProj, PlainSched>(F.lds, DM, S, E);
        p1_thin(F);
    } SEAM(1);
    if (IN(2)) {
#ifndef DBG_NO_CONV
        p2_conv(F, args);
#endif
#ifndef DBG_NO_IDX
        p2_indexer(F);
#endif
    } SEAM(2);
    if (IN(3)) { p3_attn(F, args); } SEAM(3);
    if (IN(4)) {
        MergeSched S{(const char*)args.ws, F.G, F.bid}; EpiMerge E{args.ws};
        pg8::gemm_phase<EpiMerge, MergeSched>(F.lds, 512, S, E);
    } SEAM(4);
    if (IN(5)) {
        PlainSched S; S.init(args.ws, WS_MG, WS_WOUT, NTOK, DM, DM, F.G, F.bid);
        EpiResid E{args.in[I_X], args.out};
        pg8::gemm_phase<EpiResid, PlainSched>(F.lds, DM, S, E);
    } SEAM(5);
    if (IN(6)) { p6_router(F, args); } SEAM(6);
    if (IN(7)) {
        moe_tables(F, l_cnt, l_tbase);
        MoeSched<8, true> S{(const char*)args.ws, MT, F.G, F.bid, l_tbase[NE] * 8};
        EpiSwiglu E{args.ws, args.in[I_BUG], MT};
        pg8::gemm_phase<EpiSwiglu, MoeSched<8, true>>(F.lds, DM, S, E);
    } SEAM(7);
    if (IN(8)) {
        moe_tables(F, l_cnt, l_tbase);
        MoeSched<4, false> S{(const char*)args.ws, MT, F.G, F.bid, l_tbase[NE] * 4};
        EpiDown E{args.ws, args.in[I_BD], MT};
        pg8::gemm_phase<EpiDown, MoeSched<4, false>>(F.lds, DFF, S, E);
    } SEAM(8);
    if (IN(9)) { moe_tables(F, l_cnt, l_tbase); p9_final(F, args, l_tbase); }
#undef IN
#undef SEAM
}

#ifdef DBG_HASH_OFF
__global__ void dbg_hash(const unsigned* __restrict__ buf, size_t nwords, unsigned* acc) {
    unsigned h = 0u;
    for (size_t i = (size_t)blockIdx.x * blockDim.x + threadIdx.x; i < nwords; i += (size_t)gridDim.x * blockDim.x) h += (buf[i] ^ (unsigned)(i * 2654435761u)) * 2246822519u + (unsigned)i;
#pragma unroll
    for (int o = 1; o < 64; o <<= 1) h += __shfl_xor(h, o);
    if ((threadIdx.x & 63) == 0) atomicAdd(acc, h);
}
__global__ void dbg_fill(float* out, size_t n, const unsigned* acc) {
    const unsigned h = *acc; const float v = (float)((h >> 7) & 0xffffu) * (1.0f / 4096.0f) + 1.0f;
    for (size_t i = (size_t)blockIdx.x * blockDim.x + threadIdx.x; i < n; i += (size_t)gridDim.x * blockDim.x) out[i] = v;
}
#endif

extern "C" void kernel_launch(void* const* d_in, const int* in_sizes, int n_in, void* d_out, int out_size, void* d_ws, size_t ws_size, hipStream_t stream) {
    static int grid = 0;
    if (grid == 0) {
        if (n_in != 21 || out_size != NTOK * DM || ws_size < WS_END) { fprintf(stderr, "kernel_launch: unexpected shapes (n_in %d, out %d, ws %zu < %zu)\n", n_in, out_size, ws_size, (size_t)WS_END); grid = -1; return; }
        int dev = 0, cus = 0, per_cu = 0;
        if (hipGetDevice(&dev) != hipSuccess || hipDeviceGetAttribute(&cus, hipDeviceAttributeMultiprocessorCount, dev) != hipSuccess) { grid = -1; return; }
        if (hipFuncSetAttribute((const void*)fwd_kernel, hipFuncAttributeMaxDynamicSharedMemorySize, LDS_BYTES) != hipSuccess) { fprintf(stderr, "kernel_launch: hipFuncSetAttribute failed\n"); grid = -1; return; }
        if (hipOccupancyMaxActiveBlocksPerMultiprocessor(&per_cu, (const void*)fwd_kernel, NTHREADS, LDS_BYTES) != hipSuccess || per_cu < 1) { fprintf(stderr, "kernel_launch: occupancy query says %d\n", per_cu); }
        (void)hipGetLastError();
        grid = cus;
    }
    if (grid < 0) return;
    (void)hipMemsetAsync((char*)d_ws + WS_CTL, 0, CTL_ZERO_BYTES, stream);
    Args a{};
    for (int i = 0; i < 21; ++i) a.in[i] = (const float*)d_in[i];
    a.out = (float*)d_out; a.ws = (unsigned char*)d_ws;
#if MK_N_LAUNCHES == 1
    a.ph_lo = 0; a.ph_hi = N_PHASES;
    hipLaunchKernelGGL(fwd_kernel, dim3(grid), dim3(NTHREADS), LDS_BYTES, stream, a);
#else
#ifndef DBG_LAST_PHASE
#define DBG_LAST_PHASE (N_PHASES - 1)
#endif
    for (int p = 0; p <= DBG_LAST_PHASE; ++p) { a.ph_lo = p; a.ph_hi = p + 1; hipLaunchKernelGGL(fwd_kernel, dim3(grid), dim3(NTHREADS), LDS_BYTES, stream, a); }
#ifdef DBG_HASH_OFF
    { const unsigned* hb = DBG_HASH_OFF == 0 ? (const unsigned*)d_out : (const unsigned*)((char*)d_ws + DBG_HASH_OFF);
      hipLaunchKernelGGL(dbg_hash, dim3(1024), dim3(256), 0, stream, hb, (size_t)(DBG_HASH_BYTES) / 4, (unsigned*)d_ws + 2);
      hipLaunchKernelGGL(dbg_fill, dim3(1024), dim3(256), 0, stream, (float*)d_out, (size_t)NTOK * DM, (const unsigned*)d_ws + 2); }
#endif
#endif
}
```

```cpp
#include <hip/hip_runtime.h>
#include <cstdio>
#include <cstdint>

#ifndef MK_N_LAUNCHES
#define MK_N_LAUNCHES 1
#endif

constexpr int NB = 8, SEQ = 2048, NMETA = 16, TT = SEQ + NMETA  , DM = 1024, NTOK = NB * SEQ  , NALL = NB * TT  ;
constexpr int AW = 512, NH = 8, HD = 64, IDXD = 64, CC = 512, CW = 31, NE = 32, DFF = 1024, TOPK = 256;
constexpr int INCOLS = 5192, TP = 2176  , VOFF = 0  , MSTR = 68  ;
constexpr float EPS = 1e-6f, LOG2E = 1.4426950408889634f;
constexpr float QSCALE = 0.125f * LOG2E;
constexpr int MAXTILES = 296;
constexpr int SC_Q = 0, SC_K = 512, SC_V = 1024, SC_IQ = 1536, SC_IK = 2048, SC_IW = 2112, SC_GLU = 2120, SC_GATE = 3144;
constexpr int WR_GLU = 2048, WR_GATE = 3072, WR_IK = 5120, WR_IW = 5184, WIN_ROWS = 5376;

constexpr size_t MiB = 1u << 20;
constexpr size_t al4k(size_t x) { return (x + 4095) & ~(size_t)4095; }
constexpr size_t WS_CTL = 0, CTL_ZERO_BYTES = 1 * MiB;
constexpr size_t WS_WIN = 1 * MiB;
constexpr size_t WS_WAO = WS_WIN + al4k((size_t)WIN_ROWS * DM * 2);
constexpr size_t WS_WCO = WS_WAO + al4k((size_t)DM * AW * 2);
constexpr size_t WS_WOUT = WS_WCO + al4k((size_t)DM * CC * 2);
constexpr size_t WS_WUG = WS_WOUT + al4k((size_t)DM * DM * 2);
constexpr size_t WS_WD = WS_WUG + al4k((size_t)NE * 2 * DFF * DM * 2);
constexpr size_t WS_XN = WS_WD + al4k((size_t)NE * DM * DFF * 2);
constexpr size_t WS_XNM = WS_XN + al4k((size_t)NTOK * DM * 2);
constexpr size_t WS_Q = WS_XNM + al4k((size_t)NMETA * DM * 2);
constexpr size_t WS_IQ = WS_Q + al4k((size_t)NTOK * AW * 2);
constexpr size_t WS_KB = WS_IQ + al4k((size_t)NTOK * AW * 2);
constexpr size_t WS_VT = WS_KB + al4k((size_t)(NALL + 64) * AW * 2);
constexpr size_t WS_IK = WS_VT + al4k((size_t)NB * AW * TP * 2);
constexpr size_t WS_IW = WS_IK + al4k((size_t)(NALL + 64) * IDXD * 2);
constexpr size_t WS_GLU = WS_IW + al4k((size_t)NTOK * 8 * 4);
constexpr size_t WS_GA = WS_GLU + al4k((size_t)NALL * CC * 2);
constexpr size_t WS_GB = WS_GA + al4k((size_t)NTOK * DM * 2);
constexpr size_t WS_MASK = WS_GB + al4k((size_t)NTOK * DM * 2);
constexpr size_t WS_AO = WS_MASK + al4k((size_t)NTOK * MSTR * 4);
constexpr size_t WS_CO = WS_AO + al4k((size_t)NTOK * AW * 2);
constexpr size_t WS_MG = WS_CO + al4k((size_t)NTOK * CC * 2);
constexpr size_t WS_TE = WS_MG + al4k((size_t)NTOK * DM * 2);
constexpr size_t WS_TP = WS_TE + al4k((size_t)NTOK * 4 * 4);
constexpr size_t WS_LIST = WS_TP + al4k((size_t)NTOK * 4 * 4);
constexpr size_t WS_LG = WS_LIST + al4k((size_t)NE * NTOK * 4);
constexpr size_t WS_ACT = WS_LG + al4k((size_t)NE * NTOK * 4);
constexpr size_t WS_YP = WS_ACT + al4k((size_t)MAXTILES * 256 * DFF * 2);
constexpr size_t WS_H1 = WS_YP + al4k((size_t)MAXTILES * 256 * DM * 2);
constexpr size_t WS_END = WS_H1 + al4k((size_t)NTOK * DM * 4);
static_assert(WS_END < ((size_t)1 << 32), "32-bit byte offsets into d_ws");
constexpr int CW_TMO = 0, CW_CODE = 1, CW_BAR = 4096, CW_ECNT = 16384;

constexpr int RING_BYTES = 131072;
constexpr int LDSX_OFF = RING_BYTES;
constexpr int MISC_OFF = RING_BYTES + 8192;
constexpr int LDS_BYTES = 147456;
constexpr int NWAVES = 8, NTHREADS = 512;

#define GAS __attribute__((address_space(1)))
#define LAS __attribute__((address_space(3)))
typedef unsigned short bf16_t;
typedef short bf16x8 __attribute__((ext_vector_type(8)));
typedef short s16x4 __attribute__((ext_vector_type(4)));
typedef float f32x4 __attribute__((ext_vector_type(4)));
typedef float f32x16 __attribute__((ext_vector_type(16)));
typedef unsigned u32x4 __attribute__((ext_vector_type(4)));
typedef unsigned u32x2 __attribute__((ext_vector_type(2)));
typedef GAS unsigned gu32;
#define RLX_AGENT __ATOMIC_RELAXED, __HIP_MEMORY_SCOPE_AGENT
#define LDS_WAIT() asm volatile("s_waitcnt lgkmcnt(0)" ::: "memory")
#define VM_WAIT() asm volatile("s_waitcnt vmcnt(0)" ::: "memory")

typedef float f32x2_t __attribute__((ext_vector_type(2))); typedef __bf16 bf16x2_t __attribute__((ext_vector_type(2)));
__device__ __forceinline__ unsigned cvt_pk_bf16(float lo, float hi) { const f32x2_t v = {lo, hi}; const bf16x2_t b = __builtin_convertvector(v, bf16x2_t); return __builtin_bit_cast(unsigned, b); }
__device__ __forceinline__ float bf2f(unsigned short b) { return __uint_as_float((unsigned)b << 16); }
__device__ __forceinline__ float bflo(unsigned w) { return __uint_as_float(w << 16); }
__device__ __forceinline__ float bfhi(unsigned w) { return __uint_as_float(w & 0xffff0000u); }
__device__ __forceinline__ float sigmoidf_(float x) { return __builtin_amdgcn_rcpf(1.0f + __builtin_amdgcn_exp2f(-LOG2E * x)); }
__device__ __forceinline__ float wave_sum(float v) {
#pragma unroll
    for (int o = 1; o < 64; o <<= 1) v += __shfl_xor(v, o);
    return v;
}

namespace pg8 {
constexpr int BM = 256, BK = 64, HALF = 128, HTB = HALF * BK * 2, STAGE_BYTES = 8 * HTB;
__host__ __device__ __forceinline__ int lds_byte(int r, int c) { const int st = (r >> 4) * 2 + (c >> 5), rr = r & 15, cc = c & 31, ob = rr * 64 + cc * 2; return st * 1024 + (ob ^ (((ob >> 9) & 1) << 5)); }
__host__ __device__ __forceinline__ void stage_rc(int b, int& R, int& C) { const int st = b / 1024, sb = b % 1024, swz = sb ^ (((sb >> 9) & 1) << 5); R = (st >> 1) * 16 + swz / 64; C = (st & 1) * 32 + (swz % 64) / 2; }

struct Unit { int pm, pn, z; };

template <class Epi, class Sched>
__device__ __forceinline__ void gemm_phase(LAS unsigned char* lds, const int K, const Sched& S, const Epi& E) {
    const int tid = threadIdx.x, wid = __builtin_amdgcn_readfirstlane(tid >> 6), lane = tid & 63, wr = wid >> 2, wc = wid & 3, fr = lane & 15, fq = lane >> 4;
    const int nt = K / BK;
    unsigned voffB[2];
#pragma unroll
    for (int i = 0; i < 2; ++i) { int R_, C_; stage_rc(tid * 16 + i * 8192, R_, C_); voffB[i] = (unsigned)(R_ * K + C_) * 2u; }
    const size_t kstep = (size_t)(BK * 2);
    const size_t hstep = (size_t)HALF * K * 2;
    const unsigned ldsw = (unsigned)wid * 1024u;
    const int aoff = lds_byte(wr * 64 + fr, fq * 8), boff = lds_byte(wc * 32 + fr, fq * 8);
    const char* const abase = S.a_base();
#define PG8_SA(b, h) (((b) * 2 + (h)) * HTB)
#define PG8_SB(b, h) ((4 + (b) * 2 + (h)) * HTB)
#define PG8_STAGE(bufoff, gbase, voff) do { _Pragma("unroll") for (int _i = 0; _i < 2; ++_i) \
        __builtin_amdgcn_global_load_lds((const unsigned*)((const char*)(gbase) + (voff)[_i]), (LAS unsigned*)(lds + (bufoff) + ldsw + _i * 8192), 16, 0, 0); } while (0)
#define PG8_LDA(dst, b, h) do { _Pragma("unroll") for (int m = 0; m < 4; ++m) _Pragma("unroll") for (int k = 0; k < 2; ++k) dst[m][k] = *(const LAS bf16x8*)(lds + PG8_SA(b, h) + aoff + m * 2048 + k * 1024); } while (0)
#define PG8_LDB(dst, b, h) do { _Pragma("unroll") for (int n = 0; n < 2; ++n) _Pragma("unroll") for (int k = 0; k < 2; ++k) dst[n][k] = *(const LAS bf16x8*)(lds + PG8_SB(b, h) + boff + n * 2048 + k * 1024); } while (0)
#define PG8_MMA(ai, bj, At, Bt) do { __builtin_amdgcn_s_setprio(1); _Pragma("unroll") for (int m = 0; m < 4; ++m) _Pragma("unroll") for (int n = 0; n < 2; ++n) _Pragma("unroll") for (int k = 0; k < 2; ++k) \
        acc[ai][bj][m][n] = __builtin_amdgcn_mfma_f32_16x16x32_bf16(Bt[n][k], At[m][k], acc[ai][bj][m][n], 0, 0, 0); __builtin_amdgcn_s_setprio(0); } while (0)
#define PG8_WAIT_V(n) asm volatile("s_waitcnt vmcnt(" #n ")" ::: "memory")
#define PG8_WAIT_L(n) asm volatile("s_waitcnt lgkmcnt(" #n ")" ::: "memory")
#define PG8_BAR __builtin_amdgcn_s_barrier()
#define PG8_SCHED __builtin_amdgcn_sched_barrier(0)
    Unit cur, nxt; int ui = 0;
    if (!S.next(0, cur)) return;
    f32x4 acc[2][2][4][2];
#pragma unroll
    for (int a = 0; a < 2; ++a)
#pragma unroll
        for (int b = 0; b < 2; ++b)
#pragma unroll
            for (int m = 0; m < 4; ++m)
#pragma unroll
                for (int n = 0; n < 2; ++n) acc[a][b][m][n] = (f32x4){0.f, 0.f, 0.f, 0.f};
    bf16x8 At[4][2], B0[2][2], B1[2][2];
    unsigned ca[2][2], na[2][2];
    S.a_offs(cur, tid, ca);
    const char* cB = S.b_base(cur);
    PG8_STAGE(PG8_SB(0, 0), cB, voffB); PG8_STAGE(PG8_SB(0, 1), cB + hstep, voffB); PG8_STAGE(PG8_SA(0, 0), abase, ca[0]); PG8_STAGE(PG8_SA(0, 1), abase, ca[1]);
    if (wr == 1) PG8_BAR;
    PG8_WAIT_V(2); PG8_BAR;
    PG8_STAGE(PG8_SB(1, 0), cB + kstep, voffB); PG8_STAGE(PG8_SA(1, 0), abase + kstep, ca[0]); PG8_STAGE(PG8_SB(1, 1), cB + hstep + kstep, voffB);
    PG8_WAIT_V(6); PG8_BAR;
    for (;;) {
        const bool has_next = S.next(ui + 1, nxt);
        const char* nB = cB;
#pragma unroll
        for (int h = 0; h < 2; ++h)
#pragma unroll
            for (int i = 0; i < 2; ++i) na[h][i] = ca[h][i];
        if (has_next) { S.a_offs(nxt, tid, na); nB = S.b_base(nxt); }
        for (int t = 0; t < nt; t += 2) {
            const bool last = (t == nt - 2);
            const char* a1 = abase + (size_t)(t + 1) * kstep;
            const char* a2 = last ? abase : abase + (size_t)(t + 2) * kstep; const char* b2 = last ? nB : cB + (size_t)(t + 2) * kstep;
            const char* a3 = a2 + kstep; const char* b3 = b2 + kstep;
            PG8_LDB(B0, 0, 0); PG8_LDB(B1, 0, 1); PG8_SCHED; PG8_LDA(At, 0, 0); PG8_STAGE(PG8_SA(1, 1), a1, ca[1]);
            PG8_WAIT_V(8); PG8_WAIT_L(0); PG8_BAR; PG8_MMA(0, 0, At, B0); PG8_MMA(0, 1, At, B1); PG8_BAR; PG8_SCHED;
            if (last) {
#pragma unroll
                for (int h = 0; h < 2; ++h)
#pragma unroll
                    for (int i = 0; i < 2; ++i) ca[h][i] = na[h][i];
            }
            PG8_LDA(At, 0, 1); PG8_STAGE(PG8_SB(0, 0), b2, voffB); PG8_STAGE(PG8_SB(0, 1), b2 + hstep, voffB); PG8_STAGE(PG8_SA(0, 0), a2, ca[0]);
            PG8_WAIT_V(8); PG8_WAIT_L(0); PG8_BAR; PG8_MMA(1, 0, At, B0); PG8_MMA(1, 1, At, B1); PG8_BAR; PG8_SCHED;
            PG8_LDB(B0, 1, 0); PG8_LDB(B1, 1, 1); PG8_SCHED; PG8_LDA(At, 1, 0); PG8_STAGE(PG8_SA(0, 1), a2, ca[1]);
            PG8_WAIT_V(8); PG8_WAIT_L(0); PG8_BAR; PG8_MMA(0, 0, At, B0); PG8_MMA(0, 1, At, B1); PG8_BAR; PG8_SCHED;
            PG8_LDA(At, 1, 1); PG8_STAGE(PG8_SB(1, 0), b3, voffB); PG8_STAGE(PG8_SB(1, 1), b3 + hstep, voffB); PG8_STAGE(PG8_SA(1, 0), a3, ca[0]);
            PG8_WAIT_V(8); PG8_WAIT_L(0); PG8_BAR; PG8_MMA(1, 0, At, B0); PG8_MMA(1, 1, At, B1); PG8_BAR; PG8_SCHED;
        }
        if (wr == 0) PG8_BAR;
        { int tz = tid; asm volatile("" : "+v"(tz));
          const int l2 = tz & 63, w2 = __builtin_amdgcn_readfirstlane(tz >> 6); E(acc, cur, w2 >> 2, w2 & 3, l2 & 15, l2 >> 4); }
        if (!has_next) break;
#pragma unroll
        for (int a = 0; a < 2; ++a)
#pragma unroll
            for (int b = 0; b < 2; ++b)
#pragma unroll
                for (int m = 0; m < 4; ++m)
#pragma unroll
                    for (int n = 0; n < 2; ++n) acc[a][b][m][n] = (f32x4){0.f, 0.f, 0.f, 0.f};
        cur = nxt; cB = nB; ++ui;
        if (wr == 1) PG8_BAR;
    }
    PG8_WAIT_V(0);
    PG8_BAR;
#undef PG8_SA
#undef PG8_SB
#undef PG8_STAGE
#undef PG8_LDA
#undef PG8_LDB
#undef PG8_MMA
#undef PG8_WAIT_V
#undef PG8_WAIT_L
#undef PG8_BAR
#undef PG8_SCHED
}
}

#define XB_TMO      128
#define XB_XCNT(j)  (256  + 64 * (j))
#define XB_XSUB(j)  (1280 + 64 * (j))
#define XB_XGEN(j)  (2304 + 64 * (j))
#define XB_TOP      3328
#define XB_TOPGEN   3392
#define XCD_BAR_WORDS 3456
#define XB_SPIN_CAP (1u << 18)
__device__ __forceinline__ unsigned xb_ld(unsigned* p)              { return __hip_atomic_load(p, __ATOMIC_RELAXED, __HIP_MEMORY_SCOPE_AGENT); }
__device__ __forceinline__ unsigned xb_add(unsigned* p, unsigned v) { return __hip_atomic_fetch_add(p, v, __ATOMIC_RELAXED, __HIP_MEMORY_SCOPE_AGENT); }
__device__ __forceinline__ unsigned xb_xcc_id() { return (unsigned)__builtin_amdgcn_s_getreg((3 << 11) | 20) & 0xFu; }
#define XB_SPIN(cond, bar) do { unsigned _sp = 0; while (cond) { __builtin_amdgcn_s_sleep(1); \
    if ((++_sp & 255u) == 0u) { if (xb_ld(&(bar)[XB_TMO])) break; if (_sp > XB_SPIN_CAP) { atomicAdd(&(bar)[XB_TMO], 1u); break; } } } } while (0)
struct XcdBarrier { unsigned* bar; unsigned x; volatile LAS unsigned* st; };
__device__ __forceinline__ XcdBarrier xcd_barrier_post(unsigned* bar, volatile LAS unsigned* st) {
    XcdBarrier b; b.bar = bar; b.x = xb_xcc_id(); b.st = st;
    if (threadIdx.x == 0) (void)xb_add(&bar[XB_XCNT(b.x)], 1u);
    return b;
}
__device__ __forceinline__ void xcd_barrier_complete(unsigned* bar, unsigned x, unsigned& nloc, unsigned& nx) {
    const unsigned G = gridDim.x * gridDim.y * gridDim.z;
    unsigned sum, cnt, mine, sp = 0u;
    for (;;) {
        sum = 0u; cnt = 0u; mine = 0u;
#pragma unroll
        for (unsigned j = 0; j < 16; ++j) { const unsigned c = xb_ld(&bar[XB_XCNT(j)]); sum += c; cnt += (c > 0u) ? 1u : 0u; mine = (j == x) ? c : mine; }
        if (sum == G) break;
        __builtin_amdgcn_s_sleep(1);
        if ((++sp & 255u) == 0u) { if (xb_ld(&bar[XB_TMO])) break; if (sp > XB_SPIN_CAP) { atomicAdd(&bar[XB_TMO], 1u); break; } }
    }
    nloc = mine > 0u ? mine : 1u; nx = cnt > 0u ? cnt : 1u;
}
__device__ __forceinline__ void xcd_barrier(const XcdBarrier& b) {
    asm volatile("s_waitcnt vmcnt(0)" ::: "memory");
    __syncthreads();
    if (threadIdx.x == 0) {
        unsigned* bar = b.bar;
        __builtin_amdgcn_s_waitcnt(0);
        unsigned nloc = b.st[0], nx = b.st[1];
        if (nloc == 0u) { xcd_barrier_complete(bar, b.x, nloc, nx); b.st[0] = nloc; b.st[1] = nx; }
        const unsigned old = xb_add(&bar[XB_XSUB(b.x)], 1u);
        const unsigned gen = old / nloc;
        if (old + 1u == (gen + 1u) * nloc) {
            __builtin_amdgcn_fence(__ATOMIC_RELEASE, "agent");
            asm volatile("s_waitcnt vmcnt(0)" ::: "memory");
            const unsigned og = xb_add(&bar[XB_TOP], 1u);
            const unsigned tg = og / nx;
            if (og + 1u == (tg + 1u) * nx) xb_add(&bar[XB_TOPGEN], 1u);
            else XB_SPIN(xb_ld(&bar[XB_TOPGEN]) == tg, bar);
            __builtin_amdgcn_fence(__ATOMIC_ACQUIRE, "agent");
            xb_add(&bar[XB_XGEN(b.x)], 1u);
            asm volatile("s_waitcnt vmcnt(0)" ::: "memory");
        } else {
            XB_SPIN(xb_ld(&bar[XB_XGEN(b.x)]) == gen, bar);
            __builtin_amdgcn_fence(__ATOMIC_ACQUIRE, "agent");
            asm volatile("s_waitcnt vmcnt(0)" ::: "memory");
        }
    }
    __syncthreads();
}

struct Args {
    const float* in[21];
    float* out; unsigned char* ws;
    int ph_lo, ph_hi, flags, pad;
};
enum { I_X = 0, I_META, I_RELB, I_NMIX, I_WIN, I_BGATE, I_WAO, I_CONVW, I_CONVB, I_LNG, I_LNB, I_WCO, I_WOUT, I_NFFN, I_WR, I_BR, I_WUG, I_BUG, I_WD, I_BD, I_NFIN };

struct Frame {
    LAS unsigned char* lds;
    unsigned char* ws;
    int tid, lane, wave;
    int G, bid;
};
template <class T> __device__ __forceinline__ T* wsp(unsigned char* ws, size_t off) { return (T*)(ws + off); }

struct P0Desc { const float* src; bf16_t* dst; int ldn, ldk; };
__device__ __forceinline__ void p0_load(const P0Desc& d, f32x4 (&v)[16], int lane) {
    const float* p = d.src + (size_t)(lane >> 4) * d.ldn + (lane & 15) * 4;
#pragma unroll
    for (int i = 0; i < 16; ++i) v[i] = *(const f32x4*)(p + (size_t)(4 * i) * d.ldn);
}
__device__ __forceinline__ void p0_store(const P0Desc& d, const f32x4 (&v)[16], LAS float* scr, int lane) {
    const int n4 = (lane & 15) * 4, kr = lane >> 4;
#pragma unroll
    for (int i = 0; i < 16; ++i) { LAS float* p = scr + (4 * i + kr) * 65 + n4; p[0] = v[i][0]; p[1] = v[i][1]; p[2] = v[i][2]; p[3] = v[i][3]; }
    LDS_WAIT(); asm volatile("" ::: "memory");
    const int c = lane & 7;
#pragma unroll
    for (int j = 0; j < 8; ++j) { const int n = (lane >> 3) + 8 * j; const LAS float* s = scr + (8 * c) * 65 + n;
        u32x4 o; o.x = cvt_pk_bf16(s[0 * 65], s[1 * 65]); o.y = cvt_pk_bf16(s[2 * 65], s[3 * 65]); o.z = cvt_pk_bf16(s[4 * 65], s[5 * 65]); o.w = cvt_pk_bf16(s[6 * 65], s[7 * 65]);
        *(u32x4*)(d.dst + (size_t)n * d.ldk + 8 * c) = o; }
    LDS_WAIT(); asm volatile("" ::: "memory");
}
__device__ __forceinline__ void rms_row_to_bf16(const float* __restrict__ xrow, const float* __restrict__ g, bf16_t* __restrict__ orow, int lane) {
    const f32x4* xr = (const f32x4*)xrow + lane; const f32x4* gr = (const f32x4*)g + lane;
    f32x4 v[4]; float s = 0.f;
#pragma unroll
    for (int j = 0; j < 4; ++j) { v[j] = xr[64 * j]; s += (v[j].x * v[j].x + v[j].y * v[j].y) + (v[j].z * v[j].z + v[j].w * v[j].w); }
    const float r = 1.0f / sqrtf(wave_sum(s) * (1.f / DM) + EPS);
    unsigned long long* o8 = (unsigned long long*)orow + lane;
#pragma unroll
    for (int j = 0; j < 4; ++j) { const f32x4 gg = gr[64 * j];
        o8[64 * j] = (unsigned long long)cvt_pk_bf16(v[j].x * r * gg.x, v[j].y * r * gg.y) | ((unsigned long long)cvt_pk_bf16(v[j].z * r * gg.z, v[j].w * r * gg.w) << 32); }
}
__device__ __forceinline__ void p0_prologue(Frame& F, const Args& a) {
    LAS float* scr = (LAS float*)(F.lds + F.wave * 16896);
    const int gw = F.bid * NWAVES + F.wave, NGW = F.G * NWAVES;
    unsigned char* ws = F.ws;
    constexpr int T_IN = 81 * 16, T_AO = 16 * 8, T_CO = 16 * 8, T_OUT = 16 * 16, T_SMALL = T_IN + T_AO + T_CO + T_OUT;
    constexpr int T_UG = NE * 32 * 16, T_D = NE * 16 * 16, T_ALL = T_SMALL + T_UG + T_D;
    auto desc = [&](int it) -> P0Desc {
        int r = it; P0Desc d;
        if (r < T_IN) { const int g = r / 16, kb = r % 16; const int dr = g * 64; int sc;
            if (dr < WR_GLU) sc = dr;
            else if (dr < WR_GATE) { const int q = dr - WR_GLU, tile = q >> 8, hf = (q >> 7) & 1, w = q & 127; sc = SC_GLU + 512 * hf + 128 * tile + w; }
            else if (dr < WR_IK) sc = SC_GATE + (dr - WR_GATE);
            else sc = SC_IK + (dr - WR_IK);
            d.src = a.in[I_WIN] + (size_t)(kb * 64) * INCOLS + sc; d.ldn = INCOLS; d.dst = wsp<bf16_t>(ws, WS_WIN) + (size_t)dr * DM + kb * 64; d.ldk = DM; return d; }
        r -= T_IN;
        if (r < T_AO) { const int g = r / 8, kb = r % 8; d.src = a.in[I_WAO] + (size_t)(kb * 64) * DM + g * 64; d.ldn = DM; d.dst = wsp<bf16_t>(ws, WS_WAO) + (size_t)(g * 64) * AW + kb * 64; d.ldk = AW; return d; }
        r -= T_AO;
        if (r < T_CO) { const int g = r / 8, kb = r % 8; d.src = a.in[I_WCO] + (size_t)(kb * 64) * DM + g * 64; d.ldn = DM; d.dst = wsp<bf16_t>(ws, WS_WCO) + (size_t)(g * 64) * CC + kb * 64; d.ldk = CC; return d; }
        r -= T_CO;
        if (r < T_OUT) { const int g = r / 16, kb = r % 16; d.src = a.in[I_WOUT] + (size_t)(kb * 64) * DM + g * 64; d.ldn = DM; d.dst = wsp<bf16_t>(ws, WS_WOUT) + (size_t)(g * 64) * DM + kb * 64; d.ldk = DM; return d; }
        r -= T_OUT;
        if (r < T_UG) { const int e = r / 512, q = r % 512, g = q % 32, kb = q / 32; const int dr = g * 64, tile = dr >> 8, hf = (dr >> 7) & 1, w = dr & 127;
            d.src = a.in[I_WUG] + (size_t)e * DM * 2 * DFF + (size_t)(kb * 64) * (2 * DFF) + DFF * hf + 128 * tile + w; d.ldn = 2 * DFF;
            d.dst = wsp<bf16_t>(ws, WS_WUG) + (size_t)e * 2 * DFF * DM + (size_t)dr * DM + kb * 64; d.ldk = DM; return d; }
        r -= T_UG;
        { const int e = r / 256, q = r % 256, g = q % 16, kb = q / 16;
            d.src = a.in[I_WD] + (size_t)e * DFF * DM + (size_t)(kb * 64) * DM + g * 64; d.ldn = DM; d.dst = wsp<bf16_t>(ws, WS_WD) + (size_t)e * DM * DFF + (size_t)(g * 64) * DFF + kb * 64; d.ldk = DFF; return d; }
    };
    if (gw < T_ALL) {
        f32x4 va[16], vb[16];
        P0Desc da = desc(gw), db = da;
        p0_load(da, va, F.lane);
        for (int it = gw; it < T_ALL; it += 2 * NGW) {
            const int i1 = it + NGW, i2 = it + 2 * NGW;
            db = desc(i1 < T_ALL ? i1 : it); p0_load(db, vb, F.lane);
            p0_store(da, va, scr, F.lane);
            da = desc(i2 < T_ALL ? i2 : it); p0_load(da, va, F.lane);
            if (i1 < T_ALL) p0_store(db, vb, scr, F.lane);
        }
    }
    { const int gt = F.bid * NTHREADS + F.tid;
      if (gt < 8 * DM / 2) { const int n = gt >> 9, k = (gt & 511) * 2; const float v0 = a.in[I_WIN][(size_t)k * INCOLS + SC_IW + n], v1 = a.in[I_WIN][(size_t)(k + 1) * INCOLS + SC_IW + n];
          *(unsigned*)(wsp<bf16_t>(ws, WS_WIN) + (size_t)(WR_IW + n) * DM + k) = cvt_pk_bf16(v0, v1); } }
    for (int m = gw; m < NTOK + NMETA; m += NGW) {
        if (m < NTOK) rms_row_to_bf16(a.in[I_X] + (size_t)m * DM, a.in[I_NMIX], wsp<bf16_t>(ws, WS_XN) + (size_t)m * DM, F.lane);
        else rms_row_to_bf16(a.in[I_META] + (size_t)(m - NTOK) * DM, a.in[I_NMIX], wsp<bf16_t>(ws, WS_XNM) + (size_t)(m - NTOK) * DM, F.lane);
    }
}

struct PlainSched {
    const char* ws; unsigned a_off, b_off; int K, nM, nN, nwg, G, c;
    __device__ __forceinline__ void init(const unsigned char* ws_, size_t a, size_t b, int M, int N, int K_, int G_, int c_) { ws = (const char*)ws_; a_off = (unsigned)a; b_off = (unsigned)b; K = K_; nM = M / 256; nN = N / 256; nwg = nM * nN; G = G_; c = c_; }
    __device__ __forceinline__ bool next(int i, pg8::Unit& u) const {
        const long L = (long)i * G + c; if (L >= nwg) return false;
        int wgid = (int)L; { const int q = nwg / 8, r = nwg % 8, xcd = wgid % 8, off = wgid / 8; wgid = (xcd < r ? xcd * (q + 1) : r * (q + 1) + (xcd - r) * q) + off; }
        const int nig = 8 * nN, gid = wgid / nig, fm = gid * 8, gsz = (nM - fm) < 8 ? (nM - fm) : 8;
        u.pm = fm + ((wgid % nig) % gsz); u.pn = (wgid % nig) / gsz; u.z = 0; return true;
    }
    __device__ __forceinline__ const char* a_base() const { return ws; }
    __device__ __forceinline__ void a_offs(const pg8::Unit& u, int tid, unsigned (&o)[2][2]) const {
        int R[2], C[2]; pg8::stage_rc(tid * 16, R[0], C[0]); pg8::stage_rc(tid * 16 + 8192, R[1], C[1]);
#pragma unroll
        for (int h = 0; h < 2; ++h)
#pragma unroll
            for (int i = 0; i < 2; ++i) o[h][i] = a_off + (unsigned)(((u.pm * 256 + h * 128 + R[i]) * K + C[i]) * 2);
    }
    __device__ __forceinline__ const char* b_base(const pg8::Unit& u) const { return ws + b_off + (size_t)u.pn * 256 * K * 2; }
};
struct MergeSched {
    const char* ws; int G, c;
    __device__ __forceinline__ bool next(int i, pg8::Unit& u) const {
        const int t = c + (i >> 1) * G;
        if (t >= 256) return false;
        u.pm = (t & 7) + 8 * (t >> 5); u.pn = (t >> 3) & 3; u.z = i & 1; return true;
    }
    __device__ __forceinline__ const char* a_base() const { return ws; }
    __device__ __forceinline__ void a_offs(const pg8::Unit& u, int tid, unsigned (&o)[2][2]) const {
        int R[2], C[2]; pg8::stage_rc(tid * 16, R[0], C[0]); pg8::stage_rc(tid * 16 + 8192, R[1], C[1]);
        const unsigned base = (unsigned)(u.z ? WS_CO : WS_AO);
#pragma unroll
        for (int h = 0; h < 2; ++h)
#pragma unroll
            for (int i = 0; i < 2; ++i) o[h][i] = base + (unsigned)(((u.pm * 256 + h * 128 + R[i]) * 512 + C[i]) * 2);
    }
    __device__ __forceinline__ const char* b_base(const pg8::Unit& u) const { return ws + (u.z ? WS_WCO : WS_WAO) + (size_t)u.pn * 256 * 512 * 2; }
};
struct MoeTables { const LAS int* cnt; const LAS int* tbase; };
template <int NC, bool GATHER>
struct MoeSched {
    const char* ws; MoeTables T; int G, c, total;
    __device__ __forceinline__ bool next(int i, pg8::Unit& u) const {
        const long L = (long)i * G + c; if (L >= total) return false;
        int wgid = (int)L; { const int q = total / 8, r = total % 8, xcd = wgid % 8, off = wgid / 8; wgid = (xcd < r ? xcd * (q + 1) : r * (q + 1) + (xcd - r) * q) + off; }
        int e = 0;
        for (int j = 1; j < NE; ++j) e += (wgid >= __builtin_amdgcn_readfirstlane(T.tbase[j]) * NC) ? 1 : 0;
        e = __builtin_amdgcn_readfirstlane(e);
        const int tb0 = __builtin_amdgcn_readfirstlane(T.tbase[e]), tb1 = __builtin_amdgcn_readfirstlane(T.tbase[e + 1]);
        const int loc = wgid - tb0 * NC, nt_e = tb1 - tb0;
        u.z = e; u.pm = loc % nt_e; u.pn = loc / nt_e; return true;
    }
    __device__ __forceinline__ const char* a_base() const { return ws; }
    __device__ __forceinline__ void a_offs(const pg8::Unit& u, int tid, unsigned (&o)[2][2]) const {
        int R[2], C[2]; pg8::stage_rc(tid * 16, R[0], C[0]); pg8::stage_rc(tid * 16 + 8192, R[1], C[1]);
        if (GATHER) {
            const int* list = (const int*)(ws + WS_LIST) + (size_t)u.z * NTOK; const int n = __builtin_amdgcn_readfirstlane(T.cnt[u.z]);
#pragma unroll
            for (int h = 0; h < 2; ++h)
#pragma unroll
                for (int i = 0; i < 2; ++i) { const int p = u.pm * 256 + h * 128 + R[i]; const int tok = (p < n) ? list[p] : 0; o[h][i] = (unsigned)WS_XN + (unsigned)((tok * DM + C[i]) * 2); }
        } else {
            const int row0 = (__builtin_amdgcn_readfirstlane(T.tbase[u.z]) + u.pm) * 256;
#pragma unroll
            for (int h = 0; h < 2; ++h)
#pragma unroll
                for (int i = 0; i < 2; ++i) o[h][i] = (unsigned)WS_ACT + (unsigned)(((row0 + h * 128 + R[i]) * DFF + C[i]) * 2);
        }
    }
    __device__ __forceinline__ const char* b_base(const pg8::Unit& u) const {
        if (GATHER) return ws + WS_WUG + ((size_t)u.z * 2 * DFF + (size_t)u.pn * 256) * DM * 2;
        else return ws + WS_WD + ((size_t)u.z * DM + (size_t)u.pn * 256) * DFF * 2;
    }
};

#define EPI_ROWS(ai, m) for (int ai = 0; ai < 2; ++ai) _Pragma("unroll") for (int m = 0; m < 4; ++m)
#define EPI_COLS(bj, n) for (int bj = 0; bj < 2; ++bj) _Pragma("unroll") for (int n = 0; n < 2; ++n)
__device__ __forceinline__ void st_bf16x4(bf16_t* p, f32x4 v) { u32x2 w; w.x = cvt_pk_bf16(v[0], v[1]); w.y = cvt_pk_bf16(v[2], v[3]); *(u32x2*)p = w; }

struct EpiInProj {
    unsigned char* ws; const float* bgate;
    __device__ __forceinline__ void operator()(const f32x4 (&acc)[2][2][4][2], const pg8::Unit& u, int wr, int wc, int fr, int fq) const {
        const int pn = u.pn, row0 = u.pm * 256 + wr * 64 + fr, col0 = wc * 32 + 4 * fq;
        const int bidx = u.pm >> 3;
        const int rowk0 = row0 + NMETA * (bidx + 1);
        if (pn < 2 || (pn >= 6 && pn < 8)) {
            bf16_t* O = wsp<bf16_t>(ws, pn < 2 ? WS_Q : WS_IQ); const int cb = (pn & 1) * 256; const float sc = pn < 2 ? QSCALE : 1.0f;
#pragma unroll
            EPI_ROWS(ai, m) { bf16_t* rp = O + (size_t)(row0 + ai * 128 + m * 16) * AW + cb + col0;
#pragma unroll
                EPI_COLS(bj, n) st_bf16x4(rp + bj * 128 + n * 16, acc[ai][bj][m][n] * sc); }
        } else if (pn < 4) {
            bf16_t* O = wsp<bf16_t>(ws, WS_KB); const int cb = (pn & 1) * 256;
#pragma unroll
            EPI_ROWS(ai, m) { bf16_t* rp = O + (size_t)(rowk0 + ai * 128 + m * 16) * AW + cb + col0;
#pragma unroll
                EPI_COLS(bj, n) st_bf16x4(rp + bj * 128 + n * 16, acc[ai][bj][m][n]); }
        } else if (pn < 6) {
            bf16_t* O = wsp<bf16_t>(ws, WS_VT) + (size_t)bidx * AW * TP; const int cb = (pn & 1) * 256;
            const int t0 = (row0 & (SEQ - 1)) + NMETA + VOFF;
#pragma unroll
            EPI_ROWS(ai, m) { const int t = t0 + ai * 128 + m * 16;
#pragma unroll
                EPI_COLS(bj, n) { const f32x4 v = acc[ai][bj][m][n]; bf16_t* cp = O + (size_t)(cb + col0 + bj * 128 + n * 16) * TP + (t & ~1);
                    const float p0 = __shfl_xor(v[0], 1), p1 = __shfl_xor(v[1], 1), p2 = __shfl_xor(v[2], 1), p3 = __shfl_xor(v[3], 1);
                    if ((fr & 1) == 0) { *(unsigned*)(cp) = cvt_pk_bf16(v[0], p0); *(unsigned*)(cp + TP) = cvt_pk_bf16(v[1], p1); }
                    else { *(unsigned*)(cp + 2 * TP) = cvt_pk_bf16(p2, v[2]); *(unsigned*)(cp + 3 * TP) = cvt_pk_bf16(p3, v[3]); } } }
        } else if (pn < 12) {
            bf16_t* O = wsp<bf16_t>(ws, WS_GLU); const int cb = (pn - 8) * 128;
#pragma unroll
            EPI_ROWS(ai, m) { bf16_t* rp = O + (size_t)(rowk0 + ai * 128 + m * 16) * CC + cb + col0;
#pragma unroll
                for (int n = 0; n < 2; ++n) { const f32x4 av = acc[ai][0][m][n], gv = acc[ai][1][m][n]; f32x4 y;
#pragma unroll
                    for (int j = 0; j < 4; ++j) y[j] = av[j] * sigmoidf_(gv[j]);
                    st_bf16x4(rp + n * 16, y); } }
        } else {
            const int gt = pn - 12; bf16_t* O = wsp<bf16_t>(ws, gt < 4 ? WS_GA : WS_GB); const int cb = (gt & 3) * 256; const float* bp = bgate + gt * 256 + col0;
            f32x4 bv[2][2];
#pragma unroll
            EPI_COLS(bj, n) bv[bj][n] = *(const f32x4*)(bp + bj * 128 + n * 16);
#pragma unroll
            EPI_ROWS(ai, m) { bf16_t* rp = O + (size_t)(row0 + ai * 128 + m * 16) * DM + cb + col0;
#pragma unroll
                EPI_COLS(bj, n) { const f32x4 x = acc[ai][bj][m][n] + bv[bj][n]; f32x4 y;
#pragma unroll
                    for (int j = 0; j < 4; ++j) y[j] = sigmoidf_(x[j]);
                    st_bf16x4(rp + bj * 128 + n * 16, y); } }
        }
    }
};
struct EpiMerge {
    unsigned char* ws;
    __device__ __forceinline__ void operator()(const f32x4 (&acc)[2][2][4][2], const pg8::Unit& u, int wr, int wc, int fr, int fq) const {
        const int row0 = u.pm * 256 + wr * 64 + fr, col0 = u.pn * 256 + wc * 32 + 4 * fq;
        const bf16_t* Gt = wsp<bf16_t>(ws, u.z ? WS_GB : WS_GA); bf16_t* O = wsp<bf16_t>(ws, WS_MG);
#pragma unroll
        EPI_ROWS(ai, m) { const size_t ro = (size_t)(row0 + ai * 128 + m * 16) * DM + col0;
#pragma unroll
            EPI_COLS(bj, n) { const size_t o = ro + bj * 128 + n * 16; const u32x2 g = *(const u32x2*)(Gt + o); const f32x4 a = acc[ai][bj][m][n];
                f32x4 y = (f32x4){bflo(g.x) * a[0], bfhi(g.x) * a[1], bflo(g.y) * a[2], bfhi(g.y) * a[3]};
                if (u.z) { const u32x2 p = *(const u32x2*)(O + o); y[0] += bflo(p.x); y[1] += bfhi(p.x); y[2] += bflo(p.y); y[3] += bfhi(p.y); }
                st_bf16x4(O + o, y); } }
    }
};
struct EpiResid {
    const float* x; float* out;
    __device__ __forceinline__ void operator()(const f32x4 (&acc)[2][2][4][2], const pg8::Unit& u, int wr, int wc, int fr, int fq) const {
        const int row0 = u.pm * 256 + wr * 64 + fr, col0 = u.pn * 256 + wc * 32 + 4 * fq;
#pragma unroll
        EPI_ROWS(ai, m) { const size_t ro = (size_t)(row0 + ai * 128 + m * 16) * DM + col0;
#pragma unroll
            EPI_COLS(bj, n) { const size_t o = ro + bj * 128 + n * 16; *(f32x4*)(out + o) = *(const f32x4*)(x + o) + acc[ai][bj][m][n]; } }
    }
};
struct EpiSwiglu {
    unsigned char* ws; const float* bug; MoeTables T;
    __device__ __forceinline__ void operator()(const f32x4 (&acc)[2][2][4][2], const pg8::Unit& u, int wr, int wc, int fr, int fq) const {
        const int e = u.z, n_e = __builtin_amdgcn_readfirstlane(T.cnt[e]), rloc0 = u.pm * 256 + wr * 64 + fr, row0 = __builtin_amdgcn_readfirstlane(T.tbase[e]) * 256 + rloc0, col0 = u.pn * 128 + wc * 32 + 4 * fq;
        const float* bp = bug + (size_t)e * 2 * DFF + col0; bf16_t* O = wsp<bf16_t>(ws, WS_ACT);
        f32x4 bg[2], bu[2];
#pragma unroll
        for (int n = 0; n < 2; ++n) { bg[n] = *(const f32x4*)(bp + n * 16); bu[n] = *(const f32x4*)(bp + DFF + n * 16); }
#pragma unroll
        EPI_ROWS(ai, m) { const int rl = rloc0 + ai * 128 + m * 16; if (rl < n_e) { bf16_t* rp = O + (size_t)(row0 + ai * 128 + m * 16) * DFF + col0;
#pragma unroll
                for (int n = 0; n < 2; ++n) { const f32x4 gv = acc[ai][0][m][n] + bg[n], uv = acc[ai][1][m][n] + bu[n]; f32x4 y;
#pragma unroll
                    for (int j = 0; j < 4; ++j) { const float g = fminf(gv[j], 7.0f), up = fminf(fmaxf(uv[j], -7.0f), 7.0f); y[j] = (up + 1.0f) * g * sigmoidf_(1.702f * g); }
                    st_bf16x4(rp + n * 16, y); } } }
    }
};
struct EpiDown {
    unsigned char* ws; const float* bd; MoeTables T;
    __device__ __forceinline__ void operator()(const f32x4 (&acc)[2][2][4][2], const pg8::Unit& u, int wr, int wc, int fr, int fq) const {
        const int e = u.z, n_e = __builtin_amdgcn_readfirstlane(T.cnt[e]), rloc0 = u.pm * 256 + wr * 64 + fr, row0 = __builtin_amdgcn_readfirstlane(T.tbase[e]) * 256 + rloc0, col0 = u.pn * 256 + wc * 32 + 4 * fq;
        const float* bp = bd + (size_t)e * DM + col0; bf16_t* O = wsp<bf16_t>(ws, WS_YP); const float* lg = wsp<float>(ws, WS_LG) + (size_t)e * NTOK;
        f32x4 bv[2][2];
#pragma unroll
        EPI_COLS(bj, n) bv[bj][n] = *(const f32x4*)(bp + bj * 128 + n * 16);
#pragma unroll
        EPI_ROWS(ai, m) { const int rl = rloc0 + ai * 128 + m * 16; if (rl < n_e) { const float gt = lg[rl]; bf16_t* rp = O + (size_t)(row0 + ai * 128 + m * 16) * DM + col0;
#pragma unroll
                EPI_COLS(bj, n) st_bf16x4(rp + bj * 128 + n * 16, (acc[ai][bj][m][n] + bv[bj][n]) * gt); } }
    }
};

template <int NT>
__device__ __forceinline__ void wave_mm16(const bf16_t* __restrict__ A, int lda, const bf16_t* const (&Bt)[NT], int K, int lane, f32x4 (&acc)[NT]) {
    const bf16_t* ap = A + (size_t)(lane & 15) * lda + 8 * (lane >> 4);
    const bf16_t* bp[NT];
#pragma unroll
    for (int t = 0; t < NT; ++t) { bp[t] = Bt[t] + (size_t)(lane & 15) * K + 8 * (lane >> 4); acc[t] = (f32x4){0.f, 0.f, 0.f, 0.f}; }
#pragma unroll 4
    for (int k0 = 0; k0 < K; k0 += 32) {
        const bf16x8 a = *(const bf16x8*)(ap + k0);
#pragma unroll
        for (int t = 0; t < NT; ++t) { const bf16x8 b = *(const bf16x8*)(bp[t] + k0); acc[t] = __builtin_amdgcn_mfma_f32_16x16x32_bf16(b, a, acc[t], 0, 0, 0); }
    }
}
__device__ __forceinline__ void p1_thin(Frame& F) {
    unsigned char* ws = F.ws;
    const bf16_t* WIN = wsp<bf16_t>(ws, WS_WIN); const bf16_t* XN = wsp<bf16_t>(ws, WS_XN); const bf16_t* XNM = wsp<bf16_t>(ws, WS_XNM);
    bf16_t* KB = wsp<bf16_t>(ws, WS_KB); bf16_t* VT = wsp<bf16_t>(ws, WS_VT); bf16_t* IK = wsp<bf16_t>(ws, WS_IK); bf16_t* GLU = wsp<bf16_t>(ws, WS_GLU); float* IW = wsp<float>(ws, WS_IW);
    const int gw = F.bid * NWAVES + F.wave, NGW = F.G * NWAVES, lane = F.lane, tk = lane & 15, nq = lane >> 4;
    for (int task = gw; task < 2048; task += NGW) {
        const int tg = task >> 1, hf = task & 1, m = tg * 16 + tk, rowk = m + NMETA * ((m >> 11) + 1);
        const bf16_t* A = XN + (size_t)tg * 16 * DM;
        if (hf == 0) {
            const bf16_t* const Bt[3] = {WIN + (size_t)(WR_IK) * DM, WIN + (size_t)(WR_IK + 16) * DM, WIN + (size_t)(WR_IK + 32) * DM}; f32x4 acc[3];
            wave_mm16<3>(A, DM, Bt, DM, lane, acc);
#pragma unroll
            for (int t = 0; t < 3; ++t) st_bf16x4(IK + (size_t)rowk * IDXD + 16 * t + 4 * nq, acc[t]);
        } else {
            const bf16_t* const Bt[2] = {WIN + (size_t)(WR_IK + 48) * DM, WIN + (size_t)(WR_IW) * DM}; f32x4 acc[2];
            wave_mm16<2>(A, DM, Bt, DM, lane, acc);
            st_bf16x4(IK + (size_t)rowk * IDXD + 48 + 4 * nq, acc[0]);
            if (nq < 2) *(f32x4*)(IW + (size_t)m * 8 + 4 * nq) = acc[1];
        }
    }
    for (int task = gw; task < 100; task += NGW) {
        if (task < 32) {
            const bf16_t* const Bt[1] = {WIN + (size_t)(SC_K + 16 * task) * DM}; f32x4 acc[1]; wave_mm16<1>(XNM, DM, Bt, DM, lane, acc);
            for (int b = 0; b < NB; ++b) st_bf16x4(KB + (size_t)(b * TT + tk) * AW + 16 * task + 4 * nq, acc[0]);
        } else if (task < 64) {
            const int t = task - 32; const bf16_t* const Bt[1] = {WIN + (size_t)(SC_V + 16 * t) * DM}; f32x4 acc[1]; wave_mm16<1>(XNM, DM, Bt, DM, lane, acc);
            const float p0 = __shfl_xor(acc[0][0], 1), p1 = __shfl_xor(acc[0][1], 1), p2 = __shfl_xor(acc[0][2], 1), p3 = __shfl_xor(acc[0][3], 1);
            const unsigned wa = (tk & 1) ? cvt_pk_bf16(p2, acc[0][2]) : cvt_pk_bf16(acc[0][0], p0), wb = (tk & 1) ? cvt_pk_bf16(p3, acc[0][3]) : cvt_pk_bf16(acc[0][1], p1);
            for (int b = 0; b < NB; ++b) { bf16_t* cp = VT + ((size_t)b * AW + 16 * t + 4 * nq + 2 * (tk & 1)) * TP + VOFF + (tk & ~1);
                *(unsigned*)cp = wa; *(unsigned*)(cp + TP) = wb; }
        } else if (task < 68) {
            const int t = task - 64; const bf16_t* const Bt[1] = {WIN + (size_t)(WR_IK + 16 * t) * DM}; f32x4 acc[1]; wave_mm16<1>(XNM, DM, Bt, DM, lane, acc);
            for (int b = 0; b < NB; ++b) st_bf16x4(IK + (size_t)(b * TT + tk) * IDXD + 16 * t + 4 * nq, acc[0]);
        } else {
            const int c16 = task - 68; const int ar = WR_GLU + 256 * (c16 >> 3) + 16 * (c16 & 7);
            const bf16_t* const Bt[2] = {WIN + (size_t)ar * DM, WIN + (size_t)(ar + 128) * DM}; f32x4 acc[2]; wave_mm16<2>(XNM, DM, Bt, DM, lane, acc);
            f32x4 y;
#pragma unroll
            for (int j = 0; j < 4; ++j) y[j] = acc[0][j] * sigmoidf_(acc[1][j]);
            for (int b = 0; b < NB; ++b) st_bf16x4(GLU + (size_t)(b * TT + tk) * CC + 16 * c16 + 4 * nq, y);
        }
    }
}

__device__ __forceinline__ void p2_conv(Frame& F, const Args& a) {
    unsigned char* ws = F.ws;
    LAS unsigned char* xs = F.lds;
    LAS float* wl = (LAS float*)(F.lds + 63488);
    const bf16_t* GLU = wsp<bf16_t>(ws, WS_GLU); bf16_t* CO = wsp<bf16_t>(ws, WS_CO);
    const float* cw = a.in[I_CONVW];
    for (int idx = F.tid; idx < CW * 128; idx += NTHREADS) { const int tap = idx >> 7, c4 = idx & 127; const f32x4 v = *(const f32x4*)(cw + tap * CC + 4 * c4); *(LAS f32x4*)(wl + tap * 512 + (c4 & 1) * 256 + (c4 >> 1) * 4) = v; }
    const int lane = F.lane, c0 = 8 * lane;
    for (int tile = F.bid; tile < NTOK / 32; tile += F.G) {
        const int b = tile >> 6, s0 = (tile & 63) * 32, p0 = NMETA + s0;
        __syncthreads();
        for (int idx = F.tid; idx < 62 * 64; idx += NTHREADS) { const int r = idx >> 6, ch = idx & 63, p = p0 - 30 + r; u32x4 v = (u32x4){0u, 0u, 0u, 0u};
            if (p >= 0) v = *(const u32x4*)(GLU + (size_t)(b * TT + p) * CC + ch * 8);
            *(LAS u32x4*)(xs + r * 1024 + ch * 16) = v; }
        __syncthreads();
        const int i0 = 4 * F.wave;
        float acc[4][8];
#pragma unroll
        for (int t = 0; t < 4; ++t)
#pragma unroll
            for (int i = 0; i < 8; ++i) acc[t][i] = 0.f;
        const LAS float* wlb = wl + lane * 4; asm volatile("" : "+v"(wlb));
        const LAS unsigned char* xsb = xs + i0 * 1024 + lane * 16; asm volatile("" : "+v"(xsb));
#pragma unroll 1
        for (int tap = 0; tap < CW; ++tap) {
            const f32x4 w0 = *(const LAS f32x4*)(wlb + tap * 512), w1 = *(const LAS f32x4*)(wlb + tap * 512 + 256);
#pragma unroll
            for (int t = 0; t < 4; ++t) {
                const u32x4 xv = *(const LAS u32x4*)(xsb + (tap + t) * 1024);
                acc[t][0] += w0[0] * bflo(xv.x); acc[t][1] += w0[1] * bfhi(xv.x); acc[t][2] += w0[2] * bflo(xv.y); acc[t][3] += w0[3] * bfhi(xv.y);
                acc[t][4] += w1[0] * bflo(xv.z); acc[t][5] += w1[1] * bfhi(xv.z); acc[t][6] += w1[2] * bflo(xv.w); acc[t][7] += w1[3] * bfhi(xv.w);
            }
        }
        float cb[8], lg[8], lb[8];
        { const f32x4* p0 = (const f32x4*)(a.in[I_CONVB] + c0); const f32x4* p1 = (const f32x4*)(a.in[I_LNG] + c0); const f32x4* p2 = (const f32x4*)(a.in[I_LNB] + c0);
#pragma unroll
          for (int hh = 0; hh < 2; ++hh) { const f32x4 u0 = p0[hh], u1 = p1[hh], u2 = p2[hh];
#pragma unroll
              for (int i = 0; i < 4; ++i) { cb[4 * hh + i] = u0[i]; lg[4 * hh + i] = u1[i]; lb[4 * hh + i] = u2[i]; } } }
#pragma unroll
        for (int t = 0; t < 4; ++t) {
            float s = 0.f;
#pragma unroll
            for (int i = 0; i < 8; ++i) { acc[t][i] += cb[i]; s += acc[t][i]; }
            const float mean = wave_sum(s) * (1.f / CC); float q = 0.f;
#pragma unroll
            for (int i = 0; i < 8; ++i) { acc[t][i] -= mean; q += acc[t][i] * acc[t][i]; }
            const float rstd = 1.0f / sqrtf(wave_sum(q) * (1.f / CC) + EPS);
            float y[8];
#pragma unroll
            for (int i = 0; i < 8; ++i) { const float z = acc[t][i] * rstd * lg[i] + lb[i]; y[i] = z * sigmoidf_(z); }
            u32x4 o; o.x = cvt_pk_bf16(y[0], y[1]); o.y = cvt_pk_bf16(y[2], y[3]); o.z = cvt_pk_bf16(y[4], y[5]); o.w = cvt_pk_bf16(y[6], y[7]);
            *(u32x4*)(CO + (size_t)(b * SEQ + s0 + i0 + t) * CC + c0) = o;
        }
    }
    __syncthreads();
}

constexpr int ROWP = 2080, NJ = 33;
__device__ __forceinline__ unsigned f2ord(float f) { const unsigned b = __float_as_uint(f); return b ^ ((b >> 31) ? 0xffffffffu : 0x80000000u); }
__device__ __forceinline__ int wave_isum(int v) {
#pragma unroll
    for (int o = 1; o < 64; o <<= 1) v += __shfl_xor(v, o);
    return v;
}
__device__ __forceinline__ int wave_isum_dpp(int v) {
    v += __builtin_amdgcn_update_dpp(0, v, 0xB1, 0xF, 0xF, false);
    v += __builtin_amdgcn_update_dpp(0, v, 0x4E, 0xF, 0xF, false);
    v += __builtin_amdgcn_update_dpp(0, v, 0x141, 0xF, 0xF, false);
    v += __builtin_amdgcn_update_dpp(0, v, 0x140, 0xF, 0xF, false);
    return __builtin_amdgcn_readlane(v, 0) + __builtin_amdgcn_readlane(v, 16) + __builtin_amdgcn_readlane(v, 32) + __builtin_amdgcn_readlane(v, 48);
}
__device__ __forceinline__ void p2_indexer_unit(Frame& F, int b, int q16, int flags) {
    unsigned char* ws = F.ws;
    const bf16_t* IQ = wsp<bf16_t>(ws, WS_IQ); const bf16_t* IK = wsp<bf16_t>(ws, WS_IK); const float* IW = wsp<float>(ws, WS_IW); unsigned* MASK = wsp<unsigned>(ws, WS_MASK);
    LAS unsigned* SU = (LAS unsigned*)F.lds;
    const int lane = F.lane, c = lane & 31, hi = lane >> 5, w = F.wave;
    const int nwblk = (q16 >> 1) + 2;
    if (!(flags & 4)) {
        const int tok0 = b * SEQ + 16 * q16;
        bf16x8 af[4][4]; f32x4 wq[4][4];
#pragma unroll
        for (int g = 0; g < 4; ++g) {
            const bf16_t* ap = IQ + (size_t)(tok0 + 4 * g + (c >> 3)) * AW + (c & 7) * IDXD + 8 * hi;
#pragma unroll
            for (int ks = 0; ks < 4; ++ks) af[g][ks] = *(const bf16x8*)(ap + 16 * ks);
#pragma unroll
            for (int q = 0; q < 4; ++q) wq[g][q] = *(const f32x4*)(IW + (size_t)(tok0 + 4 * g + q) * 8 + 4 * hi);
        }
        const int rel0 = NMETA + 16 * q16 + 2 * hi - c;
        const bf16_t* kp = IK + (size_t)(b * TT + c) * IDXD + 8 * hi;
        LAS unsigned* srow = SU + (2 * hi) * ROWP + c;
        bf16x8 bfr[4], bnx[4];
#pragma unroll
        for (int ks = 0; ks < 4; ++ks) { bfr[ks] = *(const bf16x8*)(kp + (size_t)(w < nwblk ? w : 0) * 32 * IDXD + 16 * ks); bnx[ks] = bfr[ks]; }
#pragma unroll
        for (int g = 0; g < 4; ++g) asm volatile("" :: "v"(af[g][0]), "v"(af[g][1]), "v"(af[g][2]), "v"(af[g][3]), "v"(wq[g][0]), "v"(wq[g][1]), "v"(wq[g][2]), "v"(wq[g][3]));
        asm volatile("" :: "v"(bfr[0]), "v"(bfr[1]), "v"(bfr[2]), "v"(bfr[3]));
        for (int blk = w; blk < nwblk; blk += 8) {
            {
                const int bn_ = blk + 8 < nwblk ? blk + 8 : blk;
#pragma unroll
                for (int ks = 0; ks < 4; ++ks) bnx[ks] = *(const bf16x8*)(kp + (size_t)bn_ * 32 * IDXD + 16 * ks); }
#pragma unroll
            for (int g = 0; g < 4; ++g) {
                f32x16 acc = {};
#pragma unroll
                for (int ks = 0; ks < 4; ++ks) acc = __builtin_amdgcn_mfma_f32_32x32x16_bf16(af[g][ks], bfr[ks], acc, 0, 0, 0);
                float part[4];
#pragma unroll
                for (int q = 0; q < 4; ++q) { float s = wq[g][q][0] * __builtin_amdgcn_fmed3f(acc[4 * q], 0.f, INFINITY);
#pragma unroll
                    for (int i = 1; i < 4; ++i) s = __builtin_fmaf(wq[g][q][i], __builtin_amdgcn_fmed3f(acc[4 * q + i], 0.f, INFINITY), s);
                    part[q] = s; }
#pragma unroll
                for (int p = 0; p < 2; ++p) {
                    const auto rr = __builtin_amdgcn_permlane32_swap(__float_as_uint(part[p]), __float_as_uint(part[p + 2]), false, false);
                    const float sc = __uint_as_float(rr[0]) + __uint_as_float(rr[1]);
                    srow[(4 * g + p) * ROWP + 32 * blk] = (32 * blk <= rel0 + 4 * g + p) ? f2ord(sc) : 0u; }
            }
#pragma unroll
            for (int ks = 0; ks < 4; ++ks) bfr[ks] = bnx[ks];
        }
    }
    __syncthreads();
    if (!(flags & 8)) {
        const int nj = (nwblk + 1) >> 1, klim = 32 * nwblk;
        unsigned U[NJ][2];
#pragma unroll
        for (int j = 0; j < NJ; ++j) {
            if (j < nj) { const int key = 64 * j + lane;
#pragma unroll
                for (int p = 0; p < 2; ++p) U[j][p] = (key < klim) ? SU[(2 * w + p) * ROWP + key] : 0u; }
            else { U[j][0] = 0u; U[j][1] = 0u; }
        }
        const int tokb = b * SEQ + 16 * q16 + 2 * w;
        unsigned lo[2], hb[2], thr[2], veq[2]; int chi[2], need[2]; bool done[2];
#pragma unroll
        for (int p = 0; p < 2; ++p) { lo[p] = 1u; hb[p] = 0xffffffffu; chi[p] = 0; need[p] = 0; veq[p] = 0u; thr[p] = 1u; done[p] = (NMETA + 16 * q16 + 2 * w + p + 1 <= TOPK); }
        for (int it = 0; it < 34; ++it) {
            if (done[0] && done[1]) break;
            unsigned mid[2]; int cl[2];
#pragma unroll
            for (int p = 0; p < 2; ++p) { mid[p] = lo[p] + ((hb[p] - lo[p]) >> 1); cl[p] = 0; }
#pragma unroll
            for (int g = 0; g < 3; ++g) if (11 * g < nj) {
#pragma unroll
                for (int jj = 0; jj < 11; ++jj)
#pragma unroll
                    for (int p = 0; p < 2; ++p) cl[p] += (U[11 * g + jj][p] >= mid[p]) ? 1 : 0; }
            const int tot = wave_isum_dpp(cl[0] | (cl[1] << 16));
            int cnt[2] = {tot & 0xffff, tot >> 16};
#ifdef DBG_CHECK_DPP
            if (wave_isum(cl[0]) != cnt[0] || wave_isum(cl[1]) != cnt[1]) __hip_atomic_store(wsp<unsigned>(ws, WS_CTL) + 3, 1u, RLX_AGENT);
#endif
#pragma unroll
            for (int p = 0; p < 2; ++p) {
                const int ct = cnt[p];
                if (!done[p]) {
                    if (ct == TOPK) { done[p] = true; thr[p] = mid[p]; need[p] = 0; }
                    else if (ct > TOPK) lo[p] = mid[p];
                    else { hb[p] = mid[p]; chi[p] = ct; }
                    if (!done[p] && hb[p] - lo[p] == 1u) { done[p] = true; thr[p] = hb[p]; veq[p] = lo[p]; need[p] = TOPK - chi[p]; }
                }
            }
        }
#pragma unroll
        for (int p = 0; p < 2; ++p) {
            int run = 0;
            unsigned long long* mrow = (unsigned long long*)(MASK + (size_t)(tokb + p) * MSTR);
#pragma unroll
            for (int j = 0; j < NJ; ++j) if (j < nj) {
                const unsigned u = U[j][p];
                const bool eq = (need[p] > 0) && (u == veq[p]);
                const unsigned long long em = __ballot(eq);
                const int rank = run + (int)__builtin_amdgcn_mbcnt_hi((unsigned)(em >> 32), __builtin_amdgcn_mbcnt_lo((unsigned)em, 0u));
                const bool take = (u >= thr[p]) || (eq && rank < need[p]);
                run += __popcll(em);
                const unsigned long long sm = __ballot(take);
                if (lane == 0) mrow[j] = sm;
            }
        }
    }
    __syncthreads();
}
__device__ __forceinline__ void p2_indexer(Frame& F, int flags) {
    for (int i = F.bid; i < 256; i += F.G) { const int b = i >> 5, j = 2 * (i & 31);
        p2_indexer_unit(F, b, j, flags); p2_indexer_unit(F, b, 127 - j, flags); p2_indexer_unit(F, b, j + 1, flags); p2_indexer_unit(F, b, 126 - j, flags); }
}

__device__ const unsigned char T5B[128] = {0, 1, 2, 3, 4, 5, 6, 7, 8, 9, 10, 11, 12, 13, 14, 15, 16, 16, 16, 17, 17, 18, 18, 18, 19, 19, 19, 20, 20, 20, 20, 21, 21, 21, 21, 22, 22, 22, 22, 22, 23, 23, 23, 23, 23, 23, 24, 24, 24, 24, 24, 24, 25, 25, 25, 25, 25, 25, 25, 26, 26, 26, 26, 26, 26, 26, 26, 27, 27, 27, 27, 27, 27, 27, 27, 27, 27, 28, 28, 28, 28, 28, 28, 28, 28, 28, 28, 29, 29, 29, 29, 29, 29, 29, 29, 29, 29, 29, 29, 30, 30, 30, 30, 30, 30, 30, 30, 30, 30, 30, 30, 30, 30, 31, 31, 31, 31, 31, 31, 31, 31, 31, 31, 31, 31, 31, 31, 31};
constexpr int TBS = 132;
__device__ __forceinline__ int crow(int r, int hi) { return (r & 3) + 8 * (r >> 2) + 4 * hi; }
constexpr int KPITCH = 144, VPITCH = 136;
constexpr int AT_K = 0, AT_V = AT_K + 2 * 64 * KPITCH, AT_TB = AT_V + 2 * 64 * VPITCH, AT_SC = AT_TB + NH * TBS * 4, AT_END = AT_SC + NWAVES * 128;
static_assert(AT_END <= RING_BYTES, "attention LDS map");
__device__ __forceinline__ void p3_attn_unit(Frame& F, int b, int h, int Q) {
    unsigned char* ws = F.ws;
    const bf16_t* Qm = wsp<bf16_t>(ws, WS_Q); const bf16_t* KB = wsp<bf16_t>(ws, WS_KB); const bf16_t* VT = wsp<bf16_t>(ws, WS_VT); const unsigned* MASK = wsp<unsigned>(ws, WS_MASK); bf16_t* AO = wsp<bf16_t>(ws, WS_AO);
    LAS unsigned char* lds = F.lds;
    const LAS float* tbh = (const LAS float*)(lds + AT_TB) + h * TBS;
    LAS float* sc = (LAS float*)(lds + AT_SC) + F.wave * 32;
    const int tid = F.tid, lane = F.lane, c = lane & 31, hi = lane >> 5, w = F.wave;
    const int qb32 = 8 * Q + w, tokq = b * SEQ + 32 * qb32 + c, posq = NMETA + 32 * qb32 + c;
    const int ktmax = (47 + 32 * qb32) >> 6, NT = 4 * Q + 5;
    bf16x8 qf[4];
#pragma unroll
    for (int ks = 0; ks < 4; ++ks) qf[ks] = *(const bf16x8*)(Qm + (size_t)tokq * AW + h * HD + 16 * ks + 8 * hi);
    const unsigned long long* mrow = (const unsigned long long*)(MASK + (size_t)tokq * MSTR);
    const int srow = tid >> 3, piece = tid & 7;
    const bf16_t* kg = KB + (size_t)(b * TT + srow) * AW + h * HD + piece * 8;
    const bf16_t* vg = VT + ((size_t)b * AW + h * HD + srow) * TP + piece * 8;
    LAS unsigned char* kl = lds + AT_K + srow * KPITCH + piece * 16;
    LAS unsigned char* vl = lds + AT_V + srow * VPITCH + piece * 16;
    const LAS unsigned char* kfb = lds + AT_K + c * KPITCH + 16 * hi;
    const LAS unsigned char* vfb = lds + AT_V + c * VPITCH + 8 * hi;
    const float NEG = -INFINITY;
    float m_run = NEG, l = 0.f; f32x16 O0 = {}, O1 = {};
    u32x4 kr = *(const u32x4*)kg, vr = *(const u32x4*)vg;
    unsigned long long mwn = mrow[0];
    *(LAS u32x4*)kl = kr; *(LAS u32x2*)vl = (u32x2){vr.x, vr.y}; *(LAS u32x2*)(vl + 8) = (u32x2){vr.z, vr.w};
    __syncthreads();
    for (int kt = 0; kt < NT; ++kt) {
        const int buf = kt & 1;
        const unsigned long long mw = mwn;
        if (kt + 1 < NT) { kr = *(const u32x4*)(kg + (size_t)(kt + 1) * 64 * AW); vr = *(const u32x4*)(vg + (kt + 1) * 64); if (kt + 1 <= ktmax) mwn = mrow[kt + 1]; }
        if (kt <= ktmax) {
            const LAS unsigned char* kp = kfb + buf * 64 * KPITCH;
            f32x16 S0 = {}, S1 = {};
#pragma unroll
            for (int ks = 0; ks < 4; ++ks) {
                const bf16x8 k0 = *(const LAS bf16x8*)(kp + ks * 32), k1 = *(const LAS bf16x8*)(kp + 32 * KPITCH + ks * 32);
                S0 = __builtin_amdgcn_mfma_f32_32x32x16_bf16(k0, qf[ks], S0, 0, 0, 0);
                S1 = __builtin_amdgcn_mfma_f32_32x32x16_bf16(k1, qf[ks], S1, 0, 0, 0);
            }
            const unsigned mw0 = (unsigned)mw >> (4 * hi), mw1 = (unsigned)(mw >> 32) >> (4 * hi);
            const int d0 = posq - 64 * kt - 4 * hi;
            const bool far = (256 * Q + 32 * w - 64 * kt) >= 175;
            float tmax = NEG;
            if (far) {
                const float bfar = tbh[128];
#pragma unroll
                for (int r = 0; r < 16; ++r) { const int ko = (r & 3) + 8 * (r >> 2);
                    S0[r] = ((mw0 >> ko) & 1u) ? S0[r] + bfar : NEG; S1[r] = ((mw1 >> ko) & 1u) ? S1[r] + bfar : NEG; tmax = fmaxf(tmax, fmaxf(S0[r], S1[r])); }
            } else {
#pragma unroll
                for (int r = 0; r < 16; ++r) { const int ko = (r & 3) + 8 * (r >> 2);
                    int da = d0 - ko, db = d0 - 32 - ko; da = da < 0 ? 0 : (da > 128 ? 128 : da); db = db < 0 ? 0 : (db > 128 ? 128 : db);
                    S0[r] = ((mw0 >> ko) & 1u) ? S0[r] + tbh[da] : NEG; S1[r] = ((mw1 >> ko) & 1u) ? S1[r] + tbh[db] : NEG; tmax = fmaxf(tmax, fmaxf(S0[r], S1[r])); }
            }
            tmax = fmaxf(tmax, __shfl_xor(tmax, 32));
            if (__any(tmax > m_run + 8.0f)) {
                const float m_new = fmaxf(m_run, tmax);
                const float alpha = (m_new == NEG) ? 1.0f : __builtin_amdgcn_exp2f(m_run - m_new);
                l *= alpha; m_run = m_new;
                if (hi == 0) sc[c] = alpha;
                LDS_WAIT(); asm volatile("" ::: "memory");
#pragma unroll
                for (int r = 0; r < 16; ++r) { const float f = sc[crow(r, hi)]; O0[r] *= f; O1[r] *= f; }
                LDS_WAIT(); asm volatile("" ::: "memory");
            }
            const float m_use = (m_run == NEG) ? 0.f : m_run;
            float ps = 0.f;
#pragma unroll
            for (int r = 0; r < 16; ++r) { S0[r] = __builtin_amdgcn_exp2f(S0[r] - m_use); S1[r] = __builtin_amdgcn_exp2f(S1[r] - m_use); ps += S0[r] + S1[r]; }
            l += ps;
            const LAS unsigned char* vp = vfb + buf * 64 * VPITCH;
#pragma unroll
            for (int s2 = 0; s2 < 4; ++s2) {
                u32x4 pw;
                if (s2 < 2) { const int o = 8 * (s2 & 1); pw.x = cvt_pk_bf16(S0[o + 0], S0[o + 1]); pw.y = cvt_pk_bf16(S0[o + 2], S0[o + 3]); pw.z = cvt_pk_bf16(S0[o + 4], S0[o + 5]); pw.w = cvt_pk_bf16(S0[o + 6], S0[o + 7]); }
                else { const int o = 8 * (s2 & 1); pw.x = cvt_pk_bf16(S1[o + 0], S1[o + 1]); pw.y = cvt_pk_bf16(S1[o + 2], S1[o + 3]); pw.z = cvt_pk_bf16(S1[o + 4], S1[o + 5]); pw.w = cvt_pk_bf16(S1[o + 6], S1[o + 7]); }
                const bf16x8 pf = __builtin_bit_cast(bf16x8, pw);
                const u32x2 a0 = *(const LAS u32x2*)(vp + s2 * 32), a1 = *(const LAS u32x2*)(vp + s2 * 32 + 16);
                const u32x2 b0 = *(const LAS u32x2*)(vp + 32 * VPITCH + s2 * 32), b1 = *(const LAS u32x2*)(vp + 32 * VPITCH + s2 * 32 + 16);
                const bf16x8 v0 = __builtin_bit_cast(bf16x8, ((u32x4){a0.x, a0.y, a1.x, a1.y})), v1 = __builtin_bit_cast(bf16x8, ((u32x4){b0.x, b0.y, b1.x, b1.y}));
                O0 = __builtin_amdgcn_mfma_f32_32x32x16_bf16(pf, v0, O0, 0, 0, 0);
                O1 = __builtin_amdgcn_mfma_f32_32x32x16_bf16(pf, v1, O1, 0, 0, 0);
            }
        }
        if (kt + 1 < NT) { LAS unsigned char* k2 = kl + (buf ^ 1) * 64 * KPITCH; LAS unsigned char* v2 = vl + (buf ^ 1) * 64 * VPITCH;
            *(LAS u32x4*)k2 = kr; *(LAS u32x2*)v2 = (u32x2){vr.x, vr.y}; *(LAS u32x2*)(v2 + 8) = (u32x2){vr.z, vr.w}; }
        __syncthreads();
    }
    const float lt = l + __shfl_xor(l, 32);
    if (hi == 0) sc[c] = 1.0f / lt;
    LDS_WAIT(); asm volatile("" ::: "memory");
    bf16_t* ob = AO + (size_t)(b * SEQ + 32 * qb32) * AW + h * HD + c;
#pragma unroll
    for (int r = 0; r < 16; ++r) { const int qr = crow(r, hi); const float f = sc[qr];
        const float a0 = O0[r] * f, a1 = O1[r] * f, b0 = __shfl_xor(a0, 1), b1 = __shfl_xor(a1, 1);
        if ((c & 1) == 0) { *(unsigned*)(ob + (size_t)qr * AW) = cvt_pk_bf16(a0, b0); *(unsigned*)(ob + (size_t)qr * AW + 32) = cvt_pk_bf16(a1, b1); } }
    LDS_WAIT(); asm volatile("" ::: "memory");
}
__device__ __forceinline__ void p3_attn(Frame& F, const Args& a) {
    LAS float* tb = (LAS float*)(F.lds + AT_TB);
    __syncthreads();
    for (int idx = F.tid; idx < NH * 129; idx += NTHREADS) { const int h = idx / 129, d = idx % 129; const int bk = d < 128 ? (int)T5B[d] : 31; tb[h * TBS + d] = a.in[I_RELB][bk * NH + h] * LOG2E; }
    __syncthreads();
    for (int i = F.bid; i < 256; i += F.G) { const int bh = i >> 2, j = i & 3; p3_attn_unit(F, bh >> 3, bh & 7, j); p3_attn_unit(F, bh >> 3, bh & 7, 7 - j); }
    __syncthreads();
}

__device__ __forceinline__ void p6_router(Frame& F, const Args& a) {
    unsigned char* ws = F.ws;
    const float* H1 = wsp<float>(ws, WS_H1); bf16_t* HN = wsp<bf16_t>(ws, WS_XN);
    const float* gf = a.in[I_NFFN]; const float* wrt = a.in[I_WR]; const float* brt = a.in[I_BR];
    int* TE = wsp<int>(ws, WS_TE); int* TPs = wsp<int>(ws, WS_TP); int* LIST = wsp<int>(ws, WS_LIST); float* LG = wsp<float>(ws, WS_LG);
    unsigned* ecnt = wsp<unsigned>(ws, WS_CTL) + CW_ECNT;
    LAS float* rinv = (LAS float*)F.lds;
    LAS float* part = (LAS float*)(F.lds + 1024);
    LAS int* lcnt = (LAS int*)(F.lds + 1024 + 8 * 64 * 33 * 4);
    LAS int* lbase = lcnt + 32;
    const int lane = F.lane, w = F.wave;
    for (int tb = F.bid; tb < NTOK / 64; tb += F.G) {
        const int t0 = tb * 64;
        __syncthreads();
        if (F.tid < 32) lcnt[F.tid] = 0;
        for (int i = 0; i < 8; ++i) {
            const int t = t0 + 8 * w + i; const f32x4* xr = (const f32x4*)(H1 + (size_t)t * DM) + lane; const f32x4* gr = (const f32x4*)gf + lane;
            f32x4 v[4]; float s = 0.f;
#pragma unroll
            for (int j = 0; j < 4; ++j) { v[j] = xr[64 * j]; s += (v[j].x * v[j].x + v[j].y * v[j].y) + (v[j].z * v[j].z + v[j].w * v[j].w); }
            const float r = 1.0f / sqrtf(wave_sum(s) * (1.f / DM) + EPS);
            if (lane == 0) rinv[8 * w + i] = r;
            unsigned long long* o8 = (unsigned long long*)(HN + (size_t)t * DM) + lane;
#pragma unroll
            for (int j = 0; j < 4; ++j) { const f32x4 gg = gr[64 * j];
                o8[64 * j] = (unsigned long long)cvt_pk_bf16(v[j].x * r * gg.x, v[j].y * r * gg.y) | ((unsigned long long)cvt_pk_bf16(v[j].z * r * gg.z, v[j].w * r * gg.w) << 32); }
        }
        __syncthreads();
        {
            const float r = rinv[lane]; const float* xr = H1 + (size_t)(t0 + lane) * DM + 128 * w;
            float acc[NE];
#pragma unroll
            for (int e = 0; e < NE; ++e) acc[e] = 0.f;
            for (int k4 = 0; k4 < 32; ++k4) {
                const f32x4 xv = *(const f32x4*)(xr + 4 * k4);
#pragma unroll
                for (int kk = 0; kk < 4; ++kk) { const int k = 128 * w + 4 * k4 + kk; const float hn = xv[kk] * r * gf[k]; const float* wrow = wrt + (size_t)k * NE;
#pragma unroll
                    for (int e = 0; e < NE; ++e) acc[e] += hn * wrow[e]; }
            }
#pragma unroll
            for (int e = 0; e < NE; ++e) part[(w * 64 + lane) * 33 + e] = acc[e];
        }
        __syncthreads();
        if (w == 0) {
            float lg[NE];
#pragma unroll
            for (int e = 0; e < NE; ++e) { float s = brt[e];
#pragma unroll
                for (int ww = 0; ww < 8; ++ww) s += part[(ww * 64 + lane) * 33 + e];
                lg[e] = s; }
            int sel[4]; float val[4];
#pragma unroll
            for (int j = 0; j < 4; ++j) { float best = -INFINITY; int bi = 0;
#pragma unroll
                for (int e = 0; e < NE; ++e) { const bool tk = lg[e] > best; best = tk ? lg[e] : best; bi = tk ? e : bi; }
                sel[j] = bi; val[j] = best;
#pragma unroll
                for (int e = 0; e < NE; ++e) lg[e] = (e == bi) ? -INFINITY : lg[e]; }
            float den = 0.f, ex[4];
#pragma unroll
            for (int j = 0; j < 4; ++j) { ex[j] = __expf(val[j] - val[0]); den += ex[j]; }
            int slot[4];
#pragma unroll
            for (int j = 0; j < 4; ++j) slot[j] = __hip_atomic_fetch_add(&lcnt[sel[j]], 1, __ATOMIC_RELAXED, __HIP_MEMORY_SCOPE_WORKGROUP);
            LDS_WAIT();
            if (lane < 32) { const int n = lcnt[lane]; lbase[lane] = n ? (int)__hip_atomic_fetch_add(ecnt + 64 * lane, (unsigned)n, RLX_AGENT) : 0; }
            LDS_WAIT(); asm volatile("" ::: "memory");
            const int t = t0 + lane;
#pragma unroll
            for (int j = 0; j < 4; ++j) { const int e = sel[j], pos = lbase[e] + slot[j]; const float g = ex[j] / den;
                TE[t * 4 + j] = e; TPs[t * 4 + j] = pos; LIST[(size_t)e * NTOK + pos] = t; LG[(size_t)e * NTOK + pos] = g; }
        }
    }
    __syncthreads();
}
__device__ __forceinline__ void moe_tables(Frame& F, LAS int* cnt, LAS int* tbase) {
    const unsigned* ecnt = wsp<unsigned>(F.ws, WS_CTL) + CW_ECNT;
    __syncthreads();
    if (F.tid < NE) cnt[F.tid] = (int)__hip_atomic_load(ecnt + 64 * F.tid, RLX_AGENT);
    __syncthreads();
    if (F.tid == 0) { int s = 0; for (int e = 0; e < NE; ++e) { tbase[e] = s; s += (cnt[e] + 255) >> 8; } tbase[NE] = s; }
    __syncthreads();
}

__device__ __forceinline__ void p9_final(Frame& F, const Args& a, const LAS int* tbase) {
    unsigned char* ws = F.ws;
    const float* H1 = wsp<float>(ws, WS_H1); float* OUT = a.out; const bf16_t* YP = wsp<bf16_t>(ws, WS_YP); const int* TE = wsp<int>(ws, WS_TE); const int* TPs = wsp<int>(ws, WS_TP); const float* gf = a.in[I_NFIN];
    const int gw = F.bid * NWAVES + F.wave, NGW = F.G * NWAVES, lane = F.lane;
    const f32x4* gr = (const f32x4*)gf + lane;
    f32x4 gg[4];
#pragma unroll
    for (int j = 0; j < 4; ++j) gg[j] = gr[64 * j];
#ifdef DBG_CHECK_DPP
    if (__hip_atomic_load(wsp<unsigned>(ws, WS_CTL) + 3, RLX_AGENT) != 0u) { const float qn = __builtin_nanf("");
#pragma unroll
        for (int j = 0; j < 4; ++j) gg[j] = (f32x4){qn, qn, qn, qn}; }
#endif
    for (int base = 0; base < NTOK; base += 8 * NGW) {
        int myrow = 0;
        { const int i = lane >> 2, j = lane & 3, t = base + gw + NGW * i; if (lane < 32 && t < NTOK) { const int e = TE[t * 4 + j], pos = TPs[t * 4 + j]; myrow = tbase[e] * 256 + pos; } }
        f32x4 va[4], vb[4]; u32x2 ya[4][4], yb[4][4];
#define P9_LOAD(i, V, Y) do { const int t_ = base + gw + NGW * (i); if (t_ < NTOK) { const f32x4* xr_ = (const f32x4*)(H1 + (size_t)t_ * DM) + lane; \
            _Pragma("unroll") for (int j_ = 0; j_ < 4; ++j_) V[j_] = xr_[64 * j_]; \
            _Pragma("unroll") for (int q_ = 0; q_ < 4; ++q_) { const int row_ = __builtin_amdgcn_readlane(myrow, 4 * (i) + q_); const u32x2* yr_ = (const u32x2*)(YP + (size_t)row_ * DM) + lane; \
                _Pragma("unroll") for (int j_ = 0; j_ < 4; ++j_) Y[q_][j_] = yr_[64 * j_]; } } } while (0)
#define P9_PROC(i, V, Y) do { const int t_ = base + gw + NGW * (i); if (t_ < NTOK) { \
            _Pragma("unroll") for (int q_ = 0; q_ < 4; ++q_) _Pragma("unroll") for (int j_ = 0; j_ < 4; ++j_) { const u32x2 y_ = Y[q_][j_]; V[j_].x += bflo(y_.x); V[j_].y += bfhi(y_.x); V[j_].z += bflo(y_.y); V[j_].w += bfhi(y_.y); } \
            float s_ = 0.f; _Pragma("unroll") for (int j_ = 0; j_ < 4; ++j_) s_ += (V[j_].x * V[j_].x + V[j_].y * V[j_].y) + (V[j_].z * V[j_].z + V[j_].w * V[j_].w); \
            const float r_ = 1.0f / sqrtf(wave_sum(s_) * (1.f / DM) + EPS); f32x4* xo_ = (f32x4*)(OUT + (size_t)t_ * DM) + lane; \
            _Pragma("unroll") for (int j_ = 0; j_ < 4; ++j_) xo_[64 * j_] = (f32x4){V[j_].x * r_ * gg[j_].x, V[j_].y * r_ * gg[j_].y, V[j_].z * r_ * gg[j_].z, V[j_].w * r_ * gg[j_].w}; } } while (0)
        P9_LOAD(0, va, ya);
#pragma unroll
        for (int i = 0; i < 8; i += 2) {
            P9_LOAD(i + 1, vb, yb);
            P9_PROC(i, va, ya);
            if (i + 2 < 8) P9_LOAD(i + 2, va, ya);
            P9_PROC(i + 1, vb, yb);
        }
#undef P9_LOAD
#undef P9_PROC
    }
}

constexpr int N_PHASES = 10;
__global__ void __launch_bounds__(NTHREADS, 2) fwd_kernel(Args args) {
    extern __shared__ __attribute__((aligned(16))) unsigned char lds_raw[];
    Frame F;
    F.lds = (LAS unsigned char*)lds_raw; F.ws = args.ws;
    F.tid = threadIdx.x; F.lane = F.tid & 63; F.wave = __builtin_amdgcn_readfirstlane(F.tid >> 6);
    F.G = gridDim.x; F.bid = blockIdx.x;
    volatile LAS unsigned* MISC = (volatile LAS unsigned*)(F.lds + MISC_OFF);
    if (F.tid < 32) MISC[F.tid] = 0u;
    __syncthreads();
    unsigned* ctl = wsp<unsigned>(args.ws, WS_CTL);
    const int lo = args.ph_lo, hi = args.ph_hi;
    const bool multi = (hi - lo) > 1;
    XcdBarrier bar; bar.bar = ctl + CW_BAR; bar.x = 0; bar.st = nullptr;
    if (multi) bar = xcd_barrier_post(ctl + CW_BAR, MISC + 8);
#ifndef PHASE_MASK
#define PHASE_MASK 0x3ff
#endif
#define IN(k) (((PHASE_MASK >> (k)) & 1) && lo <= (k) && (k) < hi)
#define SEAM(k) do { if (IN(k) && IN((k) + 1)) xcd_barrier(bar); } while (0)
    LAS int* l_cnt = (LAS int*)(F.lds + LDSX_OFF); LAS int* l_tbase = l_cnt + 64;
    const MoeTables MT{l_cnt, l_tbase};

    if (IN(0)) { p0_prologue(F, args); } SEAM(0);
    if (IN(1)) {
        PlainSched S; S.init(args.ws, WS_XN, WS_WIN, NTOK, 5120, DM, F.G, F.bid);
        EpiInProj E{args.ws, args.in[I_BGATE]};
        pg8::gemm_phase<EpiInProj, PlainSched>(F.lds, DM, S, E);
        p1_thin(F);
    } SEAM(1);
    if (IN(2)) {
        if (!(args.flags & 1)) p2_conv(F, args);
        if (!(args.flags & 2)) p2_indexer(F, args.flags);
    } SEAM(2);
    if (IN(3)) { p3_attn(F, args); } SEAM(3);
    if (IN(4)) {
        MergeSched S{(const char*)args.ws, F.G, F.bid}; EpiMerge E{args.ws};
        pg8::gemm_phase<EpiMerge, MergeSched>(F.lds, 512, S, E);
    } SEAM(4);
    if (IN(5)) {
        PlainSched S; S.init(args.ws, WS_MG, WS_WOUT, NTOK, DM, DM, F.G, F.bid);
        EpiResid E{args.in[I_X], wsp<float>(args.ws, WS_H1)};
        pg8::gemm_phase<EpiResid, PlainSched>(F.lds, DM, S, E);
    } SEAM(5);
    if (IN(6)) { p6_router(F, args); } SEAM(6);
    if (IN(7)) {
        moe_tables(F, l_cnt, l_tbase);
        MoeSched<8, true> S{(const char*)args.ws, MT, F.G, F.bid, l_tbase[NE] * 8};
        EpiSwiglu E{args.ws, args.in[I_BUG], MT};
        pg8::gemm_phase<EpiSwiglu, MoeSched<8, true>>(F.lds, DM, S, E);
    } SEAM(7);
    if (IN(8)) {
        moe_tables(F, l_cnt, l_tbase);
        MoeSched<4, false> S{(const char*)args.ws, MT, F.G, F.bid, l_tbase[NE] * 4};
        EpiDown E{args.ws, args.in[I_BD], MT};
        pg8::gemm_phase<EpiDown, MoeSched<4, false>>(F.lds, DFF, S, E);
    } SEAM(8);
    if (IN(9)) { moe_tables(F, l_cnt, l_tbase); p9_final(F, args, l_tbase); }
#undef IN
#undef SEAM
}

#ifdef DBG_HASH_OFF
__global__ void dbg_hash(const unsigned* __restrict__ buf, size_t nwords, unsigned* acc) {
    unsigned h = 0u;
    for (size_t i = (size_t)blockIdx.x * blockDim.x + threadIdx.x; i < nwords; i += (size_t)gridDim.x * blockDim.x) h += (buf[i] ^ (unsigned)(i * 2654435761u)) * 2246822519u + (unsigned)i;
#pragma unroll
    for (int o = 1; o < 64; o <<= 1) h += __shfl_xor(h, o);
    if ((threadIdx.x & 63) == 0) atomicAdd(acc, h);
}
__global__ void dbg_fill(float* out, size_t n, const unsigned* acc) {
    const unsigned h = *acc; const float v = (float)((h >> 7) & 0xffffu) * (1.0f / 4096.0f) + 1.0f;
    for (size_t i = (size_t)blockIdx.x * blockDim.x + threadIdx.x; i < n; i += (size_t)gridDim.x * blockDim.x) out[i] = v;
}
#endif

extern "C" void kernel_launch(void* const* d_in, const int* in_sizes, int n_in, void* d_out, int out_size, void* d_ws, size_t ws_size, hipStream_t stream) {
    static int grid = 0;
    if (grid == 0) {
        if (n_in != 21 || out_size != NTOK * DM || ws_size < WS_END) { fprintf(stderr, "kernel_launch: unexpected shapes (n_in %d, out %d, ws %zu < %zu)\n", n_in, out_size, ws_size, (size_t)WS_END); grid = -1; return; }
        int dev = 0, cus = 0, per_cu = 0;
        if (hipGetDevice(&dev) != hipSuccess || hipDeviceGetAttribute(&cus, hipDeviceAttributeMultiprocessorCount, dev) != hipSuccess) { grid = -1; return; }
        if (hipFuncSetAttribute((const void*)fwd_kernel, hipFuncAttributeMaxDynamicSharedMemorySize, LDS_BYTES) != hipSuccess) { fprintf(stderr, "kernel_launch: hipFuncSetAttribute failed\n"); grid = -1; return; }
        if (hipOccupancyMaxActiveBlocksPerMultiprocessor(&per_cu, (const void*)fwd_kernel, NTHREADS, LDS_BYTES) != hipSuccess || per_cu < 1) { fprintf(stderr, "kernel_launch: occupancy query says %d\n", per_cu); }
        (void)hipGetLastError();
        grid = cus;
    }
    if (grid < 0) return;
    (void)hipMemsetAsync((char*)d_ws + WS_CTL, 0, CTL_ZERO_BYTES, stream);
    Args a{};
    for (int i = 0; i < 21; ++i) a.in[i] = (const float*)d_in[i];
    a.out = (float*)d_out; a.ws = (unsigned char*)d_ws;
#if MK_N_LAUNCHES == 1
    a.ph_lo = 0; a.ph_hi = N_PHASES;
    hipLaunchKernelGGL(fwd_kernel, dim3(grid), dim3(NTHREADS), LDS_BYTES, stream, a);
#else
#ifndef DBG_LAST_PHASE
#define DBG_LAST_PHASE (N_PHASES - 1)
#endif
#ifndef DBG_DUP_MASK
#define DBG_DUP_MASK 0
#endif
#ifndef DBG_DUP_FLAGS
#define DBG_DUP_FLAGS 0
#endif
    for (int p = 0; p <= DBG_LAST_PHASE; ++p) { a.ph_lo = p; a.ph_hi = p + 1;
        const int nrep = ((DBG_DUP_MASK >> p) & 1) ? 2 : 1;
        for (int rep = 0; rep < nrep; ++rep) { a.flags = (nrep == 2 && rep == 0) ? DBG_DUP_FLAGS : 0; if (rep == 1 && p == 6) (void)hipMemsetAsync((char*)d_ws + WS_CTL, 0, CTL_ZERO_BYTES, stream);
            hipLaunchKernelGGL(fwd_kernel, dim3(grid), dim3(NTHREADS), LDS_BYTES, stream, a); } }
#ifdef DBG_HASH_OFF
    { const unsigned* hb = DBG_HASH_OFF == 0 ? (const unsigned*)d_out : (const unsigned*)((char*)d_ws + DBG_HASH_OFF);
      hipLaunchKernelGGL(dbg_hash, dim3(1024), dim3(256), 0, stream, hb, (size_t)(DBG_HASH_BYTES) / 4, (unsigned*)d_ws + 2);
      hipLaunchKernelGGL(dbg_fill, dim3(1024), dim3(256), 0, stream, (float*)d_out, (size_t)NTOK * DM, (const unsigned*)d_ws + 2); }
#endif
#endif
}
```

```cpp
#include <hip/hip_runtime.h>
#include <cstdio>
#include <cstdint>

#ifndef MK_N_LAUNCHES
#define MK_N_LAUNCHES 1
#endif

constexpr int NB = 8, SEQ = 2048, NMETA = 16, TT = SEQ + NMETA  , DM = 1024, NTOK = NB * SEQ  , NALL = NB * TT  ;
constexpr int AW = 512, NH = 8, HD = 64, IDXD = 64, CC = 512, CW = 31, NE = 32, DFF = 1024, TOPK = 256;
constexpr int INCOLS = 5192, TP = 2176  , VOFF = 0  , MSTR = 68  ;
constexpr float EPS = 1e-6f, LOG2E = 1.4426950408889634f;
constexpr float QSCALE = 0.125f * LOG2E;
constexpr int MAXTILES = 296;
constexpr int SC_Q = 0, SC_K = 512, SC_V = 1024, SC_IQ = 1536, SC_IK = 2048, SC_IW = 2112, SC_GLU = 2120, SC_GATE = 3144;
constexpr int WR_GLU = 2048, WR_GATE = 3072, WR_IK = 5120, WR_IW = 5184, WIN_ROWS = 5376;

constexpr size_t MiB = 1u << 20;
constexpr size_t al4k(size_t x) { return (x + 4095) & ~(size_t)4095; }
constexpr size_t WS_CTL = 0, CTL_ZERO_BYTES = 1 * MiB;
constexpr size_t WS_WIN = 1 * MiB;
constexpr size_t WS_WAO = WS_WIN + al4k((size_t)WIN_ROWS * DM * 2);
constexpr size_t WS_WCO = WS_WAO + al4k((size_t)DM * AW * 2);
constexpr size_t WS_WOUT = WS_WCO + al4k((size_t)DM * CC * 2);
constexpr size_t WS_WUG = WS_WOUT + al4k((size_t)DM * DM * 2);
constexpr size_t WS_WD = WS_WUG + al4k((size_t)NE * 2 * DFF * DM * 2);
constexpr size_t WS_XN = WS_WD + al4k((size_t)NE * DM * DFF * 2);
constexpr size_t WS_XNM = WS_XN + al4k((size_t)NTOK * DM * 2);
constexpr size_t WS_Q = WS_XNM + al4k((size_t)NMETA * DM * 2);
constexpr size_t WS_IQ = WS_Q + al4k((size_t)NTOK * AW * 2);
constexpr size_t WS_KB = WS_IQ + al4k((size_t)NTOK * AW * 2);
constexpr size_t WS_VT = WS_KB + al4k((size_t)(NALL + 64) * AW * 2);
constexpr size_t WS_IK = WS_VT + al4k((size_t)NB * AW * TP * 2);
constexpr size_t WS_IW = WS_IK + al4k((size_t)(NALL + 64) * IDXD * 2);
constexpr size_t WS_GLU = WS_IW + al4k((size_t)NTOK * 8 * 4);
constexpr size_t WS_GA = WS_GLU + al4k((size_t)NALL * CC * 2);
constexpr size_t WS_GB = WS_GA + al4k((size_t)NTOK * DM * 2);
constexpr size_t WS_MASK = WS_GB + al4k((size_t)NTOK * DM * 2);
constexpr size_t WS_AO = WS_MASK + al4k((size_t)NTOK * MSTR * 4);
constexpr size_t WS_CO = WS_AO + al4k((size_t)NTOK * AW * 2);
constexpr size_t WS_MG = WS_CO + al4k((size_t)NTOK * CC * 2);
constexpr size_t WS_TE = WS_MG + al4k((size_t)NTOK * DM * 2);
constexpr size_t WS_TP = WS_TE + al4k((size_t)NTOK * 4 * 4);
constexpr size_t WS_LIST = WS_TP + al4k((size_t)NTOK * 4 * 4);
constexpr size_t WS_LG = WS_LIST + al4k((size_t)NE * NTOK * 4);
constexpr size_t WS_ACT = WS_LG + al4k((size_t)NE * NTOK * 4);
constexpr size_t WS_YP = WS_ACT + al4k((size_t)MAXTILES * 256 * DFF * 2);
constexpr size_t WS_H1 = WS_YP + al4k((size_t)MAXTILES * 256 * DM * 2);
constexpr size_t WS_WRT = WS_H1 + al4k((size_t)NTOK * DM * 4);
constexpr size_t WS_RG = WS_WRT + al4k((size_t)2 * NE * DM * 2);
constexpr size_t WS_END = WS_RG + al4k((size_t)NE * NTOK * 4);
static_assert(WS_END < ((size_t)1 << 32), "32-bit byte offsets into d_ws");
constexpr int CW_TMO = 0, CW_CODE = 1, CW_BAR = 4096, CW_ECNT = 16384;

constexpr int RING_BYTES = 131072;
constexpr int LDSX_OFF = 153600;
constexpr int MISC_OFF = 161792;
constexpr int LDS_BYTES = 163840;
constexpr int NWAVES = 8, NTHREADS = 512;

#define GAS __attribute__((address_space(1)))
#define LAS __attribute__((address_space(3)))
typedef unsigned short bf16_t;
typedef short bf16x8 __attribute__((ext_vector_type(8)));
typedef short s16x4 __attribute__((ext_vector_type(4)));
typedef float f32x4 __attribute__((ext_vector_type(4)));
typedef float f32x16 __attribute__((ext_vector_type(16)));
typedef unsigned u32x4 __attribute__((ext_vector_type(4)));
typedef unsigned u32x2 __attribute__((ext_vector_type(2)));
typedef GAS unsigned gu32;
#define RLX_AGENT __ATOMIC_RELAXED, __HIP_MEMORY_SCOPE_AGENT
#define LDS_WAIT() asm volatile("s_waitcnt lgkmcnt(0)" ::: "memory")
#define VM_WAIT() asm volatile("s_waitcnt vmcnt(0)" ::: "memory")

typedef float f32x2_t __attribute__((ext_vector_type(2))); typedef __bf16 bf16x2_t __attribute__((ext_vector_type(2)));
__device__ __forceinline__ unsigned cvt_pk_bf16(float lo, float hi) { const f32x2_t v = {lo, hi}; const bf16x2_t b = __builtin_convertvector(v, bf16x2_t); return __builtin_bit_cast(unsigned, b); }
__device__ __forceinline__ float bf2f(unsigned short b) { return __uint_as_float((unsigned)b << 16); }
__device__ __forceinline__ float bflo(unsigned w) { return __uint_as_float(w << 16); }
__device__ __forceinline__ float bfhi(unsigned w) { return __uint_as_float(w & 0xffff0000u); }
__device__ __forceinline__ float sigmoidf_(float x) { return __builtin_amdgcn_rcpf(1.0f + __builtin_amdgcn_exp2f(-LOG2E * x)); }
__device__ __forceinline__ float wave_sum(float v) {
#pragma unroll
    for (int o = 1; o < 64; o <<= 1) v += __shfl_xor(v, o);
    return v;
}

namespace pg8 {
constexpr int BM = 256, BK = 64, HALF = 128, HTB = HALF * BK * 2, STAGE_BYTES = 8 * HTB;
__host__ __device__ __forceinline__ int lds_byte(int r, int c) { const int st = (r >> 4) * 2 + (c >> 5), rr = r & 15, cc = c & 31, ob = rr * 64 + cc * 2; return st * 1024 + (ob ^ (((ob >> 9) & 1) << 5)); }
__host__ __device__ __forceinline__ void stage_rc(int b, int& R, int& C) { const int st = b / 1024, sb = b % 1024, swz = sb ^ (((sb >> 9) & 1) << 5); R = (st >> 1) * 16 + swz / 64; C = (st & 1) * 32 + (swz % 64) / 2; }

struct Unit { int pm, pn, z; };

template <class Epi, class Sched>
__device__ __forceinline__ void gemm_phase(LAS unsigned char* lds, const int K, const Sched& S, const Epi& E) {
    const int tid = threadIdx.x, wid = __builtin_amdgcn_readfirstlane(tid >> 6), lane = tid & 63, wr = wid >> 2, wc = wid & 3, fr = lane & 15, fq = lane >> 4;
    const int nt = K / BK;
    unsigned voffB[2];
#pragma unroll
    for (int i = 0; i < 2; ++i) { int R_, C_; stage_rc(tid * 16 + i * 8192, R_, C_); voffB[i] = (unsigned)(R_ * K + C_) * 2u; }
    const size_t kstep = (size_t)(BK * 2);
    const size_t hstep = (size_t)HALF * K * 2;
    const unsigned ldsw = (unsigned)wid * 1024u;
    const int aoff = lds_byte(wr * 64 + fr, fq * 8), boff = lds_byte(wc * 32 + fr, fq * 8);
    const char* const abase = S.a_base();
#define PG8_SA(b, h) (((b) * 2 + (h)) * HTB)
#define PG8_SB(b, h) ((4 + (b) * 2 + (h)) * HTB)
#define PG8_STAGE(bufoff, gbase, voff) do { _Pragma("unroll") for (int _i = 0; _i < 2; ++_i) \
        __builtin_amdgcn_global_load_lds((const unsigned*)((const char*)(gbase) + (voff)[_i]), (LAS unsigned*)(lds + (bufoff) + ldsw + _i * 8192), 16, 0, 0); } while (0)
#define PG8_LDA(dst, b, h) do { _Pragma("unroll") for (int m = 0; m < 4; ++m) _Pragma("unroll") for (int k = 0; k < 2; ++k) dst[m][k] = *(const LAS bf16x8*)(lds + PG8_SA(b, h) + aoff + m * 2048 + k * 1024); } while (0)
#define PG8_LDB(dst, b, h) do { _Pragma("unroll") for (int n = 0; n < 2; ++n) _Pragma("unroll") for (int k = 0; k < 2; ++k) dst[n][k] = *(const LAS bf16x8*)(lds + PG8_SB(b, h) + boff + n * 2048 + k * 1024); } while (0)
#define PG8_MMA(ai, bj, At, Bt) do { __builtin_amdgcn_s_setprio(1); _Pragma("unroll") for (int m = 0; m < 4; ++m) _Pragma("unroll") for (int n = 0; n < 2; ++n) _Pragma("unroll") for (int k = 0; k < 2; ++k) \
        acc[ai][bj][m][n] = __builtin_amdgcn_mfma_f32_16x16x32_bf16(Bt[n][k], At[m][k], acc[ai][bj][m][n], 0, 0, 0); __builtin_amdgcn_s_setprio(0); } while (0)
#define PG8_WAIT_V(n) asm volatile("s_waitcnt vmcnt(" #n ")" ::: "memory")
#define PG8_WAIT_L(n) asm volatile("s_waitcnt lgkmcnt(" #n ")" ::: "memory")
#define PG8_BAR __builtin_amdgcn_s_barrier()
#define PG8_SCHED __builtin_amdgcn_sched_barrier(0)
    Unit cur, nxt; int ui = 0;
    if (!S.next(0, cur)) return;
    f32x4 acc[2][2][4][2];
#pragma unroll
    for (int a = 0; a < 2; ++a)
#pragma unroll
        for (int b = 0; b < 2; ++b)
#pragma unroll
            for (int m = 0; m < 4; ++m)
#pragma unroll
                for (int n = 0; n < 2; ++n) acc[a][b][m][n] = (f32x4){0.f, 0.f, 0.f, 0.f};
    bf16x8 At[4][2], B0[2][2], B1[2][2];
    unsigned ca[2][2], na[2][2];
    S.a_offs(cur, tid, ca);
    const char* cB = S.b_base(cur);
    PG8_STAGE(PG8_SB(0, 0), cB, voffB); PG8_STAGE(PG8_SB(0, 1), cB + hstep, voffB); PG8_STAGE(PG8_SA(0, 0), abase, ca[0]); PG8_STAGE(PG8_SA(0, 1), abase, ca[1]);
    if (wr == 1) PG8_BAR;
    PG8_WAIT_V(2); PG8_BAR;
    PG8_STAGE(PG8_SB(1, 0), cB + kstep, voffB); PG8_STAGE(PG8_SA(1, 0), abase + kstep, ca[0]); PG8_STAGE(PG8_SB(1, 1), cB + hstep + kstep, voffB);
    PG8_WAIT_V(6); PG8_BAR;
    for (;;) {
        const bool has_next = S.next(ui + 1, nxt);
        const char* nB = cB;
#pragma unroll
        for (int h = 0; h < 2; ++h)
#pragma unroll
            for (int i = 0; i < 2; ++i) na[h][i] = ca[h][i];
        if (has_next) { S.a_offs(nxt, tid, na); nB = S.b_base(nxt); }
        for (int t = 0; t < nt; t += 2) {
            const bool last = (t == nt - 2);
            const char* a1 = abase + (size_t)(t + 1) * kstep;
            const char* a2 = last ? abase : abase + (size_t)(t + 2) * kstep; const char* b2 = last ? nB : cB + (size_t)(t + 2) * kstep;
            const char* a3 = a2 + kstep; const char* b3 = b2 + kstep;
            PG8_LDB(B0, 0, 0); PG8_LDB(B1, 0, 1); PG8_SCHED; PG8_LDA(At, 0, 0); PG8_STAGE(PG8_SA(1, 1), a1, ca[1]);
            PG8_WAIT_V(8); PG8_WAIT_L(0); PG8_BAR; PG8_MMA(0, 0, At, B0); PG8_MMA(0, 1, At, B1); PG8_BAR; PG8_SCHED;
            if (last) {
#pragma unroll
                for (int h = 0; h < 2; ++h)
#pragma unroll
                    for (int i = 0; i < 2; ++i) ca[h][i] = na[h][i];
            }
            PG8_LDA(At, 0, 1); PG8_STAGE(PG8_SB(0, 0), b2, voffB); PG8_STAGE(PG8_SB(0, 1), b2 + hstep, voffB); PG8_STAGE(PG8_SA(0, 0), a2, ca[0]);
            PG8_WAIT_V(8); PG8_WAIT_L(0); PG8_BAR; PG8_MMA(1, 0, At, B0); PG8_MMA(1, 1, At, B1); PG8_BAR; PG8_SCHED;
            PG8_LDB(B0, 1, 0); PG8_LDB(B1, 1, 1); PG8_SCHED; PG8_LDA(At, 1, 0); PG8_STAGE(PG8_SA(0, 1), a2, ca[1]);
            PG8_WAIT_V(8); PG8_WAIT_L(0); PG8_BAR; PG8_MMA(0, 0, At, B0); PG8_MMA(0, 1, At, B1); PG8_BAR; PG8_SCHED;
            PG8_LDA(At, 1, 1); PG8_STAGE(PG8_SB(1, 0), b3, voffB); PG8_STAGE(PG8_SB(1, 1), b3 + hstep, voffB); PG8_STAGE(PG8_SA(1, 0), a3, ca[0]);
            PG8_WAIT_V(8); PG8_WAIT_L(0); PG8_BAR; PG8_MMA(1, 0, At, B0); PG8_MMA(1, 1, At, B1); PG8_BAR; PG8_SCHED;
        }
        if (wr == 0) PG8_BAR;
        { int tz = tid; asm volatile("" : "+v"(tz));
          const int l2 = tz & 63, w2 = __builtin_amdgcn_readfirstlane(tz >> 6); E(acc, cur, w2 >> 2, w2 & 3, l2 & 15, l2 >> 4); }
        if (!has_next) break;
#pragma unroll
        for (int a = 0; a < 2; ++a)
#pragma unroll
            for (int b = 0; b < 2; ++b)
#pragma unroll
                for (int m = 0; m < 4; ++m)
#pragma unroll
                    for (int n = 0; n < 2; ++n) acc[a][b][m][n] = (f32x4){0.f, 0.f, 0.f, 0.f};
        cur = nxt; cB = nB; ++ui;
        if (wr == 1) PG8_BAR;
    }
    PG8_WAIT_V(0);
    PG8_BAR;
#undef PG8_SA
#undef PG8_SB
#undef PG8_STAGE
#undef PG8_LDA
#undef PG8_LDB
#undef PG8_MMA
#undef PG8_WAIT_V
#undef PG8_WAIT_L
#undef PG8_BAR
#undef PG8_SCHED
}
}

#define XB_TMO      128
#define XB_XCNT(j)  (256  + 64 * (j))
#define XB_XSUB(j)  (1280 + 64 * (j))
#define XB_XGEN(j)  (2304 + 64 * (j))
#define XB_TOP      3328
#define XB_TOPGEN   3392
#define XCD_BAR_WORDS 3456
#define XB_SPIN_CAP (1u << 18)
__device__ __forceinline__ unsigned xb_ld(unsigned* p)              { return __hip_atomic_load(p, __ATOMIC_RELAXED, __HIP_MEMORY_SCOPE_AGENT); }
__device__ __forceinline__ unsigned xb_add(unsigned* p, unsigned v) { return __hip_atomic_fetch_add(p, v, __ATOMIC_RELAXED, __HIP_MEMORY_SCOPE_AGENT); }
__device__ __forceinline__ unsigned xb_xcc_id() { return (unsigned)__builtin_amdgcn_s_getreg((3 << 11) | 20) & 0xFu; }
#define XB_SPIN(cond, bar) do { unsigned _sp = 0; while (cond) { __builtin_amdgcn_s_sleep(1); \
    if ((++_sp & 255u) == 0u) { if (xb_ld(&(bar)[XB_TMO])) break; if (_sp > XB_SPIN_CAP) { atomicAdd(&(bar)[XB_TMO], 1u); break; } } } } while (0)
struct XcdBarrier { unsigned* bar; unsigned x; volatile LAS unsigned* st; };
__device__ __forceinline__ XcdBarrier xcd_barrier_post(unsigned* bar, volatile LAS unsigned* st) {
    XcdBarrier b; b.bar = bar; b.x = xb_xcc_id(); b.st = st;
    if (threadIdx.x == 0) (void)xb_add(&bar[XB_XCNT(b.x)], 1u);
    return b;
}
__device__ __forceinline__ void xcd_barrier_complete(unsigned* bar, unsigned x, unsigned& nloc, unsigned& nx) {
    const unsigned G = gridDim.x * gridDim.y * gridDim.z;
    unsigned sum, cnt, mine, sp = 0u;
    for (;;) {
        sum = 0u; cnt = 0u; mine = 0u;
#pragma unroll
        for (unsigned j = 0; j < 16; ++j) { const unsigned c = xb_ld(&bar[XB_XCNT(j)]); sum += c; cnt += (c > 0u) ? 1u : 0u; mine = (j == x) ? c : mine; }
        if (sum == G) break;
        __builtin_amdgcn_s_sleep(1);
        if ((++sp & 255u) == 0u) { if (xb_ld(&bar[XB_TMO])) break; if (sp > XB_SPIN_CAP) { atomicAdd(&bar[XB_TMO], 1u); break; } }
    }
    nloc = mine > 0u ? mine : 1u; nx = cnt > 0u ? cnt : 1u;
}
__device__ __forceinline__ void xcd_barrier(const XcdBarrier& b) {
    asm volatile("s_waitcnt vmcnt(0)" ::: "memory");
    __syncthreads();
    if (threadIdx.x == 0) {
        unsigned* bar = b.bar;
        __builtin_amdgcn_s_waitcnt(0);
        unsigned nloc = b.st[0], nx = b.st[1];
        if (nloc == 0u) { xcd_barrier_complete(bar, b.x, nloc, nx); b.st[0] = nloc; b.st[1] = nx; }
        const unsigned old = xb_add(&bar[XB_XSUB(b.x)], 1u);
        const unsigned gen = old / nloc;
        if (old + 1u == (gen + 1u) * nloc) {
            __builtin_amdgcn_fence(__ATOMIC_RELEASE, "agent");
            asm volatile("s_waitcnt vmcnt(0)" ::: "memory");
            const unsigned og = xb_add(&bar[XB_TOP], 1u);
            const unsigned tg = og / nx;
            if (og + 1u == (tg + 1u) * nx) xb_add(&bar[XB_TOPGEN], 1u);
            else XB_SPIN(xb_ld(&bar[XB_TOPGEN]) == tg, bar);
            __builtin_amdgcn_fence(__ATOMIC_ACQUIRE, "agent");
            xb_add(&bar[XB_XGEN(b.x)], 1u);
            asm volatile("s_waitcnt vmcnt(0)" ::: "memory");
        } else {
            XB_SPIN(xb_ld(&bar[XB_XGEN(b.x)]) == gen, bar);
            __builtin_amdgcn_fence(__ATOMIC_ACQUIRE, "agent");
            asm volatile("s_waitcnt vmcnt(0)" ::: "memory");
        }
    }
    __syncthreads();
}

struct Args {
    const float* in[21];
    float* out; unsigned char* ws;
    int ph_lo, ph_hi, flags, pad;
};
enum { I_X = 0, I_META, I_RELB, I_NMIX, I_WIN, I_BGATE, I_WAO, I_CONVW, I_CONVB, I_LNG, I_LNB, I_WCO, I_WOUT, I_NFFN, I_WR, I_BR, I_WUG, I_BUG, I_WD, I_BD, I_NFIN };

struct Frame {
    LAS unsigned char* lds;
    unsigned char* ws;
    int tid, lane, wave;
    int G, bid;
};
template <class T> __device__ __forceinline__ T* wsp(unsigned char* ws, size_t off) { return (T*)(ws + off); }

struct P0Desc { const float* src; bf16_t* dst; int ldn, ldk; };
__device__ __forceinline__ void p0_load(const P0Desc& d, f32x4 (&v)[16], int lane) {
    const float* p = d.src + (size_t)(lane >> 4) * d.ldn + (lane & 15) * 4;
#pragma unroll
    for (int i = 0; i < 16; ++i) v[i] = *(const f32x4*)(p + (size_t)(4 * i) * d.ldn);
}
__device__ __forceinline__ void p0_store(const P0Desc& d, const f32x4 (&v)[16], LAS float* scr, int lane) {
    const int n4 = (lane & 15) * 4, kr = lane >> 4;
#pragma unroll
    for (int i = 0; i < 16; ++i) { LAS float* p = scr + (4 * i + kr) * 65 + n4; p[0] = v[i][0]; p[1] = v[i][1]; p[2] = v[i][2]; p[3] = v[i][3]; }
    LDS_WAIT(); asm volatile("" ::: "memory");
    const int c = lane & 7;
#pragma unroll
    for (int j = 0; j < 8; ++j) { const int n = (lane >> 3) + 8 * j; const LAS float* s = scr + (8 * c) * 65 + n;
        u32x4 o; o.x = cvt_pk_bf16(s[0 * 65], s[1 * 65]); o.y = cvt_pk_bf16(s[2 * 65], s[3 * 65]); o.z = cvt_pk_bf16(s[4 * 65], s[5 * 65]); o.w = cvt_pk_bf16(s[6 * 65], s[7 * 65]);
        *(u32x4*)(d.dst + (size_t)n * d.ldk + 8 * c) = o; }
    LDS_WAIT(); asm volatile("" ::: "memory");
}
__device__ __forceinline__ void rms_row_to_bf16(const float* __restrict__ xrow, const float* __restrict__ g, bf16_t* __restrict__ orow, int lane) {
    const f32x4* xr = (const f32x4*)xrow + lane; const f32x4* gr = (const f32x4*)g + lane;
    f32x4 v[4]; float s = 0.f;
#pragma unroll
    for (int j = 0; j < 4; ++j) { v[j] = xr[64 * j]; s += (v[j].x * v[j].x + v[j].y * v[j].y) + (v[j].z * v[j].z + v[j].w * v[j].w); }
    const float r = 1.0f / sqrtf(wave_sum(s) * (1.f / DM) + EPS);
    unsigned long long* o8 = (unsigned long long*)orow + lane;
#pragma unroll
    for (int j = 0; j < 4; ++j) { const f32x4 gg = gr[64 * j];
        o8[64 * j] = (unsigned long long)cvt_pk_bf16(v[j].x * r * gg.x, v[j].y * r * gg.y) | ((unsigned long long)cvt_pk_bf16(v[j].z * r * gg.z, v[j].w * r * gg.w) << 32); }
}
__device__ __forceinline__ void p0_prologue(Frame& F, const Args& a) {
    LAS float* scr = (LAS float*)(F.lds + F.wave * 16896);
    const int gw = F.bid * NWAVES + F.wave, NGW = F.G * NWAVES;
    unsigned char* ws = F.ws;
    constexpr int T_IN = 81 * 16, T_AO = 16 * 8, T_CO = 16 * 8, T_OUT = 16 * 16, T_SMALL = T_IN + T_AO + T_CO + T_OUT;
    constexpr int T_UG = NE * 32 * 16, T_D = NE * 16 * 16, T_ALL = T_SMALL + T_UG + T_D;
    auto desc = [&](int it) -> P0Desc {
        int r = it; P0Desc d;
        if (r < T_IN) { const int g = r / 16, kb = r % 16; const int dr = g * 64; int sc;
            if (dr < WR_GLU) sc = dr;
            else if (dr < WR_GATE) { const int q = dr - WR_GLU, tile = q >> 8, hf = (q >> 7) & 1, w = q & 127; sc = SC_GLU + 512 * hf + 128 * tile + w; }
            else if (dr < WR_IK) sc = SC_GATE + (dr - WR_GATE);
            else sc = SC_IK + (dr - WR_IK);
            d.src = a.in[I_WIN] + (size_t)(kb * 64) * INCOLS + sc; d.ldn = INCOLS; d.dst = wsp<bf16_t>(ws, WS_WIN) + (size_t)dr * DM + kb * 64; d.ldk = DM; return d; }
        r -= T_IN;
        if (r < T_AO) { const int g = r / 8, kb = r % 8; d.src = a.in[I_WAO] + (size_t)(kb * 64) * DM + g * 64; d.ldn = DM; d.dst = wsp<bf16_t>(ws, WS_WAO) + (size_t)(g * 64) * AW + kb * 64; d.ldk = AW; return d; }
        r -= T_AO;
        if (r < T_CO) { const int g = r / 8, kb = r % 8; d.src = a.in[I_WCO] + (size_t)(kb * 64) * DM + g * 64; d.ldn = DM; d.dst = wsp<bf16_t>(ws, WS_WCO) + (size_t)(g * 64) * CC + kb * 64; d.ldk = CC; return d; }
        r -= T_CO;
        if (r < T_OUT) { const int g = r / 16, kb = r % 16; d.src = a.in[I_WOUT] + (size_t)(kb * 64) * DM + g * 64; d.ldn = DM; d.dst = wsp<bf16_t>(ws, WS_WOUT) + (size_t)(g * 64) * DM + kb * 64; d.ldk = DM; return d; }
        r -= T_OUT;
        if (r < T_UG) { const int e = r / 512, q = r % 512, g = q % 32, kb = q / 32; const int dr = g * 64, tile = dr >> 8, hf = (dr >> 7) & 1, w = dr & 127;
            d.src = a.in[I_WUG] + (size_t)e * DM * 2 * DFF + (size_t)(kb * 64) * (2 * DFF) + DFF * hf + 128 * tile + w; d.ldn = 2 * DFF;
            d.dst = wsp<bf16_t>(ws, WS_WUG) + (size_t)e * 2 * DFF * DM + (size_t)dr * DM + kb * 64; d.ldk = DM; return d; }
        r -= T_UG;
        { const int e = r / 256, q = r % 256, g = q % 16, kb = q / 16;
            d.src = a.in[I_WD] + (size_t)e * DFF * DM + (size_t)(kb * 64) * DM + g * 64; d.ldn = DM; d.dst = wsp<bf16_t>(ws, WS_WD) + (size_t)e * DM * DFF + (size_t)(g * 64) * DFF + kb * 64; d.ldk = DFF; return d; }
    };
    if (gw < T_ALL) {
        f32x4 va[16], vb[16];
        P0Desc da = desc(gw), db = da;
        p0_load(da, va, F.lane);
        for (int it = gw; it < T_ALL; it += 2 * NGW) {
            const int i1 = it + NGW, i2 = it + 2 * NGW;
            db = desc(i1 < T_ALL ? i1 : it); p0_load(db, vb, F.lane);
            p0_store(da, va, scr, F.lane);
            da = desc(i2 < T_ALL ? i2 : it); p0_load(da, va, F.lane);
            if (i1 < T_ALL) p0_store(db, vb, scr, F.lane);
        }
    }
    { const int gt = F.bid * NTHREADS + F.tid;
      if (gt < 8 * DM / 2) { const int n = gt >> 9, k = (gt & 511) * 2; const float v0 = a.in[I_WIN][(size_t)k * INCOLS + SC_IW + n], v1 = a.in[I_WIN][(size_t)(k + 1) * INCOLS + SC_IW + n];
          *(unsigned*)(wsp<bf16_t>(ws, WS_WIN) + (size_t)(WR_IW + n) * DM + k) = cvt_pk_bf16(v0, v1); } }
    { const int gt = F.bid * NTHREADS + F.tid;
      if (gt < NE * DM / 2) { const int e = gt >> 9, d = (gt & 511) * 2; const float v0 = a.in[I_NFFN][d] * a.in[I_WR][(size_t)d * NE + e], v1 = a.in[I_NFFN][d + 1] * a.in[I_WR][(size_t)(d + 1) * NE + e];
          const unsigned hi = cvt_pk_bf16(v0, v1); const unsigned lo = cvt_pk_bf16(v0 - bflo(hi), v1 - bfhi(hi));
          *(unsigned*)(wsp<bf16_t>(ws, WS_WRT) + (size_t)e * DM + d) = hi; *(unsigned*)(wsp<bf16_t>(ws, WS_WRT) + (size_t)(NE + e) * DM + d) = lo; } }
    for (int m = gw; m < NTOK + NMETA; m += NGW) {
        if (m < NTOK) rms_row_to_bf16(a.in[I_X] + (size_t)m * DM, a.in[I_NMIX], wsp<bf16_t>(ws, WS_XN) + (size_t)m * DM, F.lane);
        else rms_row_to_bf16(a.in[I_META] + (size_t)(m - NTOK) * DM, a.in[I_NMIX], wsp<bf16_t>(ws, WS_XNM) + (size_t)(m - NTOK) * DM, F.lane);
    }
}

struct PlainSched {
    const char* ws; unsigned a_off, b_off; int K, nM, nN, nwg, G, c;
    __device__ __forceinline__ void init(const unsigned char* ws_, size_t a, size_t b, int M, int N, int K_, int G_, int c_) { ws = (const char*)ws_; a_off = (unsigned)a; b_off = (unsigned)b; K = K_; nM = M / 256; nN = N / 256; nwg = nM * nN; G = G_; c = c_; }
    __device__ __forceinline__ bool next(int i, pg8::Unit& u) const {
        const long L = (long)i * G + c; if (L >= nwg) return false;
        int wgid = (int)L; { const int q = nwg / 8, r = nwg % 8, xcd = wgid % 8, off = wgid / 8; wgid = (xcd < r ? xcd * (q + 1) : r * (q + 1) + (xcd - r) * q) + off; }
        const int nig = 8 * nN, gid = wgid / nig, fm = gid * 8, gsz = (nM - fm) < 8 ? (nM - fm) : 8;
        u.pm = fm + ((wgid % nig) % gsz); u.pn = (wgid % nig) / gsz; u.z = 0; return true;
    }
    __device__ __forceinline__ const char* a_base() const { return ws; }
    __device__ __forceinline__ void a_offs(const pg8::Unit& u, int tid, unsigned (&o)[2][2]) const {
        int R[2], C[2]; pg8::stage_rc(tid * 16, R[0], C[0]); pg8::stage_rc(tid * 16 + 8192, R[1], C[1]);
#pragma unroll
        for (int h = 0; h < 2; ++h)
#pragma unroll
            for (int i = 0; i < 2; ++i) o[h][i] = a_off + (unsigned)(((u.pm * 256 + h * 128 + R[i]) * K + C[i]) * 2);
    }
    __device__ __forceinline__ const char* b_base(const pg8::Unit& u) const { return ws + b_off + (size_t)u.pn * 256 * K * 2; }
};
struct MergeSched {
    const char* ws; int G, c;
    __device__ __forceinline__ bool next(int i, pg8::Unit& u) const {
        const int t = c + (i >> 1) * G;
        if (t >= 256) return false;
        u.pm = (t & 7) + 8 * (t >> 5); u.pn = (t >> 3) & 3; u.z = i & 1; return true;
    }
    __device__ __forceinline__ const char* a_base() const { return ws; }
    __device__ __forceinline__ void a_offs(const pg8::Unit& u, int tid, unsigned (&o)[2][2]) const {
        int R[2], C[2]; pg8::stage_rc(tid * 16, R[0], C[0]); pg8::stage_rc(tid * 16 + 8192, R[1], C[1]);
        const unsigned base = (unsigned)(u.z ? WS_CO : WS_AO);
#pragma unroll
        for (int h = 0; h < 2; ++h)
#pragma unroll
            for (int i = 0; i < 2; ++i) o[h][i] = base + (unsigned)(((u.pm * 256 + h * 128 + R[i]) * 512 + C[i]) * 2);
    }
    __device__ __forceinline__ const char* b_base(const pg8::Unit& u) const { return ws + (u.z ? WS_WCO : WS_WAO) + (size_t)u.pn * 256 * 512 * 2; }
};
struct MoeTables { const LAS int* cnt; const LAS int* tbase; };
template <int NC, bool GATHER>
struct MoeSched {
    const char* ws; MoeTables T; int G, c, total;
    __device__ __forceinline__ bool next(int i, pg8::Unit& u) const {
        const long L = (long)i * G + c; if (L >= total) return false;
        int wgid = (int)L; { const int q = total / 8, r = total % 8, xcd = wgid % 8, off = wgid / 8; wgid = (xcd < r ? xcd * (q + 1) : r * (q + 1) + (xcd - r) * q) + off; }
        int e = 0;
        for (int j = 1; j < NE; ++j) e += (wgid >= __builtin_amdgcn_readfirstlane(T.tbase[j]) * NC) ? 1 : 0;
        e = __builtin_amdgcn_readfirstlane(e);
        const int tb0 = __builtin_amdgcn_readfirstlane(T.tbase[e]), tb1 = __builtin_amdgcn_readfirstlane(T.tbase[e + 1]);
        const int loc = wgid - tb0 * NC, nt_e = tb1 - tb0;
        u.z = e; u.pm = loc % nt_e; u.pn = loc / nt_e; return true;
    }
    __device__ __forceinline__ const char* a_base() const { return ws; }
    __device__ __forceinline__ void a_offs(const pg8::Unit& u, int tid, unsigned (&o)[2][2]) const {
        int R[2], C[2]; pg8::stage_rc(tid * 16, R[0], C[0]); pg8::stage_rc(tid * 16 + 8192, R[1], C[1]);
        if (GATHER) {
            const int* list = (const int*)(ws + WS_LIST) + (size_t)u.z * NTOK; const int n = __builtin_amdgcn_readfirstlane(T.cnt[u.z]);
#pragma unroll
            for (int h = 0; h < 2; ++h)
#pragma unroll
                for (int i = 0; i < 2; ++i) { const int p = u.pm * 256 + h * 128 + R[i]; const int tok = (p < n) ? list[p] : 0; o[h][i] = (unsigned)WS_XN + (unsigned)((tok * DM + C[i]) * 2); }
        } else {
            const int row0 = (__builtin_amdgcn_readfirstlane(T.tbase[u.z]) + u.pm) * 256;
#pragma unroll
            for (int h = 0; h < 2; ++h)
#pragma unroll
                for (int i = 0; i < 2; ++i) o[h][i] = (unsigned)WS_ACT + (unsigned)(((row0 + h * 128 + R[i]) * DFF + C[i]) * 2);
        }
    }
    __device__ __forceinline__ const char* b_base(const pg8::Unit& u) const {
        if (GATHER) return ws + WS_WUG + ((size_t)u.z * 2 * DFF + (size_t)u.pn * 256) * DM * 2;
        else return ws + WS_WD + ((size_t)u.z * DM + (size_t)u.pn * 256) * DFF * 2;
    }
};

#define EPI_ROWS(ai, m) for (int ai = 0; ai < 2; ++ai) _Pragma("unroll") for (int m = 0; m < 4; ++m)
#define EPI_COLS(bj, n) for (int bj = 0; bj < 2; ++bj) _Pragma("unroll") for (int n = 0; n < 2; ++n)
__device__ __forceinline__ void st_bf16x4(bf16_t* p, f32x4 v) { u32x2 w; w.x = cvt_pk_bf16(v[0], v[1]); w.y = cvt_pk_bf16(v[2], v[3]); *(u32x2*)p = w; }

struct EpiInProj {
    unsigned char* ws; const float* bgate;
    __device__ __forceinline__ void operator()(const f32x4 (&acc)[2][2][4][2], const pg8::Unit& u, int wr, int wc, int fr, int fq) const {
        const int pn = u.pn, row0 = u.pm * 256 + wr * 64 + fr, col0 = wc * 32 + 4 * fq;
        const int bidx = u.pm >> 3;
        const int rowk0 = row0 + NMETA * (bidx + 1);
        if (pn < 2 || (pn >= 6 && pn < 8)) {
            bf16_t* O = wsp<bf16_t>(ws, pn < 2 ? WS_Q : WS_IQ); const int cb = (pn & 1) * 256; const float sc = pn < 2 ? QSCALE : 1.0f;
#pragma unroll
            EPI_ROWS(ai, m) { bf16_t* rp = O + (size_t)(row0 + ai * 128 + m * 16) * AW + cb + col0;
#pragma unroll
                EPI_COLS(bj, n) st_bf16x4(rp + bj * 128 + n * 16, acc[ai][bj][m][n] * sc); }
        } else if (pn < 4) {
            bf16_t* O = wsp<bf16_t>(ws, WS_KB); const int cb = (pn & 1) * 256;
#pragma unroll
            EPI_ROWS(ai, m) { bf16_t* rp = O + (size_t)(rowk0 + ai * 128 + m * 16) * AW + cb + col0;
#pragma unroll
                EPI_COLS(bj, n) st_bf16x4(rp + bj * 128 + n * 16, acc[ai][bj][m][n]); }
        } else if (pn < 6) {
            bf16_t* O = wsp<bf16_t>(ws, WS_VT) + (size_t)bidx * AW * TP; const int cb = (pn & 1) * 256;
            const int t0 = (row0 & (SEQ - 1)) + NMETA + VOFF;
#pragma unroll
            EPI_ROWS(ai, m) { const int t = t0 + ai * 128 + m * 16;
#pragma unroll
                EPI_COLS(bj, n) { const f32x4 v = acc[ai][bj][m][n]; bf16_t* cp = O + (size_t)(cb + col0 + bj * 128 + n * 16) * TP + (t & ~1);
                    const float p0 = __shfl_xor(v[0], 1), p1 = __shfl_xor(v[1], 1), p2 = __shfl_xor(v[2], 1), p3 = __shfl_xor(v[3], 1);
                    if ((fr & 1) == 0) { *(unsigned*)(cp) = cvt_pk_bf16(v[0], p0); *(unsigned*)(cp + TP) = cvt_pk_bf16(v[1], p1); }
                    else { *(unsigned*)(cp + 2 * TP) = cvt_pk_bf16(p2, v[2]); *(unsigned*)(cp + 3 * TP) = cvt_pk_bf16(p3, v[3]); } } }
        } else if (pn < 12) {
            bf16_t* O = wsp<bf16_t>(ws, WS_GLU); const int cb = (pn - 8) * 128;
#pragma unroll
            EPI_ROWS(ai, m) { bf16_t* rp = O + (size_t)(rowk0 + ai * 128 + m * 16) * CC + cb + col0;
#pragma unroll
                for (int n = 0; n < 2; ++n) { const f32x4 av = acc[ai][0][m][n], gv = acc[ai][1][m][n]; f32x4 y;
#pragma unroll
                    for (int j = 0; j < 4; ++j) y[j] = av[j] * sigmoidf_(gv[j]);
                    st_bf16x4(rp + n * 16, y); } }
        } else {
            const int gt = pn - 12; bf16_t* O = wsp<bf16_t>(ws, gt < 4 ? WS_GA : WS_GB); const int cb = (gt & 3) * 256; const float* bp = bgate + gt * 256 + col0;
            f32x4 bv[2][2];
#pragma unroll
            EPI_COLS(bj, n) bv[bj][n] = *(const f32x4*)(bp + bj * 128 + n * 16);
#pragma unroll
            EPI_ROWS(ai, m) { bf16_t* rp = O + (size_t)(row0 + ai * 128 + m * 16) * DM + cb + col0;
#pragma unroll
                EPI_COLS(bj, n) { const f32x4 x = acc[ai][bj][m][n] + bv[bj][n]; f32x4 y;
#pragma unroll
                    for (int j = 0; j < 4; ++j) y[j] = sigmoidf_(x[j]);
                    st_bf16x4(rp + bj * 128 + n * 16, y); } }
        }
    }
};
struct EpiMerge {
    unsigned char* ws;
    __device__ __forceinline__ void operator()(const f32x4 (&acc)[2][2][4][2], const pg8::Unit& u, int wr, int wc, int fr, int fq) const {
        const int row0 = u.pm * 256 + wr * 64 + fr, col0 = u.pn * 256 + wc * 32 + 4 * fq;
        const bf16_t* Gt = wsp<bf16_t>(ws, u.z ? WS_GB : WS_GA); bf16_t* O = wsp<bf16_t>(ws, WS_MG);
#pragma unroll
        EPI_ROWS(ai, m) { const size_t ro = (size_t)(row0 + ai * 128 + m * 16) * DM + col0;
#pragma unroll
            EPI_COLS(bj, n) { const size_t o = ro + bj * 128 + n * 16; const u32x2 g = *(const u32x2*)(Gt + o); const f32x4 a = acc[ai][bj][m][n];
                f32x4 y = (f32x4){bflo(g.x) * a[0], bfhi(g.x) * a[1], bflo(g.y) * a[2], bfhi(g.y) * a[3]};
                if (u.z) { const u32x2 p = *(const u32x2*)(O + o); y[0] += bflo(p.x); y[1] += bfhi(p.x); y[2] += bflo(p.y); y[3] += bfhi(p.y); }
                st_bf16x4(O + o, y); } }
    }
};
struct EpiResid {
    const float* x; float* out;
    __device__ __forceinline__ void operator()(const f32x4 (&acc)[2][2][4][2], const pg8::Unit& u, int wr, int wc, int fr, int fq) const {
        const int row0 = u.pm * 256 + wr * 64 + fr, col0 = u.pn * 256 + wc * 32 + 4 * fq;
#pragma unroll
        EPI_ROWS(ai, m) { const size_t ro = (size_t)(row0 + ai * 128 + m * 16) * DM + col0;
#pragma unroll
            EPI_COLS(bj, n) { const size_t o = ro + bj * 128 + n * 16; *(f32x4*)(out + o) = *(const f32x4*)(x + o) + acc[ai][bj][m][n]; } }
    }
};
struct EpiSwiglu {
    unsigned char* ws; const float* bug; MoeTables T;
    __device__ __forceinline__ void operator()(const f32x4 (&acc)[2][2][4][2], const pg8::Unit& u, int wr, int wc, int fr, int fq) const {
        const int e = u.z, n_e = __builtin_amdgcn_readfirstlane(T.cnt[e]), rloc0 = u.pm * 256 + wr * 64 + fr, row0 = __builtin_amdgcn_readfirstlane(T.tbase[e]) * 256 + rloc0, col0 = u.pn * 128 + wc * 32 + 4 * fq;
        const float* bp = bug + (size_t)e * 2 * DFF + col0; bf16_t* O = wsp<bf16_t>(ws, WS_ACT); const float* rg = wsp<float>(ws, WS_RG) + (size_t)e * NTOK;
        f32x4 bg[2], bu[2];
#pragma unroll
        for (int n = 0; n < 2; ++n) { bg[n] = *(const f32x4*)(bp + n * 16); bu[n] = *(const f32x4*)(bp + DFF + n * 16); }
#pragma unroll
        EPI_ROWS(ai, m) { const int rl = rloc0 + ai * 128 + m * 16; if (rl < n_e) { bf16_t* rp = O + (size_t)(row0 + ai * 128 + m * 16) * DFF + col0; const float rv = rg[rl];
#pragma unroll
                for (int n = 0; n < 2; ++n) { const f32x4 gv = acc[ai][0][m][n] * rv + bg[n], uv = acc[ai][1][m][n] * rv + bu[n]; f32x4 y;
#pragma unroll
                    for (int j = 0; j < 4; ++j) { const float g = fminf(gv[j], 7.0f), up = fminf(fmaxf(uv[j], -7.0f), 7.0f); y[j] = (up + 1.0f) * g * sigmoidf_(1.702f * g); }
                    st_bf16x4(rp + n * 16, y); } } }
    }
};
struct EpiDown {
    unsigned char* ws; const float* bd; MoeTables T;
    __device__ __forceinline__ void operator()(const f32x4 (&acc)[2][2][4][2], const pg8::Unit& u, int wr, int wc, int fr, int fq) const {
        const int e = u.z, n_e = __builtin_amdgcn_readfirstlane(T.cnt[e]), rloc0 = u.pm * 256 + wr * 64 + fr, row0 = __builtin_amdgcn_readfirstlane(T.tbase[e]) * 256 + rloc0, col0 = u.pn * 256 + wc * 32 + 4 * fq;
        const float* bp = bd + (size_t)e * DM + col0; bf16_t* O = wsp<bf16_t>(ws, WS_YP); const float* lg = wsp<float>(ws, WS_LG) + (size_t)e * NTOK;
        f32x4 bv[2][2];
#pragma unroll
        EPI_COLS(bj, n) bv[bj][n] = *(const f32x4*)(bp + bj * 128 + n * 16);
#pragma unroll
        EPI_ROWS(ai, m) { const int rl = rloc0 + ai * 128 + m * 16; if (rl < n_e) { const float gt = lg[rl]; bf16_t* rp = O + (size_t)(row0 + ai * 128 + m * 16) * DM + col0;
#pragma unroll
                EPI_COLS(bj, n) st_bf16x4(rp + bj * 128 + n * 16, (acc[ai][bj][m][n] + bv[bj][n]) * gt); } }
    }
};

template <int NT>
__device__ __forceinline__ void wave_mm16(const bf16_t* __restrict__ A, int lda, const bf16_t* const (&Bt)[NT], int K, int lane, f32x4 (&acc)[NT]) {
    const bf16_t* ap = A + (size_t)(lane & 15) * lda + 8 * (lane >> 4);
    const bf16_t* bp[NT];
#pragma unroll
    for (int t = 0; t < NT; ++t) { bp[t] = Bt[t] + (size_t)(lane & 15) * K + 8 * (lane >> 4); acc[t] = (f32x4){0.f, 0.f, 0.f, 0.f}; }
#pragma unroll 4
    for (int k0 = 0; k0 < K; k0 += 32) {
        const bf16x8 a = *(const bf16x8*)(ap + k0);
#pragma unroll
        for (int t = 0; t < NT; ++t) { const bf16x8 b = *(const bf16x8*)(bp[t] + k0); acc[t] = __builtin_amdgcn_mfma_f32_16x16x32_bf16(b, a, acc[t], 0, 0, 0); }
    }
}
__device__ __forceinline__ void p1_thin(Frame& F) {
    unsigned char* ws = F.ws;
    const bf16_t* WIN = wsp<bf16_t>(ws, WS_WIN); const bf16_t* XN = wsp<bf16_t>(ws, WS_XN); const bf16_t* XNM = wsp<bf16_t>(ws, WS_XNM);
    bf16_t* KB = wsp<bf16_t>(ws, WS_KB); bf16_t* VT = wsp<bf16_t>(ws, WS_VT); bf16_t* IK = wsp<bf16_t>(ws, WS_IK); bf16_t* GLU = wsp<bf16_t>(ws, WS_GLU); float* IW = wsp<float>(ws, WS_IW);
    const int gw = F.bid * NWAVES + F.wave, NGW = F.G * NWAVES, lane = F.lane, tk = lane & 15, nq = lane >> 4;
    for (int task = gw; task < 2048; task += NGW) {
        const int tg = task >> 1, hf = task & 1, m = tg * 16 + tk, rowk = m + NMETA * ((m >> 11) + 1);
        const bf16_t* A = XN + (size_t)tg * 16 * DM;
        if (hf == 0) {
            const bf16_t* const Bt[3] = {WIN + (size_t)(WR_IK) * DM, WIN + (size_t)(WR_IK + 16) * DM, WIN + (size_t)(WR_IK + 32) * DM}; f32x4 acc[3];
            wave_mm16<3>(A, DM, Bt, DM, lane, acc);
#pragma unroll
            for (int t = 0; t < 3; ++t) st_bf16x4(IK + (size_t)rowk * IDXD + 16 * t + 4 * nq, acc[t]);
        } else {
            const bf16_t* const Bt[2] = {WIN + (size_t)(WR_IK + 48) * DM, WIN + (size_t)(WR_IW) * DM}; f32x4 acc[2];
            wave_mm16<2>(A, DM, Bt, DM, lane, acc);
            st_bf16x4(IK + (size_t)rowk * IDXD + 48 + 4 * nq, acc[0]);
            if (nq < 2) *(f32x4*)(IW + (size_t)m * 8 + 4 * nq) = acc[1];
        }
    }
    for (int task = gw; task < 100; task += NGW) {
        if (task < 32) {
            const bf16_t* const Bt[1] = {WIN + (size_t)(SC_K + 16 * task) * DM}; f32x4 acc[1]; wave_mm16<1>(XNM, DM, Bt, DM, lane, acc);
            for (int b = 0; b < NB; ++b) st_bf16x4(KB + (size_t)(b * TT + tk) * AW + 16 * task + 4 * nq, acc[0]);
        } else if (task < 64) {
            const int t = task - 32; const bf16_t* const Bt[1] = {WIN + (size_t)(SC_V + 16 * t) * DM}; f32x4 acc[1]; wave_mm16<1>(XNM, DM, Bt, DM, lane, acc);
            const float p0 = __shfl_xor(acc[0][0], 1), p1 = __shfl_xor(acc[0][1], 1), p2 = __shfl_xor(acc[0][2], 1), p3 = __shfl_xor(acc[0][3], 1);
            const unsigned wa = (tk & 1) ? cvt_pk_bf16(p2, acc[0][2]) : cvt_pk_bf16(acc[0][0], p0), wb = (tk & 1) ? cvt_pk_bf16(p3, acc[0][3]) : cvt_pk_bf16(acc[0][1], p1);
            for (int b = 0; b < NB; ++b) { bf16_t* cp = VT + ((size_t)b * AW + 16 * t + 4 * nq + 2 * (tk & 1)) * TP + VOFF + (tk & ~1);
                *(unsigned*)cp = wa; *(unsigned*)(cp + TP) = wb; }
        } else if (task < 68) {
            const int t = task - 64; const bf16_t* const Bt[1] = {WIN + (size_t)(WR_IK + 16 * t) * DM}; f32x4 acc[1]; wave_mm16<1>(XNM, DM, Bt, DM, lane, acc);
            for (int b = 0; b < NB; ++b) st_bf16x4(IK + (size_t)(b * TT + tk) * IDXD + 16 * t + 4 * nq, acc[0]);
        } else {
            const int c16 = task - 68; const int ar = WR_GLU + 256 * (c16 >> 3) + 16 * (c16 & 7);
            const bf16_t* const Bt[2] = {WIN + (size_t)ar * DM, WIN + (size_t)(ar + 128) * DM}; f32x4 acc[2]; wave_mm16<2>(XNM, DM, Bt, DM, lane, acc);
            f32x4 y;
#pragma unroll
            for (int j = 0; j < 4; ++j) y[j] = acc[0][j] * sigmoidf_(acc[1][j]);
            for (int b = 0; b < NB; ++b) st_bf16x4(GLU + (size_t)(b * TT + tk) * CC + 16 * c16 + 4 * nq, y);
        }
    }
}

__device__ __forceinline__ void p2_conv(Frame& F, const Args& a) {
    unsigned char* ws = F.ws;
    LAS unsigned char* xs = F.lds;
    LAS float* wl = (LAS float*)(F.lds + 63488);
    const bf16_t* GLU = wsp<bf16_t>(ws, WS_GLU); bf16_t* CO = wsp<bf16_t>(ws, WS_CO);
    const float* cw = a.in[I_CONVW];
    for (int idx = F.tid; idx < CW * 128; idx += NTHREADS) { const int tap = idx >> 7, c4 = idx & 127; const f32x4 v = *(const f32x4*)(cw + tap * CC + 4 * c4); *(LAS f32x4*)(wl + tap * 512 + (c4 & 1) * 256 + (c4 >> 1) * 4) = v; }
    const int lane = F.lane, c0 = 8 * lane;
    for (int tile = F.bid; tile < NTOK / 32; tile += F.G) {
        const int b = tile >> 6, s0 = (tile & 63) * 32, p0 = NMETA + s0;
        __syncthreads();
        for (int idx = F.tid; idx < 62 * 64; idx += NTHREADS) { const int r = idx >> 6, ch = idx & 63, p = p0 - 30 + r; u32x4 v = (u32x4){0u, 0u, 0u, 0u};
            if (p >= 0) v = *(const u32x4*)(GLU + (size_t)(b * TT + p) * CC + ch * 8);
            *(LAS u32x4*)(xs + r * 1024 + ch * 16) = v; }
        __syncthreads();
        const int i0 = 4 * F.wave;
        float acc[4][8];
#pragma unroll
        for (int t = 0; t < 4; ++t)
#pragma unroll
            for (int i = 0; i < 8; ++i) acc[t][i] = 0.f;
        const LAS float* wlb = wl + lane * 4; asm volatile("" : "+v"(wlb));
        const LAS unsigned char* xsb = xs + i0 * 1024 + lane * 16; asm volatile("" : "+v"(xsb));
#pragma unroll 1
        for (int tap = 0; tap < CW; ++tap) {
            const f32x4 w0 = *(const LAS f32x4*)(wlb + tap * 512), w1 = *(const LAS f32x4*)(wlb + tap * 512 + 256);
#pragma unroll
            for (int t = 0; t < 4; ++t) {
                const u32x4 xv = *(const LAS u32x4*)(xsb + (tap + t) * 1024);
                acc[t][0] += w0[0] * bflo(xv.x); acc[t][1] += w0[1] * bfhi(xv.x); acc[t][2] += w0[2] * bflo(xv.y); acc[t][3] += w0[3] * bfhi(xv.y);
                acc[t][4] += w1[0] * bflo(xv.z); acc[t][5] += w1[1] * bfhi(xv.z); acc[t][6] += w1[2] * bflo(xv.w); acc[t][7] += w1[3] * bfhi(xv.w);
            }
        }
        float cb[8], lg[8], lb[8];
        { const f32x4* p0 = (const f32x4*)(a.in[I_CONVB] + c0); const f32x4* p1 = (const f32x4*)(a.in[I_LNG] + c0); const f32x4* p2 = (const f32x4*)(a.in[I_LNB] + c0);
#pragma unroll
          for (int hh = 0; hh < 2; ++hh) { const f32x4 u0 = p0[hh], u1 = p1[hh], u2 = p2[hh];
#pragma unroll
              for (int i = 0; i < 4; ++i) { cb[4 * hh + i] = u0[i]; lg[4 * hh + i] = u1[i]; lb[4 * hh + i] = u2[i]; } } }
#pragma unroll
        for (int t = 0; t < 4; ++t) {
            float s = 0.f;
#pragma unroll
            for (int i = 0; i < 8; ++i) { acc[t][i] += cb[i]; s += acc[t][i]; }
            const float mean = wave_sum(s) * (1.f / CC); float q = 0.f;
#pragma unroll
            for (int i = 0; i < 8; ++i) { acc[t][i] -= mean; q += acc[t][i] * acc[t][i]; }
            const float rstd = 1.0f / sqrtf(wave_sum(q) * (1.f / CC) + EPS);
            float y[8];
#pragma unroll
            for (int i = 0; i < 8; ++i) { const float z = acc[t][i] * rstd * lg[i] + lb[i]; y[i] = z * sigmoidf_(z); }
            u32x4 o; o.x = cvt_pk_bf16(y[0], y[1]); o.y = cvt_pk_bf16(y[2], y[3]); o.z = cvt_pk_bf16(y[4], y[5]); o.w = cvt_pk_bf16(y[6], y[7]);
            *(u32x4*)(CO + (size_t)(b * SEQ + s0 + i0 + t) * CC + c0) = o;
        }
    }
    __syncthreads();
}

constexpr int ROWP = 2080, NJ = 33;
__device__ __forceinline__ unsigned f2ord(float f) { const unsigned b = __float_as_uint(f); return b ^ ((b >> 31) ? 0xffffffffu : 0x80000000u); }
__device__ __forceinline__ int wave_isum(int v) {
#pragma unroll
    for (int o = 1; o < 64; o <<= 1) v += __shfl_xor(v, o);
    return v;
}
__device__ __forceinline__ int wave_isum_dpp(int v) {
    v += __builtin_amdgcn_update_dpp(0, v, 0xB1, 0xF, 0xF, false);
    v += __builtin_amdgcn_update_dpp(0, v, 0x4E, 0xF, 0xF, false);
    v += __builtin_amdgcn_update_dpp(0, v, 0x141, 0xF, 0xF, false);
    v += __builtin_amdgcn_update_dpp(0, v, 0x140, 0xF, 0xF, false);
    return __builtin_amdgcn_readlane(v, 0) + __builtin_amdgcn_readlane(v, 16) + __builtin_amdgcn_readlane(v, 32) + __builtin_amdgcn_readlane(v, 48);
}
__device__ __forceinline__ void p2_indexer_unit(Frame& F, int b, int q16, int flags) {
    unsigned char* ws = F.ws;
    const bf16_t* IQ = wsp<bf16_t>(ws, WS_IQ); const bf16_t* IK = wsp<bf16_t>(ws, WS_IK); const float* IW = wsp<float>(ws, WS_IW); unsigned* MASK = wsp<unsigned>(ws, WS_MASK);
    LAS unsigned* SU = (LAS unsigned*)F.lds;
    const int lane = F.lane, c = lane & 31, hi = lane >> 5, w = F.wave;
    const int nwblk = (q16 >> 1) + 2;
    if (!(flags & 4)) {
        const int tok0 = b * SEQ + 16 * q16;
        bf16x8 af[4][4]; f32x4 wq[4][4];
#pragma unroll
        for (int g = 0; g < 4; ++g) {
            const bf16_t* ap = IQ + (size_t)(tok0 + 4 * g + (c >> 3)) * AW + (c & 7) * IDXD + 8 * hi;
#pragma unroll
            for (int ks = 0; ks < 4; ++ks) af[g][ks] = *(const bf16x8*)(ap + 16 * ks);
#pragma unroll
            for (int q = 0; q < 4; ++q) wq[g][q] = *(const f32x4*)(IW + (size_t)(tok0 + 4 * g + q) * 8 + 4 * hi);
        }
        const int rel0 = NMETA + 16 * q16 + 2 * hi - c;
        const bf16_t* kp = IK + (size_t)(b * TT + c) * IDXD + 8 * hi;
        LAS unsigned* srow = SU + (2 * hi) * ROWP + c;
        bf16x8 bfr[4], bnx[4];
#pragma unroll
        for (int ks = 0; ks < 4; ++ks) { bfr[ks] = *(const bf16x8*)(kp + (size_t)(w < nwblk ? w : 0) * 32 * IDXD + 16 * ks); bnx[ks] = bfr[ks]; }
#pragma unroll
        for (int g = 0; g < 4; ++g) asm volatile("" :: "v"(af[g][0]), "v"(af[g][1]), "v"(af[g][2]), "v"(af[g][3]), "v"(wq[g][0]), "v"(wq[g][1]), "v"(wq[g][2]), "v"(wq[g][3]));
        asm volatile("" :: "v"(bfr[0]), "v"(bfr[1]), "v"(bfr[2]), "v"(bfr[3]));
        for (int blk = w; blk < nwblk; blk += 8) {
            {
                const int bn_ = blk + 8 < nwblk ? blk + 8 : blk;
#pragma unroll
                for (int ks = 0; ks < 4; ++ks) bnx[ks] = *(const bf16x8*)(kp + (size_t)bn_ * 32 * IDXD + 16 * ks); }
#pragma unroll
            for (int g = 0; g < 4; ++g) {
                f32x16 acc = {};
#pragma unroll
                for (int ks = 0; ks < 4; ++ks) acc = __builtin_amdgcn_mfma_f32_32x32x16_bf16(af[g][ks], bfr[ks], acc, 0, 0, 0);
                float part[4];
#pragma unroll
                for (int q = 0; q < 4; ++q) { float s = wq[g][q][0] * __builtin_amdgcn_fmed3f(acc[4 * q], 0.f, INFINITY);
#pragma unroll
                    for (int i = 1; i < 4; ++i) s = __builtin_fmaf(wq[g][q][i], __builtin_amdgcn_fmed3f(acc[4 * q + i], 0.f, INFINITY), s);
                    part[q] = s; }
#pragma unroll
                for (int p = 0; p < 2; ++p) {
                    const auto rr = __builtin_amdgcn_permlane32_swap(__float_as_uint(part[p]), __float_as_uint(part[p + 2]), false, false);
                    const float sc = __uint_as_float(rr[0]) + __uint_as_float(rr[1]);
                    srow[(4 * g + p) * ROWP + 32 * blk] = (32 * blk <= rel0 + 4 * g + p) ? f2ord(sc) : 0u; }
            }
#pragma unroll
            for (int ks = 0; ks < 4; ++ks) bfr[ks] = bnx[ks];
        }
    }
    __syncthreads();
    if (!(flags & 8)) {
        const int nj = (nwblk + 1) >> 1, klim = 32 * nwblk;
        unsigned U[NJ][2];
#pragma unroll
        for (int j = 0; j < NJ; ++j) {
            if (j < nj) { const int key = 64 * j + lane;
#pragma unroll
                for (int p = 0; p < 2; ++p) U[j][p] = (key < klim) ? SU[(2 * w + p) * ROWP + key] : 0u; }
            else { U[j][0] = 0u; U[j][1] = 0u; }
        }
        const int tokb = b * SEQ + 16 * q16 + 2 * w;
        unsigned lo[2], hb[2], thr[2], veq[2]; int chi[2], need[2]; bool done[2];
#pragma unroll
        for (int p = 0; p < 2; ++p) { lo[p] = 1u; hb[p] = 0xffffffffu; chi[p] = 0; need[p] = 0; veq[p] = 0u; thr[p] = 1u; done[p] = (NMETA + 16 * q16 + 2 * w + p + 1 <= TOPK); }
        for (int it = 0; it < 34; ++it) {
            if (done[0] && done[1]) break;
            unsigned mid[2]; int cl[2];
#pragma unroll
            for (int p = 0; p < 2; ++p) { mid[p] = lo[p] + ((hb[p] - lo[p]) >> 1); cl[p] = 0; }
#pragma unroll
            for (int g = 0; g < 3; ++g) if (11 * g < nj) {
#pragma unroll
                for (int jj = 0; jj < 11; ++jj)
#pragma unroll
                    for (int p = 0; p < 2; ++p) cl[p] += (U[11 * g + jj][p] >= mid[p]) ? 1 : 0; }
            const int tot = wave_isum_dpp(cl[0] | (cl[1] << 16));
            int cnt[2] = {tot & 0xffff, tot >> 16};
#ifdef DBG_CHECK_DPP
            if (wave_isum(cl[0]) != cnt[0] || wave_isum(cl[1]) != cnt[1]) __hip_atomic_store(wsp<unsigned>(ws, WS_CTL) + 3, 1u, RLX_AGENT);
#endif
#pragma unroll
            for (int p = 0; p < 2; ++p) {
                const int ct = cnt[p];
                if (!done[p]) {
                    if (ct == TOPK) { done[p] = true; thr[p] = mid[p]; need[p] = 0; }
                    else if (ct > TOPK) lo[p] = mid[p];
                    else { hb[p] = mid[p]; chi[p] = ct; }
                    if (!done[p] && hb[p] - lo[p] == 1u) { done[p] = true; thr[p] = hb[p]; veq[p] = lo[p]; need[p] = TOPK - chi[p]; }
                }
            }
        }
#pragma unroll
        for (int p = 0; p < 2; ++p) {
            int run = 0;
            unsigned long long* mrow = (unsigned long long*)(MASK + (size_t)(tokb + p) * MSTR);
#pragma unroll
            for (int j = 0; j < NJ; ++j) if (j < nj) {
                const unsigned u = U[j][p];
                const bool eq = (need[p] > 0) && (u == veq[p]);
                const unsigned long long em = __ballot(eq);
                const int rank = run + (int)__builtin_amdgcn_mbcnt_hi((unsigned)(em >> 32), __builtin_amdgcn_mbcnt_lo((unsigned)em, 0u));
                const bool take = (u >= thr[p]) || (eq && rank < need[p]);
                run += __popcll(em);
                const unsigned long long sm = __ballot(take);
                if (lane == 0) mrow[j] = sm;
            }
        }
    }
    __syncthreads();
}
__device__ __forceinline__ void p2_indexer(Frame& F, int flags) {
    for (int i = F.bid; i < 256; i += F.G) { const int b = i >> 5, j = 2 * (i & 31);
        p2_indexer_unit(F, b, j, flags); p2_indexer_unit(F, b, 127 - j, flags); p2_indexer_unit(F, b, j + 1, flags); p2_indexer_unit(F, b, 126 - j, flags); }
}

__device__ const unsigned char T5B[128] = {0, 1, 2, 3, 4, 5, 6, 7, 8, 9, 10, 11, 12, 13, 14, 15, 16, 16, 16, 17, 17, 18, 18, 18, 19, 19, 19, 20, 20, 20, 20, 21, 21, 21, 21, 22, 22, 22, 22, 22, 23, 23, 23, 23, 23, 23, 24, 24, 24, 24, 24, 24, 25, 25, 25, 25, 25, 25, 25, 26, 26, 26, 26, 26, 26, 26, 26, 27, 27, 27, 27, 27, 27, 27, 27, 27, 27, 28, 28, 28, 28, 28, 28, 28, 28, 28, 28, 29, 29, 29, 29, 29, 29, 29, 29, 29, 29, 29, 29, 30, 30, 30, 30, 30, 30, 30, 30, 30, 30, 30, 30, 30, 30, 31, 31, 31, 31, 31, 31, 31, 31, 31, 31, 31, 31, 31, 31, 31};
constexpr int TBS = 132;
__device__ __forceinline__ int crow(int r, int hi) { return (r & 3) + 8 * (r >> 2) + 4 * hi; }
constexpr int KPITCH = 144, VPITCH = 136;
constexpr int AT_K = 0, AT_V = AT_K + 2 * 64 * KPITCH, AT_TB = AT_V + 2 * 64 * VPITCH, AT_SC = AT_TB + NH * TBS * 4, AT_END = AT_SC + NWAVES * 128;
static_assert(AT_END <= RING_BYTES, "attention LDS map");
__device__ __forceinline__ void p3_attn_unit(Frame& F, int b, int h, int Q) {
    unsigned char* ws = F.ws;
    const bf16_t* Qm = wsp<bf16_t>(ws, WS_Q); const bf16_t* KB = wsp<bf16_t>(ws, WS_KB); const bf16_t* VT = wsp<bf16_t>(ws, WS_VT); const unsigned* MASK = wsp<unsigned>(ws, WS_MASK); bf16_t* AO = wsp<bf16_t>(ws, WS_AO);
    LAS unsigned char* lds = F.lds;
    const LAS float* tbh = (const LAS float*)(lds + AT_TB) + h * TBS;
    LAS float* sc = (LAS float*)(lds + AT_SC) + F.wave * 32;
    const int tid = F.tid, lane = F.lane, c = lane & 31, hi = lane >> 5, w = F.wave;
    const int qb32 = 8 * Q + w, tokq = b * SEQ + 32 * qb32 + c, posq = NMETA + 32 * qb32 + c;
    const int ktmax = (47 + 32 * qb32) >> 6, NT = 4 * Q + 5;
    bf16x8 qf[4];
#pragma unroll
    for (int ks = 0; ks < 4; ++ks) qf[ks] = *(const bf16x8*)(Qm + (size_t)tokq * AW + h * HD + 16 * ks + 8 * hi);
    const unsigned long long* mrow = (const unsigned long long*)(MASK + (size_t)tokq * MSTR);
    const int srow = tid >> 3, piece = tid & 7;
    const bf16_t* kg = KB + (size_t)(b * TT + srow) * AW + h * HD + piece * 8;
    const bf16_t* vg = VT + ((size_t)b * AW + h * HD + srow) * TP + piece * 8;
    LAS unsigned char* kl = lds + AT_K + srow * KPITCH + piece * 16;
    LAS unsigned char* vl = lds + AT_V + srow * VPITCH + piece * 16;
    const LAS unsigned char* kfb = lds + AT_K + c * KPITCH + 16 * hi;
    const LAS unsigned char* vfb = lds + AT_V + c * VPITCH + 8 * hi;
    const float NEG = -INFINITY;
    float m_run = NEG, l = 0.f; f32x16 O0 = {}, O1 = {};
    u32x4 kr = *(const u32x4*)kg, vr = *(const u32x4*)vg;
    unsigned long long mwn = mrow[0];
    *(LAS u32x4*)kl = kr; *(LAS u32x2*)vl = (u32x2){vr.x, vr.y}; *(LAS u32x2*)(vl + 8) = (u32x2){vr.z, vr.w};
    __syncthreads();
    for (int kt = 0; kt < NT; ++kt) {
        const int buf = kt & 1;
        const unsigned long long mw = mwn;
        if (kt + 1 < NT) { kr = *(const u32x4*)(kg + (size_t)(kt + 1) * 64 * AW); vr = *(const u32x4*)(vg + (kt + 1) * 64); if (kt + 1 <= ktmax) mwn = mrow[kt + 1]; }
        if (kt <= ktmax) {
            const LAS unsigned char* kp = kfb + buf * 64 * KPITCH;
            f32x16 S0 = {}, S1 = {};
#pragma unroll
            for (int ks = 0; ks < 4; ++ks) {
                const bf16x8 k0 = *(const LAS bf16x8*)(kp + ks * 32), k1 = *(const LAS bf16x8*)(kp + 32 * KPITCH + ks * 32);
                S0 = __builtin_amdgcn_mfma_f32_32x32x16_bf16(k0, qf[ks], S0, 0, 0, 0);
                S1 = __builtin_amdgcn_mfma_f32_32x32x16_bf16(k1, qf[ks], S1, 0, 0, 0);
            }
            const unsigned mw0 = (unsigned)mw >> (4 * hi), mw1 = (unsigned)(mw >> 32) >> (4 * hi);
            const int d0 = posq - 64 * kt - 4 * hi;
            const bool far = (256 * Q + 32 * w - 64 * kt) >= 175;
            float tmax = NEG;
            if (far) {
                const float bfar = tbh[128];
#pragma unroll
                for (int r = 0; r < 16; ++r) { const int ko = (r & 3) + 8 * (r >> 2);
                    S0[r] = ((mw0 >> ko) & 1u) ? S0[r] + bfar : NEG; S1[r] = ((mw1 >> ko) & 1u) ? S1[r] + bfar : NEG; tmax = fmaxf(tmax, fmaxf(S0[r], S1[r])); }
            } else {
#pragma unroll
                for (int r = 0; r < 16; ++r) { const int ko = (r & 3) + 8 * (r >> 2);
                    int da = d0 - ko, db = d0 - 32 - ko; da = da < 0 ? 0 : (da > 128 ? 128 : da); db = db < 0 ? 0 : (db > 128 ? 128 : db);
                    S0[r] = ((mw0 >> ko) & 1u) ? S0[r] + tbh[da] : NEG; S1[r] = ((mw1 >> ko) & 1u) ? S1[r] + tbh[db] : NEG; tmax = fmaxf(tmax, fmaxf(S0[r], S1[r])); }
            }
            tmax = fmaxf(tmax, __shfl_xor(tmax, 32));
            if (__any(tmax > m_run + 8.0f)) {
                const float m_new = fmaxf(m_run, tmax);
                const float alpha = (m_new == NEG) ? 1.0f : __builtin_amdgcn_exp2f(m_run - m_new);
                l *= alpha; m_run = m_new;
                if (hi == 0) sc[c] = alpha;
                LDS_WAIT(); asm volatile("" ::: "memory");
#pragma unroll
                for (int r = 0; r < 16; ++r) { const float f = sc[crow(r, hi)]; O0[r] *= f; O1[r] *= f; }
                LDS_WAIT(); asm volatile("" ::: "memory");
            }
            const float m_use = (m_run == NEG) ? 0.f : m_run;
            float ps = 0.f;
#pragma unroll
            for (int r = 0; r < 16; ++r) { S0[r] = __builtin_amdgcn_exp2f(S0[r] - m_use); S1[r] = __builtin_amdgcn_exp2f(S1[r] - m_use); ps += S0[r] + S1[r]; }
            l += ps;
            const LAS unsigned char* vp = vfb + buf * 64 * VPITCH;
#pragma unroll
            for (int s2 = 0; s2 < 4; ++s2) {
                u32x4 pw;
                if (s2 < 2) { const int o = 8 * (s2 & 1); pw.x = cvt_pk_bf16(S0[o + 0], S0[o + 1]); pw.y = cvt_pk_bf16(S0[o + 2], S0[o + 3]); pw.z = cvt_pk_bf16(S0[o + 4], S0[o + 5]); pw.w = cvt_pk_bf16(S0[o + 6], S0[o + 7]); }
                else { const int o = 8 * (s2 & 1); pw.x = cvt_pk_bf16(S1[o + 0], S1[o + 1]); pw.y = cvt_pk_bf16(S1[o + 2], S1[o + 3]); pw.z = cvt_pk_bf16(S1[o + 4], S1[o + 5]); pw.w = cvt_pk_bf16(S1[o + 6], S1[o + 7]); }
                const bf16x8 pf = __builtin_bit_cast(bf16x8, pw);
                const u32x2 a0 = *(const LAS u32x2*)(vp + s2 * 32), a1 = *(const LAS u32x2*)(vp + s2 * 32 + 16);
                const u32x2 b0 = *(const LAS u32x2*)(vp + 32 * VPITCH + s2 * 32), b1 = *(const LAS u32x2*)(vp + 32 * VPITCH + s2 * 32 + 16);
                const bf16x8 v0 = __builtin_bit_cast(bf16x8, ((u32x4){a0.x, a0.y, a1.x, a1.y})), v1 = __builtin_bit_cast(bf16x8, ((u32x4){b0.x, b0.y, b1.x, b1.y}));
                O0 = __builtin_amdgcn_mfma_f32_32x32x16_bf16(pf, v0, O0, 0, 0, 0);
                O1 = __builtin_amdgcn_mfma_f32_32x32x16_bf16(pf, v1, O1, 0, 0, 0);
            }
        }
        if (kt + 1 < NT) { LAS unsigned char* k2 = kl + (buf ^ 1) * 64 * KPITCH; LAS unsigned char* v2 = vl + (buf ^ 1) * 64 * VPITCH;
            *(LAS u32x4*)k2 = kr; *(LAS u32x2*)v2 = (u32x2){vr.x, vr.y}; *(LAS u32x2*)(v2 + 8) = (u32x2){vr.z, vr.w}; }
        __syncthreads();
    }
    const float lt = l + __shfl_xor(l, 32);
    if (hi == 0) sc[c] = 1.0f / lt;
    LDS_WAIT(); asm volatile("" ::: "memory");
    bf16_t* ob = AO + (size_t)(b * SEQ + 32 * qb32) * AW + h * HD + c;
#pragma unroll
    for (int r = 0; r < 16; ++r) { const int qr = crow(r, hi); const float f = sc[qr];
        const float a0 = O0[r] * f, a1 = O1[r] * f, b0 = __shfl_xor(a0, 1), b1 = __shfl_xor(a1, 1);
        if ((c & 1) == 0) { *(unsigned*)(ob + (size_t)qr * AW) = cvt_pk_bf16(a0, b0); *(unsigned*)(ob + (size_t)qr * AW + 32) = cvt_pk_bf16(a1, b1); } }
    LDS_WAIT(); asm volatile("" ::: "memory");
}
__device__ __forceinline__ void p3_attn(Frame& F, const Args& a) {
    LAS float* tb = (LAS float*)(F.lds + AT_TB);
    __syncthreads();
    for (int idx = F.tid; idx < NH * 129; idx += NTHREADS) { const int h = idx / 129, d = idx % 129; const int bk = d < 128 ? (int)T5B[d] : 31; tb[h * TBS + d] = a.in[I_RELB][bk * NH + h] * LOG2E; }
    __syncthreads();
    for (int i = F.bid; i < 256; i += F.G) { const int bh = i >> 2, j = i & 3; p3_attn_unit(F, bh >> 3, bh & 7, j); p3_attn_unit(F, bh >> 3, bh & 7, 7 - j); }
    __syncthreads();
}

constexpr int WLP = 2064;
constexpr int P6_WHI = 0, P6_WLO = NE * WLP, P6_PART = 2 * NE * WLP, P6_SSP = P6_PART + 2 * 64 * 33 * 4, P6_CNT = P6_SSP + 2 * 64 * 4, P6_END = P6_CNT + 256;
static_assert(P6_END <= LDSX_OFF, "router LDS map");
__device__ __forceinline__ void p6_router(Frame& F, const Args& a) {
    unsigned char* ws = F.ws;
    const float* H1 = wsp<float>(ws, WS_H1); bf16_t* HN = wsp<bf16_t>(ws, WS_XN);
    const float* gf = a.in[I_NFFN]; const float* brt = a.in[I_BR];
    int* TE = wsp<int>(ws, WS_TE); int* TPs = wsp<int>(ws, WS_TP); int* LIST = wsp<int>(ws, WS_LIST); float* LG = wsp<float>(ws, WS_LG); float* RG = wsp<float>(ws, WS_RG);
    unsigned* ecnt = wsp<unsigned>(ws, WS_CTL) + CW_ECNT;
    LAS unsigned char* lds = F.lds;
    LAS float* part = (LAS float*)(lds + P6_PART);
    LAS float* ssp = (LAS float*)(lds + P6_SSP);
    LAS int* lcnt = (LAS int*)(lds + P6_CNT);
    LAS int* lbase = lcnt + 32;
    const int lane = F.lane, w = F.wave, tk = lane & 15, kq = lane >> 4;
    __syncthreads();
    { const unsigned char* src = ws + WS_WRT;
      for (int p = F.tid; p < 2 * NE * 128; p += NTHREADS) { const int arr = p >> 12, row = (p >> 7) & 31, c16 = p & 127;
          *(LAS u32x4*)(lds + arr * (NE * WLP) + row * WLP + c16 * 16) = *(const u32x4*)(src + (size_t)arr * NE * DM * 2 + (size_t)row * DM * 2 + c16 * 16); } }
    for (int tb = F.bid; tb < NTOK / 64; tb += F.G) {
        const int t0 = tb * 64;
        __syncthreads();
        if (F.tid < 32) lcnt[F.tid] = 0;
        {
            const int tg = w & 3, kh = w >> 2, tok = t0 + 16 * tg + tk;
            const float* xr = H1 + (size_t)tok * DM + 512 * kh + 8 * kq; const float* gr = gf + 512 * kh + 8 * kq;
            bf16_t* hr = HN + (size_t)tok * DM + 512 * kh + 8 * kq;
            const LAS unsigned char* wl = lds + tk * WLP + (512 * kh + 8 * kq) * 2;
            f32x4 xa[16], xb[16];
#pragma unroll
            for (int ks = 0; ks < 16; ++ks) { xa[ks] = *(const f32x4*)(xr + 32 * ks); xb[ks] = *(const f32x4*)(xr + 32 * ks + 4); }
            f32x4 acc0 = {0.f, 0.f, 0.f, 0.f}, acc1 = acc0; float ss = 0.f;
#pragma unroll
            for (int ks = 0; ks < 16; ++ks) {
                const f32x4 g0 = *(const f32x4*)(gr + 32 * ks), g1 = *(const f32x4*)(gr + 32 * ks + 4);
                const f32x4 x0 = xa[ks], x1 = xb[ks];
                u32x4 hn; hn.x = cvt_pk_bf16(x0[0] * g0[0], x0[1] * g0[1]); hn.y = cvt_pk_bf16(x0[2] * g0[2], x0[3] * g0[3]); hn.z = cvt_pk_bf16(x1[0] * g1[0], x1[1] * g1[1]); hn.w = cvt_pk_bf16(x1[2] * g1[2], x1[3] * g1[3]);
                *(u32x4*)(hr + 32 * ks) = hn;
                ss += (x0[0] * x0[0] + x0[1] * x0[1]) + (x0[2] * x0[2] + x0[3] * x0[3]) + (x1[0] * x1[0] + x1[1] * x1[1]) + (x1[2] * x1[2] + x1[3] * x1[3]);
                u32x4 xh; xh.x = cvt_pk_bf16(x0[0], x0[1]); xh.y = cvt_pk_bf16(x0[2], x0[3]); xh.z = cvt_pk_bf16(x1[0], x1[1]); xh.w = cvt_pk_bf16(x1[2], x1[3]);
                u32x4 xl; xl.x = cvt_pk_bf16(x0[0] - bflo(xh.x), x0[1] - bfhi(xh.x)); xl.y = cvt_pk_bf16(x0[2] - bflo(xh.y), x0[3] - bfhi(xh.y));
                          xl.z = cvt_pk_bf16(x1[0] - bflo(xh.z), x1[1] - bfhi(xh.z)); xl.w = cvt_pk_bf16(x1[2] - bflo(xh.w), x1[3] - bfhi(xh.w));
                const bf16x8 fxh = __builtin_bit_cast(bf16x8, xh), fxl = __builtin_bit_cast(bf16x8, xl);
                const bf16x8 wh0 = *(const LAS bf16x8*)(wl + P6_WHI + ks * 64), wh1 = *(const LAS bf16x8*)(wl + P6_WHI + 16 * WLP + ks * 64);
                const bf16x8 wl0 = *(const LAS bf16x8*)(wl + P6_WLO + ks * 64), wl1 = *(const LAS bf16x8*)(wl + P6_WLO + 16 * WLP + ks * 64);
                acc0 = __builtin_amdgcn_mfma_f32_16x16x32_bf16(wh0, fxh, acc0, 0, 0, 0); acc1 = __builtin_amdgcn_mfma_f32_16x16x32_bf16(wh1, fxh, acc1, 0, 0, 0);
                acc0 = __builtin_amdgcn_mfma_f32_16x16x32_bf16(wl0, fxh, acc0, 0, 0, 0); acc1 = __builtin_amdgcn_mfma_f32_16x16x32_bf16(wl1, fxh, acc1, 0, 0, 0);
                acc0 = __builtin_amdgcn_mfma_f32_16x16x32_bf16(wh0, fxl, acc0, 0, 0, 0); acc1 = __builtin_amdgcn_mfma_f32_16x16x32_bf16(wh1, fxl, acc1, 0, 0, 0);
            }
            ss += __shfl_xor(ss, 16); ss += __shfl_xor(ss, 32);
            LAS float* pp = part + ((kh * 64) + 16 * tg + tk) * 33 + 4 * kq;
#pragma unroll
            for (int r = 0; r < 4; ++r) { pp[r] = acc0[r]; pp[16 + r] = acc1[r]; }
            if (kq == 0) ssp[kh * 64 + 16 * tg + tk] = ss;
        }
        __syncthreads();
        if (w == 0) {
            const float rinv = 1.0f / sqrtf((ssp[lane] + ssp[64 + lane]) * (1.f / DM) + EPS);
            float lg[NE];
#pragma unroll
            for (int e = 0; e < NE; ++e) lg[e] = (part[lane * 33 + e] + part[(64 + lane) * 33 + e]) * rinv + brt[e];
            int sel[4]; float val[4];
#pragma unroll
            for (int j = 0; j < 4; ++j) { float best = -INFINITY; int bi = 0;
#pragma unroll
                for (int e = 0; e < NE; ++e) { const bool tk_ = lg[e] > best; best = tk_ ? lg[e] : best; bi = tk_ ? e : bi; }
                sel[j] = bi; val[j] = best;
#pragma unroll
                for (int e = 0; e < NE; ++e) lg[e] = (e == bi) ? -INFINITY : lg[e]; }
            float den = 0.f, ex[4];
#pragma unroll
            for (int j = 0; j < 4; ++j) { ex[j] = __expf(val[j] - val[0]); den += ex[j]; }
            int slot[4];
#pragma unroll
            for (int j = 0; j < 4; ++j) slot[j] = __hip_atomic_fetch_add(&lcnt[sel[j]], 1, __ATOMIC_RELAXED, __HIP_MEMORY_SCOPE_WORKGROUP);
            LDS_WAIT();
            if (lane < 32) { const int n = lcnt[lane]; lbase[lane] = n ? (int)__hip_atomic_fetch_add(ecnt + 64 * lane, (unsigned)n, RLX_AGENT) : 0; }
            LDS_WAIT(); asm volatile("" ::: "memory");
            const int t = t0 + lane;
#pragma unroll
            for (int j = 0; j < 4; ++j) { const int e = sel[j], pos = lbase[e] + slot[j]; const float g = ex[j] / den;
                TE[t * 4 + j] = e; TPs[t * 4 + j] = pos; LIST[(size_t)e * NTOK + pos] = t; LG[(size_t)e * NTOK + pos] = g; RG[(size_t)e * NTOK + pos] = rinv; }
        }
    }
    __syncthreads();
}
__device__ __forceinline__ void moe_tables(Frame& F, LAS int* cnt, LAS int* tbase) {
    const unsigned* ecnt = wsp<unsigned>(F.ws, WS_CTL) + CW_ECNT;
    __syncthreads();
    if (F.tid < NE) cnt[F.tid] = (int)__hip_atomic_load(ecnt + 64 * F.tid, RLX_AGENT);
    __syncthreads();
    if (F.tid == 0) { int s = 0; for (int e = 0; e < NE; ++e) { tbase[e] = s; s += (cnt[e] + 255) >> 8; } tbase[NE] = s; }
    __syncthreads();
}

__device__ __forceinline__ void p9_final(Frame& F, const Args& a, const LAS int* tbase) {
    unsigned char* ws = F.ws;
    const float* H1 = wsp<float>(ws, WS_H1); float* OUT = a.out; const bf16_t* YP = wsp<bf16_t>(ws, WS_YP); const int* TE = wsp<int>(ws, WS_TE); const int* TPs = wsp<int>(ws, WS_TP); const float* gf = a.in[I_NFIN];
    const int gw = F.bid * NWAVES + F.wave, NGW = F.G * NWAVES, lane = F.lane;
    const f32x4* gr = (const f32x4*)gf + lane;
    f32x4 gg[4];
#pragma unroll
    for (int j = 0; j < 4; ++j) gg[j] = gr[64 * j];
#ifdef DBG_CHECK_DPP
    if (__hip_atomic_load(wsp<unsigned>(ws, WS_CTL) + 3, RLX_AGENT) != 0u) { const float qn = __builtin_nanf("");
#pragma unroll
        for (int j = 0; j < 4; ++j) gg[j] = (f32x4){qn, qn, qn, qn}; }
#endif
    for (int base = 0; base < NTOK; base += 8 * NGW) {
        int myrow = 0;
        { const int i = lane >> 2, j = lane & 3, t = base + gw + NGW * i; if (lane < 32 && t < NTOK) { const int e = TE[t * 4 + j], pos = TPs[t * 4 + j]; myrow = tbase[e] * 256 + pos; } }
        f32x4 va[4], vb[4]; u32x2 ya[4][4], yb[4][4];
#define P9_LOAD(i, V, Y) do { const int t_ = base + gw + NGW * (i); if (t_ < NTOK) { const f32x4* xr_ = (const f32x4*)(H1 + (size_t)t_ * DM) + lane; \
            _Pragma("unroll") for (int j_ = 0; j_ < 4; ++j_) V[j_] = xr_[64 * j_]; \
            _Pragma("unroll") for (int q_ = 0; q_ < 4; ++q_) { const int row_ = __builtin_amdgcn_readlane(myrow, 4 * (i) + q_); const u32x2* yr_ = (const u32x2*)(YP + (size_t)row_ * DM) + lane; \
                _Pragma("unroll") for (int j_ = 0; j_ < 4; ++j_) Y[q_][j_] = yr_[64 * j_]; } } } while (0)
#define P9_PROC(i, V, Y) do { const int t_ = base + gw + NGW * (i); if (t_ < NTOK) { \
            _Pragma("unroll") for (int q_ = 0; q_ < 4; ++q_) _Pragma("unroll") for (int j_ = 0; j_ < 4; ++j_) { const u32x2 y_ = Y[q_][j_]; V[j_].x += bflo(y_.x); V[j_].y += bfhi(y_.x); V[j_].z += bflo(y_.y); V[j_].w += bfhi(y_.y); } \
            float s_ = 0.f; _Pragma("unroll") for (int j_ = 0; j_ < 4; ++j_) s_ += (V[j_].x * V[j_].x + V[j_].y * V[j_].y) + (V[j_].z * V[j_].z + V[j_].w * V[j_].w); \
            const float r_ = 1.0f / sqrtf(wave_sum(s_) * (1.f / DM) + EPS); f32x4* xo_ = (f32x4*)(OUT + (size_t)t_ * DM) + lane; \
            _Pragma("unroll") for (int j_ = 0; j_ < 4; ++j_) xo_[64 * j_] = (f32x4){V[j_].x * r_ * gg[j_].x, V[j_].y * r_ * gg[j_].y, V[j_].z * r_ * gg[j_].z, V[j_].w * r_ * gg[j_].w}; } } while (0)
        P9_LOAD(0, va, ya);
#pragma unroll
        for (int i = 0; i < 8; i += 2) {
            P9_LOAD(i + 1, vb, yb);
            P9_PROC(i, va, ya);
            if (i + 2 < 8) P9_LOAD(i + 2, va, ya);
            P9_PROC(i + 1, vb, yb);
        }
#undef P9_LOAD
#undef P9_PROC
    }
}

constexpr int N_PHASES = 10;
__global__ void __launch_bounds__(NTHREADS, 2) fwd_kernel(Args args) {
    extern __shared__ __attribute__((aligned(16))) unsigned char lds_raw[];
    Frame F;
    F.lds = (LAS unsigned char*)lds_raw; F.ws = args.ws;
    F.tid = threadIdx.x; F.lane = F.tid & 63; F.wave = __builtin_amdgcn_readfirstlane(F.tid >> 6);
    F.G = gridDim.x; F.bid = blockIdx.x;
    volatile LAS unsigned* MISC = (volatile LAS unsigned*)(F.lds + MISC_OFF);
    if (F.tid < 32) MISC[F.tid] = 0u;
    __syncthreads();
    unsigned* ctl = wsp<unsigned>(args.ws, WS_CTL);
    const int lo = args.ph_lo, hi = args.ph_hi;
    const bool multi = (hi - lo) > 1;
    XcdBarrier bar; bar.bar = ctl + CW_BAR; bar.x = 0; bar.st = nullptr;
    if (multi) bar = xcd_barrier_post(ctl + CW_BAR, MISC + 8);
#ifndef PHASE_MASK
#define PHASE_MASK 0x3ff
#endif
#define IN(k) (((PHASE_MASK >> (k)) & 1) && lo <= (k) && (k) < hi)
#define SEAM(k) do { if (IN(k) && IN((k) + 1)) xcd_barrier(bar); } while (0)
    LAS int* l_cnt = (LAS int*)(F.lds + LDSX_OFF); LAS int* l_tbase = l_cnt + 64;
    const MoeTables MT{l_cnt, l_tbase};

    if (IN(0)) { p0_prologue(F, args); } SEAM(0);
    if (IN(1)) {
        PlainSched S; S.init(args.ws, WS_XN, WS_WIN, NTOK, 5120, DM, F.G, F.bid);
        EpiInProj E{args.ws, args.in[I_BGATE]};
        pg8::gemm_phase<EpiInProj, PlainSched>(F.lds, DM, S, E);
        p1_thin(F);
    } SEAM(1);
    if (IN(2)) {
        if (!(args.flags & 1)) p2_conv(F, args);
        if (!(args.flags & 2)) p2_indexer(F, args.flags);
    } SEAM(2);
    if (IN(3)) { p3_attn(F, args); } SEAM(3);
    if (IN(4)) {
        MergeSched S{(const char*)args.ws, F.G, F.bid}; EpiMerge E{args.ws};
        pg8::gemm_phase<EpiMerge, MergeSched>(F.lds, 512, S, E);
    } SEAM(4);
    if (IN(5)) {
        PlainSched S; S.init(args.ws, WS_MG, WS_WOUT, NTOK, DM, DM, F.G, F.bid);
        EpiResid E{args.in[I_X], wsp<float>(args.ws, WS_H1)};
        pg8::gemm_phase<EpiResid, PlainSched>(F.lds, DM, S, E);
    } SEAM(5);
    if (IN(6)) { p6_router(F, args); } SEAM(6);
    if (IN(7)) {
        moe_tables(F, l_cnt, l_tbase);
        MoeSched<8, true> S{(const char*)args.ws, MT, F.G, F.bid, l_tbase[NE] * 8};
        EpiSwiglu E{args.ws, args.in[I_BUG], MT};
        pg8::gemm_phase<EpiSwiglu, MoeSched<8, true>>(F.lds, DM, S, E);
    } SEAM(7);
    if (IN(8)) {
        moe_tables(F, l_cnt, l_tbase);
        MoeSched<4, false> S{(const char*)args.ws, MT, F.G, F.bid, l_tbase[NE] * 4};
        EpiDown E{args.ws, args.in[I_BD], MT};
        pg8::gemm_phase<EpiDown, MoeSched<4, false>>(F.lds, DFF, S, E);
    } SEAM(8);
    if (IN(9)) { moe_tables(F, l_cnt, l_tbase); p9_final(F, args, l_tbase); }
#undef IN
#undef SEAM
}

#ifdef DBG_HASH_OFF
__global__ void dbg_hash(const unsigned* __restrict__ buf, size_t nwords, unsigned* acc) {
    unsigned h = 0u;
    for (size_t i = (size_t)blockIdx.x * blockDim.x + threadIdx.x; i < nwords; i += (size_t)gridDim.x * blockDim.x) h += (buf[i] ^ (unsigned)(i * 2654435761u)) * 2246822519u + (unsigned)i;
#pragma unroll
    for (int o = 1; o < 64; o <<= 1) h += __shfl_xor(h, o);
    if ((threadIdx.x & 63) == 0) atomicAdd(acc, h);
}
__global__ void dbg_fill(float* out, size_t n, const unsigned* acc) {
    const unsigned h = *acc; const float v = (float)((h >> 7) & 0xffffu) * (1.0f / 4096.0f) + 1.0f;
    for (size_t i = (size_t)blockIdx.x * blockDim.x + threadIdx.x; i < n; i += (size_t)gridDim.x * blockDim.x) out[i] = v;
}
#endif

extern "C" void kernel_launch(void* const* d_in, const int* in_sizes, int n_in, void* d_out, int out_size, void* d_ws, size_t ws_size, hipStream_t stream) {
    static int grid = 0;
    if (grid == 0) {
        if (n_in != 21 || out_size != NTOK * DM || ws_size < WS_END) { fprintf(stderr, "kernel_launch: unexpected shapes (n_in %d, out %d, ws %zu < %zu)\n", n_in, out_size, ws_size, (size_t)WS_END); grid = -1; return; }
        int dev = 0, cus = 0, per_cu = 0;
        if (hipGetDevice(&dev) != hipSuccess || hipDeviceGetAttribute(&cus, hipDeviceAttributeMultiprocessorCount, dev) != hipSuccess) { grid = -1; return; }
        if (hipFuncSetAttribute((const void*)fwd_kernel, hipFuncAttributeMaxDynamicSharedMemorySize, LDS_BYTES) != hipSuccess) { fprintf(stderr, "kernel_launch: hipFuncSetAttribute failed\n"); grid = -1; return; }
        if (hipOccupancyMaxActiveBlocksPerMultiprocessor(&per_cu, (const void*)fwd_kernel, NTHREADS, LDS_BYTES) != hipSuccess || per_cu < 1) { fprintf(stderr, "kernel_launch: occupancy query says %d\n", per_cu); }
        (void)hipGetLastError();
        grid = cus;
    }
    if (grid < 0) return;
    (void)hipMemsetAsync((char*)d_ws + WS_CTL, 0, CTL_ZERO_BYTES, stream);
    Args a{};
    for (int i = 0; i < 21; ++i) a.in[i] = (const float*)d_in[i];
    a.out = (float*)d_out; a.ws = (unsigned char*)d_ws;
#if MK_N_LAUNCHES == 1
    a.ph_lo = 0; a.ph_hi = N_PHASES;
    hipLaunchKernelGGL(fwd_kernel, dim3(grid), dim3(NTHREADS), LDS_BYTES, stream, a);
#else
#ifndef DBG_LAST_PHASE
#define DBG_LAST_PHASE (N_PHASES - 1)
#endif
#ifndef DBG_DUP_MASK
#define DBG_DUP_MASK 0
#endif
#ifndef DBG_DUP_FLAGS
#define DBG_DUP_FLAGS 0
#endif
    for (int p = 0; p <= DBG_LAST_PHASE; ++p) { a.ph_lo = p; a.ph_hi = p + 1;
        const int nrep = ((DBG_DUP_MASK >> p) & 1) ? 2 : 1;
        for (int rep = 0; rep < nrep; ++rep) { a.flags = (nrep == 2 && rep == 0) ? DBG_DUP_FLAGS : 0; if (rep == 1 && p == 6) (void)hipMemsetAsync((char*)d_ws + WS_CTL, 0, CTL_ZERO_BYTES, stream);
            hipLaunchKernelGGL(fwd_kernel, dim3(grid), dim3(NTHREADS), LDS_BYTES, stream, a); } }
#ifdef DBG_HASH_OFF
    { const unsigned* hb = DBG_HASH_OFF == 0 ? (const unsigned*)d_out : (const unsigned*)((char*)d_ws + DBG_HASH_OFF);
      hipLaunchKernelGGL(dbg_hash, dim3(1024), dim3(256), 0, stream, hb, (size_t)(DBG_HASH_BYTES) / 4, (unsigned*)d_ws + 2);
      hipLaunchKernelGGL(dbg_fill, dim3(1024), dim3(256), 0, stream, (float*)d_out, (size_t)NTOK * DM, (const unsigned*)d_ws + 2); }
#endif
#endif
}
```

```cpp
#include <hip/hip_runtime.h>
#include <cstdio>
#include <cstdint>

#ifndef MK_N_LAUNCHES
#define MK_N_LAUNCHES 1
#endif

constexpr int NB = 8, SEQ = 2048, NMETA = 16, TT = SEQ + NMETA  , DM = 1024, NTOK = NB * SEQ  , NALL = NB * TT  ;
constexpr int AW = 512, NH = 8, HD = 64, IDXD = 64, CC = 512, CW = 31, NE = 32, DFF = 1024, TOPK = 256;
constexpr int INCOLS = 5192, TP = 2176  , VOFF = 0  , MSTR = 68  ;
constexpr float EPS = 1e-6f, LOG2E = 1.4426950408889634f;
constexpr float QSCALE = 0.125f * LOG2E;
constexpr int MAXTILES = 296;
constexpr int SC_Q = 0, SC_K = 512, SC_V = 1024, SC_IQ = 1536, SC_IK = 2048, SC_IW = 2112, SC_GLU = 2120, SC_GATE = 3144;
constexpr int WR_GLU = 2048, WR_GATE = 3072, WR_IK = 5120, WR_IW = 5184, WIN_ROWS = 5376;

constexpr size_t MiB = 1u << 20;
constexpr size_t al4k(size_t x) { return (x + 4095) & ~(size_t)4095; }
constexpr size_t WS_CTL = 0, CTL_ZERO_BYTES = 1 * MiB;
constexpr size_t WS_WIN = 1 * MiB;
constexpr size_t WS_WAO = WS_WIN + al4k((size_t)WIN_ROWS * DM * 2);
constexpr size_t WS_WCO = WS_WAO + al4k((size_t)DM * AW * 2);
constexpr size_t WS_WOUT = WS_WCO + al4k((size_t)DM * CC * 2);
constexpr size_t WS_WUG = WS_WOUT + al4k((size_t)DM * DM * 2);
constexpr size_t WS_WD = WS_WUG + al4k((size_t)NE * 2 * DFF * DM * 2);
constexpr size_t WS_XN = WS_WD + al4k((size_t)NE * DM * DFF * 2);
constexpr size_t WS_XNM = WS_XN + al4k((size_t)NTOK * DM * 2);
constexpr size_t WS_Q = WS_XNM + al4k((size_t)NMETA * DM * 2);
constexpr size_t WS_IQ = WS_Q + al4k((size_t)NTOK * AW * 2);
constexpr size_t WS_KB = WS_IQ + al4k((size_t)NTOK * AW * 2);
constexpr size_t WS_VT = WS_KB + al4k((size_t)(NALL + 64) * AW * 2);
constexpr size_t WS_IK = WS_VT + al4k((size_t)NB * AW * TP * 2);
constexpr size_t WS_IW = WS_IK + al4k((size_t)(NALL + 64) * IDXD * 2);
constexpr size_t WS_GLU = WS_IW + al4k((size_t)NTOK * 8 * 4);
constexpr size_t WS_GA = WS_GLU + al4k((size_t)NALL * CC * 2);
constexpr size_t WS_GB = WS_GA + al4k((size_t)NTOK * DM * 2);
constexpr size_t WS_MASK = WS_GB + al4k((size_t)NTOK * DM * 2);
constexpr size_t WS_AO = WS_MASK + al4k((size_t)NTOK * MSTR * 4);
constexpr size_t WS_CO = WS_AO + al4k((size_t)NTOK * AW * 2);
constexpr size_t WS_MG = WS_CO + al4k((size_t)NTOK * CC * 2);
constexpr size_t WS_TE = WS_MG + al4k((size_t)NTOK * DM * 2);
constexpr size_t WS_TP = WS_TE + al4k((size_t)NTOK * 4 * 4);
constexpr size_t WS_LIST = WS_TP + al4k((size_t)NTOK * 4 * 4);
constexpr size_t WS_LG = WS_LIST + al4k((size_t)NE * NTOK * 4);
constexpr size_t WS_ACT = WS_LG + al4k((size_t)NE * NTOK * 4);
constexpr size_t WS_YP = WS_ACT + al4k((size_t)MAXTILES * 256 * DFF * 2);
constexpr size_t WS_H1 = WS_YP + al4k((size_t)MAXTILES * 256 * DM * 2);
constexpr size_t WS_WRT = WS_H1 + al4k((size_t)NTOK * DM * 4);
constexpr size_t WS_RG = WS_WRT + al4k((size_t)2 * NE * DM * 2);
constexpr size_t WS_END = WS_RG + al4k((size_t)NE * NTOK * 4);
static_assert(WS_END < ((size_t)1 << 32), "32-bit byte offsets into d_ws");
constexpr int CW_TMO = 0, CW_CODE = 1, CW_BAR = 4096, CW_ECNT = 16384;

constexpr int RING_BYTES = 131072;
constexpr int LDSX_OFF = 153600;
constexpr int MISC_OFF = 161792;
constexpr int LDS_BYTES = 163840;
constexpr int NWAVES = 8, NTHREADS = 512;

#define GAS __attribute__((address_space(1)))
#define LAS __attribute__((address_space(3)))
typedef unsigned short bf16_t;
typedef short bf16x8 __attribute__((ext_vector_type(8)));
typedef short s16x4 __attribute__((ext_vector_type(4)));
typedef float f32x4 __attribute__((ext_vector_type(4)));
typedef float f32x16 __attribute__((ext_vector_type(16)));
typedef unsigned u32x4 __attribute__((ext_vector_type(4)));
typedef unsigned u32x2 __attribute__((ext_vector_type(2)));
typedef GAS unsigned gu32;
#define RLX_AGENT __ATOMIC_RELAXED, __HIP_MEMORY_SCOPE_AGENT
#define LDS_WAIT() asm volatile("s_waitcnt lgkmcnt(0)" ::: "memory")
#define VM_WAIT() asm volatile("s_waitcnt vmcnt(0)" ::: "memory")

typedef float f32x2_t __attribute__((ext_vector_type(2))); typedef __bf16 bf16x2_t __attribute__((ext_vector_type(2)));
__device__ __forceinline__ unsigned cvt_pk_bf16(float lo, float hi) { const f32x2_t v = {lo, hi}; const bf16x2_t b = __builtin_convertvector(v, bf16x2_t); return __builtin_bit_cast(unsigned, b); }
__device__ __forceinline__ float bf2f(unsigned short b) { return __uint_as_float((unsigned)b << 16); }
__device__ __forceinline__ float bflo(unsigned w) { return __uint_as_float(w << 16); }
__device__ __forceinline__ float bfhi(unsigned w) { return __uint_as_float(w & 0xffff0000u); }
__device__ __forceinline__ float sigmoidf_(float x) { return __builtin_amdgcn_rcpf(1.0f + __builtin_amdgcn_exp2f(-LOG2E * x)); }
__device__ __forceinline__ float wave_sum(float v) {
#pragma unroll
    for (int o = 1; o < 64; o <<= 1) v += __shfl_xor(v, o);
    return v;
}

namespace pg8 {
constexpr int BM = 256, BK = 64, HALF = 128, HTB = HALF * BK * 2, STAGE_BYTES = 8 * HTB;
__host__ __device__ __forceinline__ int lds_byte(int r, int c) { const int st = (r >> 4) * 2 + (c >> 5), rr = r & 15, cc = c & 31, ob = rr * 64 + cc * 2; return st * 1024 + (ob ^ (((ob >> 9) & 1) << 5)); }
__host__ __device__ __forceinline__ void stage_rc(int b, int& R, int& C) { const int st = b / 1024, sb = b % 1024, swz = sb ^ (((sb >> 9) & 1) << 5); R = (st >> 1) * 16 + swz / 64; C = (st & 1) * 32 + (swz % 64) / 2; }

struct Unit { int pm, pn, z; };

template <class Epi, class Sched>
__device__ __forceinline__ void gemm_phase(LAS unsigned char* lds, const int K, const Sched& S, const Epi& E) {
    const int tid = threadIdx.x, wid = __builtin_amdgcn_readfirstlane(tid >> 6), lane = tid & 63, wr = wid >> 2, wc = wid & 3, fr = lane & 15, fq = lane >> 4;
    const int nt = K / BK;
    unsigned voffB[2];
#pragma unroll
    for (int i = 0; i < 2; ++i) { int R_, C_; stage_rc(tid * 16 + i * 8192, R_, C_); voffB[i] = (unsigned)(R_ * K + C_) * 2u; }
    const size_t kstep = (size_t)(BK * 2);
    const size_t hstep = (size_t)HALF * K * 2;
    const unsigned ldsw = (unsigned)wid * 1024u;
    const int aoff = lds_byte(wr * 64 + fr, fq * 8), boff = lds_byte(wc * 32 + fr, fq * 8);
    const char* const abase = S.a_base();
#define PG8_SA(b, h) (((b) * 2 + (h)) * HTB)
#define PG8_SB(b, h) ((4 + (b) * 2 + (h)) * HTB)
#define PG8_STAGE(bufoff, gbase, voff) do { _Pragma("unroll") for (int _i = 0; _i < 2; ++_i) \
        __builtin_amdgcn_global_load_lds((const unsigned*)((const char*)(gbase) + (voff)[_i]), (LAS unsigned*)(lds + (bufoff) + ldsw + _i * 8192), 16, 0, 0); } while (0)
#define PG8_LDA(dst, b, h) do { _Pragma("unroll") for (int m = 0; m < 4; ++m) _Pragma("unroll") for (int k = 0; k < 2; ++k) dst[m][k] = *(const LAS bf16x8*)(lds + PG8_SA(b, h) + aoff + m * 2048 + k * 1024); } while (0)
#define PG8_LDB(dst, b, h) do { _Pragma("unroll") for (int n = 0; n < 2; ++n) _Pragma("unroll") for (int k = 0; k < 2; ++k) dst[n][k] = *(const LAS bf16x8*)(lds + PG8_SB(b, h) + boff + n * 2048 + k * 1024); } while (0)
#define PG8_MMA(ai, bj, At, Bt) do { __builtin_amdgcn_s_setprio(1); _Pragma("unroll") for (int m = 0; m < 4; ++m) _Pragma("unroll") for (int n = 0; n < 2; ++n) _Pragma("unroll") for (int k = 0; k < 2; ++k) \
        acc[ai][bj][m][n] = __builtin_amdgcn_mfma_f32_16x16x32_bf16(Bt[n][k], At[m][k], acc[ai][bj][m][n], 0, 0, 0); __builtin_amdgcn_s_setprio(0); } while (0)
#define PG8_WAIT_V(n) asm volatile("s_waitcnt vmcnt(" #n ")" ::: "memory")
#define PG8_WAIT_L(n) asm volatile("s_waitcnt lgkmcnt(" #n ")" ::: "memory")
#define PG8_BAR __builtin_amdgcn_s_barrier()
#define PG8_SCHED __builtin_amdgcn_sched_barrier(0)
    Unit cur, nxt; int ui = 0;
    if (!S.next(0, cur)) return;
    f32x4 acc[2][2][4][2];
#pragma unroll
    for (int a = 0; a < 2; ++a)
#pragma unroll
        for (int b = 0; b < 2; ++b)
#pragma unroll
            for (int m = 0; m < 4; ++m)
#pragma unroll
                for (int n = 0; n < 2; ++n) acc[a][b][m][n] = (f32x4){0.f, 0.f, 0.f, 0.f};
    bf16x8 At[4][2], B0[2][2], B1[2][2];
    unsigned ca[2][2], na[2][2];
    S.a_offs(cur, tid, ca);
    const char* cB = S.b_base(cur);
    PG8_STAGE(PG8_SB(0, 0), cB, voffB); PG8_STAGE(PG8_SB(0, 1), cB + hstep, voffB); PG8_STAGE(PG8_SA(0, 0), abase, ca[0]); PG8_STAGE(PG8_SA(0, 1), abase, ca[1]);
    if (wr == 1) PG8_BAR;
    PG8_WAIT_V(2); PG8_BAR;
    PG8_STAGE(PG8_SB(1, 0), cB + kstep, voffB); PG8_STAGE(PG8_SA(1, 0), abase + kstep, ca[0]); PG8_STAGE(PG8_SB(1, 1), cB + hstep + kstep, voffB);
    PG8_WAIT_V(6); PG8_BAR;
    for (;;) {
        const bool has_next = S.next(ui + 1, nxt);
        const char* nB = cB;
#pragma unroll
        for (int h = 0; h < 2; ++h)
#pragma unroll
            for (int i = 0; i < 2; ++i) na[h][i] = ca[h][i];
        if (has_next) { S.a_offs(nxt, tid, na); nB = S.b_base(nxt); }
        for (int t = 0; t < nt; t += 2) {
            const bool last = (t == nt - 2);
            const char* a1 = abase + (size_t)(t + 1) * kstep;
            const char* a2 = last ? abase : abase + (size_t)(t + 2) * kstep; const char* b2 = last ? nB : cB + (size_t)(t + 2) * kstep;
            const char* a3 = a2 + kstep; const char* b3 = b2 + kstep;
            PG8_LDB(B0, 0, 0); PG8_LDB(B1, 0, 1); PG8_SCHED; PG8_LDA(At, 0, 0); PG8_STAGE(PG8_SA(1, 1), a1, ca[1]);
            PG8_WAIT_V(8); PG8_WAIT_L(0); PG8_BAR; PG8_MMA(0, 0, At, B0); PG8_MMA(0, 1, At, B1); PG8_BAR; PG8_SCHED;
            if (last) {
#pragma unroll
                for (int h = 0; h < 2; ++h)
#pragma unroll
                    for (int i = 0; i < 2; ++i) ca[h][i] = na[h][i];
            }
            PG8_LDA(At, 0, 1); PG8_STAGE(PG8_SB(0, 0), b2, voffB); PG8_STAGE(PG8_SB(0, 1), b2 + hstep, voffB); PG8_STAGE(PG8_SA(0, 0), a2, ca[0]);
            PG8_WAIT_V(8); PG8_WAIT_L(0); PG8_BAR; PG8_MMA(1, 0, At, B0); PG8_MMA(1, 1, At, B1); PG8_BAR; PG8_SCHED;
            PG8_LDB(B0, 1, 0); PG8_LDB(B1, 1, 1); PG8_SCHED; PG8_LDA(At, 1, 0); PG8_STAGE(PG8_SA(0, 1), a2, ca[1]);
            PG8_WAIT_V(8); PG8_WAIT_L(0); PG8_BAR; PG8_MMA(0, 0, At, B0); PG8_MMA(0, 1, At, B1); PG8_BAR; PG8_SCHED;
            PG8_LDA(At, 1, 1); PG8_STAGE(PG8_SB(1, 0), b3, voffB); PG8_STAGE(PG8_SB(1, 1), b3 + hstep, voffB); PG8_STAGE(PG8_SA(1, 0), a3, ca[0]);
            PG8_WAIT_V(8); PG8_WAIT_L(0); PG8_BAR; PG8_MMA(1, 0, At, B0); PG8_MMA(1, 1, At, B1); PG8_BAR; PG8_SCHED;
        }
        if (wr == 0) PG8_BAR;
        { int tz = tid; asm volatile("" : "+v"(tz));
          const int l2 = tz & 63, w2 = __builtin_amdgcn_readfirstlane(tz >> 6); E(acc, cur, w2 >> 2, w2 & 3, l2 & 15, l2 >> 4); }
        if (!has_next) break;
#pragma unroll
        for (int a = 0; a < 2; ++a)
#pragma unroll
            for (int b = 0; b < 2; ++b)
#pragma unroll
                for (int m = 0; m < 4; ++m)
#pragma unroll
                    for (int n = 0; n < 2; ++n) acc[a][b][m][n] = (f32x4){0.f, 0.f, 0.f, 0.f};
        cur = nxt; cB = nB; ++ui;
        if (wr == 1) PG8_BAR;
    }
    PG8_WAIT_V(0);
    PG8_BAR;
#undef PG8_SA
#undef PG8_SB
#undef PG8_STAGE
#undef PG8_LDA
#undef PG8_LDB
#undef PG8_MMA
#undef PG8_WAIT_V
#undef PG8_WAIT_L
#undef PG8_BAR
#undef PG8_SCHED
}
}

#define XB_TMO      128
#define XB_XCNT(j)  (256  + 64 * (j))
#define XB_XSUB(j)  (1280 + 64 * (j))
#define XB_XGEN(j)  (2304 + 64 * (j))
#define XB_TOP      3328
#define XB_TOPGEN   3392
#define XCD_BAR_WORDS 3456
#define XB_SPIN_CAP (1u << 18)
__device__ __forceinline__ unsigned xb_ld(unsigned* p)              { return __hip_atomic_load(p, __ATOMIC_RELAXED, __HIP_MEMORY_SCOPE_AGENT); }
__device__ __forceinline__ unsigned xb_add(unsigned* p, unsigned v) { return __hip_atomic_fetch_add(p, v, __ATOMIC_RELAXED, __HIP_MEMORY_SCOPE_AGENT); }
__device__ __forceinline__ unsigned xb_xcc_id() { return (unsigned)__builtin_amdgcn_s_getreg((3 << 11) | 20) & 0xFu; }
#define XB_SPIN(cond, bar) do { unsigned _sp = 0; while (cond) { __builtin_amdgcn_s_sleep(1); \
    if ((++_sp & 255u) == 0u) { if (xb_ld(&(bar)[XB_TMO])) break; if (_sp > XB_SPIN_CAP) { atomicAdd(&(bar)[XB_TMO], 1u); break; } } } } while (0)
struct XcdBarrier { unsigned* bar; unsigned x; volatile LAS unsigned* st; };
__device__ __forceinline__ XcdBarrier xcd_barrier_post(unsigned* bar, volatile LAS unsigned* st) {
    XcdBarrier b; b.bar = bar; b.x = xb_xcc_id(); b.st = st;
    if (threadIdx.x == 0) (void)xb_add(&bar[XB_XCNT(b.x)], 1u);
    return b;
}
__device__ __forceinline__ void xcd_barrier_complete(unsigned* bar, unsigned x, unsigned& nloc, unsigned& nx) {
    const unsigned G = gridDim.x * gridDim.y * gridDim.z;
    unsigned sum, cnt, mine, sp = 0u;
    for (;;) {
        sum = 0u; cnt = 0u; mine = 0u;
#pragma unroll
        for (unsigned j = 0; j < 16; ++j) { const unsigned c = xb_ld(&bar[XB_XCNT(j)]); sum += c; cnt += (c > 0u) ? 1u : 0u; mine = (j == x) ? c : mine; }
        if (sum == G) break;
        __builtin_amdgcn_s_sleep(1);
        if ((++sp & 255u) == 0u) { if (xb_ld(&bar[XB_TMO])) break; if (sp > XB_SPIN_CAP) { atomicAdd(&bar[XB_TMO], 1u); break; } }
    }
    nloc = mine > 0u ? mine : 1u; nx = cnt > 0u ? cnt : 1u;
}
__device__ __forceinline__ void xcd_barrier(const XcdBarrier& b) {
    asm volatile("s_waitcnt vmcnt(0)" ::: "memory");
    __syncthreads();
    if (threadIdx.x == 0) {
        unsigned* bar = b.bar;
        __builtin_amdgcn_s_waitcnt(0);
        unsigned nloc = b.st[0], nx = b.st[1];
        if (nloc == 0u) { xcd_barrier_complete(bar, b.x, nloc, nx); b.st[0] = nloc; b.st[1] = nx; }
        const unsigned old = xb_add(&bar[XB_XSUB(b.x)], 1u);
        const unsigned gen = old / nloc;
        if (old + 1u == (gen + 1u) * nloc) {
            __builtin_amdgcn_fence(__ATOMIC_RELEASE, "agent");
            asm volatile("s_waitcnt vmcnt(0)" ::: "memory");
            const unsigned og = xb_add(&bar[XB_TOP], 1u);
            const unsigned tg = og / nx;
            if (og + 1u == (tg + 1u) * nx) xb_add(&bar[XB_TOPGEN], 1u);
            else XB_SPIN(xb_ld(&bar[XB_TOPGEN]) == tg, bar);
            __builtin_amdgcn_fence(__ATOMIC_ACQUIRE, "agent");
            xb_add(&bar[XB_XGEN(b.x)], 1u);
            asm volatile("s_waitcnt vmcnt(0)" ::: "memory");
        } else {
            XB_SPIN(xb_ld(&bar[XB_XGEN(b.x)]) == gen, bar);
            __builtin_amdgcn_fence(__ATOMIC_ACQUIRE, "agent");
            asm volatile("s_waitcnt vmcnt(0)" ::: "memory");
        }
    }
    __syncthreads();
}

struct Args {
    const float* in[21];
    float* out; unsigned char* ws;
    int ph_lo, ph_hi, flags, pad;
};
enum { I_X = 0, I_META, I_RELB, I_NMIX, I_WIN, I_BGATE, I_WAO, I_CONVW, I_CONVB, I_LNG, I_LNB, I_WCO, I_WOUT, I_NFFN, I_WR, I_BR, I_WUG, I_BUG, I_WD, I_BD, I_NFIN };

struct Frame {
    LAS unsigned char* lds;
    unsigned char* ws;
    int tid, lane, wave;
    int G, bid;
};
template <class T> __device__ __forceinline__ T* wsp(unsigned char* ws, size_t off) { return (T*)(ws + off); }

struct P0Desc { const float* src; bf16_t* dst; int ldn, ldk; };
__device__ __forceinline__ void p0_load(const P0Desc& d, f32x4 (&v)[16], int lane) {
    const float* p = d.src + (size_t)(lane >> 4) * d.ldn + (lane & 15) * 4;
#pragma unroll
    for (int i = 0; i < 16; ++i) v[i] = *(const f32x4*)(p + (size_t)(4 * i) * d.ldn);
}
__device__ __forceinline__ void p0_store(const P0Desc& d, const f32x4 (&v)[16], LAS float* scr, int lane) {
    const int n4 = (lane & 15) * 4, kr = lane >> 4;
#pragma unroll
    for (int i = 0; i < 16; ++i) { LAS float* p = scr + (4 * i + kr) * 65 + n4; p[0] = v[i][0]; p[1] = v[i][1]; p[2] = v[i][2]; p[3] = v[i][3]; }
    LDS_WAIT(); asm volatile("" ::: "memory");
    const int c = lane & 7;
#pragma unroll
    for (int j = 0; j < 8; ++j) { const int n = (lane >> 3) + 8 * j; const LAS float* s = scr + (8 * c) * 65 + n;
        u32x4 o; o.x = cvt_pk_bf16(s[0 * 65], s[1 * 65]); o.y = cvt_pk_bf16(s[2 * 65], s[3 * 65]); o.z = cvt_pk_bf16(s[4 * 65], s[5 * 65]); o.w = cvt_pk_bf16(s[6 * 65], s[7 * 65]);
        *(u32x4*)(d.dst + (size_t)n * d.ldk + 8 * c) = o; }
    LDS_WAIT(); asm volatile("" ::: "memory");
}
__device__ __forceinline__ void rms_row_to_bf16(const float* __restrict__ xrow, const float* __restrict__ g, bf16_t* __restrict__ orow, int lane) {
    const f32x4* xr = (const f32x4*)xrow + lane; const f32x4* gr = (const f32x4*)g + lane;
    f32x4 v[4]; float s = 0.f;
#pragma unroll
    for (int j = 0; j < 4; ++j) { v[j] = xr[64 * j]; s += (v[j].x * v[j].x + v[j].y * v[j].y) + (v[j].z * v[j].z + v[j].w * v[j].w); }
    const float r = 1.0f / sqrtf(wave_sum(s) * (1.f / DM) + EPS);
    unsigned long long* o8 = (unsigned long long*)orow + lane;
#pragma unroll
    for (int j = 0; j < 4; ++j) { const f32x4 gg = gr[64 * j];
        o8[64 * j] = (unsigned long long)cvt_pk_bf16(v[j].x * r * gg.x, v[j].y * r * gg.y) | ((unsigned long long)cvt_pk_bf16(v[j].z * r * gg.z, v[j].w * r * gg.w) << 32); }
}
__device__ __forceinline__ void p0_prologue(Frame& F, const Args& a) {
    LAS float* scr = (LAS float*)(F.lds + F.wave * 16896);
    const int gw = F.bid * NWAVES + F.wave, NGW = F.G * NWAVES;
    unsigned char* ws = F.ws;
    constexpr int T_IN = 81 * 16, T_AO = 16 * 8, T_CO = 16 * 8, T_OUT = 16 * 16, T_SMALL = T_IN + T_AO + T_CO + T_OUT;
    constexpr int T_UG = NE * 32 * 16, T_D = NE * 16 * 16, T_ALL = T_SMALL + T_UG + T_D;
    auto desc = [&](int it) -> P0Desc {
        int r = it; P0Desc d;
        if (r < T_IN) { const int g = r / 16, kb = r % 16; const int dr = g * 64; int sc;
            if (dr < WR_GLU) sc = dr;
            else if (dr < WR_GATE) { const int q = dr - WR_GLU, tile = q >> 8, hf = (q >> 7) & 1, w = q & 127; sc = SC_GLU + 512 * hf + 128 * tile + w; }
            else if (dr < WR_IK) sc = SC_GATE + (dr - WR_GATE);
            else sc = SC_IK + (dr - WR_IK);
            d.src = a.in[I_WIN] + (size_t)(kb * 64) * INCOLS + sc; d.ldn = INCOLS; d.dst = wsp<bf16_t>(ws, WS_WIN) + (size_t)dr * DM + kb * 64; d.ldk = DM; return d; }
        r -= T_IN;
        if (r < T_AO) { const int g = r / 8, kb = r % 8; d.src = a.in[I_WAO] + (size_t)(kb * 64) * DM + g * 64; d.ldn = DM; d.dst = wsp<bf16_t>(ws, WS_WAO) + (size_t)(g * 64) * AW + kb * 64; d.ldk = AW; return d; }
        r -= T_AO;
        if (r < T_CO) { const int g = r / 8, kb = r % 8; d.src = a.in[I_WCO] + (size_t)(kb * 64) * DM + g * 64; d.ldn = DM; d.dst = wsp<bf16_t>(ws, WS_WCO) + (size_t)(g * 64) * CC + kb * 64; d.ldk = CC; return d; }
        r -= T_CO;
        if (r < T_OUT) { const int g = r / 16, kb = r % 16; d.src = a.in[I_WOUT] + (size_t)(kb * 64) * DM + g * 64; d.ldn = DM; d.dst = wsp<bf16_t>(ws, WS_WOUT) + (size_t)(g * 64) * DM + kb * 64; d.ldk = DM; return d; }
        r -= T_OUT;
        if (r < T_UG) { const int e = r / 512, q = r % 512, g = q % 32, kb = q / 32; const int dr = g * 64, tile = dr >> 8, hf = (dr >> 7) & 1, w = dr & 127;
            d.src = a.in[I_WUG] + (size_t)e * DM * 2 * DFF + (size_t)(kb * 64) * (2 * DFF) + DFF * hf + 128 * tile + w; d.ldn = 2 * DFF;
            d.dst = wsp<bf16_t>(ws, WS_WUG) + (size_t)e * 2 * DFF * DM + (size_t)dr * DM + kb * 64; d.ldk = DM; return d; }
        r -= T_UG;
        { const int e = r / 256, q = r % 256, g = q % 16, kb = q / 16;
            d.src = a.in[I_WD] + (size_t)e * DFF * DM + (size_t)(kb * 64) * DM + g * 64; d.ldn = DM; d.dst = wsp<bf16_t>(ws, WS_WD) + (size_t)e * DM * DFF + (size_t)(g * 64) * DFF + kb * 64; d.ldk = DFF; return d; }
    };
    if (gw < T_ALL) {
        f32x4 va[16], vb[16];
        P0Desc da = desc(gw), db = da;
        p0_load(da, va, F.lane);
        for (int it = gw; it < T_ALL; it += 2 * NGW) {
            const int i1 = it + NGW, i2 = it + 2 * NGW;
            db = desc(i1 < T_ALL ? i1 : it); p0_load(db, vb, F.lane);
            p0_store(da, va, scr, F.lane);
            da = desc(i2 < T_ALL ? i2 : it); p0_load(da, va, F.lane);
            if (i1 < T_ALL) p0_store(db, vb, scr, F.lane);
        }
    }
    { const int gt = F.bid * NTHREADS + F.tid;
      if (gt < 8 * DM / 2) { const int n = gt >> 9, k = (gt & 511) * 2; const float v0 = a.in[I_WIN][(size_t)k * INCOLS + SC_IW + n], v1 = a.in[I_WIN][(size_t)(k + 1) * INCOLS + SC_IW + n];
          *(unsigned*)(wsp<bf16_t>(ws, WS_WIN) + (size_t)(WR_IW + n) * DM + k) = cvt_pk_bf16(v0, v1); } }
    { const int gt = F.bid * NTHREADS + F.tid;
      if (gt < NE * DM / 2) { const int e = gt >> 9, d = (gt & 511) * 2; const float v0 = a.in[I_NFFN][d] * a.in[I_WR][(size_t)d * NE + e], v1 = a.in[I_NFFN][d + 1] * a.in[I_WR][(size_t)(d + 1) * NE + e];
          const unsigned hi = cvt_pk_bf16(v0, v1); const unsigned lo = cvt_pk_bf16(v0 - bflo(hi), v1 - bfhi(hi));
          *(unsigned*)(wsp<bf16_t>(ws, WS_WRT) + (size_t)e * DM + d) = hi; *(unsigned*)(wsp<bf16_t>(ws, WS_WRT) + (size_t)(NE + e) * DM + d) = lo; } }
    for (int m = gw; m < NTOK + NMETA; m += NGW) {
        if (m < NTOK) rms_row_to_bf16(a.in[I_X] + (size_t)m * DM, a.in[I_NMIX], wsp<bf16_t>(ws, WS_XN) + (size_t)m * DM, F.lane);
        else rms_row_to_bf16(a.in[I_META] + (size_t)(m - NTOK) * DM, a.in[I_NMIX], wsp<bf16_t>(ws, WS_XNM) + (size_t)(m - NTOK) * DM, F.lane);
    }
}

struct PlainSched {
    const char* ws; unsigned a_off, b_off; int K, nM, nN, nwg, G, c;
    __device__ __forceinline__ void init(const unsigned char* ws_, size_t a, size_t b, int M, int N, int K_, int G_, int c_) { ws = (const char*)ws_; a_off = (unsigned)a; b_off = (unsigned)b; K = K_; nM = M / 256; nN = N / 256; nwg = nM * nN; G = G_; c = c_; }
    __device__ __forceinline__ bool next(int i, pg8::Unit& u) const {
        const long L = (long)i * G + c; if (L >= nwg) return false;
        int wgid = (int)L; { const int q = nwg / 8, r = nwg % 8, xcd = wgid % 8, off = wgid / 8; wgid = (xcd < r ? xcd * (q + 1) : r * (q + 1) + (xcd - r) * q) + off; }
        const int nig = 8 * nN, gid = wgid / nig, fm = gid * 8, gsz = (nM - fm) < 8 ? (nM - fm) : 8;
        u.pm = fm + ((wgid % nig) % gsz); u.pn = (wgid % nig) / gsz; u.z = 0; return true;
    }
    __device__ __forceinline__ const char* a_base() const { return ws; }
    __device__ __forceinline__ void a_offs(const pg8::Unit& u, int tid, unsigned (&o)[2][2]) const {
        int R[2], C[2]; pg8::stage_rc(tid * 16, R[0], C[0]); pg8::stage_rc(tid * 16 + 8192, R[1], C[1]);
#pragma unroll
        for (int h = 0; h < 2; ++h)
#pragma unroll
            for (int i = 0; i < 2; ++i) o[h][i] = a_off + (unsigned)(((u.pm * 256 + h * 128 + R[i]) * K + C[i]) * 2);
    }
    __device__ __forceinline__ const char* b_base(const pg8::Unit& u) const { return ws + b_off + (size_t)u.pn * 256 * K * 2; }
};
struct MergeSched {
    const char* ws; int G, c;
    __device__ __forceinline__ bool next(int i, pg8::Unit& u) const {
        const int t = c + (i >> 1) * G;
        if (t >= 256) return false;
        u.pm = (t & 7) + 8 * (t >> 5); u.pn = (t >> 3) & 3; u.z = i & 1; return true;
    }
    __device__ __forceinline__ const char* a_base() const { return ws; }
    __device__ __forceinline__ void a_offs(const pg8::Unit& u, int tid, unsigned (&o)[2][2]) const {
        int R[2], C[2]; pg8::stage_rc(tid * 16, R[0], C[0]); pg8::stage_rc(tid * 16 + 8192, R[1], C[1]);
        const unsigned base = (unsigned)(u.z ? WS_CO : WS_AO);
#pragma unroll
        for (int h = 0; h < 2; ++h)
#pragma unroll
            for (int i = 0; i < 2; ++i) o[h][i] = base + (unsigned)(((u.pm * 256 + h * 128 + R[i]) * 512 + C[i]) * 2);
    }
    __device__ __forceinline__ const char* b_base(const pg8::Unit& u) const { return ws + (u.z ? WS_WCO : WS_WAO) + (size_t)u.pn * 256 * 512 * 2; }
};
struct MoeTables { const LAS int* cnt; const LAS int* tbase; };
template <int NC, bool GATHER>
struct MoeSched {
    const char* ws; MoeTables T; int G, c, total;
    __device__ __forceinline__ bool next(int i, pg8::Unit& u) const {
        const long L = (long)i * G + c; if (L >= total) return false;
        int wgid = (int)L; { const int q = total / 8, r = total % 8, xcd = wgid % 8, off = wgid / 8; wgid = (xcd < r ? xcd * (q + 1) : r * (q + 1) + (xcd - r) * q) + off; }
        int e = 0;
        for (int j = 1; j < NE; ++j) e += (wgid >= __builtin_amdgcn_readfirstlane(T.tbase[j]) * NC) ? 1 : 0;
        e = __builtin_amdgcn_readfirstlane(e);
        const int tb0 = __builtin_amdgcn_readfirstlane(T.tbase[e]), tb1 = __builtin_amdgcn_readfirstlane(T.tbase[e + 1]);
        const int loc = wgid - tb0 * NC, nt_e = tb1 - tb0;
        u.z = e; u.pm = loc % nt_e; u.pn = loc / nt_e; return true;
    }
    __device__ __forceinline__ const char* a_base() const { return ws; }
    __device__ __forceinline__ void a_offs(const pg8::Unit& u, int tid, unsigned (&o)[2][2]) const {
        int R[2], C[2]; pg8::stage_rc(tid * 16, R[0], C[0]); pg8::stage_rc(tid * 16 + 8192, R[1], C[1]);
        if (GATHER) {
            const int* list = (const int*)(ws + WS_LIST) + (size_t)u.z * NTOK; const int n = __builtin_amdgcn_readfirstlane(T.cnt[u.z]);
#pragma unroll
            for (int h = 0; h < 2; ++h)
#pragma unroll
                for (int i = 0; i < 2; ++i) { const int p = u.pm * 256 + h * 128 + R[i]; const int tok = (p < n) ? list[p] : 0; o[h][i] = (unsigned)WS_XN + (unsigned)((tok * DM + C[i]) * 2); }
        } else {
            const int row0 = (__builtin_amdgcn_readfirstlane(T.tbase[u.z]) + u.pm) * 256;
#pragma unroll
            for (int h = 0; h < 2; ++h)
#pragma unroll
                for (int i = 0; i < 2; ++i) o[h][i] = (unsigned)WS_ACT + (unsigned)(((row0 + h * 128 + R[i]) * DFF + C[i]) * 2);
        }
    }
    __device__ __forceinline__ const char* b_base(const pg8::Unit& u) const {
        if (GATHER) return ws + WS_WUG + ((size_t)u.z * 2 * DFF + (size_t)u.pn * 256) * DM * 2;
        else return ws + WS_WD + ((size_t)u.z * DM + (size_t)u.pn * 256) * DFF * 2;
    }
};

#define EPI_ROWS(ai, m) for (int ai = 0; ai < 2; ++ai) _Pragma("unroll") for (int m = 0; m < 4; ++m)
#define EPI_COLS(bj, n) for (int bj = 0; bj < 2; ++bj) _Pragma("unroll") for (int n = 0; n < 2; ++n)
__device__ __forceinline__ void st_bf16x4(bf16_t* p, f32x4 v) { u32x2 w; w.x = cvt_pk_bf16(v[0], v[1]); w.y = cvt_pk_bf16(v[2], v[3]); *(u32x2*)p = w; }

struct EpiInProj {
    unsigned char* ws; const float* bgate;
    __device__ __forceinline__ void operator()(const f32x4 (&acc)[2][2][4][2], const pg8::Unit& u, int wr, int wc, int fr, int fq) const {
        const int pn = u.pn, row0 = u.pm * 256 + wr * 64 + fr, col0 = wc * 32 + 4 * fq;
        const int bidx = u.pm >> 3;
        const int rowk0 = row0 + NMETA * (bidx + 1);
        if (pn < 2 || (pn >= 6 && pn < 8)) {
            bf16_t* O = wsp<bf16_t>(ws, pn < 2 ? WS_Q : WS_IQ); const int cb = (pn & 1) * 256; const float sc = pn < 2 ? QSCALE : 1.0f;
#pragma unroll
            EPI_ROWS(ai, m) { bf16_t* rp = O + (size_t)(row0 + ai * 128 + m * 16) * AW + cb + col0;
#pragma unroll
                EPI_COLS(bj, n) st_bf16x4(rp + bj * 128 + n * 16, acc[ai][bj][m][n] * sc); }
        } else if (pn < 4) {
            bf16_t* O = wsp<bf16_t>(ws, WS_KB); const int cb = (pn & 1) * 256;
#pragma unroll
            EPI_ROWS(ai, m) { bf16_t* rp = O + (size_t)(rowk0 + ai * 128 + m * 16) * AW + cb + col0;
#pragma unroll
                EPI_COLS(bj, n) st_bf16x4(rp + bj * 128 + n * 16, acc[ai][bj][m][n]); }
        } else if (pn < 6) {
            bf16_t* O = wsp<bf16_t>(ws, WS_VT) + (size_t)bidx * AW * TP; const int cb = (pn & 1) * 256;
            const int t0 = (row0 & (SEQ - 1)) + NMETA + VOFF;
#pragma unroll
            EPI_ROWS(ai, m) { const int t = t0 + ai * 128 + m * 16;
#pragma unroll
                EPI_COLS(bj, n) { const f32x4 v = acc[ai][bj][m][n]; bf16_t* cp = O + (size_t)(cb + col0 + bj * 128 + n * 16) * TP + (t & ~1);
                    const float p0 = __shfl_xor(v[0], 1), p1 = __shfl_xor(v[1], 1), p2 = __shfl_xor(v[2], 1), p3 = __shfl_xor(v[3], 1);
                    if ((fr & 1) == 0) { *(unsigned*)(cp) = cvt_pk_bf16(v[0], p0); *(unsigned*)(cp + TP) = cvt_pk_bf16(v[1], p1); }
                    else { *(unsigned*)(cp + 2 * TP) = cvt_pk_bf16(p2, v[2]); *(unsigned*)(cp + 3 * TP) = cvt_pk_bf16(p3, v[3]); } } }
        } else if (pn < 12) {
            bf16_t* O = wsp<bf16_t>(ws, WS_GLU); const int cb = (pn - 8) * 128;
#pragma unroll
            EPI_ROWS(ai, m) { bf16_t* rp = O + (size_t)(rowk0 + ai * 128 + m * 16) * CC + cb + col0;
#pragma unroll
                for (int n = 0; n < 2; ++n) { const f32x4 av = acc[ai][0][m][n], gv = acc[ai][1][m][n]; f32x4 y;
#pragma unroll
                    for (int j = 0; j < 4; ++j) y[j] = av[j] * sigmoidf_(gv[j]);
                    st_bf16x4(rp + n * 16, y); } }
        } else {
            const int gt = pn - 12; bf16_t* O = wsp<bf16_t>(ws, gt < 4 ? WS_GA : WS_GB); const int cb = (gt & 3) * 256; const float* bp = bgate + gt * 256 + col0;
            f32x4 bv[2][2];
#pragma unroll
            EPI_COLS(bj, n) bv[bj][n] = *(const f32x4*)(bp + bj * 128 + n * 16);
#pragma unroll
            EPI_ROWS(ai, m) { bf16_t* rp = O + (size_t)(row0 + ai * 128 + m * 16) * DM + cb + col0;
#pragma unroll
                EPI_COLS(bj, n) { const f32x4 x = acc[ai][bj][m][n] + bv[bj][n]; f32x4 y;
#pragma unroll
                    for (int j = 0; j < 4; ++j) y[j] = sigmoidf_(x[j]);
                    st_bf16x4(rp + bj * 128 + n * 16, y); } }
        }
    }
};
struct EpiMerge {
    unsigned char* ws;
    __device__ __forceinline__ void operator()(const f32x4 (&acc)[2][2][4][2], const pg8::Unit& u, int wr, int wc, int fr, int fq) const {
        const int row0 = u.pm * 256 + wr * 64 + fr, col0 = u.pn * 256 + wc * 32 + 4 * fq;
        const bf16_t* Gt = wsp<bf16_t>(ws, u.z ? WS_GB : WS_GA); bf16_t* O = wsp<bf16_t>(ws, WS_MG);
#pragma unroll
        EPI_ROWS(ai, m) { const size_t ro = (size_t)(row0 + ai * 128 + m * 16) * DM + col0;
#pragma unroll
            EPI_COLS(bj, n) { const size_t o = ro + bj * 128 + n * 16; const u32x2 g = *(const u32x2*)(Gt + o); const f32x4 a = acc[ai][bj][m][n];
                f32x4 y = (f32x4){bflo(g.x) * a[0], bfhi(g.x) * a[1], bflo(g.y) * a[2], bfhi(g.y) * a[3]};
                if (u.z) { const u32x2 p = *(const u32x2*)(O + o); y[0] += bflo(p.x); y[1] += bfhi(p.x); y[2] += bflo(p.y); y[3] += bfhi(p.y); }
                st_bf16x4(O + o, y); } }
    }
};
struct EpiResid {
    const float* x; float* out;
    __device__ __forceinline__ void operator()(const f32x4 (&acc)[2][2][4][2], const pg8::Unit& u, int wr, int wc, int fr, int fq) const {
        const int row0 = u.pm * 256 + wr * 64 + fr, col0 = u.pn * 256 + wc * 32 + 4 * fq;
#pragma unroll
        EPI_ROWS(ai, m) { const size_t ro = (size_t)(row0 + ai * 128 + m * 16) * DM + col0;
#pragma unroll
            EPI_COLS(bj, n) { const size_t o = ro + bj * 128 + n * 16; *(f32x4*)(out + o) = *(const f32x4*)(x + o) + acc[ai][bj][m][n]; } }
    }
};
struct EpiSwiglu {
    unsigned char* ws; const float* bug; MoeTables T;
    __device__ __forceinline__ void operator()(const f32x4 (&acc)[2][2][4][2], const pg8::Unit& u, int wr, int wc, int fr, int fq) const {
        const int e = u.z, n_e = __builtin_amdgcn_readfirstlane(T.cnt[e]), rloc0 = u.pm * 256 + wr * 64 + fr, row0 = __builtin_amdgcn_readfirstlane(T.tbase[e]) * 256 + rloc0, col0 = u.pn * 128 + wc * 32 + 4 * fq;
        const float* bp = bug + (size_t)e * 2 * DFF + col0; bf16_t* O = wsp<bf16_t>(ws, WS_ACT); const float* rg = wsp<float>(ws, WS_RG) + (size_t)e * NTOK;
        f32x4 bg[2], bu[2];
#pragma unroll
        for (int n = 0; n < 2; ++n) { bg[n] = *(const f32x4*)(bp + n * 16); bu[n] = *(const f32x4*)(bp + DFF + n * 16); }
#pragma unroll
        EPI_ROWS(ai, m) { const int rl = rloc0 + ai * 128 + m * 16; if (rl < n_e) { bf16_t* rp = O + (size_t)(row0 + ai * 128 + m * 16) * DFF + col0; const float rv = rg[rl];
#pragma unroll
                for (int n = 0; n < 2; ++n) { const f32x4 gv = acc[ai][0][m][n] * rv + bg[n], uv = acc[ai][1][m][n] * rv + bu[n]; f32x4 y;
#pragma unroll
                    for (int j = 0; j < 4; ++j) { const float g = fminf(gv[j], 7.0f), up = fminf(fmaxf(uv[j], -7.0f), 7.0f); y[j] = (up + 1.0f) * g * sigmoidf_(1.702f * g); }
                    st_bf16x4(rp + n * 16, y); } } }
    }
};
struct EpiDown {
    unsigned char* ws; const float* bd; MoeTables T;
    __device__ __forceinline__ void operator()(const f32x4 (&acc)[2][2][4][2], const pg8::Unit& u, int wr, int wc, int fr, int fq) const {
        const int e = u.z, n_e = __builtin_amdgcn_readfirstlane(T.cnt[e]), rloc0 = u.pm * 256 + wr * 64 + fr, row0 = __builtin_amdgcn_readfirstlane(T.tbase[e]) * 256 + rloc0, col0 = u.pn * 256 + wc * 32 + 4 * fq;
        const float* bp = bd + (size_t)e * DM + col0; bf16_t* O = wsp<bf16_t>(ws, WS_YP); const float* lg = wsp<float>(ws, WS_LG) + (size_t)e * NTOK;
        f32x4 bv[2][2];
#pragma unroll
        EPI_COLS(bj, n) bv[bj][n] = *(const f32x4*)(bp + bj * 128 + n * 16);
#pragma unroll
        EPI_ROWS(ai, m) { const int rl = rloc0 + ai * 128 + m * 16; if (rl < n_e) { const float gt = lg[rl]; bf16_t* rp = O + (size_t)(row0 + ai * 128 + m * 16) * DM + col0;
#pragma unroll
                EPI_COLS(bj, n) st_bf16x4(rp + bj * 128 + n * 16, (acc[ai][bj][m][n] + bv[bj][n]) * gt); } }
    }
};

template <int NT>
__device__ __forceinline__ void wave_mm16(const bf16_t* __restrict__ A, int lda, const bf16_t* const (&Bt)[NT], int K, int lane, f32x4 (&acc)[NT]) {
    const bf16_t* ap = A + (size_t)(lane & 15) * lda + 8 * (lane >> 4);
    const bf16_t* bp[NT];
#pragma unroll
    for (int t = 0; t < NT; ++t) { bp[t] = Bt[t] + (size_t)(lane & 15) * K + 8 * (lane >> 4); acc[t] = (f32x4){0.f, 0.f, 0.f, 0.f}; }
#pragma unroll (NT == 1 ? 16 : 8)
    for (int k0 = 0; k0 < K; k0 += 32) {
        const bf16x8 a = *(const bf16x8*)(ap + k0);
#pragma unroll
        for (int t = 0; t < NT; ++t) { const bf16x8 b = *(const bf16x8*)(bp[t] + k0); acc[t] = __builtin_amdgcn_mfma_f32_16x16x32_bf16(b, a, acc[t], 0, 0, 0); }
    }
}
__device__ __forceinline__ void p1_thin(Frame& F, int dbgflags) {
    unsigned char* ws = F.ws;
    const bf16_t* WIN = wsp<bf16_t>(ws, WS_WIN); const bf16_t* XN = wsp<bf16_t>(ws, WS_XN); const bf16_t* XNM = wsp<bf16_t>(ws, WS_XNM);
    bf16_t* KB = wsp<bf16_t>(ws, WS_KB); bf16_t* VT = wsp<bf16_t>(ws, WS_VT); bf16_t* IK = wsp<bf16_t>(ws, WS_IK); bf16_t* GLU = wsp<bf16_t>(ws, WS_GLU); float* IW = wsp<float>(ws, WS_IW);
    const int gw = F.bid * NWAVES + F.wave, NGW = F.G * NWAVES, lane = F.lane, tk = lane & 15, nq = lane >> 4;
    {
        constexpr int WBP = 2064;
        LAS unsigned char* lds = F.lds;
        __syncthreads();
        { const unsigned char* src = (const unsigned char*)(WIN + (size_t)WR_IK * DM);
          for (int p = F.tid; p < 72 * 128; p += NTHREADS) { const int row = p >> 7, c16 = p & 127; *(LAS u32x4*)(lds + row * WBP + c16 * 16) = *(const u32x4*)(src + (size_t)row * DM * 2 + c16 * 16); } }
        __syncthreads();
        const int tg = F.wave & 3, hf = F.wave >> 2, kq = nq;
        for (int tb = F.bid; tb < NTOK / 64; tb += F.G) {
            const int m = tb * 64 + 16 * tg + tk, rowk = m + NMETA * ((m >> 11) + 1);
            const bf16_t* xr = XN + (size_t)m * DM + 16 * kq;
            bf16x8 xa[16], xb[16];
#pragma unroll
            for (int sblk = 0; sblk < 16; ++sblk) { xa[sblk] = *(const bf16x8*)(xr + 64 * sblk); xb[sblk] = *(const bf16x8*)(xr + 64 * sblk + 8); }
            const LAS unsigned char* wb = lds + tk * WBP + 32 * kq;
            if (hf == 0) {
                f32x4 acc[3] = {{0.f, 0.f, 0.f, 0.f}, {0.f, 0.f, 0.f, 0.f}, {0.f, 0.f, 0.f, 0.f}};
#pragma unroll
                for (int sblk = 0; sblk < 16; ++sblk)
#pragma unroll
                    for (int t = 0; t < 3; ++t) { const bf16x8 b0 = *(const LAS bf16x8*)(wb + 16 * t * WBP + 128 * sblk), b1 = *(const LAS bf16x8*)(wb + 16 * t * WBP + 128 * sblk + 16);
                        acc[t] = __builtin_amdgcn_mfma_f32_16x16x32_bf16(b0, xa[sblk], acc[t], 0, 0, 0); acc[t] = __builtin_amdgcn_mfma_f32_16x16x32_bf16(b1, xb[sblk], acc[t], 0, 0, 0); }
#pragma unroll
                for (int t = 0; t < 3; ++t) st_bf16x4(IK + (size_t)rowk * IDXD + 16 * t + 4 * nq, acc[t]);
            } else {
                f32x4 acc[2] = {{0.f, 0.f, 0.f, 0.f}, {0.f, 0.f, 0.f, 0.f}};
#pragma unroll
                for (int sblk = 0; sblk < 16; ++sblk)
#pragma unroll
                    for (int t = 0; t < 2; ++t) { const bf16x8 b0 = *(const LAS bf16x8*)(wb + 16 * (3 + t) * WBP + 128 * sblk), b1 = *(const LAS bf16x8*)(wb + 16 * (3 + t) * WBP + 128 * sblk + 16);
                        acc[t] = __builtin_amdgcn_mfma_f32_16x16x32_bf16(b0, xa[sblk], acc[t], 0, 0, 0); acc[t] = __builtin_amdgcn_mfma_f32_16x16x32_bf16(b1, xb[sblk], acc[t], 0, 0, 0); }
                st_bf16x4(IK + (size_t)rowk * IDXD + 48 + 4 * nq, acc[0]);
                if (nq < 2) *(f32x4*)(IW + (size_t)m * 8 + 4 * nq) = acc[1];
            }
        }
        __syncthreads();
    }
    if (!(dbgflags & 256)) for (int task = gw; task < 100; task += NGW) {
        if (task < 32) {
            const bf16_t* const Bt[1] = {WIN + (size_t)(SC_K + 16 * task) * DM}; f32x4 acc[1]; wave_mm16<1>(XNM, DM, Bt, DM, lane, acc);
            for (int b = 0; b < NB; ++b) st_bf16x4(KB + (size_t)(b * TT + tk) * AW + 16 * task + 4 * nq, acc[0]);
        } else if (task < 64) {
            const int t = task - 32; const bf16_t* const Bt[1] = {WIN + (size_t)(SC_V + 16 * t) * DM}; f32x4 acc[1]; wave_mm16<1>(XNM, DM, Bt, DM, lane, acc);
            const float p0 = __shfl_xor(acc[0][0], 1), p1 = __shfl_xor(acc[0][1], 1), p2 = __shfl_xor(acc[0][2], 1), p3 = __shfl_xor(acc[0][3], 1);
            const unsigned wa = (tk & 1) ? cvt_pk_bf16(p2, acc[0][2]) : cvt_pk_bf16(acc[0][0], p0), wb = (tk & 1) ? cvt_pk_bf16(p3, acc[0][3]) : cvt_pk_bf16(acc[0][1], p1);
            for (int b = 0; b < NB; ++b) { bf16_t* cp = VT + ((size_t)b * AW + 16 * t + 4 * nq + 2 * (tk & 1)) * TP + VOFF + (tk & ~1);
                *(unsigned*)cp = wa; *(unsigned*)(cp + TP) = wb; }
        } else if (task < 68) {
            const int t = task - 64; const bf16_t* const Bt[1] = {WIN + (size_t)(WR_IK + 16 * t) * DM}; f32x4 acc[1]; wave_mm16<1>(XNM, DM, Bt, DM, lane, acc);
            for (int b = 0; b < NB; ++b) st_bf16x4(IK + (size_t)(b * TT + tk) * IDXD + 16 * t + 4 * nq, acc[0]);
        } else {
            const int c16 = task - 68; const int ar = WR_GLU + 256 * (c16 >> 3) + 16 * (c16 & 7);
            const bf16_t* const Bt[2] = {WIN + (size_t)ar * DM, WIN + (size_t)(ar + 128) * DM}; f32x4 acc[2]; wave_mm16<2>(XNM, DM, Bt, DM, lane, acc);
            f32x4 y;
#pragma unroll
            for (int j = 0; j < 4; ++j) y[j] = acc[0][j] * sigmoidf_(acc[1][j]);
            for (int b = 0; b < NB; ++b) st_bf16x4(GLU + (size_t)(b * TT + tk) * CC + 16 * c16 + 4 * nq, y);
        }
    }
}

__device__ __forceinline__ void p2_conv(Frame& F, const Args& a) {
    unsigned char* ws = F.ws;
    LAS unsigned char* xs = F.lds;
    LAS float* wl = (LAS float*)(F.lds + 63488);
    const bf16_t* GLU = wsp<bf16_t>(ws, WS_GLU); bf16_t* CO = wsp<bf16_t>(ws, WS_CO);
    const float* cw = a.in[I_CONVW];
    for (int idx = F.tid; idx < CW * 128; idx += NTHREADS) { const int tap = idx >> 7, c4 = idx & 127; const f32x4 v = *(const f32x4*)(cw + tap * CC + 4 * c4); *(LAS f32x4*)(wl + tap * 512 + (c4 & 1) * 256 + (c4 >> 1) * 4) = v; }
    const int lane = F.lane, c0 = 8 * lane;
    for (int tile = F.bid; tile < NTOK / 32; tile += F.G) {
        const int b = tile >> 6, s0 = (tile & 63) * 32, p0 = NMETA + s0;
        __syncthreads();
        for (int idx = F.tid; idx < 62 * 64; idx += NTHREADS) { const int r = idx >> 6, ch = idx & 63, p = p0 - 30 + r; u32x4 v = (u32x4){0u, 0u, 0u, 0u};
            if (p >= 0) v = *(const u32x4*)(GLU + (size_t)(b * TT + p) * CC + ch * 8);
            *(LAS u32x4*)(xs + r * 1024 + ch * 16) = v; }
        __syncthreads();
        const int i0 = 4 * F.wave;
        float acc[4][8];
#pragma unroll
        for (int t = 0; t < 4; ++t)
#pragma unroll
            for (int i = 0; i < 8; ++i) acc[t][i] = 0.f;
        const LAS float* wlb = wl + lane * 4; asm volatile("" : "+v"(wlb));
        const LAS unsigned char* xsb = xs + i0 * 1024 + lane * 16; asm volatile("" : "+v"(xsb));
#pragma unroll 1
        for (int tap = 0; tap < CW; ++tap) {
            const f32x4 w0 = *(const LAS f32x4*)(wlb + tap * 512), w1 = *(const LAS f32x4*)(wlb + tap * 512 + 256);
#pragma unroll
            for (int t = 0; t < 4; ++t) {
                const u32x4 xv = *(const LAS u32x4*)(xsb + (tap + t) * 1024);
                acc[t][0] += w0[0] * bflo(xv.x); acc[t][1] += w0[1] * bfhi(xv.x); acc[t][2] += w0[2] * bflo(xv.y); acc[t][3] += w0[3] * bfhi(xv.y);
                acc[t][4] += w1[0] * bflo(xv.z); acc[t][5] += w1[1] * bfhi(xv.z); acc[t][6] += w1[2] * bflo(xv.w); acc[t][7] += w1[3] * bfhi(xv.w);
            }
        }
        float cb[8], lg[8], lb[8];
        { const f32x4* p0 = (const f32x4*)(a.in[I_CONVB] + c0); const f32x4* p1 = (const f32x4*)(a.in[I_LNG] + c0); const f32x4* p2 = (const f32x4*)(a.in[I_LNB] + c0);
#pragma unroll
          for (int hh = 0; hh < 2; ++hh) { const f32x4 u0 = p0[hh], u1 = p1[hh], u2 = p2[hh];
#pragma unroll
              for (int i = 0; i < 4; ++i) { cb[4 * hh + i] = u0[i]; lg[4 * hh + i] = u1[i]; lb[4 * hh + i] = u2[i]; } } }
#pragma unroll
        for (int t = 0; t < 4; ++t) {
            float s = 0.f;
#pragma unroll
            for (int i = 0; i < 8; ++i) { acc[t][i] += cb[i]; s += acc[t][i]; }
            const float mean = wave_sum(s) * (1.f / CC); float q = 0.f;
#pragma unroll
            for (int i = 0; i < 8; ++i) { acc[t][i] -= mean; q += acc[t][i] * acc[t][i]; }
            const float rstd = 1.0f / sqrtf(wave_sum(q) * (1.f / CC) + EPS);
            float y[8];
#pragma unroll
            for (int i = 0; i < 8; ++i) { const float z = acc[t][i] * rstd * lg[i] + lb[i]; y[i] = z * sigmoidf_(z); }
            u32x4 o; o.x = cvt_pk_bf16(y[0], y[1]); o.y = cvt_pk_bf16(y[2], y[3]); o.z = cvt_pk_bf16(y[4], y[5]); o.w = cvt_pk_bf16(y[6], y[7]);
            *(u32x4*)(CO + (size_t)(b * SEQ + s0 + i0 + t) * CC + c0) = o;
        }
    }
    __syncthreads();
}

constexpr int ROWP = 2080, NJ = 33;
__device__ __forceinline__ unsigned f2ord(float f) { const unsigned b = __float_as_uint(f); return b ^ ((b >> 31) ? 0xffffffffu : 0x80000000u); }
__device__ __forceinline__ int wave_isum(int v) {
#pragma unroll
    for (int o = 1; o < 64; o <<= 1) v += __shfl_xor(v, o);
    return v;
}
__device__ __forceinline__ int wave_isum_dpp(int v) {
    v += __builtin_amdgcn_update_dpp(0, v, 0xB1, 0xF, 0xF, false);
    v += __builtin_amdgcn_update_dpp(0, v, 0x4E, 0xF, 0xF, false);
    v += __builtin_amdgcn_update_dpp(0, v, 0x141, 0xF, 0xF, false);
    v += __builtin_amdgcn_update_dpp(0, v, 0x140, 0xF, 0xF, false);
    return __builtin_amdgcn_readlane(v, 0) + __builtin_amdgcn_readlane(v, 16) + __builtin_amdgcn_readlane(v, 32) + __builtin_amdgcn_readlane(v, 48);
}
__device__ __forceinline__ void p2_indexer_unit(Frame& F, int b, int q16, int flags) {
    unsigned char* ws = F.ws;
    const bf16_t* IQ = wsp<bf16_t>(ws, WS_IQ); const bf16_t* IK = wsp<bf16_t>(ws, WS_IK); const float* IW = wsp<float>(ws, WS_IW); unsigned* MASK = wsp<unsigned>(ws, WS_MASK);
    LAS unsigned* SU = (LAS unsigned*)F.lds;
    const int lane = F.lane, c = lane & 31, hi = lane >> 5, w = F.wave;
    const int nwblk = (q16 >> 1) + 2;
    if (!(flags & 4)) {
        const int tok0 = b * SEQ + 16 * q16;
        bf16x8 af[4][4]; f32x4 wq[4][4];
#pragma unroll
        for (int g = 0; g < 4; ++g) {
            const bf16_t* ap = IQ + (size_t)(tok0 + 4 * g + (c >> 3)) * AW + (c & 7) * IDXD + 8 * hi;
#pragma unroll
            for (int ks = 0; ks < 4; ++ks) af[g][ks] = *(const bf16x8*)(ap + 16 * ks);
#pragma unroll
            for (int q = 0; q < 4; ++q) wq[g][q] = *(const f32x4*)(IW + (size_t)(tok0 + 4 * g + q) * 8 + 4 * hi);
        }
        const int rel0 = NMETA + 16 * q16 + 2 * hi - c;
        const bf16_t* kp = IK + (size_t)(b * TT + c) * IDXD + 8 * hi;
        LAS unsigned* srow = SU + (2 * hi) * ROWP + c;
        bf16x8 bfr[4], bnx[4];
#pragma unroll
        for (int ks = 0; ks < 4; ++ks) { bfr[ks] = *(const bf16x8*)(kp + (size_t)(w < nwblk ? w : 0) * 32 * IDXD + 16 * ks); bnx[ks] = bfr[ks]; }
#pragma unroll
        for (int g = 0; g < 4; ++g) asm volatile("" :: "v"(af[g][0]), "v"(af[g][1]), "v"(af[g][2]), "v"(af[g][3]), "v"(wq[g][0]), "v"(wq[g][1]), "v"(wq[g][2]), "v"(wq[g][3]));
        asm volatile("" :: "v"(bfr[0]), "v"(bfr[1]), "v"(bfr[2]), "v"(bfr[3]));
        for (int blk = w; blk < nwblk; blk += 8) {
            {
                const int bn_ = blk + 8 < nwblk ? blk + 8 : blk;
#pragma unroll
                for (int ks = 0; ks < 4; ++ks) bnx[ks] = *(const bf16x8*)(kp + (size_t)bn_ * 32 * IDXD + 16 * ks); }
#pragma unroll
            for (int g = 0; g < 4; ++g) {
                f32x16 acc = {};
#pragma unroll
                for (int ks = 0; ks < 4; ++ks) acc = __builtin_amdgcn_mfma_f32_32x32x16_bf16(af[g][ks], bfr[ks], acc, 0, 0, 0);
                float part[4];
#pragma unroll
                for (int q = 0; q < 4; ++q) { float s = wq[g][q][0] * __builtin_amdgcn_fmed3f(acc[4 * q], 0.f, INFINITY);
#pragma unroll
                    for (int i = 1; i < 4; ++i) s = __builtin_fmaf(wq[g][q][i], __builtin_amdgcn_fmed3f(acc[4 * q + i], 0.f, INFINITY), s);
                    part[q] = s; }
#pragma unroll
                for (int p = 0; p < 2; ++p) {
                    const auto rr = __builtin_amdgcn_permlane32_swap(__float_as_uint(part[p]), __float_as_uint(part[p + 2]), false, false);
                    const float sc = __uint_as_float(rr[0]) + __uint_as_float(rr[1]);
                    srow[(4 * g + p) * ROWP + 32 * blk] = (32 * blk <= rel0 + 4 * g + p) ? f2ord(sc) : 0u; }
            }
#pragma unroll
            for (int ks = 0; ks < 4; ++ks) bfr[ks] = bnx[ks];
        }
    }
    __syncthreads();
    if (!(flags & 8)) {
        const int nj = (nwblk + 1) >> 1, klim = 32 * nwblk;
        unsigned U[NJ][2];
#pragma unroll
        for (int j = 0; j < NJ; ++j) {
            if (j < nj) { const int key = 64 * j + lane;
#pragma unroll
                for (int p = 0; p < 2; ++p) U[j][p] = (key < klim) ? SU[(2 * w + p) * ROWP + key] : 0u; }
            else { U[j][0] = 0u; U[j][1] = 0u; }
        }
        const int tokb = b * SEQ + 16 * q16 + 2 * w;
        unsigned lo[2], hb[2], thr[2], veq[2]; int chi[2], need[2]; bool done[2];
#pragma unroll
        for (int p = 0; p < 2; ++p) { lo[p] = 1u; hb[p] = 0xffffffffu; chi[p] = 0; need[p] = 0; veq[p] = 0u; thr[p] = 1u; done[p] = (NMETA + 16 * q16 + 2 * w + p + 1 <= TOPK); }
        for (int it = 0; it < 34; ++it) {
            if (done[0] && done[1]) break;
            unsigned mid[2]; int cl[2];
#pragma unroll
            for (int p = 0; p < 2; ++p) { mid[p] = lo[p] + ((hb[p] - lo[p]) >> 1); cl[p] = 0; }
#pragma unroll
            for (int g = 0; g < 3; ++g) if (11 * g < nj) {
#pragma unroll
                for (int jj = 0; jj < 11; ++jj)
#pragma unroll
                    for (int p = 0; p < 2; ++p) cl[p] += (U[11 * g + jj][p] >= mid[p]) ? 1 : 0; }
            const int tot = wave_isum_dpp(cl[0] | (cl[1] << 16));
            int cnt[2] = {tot & 0xffff, tot >> 16};
#ifdef DBG_CHECK_DPP
            if (wave_isum(cl[0]) != cnt[0] || wave_isum(cl[1]) != cnt[1]) __hip_atomic_store(wsp<unsigned>(ws, WS_CTL) + 3, 1u, RLX_AGENT);
#endif
#pragma unroll
            for (int p = 0; p < 2; ++p) {
                const int ct = cnt[p];
                if (!done[p]) {
                    if (ct == TOPK) { done[p] = true; thr[p] = mid[p]; need[p] = 0; }
                    else if (ct > TOPK) lo[p] = mid[p];
                    else { hb[p] = mid[p]; chi[p] = ct; }
                    if (!done[p] && hb[p] - lo[p] == 1u) { done[p] = true; thr[p] = hb[p]; veq[p] = lo[p]; need[p] = TOPK - chi[p]; }
                }
            }
        }
#pragma unroll
        for (int p = 0; p < 2; ++p) {
            int run = 0;
            unsigned long long* mrow = (unsigned long long*)(MASK + (size_t)(tokb + p) * MSTR);
#pragma unroll
            for (int j = 0; j < NJ; ++j) if (j < nj) {
                const unsigned u = U[j][p];
                const bool eq = (need[p] > 0) && (u == veq[p]);
                const unsigned long long em = __ballot(eq);
                const int rank = run + (int)__builtin_amdgcn_mbcnt_hi((unsigned)(em >> 32), __builtin_amdgcn_mbcnt_lo((unsigned)em, 0u));
                const bool take = (u >= thr[p]) || (eq && rank < need[p]);
                run += __popcll(em);
                const unsigned long long sm = __ballot(take);
                if (lane == 0) mrow[j] = sm;
            }
        }
    }
    __syncthreads();
}
__device__ __forceinline__ void p2_indexer(Frame& F, int flags) {
    for (int i = F.bid; i < 256; i += F.G) { const int b = i >> 5, j = 2 * (i & 31);
        p2_indexer_unit(F, b, j, flags); p2_indexer_unit(F, b, 127 - j, flags); p2_indexer_unit(F, b, j + 1, flags); p2_indexer_unit(F, b, 126 - j, flags); }
}

__device__ const unsigned char T5B[128] = {0, 1, 2, 3, 4, 5, 6, 7, 8, 9, 10, 11, 12, 13, 14, 15, 16, 16, 16, 17, 17, 18, 18, 18, 19, 19, 19, 20, 20, 20, 20, 21, 21, 21, 21, 22, 22, 22, 22, 22, 23, 23, 23, 23, 23, 23, 24, 24, 24, 24, 24, 24, 25, 25, 25, 25, 25, 25, 25, 26, 26, 26, 26, 26, 26, 26, 26, 27, 27, 27, 27, 27, 27, 27, 27, 27, 27, 28, 28, 28, 28, 28, 28, 28, 28, 28, 28, 29, 29, 29, 29, 29, 29, 29, 29, 29, 29, 29, 29, 30, 30, 30, 30, 30, 30, 30, 30, 30, 30, 30, 30, 30, 30, 31, 31, 31, 31, 31, 31, 31, 31, 31, 31, 31, 31, 31, 31, 31};
constexpr int TBS = 132;
__device__ __forceinline__ int crow(int r, int hi) { return (r & 3) + 8 * (r >> 2) + 4 * hi; }
constexpr int KPITCH = 144, VPITCH = 136;
constexpr int AT_K = 0, AT_V = AT_K + 2 * 64 * KPITCH, AT_TB = AT_V + 2 * 64 * VPITCH, AT_SC = AT_TB + NH * TBS * 4, AT_END = AT_SC + NWAVES * 128;
static_assert(AT_END <= RING_BYTES, "attention LDS map");
__device__ __forceinline__ void p3_attn_unit(Frame& F, int b, int h, int Q) {
    unsigned char* ws = F.ws;
    const bf16_t* Qm = wsp<bf16_t>(ws, WS_Q); const bf16_t* KB = wsp<bf16_t>(ws, WS_KB); const bf16_t* VT = wsp<bf16_t>(ws, WS_VT); const unsigned* MASK = wsp<unsigned>(ws, WS_MASK); bf16_t* AO = wsp<bf16_t>(ws, WS_AO);
    LAS unsigned char* lds = F.lds;
    const LAS float* tbh = (const LAS float*)(lds + AT_TB) + h * TBS;
    LAS float* sc = (LAS float*)(lds + AT_SC) + F.wave * 32;
    const int tid = F.tid, lane = F.lane, c = lane & 31, hi = lane >> 5, w = F.wave;
    const int qb32 = 8 * Q + w, tokq = b * SEQ + 32 * qb32 + c, posq = NMETA + 32 * qb32 + c;
    const int ktmax = (47 + 32 * qb32) >> 6, NT = 4 * Q + 5;
    bf16x8 qf[4];
#pragma unroll
    for (int ks = 0; ks < 4; ++ks) qf[ks] = *(const bf16x8*)(Qm + (size_t)tokq * AW + h * HD + 16 * ks + 8 * hi);
    const unsigned long long* mrow = (const unsigned long long*)(MASK + (size_t)tokq * MSTR);
    const int srow = tid >> 3, piece = tid & 7;
    const bf16_t* kg = KB + (size_t)(b * TT + srow) * AW + h * HD + piece * 8;
    const bf16_t* vg = VT + ((size_t)b * AW + h * HD + srow) * TP + piece * 8;
    LAS unsigned char* kl = lds + AT_K + srow * KPITCH + piece * 16;
    LAS unsigned char* vl = lds + AT_V + srow * VPITCH + piece * 16;
    const LAS unsigned char* kfb = lds + AT_K + c * KPITCH + 16 * hi;
    const LAS unsigned char* vfb = lds + AT_V + c * VPITCH + 8 * hi;
    const float NEG = -INFINITY;
    float m_run = NEG, l = 0.f; f32x16 O0 = {}, O1 = {};
    u32x4 kr = *(const u32x4*)kg, vr = *(const u32x4*)vg;
    unsigned long long mwn = mrow[0];
    *(LAS u32x4*)kl = kr; *(LAS u32x2*)vl = (u32x2){vr.x, vr.y}; *(LAS u32x2*)(vl + 8) = (u32x2){vr.z, vr.w};
    __syncthreads();
    for (int kt = 0; kt < NT; ++kt) {
        const int buf = kt & 1;
        const unsigned long long mw = mwn;
        if (kt + 1 < NT) { kr = *(const u32x4*)(kg + (size_t)(kt + 1) * 64 * AW); vr = *(const u32x4*)(vg + (kt + 1) * 64); if (kt + 1 <= ktmax) mwn = mrow[kt + 1]; }
        if (kt <= ktmax) {
            const LAS unsigned char* kp = kfb + buf * 64 * KPITCH;
            f32x16 S0 = {}, S1 = {};
#pragma unroll
            for (int ks = 0; ks < 4; ++ks) {
                const bf16x8 k0 = *(const LAS bf16x8*)(kp + ks * 32), k1 = *(const LAS bf16x8*)(kp + 32 * KPITCH + ks * 32);
                S0 = __builtin_amdgcn_mfma_f32_32x32x16_bf16(k0, qf[ks], S0, 0, 0, 0);
                S1 = __builtin_amdgcn_mfma_f32_32x32x16_bf16(k1, qf[ks], S1, 0, 0, 0);
            }
            const unsigned mw0 = (unsigned)mw >> (4 * hi), mw1 = (unsigned)(mw >> 32) >> (4 * hi);
            const int d0 = posq - 64 * kt - 4 * hi;
            const bool far = (256 * Q + 32 * w - 64 * kt) >= 175;
            float tmax = NEG;
            if (far) {
                const float bfar = tbh[128];
#pragma unroll
                for (int r = 0; r < 16; ++r) { const int ko = (r & 3) + 8 * (r >> 2);
                    S0[r] = ((mw0 >> ko) & 1u) ? S0[r] + bfar : NEG; S1[r] = ((mw1 >> ko) & 1u) ? S1[r] + bfar : NEG; tmax = fmaxf(tmax, fmaxf(S0[r], S1[r])); }
            } else {
#pragma unroll
                for (int r = 0; r < 16; ++r) { const int ko = (r & 3) + 8 * (r >> 2);
                    int da = d0 - ko, db = d0 - 32 - ko; da = da < 0 ? 0 : (da > 128 ? 128 : da); db = db < 0 ? 0 : (db > 128 ? 128 : db);
                    S0[r] = ((mw0 >> ko) & 1u) ? S0[r] + tbh[da] : NEG; S1[r] = ((mw1 >> ko) & 1u) ? S1[r] + tbh[db] : NEG; tmax = fmaxf(tmax, fmaxf(S0[r], S1[r])); }
            }
            tmax = fmaxf(tmax, __shfl_xor(tmax, 32));
            if (__any(tmax > m_run + 8.0f)) {
                const float m_new = fmaxf(m_run, tmax);
                const float alpha = (m_new == NEG) ? 1.0f : __builtin_amdgcn_exp2f(m_run - m_new);
                l *= alpha; m_run = m_new;
                if (hi == 0) sc[c] = alpha;
                LDS_WAIT(); asm volatile("" ::: "memory");
#pragma unroll
                for (int r = 0; r < 16; ++r) { const float f = sc[crow(r, hi)]; O0[r] *= f; O1[r] *= f; }
                LDS_WAIT(); asm volatile("" ::: "memory");
            }
            const float m_use = (m_run == NEG) ? 0.f : m_run;
            float ps = 0.f;
#pragma unroll
            for (int r = 0; r < 16; ++r) { S0[r] = __builtin_amdgcn_exp2f(S0[r] - m_use); S1[r] = __builtin_amdgcn_exp2f(S1[r] - m_use); ps += S0[r] + S1[r]; }
            l += ps;
            const LAS unsigned char* vp = vfb + buf * 64 * VPITCH;
#pragma unroll
            for (int s2 = 0; s2 < 4; ++s2) {
                u32x4 pw;
                if (s2 < 2) { const int o = 8 * (s2 & 1); pw.x = cvt_pk_bf16(S0[o + 0], S0[o + 1]); pw.y = cvt_pk_bf16(S0[o + 2], S0[o + 3]); pw.z = cvt_pk_bf16(S0[o + 4], S0[o + 5]); pw.w = cvt_pk_bf16(S0[o + 6], S0[o + 7]); }
                else { const int o = 8 * (s2 & 1); pw.x = cvt_pk_bf16(S1[o + 0], S1[o + 1]); pw.y = cvt_pk_bf16(S1[o + 2], S1[o + 3]); pw.z = cvt_pk_bf16(S1[o + 4], S1[o + 5]); pw.w = cvt_pk_bf16(S1[o + 6], S1[o + 7]); }
                const bf16x8 pf = __builtin_bit_cast(bf16x8, pw);
                const u32x2 a0 = *(const LAS u32x2*)(vp + s2 * 32), a1 = *(const LAS u32x2*)(vp + s2 * 32 + 16);
                const u32x2 b0 = *(const LAS u32x2*)(vp + 32 * VPITCH + s2 * 32), b1 = *(const LAS u32x2*)(vp + 32 * VPITCH + s2 * 32 + 16);
                const bf16x8 v0 = __builtin_bit_cast(bf16x8, ((u32x4){a0.x, a0.y, a1.x, a1.y})), v1 = __builtin_bit_cast(bf16x8, ((u32x4){b0.x, b0.y, b1.x, b1.y}));
                O0 = __builtin_amdgcn_mfma_f32_32x32x16_bf16(pf, v0, O0, 0, 0, 0);
                O1 = __builtin_amdgcn_mfma_f32_32x32x16_bf16(pf, v1, O1, 0, 0, 0);
            }
        }
        if (kt + 1 < NT) { LAS unsigned char* k2 = kl + (buf ^ 1) * 64 * KPITCH; LAS unsigned char* v2 = vl + (buf ^ 1) * 64 * VPITCH;
            *(LAS u32x4*)k2 = kr; *(LAS u32x2*)v2 = (u32x2){vr.x, vr.y}; *(LAS u32x2*)(v2 + 8) = (u32x2){vr.z, vr.w}; }
        __syncthreads();
    }
    const float lt = l + __shfl_xor(l, 32);
    if (hi == 0) sc[c] = 1.0f / lt;
    LDS_WAIT(); asm volatile("" ::: "memory");
    bf16_t* ob = AO + (size_t)(b * SEQ + 32 * qb32) * AW + h * HD + c;
#pragma unroll
    for (int r = 0; r < 16; ++r) { const int qr = crow(r, hi); const float f = sc[qr];
        const float a0 = O0[r] * f, a1 = O1[r] * f, b0 = __shfl_xor(a0, 1), b1 = __shfl_xor(a1, 1);
        if ((c & 1) == 0) { *(unsigned*)(ob + (size_t)qr * AW) = cvt_pk_bf16(a0, b0); *(unsigned*)(ob + (size_t)qr * AW + 32) = cvt_pk_bf16(a1, b1); } }
    LDS_WAIT(); asm volatile("" ::: "memory");
}
__device__ __forceinline__ void p3_attn(Frame& F, const Args& a) {
    LAS float* tb = (LAS float*)(F.lds + AT_TB);
    __syncthreads();
    for (int idx = F.tid; idx < NH * 129; idx += NTHREADS) { const int h = idx / 129, d = idx % 129; const int bk = d < 128 ? (int)T5B[d] : 31; tb[h * TBS + d] = a.in[I_RELB][bk * NH + h] * LOG2E; }
    __syncthreads();
    for (int i = F.bid; i < 256; i += F.G) { const int bh = i >> 2, j = i & 3; p3_attn_unit(F, bh >> 3, bh & 7, j); p3_attn_unit(F, bh >> 3, bh & 7, 7 - j); }
    __syncthreads();
}

constexpr int WLP = 2064;
constexpr int P6_WHI = 0, P6_WLO = NE * WLP, P6_PART = 2 * NE * WLP, P6_SSP = P6_PART + 2 * 64 * 33 * 4, P6_CNT = P6_SSP + 2 * 64 * 4, P6_END = P6_CNT + 256;
static_assert(P6_END <= LDSX_OFF, "router LDS map");
__device__ __forceinline__ void p6_router(Frame& F, const Args& a) {
    unsigned char* ws = F.ws;
    const float* H1 = wsp<float>(ws, WS_H1); bf16_t* HN = wsp<bf16_t>(ws, WS_XN);
    const float* gf = a.in[I_NFFN]; const float* brt = a.in[I_BR];
    int* TE = wsp<int>(ws, WS_TE); int* TPs = wsp<int>(ws, WS_TP); int* LIST = wsp<int>(ws, WS_LIST); float* LG = wsp<float>(ws, WS_LG); float* RG = wsp<float>(ws, WS_RG);
    unsigned* ecnt = wsp<unsigned>(ws, WS_CTL) + CW_ECNT;
    LAS unsigned char* lds = F.lds;
    LAS float* part = (LAS float*)(lds + P6_PART);
    LAS float* ssp = (LAS float*)(lds + P6_SSP);
    LAS int* lcnt = (LAS int*)(lds + P6_CNT);
    LAS int* lbase = lcnt + 32;
    const int lane = F.lane, w = F.wave, tk = lane & 15, kq = lane >> 4;
    __syncthreads();
    { const unsigned char* src = ws + WS_WRT;
      for (int p = F.tid; p < 2 * NE * 128; p += NTHREADS) { const int arr = p >> 12, row = (p >> 7) & 31, c16 = p & 127;
          *(LAS u32x4*)(lds + arr * (NE * WLP) + row * WLP + c16 * 16) = *(const u32x4*)(src + (size_t)arr * NE * DM * 2 + (size_t)row * DM * 2 + c16 * 16); } }
    for (int tb = F.bid; tb < NTOK / 64; tb += F.G) {
        const int t0 = tb * 64;
        __syncthreads();
        if (F.tid < 32) lcnt[F.tid] = 0;
        {
            const int tg = w & 3, kh = w >> 2, tok = t0 + 16 * tg + tk;
            const float* xr = H1 + (size_t)tok * DM + 512 * kh + 8 * kq; const float* gr = gf + 512 * kh + 8 * kq;
            bf16_t* hr = HN + (size_t)tok * DM + 512 * kh + 8 * kq;
            const LAS unsigned char* wl = lds + tk * WLP + (512 * kh + 8 * kq) * 2;
            f32x4 xa[16], xb[16];
#pragma unroll
            for (int ks = 0; ks < 16; ++ks) { xa[ks] = *(const f32x4*)(xr + 32 * ks); xb[ks] = *(const f32x4*)(xr + 32 * ks + 4); }
            f32x4 acc0 = {0.f, 0.f, 0.f, 0.f}, acc1 = acc0; float ss = 0.f;
#pragma unroll
            for (int ks = 0; ks < 16; ++ks) {
                const f32x4 g0 = *(const f32x4*)(gr + 32 * ks), g1 = *(const f32x4*)(gr + 32 * ks + 4);
                const f32x4 x0 = xa[ks], x1 = xb[ks];
                u32x4 hn; hn.x = cvt_pk_bf16(x0[0] * g0[0], x0[1] * g0[1]); hn.y = cvt_pk_bf16(x0[2] * g0[2], x0[3] * g0[3]); hn.z = cvt_pk_bf16(x1[0] * g1[0], x1[1] * g1[1]); hn.w = cvt_pk_bf16(x1[2] * g1[2], x1[3] * g1[3]);
                *(u32x4*)(hr + 32 * ks) = hn;
                ss += (x0[0] * x0[0] + x0[1] * x0[1]) + (x0[2] * x0[2] + x0[3] * x0[3]) + (x1[0] * x1[0] + x1[1] * x1[1]) + (x1[2] * x1[2] + x1[3] * x1[3]);
                u32x4 xh; xh.x = cvt_pk_bf16(x0[0], x0[1]); xh.y = cvt_pk_bf16(x0[2], x0[3]); xh.z = cvt_pk_bf16(x1[0], x1[1]); xh.w = cvt_pk_bf16(x1[2], x1[3]);
                u32x4 xl; xl.x = cvt_pk_bf16(x0[0] - bflo(xh.x), x0[1] - bfhi(xh.x)); xl.y = cvt_pk_bf16(x0[2] - bflo(xh.y), x0[3] - bfhi(xh.y));
                          xl.z = cvt_pk_bf16(x1[0] - bflo(xh.z), x1[1] - bfhi(xh.z)); xl.w = cvt_pk_bf16(x1[2] - bflo(xh.w), x1[3] - bfhi(xh.w));
                const bf16x8 fxh = __builtin_bit_cast(bf16x8, xh), fxl = __builtin_bit_cast(bf16x8, xl);
                const bf16x8 wh0 = *(const LAS bf16x8*)(wl + P6_WHI + ks * 64), wh1 = *(const LAS bf16x8*)(wl + P6_WHI + 16 * WLP + ks * 64);
                const bf16x8 wl0 = *(const LAS bf16x8*)(wl + P6_WLO + ks * 64), wl1 = *(const LAS bf16x8*)(wl + P6_WLO + 16 * WLP + ks * 64);
                acc0 = __builtin_amdgcn_mfma_f32_16x16x32_bf16(wh0, fxh, acc0, 0, 0, 0); acc1 = __builtin_amdgcn_mfma_f32_16x16x32_bf16(wh1, fxh, acc1, 0, 0, 0);
                acc0 = __builtin_amdgcn_mfma_f32_16x16x32_bf16(wl0, fxh, acc0, 0, 0, 0); acc1 = __builtin_amdgcn_mfma_f32_16x16x32_bf16(wl1, fxh, acc1, 0, 0, 0);
                acc0 = __builtin_amdgcn_mfma_f32_16x16x32_bf16(wh0, fxl, acc0, 0, 0, 0); acc1 = __builtin_amdgcn_mfma_f32_16x16x32_bf16(wh1, fxl, acc1, 0, 0, 0);
            }
            ss += __shfl_xor(ss, 16); ss += __shfl_xor(ss, 32);
            LAS float* pp = part + ((kh * 64) + 16 * tg + tk) * 33 + 4 * kq;
#pragma unroll
            for (int r = 0; r < 4; ++r) { pp[r] = acc0[r]; pp[16 + r] = acc1[r]; }
            if (kq == 0) ssp[kh * 64 + 16 * tg + tk] = ss;
        }
        __syncthreads();
        if (w == 0) {
            const float rinv = 1.0f / sqrtf((ssp[lane] + ssp[64 + lane]) * (1.f / DM) + EPS);
            float lg[NE];
#pragma unroll
            for (int e = 0; e < NE; ++e) lg[e] = (part[lane * 33 + e] + part[(64 + lane) * 33 + e]) * rinv + brt[e];
            int sel[4]; float val[4];
#pragma unroll
            for (int j = 0; j < 4; ++j) { float best = -INFINITY; int bi = 0;
#pragma unroll
                for (int e = 0; e < NE; ++e) { const bool tk_ = lg[e] > best; best = tk_ ? lg[e] : best; bi = tk_ ? e : bi; }
                sel[j] = bi; val[j] = best;
#pragma unroll
                for (int e = 0; e < NE; ++e) lg[e] = (e == bi) ? -INFINITY : lg[e]; }
            float den = 0.f, ex[4];
#pragma unroll
            for (int j = 0; j < 4; ++j) { ex[j] = __expf(val[j] - val[0]); den += ex[j]; }
            int slot[4];
#pragma unroll
            for (int j = 0; j < 4; ++j) slot[j] = __hip_atomic_fetch_add(&lcnt[sel[j]], 1, __ATOMIC_RELAXED, __HIP_MEMORY_SCOPE_WORKGROUP);
            LDS_WAIT();
            if (lane < 32) { const int n = lcnt[lane]; lbase[lane] = n ? (int)__hip_atomic_fetch_add(ecnt + 64 * lane, (unsigned)n, RLX_AGENT) : 0; }
            LDS_WAIT(); asm volatile("" ::: "memory");
            const int t = t0 + lane;
#pragma unroll
            for (int j = 0; j < 4; ++j) { const int e = sel[j], pos = lbase[e] + slot[j]; const float g = ex[j] / den;
                TE[t * 4 + j] = e; TPs[t * 4 + j] = pos; LIST[(size_t)e * NTOK + pos] = t; LG[(size_t)e * NTOK + pos] = g; RG[(size_t)e * NTOK + pos] = rinv; }
        }
    }
    __syncthreads();
}
__device__ __forceinline__ void moe_tables(Frame& F, LAS int* cnt, LAS int* tbase) {
    const unsigned* ecnt = wsp<unsigned>(F.ws, WS_CTL) + CW_ECNT;
    __syncthreads();
    if (F.tid < NE) cnt[F.tid] = (int)__hip_atomic_load(ecnt + 64 * F.tid, RLX_AGENT);
    __syncthreads();
    if (F.tid == 0) { int s = 0; for (int e = 0; e < NE; ++e) { tbase[e] = s; s += (cnt[e] + 255) >> 8; } tbase[NE] = s; }
    __syncthreads();
}

__device__ __forceinline__ void p9_final(Frame& F, const Args& a, const LAS int* tbase) {
    unsigned char* ws = F.ws;
    const float* H1 = wsp<float>(ws, WS_H1); float* OUT = a.out; const bf16_t* YP = wsp<bf16_t>(ws, WS_YP); const int* TE = wsp<int>(ws, WS_TE); const int* TPs = wsp<int>(ws, WS_TP); const float* gf = a.in[I_NFIN];
    const int gw = F.bid * NWAVES + F.wave, NGW = F.G * NWAVES, lane = F.lane;
    const f32x4* gr = (const f32x4*)gf + lane;
    f32x4 gg[4];
#pragma unroll
    for (int j = 0; j < 4; ++j) gg[j] = gr[64 * j];
#ifdef DBG_CHECK_DPP
    if (__hip_atomic_load(wsp<unsigned>(ws, WS_CTL) + 3, RLX_AGENT) != 0u) { const float qn = __builtin_nanf("");
#pragma unroll
        for (int j = 0; j < 4; ++j) gg[j] = (f32x4){qn, qn, qn, qn}; }
#endif
    for (int base = 0; base < NTOK; base += 8 * NGW) {
        int myrow = 0;
        { const int i = lane >> 2, j = lane & 3, t = base + gw + NGW * i; if (lane < 32 && t < NTOK) { const int e = TE[t * 4 + j], pos = TPs[t * 4 + j]; myrow = tbase[e] * 256 + pos; } }
        f32x4 va[4], vb[4]; u32x2 ya[4][4], yb[4][4];
#define P9_LOAD(i, V, Y) do { const int t_ = base + gw + NGW * (i); if (t_ < NTOK) { const f32x4* xr_ = (const f32x4*)(H1 + (size_t)t_ * DM) + lane; \
            _Pragma("unroll") for (int j_ = 0; j_ < 4; ++j_) V[j_] = xr_[64 * j_]; \
            _Pragma("unroll") for (int q_ = 0; q_ < 4; ++q_) { const int row_ = __builtin_amdgcn_readlane(myrow, 4 * (i) + q_); const u32x2* yr_ = (const u32x2*)(YP + (size_t)row_ * DM) + lane; \
                _Pragma("unroll") for (int j_ = 0; j_ < 4; ++j_) Y[q_][j_] = yr_[64 * j_]; } } } while (0)
#define P9_PROC(i, V, Y) do { const int t_ = base + gw + NGW * (i); if (t_ < NTOK) { \
            _Pragma("unroll") for (int q_ = 0; q_ < 4; ++q_) _Pragma("unroll") for (int j_ = 0; j_ < 4; ++j_) { const u32x2 y_ = Y[q_][j_]; V[j_].x += bflo(y_.x); V[j_].y += bfhi(y_.x); V[j_].z += bflo(y_.y); V[j_].w += bfhi(y_.y); } \
            float s_ = 0.f; _Pragma("unroll") for (int j_ = 0; j_ < 4; ++j_) s_ += (V[j_].x * V[j_].x + V[j_].y * V[j_].y) + (V[j_].z * V[j_].z + V[j_].w * V[j_].w); \
            const float r_ = 1.0f / sqrtf(wave_sum(s_) * (1.f / DM) + EPS); f32x4* xo_ = (f32x4*)(OUT + (size_t)t_ * DM) + lane; \
            _Pragma("unroll") for (int j_ = 0; j_ < 4; ++j_) xo_[64 * j_] = (f32x4){V[j_].x * r_ * gg[j_].x, V[j_].y * r_ * gg[j_].y, V[j_].z * r_ * gg[j_].z, V[j_].w * r_ * gg[j_].w}; } } while (0)
        P9_LOAD(0, va, ya);
#pragma unroll
        for (int i = 0; i < 8; i += 2) {
            P9_LOAD(i + 1, vb, yb);
            P9_PROC(i, va, ya);
            if (i + 2 < 8) P9_LOAD(i + 2, va, ya);
            P9_PROC(i + 1, vb, yb);
        }
#undef P9_LOAD
#undef P9_PROC
    }
}

constexpr int N_PHASES = 10;
__global__ void __launch_bounds__(NTHREADS, 2) fwd_kernel(Args args) {
    extern __shared__ __attribute__((aligned(16))) unsigned char lds_raw[];
    Frame F;
    F.lds = (LAS unsigned char*)lds_raw; F.ws = args.ws;
    F.tid = threadIdx.x; F.lane = F.tid & 63; F.wave = __builtin_amdgcn_readfirstlane(F.tid >> 6);
    F.G = gridDim.x; F.bid = blockIdx.x;
    volatile LAS unsigned* MISC = (volatile LAS unsigned*)(F.lds + MISC_OFF);
    if (F.tid < 32) MISC[F.tid] = 0u;
    __syncthreads();
    unsigned* ctl = wsp<unsigned>(args.ws, WS_CTL);
    const int lo = args.ph_lo, hi = args.ph_hi;
    const bool multi = (hi - lo) > 1;
    XcdBarrier bar; bar.bar = ctl + CW_BAR; bar.x = 0; bar.st = nullptr;
    if (multi) bar = xcd_barrier_post(ctl + CW_BAR, MISC + 8);
#ifndef PHASE_MASK
#define PHASE_MASK 0x3ff
#endif
#define IN(k) (((PHASE_MASK >> (k)) & 1) && lo <= (k) && (k) < hi)
#define SEAM(k) do { if (IN(k) && IN((k) + 1)) xcd_barrier(bar); } while (0)
    LAS int* l_cnt = (LAS int*)(F.lds + LDSX_OFF); LAS int* l_tbase = l_cnt + 64;
    const MoeTables MT{l_cnt, l_tbase};

    if (IN(0)) { p0_prologue(F, args); } SEAM(0);
    if (IN(1)) {
        PlainSched S; S.init(args.ws, WS_XN, WS_WIN, NTOK, 5120, DM, F.G, F.bid);
        EpiInProj E{args.ws, args.in[I_BGATE]};
        if (!(args.flags & 64)) pg8::gemm_phase<EpiInProj, PlainSched>(F.lds, DM, S, E);
        if (!(args.flags & 128)) p1_thin(F, args.flags);
    } SEAM(1);
    if (IN(2)) {
        if (!(args.flags & 1)) p2_conv(F, args);
        if (!(args.flags & 2)) p2_indexer(F, args.flags);
    } SEAM(2);
    if (IN(3)) { p3_attn(F, args); } SEAM(3);
    if (IN(4)) {
        MergeSched S{(const char*)args.ws, F.G, F.bid}; EpiMerge E{args.ws};
        pg8::gemm_phase<EpiMerge, MergeSched>(F.lds, 512, S, E);
    } SEAM(4);
    if (IN(5)) {
        PlainSched S; S.init(args.ws, WS_MG, WS_WOUT, NTOK, DM, DM, F.G, F.bid);
        EpiResid E{args.in[I_X], wsp<float>(args.ws, WS_H1)};
        pg8::gemm_phase<EpiResid, PlainSched>(F.lds, DM, S, E);
    } SEAM(5);
    if (IN(6)) { p6_router(F, args); } SEAM(6);
    if (IN(7)) {
        moe_tables(F, l_cnt, l_tbase);
        MoeSched<8, true> S{(const char*)args.ws, MT, F.G, F.bid, l_tbase[NE] * 8};
        EpiSwiglu E{args.ws, args.in[I_BUG], MT};
        pg8::gemm_phase<EpiSwiglu, MoeSched<8, true>>(F.lds, DM, S, E);
    } SEAM(7);
    if (IN(8)) {
        moe_tables(F, l_cnt, l_tbase);
        MoeSched<4, false> S{(const char*)args.ws, MT, F.G, F.bid, l_tbase[NE] * 4};
        EpiDown E{args.ws, args.in[I_BD], MT};
        pg8::gemm_phase<EpiDown, MoeSched<4, false>>(F.lds, DFF, S, E);
    } SEAM(8);
    if (IN(9)) { moe_tables(F, l_cnt, l_tbase); p9_final(F, args, l_tbase); }
#undef IN
#undef SEAM
}

#ifdef DBG_HASH_OFF
__global__ void dbg_hash(const unsigned* __restrict__ buf, size_t nwords, unsigned* acc) {
    unsigned h = 0u;
    for (size_t i = (size_t)blockIdx.x * blockDim.x + threadIdx.x; i < nwords; i += (size_t)gridDim.x * blockDim.x) h += (buf[i] ^ (unsigned)(i * 2654435761u)) * 2246822519u + (unsigned)i;
#pragma unroll
    for (int o = 1; o < 64; o <<= 1) h += __shfl_xor(h, o);
    if ((threadIdx.x & 63) == 0) atomicAdd(acc, h);
}
__global__ void dbg_fill(float* out, size_t n, const unsigned* acc) {
    const unsigned h = *acc; const float v = (float)((h >> 7) & 0xffffu) * (1.0f / 4096.0f) + 1.0f;
    for (size_t i = (size_t)blockIdx.x * blockDim.x + threadIdx.x; i < n; i += (size_t)gridDim.x * blockDim.x) out[i] = v;
}
#endif

extern "C" void kernel_launch(void* const* d_in, const int* in_sizes, int n_in, void* d_out, int out_size, void* d_ws, size_t ws_size, hipStream_t stream) {
    static int grid = 0;
    if (grid == 0) {
        if (n_in != 21 || out_size != NTOK * DM || ws_size < WS_END) { fprintf(stderr, "kernel_launch: unexpected shapes (n_in %d, out %d, ws %zu < %zu)\n", n_in, out_size, ws_size, (size_t)WS_END); grid = -1; return; }
        int dev = 0, cus = 0, per_cu = 0;
        if (hipGetDevice(&dev) != hipSuccess || hipDeviceGetAttribute(&cus, hipDeviceAttributeMultiprocessorCount, dev) != hipSuccess) { grid = -1; return; }
        if (hipFuncSetAttribute((const void*)fwd_kernel, hipFuncAttributeMaxDynamicSharedMemorySize, LDS_BYTES) != hipSuccess) { fprintf(stderr, "kernel_launch: hipFuncSetAttribute failed\n"); grid = -1; return; }
        if (hipOccupancyMaxActiveBlocksPerMultiprocessor(&per_cu, (const void*)fwd_kernel, NTHREADS, LDS_BYTES) != hipSuccess || per_cu < 1) { fprintf(stderr, "kernel_launch: occupancy query says %d\n", per_cu); }
        (void)hipGetLastError();
        grid = cus;
    }
    if (grid < 0) return;
    (void)hipMemsetAsync((char*)d_ws + WS_CTL, 0, CTL_ZERO_BYTES, stream);
    Args a{};
    for (int i = 0; i < 21; ++i) a.in[i] = (const float*)d_in[i];
    a.out = (float*)d_out; a.ws = (unsigned char*)d_ws;
#if MK_N_LAUNCHES == 1
    a.ph_lo = 0; a.ph_hi = N_PHASES;
    hipLaunchKernelGGL(fwd_kernel, dim3(grid), dim3(NTHREADS), LDS_BYTES, stream, a);
#else
#ifndef DBG_LAST_PHASE
#define DBG_LAST_PHASE (N_PHASES - 1)
#endif
#ifndef DBG_DUP_MASK
#define DBG_DUP_MASK 0
#endif
#ifndef DBG_DUP_FLAGS
#define DBG_DUP_FLAGS 0
#endif
    for (int p = 0; p <= DBG_LAST_PHASE; ++p) { a.ph_lo = p; a.ph_hi = p + 1;
        const int nrep = ((DBG_DUP_MASK >> p) & 1) ? 2 : 1;
        for (int rep = 0; rep < nrep; ++rep) { a.flags = (nrep == 2 && rep == 0) ? DBG_DUP_FLAGS : 0; if (rep == 1 && p == 6) (void)hipMemsetAsync((char*)d_ws + WS_CTL, 0, CTL_ZERO_BYTES, stream);
            hipLaunchKernelGGL(fwd_kernel, dim3(grid), dim3(NTHREADS), LDS_BYTES, stream, a); } }
#ifdef DBG_HASH_OFF
    { const unsigned* hb = DBG_HASH_OFF == 0 ? (const unsigned*)d_out : (const unsigned*)((char*)d_ws + DBG_HASH_OFF);
      hipLaunchKernelGGL(dbg_hash, dim3(1024), dim3(256), 0, stream, hb, (size_t)(DBG_HASH_BYTES) / 4, (unsigned*)d_ws + 2);
      hipLaunchKernelGGL(dbg_fill, dim3(1024), dim3(256), 0, stream, (float*)d_out, (size_t)NTOK * DM, (const unsigned*)d_ws + 2); }
#endif
#endif
}
```

```cpp
#include <hip/hip_runtime.h>
#include <cstdio>
#include <cstdint>

#ifndef MK_N_LAUNCHES
#define MK_N_LAUNCHES 1
#endif

constexpr int NB = 8, SEQ = 2048, NMETA = 16, TT = SEQ + NMETA  , DM = 1024, NTOK = NB * SEQ  , NALL = NB * TT  ;
constexpr int AW = 512, NH = 8, HD = 64, IDXD = 64, CC = 512, CW = 31, NE = 32, DFF = 1024, TOPK = 256;
constexpr int INCOLS = 5192, TP = 2176  , VOFF = 0  , MSTR = 68  ;
constexpr float EPS = 1e-6f, LOG2E = 1.4426950408889634f;
constexpr float QSCALE = 0.125f * LOG2E;
constexpr int MAXTILES = 296;
constexpr int SC_Q = 0, SC_K = 512, SC_V = 1024, SC_IQ = 1536, SC_IK = 2048, SC_IW = 2112, SC_GLU = 2120, SC_GATE = 3144;
constexpr int WR_GLU = 2048, WR_GATE = 3072, WR_IK = 5120, WR_IW = 5184, WIN_ROWS = 5376;

constexpr size_t MiB = 1u << 20;
constexpr size_t al4k(size_t x) { return (x + 4095) & ~(size_t)4095; }
constexpr size_t WS_CTL = 0, CTL_ZERO_BYTES = 1 * MiB;
constexpr size_t WS_WIN = 1 * MiB;
constexpr size_t WS_WAO = WS_WIN + al4k((size_t)WIN_ROWS * DM * 2);
constexpr size_t WS_WCO = WS_WAO + al4k((size_t)DM * AW * 2);
constexpr size_t WS_WOUT = WS_WCO + al4k((size_t)DM * CC * 2);
constexpr size_t WS_WUG = WS_WOUT + al4k((size_t)DM * DM * 2);
constexpr size_t WS_WD = WS_WUG + al4k((size_t)NE * 2 * DFF * DM * 2);
constexpr size_t WS_XN = WS_WD + al4k((size_t)NE * DM * DFF * 2);
constexpr size_t WS_XNM = WS_XN + al4k((size_t)NTOK * DM * 2);
constexpr size_t WS_Q = WS_XNM + al4k((size_t)NMETA * DM * 2);
constexpr size_t WS_IQ = WS_Q + al4k((size_t)NTOK * AW * 2);
constexpr size_t WS_KB = WS_IQ + al4k((size_t)NTOK * AW * 2);
constexpr size_t WS_VT = WS_KB + al4k((size_t)(NALL + 64) * AW * 2);
constexpr size_t WS_IK = WS_VT + al4k((size_t)NB * AW * TP * 2);
constexpr size_t WS_IW = WS_IK + al4k((size_t)(NALL + 64) * IDXD * 2);
constexpr size_t WS_GLU = WS_IW + al4k((size_t)NTOK * 8 * 4);
constexpr size_t WS_GA = WS_GLU + al4k((size_t)NALL * CC * 2);
constexpr size_t WS_GB = WS_GA + al4k((size_t)NTOK * DM * 2);
constexpr size_t WS_MASK = WS_GB + al4k((size_t)NTOK * DM * 2);
constexpr size_t WS_AO = WS_MASK + al4k((size_t)NTOK * MSTR * 4);
constexpr size_t WS_CO = WS_AO + al4k((size_t)NTOK * AW * 2);
constexpr size_t WS_MG = WS_CO + al4k((size_t)NTOK * CC * 2);
constexpr size_t WS_TE = WS_MG + al4k((size_t)NTOK * DM * 2);
constexpr size_t WS_TP = WS_TE + al4k((size_t)NTOK * 4 * 4);
constexpr size_t WS_LIST = WS_TP + al4k((size_t)NTOK * 4 * 4);
constexpr size_t WS_LG = WS_LIST + al4k((size_t)NE * NTOK * 4);
constexpr size_t WS_ACT = WS_LG + al4k((size_t)NE * NTOK * 4);
constexpr size_t WS_YP = WS_ACT + al4k((size_t)MAXTILES * 256 * DFF * 2);
constexpr size_t WS_H1 = WS_YP + al4k((size_t)MAXTILES * 256 * DM * 2);
constexpr size_t WS_WRT = WS_H1 + al4k((size_t)NTOK * DM * 4);
constexpr size_t WS_RG = WS_WRT + al4k((size_t)2 * NE * DM * 2);
constexpr size_t WS_DUMMY = WS_RG + al4k((size_t)NE * NTOK * 4);
constexpr size_t WS_END = WS_DUMMY + 4096;
static_assert(WS_END < ((size_t)1 << 32), "32-bit byte offsets into d_ws");
constexpr int CW_TMO = 0, CW_CODE = 1, CW_BAR = 4096, CW_ECNT = 16384;

constexpr int RING_BYTES = 131072;
constexpr int LDSX_OFF = 153600;
constexpr int MISC_OFF = 161792;
constexpr int LDS_BYTES = 163840;
constexpr int NWAVES = 8, NTHREADS = 512;

#define GAS __attribute__((address_space(1)))
#define LAS __attribute__((address_space(3)))
typedef unsigned short bf16_t;
typedef short bf16x8 __attribute__((ext_vector_type(8)));
typedef short s16x4 __attribute__((ext_vector_type(4)));
typedef float f32x4 __attribute__((ext_vector_type(4)));
typedef float f32x16 __attribute__((ext_vector_type(16)));
typedef unsigned u32x4 __attribute__((ext_vector_type(4)));
typedef unsigned u32x2 __attribute__((ext_vector_type(2)));
typedef GAS unsigned gu32;
#define RLX_AGENT __ATOMIC_RELAXED, __HIP_MEMORY_SCOPE_AGENT
#define LDS_WAIT() asm volatile("s_waitcnt lgkmcnt(0)" ::: "memory")
#define VM_WAIT() asm volatile("s_waitcnt vmcnt(0)" ::: "memory")

typedef float f32x2_t __attribute__((ext_vector_type(2))); typedef __bf16 bf16x2_t __attribute__((ext_vector_type(2)));
__device__ __forceinline__ unsigned cvt_pk_bf16(float lo, float hi) { const f32x2_t v = {lo, hi}; const bf16x2_t b = __builtin_convertvector(v, bf16x2_t); return __builtin_bit_cast(unsigned, b); }
__device__ __forceinline__ float bf2f(unsigned short b) { return __uint_as_float((unsigned)b << 16); }
__device__ __forceinline__ float bflo(unsigned w) { return __uint_as_float(w << 16); }
__device__ __forceinline__ float bfhi(unsigned w) { return __uint_as_float(w & 0xffff0000u); }
__device__ __forceinline__ float sigmoidf_(float x) { return __builtin_amdgcn_rcpf(1.0f + __builtin_amdgcn_exp2f(-LOG2E * x)); }
__device__ __forceinline__ float wave_sum(float v) {
#pragma unroll
    for (int o = 1; o < 64; o <<= 1) v += __shfl_xor(v, o);
    return v;
}

namespace pg8 {
constexpr int BM = 256, BK = 64, HALF = 128, HTB = HALF * BK * 2, STAGE_BYTES = 8 * HTB;
__host__ __device__ __forceinline__ int lds_byte(int r, int c) { const int st = (r >> 4) * 2 + (c >> 5), rr = r & 15, cc = c & 31, ob = rr * 64 + cc * 2; return st * 1024 + (ob ^ (((ob >> 9) & 1) << 5)); }
__host__ __device__ __forceinline__ void stage_rc(int b, int& R, int& C) { const int st = b / 1024, sb = b % 1024, swz = sb ^ (((sb >> 9) & 1) << 5); R = (st >> 1) * 16 + swz / 64; C = (st & 1) * 32 + (swz % 64) / 2; }

struct Unit { int pm, pn, z; };

template <class Epi, class Sched>
__device__ __forceinline__ void gemm_phase(LAS unsigned char* lds, const int K, const Sched& S, const Epi& E) {
    const int tid = threadIdx.x, wid = __builtin_amdgcn_readfirstlane(tid >> 6), lane = tid & 63, wr = wid >> 2, wc = wid & 3, fr = lane & 15, fq = lane >> 4;
    const int nt = K / BK;
    unsigned voffB[2];
#pragma unroll
    for (int i = 0; i < 2; ++i) { int R_, C_; stage_rc(tid * 16 + i * 8192, R_, C_); voffB[i] = (unsigned)(R_ * K + C_) * 2u; }
    const size_t kstep = (size_t)(BK * 2);
    const size_t hstep = (size_t)HALF * K * 2;
    const unsigned ldsw = (unsigned)wid * 1024u;
    const int aoff = lds_byte(wr * 64 + fr, fq * 8), boff = lds_byte(wc * 32 + fr, fq * 8);
    const char* const abase = S.a_base();
#define PG8_SA(b, h) (((b) * 2 + (h)) * HTB)
#define PG8_SB(b, h) ((4 + (b) * 2 + (h)) * HTB)
#define PG8_STAGE(bufoff, gbase, voff) do { _Pragma("unroll") for (int _i = 0; _i < 2; ++_i) \
        __builtin_amdgcn_global_load_lds((const unsigned*)((const char*)(gbase) + (voff)[_i]), (LAS unsigned*)(lds + (bufoff) + ldsw + _i * 8192), 16, 0, 0); } while (0)
#define PG8_LDA(dst, b, h) do { _Pragma("unroll") for (int m = 0; m < 4; ++m) _Pragma("unroll") for (int k = 0; k < 2; ++k) dst[m][k] = *(const LAS bf16x8*)(lds + PG8_SA(b, h) + aoff + m * 2048 + k * 1024); } while (0)
#define PG8_LDB(dst, b, h) do { _Pragma("unroll") for (int n = 0; n < 2; ++n) _Pragma("unroll") for (int k = 0; k < 2; ++k) dst[n][k] = *(const LAS bf16x8*)(lds + PG8_SB(b, h) + boff + n * 2048 + k * 1024); } while (0)
#define PG8_MMA(ai, bj, At, Bt) do { __builtin_amdgcn_s_setprio(1); _Pragma("unroll") for (int m = 0; m < 4; ++m) _Pragma("unroll") for (int n = 0; n < 2; ++n) _Pragma("unroll") for (int k = 0; k < 2; ++k) \
        acc[ai][bj][m][n] = __builtin_amdgcn_mfma_f32_16x16x32_bf16(Bt[n][k], At[m][k], acc[ai][bj][m][n], 0, 0, 0); __builtin_amdgcn_s_setprio(0); } while (0)
#define PG8_WAIT_V(n) asm volatile("s_waitcnt vmcnt(" #n ")" ::: "memory")
#define PG8_WAIT_L(n) asm volatile("s_waitcnt lgkmcnt(" #n ")" ::: "memory")
#define PG8_BAR __builtin_amdgcn_s_barrier()
#define PG8_SCHED __builtin_amdgcn_sched_barrier(0)
    Unit cur, nxt; int ui = 0;
    if (!S.next(0, cur)) return;
    f32x4 acc[2][2][4][2];
#pragma unroll
    for (int a = 0; a < 2; ++a)
#pragma unroll
        for (int b = 0; b < 2; ++b)
#pragma unroll
            for (int m = 0; m < 4; ++m)
#pragma unroll
                for (int n = 0; n < 2; ++n) acc[a][b][m][n] = (f32x4){0.f, 0.f, 0.f, 0.f};
    bf16x8 At[4][2], B0[2][2], B1[2][2];
    unsigned ca[2][2], na[2][2];
    S.a_offs(cur, tid, ca);
    const char* cB = S.b_base(cur);
    PG8_STAGE(PG8_SB(0, 0), cB, voffB); PG8_STAGE(PG8_SB(0, 1), cB + hstep, voffB); PG8_STAGE(PG8_SA(0, 0), abase, ca[0]); PG8_STAGE(PG8_SA(0, 1), abase, ca[1]);
    if (wr == 1) PG8_BAR;
    PG8_WAIT_V(2); PG8_BAR;
    PG8_STAGE(PG8_SB(1, 0), cB + kstep, voffB); PG8_STAGE(PG8_SA(1, 0), abase + kstep, ca[0]); PG8_STAGE(PG8_SB(1, 1), cB + hstep + kstep, voffB);
    PG8_WAIT_V(6); PG8_BAR;
    for (;;) {
        const bool has_next = S.next(ui + 1, nxt);
        const char* nB = cB;
#pragma unroll
        for (int h = 0; h < 2; ++h)
#pragma unroll
            for (int i = 0; i < 2; ++i) na[h][i] = ca[h][i];
        if (has_next) { S.a_offs(nxt, tid, na); nB = S.b_base(nxt); }
        for (int t = 0; t < nt; t += 2) {
            const bool last = (t == nt - 2);
            const char* a1 = abase + (size_t)(t + 1) * kstep;
            const char* a2 = last ? abase : abase + (size_t)(t + 2) * kstep; const char* b2 = last ? nB : cB + (size_t)(t + 2) * kstep;
            const char* a3 = a2 + kstep; const char* b3 = b2 + kstep;
            PG8_LDB(B0, 0, 0); PG8_LDB(B1, 0, 1); PG8_SCHED; PG8_LDA(At, 0, 0); PG8_STAGE(PG8_SA(1, 1), a1, ca[1]);
            PG8_WAIT_V(8); PG8_WAIT_L(0); PG8_BAR; PG8_MMA(0, 0, At, B0); PG8_MMA(0, 1, At, B1); PG8_BAR; PG8_SCHED;
            if (last) {
#pragma unroll
                for (int h = 0; h < 2; ++h)
#pragma unroll
                    for (int i = 0; i < 2; ++i) ca[h][i] = na[h][i];
            }
            PG8_LDA(At, 0, 1); PG8_STAGE(PG8_SB(0, 0), b2, voffB); PG8_STAGE(PG8_SB(0, 1), b2 + hstep, voffB); PG8_STAGE(PG8_SA(0, 0), a2, ca[0]);
            PG8_WAIT_V(8); PG8_WAIT_L(0); PG8_BAR; PG8_MMA(1, 0, At, B0); PG8_MMA(1, 1, At, B1); PG8_BAR; PG8_SCHED;
            PG8_LDB(B0, 1, 0); PG8_LDB(B1, 1, 1); PG8_SCHED; PG8_LDA(At, 1, 0); PG8_STAGE(PG8_SA(0, 1), a2, ca[1]);
            PG8_WAIT_V(8); PG8_WAIT_L(0); PG8_BAR; PG8_MMA(0, 0, At, B0); PG8_MMA(0, 1, At, B1); PG8_BAR; PG8_SCHED;
            PG8_LDA(At, 1, 1); PG8_STAGE(PG8_SB(1, 0), b3, voffB); PG8_STAGE(PG8_SB(1, 1), b3 + hstep, voffB); PG8_STAGE(PG8_SA(1, 0), a3, ca[0]);
            PG8_WAIT_V(8); PG8_WAIT_L(0); PG8_BAR; PG8_MMA(1, 0, At, B0); PG8_MMA(1, 1, At, B1); PG8_BAR; PG8_SCHED;
        }
        if (wr == 0) PG8_BAR;
        { int tz = tid; asm volatile("" : "+v"(tz));
          const int l2 = tz & 63, w2 = __builtin_amdgcn_readfirstlane(tz >> 6); E(acc, cur, w2 >> 2, w2 & 3, l2 & 15, l2 >> 4); }
        if (!has_next) break;
#pragma unroll
        for (int a = 0; a < 2; ++a)
#pragma unroll
            for (int b = 0; b < 2; ++b)
#pragma unroll
                for (int m = 0; m < 4; ++m)
#pragma unroll
                    for (int n = 0; n < 2; ++n) acc[a][b][m][n] = (f32x4){0.f, 0.f, 0.f, 0.f};
        cur = nxt; cB = nB; ++ui;
        if (wr == 1) PG8_BAR;
    }
    PG8_WAIT_V(0);
    PG8_BAR;
#undef PG8_SA
#undef PG8_SB
#undef PG8_STAGE
#undef PG8_LDA
#undef PG8_LDB
#undef PG8_MMA
#undef PG8_WAIT_V
#undef PG8_WAIT_L
#undef PG8_BAR
#undef PG8_SCHED
}
}

#define XB_TMO      128
#define XB_XCNT(j)  (256  + 64 * (j))
#define XB_XSUB(j)  (1280 + 64 * (j))
#define XB_XGEN(j)  (2304 + 64 * (j))
#define XB_TOP      3328
#define XB_TOPGEN   3392
#define XCD_BAR_WORDS 3456
#define XB_SPIN_CAP (1u << 18)
__device__ __forceinline__ unsigned xb_ld(unsigned* p)              { return __hip_atomic_load(p, __ATOMIC_RELAXED, __HIP_MEMORY_SCOPE_AGENT); }
__device__ __forceinline__ unsigned xb_add(unsigned* p, unsigned v) { return __hip_atomic_fetch_add(p, v, __ATOMIC_RELAXED, __HIP_MEMORY_SCOPE_AGENT); }
__device__ __forceinline__ unsigned xb_xcc_id() { return (unsigned)__builtin_amdgcn_s_getreg((3 << 11) | 20) & 0xFu; }
#define XB_SPIN(cond, bar) do { unsigned _sp = 0; while (cond) { __builtin_amdgcn_s_sleep(1); \
    if ((++_sp & 255u) == 0u) { if (xb_ld(&(bar)[XB_TMO])) break; if (_sp > XB_SPIN_CAP) { atomicAdd(&(bar)[XB_TMO], 1u); break; } } } } while (0)
struct XcdBarrier { unsigned* bar; unsigned x; volatile LAS unsigned* st; };
__device__ __forceinline__ XcdBarrier xcd_barrier_post(unsigned* bar, volatile LAS unsigned* st) {
    XcdBarrier b; b.bar = bar; b.x = xb_xcc_id(); b.st = st;
    if (threadIdx.x == 0) (void)xb_add(&bar[XB_XCNT(b.x)], 1u);
    return b;
}
__device__ __forceinline__ void xcd_barrier_complete(unsigned* bar, unsigned x, unsigned& nloc, unsigned& nx) {
    const unsigned G = gridDim.x * gridDim.y * gridDim.z;
    unsigned sum, cnt, mine, sp = 0u;
    for (;;) {
        sum = 0u; cnt = 0u; mine = 0u;
#pragma unroll
        for (unsigned j = 0; j < 16; ++j) { const unsigned c = xb_ld(&bar[XB_XCNT(j)]); sum += c; cnt += (c > 0u) ? 1u : 0u; mine = (j == x) ? c : mine; }
        if (sum == G) break;
        __builtin_amdgcn_s_sleep(1);
        if ((++sp & 255u) == 0u) { if (xb_ld(&bar[XB_TMO])) break; if (sp > XB_SPIN_CAP) { atomicAdd(&bar[XB_TMO], 1u); break; } }
    }
    nloc = mine > 0u ? mine : 1u; nx = cnt > 0u ? cnt : 1u;
}
__device__ __forceinline__ void xcd_barrier(const XcdBarrier& b) {
    asm volatile("s_waitcnt vmcnt(0)" ::: "memory");
    __syncthreads();
    if (threadIdx.x == 0) {
        unsigned* bar = b.bar;
        __builtin_amdgcn_s_waitcnt(0);
        unsigned nloc = b.st[0], nx = b.st[1];
        if (nloc == 0u) { xcd_barrier_complete(bar, b.x, nloc, nx); b.st[0] = nloc; b.st[1] = nx; }
        const unsigned old = xb_add(&bar[XB_XSUB(b.x)], 1u);
        const unsigned gen = old / nloc;
        if (old + 1u == (gen + 1u) * nloc) {
            __builtin_amdgcn_fence(__ATOMIC_RELEASE, "agent");
            asm volatile("s_waitcnt vmcnt(0)" ::: "memory");
            const unsigned og = xb_add(&bar[XB_TOP], 1u);
            const unsigned tg = og / nx;
            if (og + 1u == (tg + 1u) * nx) xb_add(&bar[XB_TOPGEN], 1u);
            else XB_SPIN(xb_ld(&bar[XB_TOPGEN]) == tg, bar);
            __builtin_amdgcn_fence(__ATOMIC_ACQUIRE, "agent");
            xb_add(&bar[XB_XGEN(b.x)], 1u);
            asm volatile("s_waitcnt vmcnt(0)" ::: "memory");
        } else {
            XB_SPIN(xb_ld(&bar[XB_XGEN(b.x)]) == gen, bar);
            __builtin_amdgcn_fence(__ATOMIC_ACQUIRE, "agent");
            asm volatile("s_waitcnt vmcnt(0)" ::: "memory");
        }
    }
    __syncthreads();
}

struct Args {
    const float* in[21];
    float* out; unsigned char* ws;
    int ph_lo, ph_hi, flags, pad;
};
enum { I_X = 0, I_META, I_RELB, I_NMIX, I_WIN, I_BGATE, I_WAO, I_CONVW, I_CONVB, I_LNG, I_LNB, I_WCO, I_WOUT, I_NFFN, I_WR, I_BR, I_WUG, I_BUG, I_WD, I_BD, I_NFIN };

struct Frame {
    LAS unsigned char* lds;
    unsigned char* ws;
    int tid, lane, wave;
    int G, bid;
};
template <class T> __device__ __forceinline__ T* wsp(unsigned char* ws, size_t off) { return (T*)(ws + off); }

struct P0Desc { const float* src; bf16_t* dst; int ldn, ldk; };
__device__ __forceinline__ void p0_load(const P0Desc& d, f32x4 (&v)[16], int lane) {
    const float* p = d.src + (size_t)(lane >> 4) * d.ldn + (lane & 15) * 4;
#pragma unroll
    for (int i = 0; i < 16; ++i) v[i] = *(const f32x4*)(p + (size_t)(4 * i) * d.ldn);
}
__device__ __forceinline__ void p0_store(const P0Desc& d, const f32x4 (&v)[16], LAS float* scr, int lane) {
    const int n4 = (lane & 15) * 4, kr = lane >> 4;
#pragma unroll
    for (int i = 0; i < 16; ++i) { LAS float* p = scr + (4 * i + kr) * 65 + n4; p[0] = v[i][0]; p[1] = v[i][1]; p[2] = v[i][2]; p[3] = v[i][3]; }
    LDS_WAIT(); asm volatile("" ::: "memory");
    const int c = lane & 7;
#pragma unroll
    for (int j = 0; j < 8; ++j) { const int n = (lane >> 3) + 8 * j; const LAS float* s = scr + (8 * c) * 65 + n;
        u32x4 o; o.x = cvt_pk_bf16(s[0 * 65], s[1 * 65]); o.y = cvt_pk_bf16(s[2 * 65], s[3 * 65]); o.z = cvt_pk_bf16(s[4 * 65], s[5 * 65]); o.w = cvt_pk_bf16(s[6 * 65], s[7 * 65]);
        *(u32x4*)(d.dst + (size_t)n * d.ldk + 8 * c) = o; }
    LDS_WAIT(); asm volatile("" ::: "memory");
}
__device__ __forceinline__ void rms_row_to_bf16(const float* __restrict__ xrow, const float* __restrict__ g, bf16_t* __restrict__ orow, int lane) {
    const f32x4* xr = (const f32x4*)xrow + lane; const f32x4* gr = (const f32x4*)g + lane;
    f32x4 v[4]; float s = 0.f;
#pragma unroll
    for (int j = 0; j < 4; ++j) { v[j] = xr[64 * j]; s += (v[j].x * v[j].x + v[j].y * v[j].y) + (v[j].z * v[j].z + v[j].w * v[j].w); }
    const float r = 1.0f / sqrtf(wave_sum(s) * (1.f / DM) + EPS);
    unsigned long long* o8 = (unsigned long long*)orow + lane;
#pragma unroll
    for (int j = 0; j < 4; ++j) { const f32x4 gg = gr[64 * j];
        o8[64 * j] = (unsigned long long)cvt_pk_bf16(v[j].x * r * gg.x, v[j].y * r * gg.y) | ((unsigned long long)cvt_pk_bf16(v[j].z * r * gg.z, v[j].w * r * gg.w) << 32); }
}
__device__ __forceinline__ void p0_prologue(Frame& F, const Args& a, const int part) {
    LAS float* scr = (LAS float*)(F.lds + F.wave * 16896);
    const int gw = F.bid * NWAVES + F.wave, NGW = F.G * NWAVES;
    unsigned char* ws = F.ws;
    constexpr int T_IN = 81 * 16, T_AO = 16 * 8, T_CO = 16 * 8, T_OUT = 16 * 16, T_SMALL = T_IN + T_AO + T_CO + T_OUT;
    constexpr int T_UG = NE * 32 * 16, T_D = NE * 16 * 16, T_ALL = T_SMALL + T_UG + T_D;
    auto desc = [&](int it) -> P0Desc {
        int r = it; P0Desc d;
        if (r < T_IN) { const int g = r / 16, kb = r % 16; const int dr = g * 64; int sc;
            if (dr < WR_GLU) sc = dr;
            else if (dr < WR_GATE) { const int q = dr - WR_GLU, tile = q >> 8, hf = (q >> 7) & 1, w = q & 127; sc = SC_GLU + 512 * hf + 128 * tile + w; }
            else if (dr < WR_IK) sc = SC_GATE + (dr - WR_GATE);
            else sc = SC_IK + (dr - WR_IK);
            d.src = a.in[I_WIN] + (size_t)(kb * 64) * INCOLS + sc; d.ldn = INCOLS; d.dst = wsp<bf16_t>(ws, WS_WIN) + (size_t)dr * DM + kb * 64; d.ldk = DM; return d; }
        r -= T_IN;
        if (r < T_AO) { const int g = r / 8, kb = r % 8; d.src = a.in[I_WAO] + (size_t)(kb * 64) * DM + g * 64; d.ldn = DM; d.dst = wsp<bf16_t>(ws, WS_WAO) + (size_t)(g * 64) * AW + kb * 64; d.ldk = AW; return d; }
        r -= T_AO;
        if (r < T_CO) { const int g = r / 8, kb = r % 8; d.src = a.in[I_WCO] + (size_t)(kb * 64) * DM + g * 64; d.ldn = DM; d.dst = wsp<bf16_t>(ws, WS_WCO) + (size_t)(g * 64) * CC + kb * 64; d.ldk = CC; return d; }
        r -= T_CO;
        if (r < T_OUT) { const int g = r / 16, kb = r % 16; d.src = a.in[I_WOUT] + (size_t)(kb * 64) * DM + g * 64; d.ldn = DM; d.dst = wsp<bf16_t>(ws, WS_WOUT) + (size_t)(g * 64) * DM + kb * 64; d.ldk = DM; return d; }
        r -= T_OUT;
        if (r < T_UG) { const int e = r / 512, q = r % 512, g = q % 32, kb = q / 32; const int dr = g * 64, tile = dr >> 8, hf = (dr >> 7) & 1, w = dr & 127;
            d.src = a.in[I_WUG] + (size_t)e * DM * 2 * DFF + (size_t)(kb * 64) * (2 * DFF) + DFF * hf + 128 * tile + w; d.ldn = 2 * DFF;
            d.dst = wsp<bf16_t>(ws, WS_WUG) + (size_t)e * 2 * DFF * DM + (size_t)dr * DM + kb * 64; d.ldk = DM; return d; }
        r -= T_UG;
        { const int e = r / 256, q = r % 256, g = q % 16, kb = q / 16;
            d.src = a.in[I_WD] + (size_t)e * DFF * DM + (size_t)(kb * 64) * DM + g * 64; d.ldn = DM; d.dst = wsp<bf16_t>(ws, WS_WD) + (size_t)e * DM * DFF + (size_t)(g * 64) * DFF + kb * 64; d.ldk = DFF; return d; }
    };
    const int T_LO = part ? T_SMALL : 0, T_HI = part ? T_ALL : T_SMALL;
    if (T_LO + gw < T_HI) {
        f32x4 va[16], vb[16];
        P0Desc da = desc(T_LO + gw), db = da;
        p0_load(da, va, F.lane);
        for (int it = T_LO + gw; it < T_HI; it += 2 * NGW) {
            const int i1 = it + NGW, i2 = it + 2 * NGW;
            db = desc(i1 < T_HI ? i1 : it); p0_load(db, vb, F.lane);
            p0_store(da, va, scr, F.lane);
            da = desc(i2 < T_HI ? i2 : it); p0_load(da, va, F.lane);
            if (i1 < T_HI) p0_store(db, vb, scr, F.lane);
        }
    }
    if (part) return;
    { const int gt = F.bid * NTHREADS + F.tid;
      if (gt < 8 * DM / 2) { const int n = gt >> 9, k = (gt & 511) * 2; const float v0 = a.in[I_WIN][(size_t)k * INCOLS + SC_IW + n], v1 = a.in[I_WIN][(size_t)(k + 1) * INCOLS + SC_IW + n];
          *(unsigned*)(wsp<bf16_t>(ws, WS_WIN) + (size_t)(WR_IW + n) * DM + k) = cvt_pk_bf16(v0, v1); } }
    { const int gt = F.bid * NTHREADS + F.tid;
      if (gt < NE * DM / 2) { const int e = gt >> 9, d = (gt & 511) * 2; const float v0 = a.in[I_NFFN][d] * a.in[I_WR][(size_t)d * NE + e], v1 = a.in[I_NFFN][d + 1] * a.in[I_WR][(size_t)(d + 1) * NE + e];
          const unsigned hi = cvt_pk_bf16(v0, v1); const unsigned lo = cvt_pk_bf16(v0 - bflo(hi), v1 - bfhi(hi));
          *(unsigned*)(wsp<bf16_t>(ws, WS_WRT) + (size_t)e * DM + d) = hi; *(unsigned*)(wsp<bf16_t>(ws, WS_WRT) + (size_t)(NE + e) * DM + d) = lo; } }
    for (int m = gw; m < NTOK + NMETA; m += NGW) {
        if (m < NTOK) rms_row_to_bf16(a.in[I_X] + (size_t)m * DM, a.in[I_NMIX], wsp<bf16_t>(ws, WS_XN) + (size_t)m * DM, F.lane);
        else rms_row_to_bf16(a.in[I_META] + (size_t)(m - NTOK) * DM, a.in[I_NMIX], wsp<bf16_t>(ws, WS_XNM) + (size_t)(m - NTOK) * DM, F.lane);
    }
}

struct PlainSched {
    const char* ws; unsigned a_off, b_off; int K, nM, nN, nwg, G, c;
    __device__ __forceinline__ void init(const unsigned char* ws_, size_t a, size_t b, int M, int N, int K_, int G_, int c_) { ws = (const char*)ws_; a_off = (unsigned)a; b_off = (unsigned)b; K = K_; nM = M / 256; nN = N / 256; nwg = nM * nN; G = G_; c = c_; }
    __device__ __forceinline__ bool next(int i, pg8::Unit& u) const {
        const long L = (long)i * G + c; if (L >= nwg) return false;
        int wgid = (int)L; { const int q = nwg / 8, r = nwg % 8, xcd = wgid % 8, off = wgid / 8; wgid = (xcd < r ? xcd * (q + 1) : r * (q + 1) + (xcd - r) * q) + off; }
        const int nig = 8 * nN, gid = wgid / nig, fm = gid * 8, gsz = (nM - fm) < 8 ? (nM - fm) : 8;
        u.pm = fm + ((wgid % nig) % gsz); u.pn = (wgid % nig) / gsz; u.z = 0; return true;
    }
    __device__ __forceinline__ const char* a_base() const { return ws; }
    __device__ __forceinline__ void a_offs(const pg8::Unit& u, int tid, unsigned (&o)[2][2]) const {
        int R[2], C[2]; pg8::stage_rc(tid * 16, R[0], C[0]); pg8::stage_rc(tid * 16 + 8192, R[1], C[1]);
#pragma unroll
        for (int h = 0; h < 2; ++h)
#pragma unroll
            for (int i = 0; i < 2; ++i) o[h][i] = a_off + (unsigned)(((u.pm * 256 + h * 128 + R[i]) * K + C[i]) * 2);
    }
    __device__ __forceinline__ const char* b_base(const pg8::Unit& u) const { return ws + b_off + (size_t)u.pn * 256 * K * 2; }
};
struct MergeSched {
    const char* ws; int G, c;
    __device__ __forceinline__ bool next(int i, pg8::Unit& u) const {
        const int t = c + (i >> 1) * G;
        if (t >= 256) return false;
        u.pm = (t & 7) + 8 * (t >> 5); u.pn = (t >> 3) & 3; u.z = i & 1; return true;
    }
    __device__ __forceinline__ const char* a_base() const { return ws; }
    __device__ __forceinline__ void a_offs(const pg8::Unit& u, int tid, unsigned (&o)[2][2]) const {
        int R[2], C[2]; pg8::stage_rc(tid * 16, R[0], C[0]); pg8::stage_rc(tid * 16 + 8192, R[1], C[1]);
        const unsigned base = (unsigned)(u.z ? WS_CO : WS_AO);
#pragma unroll
        for (int h = 0; h < 2; ++h)
#pragma unroll
            for (int i = 0; i < 2; ++i) o[h][i] = base + (unsigned)(((u.pm * 256 + h * 128 + R[i]) * 512 + C[i]) * 2);
    }
    __device__ __forceinline__ const char* b_base(const pg8::Unit& u) const { return ws + (u.z ? WS_WCO : WS_WAO) + (size_t)u.pn * 256 * 512 * 2; }
};
struct MoeTables { const LAS int* cnt; const LAS int* tbase; };
template <int NC, bool GATHER>
struct MoeSched {
    const char* ws; MoeTables T; int G, c, total;
    __device__ __forceinline__ bool next(int i, pg8::Unit& u) const {
        const long L = (long)i * G + c; if (L >= total) return false;
        int wgid = (int)L; { const int q = total / 8, r = total % 8, xcd = wgid % 8, off = wgid / 8; wgid = (xcd < r ? xcd * (q + 1) : r * (q + 1) + (xcd - r) * q) + off; }
        int e = 0;
        for (int j = 1; j < NE; ++j) e += (wgid >= __builtin_amdgcn_readfirstlane(T.tbase[j]) * NC) ? 1 : 0;
        e = __builtin_amdgcn_readfirstlane(e);
        const int tb0 = __builtin_amdgcn_readfirstlane(T.tbase[e]), tb1 = __builtin_amdgcn_readfirstlane(T.tbase[e + 1]);
        const int loc = wgid - tb0 * NC, nt_e = tb1 - tb0;
        u.z = e; u.pm = loc % nt_e; u.pn = loc / nt_e; return true;
    }
    __device__ __forceinline__ const char* a_base() const { return ws; }
    __device__ __forceinline__ void a_offs(const pg8::Unit& u, int tid, unsigned (&o)[2][2]) const {
        int R[2], C[2]; pg8::stage_rc(tid * 16, R[0], C[0]); pg8::stage_rc(tid * 16 + 8192, R[1], C[1]);
        if (GATHER) {
            const int* list = (const int*)(ws + WS_LIST) + (size_t)u.z * NTOK; const int n = __builtin_amdgcn_readfirstlane(T.cnt[u.z]);
#pragma unroll
            for (int h = 0; h < 2; ++h)
#pragma unroll
                for (int i = 0; i < 2; ++i) { const int p = u.pm * 256 + h * 128 + R[i]; const int tok = list[p < n ? p : 0];
                    o[h][i] = (unsigned)WS_XN + (unsigned)((tok * DM + C[i]) * 2); }
        } else {
            const int row0 = (__builtin_amdgcn_readfirstlane(T.tbase[u.z]) + u.pm) * 256;
#pragma unroll
            for (int h = 0; h < 2; ++h)
#pragma unroll
                for (int i = 0; i < 2; ++i) o[h][i] = (unsigned)WS_ACT + (unsigned)(((row0 + h * 128 + R[i]) * DFF + C[i]) * 2);
        }
    }
    __device__ __forceinline__ const char* b_base(const pg8::Unit& u) const {
        if (GATHER) return ws + WS_WUG + ((size_t)u.z * 2 * DFF + (size_t)u.pn * 256) * DM * 2;
        else return ws + WS_WD + ((size_t)u.z * DM + (size_t)u.pn * 256) * DFF * 2;
    }
};

#define EPI_ROWS(ai, m) for (int ai = 0; ai < 2; ++ai) _Pragma("unroll") for (int m = 0; m < 4; ++m)
#define EPI_COLS(bj, n) for (int bj = 0; bj < 2; ++bj) _Pragma("unroll") for (int n = 0; n < 2; ++n)
__device__ __forceinline__ void st_bf16x4(bf16_t* p, f32x4 v) { u32x2 w; w.x = cvt_pk_bf16(v[0], v[1]); w.y = cvt_pk_bf16(v[2], v[3]); *(u32x2*)p = w; }

struct EpiInProj {
    unsigned char* ws; const float* bgate;
    __device__ __forceinline__ void operator()(const f32x4 (&acc)[2][2][4][2], const pg8::Unit& u, int wr, int wc, int fr, int fq) const {
        const int pn = u.pn, row0 = u.pm * 256 + wr * 64 + fr, col0 = wc * 32 + 4 * fq;
        const int bidx = u.pm >> 3;
        const int rowk0 = row0 + NMETA * (bidx + 1);
        if (pn < 2 || (pn >= 6 && pn < 8)) {
            bf16_t* O = wsp<bf16_t>(ws, pn < 2 ? WS_Q : WS_IQ); const int cb = (pn & 1) * 256; const float sc = pn < 2 ? QSCALE : 1.0f;
#pragma unroll
            EPI_ROWS(ai, m) { bf16_t* rp = O + (size_t)(row0 + ai * 128 + m * 16) * AW + cb + col0;
#pragma unroll
                EPI_COLS(bj, n) st_bf16x4(rp + bj * 128 + n * 16, acc[ai][bj][m][n] * sc); }
        } else if (pn < 4) {
            bf16_t* O = wsp<bf16_t>(ws, WS_KB); const int cb = (pn & 1) * 256;
#pragma unroll
            EPI_ROWS(ai, m) { bf16_t* rp = O + (size_t)(rowk0 + ai * 128 + m * 16) * AW + cb + col0;
#pragma unroll
                EPI_COLS(bj, n) st_bf16x4(rp + bj * 128 + n * 16, acc[ai][bj][m][n]); }
        } else if (pn < 6) {
            bf16_t* O = wsp<bf16_t>(ws, WS_VT) + (size_t)bidx * AW * TP; const int cb = (pn & 1) * 256;
            const int t0 = (row0 & (SEQ - 1)) + NMETA + VOFF;
#pragma unroll
            EPI_ROWS(ai, m) { const int t = t0 + ai * 128 + m * 16;
#pragma unroll
                EPI_COLS(bj, n) { const f32x4 v = acc[ai][bj][m][n]; bf16_t* cp = O + (size_t)(cb + col0 + bj * 128 + n * 16) * TP + (t & ~1);
                    const float p0 = __shfl_xor(v[0], 1), p1 = __shfl_xor(v[1], 1), p2 = __shfl_xor(v[2], 1), p3 = __shfl_xor(v[3], 1);
                    if ((fr & 1) == 0) { *(unsigned*)(cp) = cvt_pk_bf16(v[0], p0); *(unsigned*)(cp + TP) = cvt_pk_bf16(v[1], p1); }
                    else { *(unsigned*)(cp + 2 * TP) = cvt_pk_bf16(p2, v[2]); *(unsigned*)(cp + 3 * TP) = cvt_pk_bf16(p3, v[3]); } } }
        } else if (pn < 12) {
            bf16_t* O = wsp<bf16_t>(ws, WS_GLU); const int cb = (pn - 8) * 128;
#pragma unroll
            EPI_ROWS(ai, m) { bf16_t* rp = O + (size_t)(rowk0 + ai * 128 + m * 16) * CC + cb + col0;
#pragma unroll
                for (int n = 0; n < 2; ++n) { const f32x4 av = acc[ai][0][m][n], gv = acc[ai][1][m][n]; f32x4 y;
#pragma unroll
                    for (int j = 0; j < 4; ++j) y[j] = av[j] * sigmoidf_(gv[j]);
                    st_bf16x4(rp + n * 16, y); } }
        } else {
            const int gt = pn - 12; bf16_t* O = wsp<bf16_t>(ws, gt < 4 ? WS_GA : WS_GB); const int cb = (gt & 3) * 256; const float* bp = bgate + gt * 256 + col0;
            f32x4 bv[2][2];
#pragma unroll
            EPI_COLS(bj, n) bv[bj][n] = *(const f32x4*)(bp + bj * 128 + n * 16);
#pragma unroll
            EPI_ROWS(ai, m) { bf16_t* rp = O + (size_t)(row0 + ai * 128 + m * 16) * DM + cb + col0;
#pragma unroll
                EPI_COLS(bj, n) { const f32x4 x = acc[ai][bj][m][n] + bv[bj][n]; f32x4 y;
#pragma unroll
                    for (int j = 0; j < 4; ++j) y[j] = sigmoidf_(x[j]);
                    st_bf16x4(rp + bj * 128 + n * 16, y); } }
        }
    }
};
struct EpiMerge {
    unsigned char* ws;
    __device__ __forceinline__ void operator()(const f32x4 (&acc)[2][2][4][2], const pg8::Unit& u, int wr, int wc, int fr, int fq) const {
        const int row0 = u.pm * 256 + wr * 64 + fr, col0 = u.pn * 256 + wc * 32 + 4 * fq;
        const bf16_t* Gt = wsp<bf16_t>(ws, u.z ? WS_GB : WS_GA); bf16_t* O = wsp<bf16_t>(ws, WS_MG);
#pragma unroll
        EPI_ROWS(ai, m) { const size_t ro = (size_t)(row0 + ai * 128 + m * 16) * DM + col0;
#pragma unroll
            EPI_COLS(bj, n) { const size_t o = ro + bj * 128 + n * 16; const u32x2 g = *(const u32x2*)(Gt + o); const f32x4 a = acc[ai][bj][m][n];
                f32x4 y = (f32x4){bflo(g.x) * a[0], bfhi(g.x) * a[1], bflo(g.y) * a[2], bfhi(g.y) * a[3]};
                if (u.z) { const u32x2 p = *(const u32x2*)(O + o); y[0] += bflo(p.x); y[1] += bfhi(p.x); y[2] += bflo(p.y); y[3] += bfhi(p.y); }
                st_bf16x4(O + o, y); } }
    }
};
struct EpiResid {
    const float* x; float* out;
    __device__ __forceinline__ void operator()(const f32x4 (&acc)[2][2][4][2], const pg8::Unit& u, int wr, int wc, int fr, int fq) const {
        const int row0 = u.pm * 256 + wr * 64 + fr, col0 = u.pn * 256 + wc * 32 + 4 * fq;
#pragma unroll
        EPI_ROWS(ai, m) { const size_t ro = (size_t)(row0 + ai * 128 + m * 16) * DM + col0;
#pragma unroll
            EPI_COLS(bj, n) { const size_t o = ro + bj * 128 + n * 16; *(f32x4*)(out + o) = *(const f32x4*)(x + o) + acc[ai][bj][m][n]; } }
    }
};
struct EpiSwiglu {
    unsigned char* ws; const float* bug; MoeTables T;
    __device__ __forceinline__ void operator()(const f32x4 (&acc)[2][2][4][2], const pg8::Unit& u, int wr, int wc, int fr, int fq) const {
        const int e = u.z, n_e = __builtin_amdgcn_readfirstlane(T.cnt[e]), rloc0 = u.pm * 256 + wr * 64 + fr, row0 = __builtin_amdgcn_readfirstlane(T.tbase[e]) * 256 + rloc0, col0 = u.pn * 128 + wc * 32 + 4 * fq;
        const float* bp = bug + (size_t)e * 2 * DFF + col0; bf16_t* O = wsp<bf16_t>(ws, WS_ACT); const float* rg = wsp<float>(ws, WS_RG) + (size_t)e * NTOK;
        f32x4 bg[2], bu[2];
#pragma unroll
        for (int n = 0; n < 2; ++n) { bg[n] = *(const f32x4*)(bp + n * 16); bu[n] = *(const f32x4*)(bp + DFF + n * 16); }
        float rvs[2][4];
#pragma unroll
        EPI_ROWS(ai, m) { const int rl = rloc0 + ai * 128 + m * 16; rvs[ai][m] = rg[rl < n_e ? rl : 0]; }
        bf16_t* const sink = wsp<bf16_t>(ws, WS_DUMMY) + col0;
#pragma unroll
        EPI_ROWS(ai, m) { const int rl = rloc0 + ai * 128 + m * 16; bf16_t* rp = (rl < n_e) ? O + (size_t)(row0 + ai * 128 + m * 16) * DFF + col0 : sink; const float rv = rvs[ai][m];
#pragma unroll
                for (int n = 0; n < 2; ++n) { const f32x4 gv = acc[ai][0][m][n] * rv + bg[n], uv = acc[ai][1][m][n] * rv + bu[n]; f32x4 y;
#pragma unroll
                    for (int j = 0; j < 4; ++j) { const float g = fminf(gv[j], 7.0f), up = fminf(fmaxf(uv[j], -7.0f), 7.0f); y[j] = (up + 1.0f) * g * sigmoidf_(1.702f * g); }
                    st_bf16x4(rp + n * 16, y); } }
    }
};
struct EpiDown {
    unsigned char* ws; const float* bd; MoeTables T;
    __device__ __forceinline__ void operator()(const f32x4 (&acc)[2][2][4][2], const pg8::Unit& u, int wr, int wc, int fr, int fq) const {
        const int e = u.z, n_e = __builtin_amdgcn_readfirstlane(T.cnt[e]), rloc0 = u.pm * 256 + wr * 64 + fr, row0 = __builtin_amdgcn_readfirstlane(T.tbase[e]) * 256 + rloc0, col0 = u.pn * 256 + wc * 32 + 4 * fq;
        const float* bp = bd + (size_t)e * DM + col0; bf16_t* O = wsp<bf16_t>(ws, WS_YP); const float* lg = wsp<float>(ws, WS_LG) + (size_t)e * NTOK;
        f32x4 bv[2][2];
#pragma unroll
        EPI_COLS(bj, n) bv[bj][n] = *(const f32x4*)(bp + bj * 128 + n * 16);
        float gts[2][4];
#pragma unroll
        EPI_ROWS(ai, m) { const int rl = rloc0 + ai * 128 + m * 16; gts[ai][m] = lg[rl < n_e ? rl : 0]; }
        bf16_t* const sink = wsp<bf16_t>(ws, WS_DUMMY) + col0;
#pragma unroll
        EPI_ROWS(ai, m) { const int rl = rloc0 + ai * 128 + m * 16; const float gt = gts[ai][m]; bf16_t* rp = (rl < n_e) ? O + (size_t)(row0 + ai * 128 + m * 16) * DM + col0 : sink;
#pragma unroll
                EPI_COLS(bj, n) st_bf16x4(rp + bj * 128 + n * 16, (acc[ai][bj][m][n] + bv[bj][n]) * gt); }
    }
};

template <int NT>
__device__ __forceinline__ void wave_mm16(const bf16_t* __restrict__ A, int lda, const bf16_t* const (&Bt)[NT], int K, int lane, f32x4 (&acc)[NT]) {
    const bf16_t* ap = A + (size_t)(lane & 15) * lda + 8 * (lane >> 4);
    const bf16_t* bp[NT];
#pragma unroll
    for (int t = 0; t < NT; ++t) { bp[t] = Bt[t] + (size_t)(lane & 15) * K + 8 * (lane >> 4); acc[t] = (f32x4){0.f, 0.f, 0.f, 0.f}; }
#pragma unroll (NT == 1 ? 16 : 8)
    for (int k0 = 0; k0 < K; k0 += 32) {
        const bf16x8 a = *(const bf16x8*)(ap + k0);
#pragma unroll
        for (int t = 0; t < NT; ++t) { const bf16x8 b = *(const bf16x8*)(bp[t] + k0); acc[t] = __builtin_amdgcn_mfma_f32_16x16x32_bf16(b, a, acc[t], 0, 0, 0); }
    }
}
__device__ __forceinline__ void p1_thin(Frame& F, int dbgflags) {
    unsigned char* ws = F.ws;
    const bf16_t* WIN = wsp<bf16_t>(ws, WS_WIN); const bf16_t* XN = wsp<bf16_t>(ws, WS_XN); const bf16_t* XNM = wsp<bf16_t>(ws, WS_XNM);
    bf16_t* KB = wsp<bf16_t>(ws, WS_KB); bf16_t* VT = wsp<bf16_t>(ws, WS_VT); bf16_t* IK = wsp<bf16_t>(ws, WS_IK); bf16_t* GLU = wsp<bf16_t>(ws, WS_GLU); float* IW = wsp<float>(ws, WS_IW);
    const int gw = F.bid * NWAVES + F.wave, NGW = F.G * NWAVES, lane = F.lane, tk = lane & 15, nq = lane >> 4;
    {
        constexpr int WBP = 2064;
        LAS unsigned char* lds = F.lds;
        __syncthreads();
        { const unsigned char* src = (const unsigned char*)(WIN + (size_t)WR_IK * DM);
          for (int p = F.tid; p < 72 * 128; p += NTHREADS) { const int row = p >> 7, c16 = p & 127; *(LAS u32x4*)(lds + row * WBP + c16 * 16) = *(const u32x4*)(src + (size_t)row * DM * 2 + c16 * 16); } }
        __syncthreads();
        const int tg = F.wave & 3, hf = F.wave >> 2, kq = nq;
        for (int tb = F.bid; tb < NTOK / 64; tb += F.G) {
            const int m = tb * 64 + 16 * tg + tk, rowk = m + NMETA * ((m >> 11) + 1);
            const bf16_t* xr = XN + (size_t)m * DM + 16 * kq;
            bf16x8 xa[16], xb[16];
#pragma unroll
            for (int sblk = 0; sblk < 16; ++sblk) { xa[sblk] = *(const bf16x8*)(xr + 64 * sblk); xb[sblk] = *(const bf16x8*)(xr + 64 * sblk + 8); }
            const LAS unsigned char* wb = lds + tk * WBP + 32 * kq;
            if (hf == 0) {
                f32x4 acc[3] = {{0.f, 0.f, 0.f, 0.f}, {0.f, 0.f, 0.f, 0.f}, {0.f, 0.f, 0.f, 0.f}};
#pragma unroll
                for (int sblk = 0; sblk < 16; ++sblk)
#pragma unroll
                    for (int t = 0; t < 3; ++t) { const bf16x8 b0 = *(const LAS bf16x8*)(wb + 16 * t * WBP + 128 * sblk), b1 = *(const LAS bf16x8*)(wb + 16 * t * WBP + 128 * sblk + 16);
                        acc[t] = __builtin_amdgcn_mfma_f32_16x16x32_bf16(b0, xa[sblk], acc[t], 0, 0, 0); acc[t] = __builtin_amdgcn_mfma_f32_16x16x32_bf16(b1, xb[sblk], acc[t], 0, 0, 0); }
#pragma unroll
                for (int t = 0; t < 3; ++t) st_bf16x4(IK + (size_t)rowk * IDXD + 16 * t + 4 * nq, acc[t]);
            } else {
                f32x4 acc[2] = {{0.f, 0.f, 0.f, 0.f}, {0.f, 0.f, 0.f, 0.f}};
#pragma unroll
                for (int sblk = 0; sblk < 16; ++sblk)
#pragma unroll
                    for (int t = 0; t < 2; ++t) { const bf16x8 b0 = *(const LAS bf16x8*)(wb + 16 * (3 + t) * WBP + 128 * sblk), b1 = *(const LAS bf16x8*)(wb + 16 * (3 + t) * WBP + 128 * sblk + 16);
                        acc[t] = __builtin_amdgcn_mfma_f32_16x16x32_bf16(b0, xa[sblk], acc[t], 0, 0, 0); acc[t] = __builtin_amdgcn_mfma_f32_16x16x32_bf16(b1, xb[sblk], acc[t], 0, 0, 0); }
                st_bf16x4(IK + (size_t)rowk * IDXD + 48 + 4 * nq, acc[0]);
                if (nq < 2) *(f32x4*)(IW + (size_t)m * 8 + 4 * nq) = acc[1];
            }
        }
        __syncthreads();
    }
    if (!(dbgflags & 256)) for (int task = gw; task < 100; task += NGW) {
        if (task < 32) {
            const bf16_t* const Bt[1] = {WIN + (size_t)(SC_K + 16 * task) * DM}; f32x4 acc[1]; wave_mm16<1>(XNM, DM, Bt, DM, lane, acc);
            for (int b = 0; b < NB; ++b) st_bf16x4(KB + (size_t)(b * TT + tk) * AW + 16 * task + 4 * nq, acc[0]);
        } else if (task < 64) {
            const int t = task - 32; const bf16_t* const Bt[1] = {WIN + (size_t)(SC_V + 16 * t) * DM}; f32x4 acc[1]; wave_mm16<1>(XNM, DM, Bt, DM, lane, acc);
            const float p0 = __shfl_xor(acc[0][0], 1), p1 = __shfl_xor(acc[0][1], 1), p2 = __shfl_xor(acc[0][2], 1), p3 = __shfl_xor(acc[0][3], 1);
            const unsigned wa = (tk & 1) ? cvt_pk_bf16(p2, acc[0][2]) : cvt_pk_bf16(acc[0][0], p0), wb = (tk & 1) ? cvt_pk_bf16(p3, acc[0][3]) : cvt_pk_bf16(acc[0][1], p1);
            for (int b = 0; b < NB; ++b) { bf16_t* cp = VT + ((size_t)b * AW + 16 * t + 4 * nq + 2 * (tk & 1)) * TP + VOFF + (tk & ~1);
                *(unsigned*)cp = wa; *(unsigned*)(cp + TP) = wb; }
        } else if (task < 68) {
            const int t = task - 64; const bf16_t* const Bt[1] = {WIN + (size_t)(WR_IK + 16 * t) * DM}; f32x4 acc[1]; wave_mm16<1>(XNM, DM, Bt, DM, lane, acc);
            for (int b = 0; b < NB; ++b) st_bf16x4(IK + (size_t)(b * TT + tk) * IDXD + 16 * t + 4 * nq, acc[0]);
        } else {
            const int c16 = task - 68; const int ar = WR_GLU + 256 * (c16 >> 3) + 16 * (c16 & 7);
            const bf16_t* const Bt[2] = {WIN + (size_t)ar * DM, WIN + (size_t)(ar + 128) * DM}; f32x4 acc[2]; wave_mm16<2>(XNM, DM, Bt, DM, lane, acc);
            f32x4 y;
#pragma unroll
            for (int j = 0; j < 4; ++j) y[j] = acc[0][j] * sigmoidf_(acc[1][j]);
            for (int b = 0; b < NB; ++b) st_bf16x4(GLU + (size_t)(b * TT + tk) * CC + 16 * c16 + 4 * nq, y);
        }
    }
}

__device__ __forceinline__ void p2_conv(Frame& F, const Args& a) {
    unsigned char* ws = F.ws;
    LAS unsigned char* xs = F.lds;
    LAS float* wl = (LAS float*)(F.lds + 63488);
    const bf16_t* GLU = wsp<bf16_t>(ws, WS_GLU); bf16_t* CO = wsp<bf16_t>(ws, WS_CO);
    const float* cw = a.in[I_CONVW];
    for (int idx = F.tid; idx < CW * 128; idx += NTHREADS) { const int tap = idx >> 7, c4 = idx & 127; const f32x4 v = *(const f32x4*)(cw + tap * CC + 4 * c4); *(LAS f32x4*)(wl + tap * 512 + (c4 & 1) * 256 + (c4 >> 1) * 4) = v; }
    const int lane = F.lane, c0 = 8 * lane;
    for (int tile = F.bid; tile < NTOK / 32; tile += F.G) {
        const int b = tile >> 6, s0 = (tile & 63) * 32, p0 = NMETA + s0;
        __syncthreads();
        for (int idx = F.tid; idx < 62 * 64; idx += NTHREADS) { const int r = idx >> 6, ch = idx & 63, p = p0 - 30 + r; u32x4 v = (u32x4){0u, 0u, 0u, 0u};
            if (p >= 0) v = *(const u32x4*)(GLU + (size_t)(b * TT + p) * CC + ch * 8);
            *(LAS u32x4*)(xs + r * 1024 + ch * 16) = v; }
        __syncthreads();
        const int i0 = 4 * F.wave;
        float acc[4][8];
#pragma unroll
        for (int t = 0; t < 4; ++t)
#pragma unroll
            for (int i = 0; i < 8; ++i) acc[t][i] = 0.f;
        const LAS float* wlb = wl + lane * 4; asm volatile("" : "+v"(wlb));
        const LAS unsigned char* xsb = xs + i0 * 1024 + lane * 16; asm volatile("" : "+v"(xsb));
#pragma unroll 1
        for (int tap = 0; tap < CW; ++tap) {
            const f32x4 w0 = *(const LAS f32x4*)(wlb + tap * 512), w1 = *(const LAS f32x4*)(wlb + tap * 512 + 256);
#pragma unroll
            for (int t = 0; t < 4; ++t) {
                const u32x4 xv = *(const LAS u32x4*)(xsb + (tap + t) * 1024);
                acc[t][0] += w0[0] * bflo(xv.x); acc[t][1] += w0[1] * bfhi(xv.x); acc[t][2] += w0[2] * bflo(xv.y); acc[t][3] += w0[3] * bfhi(xv.y);
                acc[t][4] += w1[0] * bflo(xv.z); acc[t][5] += w1[1] * bfhi(xv.z); acc[t][6] += w1[2] * bflo(xv.w); acc[t][7] += w1[3] * bfhi(xv.w);
            }
        }
        float cb[8], lg[8], lb[8];
        { const f32x4* p0 = (const f32x4*)(a.in[I_CONVB] + c0); const f32x4* p1 = (const f32x4*)(a.in[I_LNG] + c0); const f32x4* p2 = (const f32x4*)(a.in[I_LNB] + c0);
#pragma unroll
          for (int hh = 0; hh < 2; ++hh) { const f32x4 u0 = p0[hh], u1 = p1[hh], u2 = p2[hh];
#pragma unroll
              for (int i = 0; i < 4; ++i) { cb[4 * hh + i] = u0[i]; lg[4 * hh + i] = u1[i]; lb[4 * hh + i] = u2[i]; } } }
#pragma unroll
        for (int t = 0; t < 4; ++t) {
            float s = 0.f;
#pragma unroll
            for (int i = 0; i < 8; ++i) { acc[t][i] += cb[i]; s += acc[t][i]; }
            const float mean = wave_sum(s) * (1.f / CC); float q = 0.f;
#pragma unroll
            for (int i = 0; i < 8; ++i) { acc[t][i] -= mean; q += acc[t][i] * acc[t][i]; }
            const float rstd = 1.0f / sqrtf(wave_sum(q) * (1.f / CC) + EPS);
            float y[8];
#pragma unroll
            for (int i = 0; i < 8; ++i) { const float z = acc[t][i] * rstd * lg[i] + lb[i]; y[i] = z * sigmoidf_(z); }
            u32x4 o; o.x = cvt_pk_bf16(y[0], y[1]); o.y = cvt_pk_bf16(y[2], y[3]); o.z = cvt_pk_bf16(y[4], y[5]); o.w = cvt_pk_bf16(y[6], y[7]);
            *(u32x4*)(CO + (size_t)(b * SEQ + s0 + i0 + t) * CC + c0) = o;
        }
    }
    __syncthreads();
}

constexpr int ROWP = 2080, NJ = 33;
__device__ __forceinline__ unsigned f2ord(float f) { const unsigned b = __float_as_uint(f); return b ^ ((b >> 31) ? 0xffffffffu : 0x80000000u); }
__device__ __forceinline__ int wave_isum(int v) {
#pragma unroll
    for (int o = 1; o < 64; o <<= 1) v += __shfl_xor(v, o);
    return v;
}
__device__ __forceinline__ int wave_isum_dpp(int v) {
    v += __builtin_amdgcn_update_dpp(0, v, 0xB1, 0xF, 0xF, false);
    v += __builtin_amdgcn_update_dpp(0, v, 0x4E, 0xF, 0xF, false);
    v += __builtin_amdgcn_update_dpp(0, v, 0x141, 0xF, 0xF, false);
    v += __builtin_amdgcn_update_dpp(0, v, 0x140, 0xF, 0xF, false);
    return __builtin_amdgcn_readlane(v, 0) + __builtin_amdgcn_readlane(v, 16) + __builtin_amdgcn_readlane(v, 32) + __builtin_amdgcn_readlane(v, 48);
}
__device__ __forceinline__ void p2_indexer_unit(Frame& F, int b, int q16, int flags) {
    unsigned char* ws = F.ws;
    const bf16_t* IQ = wsp<bf16_t>(ws, WS_IQ); const bf16_t* IK = wsp<bf16_t>(ws, WS_IK); const float* IW = wsp<float>(ws, WS_IW); unsigned* MASK = wsp<unsigned>(ws, WS_MASK);
    LAS unsigned* SU = (LAS unsigned*)F.lds;
    const int lane = F.lane, c = lane & 31, hi = lane >> 5, w = F.wave;
    const int nwblk = (q16 >> 1) + 2;
    if (!(flags & 4)) {
        const int tok0 = b * SEQ + 16 * q16;
        bf16x8 af[4][4]; f32x4 wq[4][4];
#pragma unroll
        for (int g = 0; g < 4; ++g) {
            const bf16_t* ap = IQ + (size_t)(tok0 + 4 * g + (c >> 3)) * AW + (c & 7) * IDXD + 8 * hi;
#pragma unroll
            for (int ks = 0; ks < 4; ++ks) af[g][ks] = *(const bf16x8*)(ap + 16 * ks);
#pragma unroll
            for (int q = 0; q < 4; ++q) wq[g][q] = *(const f32x4*)(IW + (size_t)(tok0 + 4 * g + q) * 8 + 4 * hi);
        }
        const int rel0 = NMETA + 16 * q16 + 2 * hi - c;
        const bf16_t* kp = IK + (size_t)(b * TT + c) * IDXD + 8 * hi;
        LAS unsigned* srow = SU + (2 * hi) * ROWP + c;
        bf16x8 bfr[4], bnx[4];
#pragma unroll
        for (int ks = 0; ks < 4; ++ks) { bfr[ks] = *(const bf16x8*)(kp + (size_t)(w < nwblk ? w : 0) * 32 * IDXD + 16 * ks); bnx[ks] = bfr[ks]; }
#pragma unroll
        for (int g = 0; g < 4; ++g) asm volatile("" :: "v"(af[g][0]), "v"(af[g][1]), "v"(af[g][2]), "v"(af[g][3]), "v"(wq[g][0]), "v"(wq[g][1]), "v"(wq[g][2]), "v"(wq[g][3]));
        asm volatile("" :: "v"(bfr[0]), "v"(bfr[1]), "v"(bfr[2]), "v"(bfr[3]));
        for (int blk = w; blk < nwblk; blk += 8) {
            {
                const int bn_ = blk + 8 < nwblk ? blk + 8 : blk;
#pragma unroll
                for (int ks = 0; ks < 4; ++ks) bnx[ks] = *(const bf16x8*)(kp + (size_t)bn_ * 32 * IDXD + 16 * ks); }
#pragma unroll
            for (int g = 0; g < 4; ++g) {
                f32x16 acc = {};
#pragma unroll
                for (int ks = 0; ks < 4; ++ks) acc = __builtin_amdgcn_mfma_f32_32x32x16_bf16(af[g][ks], bfr[ks], acc, 0, 0, 0);
                float part[4];
#pragma unroll
                for (int q = 0; q < 4; ++q) { float s = wq[g][q][0] * __builtin_amdgcn_fmed3f(acc[4 * q], 0.f, INFINITY);
#pragma unroll
                    for (int i = 1; i < 4; ++i) s = __builtin_fmaf(wq[g][q][i], __builtin_amdgcn_fmed3f(acc[4 * q + i], 0.f, INFINITY), s);
                    part[q] = s; }
#pragma unroll
                for (int p = 0; p < 2; ++p) {
                    const auto rr = __builtin_amdgcn_permlane32_swap(__float_as_uint(part[p]), __float_as_uint(part[p + 2]), false, false);
                    const float sc = __uint_as_float(rr[0]) + __uint_as_float(rr[1]);
                    srow[(4 * g + p) * ROWP + 32 * blk] = (32 * blk <= rel0 + 4 * g + p) ? f2ord(sc) : 0u; }
            }
#pragma unroll
            for (int ks = 0; ks < 4; ++ks) bfr[ks] = bnx[ks];
        }
    }
    __syncthreads();
    if (!(flags & 8)) {
        const int nj = (nwblk + 1) >> 1, klim = 32 * nwblk;
        unsigned U[NJ][2];
#pragma unroll
        for (int j = 0; j < NJ; ++j) {
            if (j < nj) { const int key = 64 * j + lane;
#pragma unroll
                for (int p = 0; p < 2; ++p) U[j][p] = (key < klim) ? SU[(2 * w + p) * ROWP + key] : 0u; }
            else { U[j][0] = 0u; U[j][1] = 0u; }
        }
        const int tokb = b * SEQ + 16 * q16 + 2 * w;
        unsigned lo[2], hb[2], thr[2], veq[2]; int chi[2], need[2]; bool done[2];
#pragma unroll
        for (int p = 0; p < 2; ++p) { lo[p] = 1u; hb[p] = 0xffffffffu; chi[p] = 0; need[p] = 0; veq[p] = 0u; thr[p] = 1u; done[p] = (NMETA + 16 * q16 + 2 * w + p + 1 <= TOPK); }
        for (int it = 0; it < 34; ++it) {
            if (done[0] && done[1]) break;
            unsigned mid[2]; int cl[2];
#pragma unroll
            for (int p = 0; p < 2; ++p) { mid[p] = lo[p] + ((hb[p] - lo[p]) >> 1); cl[p] = 0; }
#pragma unroll
            for (int g = 0; g < 3; ++g) if (11 * g < nj) {
#pragma unroll
                for (int jj = 0; jj < 11; ++jj)
#pragma unroll
                    for (int p = 0; p < 2; ++p) cl[p] += (U[11 * g + jj][p] >= mid[p]) ? 1 : 0; }
            const int tot = wave_isum_dpp(cl[0] | (cl[1] << 16));
            int cnt[2] = {tot & 0xffff, tot >> 16};
#ifdef DBG_CHECK_DPP
            if (wave_isum(cl[0]) != cnt[0] || wave_isum(cl[1]) != cnt[1]) __hip_atomic_store(wsp<unsigned>(ws, WS_CTL) + 3, 1u, RLX_AGENT);
#endif
#pragma unroll
            for (int p = 0; p < 2; ++p) {
                const int ct = cnt[p];
                if (!done[p]) {
                    if (ct == TOPK) { done[p] = true; thr[p] = mid[p]; need[p] = 0; }
                    else if (ct > TOPK) lo[p] = mid[p];
                    else { hb[p] = mid[p]; chi[p] = ct; }
                    if (!done[p] && hb[p] - lo[p] == 1u) { done[p] = true; thr[p] = hb[p]; veq[p] = lo[p]; need[p] = TOPK - chi[p]; }
                }
            }
        }
#pragma unroll
        for (int p = 0; p < 2; ++p) {
            int run = 0;
            unsigned long long* mrow = (unsigned long long*)(MASK + (size_t)(tokb + p) * MSTR);
#pragma unroll
            for (int j = 0; j < NJ; ++j) if (j < nj) {
                const unsigned u = U[j][p];
                const bool eq = (need[p] > 0) && (u == veq[p]);
                const unsigned long long em = __ballot(eq);
                const int rank = run + (int)__builtin_amdgcn_mbcnt_hi((unsigned)(em >> 32), __builtin_amdgcn_mbcnt_lo((unsigned)em, 0u));
                const bool take = (u >= thr[p]) || (eq && rank < need[p]);
                run += __popcll(em);
                const unsigned long long sm = __ballot(take);
                if (lane == 0) mrow[j] = sm;
            }
        }
    }
    __syncthreads();
}
__device__ __forceinline__ void p2_indexer(Frame& F, int flags, int half) {
    for (int i = F.bid; i < 256; i += F.G) { const int b = i >> 5, j = 2 * (i & 31);
        if (half == 0) { p2_indexer_unit(F, b, j, flags); p2_indexer_unit(F, b, 127 - j, flags); }
        else { p2_indexer_unit(F, b, j + 1, flags); p2_indexer_unit(F, b, 126 - j, flags); } }
}

__device__ const unsigned char T5B[128] = {0, 1, 2, 3, 4, 5, 6, 7, 8, 9, 10, 11, 12, 13, 14, 15, 16, 16, 16, 17, 17, 18, 18, 18, 19, 19, 19, 20, 20, 20, 20, 21, 21, 21, 21, 22, 22, 22, 22, 22, 23, 23, 23, 23, 23, 23, 24, 24, 24, 24, 24, 24, 25, 25, 25, 25, 25, 25, 25, 26, 26, 26, 26, 26, 26, 26, 26, 27, 27, 27, 27, 27, 27, 27, 27, 27, 27, 28, 28, 28, 28, 28, 28, 28, 28, 28, 28, 29, 29, 29, 29, 29, 29, 29, 29, 29, 29, 29, 29, 30, 30, 30, 30, 30, 30, 30, 30, 30, 30, 30, 30, 30, 30, 31, 31, 31, 31, 31, 31, 31, 31, 31, 31, 31, 31, 31, 31, 31};
constexpr int TBS = 132;
__device__ __forceinline__ int crow(int r, int hi) { return (r & 3) + 8 * (r >> 2) + 4 * hi; }
constexpr int KPITCH = 144, VPITCH = 136;
constexpr int AT_K = 0, AT_V = AT_K + 2 * 64 * KPITCH, AT_TB = AT_V + 2 * 64 * VPITCH, AT_SC = AT_TB + NH * TBS * 4, AT_END = AT_SC + NWAVES * 128;
static_assert(AT_END <= RING_BYTES, "attention LDS map");
__device__ __forceinline__ void p3_attn_unit(Frame& F, int b, int h, int Q) {
    unsigned char* ws = F.ws;
    const bf16_t* Qm = wsp<bf16_t>(ws, WS_Q); const bf16_t* KB = wsp<bf16_t>(ws, WS_KB); const bf16_t* VT = wsp<bf16_t>(ws, WS_VT); const unsigned* MASK = wsp<unsigned>(ws, WS_MASK); bf16_t* AO = wsp<bf16_t>(ws, WS_AO);
    LAS unsigned char* lds = F.lds;
    const LAS float* tbh = (const LAS float*)(lds + AT_TB) + h * TBS;
    LAS float* sc = (LAS float*)(lds + AT_SC) + F.wave * 32;
    const int tid = F.tid, lane = F.lane, c = lane & 31, hi = lane >> 5, w = F.wave;
    const int qb32 = 8 * Q + w, tokq = b * SEQ + 32 * qb32 + c, posq = NMETA + 32 * qb32 + c;
    const int ktmax = (47 + 32 * qb32) >> 6, NT = 4 * Q + 5;
    bf16x8 qf[4];
#pragma unroll
    for (int ks = 0; ks < 4; ++ks) qf[ks] = *(const bf16x8*)(Qm + (size_t)tokq * AW + h * HD + 16 * ks + 8 * hi);
    const unsigned long long* mrow = (const unsigned long long*)(MASK + (size_t)tokq * MSTR);
    const int srow = tid >> 3, piece = tid & 7;
    const bf16_t* kg = KB + (size_t)(b * TT + srow) * AW + h * HD + piece * 8;
    const bf16_t* vg = VT + ((size_t)b * AW + h * HD + srow) * TP + piece * 8;
    LAS unsigned char* kl = lds + AT_K + srow * KPITCH + piece * 16;
    LAS unsigned char* vl = lds + AT_V + srow * VPITCH + piece * 16;
    const LAS unsigned char* kfb = lds + AT_K + c * KPITCH + 16 * hi;
    const LAS unsigned char* vfb = lds + AT_V + c * VPITCH + 8 * hi;
    const unsigned NEGB = 0xff800000u;
    const float bfar = tbh[128];
    float m_abs = 0.f; bool has = false;
    f32x16 O0 = {}, O1 = {}, LS = {}, CI;
#pragma unroll
    for (int r = 0; r < 16; ++r) CI[r] = bfar;
    const bf16x8 ones = __builtin_bit_cast(bf16x8, ((u32x4){0x3f803f80u, 0x3f803f80u, 0x3f803f80u, 0x3f803f80u}));
    u32x4 kr = *(const u32x4*)kg, vr = *(const u32x4*)vg;
    unsigned long long mwn = mrow[0];
    *(LAS u32x4*)kl = kr; *(LAS u32x2*)vl = (u32x2){vr.x, vr.y}; *(LAS u32x2*)(vl + 8) = (u32x2){vr.z, vr.w};
    __syncthreads();
    for (int kt = 0; kt < NT; ++kt) {
        const int buf = kt & 1;
        const unsigned long long mw = mwn;
        if (kt + 1 < NT) { kr = *(const u32x4*)(kg + (size_t)(kt + 1) * 64 * AW); vr = *(const u32x4*)(vg + (kt + 1) * 64); if (kt + 1 <= ktmax) mwn = mrow[kt + 1]; }
        if (kt <= ktmax) {
            const LAS unsigned char* kp = kfb + buf * 64 * KPITCH;
            f32x16 S0 = CI, S1 = CI;
#pragma unroll
            for (int ks = 0; ks < 4; ++ks) {
                const bf16x8 k0 = *(const LAS bf16x8*)(kp + ks * 32), k1 = *(const LAS bf16x8*)(kp + 32 * KPITCH + ks * 32);
                S0 = __builtin_amdgcn_mfma_f32_32x32x16_bf16(k0, qf[ks], S0, 0, 0, 0);
                S1 = __builtin_amdgcn_mfma_f32_32x32x16_bf16(k1, qf[ks], S1, 0, 0, 0);
            }
            const int mw0 = (int)((unsigned)mw >> (4 * hi)), mw1 = (int)((unsigned)(mw >> 32) >> (4 * hi));
            const bool far = (256 * Q + 32 * w - 64 * kt) >= 175;
            if (!far) {
                const int d0 = posq - 64 * kt - 4 * hi;
#pragma unroll
                for (int r = 0; r < 16; ++r) { const int ko = (r & 3) + 8 * (r >> 2);
                    int da = d0 - ko, db = d0 - 32 - ko; da = da < 0 ? 0 : (da > 128 ? 128 : da); db = db < 0 ? 0 : (db > 128 ? 128 : db);
                    S0[r] += tbh[da] - bfar; S1[r] += tbh[db] - bfar; }
            }
            float tmax = -INFINITY;
#pragma unroll
            for (int r = 0; r < 16; ++r) { const int ko = (r & 3) + 8 * (r >> 2);
                const unsigned t0 = (unsigned)__builtin_amdgcn_sbfe(mw0, ko, 1), t1 = (unsigned)__builtin_amdgcn_sbfe(mw1, ko, 1);
                S0[r] = __uint_as_float((__float_as_uint(S0[r]) & t0) | (NEGB & ~t0)); S1[r] = __uint_as_float((__float_as_uint(S1[r]) & t1) | (NEGB & ~t1));
                tmax = fmaxf(tmax, fmaxf(S0[r], S1[r])); }
            tmax = fmaxf(tmax, __shfl_xor(tmax, 32));
            if (__any(tmax > 8.0f || (!has && tmax > -INFINITY))) {
                const bool upd = tmax > -INFINITY && (!has || tmax > 0.f);
                const float dl = upd ? tmax : 0.f;
                const float alpha = has ? __builtin_amdgcn_exp2f(-dl) : 1.0f;
                m_abs += dl; has = has || upd;
#pragma unroll
                for (int r = 0; r < 16; ++r) { S0[r] -= dl; S1[r] -= dl; CI[r] = bfar - m_abs; }
                if (hi == 0) sc[c] = alpha;
                LDS_WAIT(); asm volatile("" ::: "memory");
#pragma unroll
                for (int r = 0; r < 16; ++r) { const float f = sc[crow(r, hi)]; O0[r] *= f; O1[r] *= f; LS[r] *= f; }
                LDS_WAIT(); asm volatile("" ::: "memory");
            }
#pragma unroll
            for (int r = 0; r < 16; ++r) { S0[r] = __builtin_amdgcn_exp2f(S0[r]); S1[r] = __builtin_amdgcn_exp2f(S1[r]); }
            const LAS unsigned char* vp = vfb + buf * 64 * VPITCH;
#pragma unroll
            for (int s2 = 0; s2 < 4; ++s2) {
                u32x4 pw;
                if (s2 < 2) { const int o = 8 * (s2 & 1); pw.x = cvt_pk_bf16(S0[o + 0], S0[o + 1]); pw.y = cvt_pk_bf16(S0[o + 2], S0[o + 3]); pw.z = cvt_pk_bf16(S0[o + 4], S0[o + 5]); pw.w = cvt_pk_bf16(S0[o + 6], S0[o + 7]); }
                else { const int o = 8 * (s2 & 1); pw.x = cvt_pk_bf16(S1[o + 0], S1[o + 1]); pw.y = cvt_pk_bf16(S1[o + 2], S1[o + 3]); pw.z = cvt_pk_bf16(S1[o + 4], S1[o + 5]); pw.w = cvt_pk_bf16(S1[o + 6], S1[o + 7]); }
                const bf16x8 pf = __builtin_bit_cast(bf16x8, pw);
                const u32x2 a0 = *(const LAS u32x2*)(vp + s2 * 32), a1 = *(const LAS u32x2*)(vp + s2 * 32 + 16);
                const u32x2 b0 = *(const LAS u32x2*)(vp + 32 * VPITCH + s2 * 32), b1 = *(const LAS u32x2*)(vp + 32 * VPITCH + s2 * 32 + 16);
                const bf16x8 v0 = __builtin_bit_cast(bf16x8, ((u32x4){a0.x, a0.y, a1.x, a1.y})), v1 = __builtin_bit_cast(bf16x8, ((u32x4){b0.x, b0.y, b1.x, b1.y}));
                O0 = __builtin_amdgcn_mfma_f32_32x32x16_bf16(pf, v0, O0, 0, 0, 0);
                O1 = __builtin_amdgcn_mfma_f32_32x32x16_bf16(pf, v1, O1, 0, 0, 0);
                LS = __builtin_amdgcn_mfma_f32_32x32x16_bf16(pf, ones, LS, 0, 0, 0);
            }
        }
        if (kt + 1 < NT) { LAS unsigned char* k2 = kl + (buf ^ 1) * 64 * KPITCH; LAS unsigned char* v2 = vl + (buf ^ 1) * 64 * VPITCH;
            *(LAS u32x4*)k2 = kr; *(LAS u32x2*)v2 = (u32x2){vr.x, vr.y}; *(LAS u32x2*)(v2 + 8) = (u32x2){vr.z, vr.w}; }
        __syncthreads();
    }
    bf16_t* ob = AO + (size_t)(b * SEQ + 32 * qb32) * AW + h * HD + c;
#pragma unroll
    for (int r = 0; r < 16; ++r) { const int qr = crow(r, hi); const float f = __builtin_amdgcn_rcpf(LS[r]);
        const float a0 = O0[r] * f, a1 = O1[r] * f, b0 = __shfl_xor(a0, 1), b1 = __shfl_xor(a1, 1);
        if ((c & 1) == 0) { *(unsigned*)(ob + (size_t)qr * AW) = cvt_pk_bf16(a0, b0); *(unsigned*)(ob + (size_t)qr * AW + 32) = cvt_pk_bf16(a1, b1); } }
}
__device__ __forceinline__ void p3_attn(Frame& F, const Args& a) {
    LAS float* tb = (LAS float*)(F.lds + AT_TB);
    __syncthreads();
    for (int idx = F.tid; idx < NH * 129; idx += NTHREADS) { const int h = idx / 129, d = idx % 129; const int bk = d < 128 ? (int)T5B[d] : 31; tb[h * TBS + d] = a.in[I_RELB][bk * NH + h] * LOG2E; }
    __syncthreads();
    for (int i = F.bid; i < 256; i += F.G) { const int bh = i >> 2, j = i & 3; p3_attn_unit(F, bh >> 3, bh & 7, j); p3_attn_unit(F, bh >> 3, bh & 7, 7 - j); }
    __syncthreads();
}

constexpr int WLP = 2064;
constexpr int P6_WHI = 0, P6_WLO = NE * WLP, P6_PART = 2 * NE * WLP, P6_SSP = P6_PART + 2 * 64 * 33 * 4, P6_CNT = P6_SSP + 2 * 64 * 4, P6_END = P6_CNT + 256;
static_assert(P6_END <= LDSX_OFF, "router LDS map");
__device__ __forceinline__ void p6_router(Frame& F, const Args& a) {
    unsigned char* ws = F.ws;
    const float* H1 = wsp<float>(ws, WS_H1); bf16_t* HN = wsp<bf16_t>(ws, WS_XN);
    const float* gf = a.in[I_NFFN]; const float* brt = a.in[I_BR];
    int* TE = wsp<int>(ws, WS_TE); int* TPs = wsp<int>(ws, WS_TP); int* LIST = wsp<int>(ws, WS_LIST); float* LG = wsp<float>(ws, WS_LG); float* RG = wsp<float>(ws, WS_RG);
    unsigned* ecnt = wsp<unsigned>(ws, WS_CTL) + CW_ECNT;
    LAS unsigned char* lds = F.lds;
    LAS float* part = (LAS float*)(lds + P6_PART);
    LAS float* ssp = (LAS float*)(lds + P6_SSP);
    LAS int* lcnt = (LAS int*)(lds + P6_CNT);
    LAS int* lbase = lcnt + 32;
    const int lane = F.lane, w = F.wave, tk = lane & 15, kq = lane >> 4;
    __syncthreads();
    { const unsigned char* src = ws + WS_WRT;
      for (int p = F.tid; p < 2 * NE * 128; p += NTHREADS) { const int arr = p >> 12, row = (p >> 7) & 31, c16 = p & 127;
          *(LAS u32x4*)(lds + arr * (NE * WLP) + row * WLP + c16 * 16) = *(const u32x4*)(src + (size_t)arr * NE * DM * 2 + (size_t)row * DM * 2 + c16 * 16); } }
    for (int tb = F.bid; tb < NTOK / 64; tb += F.G) {
        const int t0 = tb * 64;
        __syncthreads();
        if (F.tid < 32) lcnt[F.tid] = 0;
        {
            const int tg = w & 3, kh = w >> 2, tok = t0 + 16 * tg + tk;
            const float* xr = H1 + (size_t)tok * DM + 512 * kh + 8 * kq; const float* gr = gf + 512 * kh + 8 * kq;
            bf16_t* hr = HN + (size_t)tok * DM + 512 * kh + 8 * kq;
            const LAS unsigned char* wl = lds + tk * WLP + (512 * kh + 8 * kq) * 2;
            f32x4 xa[16], xb[16];
#pragma unroll
            for (int ks = 0; ks < 16; ++ks) { xa[ks] = *(const f32x4*)(xr + 32 * ks); xb[ks] = *(const f32x4*)(xr + 32 * ks + 4); }
            f32x4 acc0 = {0.f, 0.f, 0.f, 0.f}, acc1 = acc0; float ss = 0.f;
#pragma unroll
            for (int ks = 0; ks < 16; ++ks) {
                const f32x4 g0 = *(const f32x4*)(gr + 32 * ks), g1 = *(const f32x4*)(gr + 32 * ks + 4);
                const f32x4 x0 = xa[ks], x1 = xb[ks];
                u32x4 hn; hn.x = cvt_pk_bf16(x0[0] * g0[0], x0[1] * g0[1]); hn.y = cvt_pk_bf16(x0[2] * g0[2], x0[3] * g0[3]); hn.z = cvt_pk_bf16(x1[0] * g1[0], x1[1] * g1[1]); hn.w = cvt_pk_bf16(x1[2] * g1[2], x1[3] * g1[3]);
                *(u32x4*)(hr + 32 * ks) = hn;
                ss += (x0[0] * x0[0] + x0[1] * x0[1]) + (x0[2] * x0[2] + x0[3] * x0[3]) + (x1[0] * x1[0] + x1[1] * x1[1]) + (x1[2] * x1[2] + x1[3] * x1[3]);
                u32x4 xh; xh.x = cvt_pk_bf16(x0[0], x0[1]); xh.y = cvt_pk_bf16(x0[2], x0[3]); xh.z = cvt_pk_bf16(x1[0], x1[1]); xh.w = cvt_pk_bf16(x1[2], x1[3]);
                u32x4 xl; xl.x = cvt_pk_bf16(x0[0] - bflo(xh.x), x0[1] - bfhi(xh.x)); xl.y = cvt_pk_bf16(x0[2] - bflo(xh.y), x0[3] - bfhi(xh.y));
                          xl.z = cvt_pk_bf16(x1[0] - bflo(xh.z), x1[1] - bfhi(xh.z)); xl.w = cvt_pk_bf16(x1[2] - bflo(xh.w), x1[3] - bfhi(xh.w));
                const bf16x8 fxh = __builtin_bit_cast(bf16x8, xh), fxl = __builtin_bit_cast(bf16x8, xl);
                const bf16x8 wh0 = *(const LAS bf16x8*)(wl + P6_WHI + ks * 64), wh1 = *(const LAS bf16x8*)(wl + P6_WHI + 16 * WLP + ks * 64);
                const bf16x8 wl0 = *(const LAS bf16x8*)(wl + P6_WLO + ks * 64), wl1 = *(const LAS bf16x8*)(wl + P6_WLO + 16 * WLP + ks * 64);
                acc0 = __builtin_amdgcn_mfma_f32_16x16x32_bf16(wh0, fxh, acc0, 0, 0, 0); acc1 = __builtin_amdgcn_mfma_f32_16x16x32_bf16(wh1, fxh, acc1, 0, 0, 0);
                acc0 = __builtin_amdgcn_mfma_f32_16x16x32_bf16(wl0, fxh, acc0, 0, 0, 0); acc1 = __builtin_amdgcn_mfma_f32_16x16x32_bf16(wl1, fxh, acc1, 0, 0, 0);
                acc0 = __builtin_amdgcn_mfma_f32_16x16x32_bf16(wh0, fxl, acc0, 0, 0, 0); acc1 = __builtin_amdgcn_mfma_f32_16x16x32_bf16(wh1, fxl, acc1, 0, 0, 0);
            }
            ss += __shfl_xor(ss, 16); ss += __shfl_xor(ss, 32);
            LAS float* pp = part + ((kh * 64) + 16 * tg + tk) * 33 + 4 * kq;
#pragma unroll
            for (int r = 0; r < 4; ++r) { pp[r] = acc0[r]; pp[16 + r] = acc1[r]; }
            if (kq == 0) ssp[kh * 64 + 16 * tg + tk] = ss;
        }
        __syncthreads();
        if (w == 0) {
            const float rinv = 1.0f / sqrtf((ssp[lane] + ssp[64 + lane]) * (1.f / DM) + EPS);
            float lg[NE];
#pragma unroll
            for (int e = 0; e < NE; ++e) lg[e] = (part[lane * 33 + e] + part[(64 + lane) * 33 + e]) * rinv + brt[e];
            int sel[4]; float val[4];
#pragma unroll
            for (int j = 0; j < 4; ++j) { float best = -INFINITY; int bi = 0;
#pragma unroll
                for (int e = 0; e < NE; ++e) { const bool tk_ = lg[e] > best; best = tk_ ? lg[e] : best; bi = tk_ ? e : bi; }
                sel[j] = bi; val[j] = best;
#pragma unroll
                for (int e = 0; e < NE; ++e) lg[e] = (e == bi) ? -INFINITY : lg[e]; }
            float den = 0.f, ex[4];
#pragma unroll
            for (int j = 0; j < 4; ++j) { ex[j] = __expf(val[j] - val[0]); den += ex[j]; }
            int slot[4];
#pragma unroll
            for (int j = 0; j < 4; ++j) slot[j] = __hip_atomic_fetch_add(&lcnt[sel[j]], 1, __ATOMIC_RELAXED, __HIP_MEMORY_SCOPE_WORKGROUP);
            LDS_WAIT();
            if (lane < 32) { const int n = lcnt[lane]; lbase[lane] = n ? (int)__hip_atomic_fetch_add(ecnt + 64 * lane, (unsigned)n, RLX_AGENT) : 0; }
            LDS_WAIT(); asm volatile("" ::: "memory");
            const int t = t0 + lane;
#pragma unroll
            for (int j = 0; j < 4; ++j) { const int e = sel[j], pos = lbase[e] + slot[j]; const float g = ex[j] / den;
                TE[t * 4 + j] = e; TPs[t * 4 + j] = pos; LIST[(size_t)e * NTOK + pos] = t; LG[(size_t)e * NTOK + pos] = g; RG[(size_t)e * NTOK + pos] = rinv; }
        }
    }
    __syncthreads();
}
__device__ __forceinline__ void moe_tables(Frame& F, LAS int* cnt, LAS int* tbase) {
    const unsigned* ecnt = wsp<unsigned>(F.ws, WS_CTL) + CW_ECNT;
    __syncthreads();
    if (F.tid < NE) cnt[F.tid] = (int)__hip_atomic_load(ecnt + 64 * F.tid, RLX_AGENT);
    __syncthreads();
    if (F.tid == 0) { int s = 0; for (int e = 0; e < NE; ++e) { tbase[e] = s; s += (cnt[e] + 255) >> 8; } tbase[NE] = s; }
    __syncthreads();
}

__device__ __forceinline__ void p9_final(Frame& F, const Args& a, const LAS int* tbase) {
    unsigned char* ws = F.ws;
    const float* H1 = wsp<float>(ws, WS_H1); float* OUT = a.out; const bf16_t* YP = wsp<bf16_t>(ws, WS_YP); const int* TE = wsp<int>(ws, WS_TE); const int* TPs = wsp<int>(ws, WS_TP); const float* gf = a.in[I_NFIN];
    const int gw = F.bid * NWAVES + F.wave, NGW = F.G * NWAVES, lane = F.lane;
    const f32x4* gr = (const f32x4*)gf + lane;
    f32x4 gg[4];
#pragma unroll
    for (int j = 0; j < 4; ++j) gg[j] = gr[64 * j];
#ifdef DBG_CHECK_DPP
    if (__hip_atomic_load(wsp<unsigned>(ws, WS_CTL) + 3, RLX_AGENT) != 0u) { const float qn = __builtin_nanf("");
#pragma unroll
        for (int j = 0; j < 4; ++j) gg[j] = (f32x4){qn, qn, qn, qn}; }
#endif
    for (int base = 0; base < NTOK; base += 8 * NGW) {
        int myrow = 0;
        { const int i = lane >> 2, j = lane & 3, t = base + gw + NGW * i; if (lane < 32 && t < NTOK) { const int e = TE[t * 4 + j], pos = TPs[t * 4 + j]; myrow = tbase[e] * 256 + pos; } }
        f32x4 va[4], vb[4]; u32x2 ya[4][4], yb[4][4];
#define P9_LOAD(i, V, Y) do { const int t_ = base + gw + NGW * (i); if (t_ < NTOK) { const f32x4* xr_ = (const f32x4*)(H1 + (size_t)t_ * DM) + lane; \
            _Pragma("unroll") for (int j_ = 0; j_ < 4; ++j_) V[j_] = xr_[64 * j_]; \
            _Pragma("unroll") for (int q_ = 0; q_ < 4; ++q_) { const int row_ = __builtin_amdgcn_readlane(myrow, 4 * (i) + q_); const u32x2* yr_ = (const u32x2*)(YP + (size_t)row_ * DM) + lane; \
                _Pragma("unroll") for (int j_ = 0; j_ < 4; ++j_) Y[q_][j_] = yr_[64 * j_]; } } } while (0)
#define P9_PROC(i, V, Y) do { const int t_ = base + gw + NGW * (i); if (t_ < NTOK) { \
            _Pragma("unroll") for (int q_ = 0; q_ < 4; ++q_) _Pragma("unroll") for (int j_ = 0; j_ < 4; ++j_) { const u32x2 y_ = Y[q_][j_]; V[j_].x += bflo(y_.x); V[j_].y += bfhi(y_.x); V[j_].z += bflo(y_.y); V[j_].w += bfhi(y_.y); } \
            float s_ = 0.f; _Pragma("unroll") for (int j_ = 0; j_ < 4; ++j_) s_ += (V[j_].x * V[j_].x + V[j_].y * V[j_].y) + (V[j_].z * V[j_].z + V[j_].w * V[j_].w); \
            const float r_ = 1.0f / sqrtf(wave_sum(s_) * (1.f / DM) + EPS); f32x4* xo_ = (f32x4*)(OUT + (size_t)t_ * DM) + lane; \
            _Pragma("unroll") for (int j_ = 0; j_ < 4; ++j_) xo_[64 * j_] = (f32x4){V[j_].x * r_ * gg[j_].x, V[j_].y * r_ * gg[j_].y, V[j_].z * r_ * gg[j_].z, V[j_].w * r_ * gg[j_].w}; } } while (0)
        P9_LOAD(0, va, ya);
#pragma unroll
        for (int i = 0; i < 8; i += 2) {
            P9_LOAD(i + 1, vb, yb);
            P9_PROC(i, va, ya);
            if (i + 2 < 8) P9_LOAD(i + 2, va, ya);
            P9_PROC(i + 1, vb, yb);
        }
#undef P9_LOAD
#undef P9_PROC
    }
}

constexpr int N_PHASES = 10;
__global__ void __launch_bounds__(NTHREADS, 2) fwd_kernel(Args args) {
    extern __shared__ __attribute__((aligned(16))) unsigned char lds_raw[];
    Frame F;
    F.lds = (LAS unsigned char*)lds_raw; F.ws = args.ws;
    F.tid = threadIdx.x; F.lane = F.tid & 63; F.wave = __builtin_amdgcn_readfirstlane(F.tid >> 6);
    F.G = gridDim.x; F.bid = blockIdx.x;
    volatile LAS unsigned* MISC = (volatile LAS unsigned*)(F.lds + MISC_OFF);
    if (F.tid < 32) MISC[F.tid] = 0u;
    __syncthreads();
    unsigned* ctl = wsp<unsigned>(args.ws, WS_CTL);
    const int lo = args.ph_lo, hi = args.ph_hi;
    const bool multi = (hi - lo) > 1;
    XcdBarrier bar; bar.bar = ctl + CW_BAR; bar.x = 0; bar.st = nullptr;
    if (multi) bar = xcd_barrier_post(ctl + CW_BAR, MISC + 8);
#ifndef PHASE_MASK
#define PHASE_MASK 0x3ff
#endif
#define IN(k) (((PHASE_MASK >> (k)) & 1) && lo <= (k) && (k) < hi)
#define SEAM(k) do { if (IN(k) && IN((k) + 1)) xcd_barrier(bar); } while (0)
    LAS int* l_cnt = (LAS int*)(F.lds + LDSX_OFF); LAS int* l_tbase = l_cnt + 64;
    const MoeTables MT{l_cnt, l_tbase};

    if (IN(0)) { p0_prologue(F, args, 0); } SEAM(0);
    if (IN(1)) {
        PlainSched S; S.init(args.ws, WS_XN, WS_WIN, NTOK, 5120, DM, F.G, F.bid);
        EpiInProj E{args.ws, args.in[I_BGATE]};
        if (!(args.flags & 64)) pg8::gemm_phase<EpiInProj, PlainSched>(F.lds, DM, S, E);
        if (!(args.flags & 128)) p1_thin(F, args.flags);
    } SEAM(1);
    if (IN(2)) {
        const int cvt_slot = (F.bid >> 3) % 3;
        if (cvt_slot == 0 && !(args.flags & 1024)) { p0_prologue(F, args, 1); __syncthreads(); }
        if (!(args.flags & 1)) p2_conv(F, args);
        if (!(args.flags & 2)) p2_indexer(F, args.flags, 0);
        if (cvt_slot == 1 && !(args.flags & 1024)) { __syncthreads(); p0_prologue(F, args, 1); __syncthreads(); }
        if (!(args.flags & 2)) p2_indexer(F, args.flags, 1);
        if (cvt_slot == 2 && !(args.flags & 1024)) { __syncthreads(); p0_prologue(F, args, 1); }
    } SEAM(2);
    if (IN(3)) { p3_attn(F, args); } SEAM(3);
    if (IN(4)) {
        MergeSched S{(const char*)args.ws, F.G, F.bid}; EpiMerge E{args.ws};
        pg8::gemm_phase<EpiMerge, MergeSched>(F.lds, 512, S, E);
    } SEAM(4);
    if (IN(5)) {
        PlainSched S; S.init(args.ws, WS_MG, WS_WOUT, NTOK, DM, DM, F.G, F.bid);
        EpiResid E{args.in[I_X], wsp<float>(args.ws, WS_H1)};
        pg8::gemm_phase<EpiResid, PlainSched>(F.lds, DM, S, E);
    } SEAM(5);
    if (IN(6)) { p6_router(F, args); } SEAM(6);
    if (IN(7)) {
        moe_tables(F, l_cnt, l_tbase);
        MoeSched<8, true> S{(const char*)args.ws, MT, F.G, F.bid, l_tbase[NE] * 8};
        EpiSwiglu E{args.ws, args.in[I_BUG], MT};
        pg8::gemm_phase<EpiSwiglu, MoeSched<8, true>>(F.lds, DM, S, E);
    } SEAM(7);
    if (IN(8)) {
        moe_tables(F, l_cnt, l_tbase);
        MoeSched<4, false> S{(const char*)args.ws, MT, F.G, F.bid, l_tbase[NE] * 4};
        EpiDown E{args.ws, args.in[I_BD], MT};
        pg8::gemm_phase<EpiDown, MoeSched<4, false>>(F.lds, DFF, S, E);
    } SEAM(8);
    if (IN(9)) { moe_tables(F, l_cnt, l_tbase); p9_final(F, args, l_tbase); }
#undef IN
#undef SEAM
}

#ifdef DBG_HASH_OFF
__global__ void dbg_hash(const unsigned* __restrict__ buf, size_t nwords, unsigned* acc) {
    unsigned h = 0u;
    for (size_t i = (size_t)blockIdx.x * blockDim.x + threadIdx.x; i < nwords; i += (size_t)gridDim.x * blockDim.x) h += (buf[i] ^ (unsigned)(i * 2654435761u)) * 2246822519u + (unsigned)i;
#pragma unroll
    for (int o = 1; o < 64; o <<= 1) h += __shfl_xor(h, o);
    if ((threadIdx.x & 63) == 0) atomicAdd(acc, h);
}
__global__ void dbg_fill(float* out, size_t n, const unsigned* acc) {
    const unsigned h = *acc; const float v = (float)((h >> 7) & 0xffffu) * (1.0f / 4096.0f) + 1.0f;
    for (size_t i = (size_t)blockIdx.x * blockDim.x + threadIdx.x; i < n; i += (size_t)gridDim.x * blockDim.x) out[i] = v;
}
#endif

extern "C" void kernel_launch(void* const* d_in, const int* in_sizes, int n_in, void* d_out, int out_size, void* d_ws, size_t ws_size, hipStream_t stream) {
    static int grid = 0;
    if (grid == 0) {
        if (n_in != 21 || out_size != NTOK * DM || ws_size < WS_END) { fprintf(stderr, "kernel_launch: unexpected shapes (n_in %d, out %d, ws %zu < %zu)\n", n_in, out_size, ws_size, (size_t)WS_END); grid = -1; return; }
        int dev = 0, cus = 0, per_cu = 0;
        if (hipGetDevice(&dev) != hipSuccess || hipDeviceGetAttribute(&cus, hipDeviceAttributeMultiprocessorCount, dev) != hipSuccess) { grid = -1; return; }
        if (hipFuncSetAttribute((const void*)fwd_kernel, hipFuncAttributeMaxDynamicSharedMemorySize, LDS_BYTES) != hipSuccess) { fprintf(stderr, "kernel_launch: hipFuncSetAttribute failed\n"); grid = -1; return; }
        if (hipOccupancyMaxActiveBlocksPerMultiprocessor(&per_cu, (const void*)fwd_kernel, NTHREADS, LDS_BYTES) != hipSuccess || per_cu < 1) { fprintf(stderr, "kernel_launch: occupancy query says %d\n", per_cu); }
        (void)hipGetLastError();
        grid = cus;
    }
    if (grid < 0) return;
    (void)hipMemsetAsync((char*)d_ws + WS_CTL, 0, CTL_ZERO_BYTES, stream);
    Args a{};
    for (int i = 0; i < 21; ++i) a.in[i] = (const float*)d_in[i];
    a.out = (float*)d_out; a.ws = (unsigned char*)d_ws;
#if MK_N_LAUNCHES == 1
    a.ph_lo = 0; a.ph_hi = N_PHASES;
    hipLaunchKernelGGL(fwd_kernel, dim3(grid), dim3(NTHREADS), LDS_BYTES, stream, a);
#else
#ifndef DBG_LAST_PHASE
#define DBG_LAST_PHASE (N_PHASES - 1)
#endif
#ifndef DBG_DUP_MASK
#define DBG_DUP_MASK 0
#endif
#ifndef DBG_DUP_FLAGS
#define DBG_DUP_FLAGS 0
#endif
    for (int p = 0; p <= DBG_LAST_PHASE; ++p) { a.ph_lo = p; a.ph_hi = p + 1;
        const int nrep = ((DBG_DUP_MASK >> p) & 1) ? 2 : 1;
        for (int rep = 0; rep < nrep; ++rep) { a.flags = (nrep == 2 && rep == 0) ? DBG_DUP_FLAGS : 0; if (rep == 1 && p == 6) (void)hipMemsetAsync((char*)d_ws + WS_CTL, 0, CTL_ZERO_BYTES, stream);
            hipLaunchKernelGGL(fwd_kernel, dim3(grid), dim3(NTHREADS), LDS_BYTES, stream, a); } }
#ifdef DBG_HASH_OFF
    { const unsigned* hb = DBG_HASH_OFF == 0 ? (const unsigned*)d_out : (const unsigned*)((char*)d_ws + DBG_HASH_OFF);
      hipLaunchKernelGGL(dbg_hash, dim3(1024), dim3(256), 0, stream, hb, (size_t)(DBG_HASH_BYTES) / 4, (unsigned*)d_ws + 2);
      hipLaunchKernelGGL(dbg_fill, dim3(1024), dim3(256), 0, stream, (float*)d_out, (size_t)NTOK * DM, (const unsigned*)d_ws + 2); }
#endif
#endif
}
```

```cpp
#include <hip/hip_runtime.h>
#include <cstdio>
#include <cstdint>

#ifndef MK_N_LAUNCHES
#define MK_N_LAUNCHES 1
#endif

constexpr int NB = 8, SEQ = 2048, NMETA = 16, TT = SEQ + NMETA  , DM = 1024, NTOK = NB * SEQ  , NALL = NB * TT  ;
constexpr int AW = 512, NH = 8, HD = 64, IDXD = 64, CC = 512, CW = 31, NE = 32, DFF = 1024, TOPK = 256;
constexpr int INCOLS = 5192, TP = 2176  , VOFF = 0  , MSTR = 68  ;
constexpr float EPS = 1e-6f, LOG2E = 1.4426950408889634f;
constexpr float QSCALE = 0.125f * LOG2E;
constexpr int MAXTILES = 296;
constexpr int SC_Q = 0, SC_K = 512, SC_V = 1024, SC_IQ = 1536, SC_IK = 2048, SC_IW = 2112, SC_GLU = 2120, SC_GATE = 3144;
constexpr int WR_GLU = 2048, WR_GATE = 3072, WR_IK = 5120, WR_IW = 5184, WIN_ROWS = 5376;

constexpr size_t MiB = 1u << 20;
constexpr size_t al4k(size_t x) { return (x + 4095) & ~(size_t)4095; }
constexpr size_t WS_CTL = 0, CTL_ZERO_BYTES = 1 * MiB;
constexpr size_t WS_WIN = 1 * MiB;
constexpr size_t WS_WAO = WS_WIN + al4k((size_t)WIN_ROWS * DM * 2);
constexpr size_t WS_WCO = WS_WAO + al4k((size_t)DM * AW * 2);
constexpr size_t WS_WOUT = WS_WCO + al4k((size_t)DM * CC * 2);
constexpr size_t WS_WUG = WS_WOUT + al4k((size_t)DM * DM * 2);
constexpr size_t WS_WD = WS_WUG + al4k((size_t)NE * 2 * DFF * DM * 2);
constexpr size_t WS_XN = WS_WD + al4k((size_t)NE * DM * DFF * 2);
constexpr size_t WS_XNM = WS_XN + al4k((size_t)NTOK * DM * 2);
constexpr size_t WS_Q = WS_XNM + al4k((size_t)NMETA * DM * 2);
constexpr size_t WS_IQ = WS_Q + al4k((size_t)NTOK * AW * 2);
constexpr size_t WS_KB = WS_IQ + al4k((size_t)NTOK * AW * 2);
constexpr size_t WS_VT = WS_KB + al4k((size_t)(NALL + 64) * AW * 2);
constexpr size_t WS_IK = WS_VT + al4k((size_t)NB * AW * TP * 2);
constexpr size_t WS_IW = WS_IK + al4k((size_t)NB * 65 * 2048 * 2);
constexpr size_t WS_GLU = WS_IW + al4k((size_t)NTOK * 8 * 4);
constexpr size_t WS_GA = WS_GLU + al4k((size_t)NALL * CC * 2);
constexpr size_t WS_GB = WS_GA + al4k((size_t)NTOK * DM * 2);
constexpr size_t WS_MASK = WS_GB + al4k((size_t)NTOK * DM * 2);
constexpr size_t WS_AO = WS_MASK + al4k((size_t)NTOK * MSTR * 4);
constexpr size_t WS_CO = WS_AO + al4k((size_t)NTOK * AW * 2);
constexpr size_t WS_MG = WS_CO + al4k((size_t)NTOK * CC * 2);
constexpr size_t WS_TE = WS_MG + al4k((size_t)NTOK * DM * 2);
constexpr size_t WS_TP = WS_TE + al4k((size_t)NTOK * 4 * 4);
constexpr size_t WS_LIST = WS_TP + al4k((size_t)NTOK * 4 * 4);
constexpr size_t WS_LG = WS_LIST + al4k((size_t)NE * NTOK * 4);
constexpr size_t WS_ACT = WS_LG + al4k((size_t)NE * NTOK * 4);
constexpr size_t WS_YP = WS_ACT + al4k((size_t)MAXTILES * 256 * DFF * 2);
constexpr size_t WS_H1 = WS_YP + al4k((size_t)MAXTILES * 256 * DM * 2);
constexpr size_t WS_WRT = WS_H1 + al4k((size_t)NTOK * DM * 4);
constexpr size_t WS_RG = WS_WRT + al4k((size_t)2 * NE * DM * 2);
constexpr size_t WS_DUMMY = WS_RG + al4k((size_t)NE * NTOK * 4);
constexpr size_t WS_END = WS_DUMMY + 4096;
static_assert(WS_END < ((size_t)1 << 32), "32-bit byte offsets into d_ws");
constexpr int CW_TMO = 0, CW_CODE = 1, CW_BAR = 4096, CW_ECNT = 16384;

constexpr int RING_BYTES = 131072;
constexpr int LDSX_OFF = 153600;
constexpr int MISC_OFF = 161792;
constexpr int LDS_BYTES = 163840;
constexpr int NWAVES = 8, NTHREADS = 512;

#define GAS __attribute__((address_space(1)))
#define LAS __attribute__((address_space(3)))
typedef unsigned short bf16_t;
typedef short bf16x8 __attribute__((ext_vector_type(8)));
typedef short s16x4 __attribute__((ext_vector_type(4)));
typedef float f32x4 __attribute__((ext_vector_type(4)));
typedef float f32x16 __attribute__((ext_vector_type(16)));
typedef unsigned u32x4 __attribute__((ext_vector_type(4)));
typedef unsigned u32x2 __attribute__((ext_vector_type(2)));
typedef GAS unsigned gu32;
#define RLX_AGENT __ATOMIC_RELAXED, __HIP_MEMORY_SCOPE_AGENT
#define LDS_WAIT() asm volatile("s_waitcnt lgkmcnt(0)" ::: "memory")
#define VM_WAIT() asm volatile("s_waitcnt vmcnt(0)" ::: "memory")

typedef float f32x2_t __attribute__((ext_vector_type(2))); typedef __bf16 bf16x2_t __attribute__((ext_vector_type(2)));
__device__ __forceinline__ unsigned cvt_pk_bf16(float lo, float hi) { const f32x2_t v = {lo, hi}; const bf16x2_t b = __builtin_convertvector(v, bf16x2_t); return __builtin_bit_cast(unsigned, b); }
__device__ __forceinline__ float bf2f(unsigned short b) { return __uint_as_float((unsigned)b << 16); }
__device__ __forceinline__ float bflo(unsigned w) { return __uint_as_float(w << 16); }
__device__ __forceinline__ float bfhi(unsigned w) { return __uint_as_float(w & 0xffff0000u); }
__device__ __forceinline__ float sigmoidf_(float x) { return __builtin_amdgcn_rcpf(1.0f + __builtin_amdgcn_exp2f(-LOG2E * x)); }
__device__ __forceinline__ float wave_sum(float v) {
#pragma unroll
    for (int o = 1; o < 64; o <<= 1) v += __shfl_xor(v, o);
    return v;
}

namespace pg8 {
constexpr int BM = 256, BK = 64, HALF = 128, HTB = HALF * BK * 2, STAGE_BYTES = 8 * HTB;
__host__ __device__ __forceinline__ int lds_byte(int r, int c) { const int st = (r >> 4) * 2 + (c >> 5), rr = r & 15, cc = c & 31, ob = rr * 64 + cc * 2; return st * 1024 + (ob ^ (((ob >> 9) & 1) << 5)); }
__host__ __device__ __forceinline__ void stage_rc(int b, int& R, int& C) { const int st = b / 1024, sb = b % 1024, swz = sb ^ (((sb >> 9) & 1) << 5); R = (st >> 1) * 16 + swz / 64; C = (st & 1) * 32 + (swz % 64) / 2; }

struct Unit { int pm, pn, z; };

template <class Epi, class Sched>
__device__ __forceinline__ void gemm_phase(LAS unsigned char* lds, const int K, const Sched& S, const Epi& E) {
    const int tid = threadIdx.x, wid = __builtin_amdgcn_readfirstlane(tid >> 6), lane = tid & 63, wr = wid >> 2, wc = wid & 3, fr = lane & 15, fq = lane >> 4;
    const int nt = K / BK;
    unsigned voffB[2];
#pragma unroll
    for (int i = 0; i < 2; ++i) { int R_, C_; stage_rc(tid * 16 + i * 8192, R_, C_); voffB[i] = (unsigned)(R_ * K + C_) * 2u; }
    const size_t kstep = (size_t)(BK * 2);
    const size_t hstep = (size_t)HALF * K * 2;
    const unsigned ldsw = (unsigned)wid * 1024u;
    const int aoff = lds_byte(wr * 64 + fr, fq * 8), boff = lds_byte(wc * 32 + fr, fq * 8);
    const char* const abase = S.a_base();
#define PG8_SA(b, h) (((b) * 2 + (h)) * HTB)
#define PG8_SB(b, h) ((4 + (b) * 2 + (h)) * HTB)
#define PG8_STAGE(bufoff, gbase, voff) do { _Pragma("unroll") for (int _i = 0; _i < 2; ++_i) \
        __builtin_amdgcn_global_load_lds((const unsigned*)((const char*)(gbase) + (voff)[_i]), (LAS unsigned*)(lds + (bufoff) + ldsw + _i * 8192), 16, 0, 0); } while (0)
#define PG8_LDA(dst, b, h) do { _Pragma("unroll") for (int m = 0; m < 4; ++m) _Pragma("unroll") for (int k = 0; k < 2; ++k) dst[m][k] = *(const LAS bf16x8*)(lds + PG8_SA(b, h) + aoff + m * 2048 + k * 1024); } while (0)
#define PG8_LDB(dst, b, h) do { _Pragma("unroll") for (int n = 0; n < 2; ++n) _Pragma("unroll") for (int k = 0; k < 2; ++k) dst[n][k] = *(const LAS bf16x8*)(lds + PG8_SB(b, h) + boff + n * 2048 + k * 1024); } while (0)
#define PG8_MMA(ai, bj, At, Bt) do { __builtin_amdgcn_s_setprio(1); _Pragma("unroll") for (int m = 0; m < 4; ++m) _Pragma("unroll") for (int n = 0; n < 2; ++n) _Pragma("unroll") for (int k = 0; k < 2; ++k) \
        acc[ai][bj][m][n] = __builtin_amdgcn_mfma_f32_16x16x32_bf16(Bt[n][k], At[m][k], acc[ai][bj][m][n], 0, 0, 0); __builtin_amdgcn_s_setprio(0); } while (0)
#define PG8_WAIT_V(n) asm volatile("s_waitcnt vmcnt(" #n ")" ::: "memory")
#define PG8_WAIT_L(n) asm volatile("s_waitcnt lgkmcnt(" #n ")" ::: "memory")
#define PG8_BAR __builtin_amdgcn_s_barrier()
#define PG8_SCHED __builtin_amdgcn_sched_barrier(0)
    Unit cur, nxt; int ui = 0;
    if (!S.next(0, cur)) return;
    f32x4 acc[2][2][4][2];
#pragma unroll
    for (int a = 0; a < 2; ++a)
#pragma unroll
        for (int b = 0; b < 2; ++b)
#pragma unroll
            for (int m = 0; m < 4; ++m)
#pragma unroll
                for (int n = 0; n < 2; ++n) acc[a][b][m][n] = (f32x4){0.f, 0.f, 0.f, 0.f};
    bf16x8 At[4][2], B0[2][2], B1[2][2];
    unsigned ca[2][2], na[2][2];
    S.a_offs(cur, tid, ca);
    const char* cB = S.b_base(cur);
    PG8_STAGE(PG8_SB(0, 0), cB, voffB); PG8_STAGE(PG8_SB(0, 1), cB + hstep, voffB); PG8_STAGE(PG8_SA(0, 0), abase, ca[0]); PG8_STAGE(PG8_SA(0, 1), abase, ca[1]);
    if (wr == 1) PG8_BAR;
    PG8_WAIT_V(2); PG8_BAR;
    PG8_STAGE(PG8_SB(1, 0), cB + kstep, voffB); PG8_STAGE(PG8_SA(1, 0), abase + kstep, ca[0]); PG8_STAGE(PG8_SB(1, 1), cB + hstep + kstep, voffB);
    PG8_WAIT_V(6); PG8_BAR;
    for (;;) {
        const bool has_next = S.next(ui + 1, nxt);
        const char* nB = cB;
#pragma unroll
        for (int h = 0; h < 2; ++h)
#pragma unroll
            for (int i = 0; i < 2; ++i) na[h][i] = ca[h][i];
        if (has_next) { S.a_offs(nxt, tid, na); nB = S.b_base(nxt); }
        for (int t = 0; t < nt; t += 2) {
            const bool last = (t == nt - 2);
            const char* a1 = abase + (size_t)(t + 1) * kstep;
            const char* a2 = last ? abase : abase + (size_t)(t + 2) * kstep; const char* b2 = last ? nB : cB + (size_t)(t + 2) * kstep;
            const char* a3 = a2 + kstep; const char* b3 = b2 + kstep;
            PG8_LDB(B0, 0, 0); PG8_LDB(B1, 0, 1); PG8_SCHED; PG8_LDA(At, 0, 0); PG8_STAGE(PG8_SA(1, 1), a1, ca[1]);
            PG8_WAIT_V(8); PG8_WAIT_L(0); PG8_BAR; PG8_MMA(0, 0, At, B0); PG8_MMA(0, 1, At, B1); PG8_BAR; PG8_SCHED;
            if (last) {
#pragma unroll
                for (int h = 0; h < 2; ++h)
#pragma unroll
                    for (int i = 0; i < 2; ++i) ca[h][i] = na[h][i];
            }
            PG8_LDA(At, 0, 1); PG8_STAGE(PG8_SB(0, 0), b2, voffB); PG8_STAGE(PG8_SB(0, 1), b2 + hstep, voffB); PG8_STAGE(PG8_SA(0, 0), a2, ca[0]);
            PG8_WAIT_V(8); PG8_WAIT_L(0); PG8_BAR; PG8_MMA(1, 0, At, B0); PG8_MMA(1, 1, At, B1); PG8_BAR; PG8_SCHED;
            PG8_LDB(B0, 1, 0); PG8_LDB(B1, 1, 1); PG8_SCHED; PG8_LDA(At, 1, 0); PG8_STAGE(PG8_SA(0, 1), a2, ca[1]);
            PG8_WAIT_V(8); PG8_WAIT_L(0); PG8_BAR; PG8_MMA(0, 0, At, B0); PG8_MMA(0, 1, At, B1); PG8_BAR; PG8_SCHED;
            PG8_LDA(At, 1, 1); PG8_STAGE(PG8_SB(1, 0), b3, voffB); PG8_STAGE(PG8_SB(1, 1), b3 + hstep, voffB); PG8_STAGE(PG8_SA(1, 0), a3, ca[0]);
            PG8_WAIT_V(8); PG8_WAIT_L(0); PG8_BAR; PG8_MMA(1, 0, At, B0); PG8_MMA(1, 1, At, B1); PG8_BAR; PG8_SCHED;
        }
        if (wr == 0) PG8_BAR;
        { int tz = tid; asm volatile("" : "+v"(tz));
          const int l2 = tz & 63, w2 = __builtin_amdgcn_readfirstlane(tz >> 6); E(acc, cur, w2 >> 2, w2 & 3, l2 & 15, l2 >> 4); }
        if (!has_next) break;
#pragma unroll
        for (int a = 0; a < 2; ++a)
#pragma unroll
            for (int b = 0; b < 2; ++b)
#pragma unroll
                for (int m = 0; m < 4; ++m)
#pragma unroll
                    for (int n = 0; n < 2; ++n) acc[a][b][m][n] = (f32x4){0.f, 0.f, 0.f, 0.f};
        cur = nxt; cB = nB; ++ui;
        if (wr == 1) PG8_BAR;
    }
    PG8_WAIT_V(0);
    PG8_BAR;
#undef PG8_SA
#undef PG8_SB
#undef PG8_STAGE
#undef PG8_LDA
#undef PG8_LDB
#undef PG8_MMA
#undef PG8_WAIT_V
#undef PG8_WAIT_L
#undef PG8_BAR
#undef PG8_SCHED
}
}

#define XB_TMO      128
#define XB_XCNT(j)  (256  + 64 * (j))
#define XB_XSUB(j)  (1280 + 64 * (j))
#define XB_XGEN(j)  (2304 + 64 * (j))
#define XB_TOP      3328
#define XB_TOPGEN   3392
#define XCD_BAR_WORDS 3456
#define XB_SPIN_CAP (1u << 18)
__device__ __forceinline__ unsigned xb_ld(unsigned* p)              { return __hip_atomic_load(p, __ATOMIC_RELAXED, __HIP_MEMORY_SCOPE_AGENT); }
__device__ __forceinline__ unsigned xb_add(unsigned* p, unsigned v) { return __hip_atomic_fetch_add(p, v, __ATOMIC_RELAXED, __HIP_MEMORY_SCOPE_AGENT); }
__device__ __forceinline__ unsigned xb_xcc_id() { return (unsigned)__builtin_amdgcn_s_getreg((3 << 11) | 20) & 0xFu; }
#define XB_SPIN(cond, bar) do { unsigned _sp = 0; while (cond) { __builtin_amdgcn_s_sleep(1); \
    if ((++_sp & 255u) == 0u) { if (xb_ld(&(bar)[XB_TMO])) break; if (_sp > XB_SPIN_CAP) { atomicAdd(&(bar)[XB_TMO], 1u); break; } } } } while (0)
struct XcdBarrier { unsigned* bar; unsigned x; volatile LAS unsigned* st; };
__device__ __forceinline__ XcdBarrier xcd_barrier_post(unsigned* bar, volatile LAS unsigned* st) {
    XcdBarrier b; b.bar = bar; b.x = xb_xcc_id(); b.st = st;
    if (threadIdx.x == 0) (void)xb_add(&bar[XB_XCNT(b.x)], 1u);
    return b;
}
__device__ __forceinline__ void xcd_barrier_complete(unsigned* bar, unsigned x, unsigned& nloc, unsigned& nx) {
    const unsigned G = gridDim.x * gridDim.y * gridDim.z;
    unsigned sum, cnt, mine, sp = 0u;
    for (;;) {
        sum = 0u; cnt = 0u; mine = 0u;
#pragma unroll
        for (unsigned j = 0; j < 16; ++j) { const unsigned c = xb_ld(&bar[XB_XCNT(j)]); sum += c; cnt += (c > 0u) ? 1u : 0u; mine = (j == x) ? c : mine; }
        if (sum == G) break;
        __builtin_amdgcn_s_sleep(1);
        if ((++sp & 255u) == 0u) { if (xb_ld(&bar[XB_TMO])) break; if (sp > XB_SPIN_CAP) { atomicAdd(&bar[XB_TMO], 1u); break; } }
    }
    nloc = mine > 0u ? mine : 1u; nx = cnt > 0u ? cnt : 1u;
}
__device__ __forceinline__ void xcd_barrier(const XcdBarrier& b) {
    asm volatile("s_waitcnt vmcnt(0)" ::: "memory");
    __syncthreads();
    if (threadIdx.x == 0) {
        unsigned* bar = b.bar;
        __builtin_amdgcn_s_waitcnt(0);
        unsigned nloc = b.st[0], nx = b.st[1];
        if (nloc == 0u) { xcd_barrier_complete(bar, b.x, nloc, nx); b.st[0] = nloc; b.st[1] = nx; }
        const unsigned old = xb_add(&bar[XB_XSUB(b.x)], 1u);
        const unsigned gen = old / nloc;
        if (old + 1u == (gen + 1u) * nloc) {
            __builtin_amdgcn_fence(__ATOMIC_RELEASE, "agent");
            asm volatile("s_waitcnt vmcnt(0)" ::: "memory");
            const unsigned og = xb_add(&bar[XB_TOP], 1u);
            const unsigned tg = og / nx;
            if (og + 1u == (tg + 1u) * nx) xb_add(&bar[XB_TOPGEN], 1u);
            else XB_SPIN(xb_ld(&bar[XB_TOPGEN]) == tg, bar);
            __builtin_amdgcn_fence(__ATOMIC_ACQUIRE, "agent");
            xb_add(&bar[XB_XGEN(b.x)], 1u);
            asm volatile("s_waitcnt vmcnt(0)" ::: "memory");
        } else {
            XB_SPIN(xb_ld(&bar[XB_XGEN(b.x)]) == gen, bar);
            __builtin_amdgcn_fence(__ATOMIC_ACQUIRE, "agent");
            asm volatile("s_waitcnt vmcnt(0)" ::: "memory");
        }
    }
    __syncthreads();
}

struct Args {
    const float* in[21];
    float* out; unsigned char* ws;
    int ph_lo, ph_hi, flags, pad;
};
enum { I_X = 0, I_META, I_RELB, I_NMIX, I_WIN, I_BGATE, I_WAO, I_CONVW, I_CONVB, I_LNG, I_LNB, I_WCO, I_WOUT, I_NFFN, I_WR, I_BR, I_WUG, I_BUG, I_WD, I_BD, I_NFIN };

struct Frame {
    LAS unsigned char* lds;
    unsigned char* ws;
    int tid, lane, wave;
    int G, bid;
};
template <class T> __device__ __forceinline__ T* wsp(unsigned char* ws, size_t off) { return (T*)(ws + off); }

struct P0Desc { const float* src; bf16_t* dst; int ldn, ldk; };
__device__ __forceinline__ void p0_load(const P0Desc& d, f32x4 (&v)[16], int lane) {
    const float* p = d.src + (size_t)(lane >> 4) * d.ldn + (lane & 15) * 4;
#pragma unroll
    for (int i = 0; i < 16; ++i) v[i] = *(const f32x4*)(p + (size_t)(4 * i) * d.ldn);
}
__device__ __forceinline__ void p0_store(const P0Desc& d, const f32x4 (&v)[16], LAS float* scr, int lane) {
    const int n4 = (lane & 15) * 4, kr = lane >> 4;
#pragma unroll
    for (int i = 0; i < 16; ++i) { LAS float* p = scr + (4 * i + kr) * 65 + n4; p[0] = v[i][0]; p[1] = v[i][1]; p[2] = v[i][2]; p[3] = v[i][3]; }
    LDS_WAIT(); asm volatile("" ::: "memory");
    const int c = lane & 7;
#pragma unroll
    for (int j = 0; j < 8; ++j) { const int n = (lane >> 3) + 8 * j; const LAS float* s = scr + (8 * c) * 65 + n;
        u32x4 o; o.x = cvt_pk_bf16(s[0 * 65], s[1 * 65]); o.y = cvt_pk_bf16(s[2 * 65], s[3 * 65]); o.z = cvt_pk_bf16(s[4 * 65], s[5 * 65]); o.w = cvt_pk_bf16(s[6 * 65], s[7 * 65]);
        *(u32x4*)(d.dst + (size_t)n * d.ldk + 8 * c) = o; }
    LDS_WAIT(); asm volatile("" ::: "memory");
}
__device__ __forceinline__ void rms_row_to_bf16(const float* __restrict__ xrow, const float* __restrict__ g, bf16_t* __restrict__ orow, int lane) {
    const f32x4* xr = (const f32x4*)xrow + lane; const f32x4* gr = (const f32x4*)g + lane;
    f32x4 v[4]; float s = 0.f;
#pragma unroll
    for (int j = 0; j < 4; ++j) { v[j] = xr[64 * j]; s += (v[j].x * v[j].x + v[j].y * v[j].y) + (v[j].z * v[j].z + v[j].w * v[j].w); }
    const float r = 1.0f / sqrtf(wave_sum(s) * (1.f / DM) + EPS);
    unsigned long long* o8 = (unsigned long long*)orow + lane;
#pragma unroll
    for (int j = 0; j < 4; ++j) { const f32x4 gg = gr[64 * j];
        o8[64 * j] = (unsigned long long)cvt_pk_bf16(v[j].x * r * gg.x, v[j].y * r * gg.y) | ((unsigned long long)cvt_pk_bf16(v[j].z * r * gg.z, v[j].w * r * gg.w) << 32); }
}
__device__ __forceinline__ void p0_prologue(Frame& F, const Args& a, const int part) {
    LAS float* scr = (LAS float*)(F.lds + F.wave * 16896);
    const int gw = F.bid * NWAVES + F.wave, NGW = F.G * NWAVES;
    unsigned char* ws = F.ws;
    constexpr int T_IN = 81 * 16, T_AO = 16 * 8, T_CO = 16 * 8, T_OUT = 16 * 16, T_SMALL = T_IN + T_AO + T_CO + T_OUT;
    constexpr int T_UG = NE * 32 * 16, T_D = NE * 16 * 16, T_ALL = T_SMALL + T_UG + T_D;
    auto desc = [&](int it) -> P0Desc {
        int r = it; P0Desc d;
        if (r < T_IN) { const int g = r / 16, kb = r % 16; const int dr = g * 64; int sc;
            if (dr < WR_GLU) sc = dr;
            else if (dr < WR_GATE) { const int q = dr - WR_GLU, tile = q >> 8, hf = (q >> 7) & 1, w = q & 127; sc = SC_GLU + 512 * hf + 128 * tile + w; }
            else if (dr < WR_IK) sc = SC_GATE + (dr - WR_GATE);
            else sc = SC_IK + (dr - WR_IK);
            d.src = a.in[I_WIN] + (size_t)(kb * 64) * INCOLS + sc; d.ldn = INCOLS; d.dst = wsp<bf16_t>(ws, WS_WIN) + (size_t)dr * DM + kb * 64; d.ldk = DM; return d; }
        r -= T_IN;
        if (r < T_AO) { const int g = r / 8, kb = r % 8; d.src = a.in[I_WAO] + (size_t)(kb * 64) * DM + g * 64; d.ldn = DM; d.dst = wsp<bf16_t>(ws, WS_WAO) + (size_t)(g * 64) * AW + kb * 64; d.ldk = AW; return d; }
        r -= T_AO;
        if (r < T_CO) { const int g = r / 8, kb = r % 8; d.src = a.in[I_WCO] + (size_t)(kb * 64) * DM + g * 64; d.ldn = DM; d.dst = wsp<bf16_t>(ws, WS_WCO) + (size_t)(g * 64) * CC + kb * 64; d.ldk = CC; return d; }
        r -= T_CO;
        if (r < T_OUT) { const int g = r / 16, kb = r % 16; d.src = a.in[I_WOUT] + (size_t)(kb * 64) * DM + g * 64; d.ldn = DM; d.dst = wsp<bf16_t>(ws, WS_WOUT) + (size_t)(g * 64) * DM + kb * 64; d.ldk = DM; return d; }
        r -= T_OUT;
        if (r < T_UG) { const int e = r / 512, q = r % 512, g = q % 32, kb = q / 32; const int dr = g * 64, tile = dr >> 8, hf = (dr >> 7) & 1, w = dr & 127;
            d.src = a.in[I_WUG] + (size_t)e * DM * 2 * DFF + (size_t)(kb * 64) * (2 * DFF) + DFF * hf + 128 * tile + w; d.ldn = 2 * DFF;
            d.dst = wsp<bf16_t>(ws, WS_WUG) + (size_t)e * 2 * DFF * DM + (size_t)dr * DM + kb * 64; d.ldk = DM; return d; }
        r -= T_UG;
        { const int e = r / 256, q = r % 256, g = q % 16, kb = q / 16;
            d.src = a.in[I_WD] + (size_t)e * DFF * DM + (size_t)(kb * 64) * DM + g * 64; d.ldn = DM; d.dst = wsp<bf16_t>(ws, WS_WD) + (size_t)e * DM * DFF + (size_t)(g * 64) * DFF + kb * 64; d.ldk = DFF; return d; }
    };
    const int T_LO = part ? T_SMALL : 0, T_HI = part ? T_ALL : T_SMALL;
    if (T_LO + gw < T_HI) {
        f32x4 va[16], vb[16];
        P0Desc da = desc(T_LO + gw), db = da;
        p0_load(da, va, F.lane);
        for (int it = T_LO + gw; it < T_HI; it += 2 * NGW) {
            const int i1 = it + NGW, i2 = it + 2 * NGW;
            db = desc(i1 < T_HI ? i1 : it); p0_load(db, vb, F.lane);
            p0_store(da, va, scr, F.lane);
            da = desc(i2 < T_HI ? i2 : it); p0_load(da, va, F.lane);
            if (i1 < T_HI) p0_store(db, vb, scr, F.lane);
        }
    }
    if (part) return;
    { const int gt = F.bid * NTHREADS + F.tid;
      if (gt < 8 * DM / 2) { const int n = gt >> 9, k = (gt & 511) * 2; const float v0 = a.in[I_WIN][(size_t)k * INCOLS + SC_IW + n], v1 = a.in[I_WIN][(size_t)(k + 1) * INCOLS + SC_IW + n];
          *(unsigned*)(wsp<bf16_t>(ws, WS_WIN) + (size_t)(WR_IW + n) * DM + k) = cvt_pk_bf16(v0, v1); } }
    { const int gt = F.bid * NTHREADS + F.tid;
      if (gt < NE * DM / 2) { const int e = gt >> 9, d = (gt & 511) * 2; const float v0 = a.in[I_NFFN][d] * a.in[I_WR][(size_t)d * NE + e], v1 = a.in[I_NFFN][d + 1] * a.in[I_WR][(size_t)(d + 1) * NE + e];
          const unsigned hi = cvt_pk_bf16(v0, v1); const unsigned lo = cvt_pk_bf16(v0 - bflo(hi), v1 - bfhi(hi));
          *(unsigned*)(wsp<bf16_t>(ws, WS_WRT) + (size_t)e * DM + d) = hi; *(unsigned*)(wsp<bf16_t>(ws, WS_WRT) + (size_t)(NE + e) * DM + d) = lo; } }
    for (int m = gw; m < NTOK + NMETA; m += NGW) {
        if (m < NTOK) rms_row_to_bf16(a.in[I_X] + (size_t)m * DM, a.in[I_NMIX], wsp<bf16_t>(ws, WS_XN) + (size_t)m * DM, F.lane);
        else rms_row_to_bf16(a.in[I_META] + (size_t)(m - NTOK) * DM, a.in[I_NMIX], wsp<bf16_t>(ws, WS_XNM) + (size_t)(m - NTOK) * DM, F.lane);
    }
}

struct PlainSched {
    const char* ws; unsigned a_off, b_off; int K, nM, nN, nwg, G, c;
    __device__ __forceinline__ void init(const unsigned char* ws_, size_t a, size_t b, int M, int N, int K_, int G_, int c_) { ws = (const char*)ws_; a_off = (unsigned)a; b_off = (unsigned)b; K = K_; nM = M / 256; nN = N / 256; nwg = nM * nN; G = G_; c = c_; }
    __device__ __forceinline__ bool next(int i, pg8::Unit& u) const {
        const long L = (long)i * G + c; if (L >= nwg) return false;
        int wgid = (int)L; { const int q = nwg / 8, r = nwg % 8, xcd = wgid % 8, off = wgid / 8; wgid = (xcd < r ? xcd * (q + 1) : r * (q + 1) + (xcd - r) * q) + off; }
        const int nig = 8 * nN, gid = wgid / nig, fm = gid * 8, gsz = (nM - fm) < 8 ? (nM - fm) : 8;
        u.pm = fm + ((wgid % nig) % gsz); u.pn = (wgid % nig) / gsz; u.z = 0; return true;
    }
    __device__ __forceinline__ const char* a_base() const { return ws; }
    __device__ __forceinline__ void a_offs(const pg8::Unit& u, int tid, unsigned (&o)[2][2]) const {
        int R[2], C[2]; pg8::stage_rc(tid * 16, R[0], C[0]); pg8::stage_rc(tid * 16 + 8192, R[1], C[1]);
#pragma unroll
        for (int h = 0; h < 2; ++h)
#pragma unroll
            for (int i = 0; i < 2; ++i) o[h][i] = a_off + (unsigned)(((u.pm * 256 + h * 128 + R[i]) * K + C[i]) * 2);
    }
    __device__ __forceinline__ const char* b_base(const pg8::Unit& u) const { return ws + b_off + (size_t)u.pn * 256 * K * 2; }
};
struct MergeSched {
    const char* ws; int G, c;
    __device__ __forceinline__ bool next(int i, pg8::Unit& u) const {
        const int t = c + (i >> 1) * G;
        if (t >= 256) return false;
        u.pm = (t & 7) + 8 * (t >> 5); u.pn = (t >> 3) & 3; u.z = i & 1; return true;
    }
    __device__ __forceinline__ const char* a_base() const { return ws; }
    __device__ __forceinline__ void a_offs(const pg8::Unit& u, int tid, unsigned (&o)[2][2]) const {
        int R[2], C[2]; pg8::stage_rc(tid * 16, R[0], C[0]); pg8::stage_rc(tid * 16 + 8192, R[1], C[1]);
        const unsigned base = (unsigned)(u.z ? WS_CO : WS_AO);
#pragma unroll
        for (int h = 0; h < 2; ++h)
#pragma unroll
            for (int i = 0; i < 2; ++i) o[h][i] = base + (unsigned)(((u.pm * 256 + h * 128 + R[i]) * 512 + C[i]) * 2);
    }
    __device__ __forceinline__ const char* b_base(const pg8::Unit& u) const { return ws + (u.z ? WS_WCO : WS_WAO) + (size_t)u.pn * 256 * 512 * 2; }
};
struct MoeTables { const LAS int* cnt; const LAS int* tbase; };
template <int NC, bool GATHER>
struct MoeSched {
    const char* ws; MoeTables T; int G, c, total;
    __device__ __forceinline__ bool next(int i, pg8::Unit& u) const {
        const long L = (long)i * G + c; if (L >= total) return false;
        int wgid = (int)L; { const int q = total / 8, r = total % 8, xcd = wgid % 8, off = wgid / 8; wgid = (xcd < r ? xcd * (q + 1) : r * (q + 1) + (xcd - r) * q) + off; }
        int e = 0;
        for (int j = 1; j < NE; ++j) e += (wgid >= __builtin_amdgcn_readfirstlane(T.tbase[j]) * NC) ? 1 : 0;
        e = __builtin_amdgcn_readfirstlane(e);
        const int tb0 = __builtin_amdgcn_readfirstlane(T.tbase[e]), tb1 = __builtin_amdgcn_readfirstlane(T.tbase[e + 1]);
        const int loc = wgid - tb0 * NC, nt_e = tb1 - tb0;
        u.z = e; u.pm = loc % nt_e; u.pn = loc / nt_e; return true;
    }
    __device__ __forceinline__ const char* a_base() const { return ws; }
    __device__ __forceinline__ void a_offs(const pg8::Unit& u, int tid, unsigned (&o)[2][2]) const {
        int R[2], C[2]; pg8::stage_rc(tid * 16, R[0], C[0]); pg8::stage_rc(tid * 16 + 8192, R[1], C[1]);
        if (GATHER) {
            const int* list = (const int*)(ws + WS_LIST) + (size_t)u.z * NTOK; const int n = __builtin_amdgcn_readfirstlane(T.cnt[u.z]);
#pragma unroll
            for (int h = 0; h < 2; ++h)
#pragma unroll
                for (int i = 0; i < 2; ++i) { const int p = u.pm * 256 + h * 128 + R[i]; const int tok = list[p < n ? p : 0];
                    o[h][i] = (unsigned)WS_XN + (unsigned)((tok * DM + C[i]) * 2); }
        } else {
            const int row0 = (__builtin_amdgcn_readfirstlane(T.tbase[u.z]) + u.pm) * 256;
#pragma unroll
            for (int h = 0; h < 2; ++h)
#pragma unroll
                for (int i = 0; i < 2; ++i) o[h][i] = (unsigned)WS_ACT + (unsigned)(((row0 + h * 128 + R[i]) * DFF + C[i]) * 2);
        }
    }
    __device__ __forceinline__ const char* b_base(const pg8::Unit& u) const {
        if (GATHER) return ws + WS_WUG + ((size_t)u.z * 2 * DFF + (size_t)u.pn * 256) * DM * 2;
        else return ws + WS_WD + ((size_t)u.z * DM + (size_t)u.pn * 256) * DFF * 2;
    }
};

#define EPI_ROWS(ai, m) for (int ai = 0; ai < 2; ++ai) _Pragma("unroll") for (int m = 0; m < 4; ++m)
#define EPI_COLS(bj, n) for (int bj = 0; bj < 2; ++bj) _Pragma("unroll") for (int n = 0; n < 2; ++n)
__device__ __forceinline__ void st_bf16x4(bf16_t* p, f32x4 v) { u32x2 w; w.x = cvt_pk_bf16(v[0], v[1]); w.y = cvt_pk_bf16(v[2], v[3]); *(u32x2*)p = w; }

struct EpiInProj {
    unsigned char* ws; const float* bgate;
    __device__ __forceinline__ void operator()(const f32x4 (&acc)[2][2][4][2], const pg8::Unit& u, int wr, int wc, int fr, int fq) const {
        const int pn = u.pn, row0 = u.pm * 256 + wr * 64 + fr, col0 = wc * 32 + 4 * fq;
        const int bidx = u.pm >> 3;
        const int rowk0 = row0 + NMETA * (bidx + 1);
        if (pn < 2 || (pn >= 6 && pn < 8)) {
            bf16_t* O = wsp<bf16_t>(ws, pn < 2 ? WS_Q : WS_IQ); const int cb = (pn & 1) * 256; const float sc = pn < 2 ? QSCALE : 1.0f;
#pragma unroll
            EPI_ROWS(ai, m) { bf16_t* rp = O + (size_t)(row0 + ai * 128 + m * 16) * AW + cb + col0;
#pragma unroll
                EPI_COLS(bj, n) st_bf16x4(rp + bj * 128 + n * 16, acc[ai][bj][m][n] * sc); }
        } else if (pn < 4) {
            bf16_t* O = wsp<bf16_t>(ws, WS_KB); const int cb = (pn & 1) * 256;
#pragma unroll
            EPI_ROWS(ai, m) { bf16_t* rp = O + (size_t)(rowk0 + ai * 128 + m * 16) * AW + cb + col0;
#pragma unroll
                EPI_COLS(bj, n) st_bf16x4(rp + bj * 128 + n * 16, acc[ai][bj][m][n]); }
        } else if (pn < 6) {
            bf16_t* O = wsp<bf16_t>(ws, WS_VT) + (size_t)bidx * AW * TP; const int cb = (pn & 1) * 256;
            const int t0 = (row0 & (SEQ - 1)) + NMETA + VOFF;
#pragma unroll
            EPI_ROWS(ai, m) { const int t = t0 + ai * 128 + m * 16;
#pragma unroll
                EPI_COLS(bj, n) { const f32x4 v = acc[ai][bj][m][n]; bf16_t* cp = O + (size_t)(cb + col0 + bj * 128 + n * 16) * TP + (t & ~1);
                    const float p0 = __shfl_xor(v[0], 1), p1 = __shfl_xor(v[1], 1), p2 = __shfl_xor(v[2], 1), p3 = __shfl_xor(v[3], 1);
                    if ((fr & 1) == 0) { *(unsigned*)(cp) = cvt_pk_bf16(v[0], p0); *(unsigned*)(cp + TP) = cvt_pk_bf16(v[1], p1); }
                    else { *(unsigned*)(cp + 2 * TP) = cvt_pk_bf16(p2, v[2]); *(unsigned*)(cp + 3 * TP) = cvt_pk_bf16(p3, v[3]); } } }
        } else if (pn < 12) {
            bf16_t* O = wsp<bf16_t>(ws, WS_GLU); const int cb = (pn - 8) * 128;
#pragma unroll
            EPI_ROWS(ai, m) { bf16_t* rp = O + (size_t)(rowk0 + ai * 128 + m * 16) * CC + cb + col0;
#pragma unroll
                for (int n = 0; n < 2; ++n) { const f32x4 av = acc[ai][0][m][n], gv = acc[ai][1][m][n]; f32x4 y;
#pragma unroll
                    for (int j = 0; j < 4; ++j) y[j] = av[j] * sigmoidf_(gv[j]);
                    st_bf16x4(rp + n * 16, y); } }
        } else {
            const int gt = pn - 12; bf16_t* O = wsp<bf16_t>(ws, gt < 4 ? WS_GA : WS_GB); const int cb = (gt & 3) * 256; const float* bp = bgate + gt * 256 + col0;
            f32x4 bv[2][2];
#pragma unroll
            EPI_COLS(bj, n) bv[bj][n] = *(const f32x4*)(bp + bj * 128 + n * 16);
#pragma unroll
            EPI_ROWS(ai, m) { bf16_t* rp = O + (size_t)(row0 + ai * 128 + m * 16) * DM + cb + col0;
#pragma unroll
                EPI_COLS(bj, n) { const f32x4 x = acc[ai][bj][m][n] + bv[bj][n]; f32x4 y;
#pragma unroll
                    for (int j = 0; j < 4; ++j) y[j] = sigmoidf_(x[j]);
                    st_bf16x4(rp + bj * 128 + n * 16, y); } }
        }
    }
};
struct EpiMerge {
    unsigned char* ws;
    __device__ __forceinline__ void operator()(const f32x4 (&acc)[2][2][4][2], const pg8::Unit& u, int wr, int wc, int fr, int fq) const {
        const int row0 = u.pm * 256 + wr * 64 + fr, col0 = u.pn * 256 + wc * 32 + 4 * fq;
        const bf16_t* Gt = wsp<bf16_t>(ws, u.z ? WS_GB : WS_GA); bf16_t* O = wsp<bf16_t>(ws, WS_MG);
#pragma unroll
        EPI_ROWS(ai, m) { const size_t ro = (size_t)(row0 + ai * 128 + m * 16) * DM + col0;
#pragma unroll
            EPI_COLS(bj, n) { const size_t o = ro + bj * 128 + n * 16; const u32x2 g = *(const u32x2*)(Gt + o); const f32x4 a = acc[ai][bj][m][n];
                f32x4 y = (f32x4){bflo(g.x) * a[0], bfhi(g.x) * a[1], bflo(g.y) * a[2], bfhi(g.y) * a[3]};
                if (u.z) { const u32x2 p = *(const u32x2*)(O + o); y[0] += bflo(p.x); y[1] += bfhi(p.x); y[2] += bflo(p.y); y[3] += bfhi(p.y); }
                st_bf16x4(O + o, y); } }
    }
};
struct EpiResid {
    const float* x; float* out;
    __device__ __forceinline__ void operator()(const f32x4 (&acc)[2][2][4][2], const pg8::Unit& u, int wr, int wc, int fr, int fq) const {
        const int row0 = u.pm * 256 + wr * 64 + fr, col0 = u.pn * 256 + wc * 32 + 4 * fq;
#pragma unroll
        EPI_ROWS(ai, m) { const size_t ro = (size_t)(row0 + ai * 128 + m * 16) * DM + col0;
#pragma unroll
            EPI_COLS(bj, n) { const size_t o = ro + bj * 128 + n * 16; *(f32x4*)(out + o) = *(const f32x4*)(x + o) + acc[ai][bj][m][n]; } }
    }
};
struct EpiSwiglu {
    unsigned char* ws; const float* bug; MoeTables T;
    __device__ __forceinline__ void operator()(const f32x4 (&acc)[2][2][4][2], const pg8::Unit& u, int wr, int wc, int fr, int fq) const {
        const int e = u.z, n_e = __builtin_amdgcn_readfirstlane(T.cnt[e]), rloc0 = u.pm * 256 + wr * 64 + fr, row0 = __builtin_amdgcn_readfirstlane(T.tbase[e]) * 256 + rloc0, col0 = u.pn * 128 + wc * 32 + 4 * fq;
        const float* bp = bug + (size_t)e * 2 * DFF + col0; bf16_t* O = wsp<bf16_t>(ws, WS_ACT); const float* rg = wsp<float>(ws, WS_RG) + (size_t)e * NTOK;
        f32x4 bg[2], bu[2];
#pragma unroll
        for (int n = 0; n < 2; ++n) { bg[n] = *(const f32x4*)(bp + n * 16); bu[n] = *(const f32x4*)(bp + DFF + n * 16); }
        float rvs[2][4];
#pragma unroll
        EPI_ROWS(ai, m) { const int rl = rloc0 + ai * 128 + m * 16; rvs[ai][m] = rg[rl < n_e ? rl : 0]; }
        bf16_t* const sink = wsp<bf16_t>(ws, WS_DUMMY) + col0;
#pragma unroll
        EPI_ROWS(ai, m) { const int rl = rloc0 + ai * 128 + m * 16; bf16_t* rp = (rl < n_e) ? O + (size_t)(row0 + ai * 128 + m * 16) * DFF + col0 : sink; const float rv = rvs[ai][m];
#pragma unroll
                for (int n = 0; n < 2; ++n) { const f32x4 gv = acc[ai][0][m][n] * rv + bg[n], uv = acc[ai][1][m][n] * rv + bu[n]; f32x4 y;
#pragma unroll
                    for (int j = 0; j < 4; ++j) { const float g = fminf(gv[j], 7.0f), up = fminf(fmaxf(uv[j], -7.0f), 7.0f); y[j] = (up + 1.0f) * g * sigmoidf_(1.702f * g); }
                    st_bf16x4(rp + n * 16, y); } }
    }
};
struct EpiDown {
    unsigned char* ws; const float* bd; MoeTables T;
    __device__ __forceinline__ void operator()(const f32x4 (&acc)[2][2][4][2], const pg8::Unit& u, int wr, int wc, int fr, int fq) const {
        const int e = u.z, n_e = __builtin_amdgcn_readfirstlane(T.cnt[e]), rloc0 = u.pm * 256 + wr * 64 + fr, row0 = __builtin_amdgcn_readfirstlane(T.tbase[e]) * 256 + rloc0, col0 = u.pn * 256 + wc * 32 + 4 * fq;
        const float* bp = bd + (size_t)e * DM + col0; bf16_t* O = wsp<bf16_t>(ws, WS_YP); const float* lg = wsp<float>(ws, WS_LG) + (size_t)e * NTOK;
        f32x4 bv[2][2];
#pragma unroll
        EPI_COLS(bj, n) bv[bj][n] = *(const f32x4*)(bp + bj * 128 + n * 16);
        float gts[2][4];
#pragma unroll
        EPI_ROWS(ai, m) { const int rl = rloc0 + ai * 128 + m * 16; gts[ai][m] = lg[rl < n_e ? rl : 0]; }
        bf16_t* const sink = wsp<bf16_t>(ws, WS_DUMMY) + col0;
#pragma unroll
        EPI_ROWS(ai, m) { const int rl = rloc0 + ai * 128 + m * 16; const float gt = gts[ai][m]; bf16_t* rp = (rl < n_e) ? O + (size_t)(row0 + ai * 128 + m * 16) * DM + col0 : sink;
#pragma unroll
                EPI_COLS(bj, n) st_bf16x4(rp + bj * 128 + n * 16, (acc[ai][bj][m][n] + bv[bj][n]) * gt); }
    }
};

constexpr int IKBLK = 65;
__device__ __forceinline__ size_t ikf_off(int b, int p, int dim) { return ((((size_t)(b * IKBLK + (p >> 5)) * 4 + (dim >> 4)) * 64 + (((dim >> 3) & 1) * 32 + (p & 31))) * 8 + (dim & 7)); }
template <int NT>
__device__ __forceinline__ void wave_mm16(const bf16_t* __restrict__ A, int lda, const bf16_t* const (&Bt)[NT], int K, int lane, f32x4 (&acc)[NT]) {
    const bf16_t* ap = A + (size_t)(lane & 15) * lda + 8 * (lane >> 4);
    const bf16_t* bp[NT];
#pragma unroll
    for (int t = 0; t < NT; ++t) { bp[t] = Bt[t] + (size_t)(lane & 15) * K + 8 * (lane >> 4); acc[t] = (f32x4){0.f, 0.f, 0.f, 0.f}; }
#pragma unroll (NT == 1 ? 16 : 8)
    for (int k0 = 0; k0 < K; k0 += 32) {
        const bf16x8 a = *(const bf16x8*)(ap + k0);
#pragma unroll
        for (int t = 0; t < NT; ++t) { const bf16x8 b = *(const bf16x8*)(bp[t] + k0); acc[t] = __builtin_amdgcn_mfma_f32_16x16x32_bf16(b, a, acc[t], 0, 0, 0); }
    }
}
__device__ __forceinline__ void p1_thin(Frame& F, int dbgflags) {
    unsigned char* ws = F.ws;
    const bf16_t* WIN = wsp<bf16_t>(ws, WS_WIN); const bf16_t* XN = wsp<bf16_t>(ws, WS_XN); const bf16_t* XNM = wsp<bf16_t>(ws, WS_XNM);
    bf16_t* KB = wsp<bf16_t>(ws, WS_KB); bf16_t* VT = wsp<bf16_t>(ws, WS_VT); bf16_t* IK = wsp<bf16_t>(ws, WS_IK); bf16_t* GLU = wsp<bf16_t>(ws, WS_GLU); float* IW = wsp<float>(ws, WS_IW);
    const int gw = F.bid * NWAVES + F.wave, NGW = F.G * NWAVES, lane = F.lane, tk = lane & 15, nq = lane >> 4;
    {
        constexpr int WBP = 2064;
        LAS unsigned char* lds = F.lds;
        __syncthreads();
        { const unsigned char* src = (const unsigned char*)(WIN + (size_t)WR_IK * DM);
          for (int p = F.tid; p < 72 * 128; p += NTHREADS) { const int row = p >> 7, c16 = p & 127; *(LAS u32x4*)(lds + row * WBP + c16 * 16) = *(const u32x4*)(src + (size_t)row * DM * 2 + c16 * 16); } }
        __syncthreads();
        const int tg = F.wave & 3, hf = F.wave >> 2, kq = nq;
        for (int tb = F.bid; tb < NTOK / 64; tb += F.G) {
            const int m = tb * 64 + 16 * tg + tk, rowk = m + NMETA * ((m >> 11) + 1);
            const bf16_t* xr = XN + (size_t)m * DM + 16 * kq;
            bf16x8 xa[16], xb[16];
#pragma unroll
            for (int sblk = 0; sblk < 16; ++sblk) { xa[sblk] = *(const bf16x8*)(xr + 64 * sblk); xb[sblk] = *(const bf16x8*)(xr + 64 * sblk + 8); }
            const LAS unsigned char* wb = lds + tk * WBP + 32 * kq;
            if (hf == 0) {
                f32x4 acc[3] = {{0.f, 0.f, 0.f, 0.f}, {0.f, 0.f, 0.f, 0.f}, {0.f, 0.f, 0.f, 0.f}};
#pragma unroll
                for (int sblk = 0; sblk < 16; ++sblk)
#pragma unroll
                    for (int t = 0; t < 3; ++t) { const bf16x8 b0 = *(const LAS bf16x8*)(wb + 16 * t * WBP + 128 * sblk), b1 = *(const LAS bf16x8*)(wb + 16 * t * WBP + 128 * sblk + 16);
                        acc[t] = __builtin_amdgcn_mfma_f32_16x16x32_bf16(b0, xa[sblk], acc[t], 0, 0, 0); acc[t] = __builtin_amdgcn_mfma_f32_16x16x32_bf16(b1, xb[sblk], acc[t], 0, 0, 0); }
#pragma unroll
                for (int t = 0; t < 3; ++t) st_bf16x4(IK + ikf_off(m >> 11, NMETA + (m & (SEQ - 1)), 16 * t + 4 * nq), acc[t]);
            } else {
                f32x4 acc[2] = {{0.f, 0.f, 0.f, 0.f}, {0.f, 0.f, 0.f, 0.f}};
#pragma unroll
                for (int sblk = 0; sblk < 16; ++sblk)
#pragma unroll
                    for (int t = 0; t < 2; ++t) { const bf16x8 b0 = *(const LAS bf16x8*)(wb + 16 * (3 + t) * WBP + 128 * sblk), b1 = *(const LAS bf16x8*)(wb + 16 * (3 + t) * WBP + 128 * sblk + 16);
                        acc[t] = __builtin_amdgcn_mfma_f32_16x16x32_bf16(b0, xa[sblk], acc[t], 0, 0, 0); acc[t] = __builtin_amdgcn_mfma_f32_16x16x32_bf16(b1, xb[sblk], acc[t], 0, 0, 0); }
                st_bf16x4(IK + ikf_off(m >> 11, NMETA + (m & (SEQ - 1)), 48 + 4 * nq), acc[0]);
                if (nq < 2) *(f32x4*)(IW + (size_t)m * 8 + 4 * nq) = acc[1];
            }
        }
        __syncthreads();
    }
    if (!(dbgflags & 256)) for (int task = gw; task < 100; task += NGW) {
        if (task < 32) {
            const bf16_t* const Bt[1] = {WIN + (size_t)(SC_K + 16 * task) * DM}; f32x4 acc[1]; wave_mm16<1>(XNM, DM, Bt, DM, lane, acc);
            for (int b = 0; b < NB; ++b) st_bf16x4(KB + (size_t)(b * TT + tk) * AW + 16 * task + 4 * nq, acc[0]);
        } else if (task < 64) {
            const int t = task - 32; const bf16_t* const Bt[1] = {WIN + (size_t)(SC_V + 16 * t) * DM}; f32x4 acc[1]; wave_mm16<1>(XNM, DM, Bt, DM, lane, acc);
            const float p0 = __shfl_xor(acc[0][0], 1), p1 = __shfl_xor(acc[0][1], 1), p2 = __shfl_xor(acc[0][2], 1), p3 = __shfl_xor(acc[0][3], 1);
            const unsigned wa = (tk & 1) ? cvt_pk_bf16(p2, acc[0][2]) : cvt_pk_bf16(acc[0][0], p0), wb = (tk & 1) ? cvt_pk_bf16(p3, acc[0][3]) : cvt_pk_bf16(acc[0][1], p1);
            for (int b = 0; b < NB; ++b) { bf16_t* cp = VT + ((size_t)b * AW + 16 * t + 4 * nq + 2 * (tk & 1)) * TP + VOFF + (tk & ~1);
                *(unsigned*)cp = wa; *(unsigned*)(cp + TP) = wb; }
        } else if (task < 68) {
            const int t = task - 64; const bf16_t* const Bt[1] = {WIN + (size_t)(WR_IK + 16 * t) * DM}; f32x4 acc[1]; wave_mm16<1>(XNM, DM, Bt, DM, lane, acc);
            for (int b = 0; b < NB; ++b) st_bf16x4(IK + ikf_off(b, tk, 16 * t + 4 * nq), acc[0]);
        } else {
            const int c16 = task - 68; const int ar = WR_GLU + 256 * (c16 >> 3) + 16 * (c16 & 7);
            const bf16_t* const Bt[2] = {WIN + (size_t)ar * DM, WIN + (size_t)(ar + 128) * DM}; f32x4 acc[2]; wave_mm16<2>(XNM, DM, Bt, DM, lane, acc);
            f32x4 y;
#pragma unroll
            for (int j = 0; j < 4; ++j) y[j] = acc[0][j] * sigmoidf_(acc[1][j]);
            for (int b = 0; b < NB; ++b) st_bf16x4(GLU + (size_t)(b * TT + tk) * CC + 16 * c16 + 4 * nq, y);
        }
    }
}

__device__ __forceinline__ void p2_conv(Frame& F, const Args& a) {
    unsigned char* ws = F.ws;
    LAS unsigned char* xs = F.lds;
    LAS float* wl = (LAS float*)(F.lds + 63488);
    const bf16_t* GLU = wsp<bf16_t>(ws, WS_GLU); bf16_t* CO = wsp<bf16_t>(ws, WS_CO);
    const float* cw = a.in[I_CONVW];
    for (int idx = F.tid; idx < CW * 128; idx += NTHREADS) { const int tap = idx >> 7, c4 = idx & 127; const f32x4 v = *(const f32x4*)(cw + tap * CC + 4 * c4); *(LAS f32x4*)(wl + tap * 512 + (c4 & 1) * 256 + (c4 >> 1) * 4) = v; }
    const int lane = F.lane, c0 = 8 * lane;
    for (int tile = F.bid; tile < NTOK / 32; tile += F.G) {
        const int b = tile >> 6, s0 = (tile & 63) * 32, p0 = NMETA + s0;
        __syncthreads();
        for (int idx = F.tid; idx < 62 * 64; idx += NTHREADS) { const int r = idx >> 6, ch = idx & 63, p = p0 - 30 + r; u32x4 v = (u32x4){0u, 0u, 0u, 0u};
            if (p >= 0) v = *(const u32x4*)(GLU + (size_t)(b * TT + p) * CC + ch * 8);
            *(LAS u32x4*)(xs + r * 1024 + ch * 16) = v; }
        __syncthreads();
        const int i0 = 4 * F.wave;
        float acc[4][8];
#pragma unroll
        for (int t = 0; t < 4; ++t)
#pragma unroll
            for (int i = 0; i < 8; ++i) acc[t][i] = 0.f;
        const LAS float* wlb = wl + lane * 4; asm volatile("" : "+v"(wlb));
        const LAS unsigned char* xsb = xs + i0 * 1024 + lane * 16; asm volatile("" : "+v"(xsb));
#pragma unroll 1
        for (int tap = 0; tap < CW; ++tap) {
            const f32x4 w0 = *(const LAS f32x4*)(wlb + tap * 512), w1 = *(const LAS f32x4*)(wlb + tap * 512 + 256);
#pragma unroll
            for (int t = 0; t < 4; ++t) {
                const u32x4 xv = *(const LAS u32x4*)(xsb + (tap + t) * 1024);
                acc[t][0] += w0[0] * bflo(xv.x); acc[t][1] += w0[1] * bfhi(xv.x); acc[t][2] += w0[2] * bflo(xv.y); acc[t][3] += w0[3] * bfhi(xv.y);
                acc[t][4] += w1[0] * bflo(xv.z); acc[t][5] += w1[1] * bfhi(xv.z); acc[t][6] += w1[2] * bflo(xv.w); acc[t][7] += w1[3] * bfhi(xv.w);
            }
        }
        float cb[8], lg[8], lb[8];
        { const f32x4* p0 = (const f32x4*)(a.in[I_CONVB] + c0); const f32x4* p1 = (const f32x4*)(a.in[I_LNG] + c0); const f32x4* p2 = (const f32x4*)(a.in[I_LNB] + c0);
#pragma unroll
          for (int hh = 0; hh < 2; ++hh) { const f32x4 u0 = p0[hh], u1 = p1[hh], u2 = p2[hh];
#pragma unroll
              for (int i = 0; i < 4; ++i) { cb[4 * hh + i] = u0[i]; lg[4 * hh + i] = u1[i]; lb[4 * hh + i] = u2[i]; } } }
#pragma unroll
        for (int t = 0; t < 4; ++t) {
            float s = 0.f;
#pragma unroll
            for (int i = 0; i < 8; ++i) { acc[t][i] += cb[i]; s += acc[t][i]; }
            const float mean = wave_sum(s) * (1.f / CC); float q = 0.f;
#pragma unroll
            for (int i = 0; i < 8; ++i) { acc[t][i] -= mean; q += acc[t][i] * acc[t][i]; }
            const float rstd = 1.0f / sqrtf(wave_sum(q) * (1.f / CC) + EPS);
            float y[8];
#pragma unroll
            for (int i = 0; i < 8; ++i) { const float z = acc[t][i] * rstd * lg[i] + lb[i]; y[i] = z * sigmoidf_(z); }
            u32x4 o; o.x = cvt_pk_bf16(y[0], y[1]); o.y = cvt_pk_bf16(y[2], y[3]); o.z = cvt_pk_bf16(y[4], y[5]); o.w = cvt_pk_bf16(y[6], y[7]);
            *(u32x4*)(CO + (size_t)(b * SEQ + s0 + i0 + t) * CC + c0) = o;
        }
    }
    __syncthreads();
}

constexpr int ROWP = 2080, NJ = 33;
__device__ __forceinline__ unsigned f2ord(float f) { const unsigned b = __float_as_uint(f); return b ^ ((b >> 31) ? 0xffffffffu : 0x80000000u); }
__device__ __forceinline__ int wave_isum(int v) {
#pragma unroll
    for (int o = 1; o < 64; o <<= 1) v += __shfl_xor(v, o);
    return v;
}
__device__ __forceinline__ int wave_isum_dpp(int v) {
    v += __builtin_amdgcn_update_dpp(0, v, 0xB1, 0xF, 0xF, false);
    v += __builtin_amdgcn_update_dpp(0, v, 0x4E, 0xF, 0xF, false);
    v += __builtin_amdgcn_update_dpp(0, v, 0x141, 0xF, 0xF, false);
    v += __builtin_amdgcn_update_dpp(0, v, 0x140, 0xF, 0xF, false);
    return __builtin_amdgcn_readlane(v, 0) + __builtin_amdgcn_readlane(v, 16) + __builtin_amdgcn_readlane(v, 32) + __builtin_amdgcn_readlane(v, 48);
}
__device__ __forceinline__ void p2_indexer_unit(Frame& F, int b, int q16, int flags) {
    unsigned char* ws = F.ws;
    const bf16_t* IQ = wsp<bf16_t>(ws, WS_IQ); const bf16_t* IK = wsp<bf16_t>(ws, WS_IK); const float* IW = wsp<float>(ws, WS_IW); unsigned* MASK = wsp<unsigned>(ws, WS_MASK);
    LAS unsigned* SU = (LAS unsigned*)F.lds;
    const int lane = F.lane, c = lane & 31, hi = lane >> 5, w = F.wave;
    const int nwblk = (q16 >> 1) + 2;
    if (!(flags & 4)) {
        const int tok0 = b * SEQ + 16 * q16;
        bf16x8 af[4][4]; f32x4 wq[4][4];
#pragma unroll
        for (int g = 0; g < 4; ++g) {
            const bf16_t* ap = IQ + (size_t)(tok0 + 4 * g + (c >> 3)) * AW + (c & 7) * IDXD + 8 * hi;
#pragma unroll
            for (int ks = 0; ks < 4; ++ks) af[g][ks] = *(const bf16x8*)(ap + 16 * ks);
#pragma unroll
            for (int q = 0; q < 4; ++q) wq[g][q] = *(const f32x4*)(IW + (size_t)(tok0 + 4 * g + q) * 8 + 4 * hi);
        }
        const int rel0 = NMETA + 16 * q16 + 2 * hi - c;
        const bf16_t* kp = IK + (size_t)b * IKBLK * 2048 + lane * 8;
        LAS unsigned* srow = SU + (2 * hi) * ROWP + c;
        bf16x8 bfr[4], bnx[4];
#pragma unroll
        for (int ks = 0; ks < 4; ++ks) { bfr[ks] = *(const bf16x8*)(kp + (size_t)(w < nwblk ? w : 0) * 2048 + 512 * ks); bnx[ks] = bfr[ks]; }
#pragma unroll
        for (int g = 0; g < 4; ++g) asm volatile("" :: "v"(af[g][0]), "v"(af[g][1]), "v"(af[g][2]), "v"(af[g][3]), "v"(wq[g][0]), "v"(wq[g][1]), "v"(wq[g][2]), "v"(wq[g][3]));
        asm volatile("" :: "v"(bfr[0]), "v"(bfr[1]), "v"(bfr[2]), "v"(bfr[3]));
        for (int blk = w; blk < nwblk; blk += 8) {
            {
                const int bn_ = blk + 8 < nwblk ? blk + 8 : blk;
#pragma unroll
                for (int ks = 0; ks < 4; ++ks) bnx[ks] = *(const bf16x8*)(kp + (size_t)bn_ * 2048 + 512 * ks); }
#pragma unroll
            for (int g = 0; g < 4; ++g) {
                f32x16 acc = {};
#pragma unroll
                for (int ks = 0; ks < 4; ++ks) acc = __builtin_amdgcn_mfma_f32_32x32x16_bf16(af[g][ks], bfr[ks], acc, 0, 0, 0);
                float part[4];
#pragma unroll
                for (int q = 0; q < 4; ++q) { float s = wq[g][q][0] * __builtin_amdgcn_fmed3f(acc[4 * q], 0.f, INFINITY);
#pragma unroll
                    for (int i = 1; i < 4; ++i) s = __builtin_fmaf(wq[g][q][i], __builtin_amdgcn_fmed3f(acc[4 * q + i], 0.f, INFINITY), s);
                    part[q] = s; }
#pragma unroll
                for (int p = 0; p < 2; ++p) {
                    const auto rr = __builtin_amdgcn_permlane32_swap(__float_as_uint(part[p]), __float_as_uint(part[p + 2]), false, false);
                    const float sc = __uint_as_float(rr[0]) + __uint_as_float(rr[1]);
                    srow[(4 * g + p) * ROWP + 32 * blk] = (32 * blk <= rel0 + 4 * g + p) ? f2ord(sc) : 0u; }
            }
#pragma unroll
            for (int ks = 0; ks < 4; ++ks) bfr[ks] = bnx[ks];
        }
    }
    __syncthreads();
    if (!(flags & 8)) {
        const int nj = (nwblk + 1) >> 1, klim = 32 * nwblk;
        unsigned U[NJ][2];
#pragma unroll
        for (int j = 0; j < NJ; ++j) {
            if (j < nj) { const int key = 64 * j + lane;
#pragma unroll
                for (int p = 0; p < 2; ++p) U[j][p] = (key < klim) ? SU[(2 * w + p) * ROWP + key] : 0u; }
            else { U[j][0] = 0u; U[j][1] = 0u; }
        }
        const int tokb = b * SEQ + 16 * q16 + 2 * w;
        unsigned lo[2], hb[2], thr[2], veq[2]; int chi[2], need[2]; bool done[2];
#pragma unroll
        for (int p = 0; p < 2; ++p) { lo[p] = 1u; hb[p] = 0xffffffffu; chi[p] = 0; need[p] = 0; veq[p] = 0u; thr[p] = 1u; done[p] = (NMETA + 16 * q16 + 2 * w + p + 1 <= TOPK); }
        for (int it = 0; it < 34; ++it) {
            if (done[0] && done[1]) break;
            unsigned mid[2]; int cl[2];
#pragma unroll
            for (int p = 0; p < 2; ++p) { mid[p] = lo[p] + ((hb[p] - lo[p]) >> 1); cl[p] = 0; }
#pragma unroll
            for (int g = 0; g < 3; ++g) if (11 * g < nj) {
#pragma unroll
                for (int jj = 0; jj < 11; ++jj)
#pragma unroll
                    for (int p = 0; p < 2; ++p) cl[p] += (U[11 * g + jj][p] >= mid[p]) ? 1 : 0; }
            const int tot = wave_isum_dpp(cl[0] | (cl[1] << 16));
            int cnt[2] = {tot & 0xffff, tot >> 16};
#ifdef DBG_CHECK_DPP
            if (wave_isum(cl[0]) != cnt[0] || wave_isum(cl[1]) != cnt[1]) __hip_atomic_store(wsp<unsigned>(ws, WS_CTL) + 3, 1u, RLX_AGENT);
#endif
#pragma unroll
            for (int p = 0; p < 2; ++p) {
                const int ct = cnt[p];
                if (!done[p]) {
                    if (ct == TOPK) { done[p] = true; thr[p] = mid[p]; need[p] = 0; }
                    else if (ct > TOPK) lo[p] = mid[p];
                    else { hb[p] = mid[p]; chi[p] = ct; }
                    if (!done[p] && hb[p] - lo[p] == 1u) { done[p] = true; thr[p] = hb[p]; veq[p] = lo[p]; need[p] = TOPK - chi[p]; }
                }
            }
        }
#pragma unroll
        for (int p = 0; p < 2; ++p) {
            int run = 0;
            unsigned long long* mrow = (unsigned long long*)(MASK + (size_t)(tokb + p) * MSTR);
#pragma unroll
            for (int j = 0; j < NJ; ++j) if (j < nj) {
                const unsigned u = U[j][p];
                const bool eq = (need[p] > 0) && (u == veq[p]);
                const unsigned long long em = __ballot(eq);
                const int rank = run + (int)__builtin_amdgcn_mbcnt_hi((unsigned)(em >> 32), __builtin_amdgcn_mbcnt_lo((unsigned)em, 0u));
                const bool take = (u >= thr[p]) || (eq && rank < need[p]);
                run += __popcll(em);
                const unsigned long long sm = __ballot(take);
                if (lane == 0) mrow[j] = sm;
            }
        }
    }
    __syncthreads();
}
__device__ __forceinline__ void p2_indexer(Frame& F, int flags, int half) {
    for (int i = F.bid; i < 256; i += F.G) { const int b = i >> 5, j = 2 * (i & 31);
        if (half == 0) { p2_indexer_unit(F, b, j, flags); p2_indexer_unit(F, b, 127 - j, flags); }
        else { p2_indexer_unit(F, b, j + 1, flags); p2_indexer_unit(F, b, 126 - j, flags); } }
}

__device__ const unsigned char T5B[128] = {0, 1, 2, 3, 4, 5, 6, 7, 8, 9, 10, 11, 12, 13, 14, 15, 16, 16, 16, 17, 17, 18, 18, 18, 19, 19, 19, 20, 20, 20, 20, 21, 21, 21, 21, 22, 22, 22, 22, 22, 23, 23, 23, 23, 23, 23, 24, 24, 24, 24, 24, 24, 25, 25, 25, 25, 25, 25, 25, 26, 26, 26, 26, 26, 26, 26, 26, 27, 27, 27, 27, 27, 27, 27, 27, 27, 27, 28, 28, 28, 28, 28, 28, 28, 28, 28, 28, 29, 29, 29, 29, 29, 29, 29, 29, 29, 29, 29, 29, 30, 30, 30, 30, 30, 30, 30, 30, 30, 30, 30, 30, 30, 30, 31, 31, 31, 31, 31, 31, 31, 31, 31, 31, 31, 31, 31, 31, 31};
constexpr int TBS = 132;
__device__ __forceinline__ int crow(int r, int hi) { return (r & 3) + 8 * (r >> 2) + 4 * hi; }
constexpr int KPITCH = 144, VPITCH = 136;
constexpr int AT_K = 0, AT_V = AT_K + 2 * 64 * KPITCH, AT_TB = AT_V + 2 * 64 * VPITCH, AT_SC = AT_TB + NH * TBS * 4, AT_END = AT_SC + NWAVES * 128;
static_assert(AT_END <= RING_BYTES, "attention LDS map");
__device__ __forceinline__ void p3_attn_unit(Frame& F, int b, int h, int Q) {
    unsigned char* ws = F.ws;
    const bf16_t* Qm = wsp<bf16_t>(ws, WS_Q); const bf16_t* KB = wsp<bf16_t>(ws, WS_KB); const bf16_t* VT = wsp<bf16_t>(ws, WS_VT); const unsigned* MASK = wsp<unsigned>(ws, WS_MASK); bf16_t* AO = wsp<bf16_t>(ws, WS_AO);
    LAS unsigned char* lds = F.lds;
    const LAS float* tbh = (const LAS float*)(lds + AT_TB) + h * TBS;
    LAS float* sc = (LAS float*)(lds + AT_SC) + F.wave * 32;
    const int tid = F.tid, lane = F.lane, c = lane & 31, hi = lane >> 5, w = F.wave;
    const int qb32 = 8 * Q + w, tokq = b * SEQ + 32 * qb32 + c, posq = NMETA + 32 * qb32 + c;
    const int ktmax = (47 + 32 * qb32) >> 6, NT = 4 * Q + 5;
    bf16x8 qf[4];
#pragma unroll
    for (int ks = 0; ks < 4; ++ks) qf[ks] = *(const bf16x8*)(Qm + (size_t)tokq * AW + h * HD + 16 * ks + 8 * hi);
    const unsigned long long* mrow = (const unsigned long long*)(MASK + (size_t)tokq * MSTR);
    const int srow = tid >> 3, piece = tid & 7;
    const bf16_t* kg = KB + (size_t)(b * TT + srow) * AW + h * HD + piece * 8;
    const bf16_t* vg = VT + ((size_t)b * AW + h * HD + srow) * TP + piece * 8;
    LAS unsigned char* kl = lds + AT_K + srow * KPITCH + piece * 16;
    LAS unsigned char* vl = lds + AT_V + srow * VPITCH + piece * 16;
    const LAS unsigned char* kfb = lds + AT_K + c * KPITCH + 16 * hi;
    const LAS unsigned char* vfb = lds + AT_V + c * VPITCH + 8 * hi;
    const unsigned NEGB = 0xff800000u;
    const float bfar = tbh[128];
    float m_abs = 0.f; bool has = false;
    f32x16 O0 = {}, O1 = {}, LS = {}, CI;
#pragma unroll
    for (int r = 0; r < 16; ++r) CI[r] = bfar;
    const bf16x8 ones = __builtin_bit_cast(bf16x8, ((u32x4){0x3f803f80u, 0x3f803f80u, 0x3f803f80u, 0x3f803f80u}));
    u32x4 kr = *(const u32x4*)kg, vr = *(const u32x4*)vg;
    unsigned long long mwn = mrow[0];
    *(LAS u32x4*)kl = kr; *(LAS u32x2*)vl = (u32x2){vr.x, vr.y}; *(LAS u32x2*)(vl + 8) = (u32x2){vr.z, vr.w};
    __syncthreads();
    for (int kt = 0; kt < NT; ++kt) {
        const int buf = kt & 1;
        const unsigned long long mw = mwn;
        if (kt + 1 < NT) { kr = *(const u32x4*)(kg + (size_t)(kt + 1) * 64 * AW); vr = *(const u32x4*)(vg + (kt + 1) * 64); if (kt + 1 <= ktmax) mwn = mrow[kt + 1]; }
        if (kt <= ktmax) {
            const LAS unsigned char* kp = kfb + buf * 64 * KPITCH;
            f32x16 S0 = CI, S1 = CI;
#pragma unroll
            for (int ks = 0; ks < 4; ++ks) {
                const bf16x8 k0 = *(const LAS bf16x8*)(kp + ks * 32), k1 = *(const LAS bf16x8*)(kp + 32 * KPITCH + ks * 32);
                S0 = __builtin_amdgcn_mfma_f32_32x32x16_bf16(k0, qf[ks], S0, 0, 0, 0);
                S1 = __builtin_amdgcn_mfma_f32_32x32x16_bf16(k1, qf[ks], S1, 0, 0, 0);
            }
            const int mw0 = (int)((unsigned)mw >> (4 * hi)), mw1 = (int)((unsigned)(mw >> 32) >> (4 * hi));
            const bool far = (256 * Q + 32 * w - 64 * kt) >= 175;
            if (!far) {
                const int d0 = posq - 64 * kt - 4 * hi;
#pragma unroll
                for (int r = 0; r < 16; ++r) { const int ko = (r & 3) + 8 * (r >> 2);
                    int da = d0 - ko, db = d0 - 32 - ko; da = da < 0 ? 0 : (da > 128 ? 128 : da); db = db < 0 ? 0 : (db > 128 ? 128 : db);
                    S0[r] += tbh[da] - bfar; S1[r] += tbh[db] - bfar; }
            }
            float tmax = -INFINITY;
#pragma unroll
            for (int r = 0; r < 16; ++r) { const int ko = (r & 3) + 8 * (r >> 2);
                const unsigned t0 = (unsigned)__builtin_amdgcn_sbfe(mw0, ko, 1), t1 = (unsigned)__builtin_amdgcn_sbfe(mw1, ko, 1);
                S0[r] = __uint_as_float((__float_as_uint(S0[r]) & t0) | (NEGB & ~t0)); S1[r] = __uint_as_float((__float_as_uint(S1[r]) & t1) | (NEGB & ~t1));
                tmax = fmaxf(tmax, fmaxf(S0[r], S1[r])); }
            tmax = fmaxf(tmax, __shfl_xor(tmax, 32));
            if (__any(tmax > 8.0f || (!has && tmax > -INFINITY))) {
                const bool upd = tmax > -INFINITY && (!has || tmax > 0.f);
                const float dl = upd ? tmax : 0.f;
                const float alpha = has ? __builtin_amdgcn_exp2f(-dl) : 1.0f;
                m_abs += dl; has = has || upd;
#pragma unroll
                for (int r = 0; r < 16; ++r) { S0[r] -= dl; S1[r] -= dl; CI[r] = bfar - m_abs; }
                if (hi == 0) sc[c] = alpha;
                LDS_WAIT(); asm volatile("" ::: "memory");
#pragma unroll
                for (int r = 0; r < 16; ++r) { const float f = sc[crow(r, hi)]; O0[r] *= f; O1[r] *= f; LS[r] *= f; }
                LDS_WAIT(); asm volatile("" ::: "memory");
            }
#pragma unroll
            for (int r = 0; r < 16; ++r) { S0[r] = __builtin_amdgcn_exp2f(S0[r]); S1[r] = __builtin_amdgcn_exp2f(S1[r]); }
            const LAS unsigned char* vp = vfb + buf * 64 * VPITCH;
#pragma unroll
            for (int s2 = 0; s2 < 4; ++s2) {
                u32x4 pw;
                if (s2 < 2) { const int o = 8 * (s2 & 1); pw.x = cvt_pk_bf16(S0[o + 0], S0[o + 1]); pw.y = cvt_pk_bf16(S0[o + 2], S0[o + 3]); pw.z = cvt_pk_bf16(S0[o + 4], S0[o + 5]); pw.w = cvt_pk_bf16(S0[o + 6], S0[o + 7]); }
                else { const int o = 8 * (s2 & 1); pw.x = cvt_pk_bf16(S1[o + 0], S1[o + 1]); pw.y = cvt_pk_bf16(S1[o + 2], S1[o + 3]); pw.z = cvt_pk_bf16(S1[o + 4], S1[o + 5]); pw.w = cvt_pk_bf16(S1[o + 6], S1[o + 7]); }
                const bf16x8 pf = __builtin_bit_cast(bf16x8, pw);
                const u32x2 a0 = *(const LAS u32x2*)(vp + s2 * 32), a1 = *(const LAS u32x2*)(vp + s2 * 32 + 16);
                const u32x2 b0 = *(const LAS u32x2*)(vp + 32 * VPITCH + s2 * 32), b1 = *(const LAS u32x2*)(vp + 32 * VPITCH + s2 * 32 + 16);
                const bf16x8 v0 = __builtin_bit_cast(bf16x8, ((u32x4){a0.x, a0.y, a1.x, a1.y})), v1 = __builtin_bit_cast(bf16x8, ((u32x4){b0.x, b0.y, b1.x, b1.y}));
                O0 = __builtin_amdgcn_mfma_f32_32x32x16_bf16(pf, v0, O0, 0, 0, 0);
                O1 = __builtin_amdgcn_mfma_f32_32x32x16_bf16(pf, v1, O1, 0, 0, 0);
                LS = __builtin_amdgcn_mfma_f32_32x32x16_bf16(pf, ones, LS, 0, 0, 0);
            }
        }
        if (kt + 1 < NT) { LAS unsigned char* k2 = kl + (buf ^ 1) * 64 * KPITCH; LAS unsigned char* v2 = vl + (buf ^ 1) * 64 * VPITCH;
            *(LAS u32x4*)k2 = kr; *(LAS u32x2*)v2 = (u32x2){vr.x, vr.y}; *(LAS u32x2*)(v2 + 8) = (u32x2){vr.z, vr.w}; }
        __syncthreads();
    }
    bf16_t* ob = AO + (size_t)(b * SEQ + 32 * qb32) * AW + h * HD + c;
#pragma unroll
    for (int r = 0; r < 16; ++r) { const int qr = crow(r, hi); const float f = __builtin_amdgcn_rcpf(LS[r]);
        const float a0 = O0[r] * f, a1 = O1[r] * f, b0 = __shfl_xor(a0, 1), b1 = __shfl_xor(a1, 1);
        if ((c & 1) == 0) { *(unsigned*)(ob + (size_t)qr * AW) = cvt_pk_bf16(a0, b0); *(unsigned*)(ob + (size_t)qr * AW + 32) = cvt_pk_bf16(a1, b1); } }
}
__device__ __forceinline__ void p3_attn(Frame& F, const Args& a) {
    LAS float* tb = (LAS float*)(F.lds + AT_TB);
    __syncthreads();
    for (int idx = F.tid; idx < NH * 129; idx += NTHREADS) { const int h = idx / 129, d = idx % 129; const int bk = d < 128 ? (int)T5B[d] : 31; tb[h * TBS + d] = a.in[I_RELB][bk * NH + h] * LOG2E; }
    __syncthreads();
    for (int i = F.bid; i < 256; i += F.G) { const int bh = i >> 2, j = i & 3; p3_attn_unit(F, bh >> 3, bh & 7, j); p3_attn_unit(F, bh >> 3, bh & 7, 7 - j); }
    __syncthreads();
}

constexpr int WLP = 2064;
constexpr int P6_WHI = 0, P6_WLO = NE * WLP, P6_PART = 2 * NE * WLP, P6_SSP = P6_PART + 2 * 64 * 33 * 4, P6_CNT = P6_SSP + 2 * 64 * 4, P6_END = P6_CNT + 256;
static_assert(P6_END <= LDSX_OFF, "router LDS map");
__device__ __forceinline__ void p6_router(Frame& F, const Args& a) {
    unsigned char* ws = F.ws;
    const float* H1 = wsp<float>(ws, WS_H1); bf16_t* HN = wsp<bf16_t>(ws, WS_XN);
    const float* gf = a.in[I_NFFN]; const float* brt = a.in[I_BR];
    int* TE = wsp<int>(ws, WS_TE); int* TPs = wsp<int>(ws, WS_TP); int* LIST = wsp<int>(ws, WS_LIST); float* LG = wsp<float>(ws, WS_LG); float* RG = wsp<float>(ws, WS_RG);
    unsigned* ecnt = wsp<unsigned>(ws, WS_CTL) + CW_ECNT;
    LAS unsigned char* lds = F.lds;
    LAS float* part = (LAS float*)(lds + P6_PART);
    LAS float* ssp = (LAS float*)(lds + P6_SSP);
    LAS int* lcnt = (LAS int*)(lds + P6_CNT);
    LAS int* lbase = lcnt + 32;
    const int lane = F.lane, w = F.wave, tk = lane & 15, kq = lane >> 4;
    __syncthreads();
    { const unsigned char* src = ws + WS_WRT;
      for (int p = F.tid; p < 2 * NE * 128; p += NTHREADS) { const int arr = p >> 12, row = (p >> 7) & 31, c16 = p & 127;
          *(LAS u32x4*)(lds + arr * (NE * WLP) + row * WLP + c16 * 16) = *(const u32x4*)(src + (size_t)arr * NE * DM * 2 + (size_t)row * DM * 2 + c16 * 16); } }
    for (int tb = F.bid; tb < NTOK / 64; tb += F.G) {
        const int t0 = tb * 64;
        __syncthreads();
        if (F.tid < 32) lcnt[F.tid] = 0;
        {
            const int tg = w & 3, kh = w >> 2, tok = t0 + 16 * tg + tk;
            const float* xr = H1 + (size_t)tok * DM + 512 * kh + 8 * kq; const float* gr = gf + 512 * kh + 8 * kq;
            bf16_t* hr = HN + (size_t)tok * DM + 512 * kh + 8 * kq;
            const LAS unsigned char* wl = lds + tk * WLP + (512 * kh + 8 * kq) * 2;
            f32x4 xa[16], xb[16];
#pragma unroll
            for (int ks = 0; ks < 16; ++ks) { xa[ks] = *(const f32x4*)(xr + 32 * ks); xb[ks] = *(const f32x4*)(xr + 32 * ks + 4); }
            f32x4 acc0 = {0.f, 0.f, 0.f, 0.f}, acc1 = acc0; float ss = 0.f;
#pragma unroll
            for (int ks = 0; ks < 16; ++ks) {
                const f32x4 g0 = *(const f32x4*)(gr + 32 * ks), g1 = *(const f32x4*)(gr + 32 * ks + 4);
                const f32x4 x0 = xa[ks], x1 = xb[ks];
                u32x4 hn; hn.x = cvt_pk_bf16(x0[0] * g0[0], x0[1] * g0[1]); hn.y = cvt_pk_bf16(x0[2] * g0[2], x0[3] * g0[3]); hn.z = cvt_pk_bf16(x1[0] * g1[0], x1[1] * g1[1]); hn.w = cvt_pk_bf16(x1[2] * g1[2], x1[3] * g1[3]);
                *(u32x4*)(hr + 32 * ks) = hn;
                ss += (x0[0] * x0[0] + x0[1] * x0[1]) + (x0[2] * x0[2] + x0[3] * x0[3]) + (x1[0] * x1[0] + x1[1] * x1[1]) + (x1[2] * x1[2] + x1[3] * x1[3]);
                u32x4 xh; xh.x = cvt_pk_bf16(x0[0], x0[1]); xh.y = cvt_pk_bf16(x0[2], x0[3]); xh.z = cvt_pk_bf16(x1[0], x1[1]); xh.w = cvt_pk_bf16(x1[2], x1[3]);
                u32x4 xl; xl.x = cvt_pk_bf16(x0[0] - bflo(xh.x), x0[1] - bfhi(xh.x)); xl.y = cvt_pk_bf16(x0[2] - bflo(xh.y), x0[3] - bfhi(xh.y));
                          xl.z = cvt_pk_bf16(x1[0] - bflo(xh.z), x1[1] - bfhi(xh.z)); xl.w = cvt_pk_bf16(x1[2] - bflo(xh.w), x1[3] - bfhi(xh.w));
                const bf16x8 fxh = __builtin_bit_cast(bf16x8, xh), fxl = __builtin_bit_cast(bf16x8, xl);
                const bf16x8 wh0 = *(const LAS bf16x8*)(wl + P6_WHI + ks * 64), wh1 = *(const LAS bf16x8*)(wl + P6_WHI + 16 * WLP + ks * 64);
                const bf16x8 wl0 = *(const LAS bf16x8*)(wl + P6_WLO + ks * 64), wl1 = *(const LAS bf16x8*)(wl + P6_WLO + 16 * WLP + ks * 64);
                acc0 = __builtin_amdgcn_mfma_f32_16x16x32_bf16(wh0, fxh, acc0, 0, 0, 0); acc1 = __builtin_amdgcn_mfma_f32_16x16x32_bf16(wh1, fxh, acc1, 0, 0, 0);
                acc0 = __builtin_amdgcn_mfma_f32_16x16x32_bf16(wl0, fxh, acc0, 0, 0, 0); acc1 = __builtin_amdgcn_mfma_f32_16x16x32_bf16(wl1, fxh, acc1, 0, 0, 0);
                acc0 = __builtin_amdgcn_mfma_f32_16x16x32_bf16(wh0, fxl, acc0, 0, 0, 0); acc1 = __builtin_amdgcn_mfma_f32_16x16x32_bf16(wh1, fxl, acc1, 0, 0, 0);
            }
            ss += __shfl_xor(ss, 16); ss += __shfl_xor(ss, 32);
            LAS float* pp = part + ((kh * 64) + 16 * tg + tk) * 33 + 4 * kq;
#pragma unroll
            for (int r = 0; r < 4; ++r) { pp[r] = acc0[r]; pp[16 + r] = acc1[r]; }
            if (kq == 0) ssp[kh * 64 + 16 * tg + tk] = ss;
        }
        __syncthreads();
        if (w == 0) {
            const float rinv = 1.0f / sqrtf((ssp[lane] + ssp[64 + lane]) * (1.f / DM) + EPS);
            float lg[NE];
#pragma unroll
            for (int e = 0; e < NE; ++e) lg[e] = (part[lane * 33 + e] + part[(64 + lane) * 33 + e]) * rinv + brt[e];
            int sel[4]; float val[4];
#pragma unroll
            for (int j = 0; j < 4; ++j) { float best = -INFINITY; int bi = 0;
#pragma unroll
                for (int e = 0; e < NE; ++e) { const bool tk_ = lg[e] > best; best = tk_ ? lg[e] : best; bi = tk_ ? e : bi; }
                sel[j] = bi; val[j] = best;
#pragma unroll
                for (int e = 0; e < NE; ++e) lg[e] = (e == bi) ? -INFINITY : lg[e]; }
            float den = 0.f, ex[4];
#pragma unroll
            for (int j = 0; j < 4; ++j) { ex[j] = __expf(val[j] - val[0]); den += ex[j]; }
            int slot[4];
#pragma unroll
            for (int j = 0; j < 4; ++j) slot[j] = __hip_atomic_fetch_add(&lcnt[sel[j]], 1, __ATOMIC_RELAXED, __HIP_MEMORY_SCOPE_WORKGROUP);
            LDS_WAIT();
            if (lane < 32) { const int n = lcnt[lane]; lbase[lane] = n ? (int)__hip_atomic_fetch_add(ecnt + 64 * lane, (unsigned)n, RLX_AGENT) : 0; }
            LDS_WAIT(); asm volatile("" ::: "memory");
            const int t = t0 + lane;
#pragma unroll
            for (int j = 0; j < 4; ++j) { const int e = sel[j], pos = lbase[e] + slot[j]; const float g = ex[j] / den;
                TE[t * 4 + j] = e; TPs[t * 4 + j] = pos; LIST[(size_t)e * NTOK + pos] = t; LG[(size_t)e * NTOK + pos] = g; RG[(size_t)e * NTOK + pos] = rinv; }
        }
    }
    __syncthreads();
}
__device__ __forceinline__ void moe_tables(Frame& F, LAS int* cnt, LAS int* tbase) {
    const unsigned* ecnt = wsp<unsigned>(F.ws, WS_CTL) + CW_ECNT;
    __syncthreads();
    if (F.tid < NE) cnt[F.tid] = (int)__hip_atomic_load(ecnt + 64 * F.tid, RLX_AGENT);
    __syncthreads();
    if (F.tid == 0) { int s = 0; for (int e = 0; e < NE; ++e) { tbase[e] = s; s += (cnt[e] + 255) >> 8; } tbase[NE] = s; }
    __syncthreads();
}

__device__ __forceinline__ void p9_final(Frame& F, const Args& a, const LAS int* tbase) {
    unsigned char* ws = F.ws;
    const float* H1 = wsp<float>(ws, WS_H1); float* OUT = a.out; const bf16_t* YP = wsp<bf16_t>(ws, WS_YP); const int* TE = wsp<int>(ws, WS_TE); const int* TPs = wsp<int>(ws, WS_TP); const float* gf = a.in[I_NFIN];
    const int gw = F.bid * NWAVES + F.wave, NGW = F.G * NWAVES, lane = F.lane;
    const f32x4* gr = (const f32x4*)gf + lane;
    f32x4 gg[4];
#pragma unroll
    for (int j = 0; j < 4; ++j) gg[j] = gr[64 * j];
#ifdef DBG_CHECK_DPP
    if (__hip_atomic_load(wsp<unsigned>(ws, WS_CTL) + 3, RLX_AGENT) != 0u) { const float qn = __builtin_nanf("");
#pragma unroll
        for (int j = 0; j < 4; ++j) gg[j] = (f32x4){qn, qn, qn, qn}; }
#endif
    for (int base = 0; base < NTOK; base += 8 * NGW) {
        int myrow = 0;
        { const int i = lane >> 2, j = lane & 3, t = base + gw + NGW * i; if (lane < 32 && t < NTOK) { const int e = TE[t * 4 + j], pos = TPs[t * 4 + j]; myrow = tbase[e] * 256 + pos; } }
        f32x4 va[4], vb[4]; u32x2 ya[4][4], yb[4][4];
#define P9_LOAD(i, V, Y) do { const int t_ = base + gw + NGW * (i); if (t_ < NTOK) { const f32x4* xr_ = (const f32x4*)(H1 + (size_t)t_ * DM) + lane; \
            _Pragma("unroll") for (int j_ = 0; j_ < 4; ++j_) V[j_] = xr_[64 * j_]; \
            _Pragma("unroll") for (int q_ = 0; q_ < 4; ++q_) { const int row_ = __builtin_amdgcn_readlane(myrow, 4 * (i) + q_); const u32x2* yr_ = (const u32x2*)(YP + (size_t)row_ * DM) + lane; \
                _Pragma("unroll") for (int j_ = 0; j_ < 4; ++j_) Y[q_][j_] = yr_[64 * j_]; } } } while (0)
#define P9_PROC(i, V, Y) do { const int t_ = base + gw + NGW * (i); if (t_ < NTOK) { \
            _Pragma("unroll") for (int q_ = 0; q_ < 4; ++q_) _Pragma("unroll") for (int j_ = 0; j_ < 4; ++j_) { const u32x2 y_ = Y[q_][j_]; V[j_].x += bflo(y_.x); V[j_].y += bfhi(y_.x); V[j_].z += bflo(y_.y); V[j_].w += bfhi(y_.y); } \
            float s_ = 0.f; _Pragma("unroll") for (int j_ = 0; j_ < 4; ++j_) s_ += (V[j_].x * V[j_].x + V[j_].y * V[j_].y) + (V[j_].z * V[j_].z + V[j_].w * V[j_].w); \
            const float r_ = 1.0f / sqrtf(wave_sum(s_) * (1.f / DM) + EPS); f32x4* xo_ = (f32x4*)(OUT + (size_t)t_ * DM) + lane; \
            _Pragma("unroll") for (int j_ = 0; j_ < 4; ++j_) xo_[64 * j_] = (f32x4){V[j_].x * r_ * gg[j_].x, V[j_].y * r_ * gg[j_].y, V[j_].z * r_ * gg[j_].z, V[j_].w * r_ * gg[j_].w}; } } while (0)
        P9_LOAD(0, va, ya);
#pragma unroll
        for (int i = 0; i < 8; i += 2) {
            P9_LOAD(i + 1, vb, yb);
            P9_PROC(i, va, ya);
            if (i + 2 < 8) P9_LOAD(i + 2, va, ya);
            P9_PROC(i + 1, vb, yb);
        }
#undef P9_LOAD
#undef P9_PROC
    }
}

constexpr int N_PHASES = 10;
__global__ void __launch_bounds__(NTHREADS, 2) fwd_kernel(Args args) {
    extern __shared__ __attribute__((aligned(16))) unsigned char lds_raw[];
    Frame F;
    F.lds = (LAS unsigned char*)lds_raw; F.ws = args.ws;
    F.tid = threadIdx.x; F.lane = F.tid & 63; F.wave = __builtin_amdgcn_readfirstlane(F.tid >> 6);
    F.G = gridDim.x; F.bid = blockIdx.x;
    volatile LAS unsigned* MISC = (volatile LAS unsigned*)(F.lds + MISC_OFF);
    if (F.tid < 32) MISC[F.tid] = 0u;
    __syncthreads();
    unsigned* ctl = wsp<unsigned>(args.ws, WS_CTL);
    const int lo = args.ph_lo, hi = args.ph_hi;
    const bool multi = (hi - lo) > 1;
    XcdBarrier bar; bar.bar = ctl + CW_BAR; bar.x = 0; bar.st = nullptr;
    if (multi) bar = xcd_barrier_post(ctl + CW_BAR, MISC + 8);
#ifndef PHASE_MASK
#define PHASE_MASK 0x3ff
#endif
#define IN(k) (((PHASE_MASK >> (k)) & 1) && lo <= (k) && (k) < hi)
#define SEAM(k) do { if (IN(k) && IN((k) + 1)) xcd_barrier(bar); } while (0)
    LAS int* l_cnt = (LAS int*)(F.lds + LDSX_OFF); LAS int* l_tbase = l_cnt + 64;
    const MoeTables MT{l_cnt, l_tbase};

    if (IN(0)) { p0_prologue(F, args, 0); } SEAM(0);
    if (IN(1)) {
        PlainSched S; S.init(args.ws, WS_XN, WS_WIN, NTOK, 5120, DM, F.G, F.bid);
        EpiInProj E{args.ws, args.in[I_BGATE]};
        if (!(args.flags & 64)) pg8::gemm_phase<EpiInProj, PlainSched>(F.lds, DM, S, E);
        if (!(args.flags & 128)) p1_thin(F, args.flags);
    } SEAM(1);
    if (IN(2)) {
        const int cvt_slot = (F.bid >> 3) % 3;
        if (cvt_slot == 0 && !(args.flags & 1024)) { p0_prologue(F, args, 1); __syncthreads(); }
        if (!(args.flags & 1)) p2_conv(F, args);
        if (!(args.flags & 2)) p2_indexer(F, args.flags, 0);
        if (cvt_slot == 1 && !(args.flags & 1024)) { __syncthreads(); p0_prologue(F, args, 1); __syncthreads(); }
        if (!(args.flags & 2)) p2_indexer(F, args.flags, 1);
        if (cvt_slot == 2 && !(args.flags & 1024)) { __syncthreads(); p0_prologue(F, args, 1); }
    } SEAM(2);
    if (IN(3)) { p3_attn(F, args); } SEAM(3);
    if (IN(4)) {
        MergeSched S{(const char*)args.ws, F.G, F.bid}; EpiMerge E{args.ws};
        pg8::gemm_phase<EpiMerge, MergeSched>(F.lds, 512, S, E);
    } SEAM(4);
    if (IN(5)) {
        PlainSched S; S.init(args.ws, WS_MG, WS_WOUT, NTOK, DM, DM, F.G, F.bid);
        EpiResid E{args.in[I_X], wsp<float>(args.ws, WS_H1)};
        pg8::gemm_phase<EpiResid, PlainSched>(F.lds, DM, S, E);
    } SEAM(5);
    if (IN(6)) { p6_router(F, args); } SEAM(6);
    if (IN(7)) {
        moe_tables(F, l_cnt, l_tbase);
        MoeSched<8, true> S{(const char*)args.ws, MT, F.G, F.bid, l_tbase[NE] * 8};
        EpiSwiglu E{args.ws, args.in[I_BUG], MT};
        pg8::gemm_phase<EpiSwiglu, MoeSched<8, true>>(F.lds, DM, S, E);
    } SEAM(7);
    if (IN(8)) {
        moe_tables(F, l_cnt, l_tbase);
        MoeSched<4, false> S{(const char*)args.ws, MT, F.G, F.bid, l_tbase[NE] * 4};
        EpiDown E{args.ws, args.in[I_BD], MT};
        pg8::gemm_phase<EpiDown, MoeSched<4, false>>(F.lds, DFF, S, E);
    } SEAM(8);
    if (IN(9)) { moe_tables(F, l_cnt, l_tbase); p9_final(F, args, l_tbase); }
#undef IN
#undef SEAM
}

#ifdef DBG_HASH_OFF
__global__ void dbg_hash(const unsigned* __restrict__ buf, size_t nwords, unsigned* acc) {
    unsigned h = 0u;
    for (size_t i = (size_t)blockIdx.x * blockDim.x + threadIdx.x; i < nwords; i += (size_t)gridDim.x * blockDim.x) h += (buf[i] ^ (unsigned)(i * 2654435761u)) * 2246822519u + (unsigned)i;
#pragma unroll
    for (int o = 1; o < 64; o <<= 1) h += __shfl_xor(h, o);
    if ((threadIdx.x & 63) == 0) atomicAdd(acc, h);
}
__global__ void dbg_fill(float* out, size_t n, const unsigned* acc) {
    const unsigned h = *acc; const float v = (float)((h >> 7) & 0xffffu) * (1.0f / 4096.0f) + 1.0f;
    for (size_t i = (size_t)blockIdx.x * blockDim.x + threadIdx.x; i < n; i += (size_t)gridDim.x * blockDim.x) out[i] = v;
}
#endif

extern "C" void kernel_launch(void* const* d_in, const int* in_sizes, int n_in, void* d_out, int out_size, void* d_ws, size_t ws_size, hipStream_t stream) {
    static int grid = 0;
    if (grid == 0) {
        if (n_in != 21 || out_size != NTOK * DM || ws_size < WS_END) { fprintf(stderr, "kernel_launch: unexpected shapes (n_in %d, out %d, ws %zu < %zu)\n", n_in, out_size, ws_size, (size_t)WS_END); grid = -1; return; }
        int dev = 0, cus = 0, per_cu = 0;
        if (hipGetDevice(&dev) != hipSuccess || hipDeviceGetAttribute(&cus, hipDeviceAttributeMultiprocessorCount, dev) != hipSuccess) { grid = -1; return; }
        if (hipFuncSetAttribute((const void*)fwd_kernel, hipFuncAttributeMaxDynamicSharedMemorySize, LDS_BYTES) != hipSuccess) { fprintf(stderr, "kernel_launch: hipFuncSetAttribute failed\n"); grid = -1; return; }
        if (hipOccupancyMaxActiveBlocksPerMultiprocessor(&per_cu, (const void*)fwd_kernel, NTHREADS, LDS_BYTES) != hipSuccess || per_cu < 1) { fprintf(stderr, "kernel_launch: occupancy query says %d\n", per_cu); }
        (void)hipGetLastError();
        grid = cus;
    }
    if (grid < 0) return;
    (void)hipMemsetAsync((char*)d_ws + WS_CTL, 0, CTL_ZERO_BYTES, stream);
    Args a{};
    for (int i = 0; i < 21; ++i) a.in[i] = (const float*)d_in[i];
    a.out = (float*)d_out; a.ws = (unsigned char*)d_ws;
#if MK_N_LAUNCHES == 1
    a.ph_lo = 0; a.ph_hi = N_PHASES;
    hipLaunchKernelGGL(fwd_kernel, dim3(grid), dim3(NTHREADS), LDS_BYTES, stream, a);
#else
#ifndef DBG_LAST_PHASE
#define DBG_LAST_PHASE (N_PHASES - 1)
#endif
#ifndef DBG_DUP_MASK
#define DBG_DUP_MASK 0
#endif
#ifndef DBG_DUP_FLAGS
#define DBG_DUP_FLAGS 0
#endif
    for (int p = 0; p <= DBG_LAST_PHASE; ++p) { a.ph_lo = p; a.ph_hi = p + 1;
        const int nrep = ((DBG_DUP_MASK >> p) & 1) ? 2 : 1;
        for (int rep = 0; rep < nrep; ++rep) { a.flags = (nrep == 2 && rep == 0) ? DBG_DUP_FLAGS : 0; if (rep == 1 && p == 6) (void)hipMemsetAsync((char*)d_ws + WS_CTL, 0, CTL_ZERO_BYTES, stream);
            hipLaunchKernelGGL(fwd_kernel, dim3(grid), dim3(NTHREADS), LDS_BYTES, stream, a); } }
#ifdef DBG_HASH_OFF
    { const unsigned* hb = DBG_HASH_OFF == 0 ? (const unsigned*)d_out : (const unsigned*)((char*)d_ws + DBG_HASH_OFF);
      hipLaunchKernelGGL(dbg_hash, dim3(1024), dim3(256), 0, stream, hb, (size_t)(DBG_HASH_BYTES) / 4, (unsigned*)d_ws + 2);
      hipLaunchKernelGGL(dbg_fill, dim3(1024), dim3(256), 0, stream, (float*)d_out, (size_t)NTOK * DM, (const unsigned*)d_ws + 2); }
#endif
#endif
}
```

```cpp
#include <hip/hip_runtime.h>
#include <cstdio>
#include <cstdint>

#ifndef MK_N_LAUNCHES
#define MK_N_LAUNCHES 1
#endif

constexpr int NB = 8, SEQ = 2048, NMETA = 16, TT = SEQ + NMETA  , DM = 1024, NTOK = NB * SEQ  , NALL = NB * TT  ;
constexpr int AW = 512, NH = 8, HD = 64, IDXD = 64, CC = 512, CW = 31, NE = 32, DFF = 1024, TOPK = 256;
constexpr int INCOLS = 5192, TP = 2176  , VOFF = 0  , MSTR = 68  ;
constexpr float EPS = 1e-6f, LOG2E = 1.4426950408889634f;
constexpr float QSCALE = 0.125f * LOG2E;
constexpr int MAXTILES = 296;
constexpr int SC_Q = 0, SC_K = 512, SC_V = 1024, SC_IQ = 1536, SC_IK = 2048, SC_IW = 2112, SC_GLU = 2120, SC_GATE = 3144;
constexpr int WR_GLU = 2048, WR_GATE = 3072, WR_IK = 5120, WR_IW = 5184, WIN_ROWS = 5376;

constexpr size_t MiB = 1u << 20;
constexpr size_t al4k(size_t x) { return (x + 4095) & ~(size_t)4095; }
constexpr size_t WS_CTL = 0, CTL_ZERO_BYTES = 1 * MiB;
constexpr size_t WS_WIN = 1 * MiB;
constexpr size_t WS_WAO = WS_WIN + al4k((size_t)WIN_ROWS * DM * 2);
constexpr size_t WS_WCO = WS_WAO + al4k((size_t)DM * AW * 2);
constexpr size_t WS_WOUT = WS_WCO + al4k((size_t)DM * CC * 2);
constexpr size_t WS_WUG = WS_WOUT + al4k((size_t)DM * DM * 2);
constexpr size_t WS_WD = WS_WUG + al4k((size_t)NE * 2 * DFF * DM * 2);
constexpr size_t WS_XN = WS_WD + al4k((size_t)NE * DM * DFF * 2);
constexpr size_t WS_XNM = WS_XN + al4k((size_t)NTOK * DM * 2);
constexpr size_t WS_Q = WS_XNM + al4k((size_t)NMETA * DM * 2);
constexpr size_t WS_IQ = WS_Q + al4k((size_t)NTOK * AW * 2);
constexpr size_t WS_KB = WS_IQ + al4k((size_t)NTOK * AW * 2);
constexpr size_t WS_VT = WS_KB + al4k((size_t)(NALL + 64) * AW * 2);
constexpr size_t WS_IK = WS_VT + al4k((size_t)NB * AW * TP * 2);
constexpr size_t WS_IW = WS_IK + al4k((size_t)NB * 65 * 2048 * 2);
constexpr size_t WS_GLU = WS_IW + al4k((size_t)NTOK * 8 * 4);
constexpr size_t WS_GA = WS_GLU + al4k((size_t)NALL * CC * 2);
constexpr size_t WS_GB = WS_GA + al4k((size_t)NTOK * DM * 2);
constexpr size_t WS_MASK = WS_GB + al4k((size_t)NTOK * DM * 2);
constexpr size_t WS_AO = WS_MASK + al4k((size_t)NTOK * MSTR * 4);
constexpr size_t WS_CO = WS_AO + al4k((size_t)NTOK * AW * 2);
constexpr size_t WS_MG = WS_CO + al4k((size_t)NTOK * CC * 2);
constexpr size_t WS_TE = WS_MG + al4k((size_t)NTOK * DM * 2);
constexpr size_t WS_TP = WS_TE + al4k((size_t)NTOK * 4 * 4);
constexpr size_t WS_LIST = WS_TP + al4k((size_t)NTOK * 4 * 4);
constexpr size_t WS_LG = WS_LIST + al4k((size_t)NE * NTOK * 4);
constexpr size_t WS_ACT = WS_LG + al4k((size_t)NE * NTOK * 4);
constexpr size_t WS_YP = WS_ACT + al4k((size_t)MAXTILES * 256 * DFF * 2);
constexpr size_t WS_H1 = WS_YP + al4k((size_t)MAXTILES * 256 * DM * 2);
constexpr size_t WS_WRT = WS_H1 + al4k((size_t)NTOK * DM * 4);
constexpr size_t WS_RG = WS_WRT + al4k((size_t)2 * NE * DM * 2);
constexpr size_t WS_DUMMY = WS_RG + al4k((size_t)NE * NTOK * 4);
constexpr size_t WS_END = WS_DUMMY + 4096;
static_assert(WS_END < ((size_t)1 << 32), "32-bit byte offsets into d_ws");
constexpr int CW_TMO = 0, CW_CODE = 1, CW_BAR = 4096, CW_ECNT = 16384;

constexpr int RING_BYTES = 131072;
constexpr int LDSX_OFF = 153600;
constexpr int MISC_OFF = 161792;
constexpr int LDS_BYTES = 163840;
constexpr int NWAVES = 8, NTHREADS = 512;

#define GAS __attribute__((address_space(1)))
#define LAS __attribute__((address_space(3)))
typedef unsigned short bf16_t;
typedef short bf16x8 __attribute__((ext_vector_type(8)));
typedef short s16x4 __attribute__((ext_vector_type(4)));
typedef float f32x4 __attribute__((ext_vector_type(4)));
typedef float f32x16 __attribute__((ext_vector_type(16)));
typedef unsigned u32x4 __attribute__((ext_vector_type(4)));
typedef unsigned u32x2 __attribute__((ext_vector_type(2)));
typedef GAS unsigned gu32;
#define RLX_AGENT __ATOMIC_RELAXED, __HIP_MEMORY_SCOPE_AGENT
#define LDS_WAIT() asm volatile("s_waitcnt lgkmcnt(0)" ::: "memory")
#define VM_WAIT() asm volatile("s_waitcnt vmcnt(0)" ::: "memory")

typedef float f32x2_t __attribute__((ext_vector_type(2))); typedef __bf16 bf16x2_t __attribute__((ext_vector_type(2)));
__device__ __forceinline__ unsigned cvt_pk_bf16(float lo, float hi) { const f32x2_t v = {lo, hi}; const bf16x2_t b = __builtin_convertvector(v, bf16x2_t); return __builtin_bit_cast(unsigned, b); }
__device__ __forceinline__ float bf2f(unsigned short b) { return __uint_as_float((unsigned)b << 16); }
__device__ __forceinline__ float bflo(unsigned w) { return __uint_as_float(w << 16); }
__device__ __forceinline__ float bfhi(unsigned w) { return __uint_as_float(w & 0xffff0000u); }
__device__ __forceinline__ float sigmoidf_(float x) { return __builtin_amdgcn_rcpf(1.0f + __builtin_amdgcn_exp2f(-LOG2E * x)); }
__device__ __forceinline__ float wave_sum(float v) {
#pragma unroll
    for (int o = 1; o < 64; o <<= 1) v += __shfl_xor(v, o);
    return v;
}

namespace pg8 {
constexpr int BM = 256, BK = 64, HALF = 128, HTB = HALF * BK * 2, STAGE_BYTES = 8 * HTB;
__host__ __device__ __forceinline__ int lds_byte(int r, int c) { const int st = (r >> 4) * 2 + (c >> 5), rr = r & 15, cc = c & 31, ob = rr * 64 + cc * 2; return st * 1024 + (ob ^ (((ob >> 9) & 1) << 5)); }
__host__ __device__ __forceinline__ void stage_rc(int b, int& R, int& C) { const int st = b / 1024, sb = b % 1024, swz = sb ^ (((sb >> 9) & 1) << 5); R = (st >> 1) * 16 + swz / 64; C = (st & 1) * 32 + (swz % 64) / 2; }

struct Unit { int pm, pn, z; };

template <class Epi, class Sched>
__device__ __forceinline__ void gemm_phase(LAS unsigned char* lds, const int K, const Sched& S, const Epi& E) {
    const int tid = threadIdx.x, wid = __builtin_amdgcn_readfirstlane(tid >> 6), lane = tid & 63, wr = wid >> 2, wc = wid & 3, fr = lane & 15, fq = lane >> 4;
    const int nt = K / BK;
    unsigned voffB[2];
#pragma unroll
    for (int i = 0; i < 2; ++i) { int R_, C_; stage_rc(tid * 16 + i * 8192, R_, C_); voffB[i] = (unsigned)(R_ * K + C_) * 2u; }
    const size_t kstep = (size_t)(BK * 2);
    const size_t hstep = (size_t)HALF * K * 2;
    const unsigned ldsw = (unsigned)wid * 1024u;
    const int aoff = lds_byte(wr * 64 + fr, fq * 8), boff = lds_byte(wc * 32 + fr, fq * 8);
    const char* const abase = S.a_base();
#define PG8_SA(b, h) (((b) * 2 + (h)) * HTB)
#define PG8_SB(b, h) ((4 + (b) * 2 + (h)) * HTB)
#define PG8_STAGE(bufoff, gbase, voff) do { _Pragma("unroll") for (int _i = 0; _i < 2; ++_i) \
        __builtin_amdgcn_global_load_lds((const unsigned*)((const char*)(gbase) + (voff)[_i]), (LAS unsigned*)(lds + (bufoff) + ldsw + _i * 8192), 16, 0, 0); } while (0)
#define PG8_LDA(dst, b, h) do { _Pragma("unroll") for (int m = 0; m < 4; ++m) _Pragma("unroll") for (int k = 0; k < 2; ++k) dst[m][k] = *(const LAS bf16x8*)(lds + PG8_SA(b, h) + aoff + m * 2048 + k * 1024); } while (0)
#define PG8_LDB(dst, b, h) do { _Pragma("unroll") for (int n = 0; n < 2; ++n) _Pragma("unroll") for (int k = 0; k < 2; ++k) dst[n][k] = *(const LAS bf16x8*)(lds + PG8_SB(b, h) + boff + n * 2048 + k * 1024); } while (0)
#define PG8_MMA(ai, bj, At, Bt) do { __builtin_amdgcn_s_setprio(1); _Pragma("unroll") for (int m = 0; m < 4; ++m) _Pragma("unroll") for (int n = 0; n < 2; ++n) _Pragma("unroll") for (int k = 0; k < 2; ++k) \
        acc[ai][bj][m][n] = __builtin_amdgcn_mfma_f32_16x16x32_bf16(Bt[n][k], At[m][k], acc[ai][bj][m][n], 0, 0, 0); __builtin_amdgcn_s_setprio(0); } while (0)
#define PG8_WAIT_V(n) asm volatile("s_waitcnt vmcnt(" #n ")" ::: "memory")
#define PG8_WAIT_L(n) asm volatile("s_waitcnt lgkmcnt(" #n ")" ::: "memory")
#define PG8_BAR __builtin_amdgcn_s_barrier()
#define PG8_SCHED __builtin_amdgcn_sched_barrier(0)
    Unit cur, nxt; int ui = 0;
    if (!S.next(0, cur)) return;
    f32x4 acc[2][2][4][2];
#pragma unroll
    for (int a = 0; a < 2; ++a)
#pragma unroll
        for (int b = 0; b < 2; ++b)
#pragma unroll
            for (int m = 0; m < 4; ++m)
#pragma unroll
                for (int n = 0; n < 2; ++n) acc[a][b][m][n] = (f32x4){0.f, 0.f, 0.f, 0.f};
    bf16x8 At[4][2], B0[2][2], B1[2][2];
    unsigned ca[2][2], na[2][2];
    S.a_offs(cur, tid, ca);
    const char* cB = S.b_base(cur);
    PG8_STAGE(PG8_SB(0, 0), cB, voffB); PG8_STAGE(PG8_SB(0, 1), cB + hstep, voffB); PG8_STAGE(PG8_SA(0, 0), abase, ca[0]); PG8_STAGE(PG8_SA(0, 1), abase, ca[1]);
    if (wr == 1) PG8_BAR;
    PG8_WAIT_V(2); PG8_BAR;
    PG8_STAGE(PG8_SB(1, 0), cB + kstep, voffB); PG8_STAGE(PG8_SA(1, 0), abase + kstep, ca[0]); PG8_STAGE(PG8_SB(1, 1), cB + hstep + kstep, voffB);
    PG8_WAIT_V(6); PG8_BAR;
    for (;;) {
        const bool has_next = S.next(ui + 1, nxt);
        const char* nB = cB;
#pragma unroll
        for (int h = 0; h < 2; ++h)
#pragma unroll
            for (int i = 0; i < 2; ++i) na[h][i] = ca[h][i];
        if (has_next) { S.a_offs(nxt, tid, na); nB = S.b_base(nxt); }
        for (int t = 0; t < nt; t += 2) {
            const bool last = (t == nt - 2);
            const char* a1 = abase + (size_t)(t + 1) * kstep;
            const char* a2 = last ? abase : abase + (size_t)(t + 2) * kstep; const char* b2 = last ? nB : cB + (size_t)(t + 2) * kstep;
            const char* a3 = a2 + kstep; const char* b3 = b2 + kstep;
            PG8_LDB(B0, 0, 0); PG8_LDB(B1, 0, 1); PG8_SCHED; PG8_LDA(At, 0, 0); PG8_STAGE(PG8_SA(1, 1), a1, ca[1]);
            PG8_WAIT_V(8); PG8_WAIT_L(0); PG8_BAR; PG8_MMA(0, 0, At, B0); PG8_MMA(0, 1, At, B1); PG8_BAR; PG8_SCHED;
            if (last) {
#pragma unroll
                for (int h = 0; h < 2; ++h)
#pragma unroll
                    for (int i = 0; i < 2; ++i) ca[h][i] = na[h][i];
            }
            PG8_LDA(At, 0, 1); PG8_STAGE(PG8_SB(0, 0), b2, voffB); PG8_STAGE(PG8_SB(0, 1), b2 + hstep, voffB); PG8_STAGE(PG8_SA(0, 0), a2, ca[0]);
            PG8_WAIT_V(8); PG8_WAIT_L(0); PG8_BAR; PG8_MMA(1, 0, At, B0); PG8_MMA(1, 1, At, B1); PG8_BAR; PG8_SCHED;
            PG8_LDB(B0, 1, 0); PG8_LDB(B1, 1, 1); PG8_SCHED; PG8_LDA(At, 1, 0); PG8_STAGE(PG8_SA(0, 1), a2, ca[1]);
            PG8_WAIT_V(8); PG8_WAIT_L(0); PG8_BAR; PG8_MMA(0, 0, At, B0); PG8_MMA(0, 1, At, B1); PG8_BAR; PG8_SCHED;
            PG8_LDA(At, 1, 1); PG8_STAGE(PG8_SB(1, 0), b3, voffB); PG8_STAGE(PG8_SB(1, 1), b3 + hstep, voffB); PG8_STAGE(PG8_SA(1, 0), a3, ca[0]);
            PG8_WAIT_V(8); PG8_WAIT_L(0); PG8_BAR; PG8_MMA(1, 0, At, B0); PG8_MMA(1, 1, At, B1); PG8_BAR; PG8_SCHED;
        }
        if (wr == 0) PG8_BAR;
        { int tz = tid; asm volatile("" : "+v"(tz));
          const int l2 = tz & 63, w2 = __builtin_amdgcn_readfirstlane(tz >> 6); E(acc, cur, w2 >> 2, w2 & 3, l2 & 15, l2 >> 4); }
        if (!has_next) break;
#pragma unroll
        for (int a = 0; a < 2; ++a)
#pragma unroll
            for (int b = 0; b < 2; ++b)
#pragma unroll
                for (int m = 0; m < 4; ++m)
#pragma unroll
                    for (int n = 0; n < 2; ++n) acc[a][b][m][n] = (f32x4){0.f, 0.f, 0.f, 0.f};
        cur = nxt; cB = nB; ++ui;
        if (wr == 1) PG8_BAR;
    }
    PG8_WAIT_V(0);
    PG8_BAR;
#undef PG8_SA
#undef PG8_SB
#undef PG8_STAGE
#undef PG8_LDA
#undef PG8_LDB
#undef PG8_MMA
#undef PG8_WAIT_V
#undef PG8_WAIT_L
#undef PG8_BAR
#undef PG8_SCHED
}
}

#define XB_TMO      128
#define XB_XCNT(j)  (256  + 64 * (j))
#define XB_XSUB(j)  (1280 + 64 * (j))
#define XB_XGEN(j)  (2304 + 64 * (j))
#define XB_TOP      3328
#define XB_TOPGEN   3392
#define XCD_BAR_WORDS 3456
#define XB_SPIN_CAP (1u << 18)
__device__ __forceinline__ unsigned xb_ld(unsigned* p)              { return __hip_atomic_load(p, __ATOMIC_RELAXED, __HIP_MEMORY_SCOPE_AGENT); }
__device__ __forceinline__ unsigned xb_add(unsigned* p, unsigned v) { return __hip_atomic_fetch_add(p, v, __ATOMIC_RELAXED, __HIP_MEMORY_SCOPE_AGENT); }
__device__ __forceinline__ unsigned xb_xcc_id() { return (unsigned)__builtin_amdgcn_s_getreg((3 << 11) | 20) & 0xFu; }
#define XB_SPIN(cond, bar) do { unsigned _sp = 0; while (cond) { __builtin_amdgcn_s_sleep(1); \
    if ((++_sp & 255u) == 0u) { if (xb_ld(&(bar)[XB_TMO])) break; if (_sp > XB_SPIN_CAP) { atomicAdd(&(bar)[XB_TMO], 1u); break; } } } } while (0)
struct XcdBarrier { unsigned* bar; unsigned x; volatile LAS unsigned* st; };
__device__ __forceinline__ XcdBarrier xcd_barrier_post(unsigned* bar, volatile LAS unsigned* st) {
    XcdBarrier b; b.bar = bar; b.x = xb_xcc_id(); b.st = st;
    if (threadIdx.x == 0) (void)xb_add(&bar[XB_XCNT(b.x)], 1u);
    return b;
}
__device__ __forceinline__ void xcd_barrier_complete(unsigned* bar, unsigned x, unsigned& nloc, unsigned& nx) {
    const unsigned G = gridDim.x * gridDim.y * gridDim.z;
    unsigned sum, cnt, mine, sp = 0u;
    for (;;) {
        sum = 0u; cnt = 0u; mine = 0u;
#pragma unroll
        for (unsigned j = 0; j < 16; ++j) { const unsigned c = xb_ld(&bar[XB_XCNT(j)]); sum += c; cnt += (c > 0u) ? 1u : 0u; mine = (j == x) ? c : mine; }
        if (sum == G) break;
        __builtin_amdgcn_s_sleep(1);
        if ((++sp & 255u) == 0u) { if (xb_ld(&bar[XB_TMO])) break; if (sp > XB_SPIN_CAP) { atomicAdd(&bar[XB_TMO], 1u); break; } }
    }
    nloc = mine > 0u ? mine : 1u; nx = cnt > 0u ? cnt : 1u;
}
__device__ __forceinline__ void xcd_barrier(const XcdBarrier& b) {
    asm volatile("s_waitcnt vmcnt(0)" ::: "memory");
    __syncthreads();
    if (threadIdx.x == 0) {
        unsigned* bar = b.bar;
        __builtin_amdgcn_s_waitcnt(0);
        unsigned nloc = b.st[0], nx = b.st[1];
        if (nloc == 0u) { xcd_barrier_complete(bar, b.x, nloc, nx); b.st[0] = nloc; b.st[1] = nx; }
        const unsigned old = xb_add(&bar[XB_XSUB(b.x)], 1u);
        const unsigned gen = old / nloc;
        if (old + 1u == (gen + 1u) * nloc) {
            __builtin_amdgcn_fence(__ATOMIC_RELEASE, "agent");
            asm volatile("s_waitcnt vmcnt(0)" ::: "memory");
            const unsigned og = xb_add(&bar[XB_TOP], 1u);
            const unsigned tg = og / nx;
            if (og + 1u == (tg + 1u) * nx) xb_add(&bar[XB_TOPGEN], 1u);
            else XB_SPIN(xb_ld(&bar[XB_TOPGEN]) == tg, bar);
            __builtin_amdgcn_fence(__ATOMIC_ACQUIRE, "agent");
            xb_add(&bar[XB_XGEN(b.x)], 1u);
            asm volatile("s_waitcnt vmcnt(0)" ::: "memory");
        } else {
            XB_SPIN(xb_ld(&bar[XB_XGEN(b.x)]) == gen, bar);
            __builtin_amdgcn_fence(__ATOMIC_ACQUIRE, "agent");
            asm volatile("s_waitcnt vmcnt(0)" ::: "memory");
        }
    }
    __syncthreads();
}

struct Args {
    const float* in[21];
    float* out; unsigned char* ws;
    int ph_lo, ph_hi, flags, pad;
};
enum { I_X = 0, I_META, I_RELB, I_NMIX, I_WIN, I_BGATE, I_WAO, I_CONVW, I_CONVB, I_LNG, I_LNB, I_WCO, I_WOUT, I_NFFN, I_WR, I_BR, I_WUG, I_BUG, I_WD, I_BD, I_NFIN };

struct Frame {
    LAS unsigned char* lds;
    unsigned char* ws;
    int tid, lane, wave;
    int G, bid;
};
template <class T> __device__ __forceinline__ T* wsp(unsigned char* ws, size_t off) { return (T*)(ws + off); }

struct P0Desc { const float* src; bf16_t* dst; int ldn, ldk; };
__device__ __forceinline__ void p0_load(const P0Desc& d, f32x4 (&v)[16], int lane) {
    const float* p = d.src + (size_t)(lane >> 4) * d.ldn + (lane & 15) * 4;
#pragma unroll
    for (int i = 0; i < 16; ++i) v[i] = *(const f32x4*)(p + (size_t)(4 * i) * d.ldn);
}
__device__ __forceinline__ void p0_store(const P0Desc& d, const f32x4 (&v)[16], LAS float* scr, int lane) {
    const int n4 = (lane & 15) * 4, kr = lane >> 4;
#pragma unroll
    for (int i = 0; i < 16; ++i) { LAS float* p = scr + (4 * i + kr) * 65 + n4; p[0] = v[i][0]; p[1] = v[i][1]; p[2] = v[i][2]; p[3] = v[i][3]; }
    LDS_WAIT(); asm volatile("" ::: "memory");
    const int c = lane & 7;
#pragma unroll
    for (int j = 0; j < 8; ++j) { const int n = (lane >> 3) + 8 * j; const LAS float* s = scr + (8 * c) * 65 + n;
        u32x4 o; o.x = cvt_pk_bf16(s[0 * 65], s[1 * 65]); o.y = cvt_pk_bf16(s[2 * 65], s[3 * 65]); o.z = cvt_pk_bf16(s[4 * 65], s[5 * 65]); o.w = cvt_pk_bf16(s[6 * 65], s[7 * 65]);
        *(u32x4*)(d.dst + (size_t)n * d.ldk + 8 * c) = o; }
    LDS_WAIT(); asm volatile("" ::: "memory");
}
__device__ __forceinline__ void rms_row_to_bf16(const float* __restrict__ xrow, const float* __restrict__ g, bf16_t* __restrict__ orow, int lane) {
    const f32x4* xr = (const f32x4*)xrow + lane; const f32x4* gr = (const f32x4*)g + lane;
    f32x4 v[4]; float s = 0.f;
#pragma unroll
    for (int j = 0; j < 4; ++j) { v[j] = xr[64 * j]; s += (v[j].x * v[j].x + v[j].y * v[j].y) + (v[j].z * v[j].z + v[j].w * v[j].w); }
    const float r = 1.0f / sqrtf(wave_sum(s) * (1.f / DM) + EPS);
    unsigned long long* o8 = (unsigned long long*)orow + lane;
#pragma unroll
    for (int j = 0; j < 4; ++j) { const f32x4 gg = gr[64 * j];
        o8[64 * j] = (unsigned long long)cvt_pk_bf16(v[j].x * r * gg.x, v[j].y * r * gg.y) | ((unsigned long long)cvt_pk_bf16(v[j].z * r * gg.z, v[j].w * r * gg.w) << 32); }
}
__device__ __forceinline__ void p0_prologue(Frame& F, const Args& a, const int part) {
    LAS float* scr = (LAS float*)(F.lds + F.wave * 16896);
    const int gw = F.bid * NWAVES + F.wave, NGW = F.G * NWAVES;
    unsigned char* ws = F.ws;
    constexpr int T_IN = 81 * 16, T_AO = 16 * 8, T_CO = 16 * 8, T_OUT = 16 * 16, T_SMALL = T_IN + T_AO + T_CO + T_OUT;
    constexpr int T_UG = NE * 32 * 16, T_D = NE * 16 * 16, T_ALL = T_SMALL + T_UG + T_D;
    auto desc = [&](int it) -> P0Desc {
        int r = it; P0Desc d;
        if (r < T_IN) { const int g = r / 16, kb = r % 16; const int dr = g * 64; int sc;
            if (dr < WR_GLU) sc = dr;
            else if (dr < WR_GATE) { const int q = dr - WR_GLU, tile = q >> 8, hf = (q >> 7) & 1, w = q & 127; sc = SC_GLU + 512 * hf + 128 * tile + w; }
            else if (dr < WR_IK) sc = SC_GATE + (dr - WR_GATE);
            else sc = SC_IK + (dr - WR_IK);
            d.src = a.in[I_WIN] + (size_t)(kb * 64) * INCOLS + sc; d.ldn = INCOLS; d.dst = wsp<bf16_t>(ws, WS_WIN) + (size_t)dr * DM + kb * 64; d.ldk = DM; return d; }
        r -= T_IN;
        if (r < T_AO) { const int g = r / 8, kb = r % 8; d.src = a.in[I_WAO] + (size_t)(kb * 64) * DM + g * 64; d.ldn = DM; d.dst = wsp<bf16_t>(ws, WS_WAO) + (size_t)(g * 64) * AW + kb * 64; d.ldk = AW; return d; }
        r -= T_AO;
        if (r < T_CO) { const int g = r / 8, kb = r % 8; d.src = a.in[I_WCO] + (size_t)(kb * 64) * DM + g * 64; d.ldn = DM; d.dst = wsp<bf16_t>(ws, WS_WCO) + (size_t)(g * 64) * CC + kb * 64; d.ldk = CC; return d; }
        r -= T_CO;
        if (r < T_OUT) { const int g = r / 16, kb = r % 16; d.src = a.in[I_WOUT] + (size_t)(kb * 64) * DM + g * 64; d.ldn = DM; d.dst = wsp<bf16_t>(ws, WS_WOUT) + (size_t)(g * 64) * DM + kb * 64; d.ldk = DM; return d; }
        r -= T_OUT;
        if (r < T_UG) { const int e = r / 512, q = r % 512, g = q % 32, kb = q / 32; const int dr = g * 64, tile = dr >> 8, hf = (dr >> 7) & 1, w = dr & 127;
            d.src = a.in[I_WUG] + (size_t)e * DM * 2 * DFF + (size_t)(kb * 64) * (2 * DFF) + DFF * hf + 128 * tile + w; d.ldn = 2 * DFF;
            d.dst = wsp<bf16_t>(ws, WS_WUG) + (size_t)e * 2 * DFF * DM + (size_t)dr * DM + kb * 64; d.ldk = DM; return d; }
        r -= T_UG;
        { const int e = r / 256, q = r % 256, g = q % 16, kb = q / 16;
            d.src = a.in[I_WD] + (size_t)e * DFF * DM + (size_t)(kb * 64) * DM + g * 64; d.ldn = DM; d.dst = wsp<bf16_t>(ws, WS_WD) + (size_t)e * DM * DFF + (size_t)(g * 64) * DFF + kb * 64; d.ldk = DFF; return d; }
    };
    const int T_LO = part ? T_SMALL : 0, T_HI = part ? T_ALL : T_SMALL;
    if (T_LO + gw < T_HI) {
        f32x4 va[16], vb[16];
        P0Desc da = desc(T_LO + gw), db = da;
        p0_load(da, va, F.lane);
        for (int it = T_LO + gw; it < T_HI; it += 2 * NGW) {
            const int i1 = it + NGW, i2 = it + 2 * NGW;
            db = desc(i1 < T_HI ? i1 : it); p0_load(db, vb, F.lane);
            p0_store(da, va, scr, F.lane);
            da = desc(i2 < T_HI ? i2 : it); p0_load(da, va, F.lane);
            if (i1 < T_HI) p0_store(db, vb, scr, F.lane);
        }
    }
    if (part) return;
    { const int gt = F.bid * NTHREADS + F.tid;
      if (gt < 8 * DM / 2) { const int n = gt >> 9, k = (gt & 511) * 2; const float v0 = a.in[I_WIN][(size_t)k * INCOLS + SC_IW + n], v1 = a.in[I_WIN][(size_t)(k + 1) * INCOLS + SC_IW + n];
          *(unsigned*)(wsp<bf16_t>(ws, WS_WIN) + (size_t)(WR_IW + n) * DM + k) = cvt_pk_bf16(v0, v1); } }
    { const int gt = F.bid * NTHREADS + F.tid;
      if (gt < NE * DM / 2) { const int e = gt >> 9, d = (gt & 511) * 2; const float v0 = a.in[I_NFFN][d] * a.in[I_WR][(size_t)d * NE + e], v1 = a.in[I_NFFN][d + 1] * a.in[I_WR][(size_t)(d + 1) * NE + e];
          const unsigned hi = cvt_pk_bf16(v0, v1); const unsigned lo = cvt_pk_bf16(v0 - bflo(hi), v1 - bfhi(hi));
          *(unsigned*)(wsp<bf16_t>(ws, WS_WRT) + (size_t)e * DM + d) = hi; *(unsigned*)(wsp<bf16_t>(ws, WS_WRT) + (size_t)(NE + e) * DM + d) = lo; } }
    for (int m = gw; m < NTOK + NMETA; m += NGW) {
        if (m < NTOK) rms_row_to_bf16(a.in[I_X] + (size_t)m * DM, a.in[I_NMIX], wsp<bf16_t>(ws, WS_XN) + (size_t)m * DM, F.lane);
        else rms_row_to_bf16(a.in[I_META] + (size_t)(m - NTOK) * DM, a.in[I_NMIX], wsp<bf16_t>(ws, WS_XNM) + (size_t)(m - NTOK) * DM, F.lane);
    }
}

struct PlainSched {
    const char* ws; unsigned a_off, b_off; int K, nM, nN, nwg, G, c;
    __device__ __forceinline__ void init(const unsigned char* ws_, size_t a, size_t b, int M, int N, int K_, int G_, int c_) { ws = (const char*)ws_; a_off = (unsigned)a; b_off = (unsigned)b; K = K_; nM = M / 256; nN = N / 256; nwg = nM * nN; G = G_; c = c_; }
    __device__ __forceinline__ bool next(int i, pg8::Unit& u) const {
        const long L = (long)i * G + c; if (L >= nwg) return false;
        int wgid = (int)L; { const int q = nwg / 8, r = nwg % 8, xcd = wgid % 8, off = wgid / 8; wgid = (xcd < r ? xcd * (q + 1) : r * (q + 1) + (xcd - r) * q) + off; }
        const int nig = 8 * nN, gid = wgid / nig, fm = gid * 8, gsz = (nM - fm) < 8 ? (nM - fm) : 8;
        u.pm = fm + ((wgid % nig) % gsz); u.pn = (wgid % nig) / gsz; u.z = 0; return true;
    }
    __device__ __forceinline__ const char* a_base() const { return ws; }
    __device__ __forceinline__ void a_offs(const pg8::Unit& u, int tid, unsigned (&o)[2][2]) const {
        int R[2], C[2]; pg8::stage_rc(tid * 16, R[0], C[0]); pg8::stage_rc(tid * 16 + 8192, R[1], C[1]);
#pragma unroll
        for (int h = 0; h < 2; ++h)
#pragma unroll
            for (int i = 0; i < 2; ++i) o[h][i] = a_off + (unsigned)(((u.pm * 256 + h * 128 + R[i]) * K + C[i]) * 2);
    }
    __device__ __forceinline__ const char* b_base(const pg8::Unit& u) const { return ws + b_off + (size_t)u.pn * 256 * K * 2; }
};
struct MergeSched {
    const char* ws; int G, c;
    __device__ __forceinline__ bool next(int i, pg8::Unit& u) const {
        const int t = c + (i >> 1) * G;
        if (t >= 256) return false;
        u.pm = (t & 7) + 8 * (t >> 5); u.pn = (t >> 3) & 3; u.z = i & 1; return true;
    }
    __device__ __forceinline__ const char* a_base() const { return ws; }
    __device__ __forceinline__ void a_offs(const pg8::Unit& u, int tid, unsigned (&o)[2][2]) const {
        int R[2], C[2]; pg8::stage_rc(tid * 16, R[0], C[0]); pg8::stage_rc(tid * 16 + 8192, R[1], C[1]);
        const unsigned base = (unsigned)(u.z ? WS_CO : WS_AO);
#pragma unroll
        for (int h = 0; h < 2; ++h)
#pragma unroll
            for (int i = 0; i < 2; ++i) o[h][i] = base + (unsigned)(((u.pm * 256 + h * 128 + R[i]) * 512 + C[i]) * 2);
    }
    __device__ __forceinline__ const char* b_base(const pg8::Unit& u) const { return ws + (u.z ? WS_WCO : WS_WAO) + (size_t)u.pn * 256 * 512 * 2; }
};
struct MoeTables { const LAS int* cnt; const LAS int* tbase; };
template <int NC, bool GATHER>
struct MoeSched {
    const char* ws; MoeTables T; int G, c, total;
    __device__ __forceinline__ bool next(int i, pg8::Unit& u) const {
        const long L = (long)i * G + c; if (L >= total) return false;
        int wgid = (int)L; { const int q = total / 8, r = total % 8, xcd = wgid % 8, off = wgid / 8; wgid = (xcd < r ? xcd * (q + 1) : r * (q + 1) + (xcd - r) * q) + off; }
        int e = 0;
        for (int j = 1; j < NE; ++j) e += (wgid >= __builtin_amdgcn_readfirstlane(T.tbase[j]) * NC) ? 1 : 0;
        e = __builtin_amdgcn_readfirstlane(e);
        const int tb0 = __builtin_amdgcn_readfirstlane(T.tbase[e]), tb1 = __builtin_amdgcn_readfirstlane(T.tbase[e + 1]);
        const int loc = wgid - tb0 * NC, nt_e = tb1 - tb0;
        u.z = e; u.pm = loc % nt_e; u.pn = loc / nt_e; return true;
    }
    __device__ __forceinline__ const char* a_base() const { return ws; }
    __device__ __forceinline__ void a_offs(const pg8::Unit& u, int tid, unsigned (&o)[2][2]) const {
        int R[2], C[2]; pg8::stage_rc(tid * 16, R[0], C[0]); pg8::stage_rc(tid * 16 + 8192, R[1], C[1]);
        if (GATHER) {
            const int* list = (const int*)(ws + WS_LIST) + (size_t)u.z * NTOK; const int n = __builtin_amdgcn_readfirstlane(T.cnt[u.z]);
#pragma unroll
            for (int h = 0; h < 2; ++h)
#pragma unroll
                for (int i = 0; i < 2; ++i) { const int p = u.pm * 256 + h * 128 + R[i]; const int tok = list[p < n ? p : 0];
                    o[h][i] = (unsigned)WS_XN + (unsigned)((tok * DM + C[i]) * 2); }
        } else {
            const int row0 = (__builtin_amdgcn_readfirstlane(T.tbase[u.z]) + u.pm) * 256;
#pragma unroll
            for (int h = 0; h < 2; ++h)
#pragma unroll
                for (int i = 0; i < 2; ++i) o[h][i] = (unsigned)WS_ACT + (unsigned)(((row0 + h * 128 + R[i]) * DFF + C[i]) * 2);
        }
    }
    __device__ __forceinline__ const char* b_base(const pg8::Unit& u) const {
        if (GATHER) return ws + WS_WUG + ((size_t)u.z * 2 * DFF + (size_t)u.pn * 256) * DM * 2;
        else return ws + WS_WD + ((size_t)u.z * DM + (size_t)u.pn * 256) * DFF * 2;
    }
};

#define EPI_ROWS(ai, m) for (int ai = 0; ai < 2; ++ai) _Pragma("unroll") for (int m = 0; m < 4; ++m)
#define EPI_COLS(bj, n) for (int bj = 0; bj < 2; ++bj) _Pragma("unroll") for (int n = 0; n < 2; ++n)
__device__ __forceinline__ void st_bf16x4(bf16_t* p, f32x4 v) { u32x2 w; w.x = cvt_pk_bf16(v[0], v[1]); w.y = cvt_pk_bf16(v[2], v[3]); *(u32x2*)p = w; }

struct EpiInProj {
    unsigned char* ws; const float* bgate;
    __device__ __forceinline__ void operator()(const f32x4 (&acc)[2][2][4][2], const pg8::Unit& u, int wr, int wc, int fr, int fq) const {
        const int pn = u.pn, row0 = u.pm * 256 + wr * 64 + fr, col0 = wc * 32 + 4 * fq;
        const int bidx = u.pm >> 3;
        const int rowk0 = row0 + NMETA * (bidx + 1);
        if (pn < 2 || (pn >= 6 && pn < 8)) {
            bf16_t* O = wsp<bf16_t>(ws, pn < 2 ? WS_Q : WS_IQ); const int cb = (pn & 1) * 256; const float sc = pn < 2 ? QSCALE : 1.0f;
#pragma unroll
            EPI_ROWS(ai, m) { bf16_t* rp = O + (size_t)(row0 + ai * 128 + m * 16) * AW + cb + col0;
#pragma unroll
                EPI_COLS(bj, n) st_bf16x4(rp + bj * 128 + n * 16, acc[ai][bj][m][n] * sc); }
        } else if (pn < 4) {
            bf16_t* O = wsp<bf16_t>(ws, WS_KB); const int cb = (pn & 1) * 256;
#pragma unroll
            EPI_ROWS(ai, m) { bf16_t* rp = O + (size_t)(rowk0 + ai * 128 + m * 16) * AW + cb + col0;
#pragma unroll
                EPI_COLS(bj, n) st_bf16x4(rp + bj * 128 + n * 16, acc[ai][bj][m][n]); }
        } else if (pn < 6) {
            bf16_t* O = wsp<bf16_t>(ws, WS_VT) + (size_t)bidx * AW * TP; const int cb = (pn & 1) * 256;
            const int t0 = (row0 & (SEQ - 1)) + NMETA + VOFF;
#pragma unroll
            EPI_ROWS(ai, m) { const int t = t0 + ai * 128 + m * 16;
#pragma unroll
                EPI_COLS(bj, n) { const f32x4 v = acc[ai][bj][m][n]; bf16_t* cp = O + (size_t)(cb + col0 + bj * 128 + n * 16) * TP + (t & ~1);
                    const float p0 = __shfl_xor(v[0], 1), p1 = __shfl_xor(v[1], 1), p2 = __shfl_xor(v[2], 1), p3 = __shfl_xor(v[3], 1);
                    if ((fr & 1) == 0) { *(unsigned*)(cp) = cvt_pk_bf16(v[0], p0); *(unsigned*)(cp + TP) = cvt_pk_bf16(v[1], p1); }
                    else { *(unsigned*)(cp + 2 * TP) = cvt_pk_bf16(p2, v[2]); *(unsigned*)(cp + 3 * TP) = cvt_pk_bf16(p3, v[3]); } } }
        } else if (pn < 12) {
            bf16_t* O = wsp<bf16_t>(ws, WS_GLU); const int cb = (pn - 8) * 128;
#pragma unroll
            EPI_ROWS(ai, m) { bf16_t* rp = O + (size_t)(rowk0 + ai * 128 + m * 16) * CC + cb + col0;
#pragma unroll
                for (int n = 0; n < 2; ++n) { const f32x4 av = acc[ai][0][m][n], gv = acc[ai][1][m][n]; f32x4 y;
#pragma unroll
                    for (int j = 0; j < 4; ++j) y[j] = av[j] * sigmoidf_(gv[j]);
                    st_bf16x4(rp + n * 16, y); } }
        } else {
            const int gt = pn - 12; bf16_t* O = wsp<bf16_t>(ws, gt < 4 ? WS_GA : WS_GB); const int cb = (gt & 3) * 256; const float* bp = bgate + gt * 256 + col0;
            f32x4 bv[2][2];
#pragma unroll
            EPI_COLS(bj, n) bv[bj][n] = *(const f32x4*)(bp + bj * 128 + n * 16);
#pragma unroll
            EPI_ROWS(ai, m) { bf16_t* rp = O + (size_t)(row0 + ai * 128 + m * 16) * DM + cb + col0;
#pragma unroll
                EPI_COLS(bj, n) { const f32x4 x = acc[ai][bj][m][n] + bv[bj][n]; f32x4 y;
#pragma unroll
                    for (int j = 0; j < 4; ++j) y[j] = sigmoidf_(x[j]);
                    st_bf16x4(rp + bj * 128 + n * 16, y); } }
        }
    }
};
struct EpiMerge {
    unsigned char* ws;
    __device__ __forceinline__ void operator()(const f32x4 (&acc)[2][2][4][2], const pg8::Unit& u, int wr, int wc, int fr, int fq) const {
        const int row0 = u.pm * 256 + wr * 64 + fr, col0 = u.pn * 256 + wc * 32 + 4 * fq;
        const bf16_t* Gt = wsp<bf16_t>(ws, u.z ? WS_GB : WS_GA); bf16_t* O = wsp<bf16_t>(ws, WS_MG);
#pragma unroll
        for (int ai = 0; ai < 2; ++ai) {
            u32x2 g[4][2][2], p[4][2][2];
#pragma unroll
            for (int m = 0; m < 4; ++m)
#pragma unroll
                EPI_COLS(bj, n) { const size_t o = (size_t)(row0 + ai * 128 + m * 16) * DM + col0 + bj * 128 + n * 16; g[m][bj][n] = *(const u32x2*)(Gt + o); p[m][bj][n] = u.z ? *(const u32x2*)(O + o) : (u32x2){0u, 0u}; }
#pragma unroll
            for (int m = 0; m < 4; ++m)
#pragma unroll
                EPI_COLS(bj, n) { const size_t o = (size_t)(row0 + ai * 128 + m * 16) * DM + col0 + bj * 128 + n * 16; const u32x2 gg = g[m][bj][n], pp = p[m][bj][n]; const f32x4 a = acc[ai][bj][m][n];
                    const f32x4 y = (f32x4){bflo(gg.x) * a[0] + bflo(pp.x), bfhi(gg.x) * a[1] + bfhi(pp.x), bflo(gg.y) * a[2] + bflo(pp.y), bfhi(gg.y) * a[3] + bfhi(pp.y)};
                    st_bf16x4(O + o, y); }
        }
    }
};
struct EpiResid {
    const float* x; float* out;
    __device__ __forceinline__ void operator()(const f32x4 (&acc)[2][2][4][2], const pg8::Unit& u, int wr, int wc, int fr, int fq) const {
        const int row0 = u.pm * 256 + wr * 64 + fr, col0 = u.pn * 256 + wc * 32 + 4 * fq;
#pragma unroll
        for (int ai = 0; ai < 2; ++ai)
#pragma unroll
            for (int mh = 0; mh < 2; ++mh) {
                f32x4 xv[2][2][2];
#pragma unroll
                for (int mm = 0; mm < 2; ++mm)
#pragma unroll
                    EPI_COLS(bj, n) xv[mm][bj][n] = *(const f32x4*)(x + (size_t)(row0 + ai * 128 + (2 * mh + mm) * 16) * DM + col0 + bj * 128 + n * 16);
#pragma unroll
                for (int mm = 0; mm < 2; ++mm)
#pragma unroll
                    EPI_COLS(bj, n) *(f32x4*)(out + (size_t)(row0 + ai * 128 + (2 * mh + mm) * 16) * DM + col0 + bj * 128 + n * 16) = xv[mm][bj][n] + acc[ai][bj][2 * mh + mm][n];
            }
    }
};
struct EpiSwiglu {
    unsigned char* ws; const float* bug; MoeTables T;
    __device__ __forceinline__ void operator()(const f32x4 (&acc)[2][2][4][2], const pg8::Unit& u, int wr, int wc, int fr, int fq) const {
        const int e = u.z, n_e = __builtin_amdgcn_readfirstlane(T.cnt[e]), rloc0 = u.pm * 256 + wr * 64 + fr, row0 = __builtin_amdgcn_readfirstlane(T.tbase[e]) * 256 + rloc0, col0 = u.pn * 128 + wc * 32 + 4 * fq;
        const float* bp = bug + (size_t)e * 2 * DFF + col0; bf16_t* O = wsp<bf16_t>(ws, WS_ACT); const float* rg = wsp<float>(ws, WS_RG) + (size_t)e * NTOK;
        f32x4 bg[2], bu[2];
#pragma unroll
        for (int n = 0; n < 2; ++n) { bg[n] = *(const f32x4*)(bp + n * 16); bu[n] = *(const f32x4*)(bp + DFF + n * 16); }
        float rvs[2][4];
#pragma unroll
        EPI_ROWS(ai, m) { const int rl = rloc0 + ai * 128 + m * 16; rvs[ai][m] = rg[rl < n_e ? rl : 0]; }
        bf16_t* const sink = wsp<bf16_t>(ws, WS_DUMMY) + col0;
#pragma unroll
        EPI_ROWS(ai, m) { const int rl = rloc0 + ai * 128 + m * 16; bf16_t* rp = (rl < n_e) ? O + (size_t)(row0 + ai * 128 + m * 16) * DFF + col0 : sink; const float rv = rvs[ai][m];
#pragma unroll
                for (int n = 0; n < 2; ++n) { const f32x4 gv = acc[ai][0][m][n] * rv + bg[n], uv = acc[ai][1][m][n] * rv + bu[n]; f32x4 y;
#pragma unroll
                    for (int j = 0; j < 4; ++j) { const float g = fminf(gv[j], 7.0f), up = fminf(fmaxf(uv[j], -7.0f), 7.0f); y[j] = (up + 1.0f) * g * sigmoidf_(1.702f * g); }
                    st_bf16x4(rp + n * 16, y); } }
    }
};
struct EpiDown {
    unsigned char* ws; const float* bd; MoeTables T;
    __device__ __forceinline__ void operator()(const f32x4 (&acc)[2][2][4][2], const pg8::Unit& u, int wr, int wc, int fr, int fq) const {
        const int e = u.z, n_e = __builtin_amdgcn_readfirstlane(T.cnt[e]), rloc0 = u.pm * 256 + wr * 64 + fr, row0 = __builtin_amdgcn_readfirstlane(T.tbase[e]) * 256 + rloc0, col0 = u.pn * 256 + wc * 32 + 4 * fq;
        const float* bp = bd + (size_t)e * DM + col0; bf16_t* O = wsp<bf16_t>(ws, WS_YP); const float* lg = wsp<float>(ws, WS_LG) + (size_t)e * NTOK;
        f32x4 bv[2][2];
#pragma unroll
        EPI_COLS(bj, n) bv[bj][n] = *(const f32x4*)(bp + bj * 128 + n * 16);
        float gts[2][4];
#pragma unroll
        EPI_ROWS(ai, m) { const int rl = rloc0 + ai * 128 + m * 16; gts[ai][m] = lg[rl < n_e ? rl : 0]; }
        bf16_t* const sink = wsp<bf16_t>(ws, WS_DUMMY) + col0;
#pragma unroll
        EPI_ROWS(ai, m) { const int rl = rloc0 + ai * 128 + m * 16; const float gt = gts[ai][m]; bf16_t* rp = (rl < n_e) ? O + (size_t)(row0 + ai * 128 + m * 16) * DM + col0 : sink;
#pragma unroll
                EPI_COLS(bj, n) st_bf16x4(rp + bj * 128 + n * 16, (acc[ai][bj][m][n] + bv[bj][n]) * gt); }
    }
};

constexpr int IKBLK = 65;
__device__ __forceinline__ size_t ikf_off(int b, int p, int dim) { return ((((size_t)(b * IKBLK + (p >> 5)) * 4 + (dim >> 4)) * 64 + (((dim >> 3) & 1) * 32 + (p & 31))) * 8 + (dim & 7)); }
template <int NT>
__device__ __forceinline__ void wave_mm16(const bf16_t* __restrict__ A, int lda, const bf16_t* const (&Bt)[NT], int K, int lane, f32x4 (&acc)[NT]) {
    const bf16_t* ap = A + (size_t)(lane & 15) * lda + 8 * (lane >> 4);
    const bf16_t* bp[NT];
#pragma unroll
    for (int t = 0; t < NT; ++t) { bp[t] = Bt[t] + (size_t)(lane & 15) * K + 8 * (lane >> 4); acc[t] = (f32x4){0.f, 0.f, 0.f, 0.f}; }
#pragma unroll (NT == 1 ? 16 : 8)
    for (int k0 = 0; k0 < K; k0 += 32) {
        const bf16x8 a = *(const bf16x8*)(ap + k0);
#pragma unroll
        for (int t = 0; t < NT; ++t) { const bf16x8 b = *(const bf16x8*)(bp[t] + k0); acc[t] = __builtin_amdgcn_mfma_f32_16x16x32_bf16(b, a, acc[t], 0, 0, 0); }
    }
}
__device__ __forceinline__ void p1_thin(Frame& F, int dbgflags) {
    unsigned char* ws = F.ws;
    const bf16_t* WIN = wsp<bf16_t>(ws, WS_WIN); const bf16_t* XN = wsp<bf16_t>(ws, WS_XN); const bf16_t* XNM = wsp<bf16_t>(ws, WS_XNM);
    bf16_t* KB = wsp<bf16_t>(ws, WS_KB); bf16_t* VT = wsp<bf16_t>(ws, WS_VT); bf16_t* IK = wsp<bf16_t>(ws, WS_IK); bf16_t* GLU = wsp<bf16_t>(ws, WS_GLU); float* IW = wsp<float>(ws, WS_IW);
    const int gw = F.bid * NWAVES + F.wave, NGW = F.G * NWAVES, lane = F.lane, tk = lane & 15, nq = lane >> 4;
    {
        constexpr int WBP = 2064;
        LAS unsigned char* lds = F.lds;
        __syncthreads();
        { const unsigned char* src = (const unsigned char*)(WIN + (size_t)WR_IK * DM);
          for (int p = F.tid; p < 72 * 128; p += NTHREADS) { const int row = p >> 7, c16 = p & 127; *(LAS u32x4*)(lds + row * WBP + c16 * 16) = *(const u32x4*)(src + (size_t)row * DM * 2 + c16 * 16); } }
        __syncthreads();
        const int tg = F.wave & 3, hf = F.wave >> 2, kq = nq;
        for (int tb = F.bid; tb < NTOK / 64; tb += F.G) {
            const int m = tb * 64 + 16 * tg + tk, rowk = m + NMETA * ((m >> 11) + 1);
            const bf16_t* xr = XN + (size_t)m * DM + 16 * kq;
            bf16x8 xa[16], xb[16];
#pragma unroll
            for (int sblk = 0; sblk < 16; ++sblk) { xa[sblk] = *(const bf16x8*)(xr + 64 * sblk); xb[sblk] = *(const bf16x8*)(xr + 64 * sblk + 8); }
            const LAS unsigned char* wb = lds + tk * WBP + 32 * kq;
            if (hf == 0) {
                f32x4 acc[3] = {{0.f, 0.f, 0.f, 0.f}, {0.f, 0.f, 0.f, 0.f}, {0.f, 0.f, 0.f, 0.f}};
#pragma unroll
                for (int sblk = 0; sblk < 16; ++sblk)
#pragma unroll
                    for (int t = 0; t < 3; ++t) { const bf16x8 b0 = *(const LAS bf16x8*)(wb + 16 * t * WBP + 128 * sblk), b1 = *(const LAS bf16x8*)(wb + 16 * t * WBP + 128 * sblk + 16);
                        acc[t] = __builtin_amdgcn_mfma_f32_16x16x32_bf16(b0, xa[sblk], acc[t], 0, 0, 0); acc[t] = __builtin_amdgcn_mfma_f32_16x16x32_bf16(b1, xb[sblk], acc[t], 0, 0, 0); }
#pragma unroll
                for (int t = 0; t < 3; ++t) st_bf16x4(IK + ikf_off(m >> 11, NMETA + (m & (SEQ - 1)), 16 * t + 4 * nq), acc[t]);
            } else {
                f32x4 acc[2] = {{0.f, 0.f, 0.f, 0.f}, {0.f, 0.f, 0.f, 0.f}};
#pragma unroll
                for (int sblk = 0; sblk < 16; ++sblk)
#pragma unroll
                    for (int t = 0; t < 2; ++t) { const bf16x8 b0 = *(const LAS bf16x8*)(wb + 16 * (3 + t) * WBP + 128 * sblk), b1 = *(const LAS bf16x8*)(wb + 16 * (3 + t) * WBP + 128 * sblk + 16);
                        acc[t] = __builtin_amdgcn_mfma_f32_16x16x32_bf16(b0, xa[sblk], acc[t], 0, 0, 0); acc[t] = __builtin_amdgcn_mfma_f32_16x16x32_bf16(b1, xb[sblk], acc[t], 0, 0, 0); }
                st_bf16x4(IK + ikf_off(m >> 11, NMETA + (m & (SEQ - 1)), 48 + 4 * nq), acc[0]);
                if (nq < 2) *(f32x4*)(IW + (size_t)m * 8 + 4 * nq) = acc[1];
            }
        }
        __syncthreads();
    }
    if (!(dbgflags & 256)) for (int task = gw; task < 100; task += NGW) {
        if (task < 32) {
            const bf16_t* const Bt[1] = {WIN + (size_t)(SC_K + 16 * task) * DM}; f32x4 acc[1]; wave_mm16<1>(XNM, DM, Bt, DM, lane, acc);
            for (int b = 0; b < NB; ++b) st_bf16x4(KB + (size_t)(b * TT + tk) * AW + 16 * task + 4 * nq, acc[0]);
        } else if (task < 64) {
            const int t = task - 32; const bf16_t* const Bt[1] = {WIN + (size_t)(SC_V + 16 * t) * DM}; f32x4 acc[1]; wave_mm16<1>(XNM, DM, Bt, DM, lane, acc);
            const float p0 = __shfl_xor(acc[0][0], 1), p1 = __shfl_xor(acc[0][1], 1), p2 = __shfl_xor(acc[0][2], 1), p3 = __shfl_xor(acc[0][3], 1);
            const unsigned wa = (tk & 1) ? cvt_pk_bf16(p2, acc[0][2]) : cvt_pk_bf16(acc[0][0], p0), wb = (tk & 1) ? cvt_pk_bf16(p3, acc[0][3]) : cvt_pk_bf16(acc[0][1], p1);
            for (int b = 0; b < NB; ++b) { bf16_t* cp = VT + ((size_t)b * AW + 16 * t + 4 * nq + 2 * (tk & 1)) * TP + VOFF + (tk & ~1);
                *(unsigned*)cp = wa; *(unsigned*)(cp + TP) = wb; }
        } else if (task < 68) {
            const int t = task - 64; const bf16_t* const Bt[1] = {WIN + (size_t)(WR_IK + 16 * t) * DM}; f32x4 acc[1]; wave_mm16<1>(XNM, DM, Bt, DM, lane, acc);
            for (int b = 0; b < NB; ++b) st_bf16x4(IK + ikf_off(b, tk, 16 * t + 4 * nq), acc[0]);
        } else {
            const int c16 = task - 68; const int ar = WR_GLU + 256 * (c16 >> 3) + 16 * (c16 & 7);
            const bf16_t* const Bt[2] = {WIN + (size_t)ar * DM, WIN + (size_t)(ar + 128) * DM}; f32x4 acc[2]; wave_mm16<2>(XNM, DM, Bt, DM, lane, acc);
            f32x4 y;
#pragma unroll
            for (int j = 0; j < 4; ++j) y[j] = acc[0][j] * sigmoidf_(acc[1][j]);
            for (int b = 0; b < NB; ++b) st_bf16x4(GLU + (size_t)(b * TT + tk) * CC + 16 * c16 + 4 * nq, y);
        }
    }
}

__device__ __forceinline__ void p2_conv(Frame& F, const Args& a) {
    unsigned char* ws = F.ws;
    LAS unsigned char* xs = F.lds;
    LAS float* wl = (LAS float*)(F.lds + 63488);
    const bf16_t* GLU = wsp<bf16_t>(ws, WS_GLU); bf16_t* CO = wsp<bf16_t>(ws, WS_CO);
    const float* cw = a.in[I_CONVW];
    for (int idx = F.tid; idx < CW * 128; idx += NTHREADS) { const int tap = idx >> 7, c4 = idx & 127; const f32x4 v = *(const f32x4*)(cw + tap * CC + 4 * c4); *(LAS f32x4*)(wl + tap * 512 + (c4 & 1) * 256 + (c4 >> 1) * 4) = v; }
    const int lane = F.lane, c0 = 8 * lane;
    for (int tile = F.bid; tile < NTOK / 32; tile += F.G) {
        const int b = tile >> 6, s0 = (tile & 63) * 32, p0 = NMETA + s0;
        __syncthreads();
        for (int idx = F.tid; idx < 62 * 64; idx += NTHREADS) { const int r = idx >> 6, ch = idx & 63, p = p0 - 30 + r; u32x4 v = (u32x4){0u, 0u, 0u, 0u};
            if (p >= 0) v = *(const u32x4*)(GLU + (size_t)(b * TT + p) * CC + ch * 8);
            *(LAS u32x4*)(xs + r * 1024 + ch * 16) = v; }
        __syncthreads();
        const int i0 = 4 * F.wave;
        float acc[4][8];
#pragma unroll
        for (int t = 0; t < 4; ++t)
#pragma unroll
            for (int i = 0; i < 8; ++i) acc[t][i] = 0.f;
        const LAS float* wlb = wl + lane * 4; asm volatile("" : "+v"(wlb));
        const LAS unsigned char* xsb = xs + i0 * 1024 + lane * 16; asm volatile("" : "+v"(xsb));
#pragma unroll 1
        for (int tap = 0; tap < CW; ++tap) {
            const f32x4 w0 = *(const LAS f32x4*)(wlb + tap * 512), w1 = *(const LAS f32x4*)(wlb + tap * 512 + 256);
#pragma unroll
            for (int t = 0; t < 4; ++t) {
                const u32x4 xv = *(const LAS u32x4*)(xsb + (tap + t) * 1024);
                acc[t][0] += w0[0] * bflo(xv.x); acc[t][1] += w0[1] * bfhi(xv.x); acc[t][2] += w0[2] * bflo(xv.y); acc[t][3] += w0[3] * bfhi(xv.y);
                acc[t][4] += w1[0] * bflo(xv.z); acc[t][5] += w1[1] * bfhi(xv.z); acc[t][6] += w1[2] * bflo(xv.w); acc[t][7] += w1[3] * bfhi(xv.w);
            }
        }
        float cb[8], lg[8], lb[8];
        { const f32x4* p0 = (const f32x4*)(a.in[I_CONVB] + c0); const f32x4* p1 = (const f32x4*)(a.in[I_LNG] + c0); const f32x4* p2 = (const f32x4*)(a.in[I_LNB] + c0);
#pragma unroll
          for (int hh = 0; hh < 2; ++hh) { const f32x4 u0 = p0[hh], u1 = p1[hh], u2 = p2[hh];
#pragma unroll
              for (int i = 0; i < 4; ++i) { cb[4 * hh + i] = u0[i]; lg[4 * hh + i] = u1[i]; lb[4 * hh + i] = u2[i]; } } }
#pragma unroll
        for (int t = 0; t < 4; ++t) {
            float s = 0.f;
#pragma unroll
            for (int i = 0; i < 8; ++i) { acc[t][i] += cb[i]; s += acc[t][i]; }
            const float mean = wave_sum(s) * (1.f / CC); float q = 0.f;
#pragma unroll
            for (int i = 0; i < 8; ++i) { acc[t][i] -= mean; q += acc[t][i] * acc[t][i]; }
            const float rstd = 1.0f / sqrtf(wave_sum(q) * (1.f / CC) + EPS);
            float y[8];
#pragma unroll
            for (int i = 0; i < 8; ++i) { const float z = acc[t][i] * rstd * lg[i] + lb[i]; y[i] = z * sigmoidf_(z); }
            u32x4 o; o.x = cvt_pk_bf16(y[0], y[1]); o.y = cvt_pk_bf16(y[2], y[3]); o.z = cvt_pk_bf16(y[4], y[5]); o.w = cvt_pk_bf16(y[6], y[7]);
            *(u32x4*)(CO + (size_t)(b * SEQ + s0 + i0 + t) * CC + c0) = o;
        }
    }
    __syncthreads();
}

constexpr int ROWP = 2080, NJ = 33;
__device__ __forceinline__ unsigned f2ord(float f) { const unsigned b = __float_as_uint(f); return b ^ ((b >> 31) ? 0xffffffffu : 0x80000000u); }
__device__ __forceinline__ int wave_isum(int v) {
#pragma unroll
    for (int o = 1; o < 64; o <<= 1) v += __shfl_xor(v, o);
    return v;
}
__device__ __forceinline__ int wave_isum_dpp(int v) {
    v += __builtin_amdgcn_update_dpp(0, v, 0xB1, 0xF, 0xF, false);
    v += __builtin_amdgcn_update_dpp(0, v, 0x4E, 0xF, 0xF, false);
    v += __builtin_amdgcn_update_dpp(0, v, 0x141, 0xF, 0xF, false);
    v += __builtin_amdgcn_update_dpp(0, v, 0x140, 0xF, 0xF, false);
    return __builtin_amdgcn_readlane(v, 0) + __builtin_amdgcn_readlane(v, 16) + __builtin_amdgcn_readlane(v, 32) + __builtin_amdgcn_readlane(v, 48);
}
__device__ __forceinline__ void p2_indexer_unit(Frame& F, int b, int q16, int flags) {
    unsigned char* ws = F.ws;
    const bf16_t* IQ = wsp<bf16_t>(ws, WS_IQ); const bf16_t* IK = wsp<bf16_t>(ws, WS_IK); const float* IW = wsp<float>(ws, WS_IW); unsigned* MASK = wsp<unsigned>(ws, WS_MASK);
    LAS unsigned* SU = (LAS unsigned*)F.lds;
    const int lane = F.lane, c = lane & 31, hi = lane >> 5, w = F.wave;
    const int nwblk = (q16 >> 1) + 2;
    if (!(flags & 4)) {
        const int tok0 = b * SEQ + 16 * q16;
        bf16x8 af[4][4]; f32x4 wq[4][4];
#pragma unroll
        for (int g = 0; g < 4; ++g) {
            const bf16_t* ap = IQ + (size_t)(tok0 + 4 * g + (c >> 3)) * AW + (c & 7) * IDXD + 8 * hi;
#pragma unroll
            for (int ks = 0; ks < 4; ++ks) af[g][ks] = *(const bf16x8*)(ap + 16 * ks);
#pragma unroll
            for (int q = 0; q < 4; ++q) wq[g][q] = *(const f32x4*)(IW + (size_t)(tok0 + 4 * g + q) * 8 + 4 * hi);
        }
        const int rel0 = NMETA + 16 * q16 + 2 * hi - c;
        const bf16_t* kp = IK + (size_t)b * IKBLK * 2048 + lane * 8;
        LAS unsigned* srow = SU + (2 * hi) * ROWP + c;
        bf16x8 bfr[4], bnx[4];
#pragma unroll
        for (int ks = 0; ks < 4; ++ks) { bfr[ks] = *(const bf16x8*)(kp + (size_t)(w < nwblk ? w : 0) * 2048 + 512 * ks); bnx[ks] = bfr[ks]; }
#pragma unroll
        for (int g = 0; g < 4; ++g) asm volatile("" :: "v"(af[g][0]), "v"(af[g][1]), "v"(af[g][2]), "v"(af[g][3]), "v"(wq[g][0]), "v"(wq[g][1]), "v"(wq[g][2]), "v"(wq[g][3]));
        asm volatile("" :: "v"(bfr[0]), "v"(bfr[1]), "v"(bfr[2]), "v"(bfr[3]));
        for (int blk = w; blk < nwblk; blk += 8) {
            {
                const int bn_ = blk + 8 < nwblk ? blk + 8 : blk;
#pragma unroll
                for (int ks = 0; ks < 4; ++ks) bnx[ks] = *(const bf16x8*)(kp + (size_t)bn_ * 2048 + 512 * ks); }
#pragma unroll
            for (int g = 0; g < 4; ++g) {
                f32x16 acc = {};
#pragma unroll
                for (int ks = 0; ks < 4; ++ks) acc = __builtin_amdgcn_mfma_f32_32x32x16_bf16(af[g][ks], bfr[ks], acc, 0, 0, 0);
                float part[4];
#pragma unroll
                for (int q = 0; q < 4; ++q) { float s = wq[g][q][0] * __builtin_amdgcn_fmed3f(acc[4 * q], 0.f, INFINITY);
#pragma unroll
                    for (int i = 1; i < 4; ++i) s = __builtin_fmaf(wq[g][q][i], __builtin_amdgcn_fmed3f(acc[4 * q + i], 0.f, INFINITY), s);
                    part[q] = s; }
#pragma unroll
                for (int p = 0; p < 2; ++p) {
                    const auto rr = __builtin_amdgcn_permlane32_swap(__float_as_uint(part[p]), __float_as_uint(part[p + 2]), false, false);
                    const float sc = __uint_as_float(rr[0]) + __uint_as_float(rr[1]);
                    srow[(4 * g + p) * ROWP + 32 * blk] = (32 * blk <= rel0 + 4 * g + p) ? f2ord(sc) : 0u; }
            }
#pragma unroll
            for (int ks = 0; ks < 4; ++ks) bfr[ks] = bnx[ks];
        }
    }
    __syncthreads();
    if (!(flags & 8)) {
        const int nj = (nwblk + 1) >> 1, klim = 32 * nwblk;
        unsigned U[NJ][2];
#pragma unroll
        for (int j = 0; j < NJ; ++j) {
            if (j < nj) { const int key = 64 * j + lane;
#pragma unroll
                for (int p = 0; p < 2; ++p) U[j][p] = (key < klim) ? SU[(2 * w + p) * ROWP + key] : 0u; }
            else { U[j][0] = 0u; U[j][1] = 0u; }
        }
        const int tokb = b * SEQ + 16 * q16 + 2 * w;
        unsigned lo[2], hb[2], thr[2], veq[2]; int chi[2], need[2]; bool done[2];
#pragma unroll
        for (int p = 0; p < 2; ++p) { lo[p] = 1u; hb[p] = 0xffffffffu; chi[p] = 0; need[p] = 0; veq[p] = 0u; thr[p] = 1u; done[p] = (NMETA + 16 * q16 + 2 * w + p + 1 <= TOPK); }
        for (int it = 0; it < 34; ++it) {
            if (done[0] && done[1]) break;
            unsigned mid[2]; int cl[2];
#pragma unroll
            for (int p = 0; p < 2; ++p) { mid[p] = lo[p] + ((hb[p] - lo[p]) >> 1); cl[p] = 0; }
#pragma unroll
            for (int g = 0; g < 3; ++g) if (11 * g < nj) {
#pragma unroll
                for (int jj = 0; jj < 11; ++jj)
#pragma unroll
                    for (int p = 0; p < 2; ++p) cl[p] += (U[11 * g + jj][p] >= mid[p]) ? 1 : 0; }
            const int tot = wave_isum_dpp(cl[0] | (cl[1] << 16));
            int cnt[2] = {tot & 0xffff, tot >> 16};
#ifdef DBG_CHECK_DPP
            if (wave_isum(cl[0]) != cnt[0] || wave_isum(cl[1]) != cnt[1]) __hip_atomic_store(wsp<unsigned>(ws, WS_CTL) + 3, 1u, RLX_AGENT);
#endif
#pragma unroll
            for (int p = 0; p < 2; ++p) {
                const int ct = cnt[p];
                if (!done[p]) {
                    if (ct == TOPK) { done[p] = true; thr[p] = mid[p]; need[p] = 0; }
                    else if (ct > TOPK) lo[p] = mid[p];
                    else { hb[p] = mid[p]; chi[p] = ct; }
                    if (!done[p] && hb[p] - lo[p] == 1u) { done[p] = true; thr[p] = hb[p]; veq[p] = lo[p]; need[p] = TOPK - chi[p]; }
                }
            }
        }
#pragma unroll
        for (int p = 0; p < 2; ++p) {
            int run = 0;
            unsigned long long* mrow = (unsigned long long*)(MASK + (size_t)(tokb + p) * MSTR);
#pragma unroll
            for (int j = 0; j < NJ; ++j) if (j < nj) {
                const unsigned u = U[j][p];
                const bool eq = (need[p] > 0) && (u == veq[p]);
                const unsigned long long em = __ballot(eq);
                const int rank = run + (int)__builtin_amdgcn_mbcnt_hi((unsigned)(em >> 32), __builtin_amdgcn_mbcnt_lo((unsigned)em, 0u));
                const bool take = (u >= thr[p]) || (eq && rank < need[p]);
                run += __popcll(em);
                const unsigned long long sm = __ballot(take);
                if (lane == 0) mrow[j] = sm;
            }
        }
    }
    __syncthreads();
}
__device__ __forceinline__ void p2_indexer(Frame& F, int flags, int half) {
    for (int i = F.bid; i < 256; i += F.G) { const int b = i >> 5, j = 2 * (i & 31);
        if (half == 0) { p2_indexer_unit(F, b, j, flags); p2_indexer_unit(F, b, 127 - j, flags); }
        else { p2_indexer_unit(F, b, j + 1, flags); p2_indexer_unit(F, b, 126 - j, flags); } }
}

__device__ const unsigned char T5B[128] = {0, 1, 2, 3, 4, 5, 6, 7, 8, 9, 10, 11, 12, 13, 14, 15, 16, 16, 16, 17, 17, 18, 18, 18, 19, 19, 19, 20, 20, 20, 20, 21, 21, 21, 21, 22, 22, 22, 22, 22, 23, 23, 23, 23, 23, 23, 24, 24, 24, 24, 24, 24, 25, 25, 25, 25, 25, 25, 25, 26, 26, 26, 26, 26, 26, 26, 26, 27, 27, 27, 27, 27, 27, 27, 27, 27, 27, 28, 28, 28, 28, 28, 28, 28, 28, 28, 28, 29, 29, 29, 29, 29, 29, 29, 29, 29, 29, 29, 29, 30, 30, 30, 30, 30, 30, 30, 30, 30, 30, 30, 30, 30, 30, 31, 31, 31, 31, 31, 31, 31, 31, 31, 31, 31, 31, 31, 31, 31};
constexpr int TBS = 132;
__device__ __forceinline__ int crow(int r, int hi) { return (r & 3) + 8 * (r >> 2) + 4 * hi; }
constexpr int KPITCH = 144, VPITCH = 136;
constexpr int AT_K = 0, AT_V = AT_K + 2 * 64 * KPITCH, AT_TB = AT_V + 2 * 64 * VPITCH, AT_SC = AT_TB + NH * TBS * 4, AT_END = AT_SC + NWAVES * 128;
static_assert(AT_END <= RING_BYTES, "attention LDS map");
__device__ __forceinline__ void p3_attn_unit(Frame& F, int b, int h, int Q) {
    unsigned char* ws = F.ws;
    const bf16_t* Qm = wsp<bf16_t>(ws, WS_Q); const bf16_t* KB = wsp<bf16_t>(ws, WS_KB); const bf16_t* VT = wsp<bf16_t>(ws, WS_VT); const unsigned* MASK = wsp<unsigned>(ws, WS_MASK); bf16_t* AO = wsp<bf16_t>(ws, WS_AO);
    LAS unsigned char* lds = F.lds;
    const LAS float* tbh = (const LAS float*)(lds + AT_TB) + h * TBS;
    LAS float* sc = (LAS float*)(lds + AT_SC) + F.wave * 32;
    const int tid = F.tid, lane = F.lane, c = lane & 31, hi = lane >> 5, w = F.wave;
    const int qb32 = 8 * Q + w, tokq = b * SEQ + 32 * qb32 + c, posq = NMETA + 32 * qb32 + c;
    const int ktmax = (47 + 32 * qb32) >> 6, NT = 4 * Q + 5;
    bf16x8 qf[4];
#pragma unroll
    for (int ks = 0; ks < 4; ++ks) qf[ks] = *(const bf16x8*)(Qm + (size_t)tokq * AW + h * HD + 16 * ks + 8 * hi);
    const unsigned long long* mrow = (const unsigned long long*)(MASK + (size_t)tokq * MSTR);
    const int srow = tid >> 3, piece = tid & 7;
    const bf16_t* kg = KB + (size_t)(b * TT + srow) * AW + h * HD + piece * 8;
    const bf16_t* vg = VT + ((size_t)b * AW + h * HD + srow) * TP + piece * 8;
    LAS unsigned char* kl = lds + AT_K + srow * KPITCH + piece * 16;
    LAS unsigned char* vl = lds + AT_V + srow * VPITCH + piece * 16;
    const LAS unsigned char* kfb = lds + AT_K + c * KPITCH + 16 * hi;
    const LAS unsigned char* vfb = lds + AT_V + c * VPITCH + 8 * hi;
    const unsigned NEGB = 0xff800000u;
    const float bfar = tbh[128];
    float m_abs = 0.f; bool has = false;
    f32x16 O0 = {}, O1 = {}, LS = {}, CI;
#pragma unroll
    for (int r = 0; r < 16; ++r) CI[r] = bfar;
    const bf16x8 ones = __builtin_bit_cast(bf16x8, ((u32x4){0x3f803f80u, 0x3f803f80u, 0x3f803f80u, 0x3f803f80u}));
    u32x4 kr = *(const u32x4*)kg, vr = *(const u32x4*)vg;
    unsigned long long mwn = mrow[0];
    *(LAS u32x4*)kl = kr; *(LAS u32x2*)vl = (u32x2){vr.x, vr.y}; *(LAS u32x2*)(vl + 8) = (u32x2){vr.z, vr.w};
    __syncthreads();
    for (int kt = 0; kt < NT; ++kt) {
        const int buf = kt & 1;
        const unsigned long long mw = mwn;
        if (kt + 1 < NT) { kr = *(const u32x4*)(kg + (size_t)(kt + 1) * 64 * AW); vr = *(const u32x4*)(vg + (kt + 1) * 64); if (kt + 1 <= ktmax) mwn = mrow[kt + 1]; }
        if (kt <= ktmax) {
            const LAS unsigned char* kp = kfb + buf * 64 * KPITCH;
            f32x16 S0 = CI, S1 = CI;
#pragma unroll
            for (int ks = 0; ks < 4; ++ks) {
                const bf16x8 k0 = *(const LAS bf16x8*)(kp + ks * 32), k1 = *(const LAS bf16x8*)(kp + 32 * KPITCH + ks * 32);
                S0 = __builtin_amdgcn_mfma_f32_32x32x16_bf16(k0, qf[ks], S0, 0, 0, 0);
                S1 = __builtin_amdgcn_mfma_f32_32x32x16_bf16(k1, qf[ks], S1, 0, 0, 0);
            }
            const int mw0 = (int)((unsigned)mw >> (4 * hi)), mw1 = (int)((unsigned)(mw >> 32) >> (4 * hi));
            const bool far = (256 * Q + 32 * w - 64 * kt) >= 175;
            if (!far) {
                const int d0 = posq - 64 * kt - 4 * hi;
#pragma unroll
                for (int r = 0; r < 16; ++r) { const int ko = (r & 3) + 8 * (r >> 2);
                    int da = d0 - ko, db = d0 - 32 - ko; da = da < 0 ? 0 : (da > 128 ? 128 : da); db = db < 0 ? 0 : (db > 128 ? 128 : db);
                    S0[r] += tbh[da] - bfar; S1[r] += tbh[db] - bfar; }
            }
            float tmax = -INFINITY;
#pragma unroll
            for (int r = 0; r < 16; ++r) { const int ko = (r & 3) + 8 * (r >> 2);
                const unsigned t0 = (unsigned)__builtin_amdgcn_sbfe(mw0, ko, 1), t1 = (unsigned)__builtin_amdgcn_sbfe(mw1, ko, 1);
                S0[r] = __uint_as_float((__float_as_uint(S0[r]) & t0) | (NEGB & ~t0)); S1[r] = __uint_as_float((__float_as_uint(S1[r]) & t1) | (NEGB & ~t1));
                tmax = fmaxf(tmax, fmaxf(S0[r], S1[r])); }
            tmax = fmaxf(tmax, __shfl_xor(tmax, 32));
            if (__any(tmax > 8.0f || (!has && tmax > -INFINITY))) {
                const bool upd = tmax > -INFINITY && (!has || tmax > 0.f);
                const float dl = upd ? tmax : 0.f;
                const float alpha = has ? __builtin_amdgcn_exp2f(-dl) : 1.0f;
                m_abs += dl; has = has || upd;
#pragma unroll
                for (int r = 0; r < 16; ++r) { S0[r] -= dl; S1[r] -= dl; CI[r] = bfar - m_abs; }
                if (hi == 0) sc[c] = alpha;
                LDS_WAIT(); asm volatile("" ::: "memory");
#pragma unroll
                for (int r = 0; r < 16; ++r) { const float f = sc[crow(r, hi)]; O0[r] *= f; O1[r] *= f; LS[r] *= f; }
                LDS_WAIT(); asm volatile("" ::: "memory");
            }
#pragma unroll
            for (int r = 0; r < 16; ++r) { S0[r] = __builtin_amdgcn_exp2f(S0[r]); S1[r] = __builtin_amdgcn_exp2f(S1[r]); }
            const LAS unsigned char* vp = vfb + buf * 64 * VPITCH;
#pragma unroll
            for (int s2 = 0; s2 < 4; ++s2) {
                u32x4 pw;
                if (s2 < 2) { const int o = 8 * (s2 & 1); pw.x = cvt_pk_bf16(S0[o + 0], S0[o + 1]); pw.y = cvt_pk_bf16(S0[o + 2], S0[o + 3]); pw.z = cvt_pk_bf16(S0[o + 4], S0[o + 5]); pw.w = cvt_pk_bf16(S0[o + 6], S0[o + 7]); }
                else { const int o = 8 * (s2 & 1); pw.x = cvt_pk_bf16(S1[o + 0], S1[o + 1]); pw.y = cvt_pk_bf16(S1[o + 2], S1[o + 3]); pw.z = cvt_pk_bf16(S1[o + 4], S1[o + 5]); pw.w = cvt_pk_bf16(S1[o + 6], S1[o + 7]); }
                const bf16x8 pf = __builtin_bit_cast(bf16x8, pw);
                const u32x2 a0 = *(const LAS u32x2*)(vp + s2 * 32), a1 = *(const LAS u32x2*)(vp + s2 * 32 + 16);
                const u32x2 b0 = *(const LAS u32x2*)(vp + 32 * VPITCH + s2 * 32), b1 = *(const LAS u32x2*)(vp + 32 * VPITCH + s2 * 32 + 16);
                const bf16x8 v0 = __builtin_bit_cast(bf16x8, ((u32x4){a0.x, a0.y, a1.x, a1.y})), v1 = __builtin_bit_cast(bf16x8, ((u32x4){b0.x, b0.y, b1.x, b1.y}));
                O0 = __builtin_amdgcn_mfma_f32_32x32x16_bf16(pf, v0, O0, 0, 0, 0);
                O1 = __builtin_amdgcn_mfma_f32_32x32x16_bf16(pf, v1, O1, 0, 0, 0);
                LS = __builtin_amdgcn_mfma_f32_32x32x16_bf16(pf, ones, LS, 0, 0, 0);
            }
        }
        if (kt + 1 < NT) { LAS unsigned char* k2 = kl + (buf ^ 1) * 64 * KPITCH; LAS unsigned char* v2 = vl + (buf ^ 1) * 64 * VPITCH;
            *(LAS u32x4*)k2 = kr; *(LAS u32x2*)v2 = (u32x2){vr.x, vr.y}; *(LAS u32x2*)(v2 + 8) = (u32x2){vr.z, vr.w}; }
        __syncthreads();
    }
    bf16_t* ob = AO + (size_t)(b * SEQ + 32 * qb32) * AW + h * HD + c;
#pragma unroll
    for (int r = 0; r < 16; ++r) { const int qr = crow(r, hi); const float f = __builtin_amdgcn_rcpf(LS[r]);
        const float a0 = O0[r] * f, a1 = O1[r] * f, b0 = __shfl_xor(a0, 1), b1 = __shfl_xor(a1, 1);
        if ((c & 1) == 0) { *(unsigned*)(ob + (size_t)qr * AW) = cvt_pk_bf16(a0, b0); *(unsigned*)(ob + (size_t)qr * AW + 32) = cvt_pk_bf16(a1, b1); } }
}
__device__ __forceinline__ void p3_attn(Frame& F, const Args& a) {
    LAS float* tb = (LAS float*)(F.lds + AT_TB);
    __syncthreads();
    for (int idx = F.tid; idx < NH * 129; idx += NTHREADS) { const int h = idx / 129, d = idx % 129; const int bk = d < 128 ? (int)T5B[d] : 31; tb[h * TBS + d] = a.in[I_RELB][bk * NH + h] * LOG2E; }
    __syncthreads();
    for (int i = F.bid; i < 256; i += F.G) { const int bh = i >> 2, j = i & 3; p3_attn_unit(F, bh >> 3, bh & 7, j); p3_attn_unit(F, bh >> 3, bh & 7, 7 - j); }
    __syncthreads();
}

constexpr int WLP = 2064;
constexpr int P6_WHI = 0, P6_WLO = NE * WLP, P6_PART = 2 * NE * WLP, P6_SSP = P6_PART + 2 * 64 * 33 * 4, P6_CNT = P6_SSP + 2 * 64 * 4, P6_END = P6_CNT + 256;
static_assert(P6_END <= LDSX_OFF, "router LDS map");
__device__ __forceinline__ void p6_router(Frame& F, const Args& a) {
    unsigned char* ws = F.ws;
    const float* H1 = wsp<float>(ws, WS_H1); bf16_t* HN = wsp<bf16_t>(ws, WS_XN);
    const float* gf = a.in[I_NFFN]; const float* brt = a.in[I_BR];
    int* TE = wsp<int>(ws, WS_TE); int* TPs = wsp<int>(ws, WS_TP); int* LIST = wsp<int>(ws, WS_LIST); float* LG = wsp<float>(ws, WS_LG); float* RG = wsp<float>(ws, WS_RG);
    unsigned* ecnt = wsp<unsigned>(ws, WS_CTL) + CW_ECNT;
    LAS unsigned char* lds = F.lds;
    LAS float* part = (LAS float*)(lds + P6_PART);
    LAS float* ssp = (LAS float*)(lds + P6_SSP);
    LAS int* lcnt = (LAS int*)(lds + P6_CNT);
    LAS int* lbase = lcnt + 32;
    const int lane = F.lane, w = F.wave, tk = lane & 15, kq = lane >> 4;
    __syncthreads();
    { const unsigned char* src = ws + WS_WRT;
      for (int p = F.tid; p < 2 * NE * 128; p += NTHREADS) { const int arr = p >> 12, row = (p >> 7) & 31, c16 = p & 127;
          *(LAS u32x4*)(lds + arr * (NE * WLP) + row * WLP + c16 * 16) = *(const u32x4*)(src + (size_t)arr * NE * DM * 2 + (size_t)row * DM * 2 + c16 * 16); } }
    for (int tb = F.bid; tb < NTOK / 64; tb += F.G) {
        const int t0 = tb * 64;
        __syncthreads();
        if (F.tid < 32) lcnt[F.tid] = 0;
        {
            const int tg = w & 3, kh = w >> 2, tok = t0 + 16 * tg + tk;
            const float* xr = H1 + (size_t)tok * DM + 512 * kh + 8 * kq; const float* gr = gf + 512 * kh + 8 * kq;
            bf16_t* hr = HN + (size_t)tok * DM + 512 * kh + 8 * kq;
            const LAS unsigned char* wl = lds + tk * WLP + (512 * kh + 8 * kq) * 2;
            f32x4 xa[16], xb[16];
#pragma unroll
            for (int ks = 0; ks < 16; ++ks) { xa[ks] = *(const f32x4*)(xr + 32 * ks); xb[ks] = *(const f32x4*)(xr + 32 * ks + 4); }
            f32x4 acc0 = {0.f, 0.f, 0.f, 0.f}, acc1 = acc0; float ss = 0.f;
#pragma unroll
            for (int ks = 0; ks < 16; ++ks) {
                const f32x4 g0 = *(const f32x4*)(gr + 32 * ks), g1 = *(const f32x4*)(gr + 32 * ks + 4);
                const f32x4 x0 = xa[ks], x1 = xb[ks];
                u32x4 hn; hn.x = cvt_pk_bf16(x0[0] * g0[0], x0[1] * g0[1]); hn.y = cvt_pk_bf16(x0[2] * g0[2], x0[3] * g0[3]); hn.z = cvt_pk_bf16(x1[0] * g1[0], x1[1] * g1[1]); hn.w = cvt_pk_bf16(x1[2] * g1[2], x1[3] * g1[3]);
                *(u32x4*)(hr + 32 * ks) = hn;
                ss += (x0[0] * x0[0] + x0[1] * x0[1]) + (x0[2] * x0[2] + x0[3] * x0[3]) + (x1[0] * x1[0] + x1[1] * x1[1]) + (x1[2] * x1[2] + x1[3] * x1[3]);
                u32x4 xh; xh.x = cvt_pk_bf16(x0[0], x0[1]); xh.y = cvt_pk_bf16(x0[2], x0[3]); xh.z = cvt_pk_bf16(x1[0], x1[1]); xh.w = cvt_pk_bf16(x1[2], x1[3]);
                u32x4 xl; xl.x = cvt_pk_bf16(x0[0] - bflo(xh.x), x0[1] - bfhi(xh.x)); xl.y = cvt_pk_bf16(x0[2] - bflo(xh.y), x0[3] - bfhi(xh.y));
                          xl.z = cvt_pk_bf16(x1[0] - bflo(xh.z), x1[1] - bfhi(xh.z)); xl.w = cvt_pk_bf16(x1[2] - bflo(xh.w), x1[3] - bfhi(xh.w));
                const bf16x8 fxh = __builtin_bit_cast(bf16x8, xh), fxl = __builtin_bit_cast(bf16x8, xl);
                const bf16x8 wh0 = *(const LAS bf16x8*)(wl + P6_WHI + ks * 64), wh1 = *(const LAS bf16x8*)(wl + P6_WHI + 16 * WLP + ks * 64);
                const bf16x8 wl0 = *(const LAS bf16x8*)(wl + P6_WLO + ks * 64), wl1 = *(const LAS bf16x8*)(wl + P6_WLO + 16 * WLP + ks * 64);
                acc0 = __builtin_amdgcn_mfma_f32_16x16x32_bf16(wh0, fxh, acc0, 0, 0, 0); acc1 = __builtin_amdgcn_mfma_f32_16x16x32_bf16(wh1, fxh, acc1, 0, 0, 0);
                acc0 = __builtin_amdgcn_mfma_f32_16x16x32_bf16(wl0, fxh, acc0, 0, 0, 0); acc1 = __builtin_amdgcn_mfma_f32_16x16x32_bf16(wl1, fxh, acc1, 0, 0, 0);
                acc0 = __builtin_amdgcn_mfma_f32_16x16x32_bf16(wh0, fxl, acc0, 0, 0, 0); acc1 = __builtin_amdgcn_mfma_f32_16x16x32_bf16(wh1, fxl, acc1, 0, 0, 0);
            }
            ss += __shfl_xor(ss, 16); ss += __shfl_xor(ss, 32);
            LAS float* pp = part + ((kh * 64) + 16 * tg + tk) * 33 + 4 * kq;
#pragma unroll
            for (int r = 0; r < 4; ++r) { pp[r] = acc0[r]; pp[16 + r] = acc1[r]; }
            if (kq == 0) ssp[kh * 64 + 16 * tg + tk] = ss;
        }
        __syncthreads();
        if (w == 0) {
            const float rinv = 1.0f / sqrtf((ssp[lane] + ssp[64 + lane]) * (1.f / DM) + EPS);
            float lg[NE];
#pragma unroll
            for (int e = 0; e < NE; ++e) lg[e] = (part[lane * 33 + e] + part[(64 + lane) * 33 + e]) * rinv + brt[e];
            int sel[4]; float val[4];
#pragma unroll
            for (int j = 0; j < 4; ++j) { float best = -INFINITY; int bi = 0;
#pragma unroll
                for (int e = 0; e < NE; ++e) { const bool tk_ = lg[e] > best; best = tk_ ? lg[e] : best; bi = tk_ ? e : bi; }
                sel[j] = bi; val[j] = best;
#pragma unroll
                for (int e = 0; e < NE; ++e) lg[e] = (e == bi) ? -INFINITY : lg[e]; }
            float den = 0.f, ex[4];
#pragma unroll
            for (int j = 0; j < 4; ++j) { ex[j] = __expf(val[j] - val[0]); den += ex[j]; }
            int slot[4];
#pragma unroll
            for (int j = 0; j < 4; ++j) slot[j] = __hip_atomic_fetch_add(&lcnt[sel[j]], 1, __ATOMIC_RELAXED, __HIP_MEMORY_SCOPE_WORKGROUP);
            LDS_WAIT();
            if (lane < 32) { const int n = lcnt[lane]; lbase[lane] = n ? (int)__hip_atomic_fetch_add(ecnt + 64 * lane, (unsigned)n, RLX_AGENT) : 0; }
            LDS_WAIT(); asm volatile("" ::: "memory");
            const int t = t0 + lane;
#pragma unroll
            for (int j = 0; j < 4; ++j) { const int e = sel[j], pos = lbase[e] + slot[j]; const float g = ex[j] / den;
                TE[t * 4 + j] = e; TPs[t * 4 + j] = pos; LIST[(size_t)e * NTOK + pos] = t; LG[(size_t)e * NTOK + pos] = g; RG[(size_t)e * NTOK + pos] = rinv; }
        }
    }
    __syncthreads();
}
__device__ __forceinline__ void moe_tables(Frame& F, LAS int* cnt, LAS int* tbase) {
    const unsigned* ecnt = wsp<unsigned>(F.ws, WS_CTL) + CW_ECNT;
    __syncthreads();
    if (F.tid < NE) cnt[F.tid] = (int)__hip_atomic_load(ecnt + 64 * F.tid, RLX_AGENT);
    __syncthreads();
    if (F.tid == 0) { int s = 0; for (int e = 0; e < NE; ++e) { tbase[e] = s; s += (cnt[e] + 255) >> 8; } tbase[NE] = s; }
    __syncthreads();
}

__device__ __forceinline__ void p9_final(Frame& F, const Args& a, const LAS int* tbase) {
    unsigned char* ws = F.ws;
    const float* H1 = wsp<float>(ws, WS_H1); float* OUT = a.out; const bf16_t* YP = wsp<bf16_t>(ws, WS_YP); const int* TE = wsp<int>(ws, WS_TE); const int* TPs = wsp<int>(ws, WS_TP); const float* gf = a.in[I_NFIN];
    const int gw = F.bid * NWAVES + F.wave, NGW = F.G * NWAVES, lane = F.lane;
    const f32x4* gr = (const f32x4*)gf + lane;
    f32x4 gg[4];
#pragma unroll
    for (int j = 0; j < 4; ++j) gg[j] = gr[64 * j];
#ifdef DBG_CHECK_DPP
    if (__hip_atomic_load(wsp<unsigned>(ws, WS_CTL) + 3, RLX_AGENT) != 0u) { const float qn = __builtin_nanf("");
#pragma unroll
        for (int j = 0; j < 4; ++j) gg[j] = (f32x4){qn, qn, qn, qn}; }
#endif
    for (int base = 0; base < NTOK; base += 8 * NGW) {
        int myrow = 0;
        { const int i = lane >> 2, j = lane & 3, t = base + gw + NGW * i; if (lane < 32 && t < NTOK) { const int e = TE[t * 4 + j], pos = TPs[t * 4 + j]; myrow = tbase[e] * 256 + pos; } }
        f32x4 va[4], vb[4]; u32x2 ya[4][4], yb[4][4];
#define P9_LOAD(i, V, Y) do { const int t_ = base + gw + NGW * (i); if (t_ < NTOK) { const f32x4* xr_ = (const f32x4*)(H1 + (size_t)t_ * DM) + lane; \
            _Pragma("unroll") for (int j_ = 0; j_ < 4; ++j_) V[j_] = xr_[64 * j_]; \
            _Pragma("unroll") for (int q_ = 0; q_ < 4; ++q_) { const int row_ = __builtin_amdgcn_readlane(myrow, 4 * (i) + q_); const u32x2* yr_ = (const u32x2*)(YP + (size_t)row_ * DM) + lane; \
                _Pragma("unroll") for (int j_ = 0; j_ < 4; ++j_) Y[q_][j_] = yr_[64 * j_]; } } } while (0)
#define P9_PROC(i, V, Y) do { const int t_ = base + gw + NGW * (i); if (t_ < NTOK) { \
            _Pragma("unroll") for (int q_ = 0; q_ < 4; ++q_) _Pragma("unroll") for (int j_ = 0; j_ < 4; ++j_) { const u32x2 y_ = Y[q_][j_]; V[j_].x += bflo(y_.x); V[j_].y += bfhi(y_.x); V[j_].z += bflo(y_.y); V[j_].w += bfhi(y_.y); } \
            float s_ = 0.f; _Pragma("unroll") for (int j_ = 0; j_ < 4; ++j_) s_ += (V[j_].x * V[j_].x + V[j_].y * V[j_].y) + (V[j_].z * V[j_].z + V[j_].w * V[j_].w); \
            const float r_ = 1.0f / sqrtf(wave_sum(s_) * (1.f / DM) + EPS); f32x4* xo_ = (f32x4*)(OUT + (size_t)t_ * DM) + lane; \
            _Pragma("unroll") for (int j_ = 0; j_ < 4; ++j_) xo_[64 * j_] = (f32x4){V[j_].x * r_ * gg[j_].x, V[j_].y * r_ * gg[j_].y, V[j_].z * r_ * gg[j_].z, V[j_].w * r_ * gg[j_].w}; } } while (0)
        P9_LOAD(0, va, ya);
#pragma unroll
        for (int i = 0; i < 8; i += 2) {
            P9_LOAD(i + 1, vb, yb);
            P9_PROC(i, va, ya);
            if (i + 2 < 8) P9_LOAD(i + 2, va, ya);
            P9_PROC(i + 1, vb, yb);
        }
#undef P9_LOAD
#undef P9_PROC
    }
}

constexpr int N_PHASES = 10;
__global__ void __launch_bounds__(NTHREADS, 2) fwd_kernel(Args args) {
    extern __shared__ __attribute__((aligned(16))) unsigned char lds_raw[];
    Frame F;
    F.lds = (LAS unsigned char*)lds_raw; F.ws = args.ws;
    F.tid = threadIdx.x; F.lane = F.tid & 63; F.wave = __builtin_amdgcn_readfirstlane(F.tid >> 6);
    F.G = gridDim.x; F.bid = blockIdx.x;
    volatile LAS unsigned* MISC = (volatile LAS unsigned*)(F.lds + MISC_OFF);
    if (F.tid < 32) MISC[F.tid] = 0u;
    __syncthreads();
    unsigned* ctl = wsp<unsigned>(args.ws, WS_CTL);
    const int lo = args.ph_lo, hi = args.ph_hi;
    const bool multi = (hi - lo) > 1;
    XcdBarrier bar; bar.bar = ctl + CW_BAR; bar.x = 0; bar.st = nullptr;
    if (multi) bar = xcd_barrier_post(ctl + CW_BAR, MISC + 8);
#ifndef PHASE_MASK
#define PHASE_MASK 0x3ff
#endif
#define IN(k) (((PHASE_MASK >> (k)) & 1) && lo <= (k) && (k) < hi)
#define SEAM(k) do { if (IN(k) && IN((k) + 1)) xcd_barrier(bar); } while (0)
    LAS int* l_cnt = (LAS int*)(F.lds + LDSX_OFF); LAS int* l_tbase = l_cnt + 64;
    const MoeTables MT{l_cnt, l_tbase};

    if (IN(0)) { p0_prologue(F, args, 0); } SEAM(0);
    if (IN(1)) {
        PlainSched S; S.init(args.ws, WS_XN, WS_WIN, NTOK, 5120, DM, F.G, F.bid);
        EpiInProj E{args.ws, args.in[I_BGATE]};
        if (!(args.flags & 64)) pg8::gemm_phase<EpiInProj, PlainSched>(F.lds, DM, S, E);
        if (!(args.flags & 128)) p1_thin(F, args.flags);
    } SEAM(1);
    if (IN(2)) {
        const int cvt_slot = (F.bid >> 3) % 3;
        if (cvt_slot == 0 && !(args.flags & 1024)) { p0_prologue(F, args, 1); __syncthreads(); }
        if (!(args.flags & 1)) p2_conv(F, args);
        if (!(args.flags & 2)) p2_indexer(F, args.flags, 0);
        if (cvt_slot == 1 && !(args.flags & 1024)) { __syncthreads(); p0_prologue(F, args, 1); __syncthreads(); }
        if (!(args.flags & 2)) p2_indexer(F, args.flags, 1);
        if (cvt_slot == 2 && !(args.flags & 1024)) { __syncthreads(); p0_prologue(F, args, 1); }
    } SEAM(2);
    if (IN(3)) { p3_attn(F, args); } SEAM(3);
    if (IN(4)) {
        MergeSched S{(const char*)args.ws, F.G, F.bid}; EpiMerge E{args.ws};
        pg8::gemm_phase<EpiMerge, MergeSched>(F.lds, 512, S, E);
    } SEAM(4);
    if (IN(5)) {
        PlainSched S; S.init(args.ws, WS_MG, WS_WOUT, NTOK, DM, DM, F.G, F.bid);
        EpiResid E{args.in[I_X], wsp<float>(args.ws, WS_H1)};
        pg8::gemm_phase<EpiResid, PlainSched>(F.lds, DM, S, E);
    } SEAM(5);
    if (IN(6)) { p6_router(F, args); } SEAM(6);
    if (IN(7)) {
        moe_tables(F, l_cnt, l_tbase);
        MoeSched<8, true> S{(const char*)args.ws, MT, F.G, F.bid, l_tbase[NE] * 8};
        EpiSwiglu E{args.ws, args.in[I_BUG], MT};
        pg8::gemm_phase<EpiSwiglu, MoeSched<8, true>>(F.lds, DM, S, E);
    } SEAM(7);
    if (IN(8)) {
        moe_tables(F, l_cnt, l_tbase);
        MoeSched<4, false> S{(const char*)args.ws, MT, F.G, F.bid, l_tbase[NE] * 4};
        EpiDown E{args.ws, args.in[I_BD], MT};
        pg8::gemm_phase<EpiDown, MoeSched<4, false>>(F.lds, DFF, S, E);
    } SEAM(8);
    if (IN(9)) { moe_tables(F, l_cnt, l_tbase); p9_final(F, args, l_tbase); }
#undef IN
#undef SEAM
}

#ifdef DBG_HASH_OFF
__global__ void dbg_hash(const unsigned* __restrict__ buf, size_t nwords, unsigned* acc) {
    unsigned h = 0u;
    for (size_t i = (size_t)blockIdx.x * blockDim.x + threadIdx.x; i < nwords; i += (size_t)gridDim.x * blockDim.x) h += (buf[i] ^ (unsigned)(i * 2654435761u)) * 2246822519u + (unsigned)i;
#pragma unroll
    for (int o = 1; o < 64; o <<= 1) h += __shfl_xor(h, o);
    if ((threadIdx.x & 63) == 0) atomicAdd(acc, h);
}
__global__ void dbg_fill(float* out, size_t n, const unsigned* acc) {
    const unsigned h = *acc; const float v = (float)((h >> 7) & 0xffffu) * (1.0f / 4096.0f) + 1.0f;
    for (size_t i = (size_t)blockIdx.x * blockDim.x + threadIdx.x; i < n; i += (size_t)gridDim.x * blockDim.x) out[i] = v;
}
#endif

extern "C" void kernel_launch(void* const* d_in, const int* in_sizes, int n_in, void* d_out, int out_size, void* d_ws, size_t ws_size, hipStream_t stream) {
    static int grid = 0;
    if (grid == 0) {
        if (n_in != 21 || out_size != NTOK * DM || ws_size < WS_END) { fprintf(stderr, "kernel_launch: unexpected shapes (n_in %d, out %d, ws %zu < %zu)\n", n_in, out_size, ws_size, (size_t)WS_END); grid = -1; return; }
        int dev = 0, cus = 0, per_cu = 0;
        if (hipGetDevice(&dev) != hipSuccess || hipDeviceGetAttribute(&cus, hipDeviceAttributeMultiprocessorCount, dev) != hipSuccess) { grid = -1; return; }
        if (hipFuncSetAttribute((const void*)fwd_kernel, hipFuncAttributeMaxDynamicSharedMemorySize, LDS_BYTES) != hipSuccess) { fprintf(stderr, "kernel_launch: hipFuncSetAttribute failed\n"); grid = -1; return; }
        if (hipOccupancyMaxActiveBlocksPerMultiprocessor(&per_cu, (const void*)fwd_kernel, NTHREADS, LDS_BYTES) != hipSuccess || per_cu < 1) { fprintf(stderr, "kernel_launch: occupancy query says %d\n", per_cu); }
        (void)hipGetLastError();
        grid = cus;
    }
    if (grid < 0) return;
    (void)hipMemsetAsync((char*)d_ws + WS_CTL, 0, CTL_ZERO_BYTES, stream);
    Args a{};
    for (int i = 0; i < 21; ++i) a.in[i] = (const float*)d_in[i];
    a.out = (float*)d_out; a.ws = (unsigned char*)d_ws;
#if MK_N_LAUNCHES == 1
    a.ph_lo = 0; a.ph_hi = N_PHASES;
    hipLaunchKernelGGL(fwd_kernel, dim3(grid), dim3(NTHREADS), LDS_BYTES, stream, a);
#else
#ifndef DBG_LAST_PHASE
#define DBG_LAST_PHASE (N_PHASES - 1)
#endif
#ifndef DBG_DUP_MASK
#define DBG_DUP_MASK 0
#endif
#ifndef DBG_DUP_FLAGS
#define DBG_DUP_FLAGS 0
#endif
    for (int p = 0; p <= DBG_LAST_PHASE; ++p) { a.ph_lo = p; a.ph_hi = p + 1;
        const int nrep = ((DBG_DUP_MASK >> p) & 1) ? 2 : 1;
        for (int rep = 0; rep < nrep; ++rep) { a.flags = (nrep == 2 && rep == 0) ? DBG_DUP_FLAGS : 0; if (rep == 1 && p == 6) (void)hipMemsetAsync((char*)d_ws + WS_CTL, 0, CTL_ZERO_BYTES, stream);
            hipLaunchKernelGGL(fwd_kernel, dim3(grid), dim3(NTHREADS), LDS_BYTES, stream, a); } }
#ifdef DBG_HASH_OFF
    { const unsigned* hb = DBG_HASH_OFF == 0 ? (const unsigned*)d_out : (const unsigned*)((char*)d_ws + DBG_HASH_OFF);
      hipLaunchKernelGGL(dbg_hash, dim3(1024), dim3(256), 0, stream, hb, (size_t)(DBG_HASH_BYTES) / 4, (unsigned*)d_ws + 2);
      hipLaunchKernelGGL(dbg_fill, dim3(1024), dim3(256), 0, stream, (float*)d_out, (size_t)NTOK * DM, (const unsigned*)d_ws + 2); }
#endif
#endif
}
```

```cpp
#include <hip/hip_runtime.h>
#include <cstdio>
#include <cstdint>

#ifndef MK_N_LAUNCHES
#define MK_N_LAUNCHES 1
#endif

constexpr int NB = 8, SEQ = 2048, NMETA = 16, TT = SEQ + NMETA  , DM = 1024, NTOK = NB * SEQ  , NALL = NB * TT  ;
constexpr int AW = 512, NH = 8, HD = 64, IDXD = 64, CC = 512, CW = 31, NE = 32, DFF = 1024, TOPK = 256;
constexpr int INCOLS = 5192, TP = 2176  , VOFF = 0  , MSTR = 68  ;
constexpr float EPS = 1e-6f, LOG2E = 1.4426950408889634f;
constexpr float QSCALE = 0.125f * LOG2E;
constexpr int MAXTILES = 296;
constexpr int SC_Q = 0, SC_K = 512, SC_V = 1024, SC_IQ = 1536, SC_IK = 2048, SC_IW = 2112, SC_GLU = 2120, SC_GATE = 3144;
constexpr int WR_GLU = 2048, WR_GATE = 3072, WR_IK = 5120, WR_IW = 5184, WIN_ROWS = 5376;

constexpr size_t MiB = 1u << 20;
constexpr size_t al4k(size_t x) { return (x + 4095) & ~(size_t)4095; }
constexpr size_t WS_CTL = 0, CTL_ZERO_BYTES = 1 * MiB;
constexpr size_t WS_WIN = 1 * MiB;
constexpr size_t WS_WAO = WS_WIN + al4k((size_t)WIN_ROWS * DM * 2);
constexpr size_t WS_WCO = WS_WAO + al4k((size_t)DM * AW * 2);
constexpr size_t WS_WOUT = WS_WCO + al4k((size_t)DM * CC * 2);
constexpr size_t WS_WUG = WS_WOUT + al4k((size_t)DM * DM * 2);
constexpr size_t WS_WD = WS_WUG + al4k((size_t)NE * 2 * DFF * DM * 2);
constexpr size_t WS_XN = WS_WD + al4k((size_t)NE * DM * DFF * 2);
constexpr size_t WS_XNM = WS_XN + al4k((size_t)NTOK * DM * 2);
constexpr size_t WS_Q = WS_XNM + al4k((size_t)NMETA * DM * 2);
constexpr size_t WS_IQ = WS_Q + al4k((size_t)NTOK * AW * 2);
constexpr size_t WS_KB = WS_IQ + al4k((size_t)NTOK * AW * 2);
constexpr size_t WS_VT = WS_KB + al4k((size_t)(NALL + 64) * AW * 2);
constexpr size_t WS_IK = WS_VT + al4k((size_t)NB * AW * TP * 2);
constexpr size_t WS_IW = WS_IK + al4k((size_t)NB * 65 * 2048 * 2);
constexpr size_t WS_GLU = WS_IW + al4k((size_t)NTOK * 8 * 4);
constexpr size_t WS_GA = WS_GLU + al4k((size_t)NALL * CC * 2);
constexpr size_t WS_GB = WS_GA + al4k((size_t)NTOK * DM * 2);
constexpr size_t WS_MASK = WS_GB + al4k((size_t)NTOK * DM * 2);
constexpr size_t WS_AO = WS_MASK + al4k((size_t)NTOK * MSTR * 4);
constexpr size_t WS_CO = WS_AO + al4k((size_t)NTOK * AW * 2);
constexpr size_t WS_MG = WS_CO + al4k((size_t)NTOK * CC * 2);
constexpr size_t WS_TE = WS_MG + al4k((size_t)NTOK * DM * 2);
constexpr size_t WS_TP = WS_TE + al4k((size_t)NTOK * 4 * 4);
constexpr size_t WS_LIST = WS_TP + al4k((size_t)NTOK * 4 * 4);
constexpr size_t WS_LG = WS_LIST + al4k((size_t)NE * NTOK * 4);
constexpr size_t WS_ACT = WS_LG + al4k((size_t)NE * NTOK * 4);
constexpr size_t WS_YP = WS_ACT + al4k((size_t)MAXTILES * 256 * DFF * 2);
constexpr size_t WS_H1 = WS_YP + al4k((size_t)MAXTILES * 256 * DM * 2);
constexpr size_t WS_WRT = WS_H1 + al4k((size_t)NTOK * DM * 4);
constexpr size_t WS_RG = WS_WRT + al4k((size_t)2 * NE * DM * 2);
constexpr size_t WS_DUMMY = WS_RG + al4k((size_t)NE * NTOK * 4);
constexpr size_t WS_END = WS_DUMMY + 4096;
static_assert(WS_END < ((size_t)1 << 32), "32-bit byte offsets into d_ws");
constexpr int CW_TMO = 0, CW_CODE = 1, CW_BAR = 4096, CW_ECNT = 16384;

constexpr int RING_BYTES = 131072;
constexpr int LDSX_OFF = 153600;
constexpr int MISC_OFF = 161792;
constexpr int LDS_BYTES = 163840;
constexpr int NWAVES = 8, NTHREADS = 512;

#define GAS __attribute__((address_space(1)))
#define LAS __attribute__((address_space(3)))
typedef unsigned short bf16_t;
typedef short bf16x8 __attribute__((ext_vector_type(8)));
typedef short s16x4 __attribute__((ext_vector_type(4)));
typedef float f32x4 __attribute__((ext_vector_type(4)));
typedef float f32x16 __attribute__((ext_vector_type(16)));
typedef unsigned u32x4 __attribute__((ext_vector_type(4)));
typedef unsigned u32x2 __attribute__((ext_vector_type(2)));
typedef GAS unsigned gu32;
#define RLX_AGENT __ATOMIC_RELAXED, __HIP_MEMORY_SCOPE_AGENT
#define LDS_WAIT() asm volatile("s_waitcnt lgkmcnt(0)" ::: "memory")
#define VM_WAIT() asm volatile("s_waitcnt vmcnt(0)" ::: "memory")

typedef float f32x2_t __attribute__((ext_vector_type(2))); typedef __bf16 bf16x2_t __attribute__((ext_vector_type(2)));
__device__ __forceinline__ unsigned cvt_pk_bf16(float lo, float hi) { const f32x2_t v = {lo, hi}; const bf16x2_t b = __builtin_convertvector(v, bf16x2_t); return __builtin_bit_cast(unsigned, b); }
__device__ __forceinline__ float bf2f(unsigned short b) { return __uint_as_float((unsigned)b << 16); }
__device__ __forceinline__ float bflo(unsigned w) { return __uint_as_float(w << 16); }
__device__ __forceinline__ float bfhi(unsigned w) { return __uint_as_float(w & 0xffff0000u); }
__device__ __forceinline__ float sigmoidf_(float x) { return __builtin_amdgcn_rcpf(1.0f + __builtin_amdgcn_exp2f(-LOG2E * x)); }
__device__ __forceinline__ float wave_sum(float v) {
#pragma unroll
    for (int o = 1; o < 64; o <<= 1) v += __shfl_xor(v, o);
    return v;
}

namespace pg8 {
constexpr int BM = 256, BK = 64, HALF = 128, HTB = HALF * BK * 2, STAGE_BYTES = 8 * HTB;
__host__ __device__ __forceinline__ int lds_byte(int r, int c) { const int st = (r >> 4) * 2 + (c >> 5), rr = r & 15, cc = c & 31, ob = rr * 64 + cc * 2; return st * 1024 + (ob ^ (((ob >> 9) & 1) << 5)); }
__host__ __device__ __forceinline__ void stage_rc(int b, int& R, int& C) { const int st = b / 1024, sb = b % 1024, swz = sb ^ (((sb >> 9) & 1) << 5); R = (st >> 1) * 16 + swz / 64; C = (st & 1) * 32 + (swz % 64) / 2; }

struct Unit { int pm, pn, z; };

template <class Epi, class Sched>
__device__ __forceinline__ void gemm_phase(LAS unsigned char* lds, const int K, const Sched& S, const Epi& E) {
    const int tid = threadIdx.x, wid = __builtin_amdgcn_readfirstlane(tid >> 6), lane = tid & 63, wr = wid >> 2, wc = wid & 3, fr = lane & 15, fq = lane >> 4;
    const int nt = K / BK;
    unsigned voffB[2];
#pragma unroll
    for (int i = 0; i < 2; ++i) { int R_, C_; stage_rc(tid * 16 + i * 8192, R_, C_); voffB[i] = (unsigned)(R_ * K + C_) * 2u; }
    const size_t kstep = (size_t)(BK * 2);
    const size_t hstep = (size_t)HALF * K * 2;
    const unsigned ldsw = (unsigned)wid * 1024u;
    const int aoff = lds_byte(wr * 64 + fr, fq * 8), boff = lds_byte(wc * 32 + fr, fq * 8);
    const char* const abase = S.a_base();
#define PG8_SA(b, h) (((b) * 2 + (h)) * HTB)
#define PG8_SB(b, h) ((4 + (b) * 2 + (h)) * HTB)
#define PG8_STAGE(bufoff, gbase, voff) do { _Pragma("unroll") for (int _i = 0; _i < 2; ++_i) \
        __builtin_amdgcn_global_load_lds((const unsigned*)((const char*)(gbase) + (voff)[_i]), (LAS unsigned*)(lds + (bufoff) + ldsw + _i * 8192), 16, 0, 0); } while (0)
#define PG8_LDA(dst, b, h) do { _Pragma("unroll") for (int m = 0; m < 4; ++m) _Pragma("unroll") for (int k = 0; k < 2; ++k) dst[m][k] = *(const LAS bf16x8*)(lds + PG8_SA(b, h) + aoff + m * 2048 + k * 1024); } while (0)
#define PG8_LDB(dst, b, h) do { _Pragma("unroll") for (int n = 0; n < 2; ++n) _Pragma("unroll") for (int k = 0; k < 2; ++k) dst[n][k] = *(const LAS bf16x8*)(lds + PG8_SB(b, h) + boff + n * 2048 + k * 1024); } while (0)
#define PG8_MMA(ai, bj, At, Bt) do { __builtin_amdgcn_s_setprio(1); _Pragma("unroll") for (int m = 0; m < 4; ++m) _Pragma("unroll") for (int n = 0; n < 2; ++n) _Pragma("unroll") for (int k = 0; k < 2; ++k) \
        acc[ai][bj][m][n] = __builtin_amdgcn_mfma_f32_16x16x32_bf16(Bt[n][k], At[m][k], acc[ai][bj][m][n], 0, 0, 0); __builtin_amdgcn_s_setprio(0); } while (0)
#define PG8_WAIT_V(n) asm volatile("s_waitcnt vmcnt(" #n ")" ::: "memory")
#define PG8_WAIT_L(n) asm volatile("s_waitcnt lgkmcnt(" #n ")" ::: "memory")
#define PG8_BAR __builtin_amdgcn_s_barrier()
#define PG8_SCHED __builtin_amdgcn_sched_barrier(0)
    Unit cur, nxt; int ui = 0;
    if (!S.next(0, cur)) return;
    f32x4 acc[2][2][4][2];
#pragma unroll
    for (int a = 0; a < 2; ++a)
#pragma unroll
        for (int b = 0; b < 2; ++b)
#pragma unroll
            for (int m = 0; m < 4; ++m)
#pragma unroll
                for (int n = 0; n < 2; ++n) acc[a][b][m][n] = (f32x4){0.f, 0.f, 0.f, 0.f};
    bf16x8 At[4][2], B0[2][2], B1[2][2];
    unsigned ca[2][2], na[2][2];
    S.a_offs(cur, tid, ca);
    const char* cB = S.b_base(cur);
    PG8_STAGE(PG8_SB(0, 0), cB, voffB); PG8_STAGE(PG8_SB(0, 1), cB + hstep, voffB); PG8_STAGE(PG8_SA(0, 0), abase, ca[0]); PG8_STAGE(PG8_SA(0, 1), abase, ca[1]);
    if (wr == 1) PG8_BAR;
    PG8_WAIT_V(2); PG8_BAR;
    PG8_STAGE(PG8_SB(1, 0), cB + kstep, voffB); PG8_STAGE(PG8_SA(1, 0), abase + kstep, ca[0]); PG8_STAGE(PG8_SB(1, 1), cB + hstep + kstep, voffB);
    PG8_WAIT_V(6); PG8_BAR;
    for (;;) {
        const bool has_next = S.next(ui + 1, nxt);
        const char* nB = cB;
#pragma unroll
        for (int h = 0; h < 2; ++h)
#pragma unroll
            for (int i = 0; i < 2; ++i) na[h][i] = ca[h][i];
        if (has_next) { S.a_offs(nxt, tid, na); nB = S.b_base(nxt); }
        for (int t = 0; t < nt; t += 2) {
            const bool last = (t == nt - 2);
            const char* a1 = abase + (size_t)(t + 1) * kstep;
            const char* a2 = last ? abase : abase + (size_t)(t + 2) * kstep; const char* b2 = last ? nB : cB + (size_t)(t + 2) * kstep;
            const char* a3 = a2 + kstep; const char* b3 = b2 + kstep;
            PG8_LDB(B0, 0, 0); PG8_LDB(B1, 0, 1); PG8_SCHED; PG8_LDA(At, 0, 0); PG8_STAGE(PG8_SA(1, 1), a1, ca[1]);
            PG8_WAIT_V(8); PG8_WAIT_L(0); PG8_BAR; PG8_MMA(0, 0, At, B0); PG8_MMA(0, 1, At, B1); PG8_BAR; PG8_SCHED;
            if (last) {
#pragma unroll
                for (int h = 0; h < 2; ++h)
#pragma unroll
                    for (int i = 0; i < 2; ++i) ca[h][i] = na[h][i];
            }
            PG8_LDA(At, 0, 1); PG8_STAGE(PG8_SB(0, 0), b2, voffB); PG8_STAGE(PG8_SB(0, 1), b2 + hstep, voffB); PG8_STAGE(PG8_SA(0, 0), a2, ca[0]);
            PG8_WAIT_V(8); PG8_WAIT_L(0); PG8_BAR; PG8_MMA(1, 0, At, B0); PG8_MMA(1, 1, At, B1); PG8_BAR; PG8_SCHED;
            PG8_LDB(B0, 1, 0); PG8_LDB(B1, 1, 1); PG8_SCHED; PG8_LDA(At, 1, 0); PG8_STAGE(PG8_SA(0, 1), a2, ca[1]);
            PG8_WAIT_V(8); PG8_WAIT_L(0); PG8_BAR; PG8_MMA(0, 0, At, B0); PG8_MMA(0, 1, At, B1); PG8_BAR; PG8_SCHED;
            PG8_LDA(At, 1, 1); PG8_STAGE(PG8_SB(1, 0), b3, voffB); PG8_STAGE(PG8_SB(1, 1), b3 + hstep, voffB); PG8_STAGE(PG8_SA(1, 0), a3, ca[0]);
            PG8_WAIT_V(8); PG8_WAIT_L(0); PG8_BAR; PG8_MMA(1, 0, At, B0); PG8_MMA(1, 1, At, B1); PG8_BAR; PG8_SCHED;
        }
        if (wr == 0) PG8_BAR;
        { int tz = tid; asm volatile("" : "+v"(tz));
          const int l2 = tz & 63, w2 = __builtin_amdgcn_readfirstlane(tz >> 6); E(acc, cur, w2 >> 2, w2 & 3, l2 & 15, l2 >> 4); }
        if (!has_next) break;
#pragma unroll
        for (int a = 0; a < 2; ++a)
#pragma unroll
            for (int b = 0; b < 2; ++b)
#pragma unroll
                for (int m = 0; m < 4; ++m)
#pragma unroll
                    for (int n = 0; n < 2; ++n) acc[a][b][m][n] = (f32x4){0.f, 0.f, 0.f, 0.f};
        cur = nxt; cB = nB; ++ui;
        if (wr == 1) PG8_BAR;
    }
    PG8_WAIT_V(0);
    PG8_BAR;
#undef PG8_SA
#undef PG8_SB
#undef PG8_STAGE
#undef PG8_LDA
#undef PG8_LDB
#undef PG8_MMA
#undef PG8_WAIT_V
#undef PG8_WAIT_L
#undef PG8_BAR
#undef PG8_SCHED
}
}

#define XB_TMO      128
#define XB_XCNT(j)  (256  + 64 * (j))
#define XB_XSUB(j)  (1280 + 64 * (j))
#define XB_XGEN(j)  (2304 + 64 * (j))
#define XB_TOP      3328
#define XB_TOPGEN   3392
#define XCD_BAR_WORDS 3456
#define XB_SPIN_CAP (1u << 18)
__device__ __forceinline__ unsigned xb_ld(unsigned* p)              { return __hip_atomic_load(p, __ATOMIC_RELAXED, __HIP_MEMORY_SCOPE_AGENT); }
__device__ __forceinline__ unsigned xb_add(unsigned* p, unsigned v) { return __hip_atomic_fetch_add(p, v, __ATOMIC_RELAXED, __HIP_MEMORY_SCOPE_AGENT); }
__device__ __forceinline__ unsigned xb_xcc_id() { return (unsigned)__builtin_amdgcn_s_getreg((3 << 11) | 20) & 0xFu; }
#define XB_SPIN(cond, bar) do { unsigned _sp = 0; while (cond) { __builtin_amdgcn_s_sleep(1); \
    if ((++_sp & 255u) == 0u) { if (xb_ld(&(bar)[XB_TMO])) break; if (_sp > XB_SPIN_CAP) { atomicAdd(&(bar)[XB_TMO], 1u); break; } } } } while (0)
struct XcdBarrier { unsigned* bar; unsigned x; volatile LAS unsigned* st; };
__device__ __forceinline__ XcdBarrier xcd_barrier_post(unsigned* bar, volatile LAS unsigned* st) {
    XcdBarrier b; b.bar = bar; b.x = xb_xcc_id(); b.st = st;
    if (threadIdx.x == 0) (void)xb_add(&bar[XB_XCNT(b.x)], 1u);
    return b;
}
__device__ __forceinline__ void xcd_barrier_complete(unsigned* bar, unsigned x, unsigned& nloc, unsigned& nx) {
    const unsigned G = gridDim.x * gridDim.y * gridDim.z;
    unsigned sum, cnt, mine, sp = 0u;
    for (;;) {
        sum = 0u; cnt = 0u; mine = 0u;
#pragma unroll
        for (unsigned j = 0; j < 16; ++j) { const unsigned c = xb_ld(&bar[XB_XCNT(j)]); sum += c; cnt += (c > 0u) ? 1u : 0u; mine = (j == x) ? c : mine; }
        if (sum == G) break;
        __builtin_amdgcn_s_sleep(1);
        if ((++sp & 255u) == 0u) { if (xb_ld(&bar[XB_TMO])) break; if (sp > XB_SPIN_CAP) { atomicAdd(&bar[XB_TMO], 1u); break; } }
    }
    nloc = mine > 0u ? mine : 1u; nx = cnt > 0u ? cnt : 1u;
}
__device__ __forceinline__ void xcd_barrier(const XcdBarrier& b) {
    asm volatile("s_waitcnt vmcnt(0)" ::: "memory");
    __syncthreads();
    if (threadIdx.x == 0) {
        unsigned* bar = b.bar;
        __builtin_amdgcn_s_waitcnt(0);
        unsigned nloc = b.st[0], nx = b.st[1];
        if (nloc == 0u) { xcd_barrier_complete(bar, b.x, nloc, nx); b.st[0] = nloc; b.st[1] = nx; }
        const unsigned old = xb_add(&bar[XB_XSUB(b.x)], 1u);
        const unsigned gen = old / nloc;
        if (old + 1u == (gen + 1u) * nloc) {
            __builtin_amdgcn_fence(__ATOMIC_RELEASE, "agent");
            asm volatile("s_waitcnt vmcnt(0)" ::: "memory");
            const unsigned og = xb_add(&bar[XB_TOP], 1u);
            const unsigned tg = og / nx;
            if (og + 1u == (tg + 1u) * nx) xb_add(&bar[XB_TOPGEN], 1u);
            else XB_SPIN(xb_ld(&bar[XB_TOPGEN]) == tg, bar);
            __builtin_amdgcn_fence(__ATOMIC_ACQUIRE, "agent");
            xb_add(&bar[XB_XGEN(b.x)], 1u);
            asm volatile("s_waitcnt vmcnt(0)" ::: "memory");
        } else {
            XB_SPIN(xb_ld(&bar[XB_XGEN(b.x)]) == gen, bar);
            __builtin_amdgcn_fence(__ATOMIC_ACQUIRE, "agent");
            asm volatile("s_waitcnt vmcnt(0)" ::: "memory");
        }
    }
    __syncthreads();
}

struct Args {
    const float* in[21];
    float* out; unsigned char* ws;
    int ph_lo, ph_hi, flags, pad;
};
enum { I_X = 0, I_META, I_RELB, I_NMIX, I_WIN, I_BGATE, I_WAO, I_CONVW, I_CONVB, I_LNG, I_LNB, I_WCO, I_WOUT, I_NFFN, I_WR, I_BR, I_WUG, I_BUG, I_WD, I_BD, I_NFIN };

struct Frame {
    LAS unsigned char* lds;
    unsigned char* ws;
    int tid, lane, wave;
    int G, bid;
};
template <class T> __device__ __forceinline__ T* wsp(unsigned char* ws, size_t off) { return (T*)(ws + off); }

struct P0Desc { const float* src; bf16_t* dst; int ldn, ldk; };
__device__ __forceinline__ void p0_load(const P0Desc& d, f32x4 (&v)[16], int lane) {
    const float* p = d.src + (size_t)(lane >> 4) * d.ldn + (lane & 15) * 4;
#pragma unroll
    for (int i = 0; i < 16; ++i) v[i] = *(const f32x4*)(p + (size_t)(4 * i) * d.ldn);
}
__device__ __forceinline__ void p0_store(const P0Desc& d, const f32x4 (&v)[16], LAS float* scr, int lane) {
    const int n4 = (lane & 15) * 4, kr = lane >> 4;
#pragma unroll
    for (int i = 0; i < 16; ++i) { LAS float* p = scr + (4 * i + kr) * 65 + n4; p[0] = v[i][0]; p[1] = v[i][1]; p[2] = v[i][2]; p[3] = v[i][3]; }
    LDS_WAIT(); asm volatile("" ::: "memory");
    const int c = lane & 7;
#pragma unroll
    for (int j = 0; j < 8; ++j) { const int n = (lane >> 3) + 8 * j; const LAS float* s = scr + (8 * c) * 65 + n;
        u32x4 o; o.x = cvt_pk_bf16(s[0 * 65], s[1 * 65]); o.y = cvt_pk_bf16(s[2 * 65], s[3 * 65]); o.z = cvt_pk_bf16(s[4 * 65], s[5 * 65]); o.w = cvt_pk_bf16(s[6 * 65], s[7 * 65]);
        *(u32x4*)(d.dst + (size_t)n * d.ldk + 8 * c) = o; }
    LDS_WAIT(); asm volatile("" ::: "memory");
}
__device__ __forceinline__ void rms_row_to_bf16(const float* __restrict__ xrow, const float* __restrict__ g, bf16_t* __restrict__ orow, int lane) {
    const f32x4* xr = (const f32x4*)xrow + lane; const f32x4* gr = (const f32x4*)g + lane;
    f32x4 v[4]; float s = 0.f;
#pragma unroll
    for (int j = 0; j < 4; ++j) { v[j] = xr[64 * j]; s += (v[j].x * v[j].x + v[j].y * v[j].y) + (v[j].z * v[j].z + v[j].w * v[j].w); }
    const float r = 1.0f / sqrtf(wave_sum(s) * (1.f / DM) + EPS);
    unsigned long long* o8 = (unsigned long long*)orow + lane;
#pragma unroll
    for (int j = 0; j < 4; ++j) { const f32x4 gg = gr[64 * j];
        o8[64 * j] = (unsigned long long)cvt_pk_bf16(v[j].x * r * gg.x, v[j].y * r * gg.y) | ((unsigned long long)cvt_pk_bf16(v[j].z * r * gg.z, v[j].w * r * gg.w) << 32); }
}
__device__ __forceinline__ void p0_prologue(Frame& F, const Args& a, const int part) {
    LAS float* scr = (LAS float*)(F.lds + F.wave * 16896);
    const int gw = F.bid * NWAVES + F.wave, NGW = F.G * NWAVES;
    unsigned char* ws = F.ws;
    constexpr int T_IN = 81 * 16, T_AO = 16 * 8, T_CO = 16 * 8, T_OUT = 16 * 16, T_SMALL = T_IN + T_AO + T_CO + T_OUT;
    constexpr int T_UG = NE * 32 * 16, T_D = NE * 16 * 16, T_ALL = T_SMALL + T_UG + T_D;
    auto desc = [&](int it) -> P0Desc {
        int r = it; P0Desc d;
        if (r < T_IN) { const int g = r / 16, kb = r % 16; const int dr = g * 64; int sc;
            if (dr < WR_GLU) sc = dr;
            else if (dr < WR_GATE) { const int q = dr - WR_GLU, tile = q >> 8, hf = (q >> 7) & 1, w = q & 127; sc = SC_GLU + 512 * hf + 128 * tile + w; }
            else if (dr < WR_IK) sc = SC_GATE + (dr - WR_GATE);
            else sc = SC_IK + (dr - WR_IK);
            d.src = a.in[I_WIN] + (size_t)(kb * 64) * INCOLS + sc; d.ldn = INCOLS; d.dst = wsp<bf16_t>(ws, WS_WIN) + (size_t)dr * DM + kb * 64; d.ldk = DM; return d; }
        r -= T_IN;
        if (r < T_AO) { const int g = r / 8, kb = r % 8; d.src = a.in[I_WAO] + (size_t)(kb * 64) * DM + g * 64; d.ldn = DM; d.dst = wsp<bf16_t>(ws, WS_WAO) + (size_t)(g * 64) * AW + kb * 64; d.ldk = AW; return d; }
        r -= T_AO;
        if (r < T_CO) { const int g = r / 8, kb = r % 8; d.src = a.in[I_WCO] + (size_t)(kb * 64) * DM + g * 64; d.ldn = DM; d.dst = wsp<bf16_t>(ws, WS_WCO) + (size_t)(g * 64) * CC + kb * 64; d.ldk = CC; return d; }
        r -= T_CO;
        if (r < T_OUT) { const int g = r / 16, kb = r % 16; d.src = a.in[I_WOUT] + (size_t)(kb * 64) * DM + g * 64; d.ldn = DM; d.dst = wsp<bf16_t>(ws, WS_WOUT) + (size_t)(g * 64) * DM + kb * 64; d.ldk = DM; return d; }
        r -= T_OUT;
        if (r < T_UG) { const int e = r / 512, q = r % 512, g = q % 32, kb = q / 32; const int dr = g * 64, tile = dr >> 8, hf = (dr >> 7) & 1, w = dr & 127;
            d.src = a.in[I_WUG] + (size_t)e * DM * 2 * DFF + (size_t)(kb * 64) * (2 * DFF) + DFF * hf + 128 * tile + w; d.ldn = 2 * DFF;
            d.dst = wsp<bf16_t>(ws, WS_WUG) + (size_t)e * 2 * DFF * DM + (size_t)dr * DM + kb * 64; d.ldk = DM; return d; }
        r -= T_UG;
        { const int e = r / 256, q = r % 256, g = q % 16, kb = q / 16;
            d.src = a.in[I_WD] + (size_t)e * DFF * DM + (size_t)(kb * 64) * DM + g * 64; d.ldn = DM; d.dst = wsp<bf16_t>(ws, WS_WD) + (size_t)e * DM * DFF + (size_t)(g * 64) * DFF + kb * 64; d.ldk = DFF; return d; }
    };
    const int T_LO = part ? T_SMALL : 0, T_HI = part ? T_ALL : T_SMALL;
    if (T_LO + gw < T_HI) {
        f32x4 va[16], vb[16];
        P0Desc da = desc(T_LO + gw), db = da;
        p0_load(da, va, F.lane);
        for (int it = T_LO + gw; it < T_HI; it += 2 * NGW) {
            const int i1 = it + NGW, i2 = it + 2 * NGW;
            db = desc(i1 < T_HI ? i1 : it); p0_load(db, vb, F.lane);
            p0_store(da, va, scr, F.lane);
            da = desc(i2 < T_HI ? i2 : it); p0_load(da, va, F.lane);
            if (i1 < T_HI) p0_store(db, vb, scr, F.lane);
        }
    }
    if (part) return;
    { const int gt = F.bid * NTHREADS + F.tid;
      if (gt < 8 * DM / 2) { const int n = gt >> 9, k = (gt & 511) * 2; const float v0 = a.in[I_WIN][(size_t)k * INCOLS + SC_IW + n], v1 = a.in[I_WIN][(size_t)(k + 1) * INCOLS + SC_IW + n];
          *(unsigned*)(wsp<bf16_t>(ws, WS_WIN) + (size_t)(WR_IW + n) * DM + k) = cvt_pk_bf16(v0, v1); } }
    { const int gt = F.bid * NTHREADS + F.tid;
      if (gt < NE * DM / 2) { const int e = gt >> 9, d = (gt & 511) * 2; const float v0 = a.in[I_NFFN][d] * a.in[I_WR][(size_t)d * NE + e], v1 = a.in[I_NFFN][d + 1] * a.in[I_WR][(size_t)(d + 1) * NE + e];
          const unsigned hi = cvt_pk_bf16(v0, v1); const unsigned lo = cvt_pk_bf16(v0 - bflo(hi), v1 - bfhi(hi));
          *(unsigned*)(wsp<bf16_t>(ws, WS_WRT) + (size_t)e * DM + d) = hi; *(unsigned*)(wsp<bf16_t>(ws, WS_WRT) + (size_t)(NE + e) * DM + d) = lo; } }
    for (int m = gw; m < NTOK + NMETA; m += NGW) {
        if (m < NTOK) rms_row_to_bf16(a.in[I_X] + (size_t)m * DM, a.in[I_NMIX], wsp<bf16_t>(ws, WS_XN) + (size_t)m * DM, F.lane);
        else rms_row_to_bf16(a.in[I_META] + (size_t)(m - NTOK) * DM, a.in[I_NMIX], wsp<bf16_t>(ws, WS_XNM) + (size_t)(m - NTOK) * DM, F.lane);
    }
}

struct PlainSched {
    const char* ws; unsigned a_off, b_off; int K, nM, nN, nwg, G, c;
    __device__ __forceinline__ void init(const unsigned char* ws_, size_t a, size_t b, int M, int N, int K_, int G_, int c_) { ws = (const char*)ws_; a_off = (unsigned)a; b_off = (unsigned)b; K = K_; nM = M / 256; nN = N / 256; nwg = nM * nN; G = G_; c = c_; }
    __device__ __forceinline__ bool next(int i, pg8::Unit& u) const {
        const long L = (long)i * G + c; if (L >= nwg) return false;
        int wgid = (int)L; { const int q = nwg / 8, r = nwg % 8, xcd = wgid % 8, off = wgid / 8; wgid = (xcd < r ? xcd * (q + 1) : r * (q + 1) + (xcd - r) * q) + off; }
        const int nig = 8 * nN, gid = wgid / nig, fm = gid * 8, gsz = (nM - fm) < 8 ? (nM - fm) : 8;
        u.pm = fm + ((wgid % nig) % gsz); u.pn = (wgid % nig) / gsz; u.z = 0; return true;
    }
    __device__ __forceinline__ const char* a_base() const { return ws; }
    __device__ __forceinline__ void a_offs(const pg8::Unit& u, int tid, unsigned (&o)[2][2]) const {
        int R[2], C[2]; pg8::stage_rc(tid * 16, R[0], C[0]); pg8::stage_rc(tid * 16 + 8192, R[1], C[1]);
#pragma unroll
        for (int h = 0; h < 2; ++h)
#pragma unroll
            for (int i = 0; i < 2; ++i) o[h][i] = a_off + (unsigned)(((u.pm * 256 + h * 128 + R[i]) * K + C[i]) * 2);
    }
    __device__ __forceinline__ const char* b_base(const pg8::Unit& u) const { return ws + b_off + (size_t)u.pn * 256 * K * 2; }
};
struct MergeSched {
    const char* ws; int G, c;
    __device__ __forceinline__ bool next(int i, pg8::Unit& u) const {
        const int t = c + (i >> 1) * G;
        if (t >= 256) return false;
        u.pm = (t & 7) + 8 * (t >> 5); u.pn = (t >> 3) & 3; u.z = i & 1; return true;
    }
    __device__ __forceinline__ const char* a_base() const { return ws; }
    __device__ __forceinline__ void a_offs(const pg8::Unit& u, int tid, unsigned (&o)[2][2]) const {
        int R[2], C[2]; pg8::stage_rc(tid * 16, R[0], C[0]); pg8::stage_rc(tid * 16 + 8192, R[1], C[1]);
        const unsigned base = (unsigned)(u.z ? WS_CO : WS_AO);
#pragma unroll
        for (int h = 0; h < 2; ++h)
#pragma unroll
            for (int i = 0; i < 2; ++i) o[h][i] = base + (unsigned)(((u.pm * 256 + h * 128 + R[i]) * 512 + C[i]) * 2);
    }
    __device__ __forceinline__ const char* b_base(const pg8::Unit& u) const { return ws + (u.z ? WS_WCO : WS_WAO) + (size_t)u.pn * 256 * 512 * 2; }
};
struct MoeTables { const LAS int* cnt; const LAS int* tbase; };
template <int NC, bool GATHER>
struct MoeSched {
    const char* ws; MoeTables T; int G, c, total;
    __device__ __forceinline__ bool next(int i, pg8::Unit& u) const {
        const long L = (long)i * G + c; if (L >= total) return false;
        int wgid = (int)L; { const int q = total / 8, r = total % 8, xcd = wgid % 8, off = wgid / 8; wgid = (xcd < r ? xcd * (q + 1) : r * (q + 1) + (xcd - r) * q) + off; }
        int e = 0;
        for (int j = 1; j < NE; ++j) e += (wgid >= __builtin_amdgcn_readfirstlane(T.tbase[j]) * NC) ? 1 : 0;
        e = __builtin_amdgcn_readfirstlane(e);
        const int tb0 = __builtin_amdgcn_readfirstlane(T.tbase[e]), tb1 = __builtin_amdgcn_readfirstlane(T.tbase[e + 1]);
        const int loc = wgid - tb0 * NC, nt_e = tb1 - tb0;
        u.z = e;
        u.pn = loc % NC; u.pm = loc / NC;
        return true;
    }
    __device__ __forceinline__ const char* a_base() const { return ws; }
    __device__ __forceinline__ void a_offs(const pg8::Unit& u, int tid, unsigned (&o)[2][2]) const {
        int R[2], C[2]; pg8::stage_rc(tid * 16, R[0], C[0]); pg8::stage_rc(tid * 16 + 8192, R[1], C[1]);
        if (GATHER) {
            const int* list = (const int*)(ws + WS_LIST) + (size_t)u.z * NTOK; const int n = __builtin_amdgcn_readfirstlane(T.cnt[u.z]);
#pragma unroll
            for (int h = 0; h < 2; ++h)
#pragma unroll
                for (int i = 0; i < 2; ++i) { const int p = u.pm * 256 + h * 128 + R[i]; const int tok = list[p < n ? p : 0];
                    o[h][i] = (unsigned)WS_XN + (unsigned)((tok * DM + C[i]) * 2); }
        } else {
            const int row0 = (__builtin_amdgcn_readfirstlane(T.tbase[u.z]) + u.pm) * 256;
#pragma unroll
            for (int h = 0; h < 2; ++h)
#pragma unroll
                for (int i = 0; i < 2; ++i) o[h][i] = (unsigned)WS_ACT + (unsigned)(((row0 + h * 128 + R[i]) * DFF + C[i]) * 2);
        }
    }
    __device__ __forceinline__ const char* b_base(const pg8::Unit& u) const {
        if (GATHER) return ws + WS_WUG + ((size_t)u.z * 2 * DFF + (size_t)u.pn * 256) * DM * 2;
        else return ws + WS_WD + ((size_t)u.z * DM + (size_t)u.pn * 256) * DFF * 2;
    }
};

#define EPI_ROWS(ai, m) for (int ai = 0; ai < 2; ++ai) _Pragma("unroll") for (int m = 0; m < 4; ++m)
#define EPI_COLS(bj, n) for (int bj = 0; bj < 2; ++bj) _Pragma("unroll") for (int n = 0; n < 2; ++n)
__device__ __forceinline__ void st_bf16x4(bf16_t* p, f32x4 v) { u32x2 w; w.x = cvt_pk_bf16(v[0], v[1]); w.y = cvt_pk_bf16(v[2], v[3]); *(u32x2*)p = w; }

struct EpiInProj {
    unsigned char* ws; const float* bgate;
    __device__ __forceinline__ void operator()(const f32x4 (&acc)[2][2][4][2], const pg8::Unit& u, int wr, int wc, int fr, int fq) const {
        const int pn = u.pn, row0 = u.pm * 256 + wr * 64 + fr, col0 = wc * 32 + 4 * fq;
        const int bidx = u.pm >> 3;
        const int rowk0 = row0 + NMETA * (bidx + 1);
        if (pn < 2 || (pn >= 6 && pn < 8)) {
            bf16_t* O = wsp<bf16_t>(ws, pn < 2 ? WS_Q : WS_IQ); const int cb = (pn & 1) * 256; const float sc = pn < 2 ? QSCALE : 1.0f;
#pragma unroll
            EPI_ROWS(ai, m) { bf16_t* rp = O + (size_t)(row0 + ai * 128 + m * 16) * AW + cb + col0;
#pragma unroll
                EPI_COLS(bj, n) st_bf16x4(rp + bj * 128 + n * 16, acc[ai][bj][m][n] * sc); }
        } else if (pn < 4) {
            bf16_t* O = wsp<bf16_t>(ws, WS_KB); const int cb = (pn & 1) * 256;
#pragma unroll
            EPI_ROWS(ai, m) { bf16_t* rp = O + (size_t)(rowk0 + ai * 128 + m * 16) * AW + cb + col0;
#pragma unroll
                EPI_COLS(bj, n) st_bf16x4(rp + bj * 128 + n * 16, acc[ai][bj][m][n]); }
        } else if (pn < 6) {
            bf16_t* O = wsp<bf16_t>(ws, WS_VT) + (size_t)bidx * AW * TP; const int cb = (pn & 1) * 256;
            const int t0 = (row0 & (SEQ - 1)) + NMETA + VOFF;
#pragma unroll
            EPI_ROWS(ai, m) { const int t = t0 + ai * 128 + m * 16;
#pragma unroll
                EPI_COLS(bj, n) { const f32x4 v = acc[ai][bj][m][n]; bf16_t* cp = O + (size_t)(cb + col0 + bj * 128 + n * 16) * TP + (t & ~1);
                    const float p0 = __shfl_xor(v[0], 1), p1 = __shfl_xor(v[1], 1), p2 = __shfl_xor(v[2], 1), p3 = __shfl_xor(v[3], 1);
                    if ((fr & 1) == 0) { *(unsigned*)(cp) = cvt_pk_bf16(v[0], p0); *(unsigned*)(cp + TP) = cvt_pk_bf16(v[1], p1); }
                    else { *(unsigned*)(cp + 2 * TP) = cvt_pk_bf16(p2, v[2]); *(unsigned*)(cp + 3 * TP) = cvt_pk_bf16(p3, v[3]); } } }
        } else if (pn < 12) {
            bf16_t* O = wsp<bf16_t>(ws, WS_GLU); const int cb = (pn - 8) * 128;
#pragma unroll
            EPI_ROWS(ai, m) { bf16_t* rp = O + (size_t)(rowk0 + ai * 128 + m * 16) * CC + cb + col0;
#pragma unroll
                for (int n = 0; n < 2; ++n) { const f32x4 av = acc[ai][0][m][n], gv = acc[ai][1][m][n]; f32x4 y;
#pragma unroll
                    for (int j = 0; j < 4; ++j) y[j] = av[j] * sigmoidf_(gv[j]);
                    st_bf16x4(rp + n * 16, y); } }
        } else {
            const int gt = pn - 12; bf16_t* O = wsp<bf16_t>(ws, gt < 4 ? WS_GA : WS_GB); const int cb = (gt & 3) * 256; const float* bp = bgate + gt * 256 + col0;
            f32x4 bv[2][2];
#pragma unroll
            EPI_COLS(bj, n) bv[bj][n] = *(const f32x4*)(bp + bj * 128 + n * 16);
#pragma unroll
            EPI_ROWS(ai, m) { bf16_t* rp = O + (size_t)(row0 + ai * 128 + m * 16) * DM + cb + col0;
#pragma unroll
                EPI_COLS(bj, n) { const f32x4 x = acc[ai][bj][m][n] + bv[bj][n]; f32x4 y;
#pragma unroll
                    for (int j = 0; j < 4; ++j) y[j] = sigmoidf_(x[j]);
                    st_bf16x4(rp + bj * 128 + n * 16, y); } }
        }
    }
};
struct EpiMerge {
    unsigned char* ws;
    __device__ __forceinline__ void operator()(const f32x4 (&acc)[2][2][4][2], const pg8::Unit& u, int wr, int wc, int fr, int fq) const {
        const int row0 = u.pm * 256 + wr * 64 + fr, col0 = u.pn * 256 + wc * 32 + 4 * fq;
        const bf16_t* Gt = wsp<bf16_t>(ws, u.z ? WS_GB : WS_GA); bf16_t* O = wsp<bf16_t>(ws, WS_MG);
#pragma unroll
        for (int ai = 0; ai < 2; ++ai) {
            u32x2 g[4][2][2], p[4][2][2];
#pragma unroll
            for (int m = 0; m < 4; ++m)
#pragma unroll
                EPI_COLS(bj, n) { const size_t o = (size_t)(row0 + ai * 128 + m * 16) * DM + col0 + bj * 128 + n * 16; g[m][bj][n] = *(const u32x2*)(Gt + o); p[m][bj][n] = u.z ? *(const u32x2*)(O + o) : (u32x2){0u, 0u}; }
#pragma unroll
            for (int m = 0; m < 4; ++m)
#pragma unroll
                EPI_COLS(bj, n) { const size_t o = (size_t)(row0 + ai * 128 + m * 16) * DM + col0 + bj * 128 + n * 16; const u32x2 gg = g[m][bj][n], pp = p[m][bj][n]; const f32x4 a = acc[ai][bj][m][n];
                    const f32x4 y = (f32x4){bflo(gg.x) * a[0] + bflo(pp.x), bfhi(gg.x) * a[1] + bfhi(pp.x), bflo(gg.y) * a[2] + bflo(pp.y), bfhi(gg.y) * a[3] + bfhi(pp.y)};
                    st_bf16x4(O + o, y); }
        }
    }
};
struct EpiResid {
    const float* x; float* out;
    __device__ __forceinline__ void operator()(const f32x4 (&acc)[2][2][4][2], const pg8::Unit& u, int wr, int wc, int fr, int fq) const {
        const int row0 = u.pm * 256 + wr * 64 + fr, col0 = u.pn * 256 + wc * 32 + 4 * fq;
#pragma unroll
        for (int ai = 0; ai < 2; ++ai)
#pragma unroll
            for (int mh = 0; mh < 2; ++mh) {
                f32x4 xv[2][2][2];
#pragma unroll
                for (int mm = 0; mm < 2; ++mm)
#pragma unroll
                    EPI_COLS(bj, n) xv[mm][bj][n] = *(const f32x4*)(x + (size_t)(row0 + ai * 128 + (2 * mh + mm) * 16) * DM + col0 + bj * 128 + n * 16);
#pragma unroll
                for (int mm = 0; mm < 2; ++mm)
#pragma unroll
                    EPI_COLS(bj, n) *(f32x4*)(out + (size_t)(row0 + ai * 128 + (2 * mh + mm) * 16) * DM + col0 + bj * 128 + n * 16) = xv[mm][bj][n] + acc[ai][bj][2 * mh + mm][n];
            }
    }
};
struct EpiSwiglu {
    unsigned char* ws; const float* bug; MoeTables T;
    __device__ __forceinline__ void operator()(const f32x4 (&acc)[2][2][4][2], const pg8::Unit& u, int wr, int wc, int fr, int fq) const {
        const int e = u.z, n_e = __builtin_amdgcn_readfirstlane(T.cnt[e]), rloc0 = u.pm * 256 + wr * 64 + fr, row0 = __builtin_amdgcn_readfirstlane(T.tbase[e]) * 256 + rloc0, col0 = u.pn * 128 + wc * 32 + 4 * fq;
        const float* bp = bug + (size_t)e * 2 * DFF + col0; bf16_t* O = wsp<bf16_t>(ws, WS_ACT); const float* rg = wsp<float>(ws, WS_RG) + (size_t)e * NTOK;
        f32x4 bg[2], bu[2];
#pragma unroll
        for (int n = 0; n < 2; ++n) { bg[n] = *(const f32x4*)(bp + n * 16); bu[n] = *(const f32x4*)(bp + DFF + n * 16); }
        float rvs[2][4];
#pragma unroll
        EPI_ROWS(ai, m) { const int rl = rloc0 + ai * 128 + m * 16; rvs[ai][m] = rg[rl < n_e ? rl : 0]; }
        bf16_t* const sink = wsp<bf16_t>(ws, WS_DUMMY) + col0;
#pragma unroll
        EPI_ROWS(ai, m) { const int rl = rloc0 + ai * 128 + m * 16; bf16_t* rp = (rl < n_e) ? O + (size_t)(row0 + ai * 128 + m * 16) * DFF + col0 : sink; const float rv = rvs[ai][m];
#pragma unroll
                for (int n = 0; n < 2; ++n) { const f32x4 gv = acc[ai][0][m][n] * rv + bg[n], uv = acc[ai][1][m][n] * rv + bu[n]; f32x4 y;
#pragma unroll
                    for (int j = 0; j < 4; ++j) { const float g = fminf(gv[j], 7.0f), up = fminf(fmaxf(uv[j], -7.0f), 7.0f); y[j] = (up + 1.0f) * g * sigmoidf_(1.702f * g); }
                    st_bf16x4(rp + n * 16, y); } }
    }
};
struct EpiDown {
    unsigned char* ws; const float* bd; MoeTables T;
    __device__ __forceinline__ void operator()(const f32x4 (&acc)[2][2][4][2], const pg8::Unit& u, int wr, int wc, int fr, int fq) const {
        const int e = u.z, n_e = __builtin_amdgcn_readfirstlane(T.cnt[e]), rloc0 = u.pm * 256 + wr * 64 + fr, row0 = __builtin_amdgcn_readfirstlane(T.tbase[e]) * 256 + rloc0, col0 = u.pn * 256 + wc * 32 + 4 * fq;
        const float* bp = bd + (size_t)e * DM + col0; bf16_t* O = wsp<bf16_t>(ws, WS_YP); const float* lg = wsp<float>(ws, WS_LG) + (size_t)e * NTOK;
        f32x4 bv[2][2];
#pragma unroll
        EPI_COLS(bj, n) bv[bj][n] = *(const f32x4*)(bp + bj * 128 + n * 16);
        float gts[2][4];
#pragma unroll
        EPI_ROWS(ai, m) { const int rl = rloc0 + ai * 128 + m * 16; gts[ai][m] = lg[rl < n_e ? rl : 0]; }
        bf16_t* const sink = wsp<bf16_t>(ws, WS_DUMMY) + col0;
#pragma unroll
        EPI_ROWS(ai, m) { const int rl = rloc0 + ai * 128 + m * 16; const float gt = gts[ai][m]; bf16_t* rp = (rl < n_e) ? O + (size_t)(row0 + ai * 128 + m * 16) * DM + col0 : sink;
#pragma unroll
                EPI_COLS(bj, n) st_bf16x4(rp + bj * 128 + n * 16, (acc[ai][bj][m][n] + bv[bj][n]) * gt); }
    }
};

constexpr int IKBLK = 65;
__device__ __forceinline__ size_t ikf_off(int b, int p, int dim) { return ((((size_t)(b * IKBLK + (p >> 5)) * 4 + (dim >> 4)) * 64 + (((dim >> 3) & 1) * 32 + (p & 31))) * 8 + (dim & 7)); }
template <int NT>
__device__ __forceinline__ void wave_mm16(const bf16_t* __restrict__ A, int lda, const bf16_t* const (&Bt)[NT], int K, int lane, f32x4 (&acc)[NT]) {
    const bf16_t* ap = A + (size_t)(lane & 15) * lda + 8 * (lane >> 4);
    const bf16_t* bp[NT];
#pragma unroll
    for (int t = 0; t < NT; ++t) { bp[t] = Bt[t] + (size_t)(lane & 15) * K + 8 * (lane >> 4); acc[t] = (f32x4){0.f, 0.f, 0.f, 0.f}; }
#pragma unroll (NT == 1 ? 16 : 8)
    for (int k0 = 0; k0 < K; k0 += 32) {
        const bf16x8 a = *(const bf16x8*)(ap + k0);
#pragma unroll
        for (int t = 0; t < NT; ++t) { const bf16x8 b = *(const bf16x8*)(bp[t] + k0); acc[t] = __builtin_amdgcn_mfma_f32_16x16x32_bf16(b, a, acc[t], 0, 0, 0); }
    }
}
__device__ __forceinline__ void p1_thin(Frame& F, int dbgflags) {
    unsigned char* ws = F.ws;
    const bf16_t* WIN = wsp<bf16_t>(ws, WS_WIN); const bf16_t* XN = wsp<bf16_t>(ws, WS_XN); const bf16_t* XNM = wsp<bf16_t>(ws, WS_XNM);
    bf16_t* KB = wsp<bf16_t>(ws, WS_KB); bf16_t* VT = wsp<bf16_t>(ws, WS_VT); bf16_t* IK = wsp<bf16_t>(ws, WS_IK); bf16_t* GLU = wsp<bf16_t>(ws, WS_GLU); float* IW = wsp<float>(ws, WS_IW);
    const int gw = F.bid * NWAVES + F.wave, NGW = F.G * NWAVES, lane = F.lane, tk = lane & 15, nq = lane >> 4;
    {
        constexpr int WBP = 2064;
        LAS unsigned char* lds = F.lds;
        __syncthreads();
        { const unsigned char* src = (const unsigned char*)(WIN + (size_t)WR_IK * DM);
          for (int p = F.tid; p < 72 * 128; p += NTHREADS) { const int row = p >> 7, c16 = p & 127; *(LAS u32x4*)(lds + row * WBP + c16 * 16) = *(const u32x4*)(src + (size_t)row * DM * 2 + c16 * 16); } }
        __syncthreads();
        const int tg = F.wave & 3, hf = F.wave >> 2, kq = nq;
        for (int tb = F.bid; tb < NTOK / 64; tb += F.G) {
            const int m = tb * 64 + 16 * tg + tk, rowk = m + NMETA * ((m >> 11) + 1);
            const bf16_t* xr = XN + (size_t)m * DM + 16 * kq;
            bf16x8 xa[16], xb[16];
#pragma unroll
            for (int sblk = 0; sblk < 16; ++sblk) { xa[sblk] = *(const bf16x8*)(xr + 64 * sblk); xb[sblk] = *(const bf16x8*)(xr + 64 * sblk + 8); }
            const LAS unsigned char* wb = lds + tk * WBP + 32 * kq;
            if (hf == 0) {
                f32x4 acc[3] = {{0.f, 0.f, 0.f, 0.f}, {0.f, 0.f, 0.f, 0.f}, {0.f, 0.f, 0.f, 0.f}};
#pragma unroll
                for (int sblk = 0; sblk < 16; ++sblk)
#pragma unroll
                    for (int t = 0; t < 3; ++t) { const bf16x8 b0 = *(const LAS bf16x8*)(wb + 16 * t * WBP + 128 * sblk), b1 = *(const LAS bf16x8*)(wb + 16 * t * WBP + 128 * sblk + 16);
                        acc[t] = __builtin_amdgcn_mfma_f32_16x16x32_bf16(b0, xa[sblk], acc[t], 0, 0, 0); acc[t] = __builtin_amdgcn_mfma_f32_16x16x32_bf16(b1, xb[sblk], acc[t], 0, 0, 0); }
#pragma unroll
                for (int t = 0; t < 3; ++t) st_bf16x4(IK + ikf_off(m >> 11, NMETA + (m & (SEQ - 1)), 16 * t + 4 * nq), acc[t]);
            } else {
                f32x4 acc[2] = {{0.f, 0.f, 0.f, 0.f}, {0.f, 0.f, 0.f, 0.f}};
#pragma unroll
                for (int sblk = 0; sblk < 16; ++sblk)
#pragma unroll
                    for (int t = 0; t < 2; ++t) { const bf16x8 b0 = *(const LAS bf16x8*)(wb + 16 * (3 + t) * WBP + 128 * sblk), b1 = *(const LAS bf16x8*)(wb + 16 * (3 + t) * WBP + 128 * sblk + 16);
                        acc[t] = __builtin_amdgcn_mfma_f32_16x16x32_bf16(b0, xa[sblk], acc[t], 0, 0, 0); acc[t] = __builtin_amdgcn_mfma_f32_16x16x32_bf16(b1, xb[sblk], acc[t], 0, 0, 0); }
                st_bf16x4(IK + ikf_off(m >> 11, NMETA + (m & (SEQ - 1)), 48 + 4 * nq), acc[0]);
                if (nq < 2) *(f32x4*)(IW + (size_t)m * 8 + 4 * nq) = acc[1];
            }
        }
        __syncthreads();
    }
    if (!(dbgflags & 256)) for (int task = gw; task < 100; task += NGW) {
        if (task < 32) {
            const bf16_t* const Bt[1] = {WIN + (size_t)(SC_K + 16 * task) * DM}; f32x4 acc[1]; wave_mm16<1>(XNM, DM, Bt, DM, lane, acc);
            for (int b = 0; b < NB; ++b) st_bf16x4(KB + (size_t)(b * TT + tk) * AW + 16 * task + 4 * nq, acc[0]);
        } else if (task < 64) {
            const int t = task - 32; const bf16_t* const Bt[1] = {WIN + (size_t)(SC_V + 16 * t) * DM}; f32x4 acc[1]; wave_mm16<1>(XNM, DM, Bt, DM, lane, acc);
            const float p0 = __shfl_xor(acc[0][0], 1), p1 = __shfl_xor(acc[0][1], 1), p2 = __shfl_xor(acc[0][2], 1), p3 = __shfl_xor(acc[0][3], 1);
            const unsigned wa = (tk & 1) ? cvt_pk_bf16(p2, acc[0][2]) : cvt_pk_bf16(acc[0][0], p0), wb = (tk & 1) ? cvt_pk_bf16(p3, acc[0][3]) : cvt_pk_bf16(acc[0][1], p1);
            for (int b = 0; b < NB; ++b) { bf16_t* cp = VT + ((size_t)b * AW + 16 * t + 4 * nq + 2 * (tk & 1)) * TP + VOFF + (tk & ~1);
                *(unsigned*)cp = wa; *(unsigned*)(cp + TP) = wb; }
        } else if (task < 68) {
            const int t = task - 64; const bf16_t* const Bt[1] = {WIN + (size_t)(WR_IK + 16 * t) * DM}; f32x4 acc[1]; wave_mm16<1>(XNM, DM, Bt, DM, lane, acc);
            for (int b = 0; b < NB; ++b) st_bf16x4(IK + ikf_off(b, tk, 16 * t + 4 * nq), acc[0]);
        } else {
            const int c16 = task - 68; const int ar = WR_GLU + 256 * (c16 >> 3) + 16 * (c16 & 7);
            const bf16_t* const Bt[2] = {WIN + (size_t)ar * DM, WIN + (size_t)(ar + 128) * DM}; f32x4 acc[2]; wave_mm16<2>(XNM, DM, Bt, DM, lane, acc);
            f32x4 y;
#pragma unroll
            for (int j = 0; j < 4; ++j) y[j] = acc[0][j] * sigmoidf_(acc[1][j]);
            for (int b = 0; b < NB; ++b) st_bf16x4(GLU + (size_t)(b * TT + tk) * CC + 16 * c16 + 4 * nq, y);
        }
    }
}

__device__ __forceinline__ void p2_conv(Frame& F, const Args& a) {
    unsigned char* ws = F.ws;
    LAS unsigned char* xs = F.lds;
    LAS float* wl = (LAS float*)(F.lds + 63488);
    const bf16_t* GLU = wsp<bf16_t>(ws, WS_GLU); bf16_t* CO = wsp<bf16_t>(ws, WS_CO);
    const float* cw = a.in[I_CONVW];
    for (int idx = F.tid; idx < CW * 128; idx += NTHREADS) { const int tap = idx >> 7, c4 = idx & 127; const f32x4 v = *(const f32x4*)(cw + tap * CC + 4 * c4); *(LAS f32x4*)(wl + tap * 512 + (c4 & 1) * 256 + (c4 >> 1) * 4) = v; }
    const int lane = F.lane, c0 = 8 * lane;
    for (int tile = F.bid; tile < NTOK / 32; tile += F.G) {
        const int b = tile >> 6, s0 = (tile & 63) * 32, p0 = NMETA + s0;
        __syncthreads();
        for (int idx = F.tid; idx < 62 * 64; idx += NTHREADS) { const int r = idx >> 6, ch = idx & 63, p = p0 - 30 + r; u32x4 v = (u32x4){0u, 0u, 0u, 0u};
            if (p >= 0) v = *(const u32x4*)(GLU + (size_t)(b * TT + p) * CC + ch * 8);
            *(LAS u32x4*)(xs + r * 1024 + ch * 16) = v; }
        __syncthreads();
        const int i0 = 4 * F.wave;
        float acc[4][8];
#pragma unroll
        for (int t = 0; t < 4; ++t)
#pragma unroll
            for (int i = 0; i < 8; ++i) acc[t][i] = 0.f;
        const LAS float* wlb = wl + lane * 4; asm volatile("" : "+v"(wlb));
        const LAS unsigned char* xsb = xs + i0 * 1024 + lane * 16; asm volatile("" : "+v"(xsb));
#pragma unroll 1
        for (int tap = 0; tap < CW; ++tap) {
            const f32x4 w0 = *(const LAS f32x4*)(wlb + tap * 512), w1 = *(const LAS f32x4*)(wlb + tap * 512 + 256);
#pragma unroll
            for (int t = 0; t < 4; ++t) {
                const u32x4 xv = *(const LAS u32x4*)(xsb + (tap + t) * 1024);
                acc[t][0] += w0[0] * bflo(xv.x); acc[t][1] += w0[1] * bfhi(xv.x); acc[t][2] += w0[2] * bflo(xv.y); acc[t][3] += w0[3] * bfhi(xv.y);
                acc[t][4] += w1[0] * bflo(xv.z); acc[t][5] += w1[1] * bfhi(xv.z); acc[t][6] += w1[2] * bflo(xv.w); acc[t][7] += w1[3] * bfhi(xv.w);
            }
        }
        float cb[8], lg[8], lb[8];
        { const f32x4* p0 = (const f32x4*)(a.in[I_CONVB] + c0); const f32x4* p1 = (const f32x4*)(a.in[I_LNG] + c0); const f32x4* p2 = (const f32x4*)(a.in[I_LNB] + c0);
#pragma unroll
          for (int hh = 0; hh < 2; ++hh) { const f32x4 u0 = p0[hh], u1 = p1[hh], u2 = p2[hh];
#pragma unroll
              for (int i = 0; i < 4; ++i) { cb[4 * hh + i] = u0[i]; lg[4 * hh + i] = u1[i]; lb[4 * hh + i] = u2[i]; } } }
#pragma unroll
        for (int t = 0; t < 4; ++t) {
            float s = 0.f;
#pragma unroll
            for (int i = 0; i < 8; ++i) { acc[t][i] += cb[i]; s += acc[t][i]; }
            const float mean = wave_sum(s) * (1.f / CC); float q = 0.f;
#pragma unroll
            for (int i = 0; i < 8; ++i) { acc[t][i] -= mean; q += acc[t][i] * acc[t][i]; }
            const float rstd = 1.0f / sqrtf(wave_sum(q) * (1.f / CC) + EPS);
            float y[8];
#pragma unroll
            for (int i = 0; i < 8; ++i) { const float z = acc[t][i] * rstd * lg[i] + lb[i]; y[i] = z * sigmoidf_(z); }
            u32x4 o; o.x = cvt_pk_bf16(y[0], y[1]); o.y = cvt_pk_bf16(y[2], y[3]); o.z = cvt_pk_bf16(y[4], y[5]); o.w = cvt_pk_bf16(y[6], y[7]);
            *(u32x4*)(CO + (size_t)(b * SEQ + s0 + i0 + t) * CC + c0) = o;
        }
    }
    __syncthreads();
}

constexpr int ROWP = 2080, NJ = 33;
__device__ __forceinline__ unsigned f2ord(float f) { const unsigned b = __float_as_uint(f); return b ^ ((b >> 31) ? 0xffffffffu : 0x80000000u); }
__device__ __forceinline__ int wave_isum(int v) {
#pragma unroll
    for (int o = 1; o < 64; o <<= 1) v += __shfl_xor(v, o);
    return v;
}
__device__ __forceinline__ int wave_isum_dpp(int v) {
    v += __builtin_amdgcn_update_dpp(0, v, 0xB1, 0xF, 0xF, false);
    v += __builtin_amdgcn_update_dpp(0, v, 0x4E, 0xF, 0xF, false);
    v += __builtin_amdgcn_update_dpp(0, v, 0x141, 0xF, 0xF, false);
    v += __builtin_amdgcn_update_dpp(0, v, 0x140, 0xF, 0xF, false);
    return __builtin_amdgcn_readlane(v, 0) + __builtin_amdgcn_readlane(v, 16) + __builtin_amdgcn_readlane(v, 32) + __builtin_amdgcn_readlane(v, 48);
}
__device__ __forceinline__ void p2_indexer_unit(Frame& F, int b, int q16, int flags) {
    unsigned char* ws = F.ws;
    const bf16_t* IQ = wsp<bf16_t>(ws, WS_IQ); const bf16_t* IK = wsp<bf16_t>(ws, WS_IK); const float* IW = wsp<float>(ws, WS_IW); unsigned* MASK = wsp<unsigned>(ws, WS_MASK);
    LAS unsigned* SU = (LAS unsigned*)F.lds;
    const int lane = F.lane, c = lane & 31, hi = lane >> 5, w = F.wave;
    const int nwblk = (q16 >> 1) + 2;
    if (!(flags & 4)) {
        const int tok0 = b * SEQ + 16 * q16;
        bf16x8 af[4][4]; f32x4 wq[4][4];
#pragma unroll
        for (int g = 0; g < 4; ++g) {
            const bf16_t* ap = IQ + (size_t)(tok0 + 4 * g + (c >> 3)) * AW + (c & 7) * IDXD + 8 * hi;
#pragma unroll
            for (int ks = 0; ks < 4; ++ks) af[g][ks] = *(const bf16x8*)(ap + 16 * ks);
#pragma unroll
            for (int q = 0; q < 4; ++q) wq[g][q] = *(const f32x4*)(IW + (size_t)(tok0 + 4 * g + q) * 8 + 4 * hi);
        }
        const int rel0 = NMETA + 16 * q16 + 2 * hi - c;
        const bf16_t* kp = IK + (size_t)b * IKBLK * 2048 + lane * 8;
        LAS unsigned* srow = SU + (2 * hi) * ROWP + c;
        bf16x8 bfr[4], bnx[4];
#pragma unroll
        for (int ks = 0; ks < 4; ++ks) { bfr[ks] = *(const bf16x8*)(kp + (size_t)(w < nwblk ? w : 0) * 2048 + 512 * ks); bnx[ks] = bfr[ks]; }
#pragma unroll
        for (int g = 0; g < 4; ++g) asm volatile("" :: "v"(af[g][0]), "v"(af[g][1]), "v"(af[g][2]), "v"(af[g][3]), "v"(wq[g][0]), "v"(wq[g][1]), "v"(wq[g][2]), "v"(wq[g][3]));
        asm volatile("" :: "v"(bfr[0]), "v"(bfr[1]), "v"(bfr[2]), "v"(bfr[3]));
        for (int blk = w; blk < nwblk; blk += 8) {
            {
                const int bn_ = blk + 8 < nwblk ? blk + 8 : blk;
#pragma unroll
                for (int ks = 0; ks < 4; ++ks) bnx[ks] = *(const bf16x8*)(kp + (size_t)bn_ * 2048 + 512 * ks); }
#pragma unroll
            for (int g = 0; g < 4; ++g) {
                f32x16 acc = {};
#pragma unroll
                for (int ks = 0; ks < 4; ++ks) acc = __builtin_amdgcn_mfma_f32_32x32x16_bf16(af[g][ks], bfr[ks], acc, 0, 0, 0);
                float part[4];
#pragma unroll
                for (int q = 0; q < 4; ++q) { float s = wq[g][q][0] * __builtin_amdgcn_fmed3f(acc[4 * q], 0.f, INFINITY);
#pragma unroll
                    for (int i = 1; i < 4; ++i) s = __builtin_fmaf(wq[g][q][i], __builtin_amdgcn_fmed3f(acc[4 * q + i], 0.f, INFINITY), s);
                    part[q] = s; }
#pragma unroll
                for (int p = 0; p < 2; ++p) {
                    const auto rr = __builtin_amdgcn_permlane32_swap(__float_as_uint(part[p]), __float_as_uint(part[p + 2]), false, false);
                    const float sc = __uint_as_float(rr[0]) + __uint_as_float(rr[1]);
                    srow[(4 * g + p) * ROWP + 32 * blk] = (32 * blk <= rel0 + 4 * g + p) ? f2ord(sc) : 0u; }
            }
#pragma unroll
            for (int ks = 0; ks < 4; ++ks) bfr[ks] = bnx[ks];
        }
    }
    __syncthreads();
    if (!(flags & 8)) {
        const int nj = (nwblk + 1) >> 1, klim = 32 * nwblk;
        unsigned U[NJ][2];
#pragma unroll
        for (int j = 0; j < NJ; ++j) {
            if (j < nj) { const int key = 64 * j + lane;
#pragma unroll
                for (int p = 0; p < 2; ++p) U[j][p] = (key < klim) ? SU[(2 * w + p) * ROWP + key] : 0u; }
            else { U[j][0] = 0u; U[j][1] = 0u; }
        }
        const int tokb = b * SEQ + 16 * q16 + 2 * w;
        unsigned lo[2], hb[2], thr[2], veq[2]; int chi[2], need[2]; bool done[2];
#pragma unroll
        for (int p = 0; p < 2; ++p) { lo[p] = 1u; hb[p] = 0xffffffffu; chi[p] = 0; need[p] = 0; veq[p] = 0u; thr[p] = 1u; done[p] = (NMETA + 16 * q16 + 2 * w + p + 1 <= TOPK); }
        for (int it = 0; it < 34; ++it) {
            if (done[0] && done[1]) break;
            unsigned mid[2]; int cl[2];
#pragma unroll
            for (int p = 0; p < 2; ++p) { mid[p] = lo[p] + ((hb[p] - lo[p]) >> 1); cl[p] = 0; }
#pragma unroll
            for (int g = 0; g < 3; ++g) if (11 * g < nj) {
#pragma unroll
                for (int jj = 0; jj < 11; ++jj)
#pragma unroll
                    for (int p = 0; p < 2; ++p) cl[p] += (U[11 * g + jj][p] >= mid[p]) ? 1 : 0; }
            const int tot = wave_isum_dpp(cl[0] | (cl[1] << 16));
            int cnt[2] = {tot & 0xffff, tot >> 16};
#ifdef DBG_CHECK_DPP
            if (wave_isum(cl[0]) != cnt[0] || wave_isum(cl[1]) != cnt[1]) __hip_atomic_store(wsp<unsigned>(ws, WS_CTL) + 3, 1u, RLX_AGENT);
#endif
#pragma unroll
            for (int p = 0; p < 2; ++p) {
                const int ct = cnt[p];
                if (!done[p]) {
                    if (ct == TOPK) { done[p] = true; thr[p] = mid[p]; need[p] = 0; }
                    else if (ct > TOPK) lo[p] = mid[p];
                    else { hb[p] = mid[p]; chi[p] = ct; }
                    if (!done[p] && hb[p] - lo[p] == 1u) { done[p] = true; thr[p] = hb[p]; veq[p] = lo[p]; need[p] = TOPK - chi[p]; }
                }
            }
        }
#pragma unroll
        for (int p = 0; p < 2; ++p) {
            int run = 0;
            unsigned long long* mrow = (unsigned long long*)(MASK + (size_t)(tokb + p) * MSTR);
#pragma unroll
            for (int j = 0; j < NJ; ++j) if (j < nj) {
                const unsigned u = U[j][p];
                const bool eq = (need[p] > 0) && (u == veq[p]);
                const unsigned long long em = __ballot(eq);
                const int rank = run + (int)__builtin_amdgcn_mbcnt_hi((unsigned)(em >> 32), __builtin_amdgcn_mbcnt_lo((unsigned)em, 0u));
                const bool take = (u >= thr[p]) || (eq && rank < need[p]);
                run += __popcll(em);
                const unsigned long long sm = __ballot(take);
                if (lane == 0) mrow[j] = sm;
            }
        }
    }
    __syncthreads();
}
__device__ __forceinline__ void p2_indexer(Frame& F, int flags, int half) {
    for (int i = F.bid; i < 256; i += F.G) { const int b = i >> 5, j = 2 * (i & 31);
        if (half == 0) { p2_indexer_unit(F, b, j, flags); p2_indexer_unit(F, b, 127 - j, flags); }
        else { p2_indexer_unit(F, b, j + 1, flags); p2_indexer_unit(F, b, 126 - j, flags); } }
}

__device__ const unsigned char T5B[128] = {0, 1, 2, 3, 4, 5, 6, 7, 8, 9, 10, 11, 12, 13, 14, 15, 16, 16, 16, 17, 17, 18, 18, 18, 19, 19, 19, 20, 20, 20, 20, 21, 21, 21, 21, 22, 22, 22, 22, 22, 23, 23, 23, 23, 23, 23, 24, 24, 24, 24, 24, 24, 25, 25, 25, 25, 25, 25, 25, 26, 26, 26, 26, 26, 26, 26, 26, 27, 27, 27, 27, 27, 27, 27, 27, 27, 27, 28, 28, 28, 28, 28, 28, 28, 28, 28, 28, 29, 29, 29, 29, 29, 29, 29, 29, 29, 29, 29, 29, 30, 30, 30, 30, 30, 30, 30, 30, 30, 30, 30, 30, 30, 30, 31, 31, 31, 31, 31, 31, 31, 31, 31, 31, 31, 31, 31, 31, 31};
constexpr int TBS = 132;
__device__ __forceinline__ int crow(int r, int hi) { return (r & 3) + 8 * (r >> 2) + 4 * hi; }
constexpr int KPITCH = 144, VPITCH = 136;
constexpr int AT_K = 0, AT_V = AT_K + 2 * 64 * KPITCH, AT_TB = AT_V + 2 * 64 * VPITCH, AT_SC = AT_TB + NH * TBS * 4, AT_END = AT_SC + NWAVES * 128;
static_assert(AT_END <= RING_BYTES, "attention LDS map");
__device__ __forceinline__ void p3_attn_unit(Frame& F, int b, int h, int Q) {
    unsigned char* ws = F.ws;
    const bf16_t* Qm = wsp<bf16_t>(ws, WS_Q); const bf16_t* KB = wsp<bf16_t>(ws, WS_KB); const bf16_t* VT = wsp<bf16_t>(ws, WS_VT); const unsigned* MASK = wsp<unsigned>(ws, WS_MASK); bf16_t* AO = wsp<bf16_t>(ws, WS_AO);
    LAS unsigned char* lds = F.lds;
    const LAS float* tbh = (const LAS float*)(lds + AT_TB) + h * TBS;
    LAS float* sc = (LAS float*)(lds + AT_SC) + F.wave * 32;
    const int tid = F.tid, lane = F.lane, c = lane & 31, hi = lane >> 5, w = F.wave;
    const int qb32 = 8 * Q + w, tokq = b * SEQ + 32 * qb32 + c, posq = NMETA + 32 * qb32 + c;
    const int ktmax = (47 + 32 * qb32) >> 6, NT = 4 * Q + 5;
    bf16x8 qf[4];
#pragma unroll
    for (int ks = 0; ks < 4; ++ks) qf[ks] = *(const bf16x8*)(Qm + (size_t)tokq * AW + h * HD + 16 * ks + 8 * hi);
    const unsigned long long* mrow = (const unsigned long long*)(MASK + (size_t)tokq * MSTR);
    const int srow = tid >> 3, piece = tid & 7;
    const bf16_t* kg = KB + (size_t)(b * TT + srow) * AW + h * HD + piece * 8;
    const bf16_t* vg = VT + ((size_t)b * AW + h * HD + srow) * TP + piece * 8;
    LAS unsigned char* kl = lds + AT_K + srow * KPITCH + piece * 16;
    LAS unsigned char* vl = lds + AT_V + srow * VPITCH + piece * 16;
    const LAS unsigned char* kfb = lds + AT_K + c * KPITCH + 16 * hi;
    const LAS unsigned char* vfb = lds + AT_V + c * VPITCH + 8 * hi;
    const unsigned NEGB = 0xff800000u;
    const float bfar = tbh[128];
    float m_abs = 0.f; bool has = false;
    f32x16 O0 = {}, O1 = {}, LS = {}, CI;
#pragma unroll
    for (int r = 0; r < 16; ++r) CI[r] = bfar;
    const bf16x8 ones = __builtin_bit_cast(bf16x8, ((u32x4){0x3f803f80u, 0x3f803f80u, 0x3f803f80u, 0x3f803f80u}));
    u32x4 kr = *(const u32x4*)kg, vr = *(const u32x4*)vg;
    unsigned long long mwn = mrow[0];
    *(LAS u32x4*)kl = kr; *(LAS u32x2*)vl = (u32x2){vr.x, vr.y}; *(LAS u32x2*)(vl + 8) = (u32x2){vr.z, vr.w};
    __syncthreads();
    for (int kt = 0; kt < NT; ++kt) {
        const int buf = kt & 1;
        const unsigned long long mw = mwn;
        if (kt + 1 < NT) { kr = *(const u32x4*)(kg + (size_t)(kt + 1) * 64 * AW); vr = *(const u32x4*)(vg + (kt + 1) * 64); if (kt + 1 <= ktmax) mwn = mrow[kt + 1]; }
        if (kt <= ktmax) {
            const LAS unsigned char* kp = kfb + buf * 64 * KPITCH;
            f32x16 S0 = CI, S1 = CI;
#pragma unroll
            for (int ks = 0; ks < 4; ++ks) {
                const bf16x8 k0 = *(const LAS bf16x8*)(kp + ks * 32), k1 = *(const LAS bf16x8*)(kp + 32 * KPITCH + ks * 32);
                S0 = __builtin_amdgcn_mfma_f32_32x32x16_bf16(k0, qf[ks], S0, 0, 0, 0);
                S1 = __builtin_amdgcn_mfma_f32_32x32x16_bf16(k1, qf[ks], S1, 0, 0, 0);
            }
            const int mw0 = (int)((unsigned)mw >> (4 * hi)), mw1 = (int)((unsigned)(mw >> 32) >> (4 * hi));
            const bool far = (256 * Q + 32 * w - 64 * kt) >= 175;
            if (!far) {
                const int d0 = posq - 64 * kt - 4 * hi;
#pragma unroll
                for (int r = 0; r < 16; ++r) { const int ko = (r & 3) + 8 * (r >> 2);
                    int da = d0 - ko, db = d0 - 32 - ko; da = da < 0 ? 0 : (da > 128 ? 128 : da); db = db < 0 ? 0 : (db > 128 ? 128 : db);
                    S0[r] += tbh[da] - bfar; S1[r] += tbh[db] - bfar; }
            }
            float tmax = -INFINITY;
#pragma unroll
            for (int r = 0; r < 16; ++r) { const int ko = (r & 3) + 8 * (r >> 2);
                const unsigned t0 = (unsigned)__builtin_amdgcn_sbfe(mw0, ko, 1), t1 = (unsigned)__builtin_amdgcn_sbfe(mw1, ko, 1);
                S0[r] = __uint_as_float((__float_as_uint(S0[r]) & t0) | (NEGB & ~t0)); S1[r] = __uint_as_float((__float_as_uint(S1[r]) & t1) | (NEGB & ~t1));
                tmax = fmaxf(tmax, fmaxf(S0[r], S1[r])); }
            tmax = fmaxf(tmax, __shfl_xor(tmax, 32));
            if (__any(tmax > 8.0f || (!has && tmax > -INFINITY))) {
                const bool upd = tmax > -INFINITY && (!has || tmax > 0.f);
                const float dl = upd ? tmax : 0.f;
                const float alpha = has ? __builtin_amdgcn_exp2f(-dl) : 1.0f;
                m_abs += dl; has = has || upd;
#pragma unroll
                for (int r = 0; r < 16; ++r) { S0[r] -= dl; S1[r] -= dl; CI[r] = bfar - m_abs; }
                if (hi == 0) sc[c] = alpha;
                LDS_WAIT(); asm volatile("" ::: "memory");
#pragma unroll
                for (int r = 0; r < 16; ++r) { const float f = sc[crow(r, hi)]; O0[r] *= f; O1[r] *= f; LS[r] *= f; }
                LDS_WAIT(); asm volatile("" ::: "memory");
            }
#pragma unroll
            for (int r = 0; r < 16; ++r) { S0[r] = __builtin_amdgcn_exp2f(S0[r]); S1[r] = __builtin_amdgcn_exp2f(S1[r]); }
            const LAS unsigned char* vp = vfb + buf * 64 * VPITCH;
#pragma unroll
            for (int s2 = 0; s2 < 4; ++s2) {
                u32x4 pw;
                if (s2 < 2) { const int o = 8 * (s2 & 1); pw.x = cvt_pk_bf16(S0[o + 0], S0[o + 1]); pw.y = cvt_pk_bf16(S0[o + 2], S0[o + 3]); pw.z = cvt_pk_bf16(S0[o + 4], S0[o + 5]); pw.w = cvt_pk_bf16(S0[o + 6], S0[o + 7]); }
                else { const int o = 8 * (s2 & 1); pw.x = cvt_pk_bf16(S1[o + 0], S1[o + 1]); pw.y = cvt_pk_bf16(S1[o + 2], S1[o + 3]); pw.z = cvt_pk_bf16(S1[o + 4], S1[o + 5]); pw.w = cvt_pk_bf16(S1[o + 6], S1[o + 7]); }
                const bf16x8 pf = __builtin_bit_cast(bf16x8, pw);
                const u32x2 a0 = *(const LAS u32x2*)(vp + s2 * 32), a1 = *(const LAS u32x2*)(vp + s2 * 32 + 16);
                const u32x2 b0 = *(const LAS u32x2*)(vp + 32 * VPITCH + s2 * 32), b1 = *(const LAS u32x2*)(vp + 32 * VPITCH + s2 * 32 + 16);
                const bf16x8 v0 = __builtin_bit_cast(bf16x8, ((u32x4){a0.x, a0.y, a1.x, a1.y})), v1 = __builtin_bit_cast(bf16x8, ((u32x4){b0.x, b0.y, b1.x, b1.y}));
                O0 = __builtin_amdgcn_mfma_f32_32x32x16_bf16(pf, v0, O0, 0, 0, 0);
                O1 = __builtin_amdgcn_mfma_f32_32x32x16_bf16(pf, v1, O1, 0, 0, 0);
                LS = __builtin_amdgcn_mfma_f32_32x32x16_bf16(pf, ones, LS, 0, 0, 0);
            }
        }
        if (kt + 1 < NT) { LAS unsigned char* k2 = kl + (buf ^ 1) * 64 * KPITCH; LAS unsigned char* v2 = vl + (buf ^ 1) * 64 * VPITCH;
            *(LAS u32x4*)k2 = kr; *(LAS u32x2*)v2 = (u32x2){vr.x, vr.y}; *(LAS u32x2*)(v2 + 8) = (u32x2){vr.z, vr.w}; }
        __syncthreads();
    }
    bf16_t* ob = AO + (size_t)(b * SEQ + 32 * qb32) * AW + h * HD + c;
#pragma unroll
    for (int r = 0; r < 16; ++r) { const int qr = crow(r, hi); const float f = __builtin_amdgcn_rcpf(LS[r]);
        const float a0 = O0[r] * f, a1 = O1[r] * f, b0 = __shfl_xor(a0, 1), b1 = __shfl_xor(a1, 1);
        if ((c & 1) == 0) { *(unsigned*)(ob + (size_t)qr * AW) = cvt_pk_bf16(a0, b0); *(unsigned*)(ob + (size_t)qr * AW + 32) = cvt_pk_bf16(a1, b1); } }
}
__device__ __forceinline__ void p3_attn(Frame& F, const Args& a) {
    LAS float* tb = (LAS float*)(F.lds + AT_TB);
    __syncthreads();
    for (int idx = F.tid; idx < NH * 129; idx += NTHREADS) { const int h = idx / 129, d = idx % 129; const int bk = d < 128 ? (int)T5B[d] : 31; tb[h * TBS + d] = a.in[I_RELB][bk * NH + h] * LOG2E; }
    __syncthreads();
    for (int i = F.bid; i < 256; i += F.G) { const int bh = i >> 2, j = i & 3; p3_attn_unit(F, bh >> 3, bh & 7, j); p3_attn_unit(F, bh >> 3, bh & 7, 7 - j); }
    __syncthreads();
}

constexpr int WLP = 2064;
constexpr int P6_WHI = 0, P6_WLO = NE * WLP, P6_PART = 2 * NE * WLP, P6_SSP = P6_PART + 2 * 64 * 33 * 4, P6_CNT = P6_SSP + 2 * 64 * 4, P6_END = P6_CNT + 256;
static_assert(P6_END <= LDSX_OFF, "router LDS map");
__device__ __forceinline__ void p6_router(Frame& F, const Args& a) {
    unsigned char* ws = F.ws;
    const float* H1 = wsp<float>(ws, WS_H1); bf16_t* HN = wsp<bf16_t>(ws, WS_XN);
    const float* gf = a.in[I_NFFN]; const float* brt = a.in[I_BR];
    int* TE = wsp<int>(ws, WS_TE); int* TPs = wsp<int>(ws, WS_TP); int* LIST = wsp<int>(ws, WS_LIST); float* LG = wsp<float>(ws, WS_LG); float* RG = wsp<float>(ws, WS_RG);
    unsigned* ecnt = wsp<unsigned>(ws, WS_CTL) + CW_ECNT;
    LAS unsigned char* lds = F.lds;
    LAS float* part = (LAS float*)(lds + P6_PART);
    LAS float* ssp = (LAS float*)(lds + P6_SSP);
    LAS int* lcnt = (LAS int*)(lds + P6_CNT);
    LAS int* lbase = lcnt + 32;
    const int lane = F.lane, w = F.wave, tk = lane & 15, kq = lane >> 4;
    __syncthreads();
    { const unsigned char* src = ws + WS_WRT;
      for (int p = F.tid; p < 2 * NE * 128; p += NTHREADS) { const int arr = p >> 12, row = (p >> 7) & 31, c16 = p & 127;
          *(LAS u32x4*)(lds + arr * (NE * WLP) + row * WLP + c16 * 16) = *(const u32x4*)(src + (size_t)arr * NE * DM * 2 + (size_t)row * DM * 2 + c16 * 16); } }
    for (int tb = F.bid; tb < NTOK / 64; tb += F.G) {
        const int t0 = tb * 64;
        __syncthreads();
        if (F.tid < 32) lcnt[F.tid] = 0;
        {
            const int tg = w & 3, kh = w >> 2, tok = t0 + 16 * tg + tk;
            const float* xr = H1 + (size_t)tok * DM + 512 * kh + 8 * kq; const float* gr = gf + 512 * kh + 8 * kq;
            bf16_t* hr = HN + (size_t)tok * DM + 512 * kh + 8 * kq;
            const LAS unsigned char* wl = lds + tk * WLP + (512 * kh + 8 * kq) * 2;
            f32x4 xa[16], xb[16];
#pragma unroll
            for (int ks = 0; ks < 16; ++ks) { xa[ks] = *(const f32x4*)(xr + 32 * ks); xb[ks] = *(const f32x4*)(xr + 32 * ks + 4); }
            f32x4 acc0 = {0.f, 0.f, 0.f, 0.f}, acc1 = acc0; float ss = 0.f;
#pragma unroll
            for (int ks = 0; ks < 16; ++ks) {
                const f32x4 g0 = *(const f32x4*)(gr + 32 * ks), g1 = *(const f32x4*)(gr + 32 * ks + 4);
                const f32x4 x0 = xa[ks], x1 = xb[ks];
                u32x4 hn; hn.x = cvt_pk_bf16(x0[0] * g0[0], x0[1] * g0[1]); hn.y = cvt_pk_bf16(x0[2] * g0[2], x0[3] * g0[3]); hn.z = cvt_pk_bf16(x1[0] * g1[0], x1[1] * g1[1]); hn.w = cvt_pk_bf16(x1[2] * g1[2], x1[3] * g1[3]);
                *(u32x4*)(hr + 32 * ks) = hn;
                ss += (x0[0] * x0[0] + x0[1] * x0[1]) + (x0[2] * x0[2] + x0[3] * x0[3]) + (x1[0] * x1[0] + x1[1] * x1[1]) + (x1[2] * x1[2] + x1[3] * x1[3]);
                u32x4 xh; xh.x = cvt_pk_bf16(x0[0], x0[1]); xh.y = cvt_pk_bf16(x0[2], x0[3]); xh.z = cvt_pk_bf16(x1[0], x1[1]); xh.w = cvt_pk_bf16(x1[2], x1[3]);
                u32x4 xl; xl.x = cvt_pk_bf16(x0[0] - bflo(xh.x), x0[1] - bfhi(xh.x)); xl.y = cvt_pk_bf16(x0[2] - bflo(xh.y), x0[3] - bfhi(xh.y));
                          xl.z = cvt_pk_bf16(x1[0] - bflo(xh.z), x1[1] - bfhi(xh.z)); xl.w = cvt_pk_bf16(x1[2] - bflo(xh.w), x1[3] - bfhi(xh.w));
                const bf16x8 fxh = __builtin_bit_cast(bf16x8, xh), fxl = __builtin_bit_cast(bf16x8, xl);
                const bf16x8 wh0 = *(const LAS bf16x8*)(wl + P6_WHI + ks * 64), wh1 = *(const LAS bf16x8*)(wl + P6_WHI + 16 * WLP + ks * 64);
                const bf16x8 wl0 = *(const LAS bf16x8*)(wl + P6_WLO + ks * 64), wl1 = *(const LAS bf16x8*)(wl + P6_WLO + 16 * WLP + ks * 64);
                acc0 = __builtin_amdgcn_mfma_f32_16x16x32_bf16(wh0, fxh, acc0, 0, 0, 0); acc1 = __builtin_amdgcn_mfma_f32_16x16x32_bf16(wh1, fxh, acc1, 0, 0, 0);
                acc0 = __builtin_amdgcn_mfma_f32_16x16x32_bf16(wl0, fxh, acc0, 0, 0, 0); acc1 = __builtin_amdgcn_mfma_f32_16x16x32_bf16(wl1, fxh, acc1, 0, 0, 0);
                acc0 = __builtin_amdgcn_mfma_f32_16x16x32_bf16(wh0, fxl, acc0, 0, 0, 0); acc1 = __builtin_amdgcn_mfma_f32_16x16x32_bf16(wh1, fxl, acc1, 0, 0, 0);
            }
            ss += __shfl_xor(ss, 16); ss += __shfl_xor(ss, 32);
            LAS float* pp = part + ((kh * 64) + 16 * tg + tk) * 33 + 4 * kq;
#pragma unroll
            for (int r = 0; r < 4; ++r) { pp[r] = acc0[r]; pp[16 + r] = acc1[r]; }
            if (kq == 0) ssp[kh * 64 + 16 * tg + tk] = ss;
        }
        __syncthreads();
        if (w == 0) {
            const float rinv = 1.0f / sqrtf((ssp[lane] + ssp[64 + lane]) * (1.f / DM) + EPS);
            float lg[NE];
#pragma unroll
            for (int e = 0; e < NE; ++e) lg[e] = (part[lane * 33 + e] + part[(64 + lane) * 33 + e]) * rinv + brt[e];
            int sel[4]; float val[4];
#pragma unroll
            for (int j = 0; j < 4; ++j) { float best = -INFINITY; int bi = 0;
#pragma unroll
                for (int e = 0; e < NE; ++e) { const bool tk_ = lg[e] > best; best = tk_ ? lg[e] : best; bi = tk_ ? e : bi; }
                sel[j] = bi; val[j] = best;
#pragma unroll
                for (int e = 0; e < NE; ++e) lg[e] = (e == bi) ? -INFINITY : lg[e]; }
            float den = 0.f, ex[4];
#pragma unroll
            for (int j = 0; j < 4; ++j) { ex[j] = __expf(val[j] - val[0]); den += ex[j]; }
            int slot[4];
#pragma unroll
            for (int j = 0; j < 4; ++j) slot[j] = __hip_atomic_fetch_add(&lcnt[sel[j]], 1, __ATOMIC_RELAXED, __HIP_MEMORY_SCOPE_WORKGROUP);
            LDS_WAIT();
            if (lane < 32) { const int n = lcnt[lane]; lbase[lane] = n ? (int)__hip_atomic_fetch_add(ecnt + 64 * lane, (unsigned)n, RLX_AGENT) : 0; }
            LDS_WAIT(); asm volatile("" ::: "memory");
            const int t = t0 + lane;
#pragma unroll
            for (int j = 0; j < 4; ++j) { const int e = sel[j], pos = lbase[e] + slot[j]; const float g = ex[j] / den;
                TE[t * 4 + j] = e; TPs[t * 4 + j] = pos; LIST[(size_t)e * NTOK + pos] = t; LG[(size_t)e * NTOK + pos] = g; RG[(size_t)e * NTOK + pos] = rinv; }
        }
    }
    __syncthreads();
}
__device__ __forceinline__ void moe_tables(Frame& F, LAS int* cnt, LAS int* tbase) {
    const unsigned* ecnt = wsp<unsigned>(F.ws, WS_CTL) + CW_ECNT;
    __syncthreads();
    if (F.tid < NE) cnt[F.tid] = (int)__hip_atomic_load(ecnt + 64 * F.tid, RLX_AGENT);
    __syncthreads();
    if (F.tid == 0) { int s = 0; for (int e = 0; e < NE; ++e) { tbase[e] = s; s += (cnt[e] + 255) >> 8; } tbase[NE] = s; }
    __syncthreads();
}

__device__ __forceinline__ void p9_final(Frame& F, const Args& a, const LAS int* tbase) {
    unsigned char* ws = F.ws;
    const float* H1 = wsp<float>(ws, WS_H1); float* OUT = a.out; const bf16_t* YP = wsp<bf16_t>(ws, WS_YP); const int* TE = wsp<int>(ws, WS_TE); const int* TPs = wsp<int>(ws, WS_TP); const float* gf = a.in[I_NFIN];
    const int gw = F.bid * NWAVES + F.wave, NGW = F.G * NWAVES, lane = F.lane;
    const f32x4* gr = (const f32x4*)gf + lane;
    f32x4 gg[4];
#pragma unroll
    for (int j = 0; j < 4; ++j) gg[j] = gr[64 * j];
#ifdef DBG_CHECK_DPP
    if (__hip_atomic_load(wsp<unsigned>(ws, WS_CTL) + 3, RLX_AGENT) != 0u) { const float qn = __builtin_nanf("");
#pragma unroll
        for (int j = 0; j < 4; ++j) gg[j] = (f32x4){qn, qn, qn, qn}; }
#endif
    for (int base = 0; base < NTOK; base += 8 * NGW) {
        int myrow = 0;
        { const int i = lane >> 2, j = lane & 3, t = base + gw + NGW * i; if (lane < 32 && t < NTOK) { const int e = TE[t * 4 + j], pos = TPs[t * 4 + j]; myrow = tbase[e] * 256 + pos; } }
        f32x4 va[4], vb[4]; u32x2 ya[4][4], yb[4][4];
#define P9_LOAD(i, V, Y) do { const int t_ = base + gw + NGW * (i); if (t_ < NTOK) { const f32x4* xr_ = (const f32x4*)(H1 + (size_t)t_ * DM) + lane; \
            _Pragma("unroll") for (int j_ = 0; j_ < 4; ++j_) V[j_] = xr_[64 * j_]; \
            _Pragma("unroll") for (int q_ = 0; q_ < 4; ++q_) { const int row_ = __builtin_amdgcn_readlane(myrow, 4 * (i) + q_); const u32x2* yr_ = (const u32x2*)(YP + (size_t)row_ * DM) + lane; \
                _Pragma("unroll") for (int j_ = 0; j_ < 4; ++j_) Y[q_][j_] = yr_[64 * j_]; } } } while (0)
#define P9_PROC(i, V, Y) do { const int t_ = base + gw + NGW * (i); if (t_ < NTOK) { \
            _Pragma("unroll") for (int q_ = 0; q_ < 4; ++q_) _Pragma("unroll") for (int j_ = 0; j_ < 4; ++j_) { const u32x2 y_ = Y[q_][j_]; V[j_].x += bflo(y_.x); V[j_].y += bfhi(y_.x); V[j_].z += bflo(y_.y); V[j_].w += bfhi(y_.y); } \
            float s_ = 0.f; _Pragma("unroll") for (int j_ = 0; j_ < 4; ++j_) s_ += (V[j_].x * V[j_].x + V[j_].y * V[j_].y) + (V[j_].z * V[j_].z + V[j_].w * V[j_].w); \
            const float r_ = 1.0f / sqrtf(wave_sum(s_) * (1.f / DM) + EPS); f32x4* xo_ = (f32x4*)(OUT + (size_t)t_ * DM) + lane; \
            _Pragma("unroll") for (int j_ = 0; j_ < 4; ++j_) xo_[64 * j_] = (f32x4){V[j_].x * r_ * gg[j_].x, V[j_].y * r_ * gg[j_].y, V[j_].z * r_ * gg[j_].z, V[j_].w * r_ * gg[j_].w}; } } while (0)
        P9_LOAD(0, va, ya);
#pragma unroll
        for (int i = 0; i < 8; i += 2) {
            P9_LOAD(i + 1, vb, yb);
            P9_PROC(i, va, ya);
            if (i + 2 < 8) P9_LOAD(i + 2, va, ya);
            P9_PROC(i + 1, vb, yb);
        }
#undef P9_LOAD
#undef P9_PROC
    }
}

constexpr int N_PHASES = 10;
__global__ void __launch_bounds__(NTHREADS, 2) fwd_kernel(Args args) {
    extern __shared__ __attribute__((aligned(16))) unsigned char lds_raw[];
    Frame F;
    F.lds = (LAS unsigned char*)lds_raw; F.ws = args.ws;
    F.tid = threadIdx.x; F.lane = F.tid & 63; F.wave = __builtin_amdgcn_readfirstlane(F.tid >> 6);
    F.G = gridDim.x; F.bid = blockIdx.x;
    volatile LAS unsigned* MISC = (volatile LAS unsigned*)(F.lds + MISC_OFF);
    if (F.tid < 32) MISC[F.tid] = 0u;
    __syncthreads();
    unsigned* ctl = wsp<unsigned>(args.ws, WS_CTL);
    const int lo = args.ph_lo, hi = args.ph_hi;
    const bool multi = (hi - lo) > 1;
    XcdBarrier bar; bar.bar = ctl + CW_BAR; bar.x = 0; bar.st = nullptr;
    if (multi) bar = xcd_barrier_post(ctl + CW_BAR, MISC + 8);
#ifndef PHASE_MASK
#define PHASE_MASK 0x3ff
#endif
#define IN(k) (((PHASE_MASK >> (k)) & 1) && lo <= (k) && (k) < hi)
#define SEAM(k) do { if (IN(k) && IN((k) + 1)) xcd_barrier(bar); } while (0)
    LAS int* l_cnt = (LAS int*)(F.lds + LDSX_OFF); LAS int* l_tbase = l_cnt + 64;
    const MoeTables MT{l_cnt, l_tbase};

    if (IN(0)) { p0_prologue(F, args, 0); } SEAM(0);
    if (IN(1)) {
        PlainSched S; S.init(args.ws, WS_XN, WS_WIN, NTOK, 5120, DM, F.G, F.bid);
        EpiInProj E{args.ws, args.in[I_BGATE]};
        if (!(args.flags & 64)) pg8::gemm_phase<EpiInProj, PlainSched>(F.lds, DM, S, E);
        if (!(args.flags & 128)) p1_thin(F, args.flags);
    } SEAM(1);
    if (IN(2)) {
        const int cvt_slot = (F.bid >> 3) % 3;
        if (cvt_slot == 0 && !(args.flags & 1024)) { p0_prologue(F, args, 1); __syncthreads(); }
        if (!(args.flags & 1)) p2_conv(F, args);
        if (!(args.flags & 2)) p2_indexer(F, args.flags, 0);
        if (cvt_slot == 1 && !(args.flags & 1024)) { __syncthreads(); p0_prologue(F, args, 1); __syncthreads(); }
        if (!(args.flags & 2)) p2_indexer(F, args.flags, 1);
        if (cvt_slot == 2 && !(args.flags & 1024)) { __syncthreads(); p0_prologue(F, args, 1); }
    } SEAM(2);
    if (IN(3)) { p3_attn(F, args); } SEAM(3);
    if (IN(4)) {
        MergeSched S{(const char*)args.ws, F.G, F.bid}; EpiMerge E{args.ws};
        pg8::gemm_phase<EpiMerge, MergeSched>(F.lds, 512, S, E);
    } SEAM(4);
    if (IN(5)) {
        PlainSched S; S.init(args.ws, WS_MG, WS_WOUT, NTOK, DM, DM, F.G, F.bid);
        EpiResid E{args.in[I_X], wsp<float>(args.ws, WS_H1)};
        pg8::gemm_phase<EpiResid, PlainSched>(F.lds, DM, S, E);
    } SEAM(5);
    if (IN(6)) { p6_router(F, args); } SEAM(6);
    if (IN(7)) {
        moe_tables(F, l_cnt, l_tbase);
        MoeSched<8, true> S{(const char*)args.ws, MT, F.G, F.bid, l_tbase[NE] * 8};
        EpiSwiglu E{args.ws, args.in[I_BUG], MT};
        pg8::gemm_phase<EpiSwiglu, MoeSched<8, true>>(F.lds, DM, S, E);
    } SEAM(7);
    if (IN(8)) {
        moe_tables(F, l_cnt, l_tbase);
        MoeSched<4, false> S{(const char*)args.ws, MT, F.G, F.bid, l_tbase[NE] * 4};
        EpiDown E{args.ws, args.in[I_BD], MT};
        pg8::gemm_phase<EpiDown, MoeSched<4, false>>(F.lds, DFF, S, E);
    } SEAM(8);
    if (IN(9)) { moe_tables(F, l_cnt, l_tbase); p9_final(F, args, l_tbase); }
#undef IN
#undef SEAM
}

#ifdef DBG_HASH_OFF
__global__ void dbg_hash(const unsigned* __restrict__ buf, size_t nwords, unsigned* acc) {
    unsigned h = 0u;
    for (size_t i = (size_t)blockIdx.x * blockDim.x + threadIdx.x; i < nwords; i += (size_t)gridDim.x * blockDim.x) h += (buf[i] ^ (unsigned)(i * 2654435761u)) * 2246822519u + (unsigned)i;
#pragma unroll
    for (int o = 1; o < 64; o <<= 1) h += __shfl_xor(h, o);
    if ((threadIdx.x & 63) == 0) atomicAdd(acc, h);
}
__global__ void dbg_fill(float* out, size_t n, const unsigned* acc) {
    const unsigned h = *acc; const float v = (float)((h >> 7) & 0xffffu) * (1.0f / 4096.0f) + 1.0f;
    for (size_t i = (size_t)blockIdx.x * blockDim.x + threadIdx.x; i < n; i += (size_t)gridDim.x * blockDim.x) out[i] = v;
}
#endif

extern "C" void kernel_launch(void* const* d_in, const int* in_sizes, int n_in, void* d_out, int out_size, void* d_ws, size_t ws_size, hipStream_t stream) {
    static int grid = 0;
    if (grid == 0) {
        if (n_in != 21 || out_size != NTOK * DM || ws_size < WS_END) { fprintf(stderr, "kernel_launch: unexpected shapes (n_in %d, out %d, ws %zu < %zu)\n", n_in, out_size, ws_size, (size_t)WS_END); grid = -1; return; }
        int dev = 0, cus = 0, per_cu = 0;
        if (hipGetDevice(&dev) != hipSuccess || hipDeviceGetAttribute(&cus, hipDeviceAttributeMultiprocessorCount, dev) != hipSuccess) { grid = -1; return; }
        if (hipFuncSetAttribute((const void*)fwd_kernel, hipFuncAttributeMaxDynamicSharedMemorySize, LDS_BYTES) != hipSuccess) { fprintf(stderr, "kernel_launch: hipFuncSetAttribute failed\n"); grid = -1; return; }
        if (hipOccupancyMaxActiveBlocksPerMultiprocessor(&per_cu, (const void*)fwd_kernel, NTHREADS, LDS_BYTES) != hipSuccess || per_cu < 1) { fprintf(stderr, "kernel_launch: occupancy query says %d\n", per_cu); }
        (void)hipGetLastError();
        grid = cus;
    }
    if (grid < 0) return;
    (void)hipMemsetAsync((char*)d_ws + WS_CTL, 0, CTL_ZERO_BYTES, stream);
    Args a{};
    for (int i = 0; i < 21; ++i) a.in[i] = (const float*)d_in[i];
    a.out = (float*)d_out; a.ws = (unsigned char*)d_ws;
#if MK_N_LAUNCHES == 1
    a.ph_lo = 0; a.ph_hi = N_PHASES;
    hipLaunchKernelGGL(fwd_kernel, dim3(grid), dim3(NTHREADS), LDS_BYTES, stream, a);
#else
#ifndef DBG_LAST_PHASE
#define DBG_LAST_PHASE (N_PHASES - 1)
#endif
#ifndef DBG_DUP_MASK
#define DBG_DUP_MASK 0
#endif
#ifndef DBG_DUP_FLAGS
#define DBG_DUP_FLAGS 0
#endif
    for (int p = 0; p <= DBG_LAST_PHASE; ++p) { a.ph_lo = p; a.ph_hi = p + 1;
        const int nrep = ((DBG_DUP_MASK >> p) & 1) ? 2 : 1;
        for (int rep = 0; rep < nrep; ++rep) { a.flags = (nrep == 2 && rep == 0) ? DBG_DUP_FLAGS : 0; if (rep == 1 && p == 6) (void)hipMemsetAsync((char*)d_ws + WS_CTL, 0, CTL_ZERO_BYTES, stream);
            hipLaunchKernelGGL(fwd_kernel, dim3(grid), dim3(NTHREADS), LDS_BYTES, stream, a); } }
#ifdef DBG_HASH_OFF
    { const unsigned* hb = DBG_HASH_OFF == 0 ? (const unsigned*)d_out : (const unsigned*)((char*)d_ws + DBG_HASH_OFF);
      hipLaunchKernelGGL(dbg_hash, dim3(1024), dim3(256), 0, stream, hb, (size_t)(DBG_HASH_BYTES) / 4, (unsigned*)d_ws + 2);
      hipLaunchKernelGGL(dbg_fill, dim3(1024), dim3(256), 0, stream, (float*)d_out, (size_t)NTOK * DM, (const unsigned*)d_ws + 2); }
#endif
#endif
}
```

```cpp
#include <hip/hip_runtime.h>
#include <cstdio>
#include <cstdint>

#ifndef MK_N_LAUNCHES
#define MK_N_LAUNCHES 1
#endif

constexpr int NB = 8, SEQ = 2048, NMETA = 16, TT = SEQ + NMETA  , DM = 1024, NTOK = NB * SEQ  , NALL = NB * TT  ;
constexpr int AW = 512, NH = 8, HD = 64, IDXD = 64, CC = 512, CW = 31, NE = 32, DFF = 1024, TOPK = 256;
constexpr int INCOLS = 5192, TP = 2176  , VOFF = 0  , MSTR = 68  ;
constexpr float EPS = 1e-6f, LOG2E = 1.4426950408889634f;
constexpr float QSCALE = 0.125f * LOG2E;
constexpr int MAXTILES = 296;
constexpr int SC_Q = 0, SC_K = 512, SC_V = 1024, SC_IQ = 1536, SC_IK = 2048, SC_IW = 2112, SC_GLU = 2120, SC_GATE = 3144;
constexpr int WR_GLU = 2048, WR_GATE = 3072, WR_IK = 5120, WR_IW = 5184, WIN_ROWS = 5376;

constexpr size_t MiB = 1u << 20;
constexpr size_t al4k(size_t x) { return (x + 4095) & ~(size_t)4095; }
constexpr size_t WS_CTL = 0, CTL_ZERO_BYTES = 1 * MiB;
constexpr size_t WS_WIN = 1 * MiB;
constexpr size_t WS_WAO = WS_WIN + al4k((size_t)WIN_ROWS * DM * 2);
constexpr size_t WS_WCO = WS_WAO + al4k((size_t)DM * AW * 2);
constexpr size_t WS_WOUT = WS_WCO + al4k((size_t)DM * CC * 2);
constexpr size_t WS_WUG = WS_WOUT + al4k((size_t)DM * DM * 2);
constexpr size_t WS_WD = WS_WUG + al4k((size_t)NE * 2 * DFF * DM * 2);
constexpr size_t WS_XN = WS_WD + al4k((size_t)NE * DM * DFF * 2);
constexpr size_t WS_XNM = WS_XN + al4k((size_t)NTOK * DM * 2);
constexpr size_t WS_Q = WS_XNM + al4k((size_t)NMETA * DM * 2);
constexpr size_t WS_IQ = WS_Q + al4k((size_t)NTOK * AW * 2);
constexpr size_t WS_KB = WS_IQ + al4k((size_t)NTOK * AW * 2);
constexpr size_t WS_VT = WS_KB + al4k((size_t)(NALL + 64) * AW * 2);
constexpr size_t WS_IK = WS_VT + al4k((size_t)NB * AW * TP * 2);
constexpr size_t WS_IW = WS_IK + al4k((size_t)NB * 65 * 2048 * 2);
constexpr size_t WS_GLU = WS_IW + al4k((size_t)NTOK * 8 * 4);
constexpr size_t WS_GA = WS_GLU + al4k((size_t)NALL * CC * 2);
constexpr size_t WS_GB = WS_GA + al4k((size_t)NTOK * DM * 2);
constexpr size_t WS_MASK = WS_GB + al4k((size_t)NTOK * DM * 2);
constexpr size_t WS_AO = WS_MASK + al4k((size_t)NTOK * MSTR * 4);
constexpr size_t WS_CO = WS_AO + al4k((size_t)NTOK * AW * 2);
constexpr size_t WS_MG = WS_CO + al4k((size_t)NTOK * CC * 2);
constexpr size_t WS_TE = WS_MG + al4k((size_t)NTOK * DM * 2);
constexpr size_t WS_TP = WS_TE + al4k((size_t)NTOK * 4 * 4);
constexpr size_t WS_LIST = WS_TP + al4k((size_t)NTOK * 4 * 4);
constexpr size_t WS_LG = WS_LIST + al4k((size_t)NE * NTOK * 4);
constexpr size_t WS_ACT = WS_LG + al4k((size_t)NE * NTOK * 4);
constexpr size_t WS_YP = WS_ACT + al4k((size_t)MAXTILES * 256 * DFF * 2);
constexpr size_t WS_H1 = WS_YP + al4k((size_t)MAXTILES * 256 * DM * 2);
constexpr size_t WS_WRT = WS_H1 + al4k((size_t)NTOK * DM * 4);
constexpr size_t WS_RG = WS_WRT + al4k((size_t)2 * NE * DM * 2);
constexpr size_t WS_DUMMY = WS_RG + al4k((size_t)NE * NTOK * 4);
constexpr size_t WS_END = WS_DUMMY + 4096;
static_assert(WS_END < ((size_t)1 << 32), "32-bit byte offsets into d_ws");
constexpr int CW_TMO = 0, CW_CODE = 1, CW_BAR = 4096, CW_ECNT = 16384;

constexpr int RING_BYTES = 131072;
constexpr int LDSX_OFF = 153600;
constexpr int MISC_OFF = 161792;
constexpr int LDS_BYTES = 163840;
constexpr int NWAVES = 8, NTHREADS = 512;

#define GAS __attribute__((address_space(1)))
#define LAS __attribute__((address_space(3)))
typedef unsigned short bf16_t;
typedef short bf16x8 __attribute__((ext_vector_type(8)));
typedef short s16x4 __attribute__((ext_vector_type(4)));
typedef float f32x4 __attribute__((ext_vector_type(4)));
typedef float f32x16 __attribute__((ext_vector_type(16)));
typedef unsigned u32x4 __attribute__((ext_vector_type(4)));
typedef unsigned u32x2 __attribute__((ext_vector_type(2)));
typedef GAS unsigned gu32;
#define RLX_AGENT __ATOMIC_RELAXED, __HIP_MEMORY_SCOPE_AGENT
#define LDS_WAIT() asm volatile("s_waitcnt lgkmcnt(0)" ::: "memory")
#define VM_WAIT() asm volatile("s_waitcnt vmcnt(0)" ::: "memory")

typedef float f32x2_t __attribute__((ext_vector_type(2))); typedef __bf16 bf16x2_t __attribute__((ext_vector_type(2)));
__device__ __forceinline__ unsigned cvt_pk_bf16(float lo, float hi) { const f32x2_t v = {lo, hi}; const bf16x2_t b = __builtin_convertvector(v, bf16x2_t); return __builtin_bit_cast(unsigned, b); }
__device__ __forceinline__ float bf2f(unsigned short b) { return __uint_as_float((unsigned)b << 16); }
__device__ __forceinline__ float bflo(unsigned w) { return __uint_as_float(w << 16); }
__device__ __forceinline__ float bfhi(unsigned w) { return __uint_as_float(w & 0xffff0000u); }
__device__ __forceinline__ float sigmoidf_(float x) { return __builtin_amdgcn_rcpf(1.0f + __builtin_amdgcn_exp2f(-LOG2E * x)); }
__device__ __forceinline__ float wave_sum(float v) {
#pragma unroll
    for (int o = 1; o < 64; o <<= 1) v += __shfl_xor(v, o);
    return v;
}

namespace pg8 {
constexpr int BM = 256, BK = 64, HALF = 128, HTB = HALF * BK * 2, STAGE_BYTES = 8 * HTB;
__host__ __device__ __forceinline__ int lds_byte(int r, int c) { const int st = (r >> 4) * 2 + (c >> 5), rr = r & 15, cc = c & 31, ob = rr * 64 + cc * 2; return st * 1024 + (ob ^ (((ob >> 9) & 1) << 5)); }
__host__ __device__ __forceinline__ void stage_rc(int b, int& R, int& C) { const int st = b / 1024, sb = b % 1024, swz = sb ^ (((sb >> 9) & 1) << 5); R = (st >> 1) * 16 + swz / 64; C = (st & 1) * 32 + (swz % 64) / 2; }

struct Unit { int pm, pn, z; };

template <class Epi, class Sched>
__device__ __forceinline__ void gemm_phase(LAS unsigned char* lds, const int K, const Sched& S, const Epi& E) {
    const int tid = threadIdx.x, wid = __builtin_amdgcn_readfirstlane(tid >> 6), lane = tid & 63, wr = wid >> 2, wc = wid & 3, fr = lane & 15, fq = lane >> 4;
    const int nt = K / BK;
    unsigned voffB[2];
#pragma unroll
    for (int i = 0; i < 2; ++i) { int R_, C_; stage_rc(tid * 16 + i * 8192, R_, C_); voffB[i] = (unsigned)(R_ * K + C_) * 2u; }
    const size_t kstep = (size_t)(BK * 2);
    const size_t hstep = (size_t)HALF * K * 2;
    const unsigned ldsw = (unsigned)wid * 1024u;
    const int aoff = lds_byte(wr * 64 + fr, fq * 8), boff = lds_byte(wc * 32 + fr, fq * 8);
    const char* const abase = S.a_base();
#define PG8_SA(b, h) (((b) * 2 + (h)) * HTB)
#define PG8_SB(b, h) ((4 + (b) * 2 + (h)) * HTB)
#define PG8_STAGE(bufoff, gbase, voff) do { _Pragma("unroll") for (int _i = 0; _i < 2; ++_i) \
        __builtin_amdgcn_global_load_lds((const unsigned*)((const char*)(gbase) + (voff)[_i]), (LAS unsigned*)(lds + (bufoff) + ldsw + _i * 8192), 16, 0, 0); } while (0)
#define PG8_LDA(dst, b, h) do { _Pragma("unroll") for (int m = 0; m < 4; ++m) _Pragma("unroll") for (int k = 0; k < 2; ++k) dst[m][k] = *(const LAS bf16x8*)(lds + PG8_SA(b, h) + aoff + m * 2048 + k * 1024); } while (0)
#define PG8_LDB(dst, b, h) do { _Pragma("unroll") for (int n = 0; n < 2; ++n) _Pragma("unroll") for (int k = 0; k < 2; ++k) dst[n][k] = *(const LAS bf16x8*)(lds + PG8_SB(b, h) + boff + n * 2048 + k * 1024); } while (0)
#define PG8_MMA(ai, bj, At, Bt) do { __builtin_amdgcn_s_setprio(1); _Pragma("unroll") for (int m = 0; m < 4; ++m) _Pragma("unroll") for (int n = 0; n < 2; ++n) _Pragma("unroll") for (int k = 0; k < 2; ++k) \
        acc[ai][bj][m][n] = __builtin_amdgcn_mfma_f32_16x16x32_bf16(Bt[n][k], At[m][k], acc[ai][bj][m][n], 0, 0, 0); __builtin_amdgcn_s_setprio(0); } while (0)
#define PG8_WAIT_V(n) asm volatile("s_waitcnt vmcnt(" #n ")" ::: "memory")
#define PG8_WAIT_L(n) asm volatile("s_waitcnt lgkmcnt(" #n ")" ::: "memory")
#define PG8_BAR __builtin_amdgcn_s_barrier()
#define PG8_SCHED __builtin_amdgcn_sched_barrier(0)
    Unit cur, nxt; int ui = 0;
    if (!S.next(0, cur)) return;
    f32x4 acc[2][2][4][2];
#pragma unroll
    for (int a = 0; a < 2; ++a)
#pragma unroll
        for (int b = 0; b < 2; ++b)
#pragma unroll
            for (int m = 0; m < 4; ++m)
#pragma unroll
                for (int n = 0; n < 2; ++n) acc[a][b][m][n] = (f32x4){0.f, 0.f, 0.f, 0.f};
    bf16x8 At[4][2], B0[2][2], B1[2][2];
    unsigned ca[2][2], na[2][2];
    S.a_offs(cur, tid, ca);
    const char* cB = S.b_base(cur);
    PG8_STAGE(PG8_SB(0, 0), cB, voffB); PG8_STAGE(PG8_SB(0, 1), cB + hstep, voffB); PG8_STAGE(PG8_SA(0, 0), abase, ca[0]); PG8_STAGE(PG8_SA(0, 1), abase, ca[1]);
    if (wr == 1) PG8_BAR;
    PG8_WAIT_V(2); PG8_BAR;
    PG8_STAGE(PG8_SB(1, 0), cB + kstep, voffB); PG8_STAGE(PG8_SA(1, 0), abase + kstep, ca[0]); PG8_STAGE(PG8_SB(1, 1), cB + hstep + kstep, voffB);
    PG8_WAIT_V(6); PG8_BAR;
    for (;;) {
        const bool has_next = S.next(ui + 1, nxt);
        const char* nB = cB;
#pragma unroll
        for (int h = 0; h < 2; ++h)
#pragma unroll
            for (int i = 0; i < 2; ++i) na[h][i] = ca[h][i];
        if (has_next) { S.a_offs(nxt, tid, na); nB = S.b_base(nxt); }
        for (int t = 0; t < nt; t += 2) {
            const bool last = (t == nt - 2);
            const char* a1 = abase + (size_t)(t + 1) * kstep;
            const char* a2 = last ? abase : abase + (size_t)(t + 2) * kstep; const char* b2 = last ? nB : cB + (size_t)(t + 2) * kstep;
            const char* a3 = a2 + kstep; const char* b3 = b2 + kstep;
            PG8_LDB(B0, 0, 0); PG8_LDB(B1, 0, 1); PG8_SCHED; PG8_LDA(At, 0, 0); PG8_STAGE(PG8_SA(1, 1), a1, ca[1]);
            PG8_WAIT_V(8); PG8_WAIT_L(0); PG8_BAR; PG8_MMA(0, 0, At, B0); PG8_MMA(0, 1, At, B1); PG8_BAR; PG8_SCHED;
            if (last) {
#pragma unroll
                for (int h = 0; h < 2; ++h)
#pragma unroll
                    for (int i = 0; i < 2; ++i) ca[h][i] = na[h][i];
            }
            PG8_LDA(At, 0, 1); PG8_STAGE(PG8_SB(0, 0), b2, voffB); PG8_STAGE(PG8_SB(0, 1), b2 + hstep, voffB); PG8_STAGE(PG8_SA(0, 0), a2, ca[0]);
            PG8_WAIT_V(8); PG8_WAIT_L(0); PG8_BAR; PG8_MMA(1, 0, At, B0); PG8_MMA(1, 1, At, B1); PG8_BAR; PG8_SCHED;
            PG8_LDB(B0, 1, 0); PG8_LDB(B1, 1, 1); PG8_SCHED; PG8_LDA(At, 1, 0); PG8_STAGE(PG8_SA(0, 1), a2, ca[1]);
            PG8_WAIT_V(8); PG8_WAIT_L(0); PG8_BAR; PG8_MMA(0, 0, At, B0); PG8_MMA(0, 1, At, B1); PG8_BAR; PG8_SCHED;
            PG8_LDA(At, 1, 1); PG8_STAGE(PG8_SB(1, 0), b3, voffB); PG8_STAGE(PG8_SB(1, 1), b3 + hstep, voffB); PG8_STAGE(PG8_SA(1, 0), a3, ca[0]);
            PG8_WAIT_V(8); PG8_WAIT_L(0); PG8_BAR; PG8_MMA(1, 0, At, B0); PG8_MMA(1, 1, At, B1); PG8_BAR; PG8_SCHED;
        }
        if (wr == 0) PG8_BAR;
        { int tz = tid; asm volatile("" : "+v"(tz));
          const int l2 = tz & 63, w2 = __builtin_amdgcn_readfirstlane(tz >> 6); E(acc, cur, w2 >> 2, w2 & 3, l2 & 15, l2 >> 4); }
        if (!has_next) break;
#pragma unroll
        for (int a = 0; a < 2; ++a)
#pragma unroll
            for (int b = 0; b < 2; ++b)
#pragma unroll
                for (int m = 0; m < 4; ++m)
#pragma unroll
                    for (int n = 0; n < 2; ++n) acc[a][b][m][n] = (f32x4){0.f, 0.f, 0.f, 0.f};
        cur = nxt; cB = nB; ++ui;
        if (wr == 1) PG8_BAR;
    }
    PG8_WAIT_V(0);
    PG8_BAR;
#undef PG8_SA
#undef PG8_SB
#undef PG8_STAGE
#undef PG8_LDA
#undef PG8_LDB
#undef PG8_MMA
#undef PG8_WAIT_V
#undef PG8_WAIT_L
#undef PG8_BAR
#undef PG8_SCHED
}
}

#define XB_TMO      128
#define XB_XCNT(j)  (256  + 64 * (j))
#define XB_XSUB(j)  (1280 + 64 * (j))
#define XB_XGEN(j)  (2304 + 64 * (j))
#define XB_TOP      3328
#define XB_TOPGEN   3392
#define XCD_BAR_WORDS 3456
#define XB_SPIN_CAP (1u << 18)
__device__ __forceinline__ unsigned xb_ld(unsigned* p)              { return __hip_atomic_load(p, __ATOMIC_RELAXED, __HIP_MEMORY_SCOPE_AGENT); }
__device__ __forceinline__ unsigned xb_add(unsigned* p, unsigned v) { return __hip_atomic_fetch_add(p, v, __ATOMIC_RELAXED, __HIP_MEMORY_SCOPE_AGENT); }
__device__ __forceinline__ unsigned xb_xcc_id() { return (unsigned)__builtin_amdgcn_s_getreg((3 << 11) | 20) & 0xFu; }
#define XB_SPIN(cond, bar) do { unsigned _sp = 0; while (cond) { __builtin_amdgcn_s_sleep(1); \
    if ((++_sp & 255u) == 0u) { if (xb_ld(&(bar)[XB_TMO])) break; if (_sp > XB_SPIN_CAP) { atomicAdd(&(bar)[XB_TMO], 1u); break; } } } } while (0)
struct XcdBarrier { unsigned* bar; unsigned x; volatile LAS unsigned* st; };
__device__ __forceinline__ XcdBarrier xcd_barrier_post(unsigned* bar, volatile LAS unsigned* st) {
    XcdBarrier b; b.bar = bar; b.x = xb_xcc_id(); b.st = st;
    if (threadIdx.x == 0) (void)xb_add(&bar[XB_XCNT(b.x)], 1u);
    return b;
}
__device__ __forceinline__ void xcd_barrier_complete(unsigned* bar, unsigned x, unsigned& nloc, unsigned& nx) {
    const unsigned G = gridDim.x * gridDim.y * gridDim.z;
    unsigned sum, cnt, mine, sp = 0u;
    for (;;) {
        sum = 0u; cnt = 0u; mine = 0u;
#pragma unroll
        for (unsigned j = 0; j < 16; ++j) { const unsigned c = xb_ld(&bar[XB_XCNT(j)]); sum += c; cnt += (c > 0u) ? 1u : 0u; mine = (j == x) ? c : mine; }
        if (sum == G) break;
        __builtin_amdgcn_s_sleep(1);
        if ((++sp & 255u) == 0u) { if (xb_ld(&bar[XB_TMO])) break; if (sp > XB_SPIN_CAP) { atomicAdd(&bar[XB_TMO], 1u); break; } }
    }
    nloc = mine > 0u ? mine : 1u; nx = cnt > 0u ? cnt : 1u;
}
__device__ __forceinline__ void xcd_barrier(const XcdBarrier& b) {
    asm volatile("s_waitcnt vmcnt(0)" ::: "memory");
    __syncthreads();
    if (threadIdx.x == 0) {
        unsigned* bar = b.bar;
        __builtin_amdgcn_s_waitcnt(0);
        unsigned nloc = b.st[0], nx = b.st[1];
        if (nloc == 0u) { xcd_barrier_complete(bar, b.x, nloc, nx); b.st[0] = nloc; b.st[1] = nx; }
        const unsigned old = xb_add(&bar[XB_XSUB(b.x)], 1u);
        const unsigned gen = old / nloc;
        if (old + 1u == (gen + 1u) * nloc) {
            __builtin_amdgcn_fence(__ATOMIC_RELEASE, "agent");
            asm volatile("s_waitcnt vmcnt(0)" ::: "memory");
            const unsigned og = xb_add(&bar[XB_TOP], 1u);
            const unsigned tg = og / nx;
            if (og + 1u == (tg + 1u) * nx) xb_add(&bar[XB_TOPGEN], 1u);
            else XB_SPIN(xb_ld(&bar[XB_TOPGEN]) == tg, bar);
            __builtin_amdgcn_fence(__ATOMIC_ACQUIRE, "agent");
            xb_add(&bar[XB_XGEN(b.x)], 1u);
            asm volatile("s_waitcnt vmcnt(0)" ::: "memory");
        } else {
            XB_SPIN(xb_ld(&bar[XB_XGEN(b.x)]) == gen, bar);
            __builtin_amdgcn_fence(__ATOMIC_ACQUIRE, "agent");
            asm volatile("s_waitcnt vmcnt(0)" ::: "memory");
        }
    }
    __syncthreads();
}

struct Args {
    const float* in[21];
    float* out; unsigned char* ws;
    int ph_lo, ph_hi, flags, pad;
};
enum { I_X = 0, I_META, I_RELB, I_NMIX, I_WIN, I_BGATE, I_WAO, I_CONVW, I_CONVB, I_LNG, I_LNB, I_WCO, I_WOUT, I_NFFN, I_WR, I_BR, I_WUG, I_BUG, I_WD, I_BD, I_NFIN };

struct Frame {
    LAS unsigned char* lds;
    unsigned char* ws;
    int tid, lane, wave;
    int G, bid;
};
template <class T> __device__ __forceinline__ T* wsp(unsigned char* ws, size_t off) { return (T*)(ws + off); }

struct P0Desc { const float* src; bf16_t* dst; int ldn, ldk; };
__device__ __forceinline__ void p0_load(const P0Desc& d, f32x4 (&v)[16], int lane) {
    const float* p = d.src + (size_t)(lane >> 4) * d.ldn + (lane & 15) * 4;
#pragma unroll
    for (int i = 0; i < 16; ++i) v[i] = *(const f32x4*)(p + (size_t)(4 * i) * d.ldn);
}
__device__ __forceinline__ void p0_store(const P0Desc& d, const f32x4 (&v)[16], LAS float* scr, int lane) {
    const int n4 = (lane & 15) * 4, kr = lane >> 4;
#pragma unroll
    for (int i = 0; i < 16; ++i) { LAS float* p = scr + (4 * i + kr) * 65 + n4; p[0] = v[i][0]; p[1] = v[i][1]; p[2] = v[i][2]; p[3] = v[i][3]; }
    LDS_WAIT(); asm volatile("" ::: "memory");
    const int c = lane & 7;
#pragma unroll
    for (int j = 0; j < 8; ++j) { const int n = (lane >> 3) + 8 * j; const LAS float* s = scr + (8 * c) * 65 + n;
        u32x4 o; o.x = cvt_pk_bf16(s[0 * 65], s[1 * 65]); o.y = cvt_pk_bf16(s[2 * 65], s[3 * 65]); o.z = cvt_pk_bf16(s[4 * 65], s[5 * 65]); o.w = cvt_pk_bf16(s[6 * 65], s[7 * 65]);
        *(u32x4*)(d.dst + (size_t)n * d.ldk + 8 * c) = o; }
    LDS_WAIT(); asm volatile("" ::: "memory");
}
__device__ __forceinline__ void rms_row_to_bf16(const float* __restrict__ xrow, const float* __restrict__ g, bf16_t* __restrict__ orow, int lane) {
    const f32x4* xr = (const f32x4*)xrow + lane; const f32x4* gr = (const f32x4*)g + lane;
    f32x4 v[4]; float s = 0.f;
#pragma unroll
    for (int j = 0; j < 4; ++j) { v[j] = xr[64 * j]; s += (v[j].x * v[j].x + v[j].y * v[j].y) + (v[j].z * v[j].z + v[j].w * v[j].w); }
    const float r = 1.0f / sqrtf(wave_sum(s) * (1.f / DM) + EPS);
    unsigned long long* o8 = (unsigned long long*)orow + lane;
#pragma unroll
    for (int j = 0; j < 4; ++j) { const f32x4 gg = gr[64 * j];
        o8[64 * j] = (unsigned long long)cvt_pk_bf16(v[j].x * r * gg.x, v[j].y * r * gg.y) | ((unsigned long long)cvt_pk_bf16(v[j].z * r * gg.z, v[j].w * r * gg.w) << 32); }
}
__device__ __forceinline__ void p0_prologue(Frame& F, const Args& a, const int part) {
    LAS float* scr = (LAS float*)(F.lds + F.wave * 16896);
    const int gw = F.bid * NWAVES + F.wave, NGW = F.G * NWAVES;
    unsigned char* ws = F.ws;
    constexpr int T_IN = 81 * 16, T_AO = 16 * 8, T_CO = 16 * 8, T_OUT = 16 * 16, T_SMALL = T_IN + T_AO + T_CO + T_OUT;
    constexpr int T_UG = NE * 32 * 16, T_D = NE * 16 * 16, T_ALL = T_SMALL + T_UG + T_D;
    auto desc = [&](int it) -> P0Desc {
        int r = it; P0Desc d;
        if (r < T_IN) { const int g = r / 16, kb = r % 16; const int dr = g * 64; int sc;
            if (dr < WR_GLU) sc = dr;
            else if (dr < WR_GATE) { const int q = dr - WR_GLU, tile = q >> 8, hf = (q >> 7) & 1, w = q & 127; sc = SC_GLU + 512 * hf + 128 * tile + w; }
            else if (dr < WR_IK) sc = SC_GATE + (dr - WR_GATE);
            else sc = SC_IK + (dr - WR_IK);
            d.src = a.in[I_WIN] + (size_t)(kb * 64) * INCOLS + sc; d.ldn = INCOLS; d.dst = wsp<bf16_t>(ws, WS_WIN) + (size_t)dr * DM + kb * 64; d.ldk = DM; return d; }
        r -= T_IN;
        if (r < T_AO) { const int g = r / 8, kb = r % 8; d.src = a.in[I_WAO] + (size_t)(kb * 64) * DM + g * 64; d.ldn = DM; d.dst = wsp<bf16_t>(ws, WS_WAO) + (size_t)(g * 64) * AW + kb * 64; d.ldk = AW; return d; }
        r -= T_AO;
        if (r < T_CO) { const int g = r / 8, kb = r % 8; d.src = a.in[I_WCO] + (size_t)(kb * 64) * DM + g * 64; d.ldn = DM; d.dst = wsp<bf16_t>(ws, WS_WCO) + (size_t)(g * 64) * CC + kb * 64; d.ldk = CC; return d; }
        r -= T_CO;
        if (r < T_OUT) { const int g = r / 16, kb = r % 16; d.src = a.in[I_WOUT] + (size_t)(kb * 64) * DM + g * 64; d.ldn = DM; d.dst = wsp<bf16_t>(ws, WS_WOUT) + (size_t)(g * 64) * DM + kb * 64; d.ldk = DM; return d; }
        r -= T_OUT;
        if (r < T_UG) { const int e = r / 512, q = r % 512, g = q % 32, kb = q / 32; const int dr = g * 64, tile = dr >> 8, hf = (dr >> 7) & 1, w = dr & 127;
            d.src = a.in[I_WUG] + (size_t)e * DM * 2 * DFF + (size_t)(kb * 64) * (2 * DFF) + DFF * hf + 128 * tile + w; d.ldn = 2 * DFF;
            d.dst = wsp<bf16_t>(ws, WS_WUG) + (size_t)e * 2 * DFF * DM + (size_t)dr * DM + kb * 64; d.ldk = DM; return d; }
        r -= T_UG;
        { const int e = r / 256, q = r % 256, g = q % 16, kb = q / 16;
            d.src = a.in[I_WD] + (size_t)e * DFF * DM + (size_t)(kb * 64) * DM + g * 64; d.ldn = DM; d.dst = wsp<bf16_t>(ws, WS_WD) + (size_t)e * DM * DFF + (size_t)(g * 64) * DFF + kb * 64; d.ldk = DFF; return d; }
    };
    const int T_LO = part ? T_SMALL : 0, T_HI = part ? T_ALL : T_SMALL;
    if (T_LO + gw < T_HI) {
        f32x4 va[16], vb[16];
        P0Desc da = desc(T_LO + gw), db = da;
        p0_load(da, va, F.lane);
        for (int it = T_LO + gw; it < T_HI; it += 2 * NGW) {
            const int i1 = it + NGW, i2 = it + 2 * NGW;
            db = desc(i1 < T_HI ? i1 : it); p0_load(db, vb, F.lane);
            p0_store(da, va, scr, F.lane);
            da = desc(i2 < T_HI ? i2 : it); p0_load(da, va, F.lane);
            if (i1 < T_HI) p0_store(db, vb, scr, F.lane);
        }
    }
    if (part) return;
    { const int gt = F.bid * NTHREADS + F.tid;
      if (gt < 8 * DM / 2) { const int n = gt >> 9, k = (gt & 511) * 2; const float v0 = a.in[I_WIN][(size_t)k * INCOLS + SC_IW + n], v1 = a.in[I_WIN][(size_t)(k + 1) * INCOLS + SC_IW + n];
          *(unsigned*)(wsp<bf16_t>(ws, WS_WIN) + (size_t)(WR_IW + n) * DM + k) = cvt_pk_bf16(v0, v1); } }
    { const int gt = F.bid * NTHREADS + F.tid;
      if (gt < NE * DM / 2) { const int e = gt >> 9, d = (gt & 511) * 2; const float v0 = a.in[I_NFFN][d] * a.in[I_WR][(size_t)d * NE + e], v1 = a.in[I_NFFN][d + 1] * a.in[I_WR][(size_t)(d + 1) * NE + e];
          const unsigned hi = cvt_pk_bf16(v0, v1); const unsigned lo = cvt_pk_bf16(v0 - bflo(hi), v1 - bfhi(hi));
          *(unsigned*)(wsp<bf16_t>(ws, WS_WRT) + (size_t)e * DM + d) = hi; *(unsigned*)(wsp<bf16_t>(ws, WS_WRT) + (size_t)(NE + e) * DM + d) = lo; } }
    for (int m = gw; m < NTOK + NMETA; m += NGW) {
        if (m < NTOK) rms_row_to_bf16(a.in[I_X] + (size_t)m * DM, a.in[I_NMIX], wsp<bf16_t>(ws, WS_XN) + (size_t)m * DM, F.lane);
        else rms_row_to_bf16(a.in[I_META] + (size_t)(m - NTOK) * DM, a.in[I_NMIX], wsp<bf16_t>(ws, WS_XNM) + (size_t)(m - NTOK) * DM, F.lane);
    }
}

struct PlainSched {
    const char* ws; unsigned a_off, b_off; int K, nM, nN, nwg, G, c;
    __device__ __forceinline__ void init(const unsigned char* ws_, size_t a, size_t b, int M, int N, int K_, int G_, int c_) { ws = (const char*)ws_; a_off = (unsigned)a; b_off = (unsigned)b; K = K_; nM = M / 256; nN = N / 256; nwg = nM * nN; G = G_; c = c_; }
    __device__ __forceinline__ bool next(int i, pg8::Unit& u) const {
        const long L = (long)i * G + c; if (L >= nwg) return false;
        int wgid = (int)L; { const int q = nwg / 8, r = nwg % 8, xcd = wgid % 8, off = wgid / 8; wgid = (xcd < r ? xcd * (q + 1) : r * (q + 1) + (xcd - r) * q) + off; }
        const int nig = 8 * nN, gid = wgid / nig, fm = gid * 8, gsz = (nM - fm) < 8 ? (nM - fm) : 8;
        u.pm = fm + ((wgid % nig) % gsz); u.pn = (wgid % nig) / gsz; u.z = 0; return true;
    }
    __device__ __forceinline__ const char* a_base() const { return ws; }
    __device__ __forceinline__ void a_offs(const pg8::Unit& u, int tid, unsigned (&o)[2][2]) const {
        int R[2], C[2]; pg8::stage_rc(tid * 16, R[0], C[0]); pg8::stage_rc(tid * 16 + 8192, R[1], C[1]);
#pragma unroll
        for (int h = 0; h < 2; ++h)
#pragma unroll
            for (int i = 0; i < 2; ++i) o[h][i] = a_off + (unsigned)(((u.pm * 256 + h * 128 + R[i]) * K + C[i]) * 2);
    }
    __device__ __forceinline__ const char* b_base(const pg8::Unit& u) const { return ws + b_off + (size_t)u.pn * 256 * K * 2; }
};
struct MergeSched {
    const char* ws; int G, c;
    __device__ __forceinline__ bool next(int i, pg8::Unit& u) const {
        const int t = c + (i >> 1) * G;
        if (t >= 256) return false;
        u.pm = (t & 7) + 8 * (t >> 5); u.pn = (t >> 3) & 3; u.z = i & 1; return true;
    }
    __device__ __forceinline__ const char* a_base() const { return ws; }
    __device__ __forceinline__ void a_offs(const pg8::Unit& u, int tid, unsigned (&o)[2][2]) const {
        int R[2], C[2]; pg8::stage_rc(tid * 16, R[0], C[0]); pg8::stage_rc(tid * 16 + 8192, R[1], C[1]);
        const unsigned base = (unsigned)(u.z ? WS_CO : WS_AO);
#pragma unroll
        for (int h = 0; h < 2; ++h)
#pragma unroll
            for (int i = 0; i < 2; ++i) o[h][i] = base + (unsigned)(((u.pm * 256 + h * 128 + R[i]) * 512 + C[i]) * 2);
    }
    __device__ __forceinline__ const char* b_base(const pg8::Unit& u) const { return ws + (u.z ? WS_WCO : WS_WAO) + (size_t)u.pn * 256 * 512 * 2; }
};
struct MoeTables { const LAS int* cnt; const LAS int* tbase; };
template <int NC, bool GATHER>
struct MoeSched {
    const char* ws; MoeTables T; int G, c, total;
    __device__ __forceinline__ bool next(int i, pg8::Unit& u) const {
        const long L = (long)i * G + c; if (L >= total) return false;
        int wgid = (int)L; { const int q = total / 8, r = total % 8, xcd = wgid % 8, off = wgid / 8; wgid = (xcd < r ? xcd * (q + 1) : r * (q + 1) + (xcd - r) * q) + off; }
        int e = 0;
        for (int j = 1; j < NE; ++j) e += (wgid >= __builtin_amdgcn_readfirstlane(T.tbase[j]) * NC) ? 1 : 0;
        e = __builtin_amdgcn_readfirstlane(e);
        const int tb0 = __builtin_amdgcn_readfirstlane(T.tbase[e]), tb1 = __builtin_amdgcn_readfirstlane(T.tbase[e + 1]);
        const int loc = wgid - tb0 * NC, nt_e = tb1 - tb0;
        u.z = e;
        u.pn = loc % NC; u.pm = loc / NC;
        return true;
    }
    __device__ __forceinline__ const char* a_base() const { return ws; }
    __device__ __forceinline__ void a_offs(const pg8::Unit& u, int tid, unsigned (&o)[2][2]) const {
        int R[2], C[2]; pg8::stage_rc(tid * 16, R[0], C[0]); pg8::stage_rc(tid * 16 + 8192, R[1], C[1]);
        if (GATHER) {
            const int* list = (const int*)(ws + WS_LIST) + (size_t)u.z * NTOK; const int n = __builtin_amdgcn_readfirstlane(T.cnt[u.z]);
#pragma unroll
            for (int h = 0; h < 2; ++h)
#pragma unroll
                for (int i = 0; i < 2; ++i) { const int p = u.pm * 256 + h * 128 + R[i]; const int tok = list[p < n ? p : 0];
                    o[h][i] = (unsigned)WS_XN + (unsigned)((tok * DM + C[i]) * 2); }
        } else {
            const int row0 = (__builtin_amdgcn_readfirstlane(T.tbase[u.z]) + u.pm) * 256;
#pragma unroll
            for (int h = 0; h < 2; ++h)
#pragma unroll
                for (int i = 0; i < 2; ++i) o[h][i] = (unsigned)WS_ACT + (unsigned)(((row0 + h * 128 + R[i]) * DFF + C[i]) * 2);
        }
    }
    __device__ __forceinline__ const char* b_base(const pg8::Unit& u) const {
        if (GATHER) return ws + WS_WUG + ((size_t)u.z * 2 * DFF + (size_t)u.pn * 256) * DM * 2;
        else return ws + WS_WD + ((size_t)u.z * DM + (size_t)u.pn * 256) * DFF * 2;
    }
};

#define EPI_ROWS(ai, m) for (int ai = 0; ai < 2; ++ai) _Pragma("unroll") for (int m = 0; m < 4; ++m)
#define EPI_COLS(bj, n) for (int bj = 0; bj < 2; ++bj) _Pragma("unroll") for (int n = 0; n < 2; ++n)
__device__ __forceinline__ void st_bf16x4(bf16_t* p, f32x4 v) { u32x2 w; w.x = cvt_pk_bf16(v[0], v[1]); w.y = cvt_pk_bf16(v[2], v[3]); *(u32x2*)p = w; }

struct EpiInProj {
    unsigned char* ws; const float* bgate;
    __device__ __forceinline__ void operator()(const f32x4 (&acc)[2][2][4][2], const pg8::Unit& u, int wr, int wc, int fr, int fq) const {
        const int pn = u.pn, row0 = u.pm * 256 + wr * 64 + fr, col0 = wc * 32 + 4 * fq;
        const int bidx = u.pm >> 3;
        const int rowk0 = row0 + NMETA * (bidx + 1);
        if (pn < 2 || (pn >= 6 && pn < 8)) {
            bf16_t* O = wsp<bf16_t>(ws, pn < 2 ? WS_Q : WS_IQ); const int cb = (pn & 1) * 256; const float sc = pn < 2 ? QSCALE : 1.0f;
#pragma unroll
            EPI_ROWS(ai, m) { bf16_t* rp = O + (size_t)(row0 + ai * 128 + m * 16) * AW + cb + col0;
#pragma unroll
                EPI_COLS(bj, n) st_bf16x4(rp + bj * 128 + n * 16, acc[ai][bj][m][n] * sc); }
        } else if (pn < 4) {
            bf16_t* O = wsp<bf16_t>(ws, WS_KB); const int cb = (pn & 1) * 256;
#pragma unroll
            EPI_ROWS(ai, m) { bf16_t* rp = O + (size_t)(rowk0 + ai * 128 + m * 16) * AW + cb + col0;
#pragma unroll
                EPI_COLS(bj, n) st_bf16x4(rp + bj * 128 + n * 16, acc[ai][bj][m][n]); }
        } else if (pn < 6) {
            bf16_t* O = wsp<bf16_t>(ws, WS_VT) + (size_t)bidx * AW * TP; const int cb = (pn & 1) * 256;
            const int t0 = (row0 & (SEQ - 1)) + NMETA + VOFF;
#pragma unroll
            EPI_ROWS(ai, m) { const int t = t0 + ai * 128 + m * 16;
#pragma unroll
                EPI_COLS(bj, n) { const f32x4 v = acc[ai][bj][m][n]; bf16_t* cp = O + (size_t)(cb + col0 + bj * 128 + n * 16) * TP + (t & ~1);
                    const float p0 = __shfl_xor(v[0], 1), p1 = __shfl_xor(v[1], 1), p2 = __shfl_xor(v[2], 1), p3 = __shfl_xor(v[3], 1);
                    if ((fr & 1) == 0) { *(unsigned*)(cp) = cvt_pk_bf16(v[0], p0); *(unsigned*)(cp + TP) = cvt_pk_bf16(v[1], p1); }
                    else { *(unsigned*)(cp + 2 * TP) = cvt_pk_bf16(p2, v[2]); *(unsigned*)(cp + 3 * TP) = cvt_pk_bf16(p3, v[3]); } } }
        } else if (pn < 12) {
            bf16_t* O = wsp<bf16_t>(ws, WS_GLU); const int cb = (pn - 8) * 128;
#pragma unroll
            EPI_ROWS(ai, m) { bf16_t* rp = O + (size_t)(rowk0 + ai * 128 + m * 16) * CC + cb + col0;
#pragma unroll
                for (int n = 0; n < 2; ++n) { const f32x4 av = acc[ai][0][m][n], gv = acc[ai][1][m][n]; f32x4 y;
#pragma unroll
                    for (int j = 0; j < 4; ++j) y[j] = av[j] * sigmoidf_(gv[j]);
                    st_bf16x4(rp + n * 16, y); } }
        } else {
            const int gt = pn - 12; bf16_t* O = wsp<bf16_t>(ws, gt < 4 ? WS_GA : WS_GB); const int cb = (gt & 3) * 256; const float* bp = bgate + gt * 256 + col0;
            f32x4 bv[2][2];
#pragma unroll
            EPI_COLS(bj, n) bv[bj][n] = *(const f32x4*)(bp + bj * 128 + n * 16);
#pragma unroll
            EPI_ROWS(ai, m) { bf16_t* rp = O + (size_t)(row0 + ai * 128 + m * 16) * DM + cb + col0;
#pragma unroll
                EPI_COLS(bj, n) { const f32x4 x = acc[ai][bj][m][n] + bv[bj][n]; f32x4 y;
#pragma unroll
                    for (int j = 0; j < 4; ++j) y[j] = sigmoidf_(x[j]);
                    st_bf16x4(rp + bj * 128 + n * 16, y); } }
        }
    }
};
struct EpiMerge {
    unsigned char* ws;
    __device__ __forceinline__ void operator()(const f32x4 (&acc)[2][2][4][2], const pg8::Unit& u, int wr, int wc, int fr, int fq) const {
        const int row0 = u.pm * 256 + wr * 64 + fr, col0 = u.pn * 256 + wc * 32 + 4 * fq;
        const bf16_t* Gt = wsp<bf16_t>(ws, u.z ? WS_GB : WS_GA); bf16_t* O = wsp<bf16_t>(ws, WS_MG);
#pragma unroll
        for (int ai = 0; ai < 2; ++ai) {
            u32x2 g[4][2][2], p[4][2][2];
#pragma unroll
            for (int m = 0; m < 4; ++m)
#pragma unroll
                EPI_COLS(bj, n) { const size_t o = (size_t)(row0 + ai * 128 + m * 16) * DM + col0 + bj * 128 + n * 16; g[m][bj][n] = *(const u32x2*)(Gt + o); p[m][bj][n] = u.z ? *(const u32x2*)(O + o) : (u32x2){0u, 0u}; }
#pragma unroll
            for (int m = 0; m < 4; ++m)
#pragma unroll
                EPI_COLS(bj, n) { const size_t o = (size_t)(row0 + ai * 128 + m * 16) * DM + col0 + bj * 128 + n * 16; const u32x2 gg = g[m][bj][n], pp = p[m][bj][n]; const f32x4 a = acc[ai][bj][m][n];
                    const f32x4 y = (f32x4){bflo(gg.x) * a[0] + bflo(pp.x), bfhi(gg.x) * a[1] + bfhi(pp.x), bflo(gg.y) * a[2] + bflo(pp.y), bfhi(gg.y) * a[3] + bfhi(pp.y)};
                    st_bf16x4(O + o, y); }
        }
    }
};
struct EpiResid {
    const float* x; float* out;
    __device__ __forceinline__ void operator()(const f32x4 (&acc)[2][2][4][2], const pg8::Unit& u, int wr, int wc, int fr, int fq) const {
        const int row0 = u.pm * 256 + wr * 64 + fr, col0 = u.pn * 256 + wc * 32 + 4 * fq;
#pragma unroll
        for (int ai = 0; ai < 2; ++ai)
#pragma unroll
            for (int mh = 0; mh < 2; ++mh) {
                f32x4 xv[2][2][2];
#pragma unroll
                for (int mm = 0; mm < 2; ++mm)
#pragma unroll
                    EPI_COLS(bj, n) xv[mm][bj][n] = *(const f32x4*)(x + (size_t)(row0 + ai * 128 + (2 * mh + mm) * 16) * DM + col0 + bj * 128 + n * 16);
#pragma unroll
                for (int mm = 0; mm < 2; ++mm)
#pragma unroll
                    EPI_COLS(bj, n) *(f32x4*)(out + (size_t)(row0 + ai * 128 + (2 * mh + mm) * 16) * DM + col0 + bj * 128 + n * 16) = xv[mm][bj][n] + acc[ai][bj][2 * mh + mm][n];
            }
    }
};
struct EpiSwiglu {
    unsigned char* ws; const float* bug; MoeTables T;
    __device__ __forceinline__ void operator()(const f32x4 (&acc)[2][2][4][2], const pg8::Unit& u, int wr, int wc, int fr, int fq) const {
        const int e = u.z, n_e = __builtin_amdgcn_readfirstlane(T.cnt[e]), rloc0 = u.pm * 256 + wr * 64 + fr, row0 = __builtin_amdgcn_readfirstlane(T.tbase[e]) * 256 + rloc0, col0 = u.pn * 128 + wc * 32 + 4 * fq;
        const float* bp = bug + (size_t)e * 2 * DFF + col0; bf16_t* O = wsp<bf16_t>(ws, WS_ACT); const float* rg = wsp<float>(ws, WS_RG) + (size_t)e * NTOK;
        f32x4 bg[2], bu[2];
#pragma unroll
        for (int n = 0; n < 2; ++n) { bg[n] = *(const f32x4*)(bp + n * 16); bu[n] = *(const f32x4*)(bp + DFF + n * 16); }
        float rvs[2][4];
#pragma unroll
        EPI_ROWS(ai, m) { const int rl = rloc0 + ai * 128 + m * 16; rvs[ai][m] = rg[rl < n_e ? rl : 0]; }
        bf16_t* const sink = wsp<bf16_t>(ws, WS_DUMMY) + col0;
#pragma unroll
        EPI_ROWS(ai, m) { const int rl = rloc0 + ai * 128 + m * 16; bf16_t* rp = (rl < n_e) ? O + (size_t)(row0 + ai * 128 + m * 16) * DFF + col0 : sink; const float rv = rvs[ai][m];
#pragma unroll
                for (int n = 0; n < 2; ++n) { const f32x4 gv = acc[ai][0][m][n] * rv + bg[n], uv = acc[ai][1][m][n] * rv + bu[n]; f32x4 y;
#pragma unroll
                    for (int j = 0; j < 4; ++j) { const float g = fminf(gv[j], 7.0f), up = fminf(fmaxf(uv[j], -7.0f), 7.0f); y[j] = (up + 1.0f) * g * sigmoidf_(1.702f * g); }
                    st_bf16x4(rp + n * 16, y); } }
    }
};
struct EpiDown {
    unsigned char* ws; const float* bd; MoeTables T;
    __device__ __forceinline__ void operator()(const f32x4 (&acc)[2][2][4][2], const pg8::Unit& u, int wr, int wc, int fr, int fq) const {
        const int e = u.z, n_e = __builtin_amdgcn_readfirstlane(T.cnt[e]), rloc0 = u.pm * 256 + wr * 64 + fr, row0 = __builtin_amdgcn_readfirstlane(T.tbase[e]) * 256 + rloc0, col0 = u.pn * 256 + wc * 32 + 4 * fq;
        const float* bp = bd + (size_t)e * DM + col0; bf16_t* O = wsp<bf16_t>(ws, WS_YP); const float* lg = wsp<float>(ws, WS_LG) + (size_t)e * NTOK;
        f32x4 bv[2][2];
#pragma unroll
        EPI_COLS(bj, n) bv[bj][n] = *(const f32x4*)(bp + bj * 128 + n * 16);
        float gts[2][4];
#pragma unroll
        EPI_ROWS(ai, m) { const int rl = rloc0 + ai * 128 + m * 16; gts[ai][m] = lg[rl < n_e ? rl : 0]; }
        bf16_t* const sink = wsp<bf16_t>(ws, WS_DUMMY) + col0;
#pragma unroll
        EPI_ROWS(ai, m) { const int rl = rloc0 + ai * 128 + m * 16; const float gt = gts[ai][m]; bf16_t* rp = (rl < n_e) ? O + (size_t)(row0 + ai * 128 + m * 16) * DM + col0 : sink;
#pragma unroll
                EPI_COLS(bj, n) st_bf16x4(rp + bj * 128 + n * 16, (acc[ai][bj][m][n] + bv[bj][n]) * gt); }
    }
};

constexpr int IKBLK = 65;
__device__ __forceinline__ size_t ikf_off(int b, int p, int dim) { return ((((size_t)(b * IKBLK + (p >> 5)) * 4 + (dim >> 4)) * 64 + (((dim >> 3) & 1) * 32 + (p & 31))) * 8 + (dim & 7)); }
template <int NT>
__device__ __forceinline__ void wave_mm16(const bf16_t* __restrict__ A, int lda, const bf16_t* const (&Bt)[NT], int K, int lane, f32x4 (&acc)[NT]) {
    const bf16_t* ap = A + (size_t)(lane & 15) * lda + 8 * (lane >> 4);
    const bf16_t* bp[NT];
#pragma unroll
    for (int t = 0; t < NT; ++t) { bp[t] = Bt[t] + (size_t)(lane & 15) * K + 8 * (lane >> 4); acc[t] = (f32x4){0.f, 0.f, 0.f, 0.f}; }
#pragma unroll (NT == 1 ? 16 : 8)
    for (int k0 = 0; k0 < K; k0 += 32) {
        const bf16x8 a = *(const bf16x8*)(ap + k0);
#pragma unroll
        for (int t = 0; t < NT; ++t) { const bf16x8 b = *(const bf16x8*)(bp[t] + k0); acc[t] = __builtin_amdgcn_mfma_f32_16x16x32_bf16(b, a, acc[t], 0, 0, 0); }
    }
}
__device__ __forceinline__ void p1_thin(Frame& F, int dbgflags) {
    unsigned char* ws = F.ws;
    const bf16_t* WIN = wsp<bf16_t>(ws, WS_WIN); const bf16_t* XN = wsp<bf16_t>(ws, WS_XN); const bf16_t* XNM = wsp<bf16_t>(ws, WS_XNM);
    bf16_t* KB = wsp<bf16_t>(ws, WS_KB); bf16_t* VT = wsp<bf16_t>(ws, WS_VT); bf16_t* IK = wsp<bf16_t>(ws, WS_IK); bf16_t* GLU = wsp<bf16_t>(ws, WS_GLU); float* IW = wsp<float>(ws, WS_IW);
    const int gw = F.bid * NWAVES + F.wave, NGW = F.G * NWAVES, lane = F.lane, tk = lane & 15, nq = lane >> 4;
    {
        constexpr int WBP = 2064;
        LAS unsigned char* lds = F.lds;
        __syncthreads();
        { const unsigned char* src = (const unsigned char*)(WIN + (size_t)WR_IK * DM);
          for (int p = F.tid; p < 72 * 128; p += NTHREADS) { const int row = p >> 7, c16 = p & 127; *(LAS u32x4*)(lds + row * WBP + c16 * 16) = *(const u32x4*)(src + (size_t)row * DM * 2 + c16 * 16); } }
        __syncthreads();
        const int tg = F.wave & 3, hf = F.wave >> 2, kq = nq;
        for (int tb = F.bid; tb < NTOK / 64; tb += F.G) {
            const int m = tb * 64 + 16 * tg + tk, rowk = m + NMETA * ((m >> 11) + 1);
            const bf16_t* xr = XN + (size_t)m * DM + 16 * kq;
            bf16x8 xa[16], xb[16];
#pragma unroll
            for (int sblk = 0; sblk < 16; ++sblk) { xa[sblk] = *(const bf16x8*)(xr + 64 * sblk); xb[sblk] = *(const bf16x8*)(xr + 64 * sblk + 8); }
            const LAS unsigned char* wb = lds + tk * WBP + 32 * kq;
            if (hf == 0) {
                f32x4 acc[3] = {{0.f, 0.f, 0.f, 0.f}, {0.f, 0.f, 0.f, 0.f}, {0.f, 0.f, 0.f, 0.f}};
#pragma unroll
                for (int sblk = 0; sblk < 16; ++sblk)
#pragma unroll
                    for (int t = 0; t < 3; ++t) { const bf16x8 b0 = *(const LAS bf16x8*)(wb + 16 * t * WBP + 128 * sblk), b1 = *(const LAS bf16x8*)(wb + 16 * t * WBP + 128 * sblk + 16);
                        acc[t] = __builtin_amdgcn_mfma_f32_16x16x32_bf16(b0, xa[sblk], acc[t], 0, 0, 0); acc[t] = __builtin_amdgcn_mfma_f32_16x16x32_bf16(b1, xb[sblk], acc[t], 0, 0, 0); }
#pragma unroll
                for (int t = 0; t < 3; ++t) st_bf16x4(IK + ikf_off(m >> 11, NMETA + (m & (SEQ - 1)), 16 * t + 4 * nq), acc[t]);
            } else {
                f32x4 acc[2] = {{0.f, 0.f, 0.f, 0.f}, {0.f, 0.f, 0.f, 0.f}};
#pragma unroll
                for (int sblk = 0; sblk < 16; ++sblk)
#pragma unroll
                    for (int t = 0; t < 2; ++t) { const bf16x8 b0 = *(const LAS bf16x8*)(wb + 16 * (3 + t) * WBP + 128 * sblk), b1 = *(const LAS bf16x8*)(wb + 16 * (3 + t) * WBP + 128 * sblk + 16);
                        acc[t] = __builtin_amdgcn_mfma_f32_16x16x32_bf16(b0, xa[sblk], acc[t], 0, 0, 0); acc[t] = __builtin_amdgcn_mfma_f32_16x16x32_bf16(b1, xb[sblk], acc[t], 0, 0, 0); }
                st_bf16x4(IK + ikf_off(m >> 11, NMETA + (m & (SEQ - 1)), 48 + 4 * nq), acc[0]);
                if (nq < 2) *(f32x4*)(IW + (size_t)m * 8 + 4 * nq) = acc[1];
            }
        }
        __syncthreads();
    }
    if (!(dbgflags & 256)) for (int task = gw; task < 100; task += NGW) {
        if (task < 32) {
            const bf16_t* const Bt[1] = {WIN + (size_t)(SC_K + 16 * task) * DM}; f32x4 acc[1]; wave_mm16<1>(XNM, DM, Bt, DM, lane, acc);
            for (int b = 0; b < NB; ++b) st_bf16x4(KB + (size_t)(b * TT + tk) * AW + 16 * task + 4 * nq, acc[0]);
        } else if (task < 64) {
            const int t = task - 32; const bf16_t* const Bt[1] = {WIN + (size_t)(SC_V + 16 * t) * DM}; f32x4 acc[1]; wave_mm16<1>(XNM, DM, Bt, DM, lane, acc);
            const float p0 = __shfl_xor(acc[0][0], 1), p1 = __shfl_xor(acc[0][1], 1), p2 = __shfl_xor(acc[0][2], 1), p3 = __shfl_xor(acc[0][3], 1);
            const unsigned wa = (tk & 1) ? cvt_pk_bf16(p2, acc[0][2]) : cvt_pk_bf16(acc[0][0], p0), wb = (tk & 1) ? cvt_pk_bf16(p3, acc[0][3]) : cvt_pk_bf16(acc[0][1], p1);
            for (int b = 0; b < NB; ++b) { bf16_t* cp = VT + ((size_t)b * AW + 16 * t + 4 * nq + 2 * (tk & 1)) * TP + VOFF + (tk & ~1);
                *(unsigned*)cp = wa; *(unsigned*)(cp + TP) = wb; }
        } else if (task < 68) {
            const int t = task - 64; const bf16_t* const Bt[1] = {WIN + (size_t)(WR_IK + 16 * t) * DM}; f32x4 acc[1]; wave_mm16<1>(XNM, DM, Bt, DM, lane, acc);
            for (int b = 0; b < NB; ++b) st_bf16x4(IK + ikf_off(b, tk, 16 * t + 4 * nq), acc[0]);
        } else {
            const int c16 = task - 68; const int ar = WR_GLU + 256 * (c16 >> 3) + 16 * (c16 & 7);
            const bf16_t* const Bt[2] = {WIN + (size_t)ar * DM, WIN + (size_t)(ar + 128) * DM}; f32x4 acc[2]; wave_mm16<2>(XNM, DM, Bt, DM, lane, acc);
            f32x4 y;
#pragma unroll
            for (int j = 0; j < 4; ++j) y[j] = acc[0][j] * sigmoidf_(acc[1][j]);
            for (int b = 0; b < NB; ++b) st_bf16x4(GLU + (size_t)(b * TT + tk) * CC + 16 * c16 + 4 * nq, y);
        }
    }
}

__device__ __forceinline__ void p2_conv(Frame& F, const Args& a) {
    unsigned char* ws = F.ws;
    LAS unsigned char* xs = F.lds;
    LAS float* wl = (LAS float*)(F.lds + 63488);
    const bf16_t* GLU = wsp<bf16_t>(ws, WS_GLU); bf16_t* CO = wsp<bf16_t>(ws, WS_CO);
    const float* cw = a.in[I_CONVW];
    for (int idx = F.tid; idx < CW * 128; idx += NTHREADS) { const int tap = idx >> 7, c4 = idx & 127; const f32x4 v = *(const f32x4*)(cw + tap * CC + 4 * c4); *(LAS f32x4*)(wl + tap * 512 + (c4 & 1) * 256 + (c4 >> 1) * 4) = v; }
    const int lane = F.lane, c0 = 8 * lane;
    for (int tile = F.bid; tile < NTOK / 32; tile += F.G) {
        const int b = tile >> 6, s0 = (tile & 63) * 32, p0 = NMETA + s0;
        __syncthreads();
        for (int idx = F.tid; idx < 62 * 64; idx += NTHREADS) { const int r = idx >> 6, ch = idx & 63, p = p0 - 30 + r; u32x4 v = (u32x4){0u, 0u, 0u, 0u};
            if (p >= 0) v = *(const u32x4*)(GLU + (size_t)(b * TT + p) * CC + ch * 8);
            *(LAS u32x4*)(xs + r * 1024 + ch * 16) = v; }
        __syncthreads();
        const int i0 = 4 * F.wave;
        float acc[4][8];
#pragma unroll
        for (int t = 0; t < 4; ++t)
#pragma unroll
            for (int i = 0; i < 8; ++i) acc[t][i] = 0.f;
        const LAS float* wlb = wl + lane * 4; asm volatile("" : "+v"(wlb));
        const LAS unsigned char* xsb = xs + i0 * 1024 + lane * 16; asm volatile("" : "+v"(xsb));
#pragma unroll 1
        for (int tap = 0; tap < CW; ++tap) {
            const f32x4 w0 = *(const LAS f32x4*)(wlb + tap * 512), w1 = *(const LAS f32x4*)(wlb + tap * 512 + 256);
#pragma unroll
            for (int t = 0; t < 4; ++t) {
                const u32x4 xv = *(const LAS u32x4*)(xsb + (tap + t) * 1024);
                acc[t][0] += w0[0] * bflo(xv.x); acc[t][1] += w0[1] * bfhi(xv.x); acc[t][2] += w0[2] * bflo(xv.y); acc[t][3] += w0[3] * bfhi(xv.y);
                acc[t][4] += w1[0] * bflo(xv.z); acc[t][5] += w1[1] * bfhi(xv.z); acc[t][6] += w1[2] * bflo(xv.w); acc[t][7] += w1[3] * bfhi(xv.w);
            }
        }
        float cb[8], lg[8], lb[8];
        { const f32x4* p0 = (const f32x4*)(a.in[I_CONVB] + c0); const f32x4* p1 = (const f32x4*)(a.in[I_LNG] + c0); const f32x4* p2 = (const f32x4*)(a.in[I_LNB] + c0);
#pragma unroll
          for (int hh = 0; hh < 2; ++hh) { const f32x4 u0 = p0[hh], u1 = p1[hh], u2 = p2[hh];
#pragma unroll
              for (int i = 0; i < 4; ++i) { cb[4 * hh + i] = u0[i]; lg[4 * hh + i] = u1[i]; lb[4 * hh + i] = u2[i]; } } }
#pragma unroll
        for (int t = 0; t < 4; ++t) {
            float s = 0.f;
#pragma unroll
            for (int i = 0; i < 8; ++i) { acc[t][i] += cb[i]; s += acc[t][i]; }
            const float mean = wave_sum(s) * (1.f / CC); float q = 0.f;
#pragma unroll
            for (int i = 0; i < 8; ++i) { acc[t][i] -= mean; q += acc[t][i] * acc[t][i]; }
            const float rstd = 1.0f / sqrtf(wave_sum(q) * (1.f / CC) + EPS);
            float y[8];
#pragma unroll
            for (int i = 0; i < 8; ++i) { const float z = acc[t][i] * rstd * lg[i] + lb[i]; y[i] = z * sigmoidf_(z); }
            u32x4 o; o.x = cvt_pk_bf16(y[0], y[1]); o.y = cvt_pk_bf16(y[2], y[3]); o.z = cvt_pk_bf16(y[4], y[5]); o.w = cvt_pk_bf16(y[6], y[7]);
            *(u32x4*)(CO + (size_t)(b * SEQ + s0 + i0 + t) * CC + c0) = o;
        }
    }
    __syncthreads();
}

constexpr int ROWP = 2080, NJ = 33;
__device__ __forceinline__ unsigned f2ord(float f) { const unsigned b = __float_as_uint(f); return b ^ ((b >> 31) ? 0xffffffffu : 0x80000000u); }
__device__ __forceinline__ int wave_isum(int v) {
#pragma unroll
    for (int o = 1; o < 64; o <<= 1) v += __shfl_xor(v, o);
    return v;
}
__device__ __forceinline__ int wave_isum_dpp(int v) {
    v += __builtin_amdgcn_update_dpp(0, v, 0xB1, 0xF, 0xF, false);
    v += __builtin_amdgcn_update_dpp(0, v, 0x4E, 0xF, 0xF, false);
    v += __builtin_amdgcn_update_dpp(0, v, 0x141, 0xF, 0xF, false);
    v += __builtin_amdgcn_update_dpp(0, v, 0x140, 0xF, 0xF, false);
    return __builtin_amdgcn_readlane(v, 0) + __builtin_amdgcn_readlane(v, 16) + __builtin_amdgcn_readlane(v, 32) + __builtin_amdgcn_readlane(v, 48);
}
__device__ __forceinline__ void p2_indexer_unit(Frame& F, int b, int q16, int flags) {
    unsigned char* ws = F.ws;
    const bf16_t* IQ = wsp<bf16_t>(ws, WS_IQ); const bf16_t* IK = wsp<bf16_t>(ws, WS_IK); const float* IW = wsp<float>(ws, WS_IW); unsigned* MASK = wsp<unsigned>(ws, WS_MASK);
    LAS unsigned* SU = (LAS unsigned*)F.lds;
    const int lane = F.lane, c = lane & 31, hi = lane >> 5, w = F.wave;
    const int nwblk = (q16 >> 1) + 2;
    if (!(flags & 4)) {
        const int tok0 = b * SEQ + 16 * q16;
        bf16x8 af[4][4]; f32x4 wq[4][4];
#pragma unroll
        for (int g = 0; g < 4; ++g) {
            const bf16_t* ap = IQ + (size_t)(tok0 + 4 * g + (c >> 3)) * AW + (c & 7) * IDXD + 8 * hi;
#pragma unroll
            for (int ks = 0; ks < 4; ++ks) af[g][ks] = *(const bf16x8*)(ap + 16 * ks);
#pragma unroll
            for (int q = 0; q < 4; ++q) wq[g][q] = *(const f32x4*)(IW + (size_t)(tok0 + 4 * g + q) * 8 + 4 * hi);
        }
        const int rel0 = NMETA + 16 * q16 + 2 * hi - c;
        const bf16_t* kp = IK + (size_t)b * IKBLK * 2048 + lane * 8;
        LAS unsigned* srow = SU + (2 * hi) * ROWP + c;
        bf16x8 bfr[4], bnx[4];
#pragma unroll
        for (int ks = 0; ks < 4; ++ks) { bfr[ks] = *(const bf16x8*)(kp + (size_t)(w < nwblk ? w : 0) * 2048 + 512 * ks); bnx[ks] = bfr[ks]; }
#pragma unroll
        for (int g = 0; g < 4; ++g) asm volatile("" :: "v"(af[g][0]), "v"(af[g][1]), "v"(af[g][2]), "v"(af[g][3]), "v"(wq[g][0]), "v"(wq[g][1]), "v"(wq[g][2]), "v"(wq[g][3]));
        asm volatile("" :: "v"(bfr[0]), "v"(bfr[1]), "v"(bfr[2]), "v"(bfr[3]));
        for (int blk = w; blk < nwblk; blk += 8) {
            {
                const int bn_ = blk + 8 < nwblk ? blk + 8 : blk;
#pragma unroll
                for (int ks = 0; ks < 4; ++ks) bnx[ks] = *(const bf16x8*)(kp + (size_t)bn_ * 2048 + 512 * ks); }
#pragma unroll
            for (int g = 0; g < 4; ++g) {
                f32x16 acc = {};
#pragma unroll
                for (int ks = 0; ks < 4; ++ks) acc = __builtin_amdgcn_mfma_f32_32x32x16_bf16(af[g][ks], bfr[ks], acc, 0, 0, 0);
                float part[4];
#pragma unroll
                for (int q = 0; q < 4; ++q) { float s = wq[g][q][0] * __builtin_amdgcn_fmed3f(acc[4 * q], 0.f, INFINITY);
#pragma unroll
                    for (int i = 1; i < 4; ++i) s = __builtin_fmaf(wq[g][q][i], __builtin_amdgcn_fmed3f(acc[4 * q + i], 0.f, INFINITY), s);
                    part[q] = s; }
#pragma unroll
                for (int p = 0; p < 2; ++p) {
                    const auto rr = __builtin_amdgcn_permlane32_swap(__float_as_uint(part[p]), __float_as_uint(part[p + 2]), false, false);
                    const float sc = __uint_as_float(rr[0]) + __uint_as_float(rr[1]);
                    srow[(4 * g + p) * ROWP + 32 * blk] = (32 * blk <= rel0 + 4 * g + p) ? f2ord(sc) : 0u; }
            }
#pragma unroll
            for (int ks = 0; ks < 4; ++ks) bfr[ks] = bnx[ks];
        }
    }
    __syncthreads();
    if (!(flags & 8)) {
        const int nj = (nwblk + 1) >> 1, klim = 32 * nwblk;
        unsigned U[NJ][2];
#pragma unroll
        for (int j = 0; j < NJ; ++j) {
            if (j < nj) { const int key = 64 * j + lane;
#pragma unroll
                for (int p = 0; p < 2; ++p) U[j][p] = (key < klim) ? SU[(2 * w + p) * ROWP + key] : 0u; }
            else { U[j][0] = 0u; U[j][1] = 0u; }
        }
        const int tokb = b * SEQ + 16 * q16 + 2 * w;
        unsigned lo[2], hb[2], thr[2], veq[2]; int chi[2], need[2]; bool done[2];
#pragma unroll
        for (int p = 0; p < 2; ++p) { lo[p] = 1u; hb[p] = 0xffffffffu; chi[p] = 0; need[p] = 0; veq[p] = 0u; thr[p] = 1u; done[p] = (NMETA + 16 * q16 + 2 * w + p + 1 <= TOPK); }
        for (int it = 0; it < 34; ++it) {
            if (done[0] && done[1]) break;
            unsigned mid[2]; int cl[2];
#pragma unroll
            for (int p = 0; p < 2; ++p) { mid[p] = lo[p] + ((hb[p] - lo[p]) >> 1); cl[p] = 0; }
#pragma unroll
            for (int g = 0; g < 3; ++g) if (11 * g < nj) {
#pragma unroll
                for (int jj = 0; jj < 11; ++jj)
#pragma unroll
                    for (int p = 0; p < 2; ++p) cl[p] += (U[11 * g + jj][p] >= mid[p]) ? 1 : 0; }
            const int tot = wave_isum_dpp(cl[0] | (cl[1] << 16));
            int cnt[2] = {tot & 0xffff, tot >> 16};
#ifdef DBG_CHECK_DPP
            if (wave_isum(cl[0]) != cnt[0] || wave_isum(cl[1]) != cnt[1]) __hip_atomic_store(wsp<unsigned>(ws, WS_CTL) + 3, 1u, RLX_AGENT);
#endif
#pragma unroll
            for (int p = 0; p < 2; ++p) {
                const int ct = cnt[p];
                if (!done[p]) {
                    if (ct == TOPK) { done[p] = true; thr[p] = mid[p]; need[p] = 0; }
                    else if (ct > TOPK) lo[p] = mid[p];
                    else { hb[p] = mid[p]; chi[p] = ct; }
                    if (!done[p] && hb[p] - lo[p] == 1u) { done[p] = true; thr[p] = hb[p]; veq[p] = lo[p]; need[p] = TOPK - chi[p]; }
                }
            }
        }
#pragma unroll
        for (int p = 0; p < 2; ++p) {
            int run = 0, wlo = 0, whi = 0;
#ifdef DBG_CHECK_SEL
            int selcnt = 0;
#endif
            const bool tied = need[p] > 0;
#pragma unroll
            for (int j = 0; j < NJ; ++j) if (j < nj) {
                const unsigned u = U[j][p];
                bool take = (u >= thr[p]);
                if (tied) {
                    const bool eq = (u == veq[p]);
                    const unsigned long long em = __ballot(eq);
                    const int rank = run + (int)__builtin_amdgcn_mbcnt_hi((unsigned)(em >> 32), __builtin_amdgcn_mbcnt_lo((unsigned)em, 0u));
                    take = take || (eq && rank < need[p]);
                    run += __popcll(em);
                }
                const unsigned long long sm = __ballot(take);
                wlo = (lane == j) ? (int)(unsigned)sm : wlo; whi = (lane == j) ? (int)(unsigned)(sm >> 32) : whi;
#ifdef DBG_CHECK_SEL
                selcnt += __popcll(sm);
#endif
            }
            unsigned long long* mrow = (unsigned long long*)(MASK + (size_t)(tokb + p) * MSTR);
            if (lane < nj) mrow[lane] = ((unsigned long long)(unsigned)whi << 32) | (unsigned)wlo;
#ifdef DBG_CHECK_SEL
            { const int nv = NMETA + 16 * q16 + 2 * w + p + 1; if (selcnt != (nv < TOPK ? nv : TOPK)) __hip_atomic_store(wsp<unsigned>(ws, WS_CTL) + 3, 1u, RLX_AGENT); }
#endif
        }
    }
    __syncthreads();
}
__device__ __forceinline__ void p2_indexer(Frame& F, int flags, int half) {
    for (int i = F.bid; i < 256; i += F.G) { const int b = i >> 5, j = 2 * (i & 31);
        if (half == 0) { p2_indexer_unit(F, b, j, flags); p2_indexer_unit(F, b, 127 - j, flags); }
        else { p2_indexer_unit(F, b, j + 1, flags); p2_indexer_unit(F, b, 126 - j, flags); } }
}

__device__ const unsigned char T5B[128] = {0, 1, 2, 3, 4, 5, 6, 7, 8, 9, 10, 11, 12, 13, 14, 15, 16, 16, 16, 17, 17, 18, 18, 18, 19, 19, 19, 20, 20, 20, 20, 21, 21, 21, 21, 22, 22, 22, 22, 22, 23, 23, 23, 23, 23, 23, 24, 24, 24, 24, 24, 24, 25, 25, 25, 25, 25, 25, 25, 26, 26, 26, 26, 26, 26, 26, 26, 27, 27, 27, 27, 27, 27, 27, 27, 27, 27, 28, 28, 28, 28, 28, 28, 28, 28, 28, 28, 29, 29, 29, 29, 29, 29, 29, 29, 29, 29, 29, 29, 30, 30, 30, 30, 30, 30, 30, 30, 30, 30, 30, 30, 30, 30, 31, 31, 31, 31, 31, 31, 31, 31, 31, 31, 31, 31, 31, 31, 31};
constexpr int TBS = 132;
__device__ __forceinline__ int crow(int r, int hi) { return (r & 3) + 8 * (r >> 2) + 4 * hi; }
constexpr int KPITCH = 144, VPITCH = 136;
constexpr int AT_K = 0, AT_V = AT_K + 2 * 64 * KPITCH, AT_TB = AT_V + 2 * 64 * VPITCH, AT_SC = AT_TB + NH * TBS * 4, AT_END = AT_SC + NWAVES * 128;
static_assert(AT_END <= RING_BYTES, "attention LDS map");
__device__ __forceinline__ void p3_attn_unit(Frame& F, int b, int h, int Q) {
    unsigned char* ws = F.ws;
    const bf16_t* Qm = wsp<bf16_t>(ws, WS_Q); const bf16_t* KB = wsp<bf16_t>(ws, WS_KB); const bf16_t* VT = wsp<bf16_t>(ws, WS_VT); const unsigned* MASK = wsp<unsigned>(ws, WS_MASK); bf16_t* AO = wsp<bf16_t>(ws, WS_AO);
    LAS unsigned char* lds = F.lds;
    const LAS float* tbh = (const LAS float*)(lds + AT_TB) + h * TBS;
    LAS float* sc = (LAS float*)(lds + AT_SC) + F.wave * 32;
    const int tid = F.tid, lane = F.lane, c = lane & 31, hi = lane >> 5, w = F.wave;
    const int qb32 = 8 * Q + w, tokq = b * SEQ + 32 * qb32 + c, posq = NMETA + 32 * qb32 + c;
    const int ktmax = (47 + 32 * qb32) >> 6, NT = 4 * Q + 5;
    bf16x8 qf[4];
#pragma unroll
    for (int ks = 0; ks < 4; ++ks) qf[ks] = *(const bf16x8*)(Qm + (size_t)tokq * AW + h * HD + 16 * ks + 8 * hi);
    const unsigned long long* mrow = (const unsigned long long*)(MASK + (size_t)tokq * MSTR);
    const int srow = tid >> 3, piece = tid & 7;
    const bf16_t* kg = KB + (size_t)(b * TT + srow) * AW + h * HD + piece * 8;
    const bf16_t* vg = VT + ((size_t)b * AW + h * HD + srow) * TP + piece * 8;
    LAS unsigned char* kl = lds + AT_K + srow * KPITCH + piece * 16;
    LAS unsigned char* vl = lds + AT_V + srow * VPITCH + piece * 16;
    const LAS unsigned char* kfb = lds + AT_K + c * KPITCH + 16 * hi;
    const LAS unsigned char* vfb = lds + AT_V + c * VPITCH + 8 * hi;
    const unsigned NEGB = 0xff800000u;
    const float bfar = tbh[128];
    float m_abs = 0.f; bool has = false;
    f32x16 O0 = {}, O1 = {}, LS = {}, CI;
#pragma unroll
    for (int r = 0; r < 16; ++r) CI[r] = bfar;
    const bf16x8 ones = __builtin_bit_cast(bf16x8, ((u32x4){0x3f803f80u, 0x3f803f80u, 0x3f803f80u, 0x3f803f80u}));
    u32x4 kr = *(const u32x4*)kg, vr = *(const u32x4*)vg;
    unsigned long long mwn = mrow[0];
    *(LAS u32x4*)kl = kr; *(LAS u32x2*)vl = (u32x2){vr.x, vr.y}; *(LAS u32x2*)(vl + 8) = (u32x2){vr.z, vr.w};
    __syncthreads();
    for (int kt = 0; kt < NT; ++kt) {
        const int buf = kt & 1;
        const unsigned long long mw = mwn;
        if (kt + 1 < NT) { kr = *(const u32x4*)(kg + (size_t)(kt + 1) * 64 * AW); vr = *(const u32x4*)(vg + (kt + 1) * 64); if (kt + 1 <= ktmax) mwn = mrow[kt + 1]; }
        if (kt <= ktmax) {
            const LAS unsigned char* kp = kfb + buf * 64 * KPITCH;
            f32x16 S0 = CI, S1 = CI;
#pragma unroll
            for (int ks = 0; ks < 4; ++ks) {
                const bf16x8 k0 = *(const LAS bf16x8*)(kp + ks * 32), k1 = *(const LAS bf16x8*)(kp + 32 * KPITCH + ks * 32);
                S0 = __builtin_amdgcn_mfma_f32_32x32x16_bf16(k0, qf[ks], S0, 0, 0, 0);
                S1 = __builtin_amdgcn_mfma_f32_32x32x16_bf16(k1, qf[ks], S1, 0, 0, 0);
            }
            const int mw0 = (int)((unsigned)mw >> (4 * hi)), mw1 = (int)((unsigned)(mw >> 32) >> (4 * hi));
            const bool far = (256 * Q + 32 * w - 64 * kt) >= 175;
            if (!far) {
                const int d0 = posq - 64 * kt - 4 * hi;
#pragma unroll
                for (int r = 0; r < 16; ++r) { const int ko = (r & 3) + 8 * (r >> 2);
                    int da = d0 - ko, db = d0 - 32 - ko; da = da < 0 ? 0 : (da > 128 ? 128 : da); db = db < 0 ? 0 : (db > 128 ? 128 : db);
                    S0[r] += tbh[da] - bfar; S1[r] += tbh[db] - bfar; }
            }
            float tmax = -INFINITY;
#pragma unroll
            for (int r = 0; r < 16; ++r) { const int ko = (r & 3) + 8 * (r >> 2);
                const unsigned t0 = (unsigned)__builtin_amdgcn_sbfe(mw0, ko, 1), t1 = (unsigned)__builtin_amdgcn_sbfe(mw1, ko, 1);
                S0[r] = __uint_as_float((__float_as_uint(S0[r]) & t0) | (NEGB & ~t0)); S1[r] = __uint_as_float((__float_as_uint(S1[r]) & t1) | (NEGB & ~t1));
                tmax = fmaxf(tmax, fmaxf(S0[r], S1[r])); }
            tmax = fmaxf(tmax, __shfl_xor(tmax, 32));
            if (__any(tmax > 8.0f || (!has && tmax > -INFINITY))) {
                const bool upd = tmax > -INFINITY && (!has || tmax > 0.f);
                const float dl = upd ? tmax : 0.f;
                const float alpha = has ? __builtin_amdgcn_exp2f(-dl) : 1.0f;
                m_abs += dl; has = has || upd;
#pragma unroll
                for (int r = 0; r < 16; ++r) { S0[r] -= dl; S1[r] -= dl; CI[r] = bfar - m_abs; }
                if (hi == 0) sc[c] = alpha;
                LDS_WAIT(); asm volatile("" ::: "memory");
#pragma unroll
                for (int r = 0; r < 16; ++r) { const float f = sc[crow(r, hi)]; O0[r] *= f; O1[r] *= f; LS[r] *= f; }
                LDS_WAIT(); asm volatile("" ::: "memory");
            }
#pragma unroll
            for (int r = 0; r < 16; ++r) { S0[r] = __builtin_amdgcn_exp2f(S0[r]); S1[r] = __builtin_amdgcn_exp2f(S1[r]); }
            const LAS unsigned char* vp = vfb + buf * 64 * VPITCH;
#pragma unroll
            for (int s2 = 0; s2 < 4; ++s2) {
                u32x4 pw;
                if (s2 < 2) { const int o = 8 * (s2 & 1); pw.x = cvt_pk_bf16(S0[o + 0], S0[o + 1]); pw.y = cvt_pk_bf16(S0[o + 2], S0[o + 3]); pw.z = cvt_pk_bf16(S0[o + 4], S0[o + 5]); pw.w = cvt_pk_bf16(S0[o + 6], S0[o + 7]); }
                else { const int o = 8 * (s2 & 1); pw.x = cvt_pk_bf16(S1[o + 0], S1[o + 1]); pw.y = cvt_pk_bf16(S1[o + 2], S1[o + 3]); pw.z = cvt_pk_bf16(S1[o + 4], S1[o + 5]); pw.w = cvt_pk_bf16(S1[o + 6], S1[o + 7]); }
                const bf16x8 pf = __builtin_bit_cast(bf16x8, pw);
                const u32x2 a0 = *(const LAS u32x2*)(vp + s2 * 32), a1 = *(const LAS u32x2*)(vp + s2 * 32 + 16);
                const u32x2 b0 = *(const LAS u32x2*)(vp + 32 * VPITCH + s2 * 32), b1 = *(const LAS u32x2*)(vp + 32 * VPITCH + s2 * 32 + 16);
                const bf16x8 v0 = __builtin_bit_cast(bf16x8, ((u32x4){a0.x, a0.y, a1.x, a1.y})), v1 = __builtin_bit_cast(bf16x8, ((u32x4){b0.x, b0.y, b1.x, b1.y}));
                O0 = __builtin_amdgcn_mfma_f32_32x32x16_bf16(pf, v0, O0, 0, 0, 0);
                O1 = __builtin_amdgcn_mfma_f32_32x32x16_bf16(pf, v1, O1, 0, 0, 0);
                LS = __builtin_amdgcn_mfma_f32_32x32x16_bf16(pf, ones, LS, 0, 0, 0);
            }
        }
        if (kt + 1 < NT) { LAS unsigned char* k2 = kl + (buf ^ 1) * 64 * KPITCH; LAS unsigned char* v2 = vl + (buf ^ 1) * 64 * VPITCH;
            *(LAS u32x4*)k2 = kr; *(LAS u32x2*)v2 = (u32x2){vr.x, vr.y}; *(LAS u32x2*)(v2 + 8) = (u32x2){vr.z, vr.w}; }
        __syncthreads();
    }
    bf16_t* ob = AO + (size_t)(b * SEQ + 32 * qb32) * AW + h * HD + c;
#pragma unroll
    for (int r = 0; r < 16; ++r) { const int qr = crow(r, hi); const float f = __builtin_amdgcn_rcpf(LS[r]);
        const float a0 = O0[r] * f, a1 = O1[r] * f, b0 = __shfl_xor(a0, 1), b1 = __shfl_xor(a1, 1);
        if ((c & 1) == 0) { *(unsigned*)(ob + (size_t)qr * AW) = cvt_pk_bf16(a0, b0); *(unsigned*)(ob + (size_t)qr * AW + 32) = cvt_pk_bf16(a1, b1); } }
}
__device__ __forceinline__ void p3_attn(Frame& F, const Args& a) {
    LAS float* tb = (LAS float*)(F.lds + AT_TB);
    __syncthreads();
    for (int idx = F.tid; idx < NH * 129; idx += NTHREADS) { const int h = idx / 129, d = idx % 129; const int bk = d < 128 ? (int)T5B[d] : 31; tb[h * TBS + d] = a.in[I_RELB][bk * NH + h] * LOG2E; }
    __syncthreads();
    for (int i = F.bid; i < 256; i += F.G) { const int bh = i >> 2, j = i & 3; p3_attn_unit(F, bh >> 3, bh & 7, j); p3_attn_unit(F, bh >> 3, bh & 7, 7 - j); }
    __syncthreads();
}

constexpr int WLP = 2064;
constexpr int P6_WHI = 0, P6_WLO = NE * WLP, P6_PART = 2 * NE * WLP, P6_SSP = P6_PART + 2 * 64 * 33 * 4, P6_CNT = P6_SSP + 2 * 64 * 4, P6_END = P6_CNT + 256;
static_assert(P6_END <= LDSX_OFF, "router LDS map");
__device__ __forceinline__ void p6_router(Frame& F, const Args& a) {
    unsigned char* ws = F.ws;
    const float* H1 = wsp<float>(ws, WS_H1); bf16_t* HN = wsp<bf16_t>(ws, WS_XN);
    const float* gf = a.in[I_NFFN]; const float* brt = a.in[I_BR];
    int* TE = wsp<int>(ws, WS_TE); int* TPs = wsp<int>(ws, WS_TP); int* LIST = wsp<int>(ws, WS_LIST); float* LG = wsp<float>(ws, WS_LG); float* RG = wsp<float>(ws, WS_RG);
    unsigned* ecnt = wsp<unsigned>(ws, WS_CTL) + CW_ECNT;
    LAS unsigned char* lds = F.lds;
    LAS float* part = (LAS float*)(lds + P6_PART);
    LAS float* ssp = (LAS float*)(lds + P6_SSP);
    LAS int* lcnt = (LAS int*)(lds + P6_CNT);
    LAS int* lbase = lcnt + 32;
    const int lane = F.lane, w = F.wave, tk = lane & 15, kq = lane >> 4;
    __syncthreads();
    { const unsigned char* src = ws + WS_WRT;
      for (int p = F.tid; p < 2 * NE * 128; p += NTHREADS) { const int arr = p >> 12, row = (p >> 7) & 31, c16 = p & 127;
          *(LAS u32x4*)(lds + arr * (NE * WLP) + row * WLP + c16 * 16) = *(const u32x4*)(src + (size_t)arr * NE * DM * 2 + (size_t)row * DM * 2 + c16 * 16); } }
    for (int tb = F.bid; tb < NTOK / 64; tb += F.G) {
        const int t0 = tb * 64;
        __syncthreads();
        if (F.tid < 32) lcnt[F.tid] = 0;
        {
            const int tg = w & 3, kh = w >> 2, tok = t0 + 16 * tg + tk;
            const float* xr = H1 + (size_t)tok * DM + 512 * kh + 8 * kq; const float* gr = gf + 512 * kh + 8 * kq;
            bf16_t* hr = HN + (size_t)tok * DM + 512 * kh + 8 * kq;
            const LAS unsigned char* wl = lds + tk * WLP + (512 * kh + 8 * kq) * 2;
            f32x4 xa[16], xb[16];
#pragma unroll
            for (int ks = 0; ks < 16; ++ks) { xa[ks] = *(const f32x4*)(xr + 32 * ks); xb[ks] = *(const f32x4*)(xr + 32 * ks + 4); }
            f32x4 acc0 = {0.f, 0.f, 0.f, 0.f}, acc1 = acc0; float ss = 0.f;
#pragma unroll
            for (int ks = 0; ks < 16; ++ks) {
                const f32x4 g0 = *(const f32x4*)(gr + 32 * ks), g1 = *(const f32x4*)(gr + 32 * ks + 4);
                const f32x4 x0 = xa[ks], x1 = xb[ks];
                u32x4 hn; hn.x = cvt_pk_bf16(x0[0] * g0[0], x0[1] * g0[1]); hn.y = cvt_pk_bf16(x0[2] * g0[2], x0[3] * g0[3]); hn.z = cvt_pk_bf16(x1[0] * g1[0], x1[1] * g1[1]); hn.w = cvt_pk_bf16(x1[2] * g1[2], x1[3] * g1[3]);
                *(u32x4*)(hr + 32 * ks) = hn;
                ss += (x0[0] * x0[0] + x0[1] * x0[1]) + (x0[2] * x0[2] + x0[3] * x0[3]) + (x1[0] * x1[0] + x1[1] * x1[1]) + (x1[2] * x1[2] + x1[3] * x1[3]);
                u32x4 xh; xh.x = cvt_pk_bf16(x0[0], x0[1]); xh.y = cvt_pk_bf16(x0[2], x0[3]); xh.z = cvt_pk_bf16(x1[0], x1[1]); xh.w = cvt_pk_bf16(x1[2], x1[3]);
                u32x4 xl; xl.x = cvt_pk_bf16(x0[0] - bflo(xh.x), x0[1] - bfhi(xh.x)); xl.y = cvt_pk_bf16(x0[2] - bflo(xh.y), x0[3] - bfhi(xh.y));
                          xl.z = cvt_pk_bf16(x1[0] - bflo(xh.z), x1[1] - bfhi(xh.z)); xl.w = cvt_pk_bf16(x1[2] - bflo(xh.w), x1[3] - bfhi(xh.w));
                const bf16x8 fxh = __builtin_bit_cast(bf16x8, xh), fxl = __builtin_bit_cast(bf16x8, xl);
                const bf16x8 wh0 = *(const LAS bf16x8*)(wl + P6_WHI + ks * 64), wh1 = *(const LAS bf16x8*)(wl + P6_WHI + 16 * WLP + ks * 64);
                const bf16x8 wl0 = *(const LAS bf16x8*)(wl + P6_WLO + ks * 64), wl1 = *(const LAS bf16x8*)(wl + P6_WLO + 16 * WLP + ks * 64);
                acc0 = __builtin_amdgcn_mfma_f32_16x16x32_bf16(wh0, fxh, acc0, 0, 0, 0); acc1 = __builtin_amdgcn_mfma_f32_16x16x32_bf16(wh1, fxh, acc1, 0, 0, 0);
                acc0 = __builtin_amdgcn_mfma_f32_16x16x32_bf16(wl0, fxh, acc0, 0, 0, 0); acc1 = __builtin_amdgcn_mfma_f32_16x16x32_bf16(wl1, fxh, acc1, 0, 0, 0);
                acc0 = __builtin_amdgcn_mfma_f32_16x16x32_bf16(wh0, fxl, acc0, 0, 0, 0); acc1 = __builtin_amdgcn_mfma_f32_16x16x32_bf16(wh1, fxl, acc1, 0, 0, 0);
            }
            ss += __shfl_xor(ss, 16); ss += __shfl_xor(ss, 32);
            LAS float* pp = part + ((kh * 64) + 16 * tg + tk) * 33 + 4 * kq;
#pragma unroll
            for (int r = 0; r < 4; ++r) { pp[r] = acc0[r]; pp[16 + r] = acc1[r]; }
            if (kq == 0) ssp[kh * 64 + 16 * tg + tk] = ss;
        }
        __syncthreads();
        if (w == 0) {
            const float rinv = 1.0f / sqrtf((ssp[lane] + ssp[64 + lane]) * (1.f / DM) + EPS);
            float lg[NE];
#pragma unroll
            for (int e = 0; e < NE; ++e) lg[e] = (part[lane * 33 + e] + part[(64 + lane) * 33 + e]) * rinv + brt[e];
            int sel[4]; float val[4];
#pragma unroll
            for (int j = 0; j < 4; ++j) { float best = -INFINITY; int bi = 0;
#pragma unroll
                for (int e = 0; e < NE; ++e) { const bool tk_ = lg[e] > best; best = tk_ ? lg[e] : best; bi = tk_ ? e : bi; }
                sel[j] = bi; val[j] = best;
#pragma unroll
                for (int e = 0; e < NE; ++e) lg[e] = (e == bi) ? -INFINITY : lg[e]; }
            float den = 0.f, ex[4];
#pragma unroll
            for (int j = 0; j < 4; ++j) { ex[j] = __expf(val[j] - val[0]); den += ex[j]; }
            int slot[4];
#pragma unroll
            for (int j = 0; j < 4; ++j) slot[j] = __hip_atomic_fetch_add(&lcnt[sel[j]], 1, __ATOMIC_RELAXED, __HIP_MEMORY_SCOPE_WORKGROUP);
            LDS_WAIT();
            if (lane < 32) { const int n = lcnt[lane]; lbase[lane] = n ? (int)__hip_atomic_fetch_add(ecnt + 64 * lane, (unsigned)n, RLX_AGENT) : 0; }
            LDS_WAIT(); asm volatile("" ::: "memory");
            const int t = t0 + lane;
#pragma unroll
            for (int j = 0; j < 4; ++j) { const int e = sel[j], pos = lbase[e] + slot[j]; const float g = ex[j] / den;
                TE[t * 4 + j] = e; TPs[t * 4 + j] = pos; LIST[(size_t)e * NTOK + pos] = t; LG[(size_t)e * NTOK + pos] = g; RG[(size_t)e * NTOK + pos] = rinv; }
        }
    }
    __syncthreads();
}
__device__ __forceinline__ void moe_tables(Frame& F, LAS int* cnt, LAS int* tbase) {
    const unsigned* ecnt = wsp<unsigned>(F.ws, WS_CTL) + CW_ECNT;
    __syncthreads();
    if (F.tid < NE) cnt[F.tid] = (int)__hip_atomic_load(ecnt + 64 * F.tid, RLX_AGENT);
    __syncthreads();
    if (F.tid == 0) { int s = 0; for (int e = 0; e < NE; ++e) { tbase[e] = s; s += (cnt[e] + 255) >> 8; } tbase[NE] = s; }
    __syncthreads();
}

__device__ __forceinline__ void p9_final(Frame& F, const Args& a, const LAS int* tbase) {
    unsigned char* ws = F.ws;
    const float* H1 = wsp<float>(ws, WS_H1); float* OUT = a.out; const bf16_t* YP = wsp<bf16_t>(ws, WS_YP); const int* TE = wsp<int>(ws, WS_TE); const int* TPs = wsp<int>(ws, WS_TP); const float* gf = a.in[I_NFIN];
    const int gw = F.bid * NWAVES + F.wave, NGW = F.G * NWAVES, lane = F.lane;
    const f32x4* gr = (const f32x4*)gf + lane;
    f32x4 gg[4];
#pragma unroll
    for (int j = 0; j < 4; ++j) gg[j] = gr[64 * j];
#ifdef DBG_CHECK_DPP
    if (__hip_atomic_load(wsp<unsigned>(ws, WS_CTL) + 3, RLX_AGENT) != 0u) { const float qn = __builtin_nanf("");
#pragma unroll
        for (int j = 0; j < 4; ++j) gg[j] = (f32x4){qn, qn, qn, qn}; }
#endif
    for (int base = 0; base < NTOK; base += 8 * NGW) {
        int myrow = 0;
        { const int i = lane >> 2, j = lane & 3, t = base + gw + NGW * i; if (lane < 32 && t < NTOK) { const int e = TE[t * 4 + j], pos = TPs[t * 4 + j]; myrow = tbase[e] * 256 + pos; } }
        f32x4 va[4], vb[4]; u32x2 ya[4][4], yb[4][4];
#define P9_LOAD(i, V, Y) do { const int t_ = base + gw + NGW * (i); if (t_ < NTOK) { const f32x4* xr_ = (const f32x4*)(H1 + (size_t)t_ * DM) + lane; \
            _Pragma("unroll") for (int j_ = 0; j_ < 4; ++j_) V[j_] = xr_[64 * j_]; \
            _Pragma("unroll") for (int q_ = 0; q_ < 4; ++q_) { const int row_ = __builtin_amdgcn_readlane(myrow, 4 * (i) + q_); const u32x2* yr_ = (const u32x2*)(YP + (size_t)row_ * DM) + lane; \
                _Pragma("unroll") for (int j_ = 0; j_ < 4; ++j_) Y[q_][j_] = yr_[64 * j_]; } } } while (0)
#define P9_PROC(i, V, Y) do { const int t_ = base + gw + NGW * (i); if (t_ < NTOK) { \
            _Pragma("unroll") for (int q_ = 0; q_ < 4; ++q_) _Pragma("unroll") for (int j_ = 0; j_ < 4; ++j_) { const u32x2 y_ = Y[q_][j_]; V[j_].x += bflo(y_.x); V[j_].y += bfhi(y_.x); V[j_].z += bflo(y_.y); V[j_].w += bfhi(y_.y); } \
            float s_ = 0.f; _Pragma("unroll") for (int j_ = 0; j_ < 4; ++j_) s_ += (V[j_].x * V[j_].x + V[j_].y * V[j_].y) + (V[j_].z * V[j_].z + V[j_].w * V[j_].w); \
            const float r_ = 1.0f / sqrtf(wave_sum(s_) * (1.f / DM) + EPS); f32x4* xo_ = (f32x4*)(OUT + (size_t)t_ * DM) + lane; \
            _Pragma("unroll") for (int j_ = 0; j_ < 4; ++j_) xo_[64 * j_] = (f32x4){V[j_].x * r_ * gg[j_].x, V[j_].y * r_ * gg[j_].y, V[j_].z * r_ * gg[j_].z, V[j_].w * r_ * gg[j_].w}; } } while (0)
        P9_LOAD(0, va, ya);
#pragma unroll
        for (int i = 0; i < 8; i += 2) {
            P9_LOAD(i + 1, vb, yb);
            P9_PROC(i, va, ya);
            if (i + 2 < 8) P9_LOAD(i + 2, va, ya);
            P9_PROC(i + 1, vb, yb);
        }
#undef P9_LOAD
#undef P9_PROC
    }
}

constexpr int N_PHASES = 10;
__global__ void __launch_bounds__(NTHREADS, 2) fwd_kernel(Args args) {
    extern __shared__ __attribute__((aligned(16))) unsigned char lds_raw[];
    Frame F;
    F.lds = (LAS unsigned char*)lds_raw; F.ws = args.ws;
    F.tid = threadIdx.x; F.lane = F.tid & 63; F.wave = __builtin_amdgcn_readfirstlane(F.tid >> 6);
    F.G = gridDim.x; F.bid = blockIdx.x;
    volatile LAS unsigned* MISC = (volatile LAS unsigned*)(F.lds + MISC_OFF);
    if (F.tid < 32) MISC[F.tid] = 0u;
    __syncthreads();
    unsigned* ctl = wsp<unsigned>(args.ws, WS_CTL);
    const int lo = args.ph_lo, hi = args.ph_hi;
    const bool multi = (hi - lo) > 1;
    XcdBarrier bar; bar.bar = ctl + CW_BAR; bar.x = 0; bar.st = nullptr;
    if (multi) bar = xcd_barrier_post(ctl + CW_BAR, MISC + 8);
#ifndef PHASE_MASK
#define PHASE_MASK 0x3ff
#endif
#define IN(k) (((PHASE_MASK >> (k)) & 1) && lo <= (k) && (k) < hi)
#define SEAM(k) do { if (IN(k) && IN((k) + 1)) xcd_barrier(bar); } while (0)
    LAS int* l_cnt = (LAS int*)(F.lds + LDSX_OFF); LAS int* l_tbase = l_cnt + 64;
    const MoeTables MT{l_cnt, l_tbase};

    if (IN(0)) { p0_prologue(F, args, 0); } SEAM(0);
    if (IN(1)) {
        PlainSched S; S.init(args.ws, WS_XN, WS_WIN, NTOK, 5120, DM, F.G, F.bid);
        EpiInProj E{args.ws, args.in[I_BGATE]};
        if (!(args.flags & 64)) pg8::gemm_phase<EpiInProj, PlainSched>(F.lds, DM, S, E);
        if (!(args.flags & 128)) p1_thin(F, args.flags);
    } SEAM(1);
    if (IN(2)) {
        const int cvt_slot = (F.bid >> 3) % 3;
        if (cvt_slot == 0 && !(args.flags & 1024)) { p0_prologue(F, args, 1); __syncthreads(); }
        if (!(args.flags & 1)) p2_conv(F, args);
        if (!(args.flags & 2)) p2_indexer(F, args.flags, 0);
        if (cvt_slot == 1 && !(args.flags & 1024)) { __syncthreads(); p0_prologue(F, args, 1); __syncthreads(); }
        if (!(args.flags & 2)) p2_indexer(F, args.flags, 1);
        if (cvt_slot == 2 && !(args.flags & 1024)) { __syncthreads(); p0_prologue(F, args, 1); }
    } SEAM(2);
    if (IN(3)) { p3_attn(F, args); } SEAM(3);
    if (IN(4)) {
        MergeSched S{(const char*)args.ws, F.G, F.bid}; EpiMerge E{args.ws};
        pg8::gemm_phase<EpiMerge, MergeSched>(F.lds, 512, S, E);
    } SEAM(4);
    if (IN(5)) {
        PlainSched S; S.init(args.ws, WS_MG, WS_WOUT, NTOK, DM, DM, F.G, F.bid);
        EpiResid E{args.in[I_X], wsp<float>(args.ws, WS_H1)};
        pg8::gemm_phase<EpiResid, PlainSched>(F.lds, DM, S, E);
    } SEAM(5);
    if (IN(6)) { p6_router(F, args); } SEAM(6);
    if (IN(7)) {
        moe_tables(F, l_cnt, l_tbase);
        MoeSched<8, true> S{(const char*)args.ws, MT, F.G, F.bid, l_tbase[NE] * 8};
        EpiSwiglu E{args.ws, args.in[I_BUG], MT};
        pg8::gemm_phase<EpiSwiglu, MoeSched<8, true>>(F.lds, DM, S, E);
    } SEAM(7);
    if (IN(8)) {
        moe_tables(F, l_cnt, l_tbase);
        MoeSched<4, false> S{(const char*)args.ws, MT, F.G, F.bid, l_tbase[NE] * 4};
        EpiDown E{args.ws, args.in[I_BD], MT};
        pg8::gemm_phase<EpiDown, MoeSched<4, false>>(F.lds, DFF, S, E);
    } SEAM(8);
    if (IN(9)) { moe_tables(F, l_cnt, l_tbase); p9_final(F, args, l_tbase); }
#undef IN
#undef SEAM
}

#ifdef DBG_HASH_OFF
__global__ void dbg_hash(const unsigned* __restrict__ buf, size_t nwords, unsigned* acc) {
    unsigned h = 0u;
    for (size_t i = (size_t)blockIdx.x * blockDim.x + threadIdx.x; i < nwords; i += (size_t)gridDim.x * blockDim.x) h += (buf[i] ^ (unsigned)(i * 2654435761u)) * 2246822519u + (unsigned)i;
#pragma unroll
    for (int o = 1; o < 64; o <<= 1) h += __shfl_xor(h, o);
    if ((threadIdx.x & 63) == 0) atomicAdd(acc, h);
}
__global__ void dbg_fill(float* out, size_t n, const unsigned* acc) {
    const unsigned h = *acc; const float v = (float)((h >> 7) & 0xffffu) * (1.0f / 4096.0f) + 1.0f;
    for (size_t i = (size_t)blockIdx.x * blockDim.x + threadIdx.x; i < n; i += (size_t)gridDim.x * blockDim.x) out[i] = v;
}
#endif

extern "C" void kernel_launch(void* const* d_in, const int* in_sizes, int n_in, void* d_out, int out_size, void* d_ws, size_t ws_size, hipStream_t stream) {
    static int grid = 0;
    if (grid == 0) {
        if (n_in != 21 || out_size != NTOK * DM || ws_size < WS_END) { fprintf(stderr, "kernel_launch: unexpected shapes (n_in %d, out %d, ws %zu < %zu)\n", n_in, out_size, ws_size, (size_t)WS_END); grid = -1; return; }
        int dev = 0, cus = 0, per_cu = 0;
        if (hipGetDevice(&dev) != hipSuccess || hipDeviceGetAttribute(&cus, hipDeviceAttributeMultiprocessorCount, dev) != hipSuccess) { grid = -1; return; }
        if (hipFuncSetAttribute((const void*)fwd_kernel, hipFuncAttributeMaxDynamicSharedMemorySize, LDS_BYTES) != hipSuccess) { fprintf(stderr, "kernel_launch: hipFuncSetAttribute failed\n"); grid = -1; return; }
        if (hipOccupancyMaxActiveBlocksPerMultiprocessor(&per_cu, (const void*)fwd_kernel, NTHREADS, LDS_BYTES) != hipSuccess || per_cu < 1) { fprintf(stderr, "kernel_launch: occupancy query says %d\n", per_cu); }
        (void)hipGetLastError();
        grid = cus;
    }
    if (grid < 0) return;
    (void)hipMemsetAsync((char*)d_ws + WS_CTL, 0, CTL_ZERO_BYTES, stream);
    Args a{};
    for (int i = 0; i < 21; ++i) a.in[i] = (const float*)d_in[i];
    a.out = (float*)d_out; a.ws = (unsigned char*)d_ws;
#if MK_N_LAUNCHES == 1
    a.ph_lo = 0; a.ph_hi = N_PHASES;
    hipLaunchKernelGGL(fwd_kernel, dim3(grid), dim3(NTHREADS), LDS_BYTES, stream, a);
#else
#ifndef DBG_LAST_PHASE
#define DBG_LAST_PHASE (N_PHASES - 1)
#endif
#ifndef DBG_DUP_MASK
#define DBG_DUP_MASK 0
#endif
#ifndef DBG_DUP_FLAGS
#define DBG_DUP_FLAGS 0
#endif
    for (int p = 0; p <= DBG_LAST_PHASE; ++p) { a.ph_lo = p; a.ph_hi = p + 1;
        const int nrep = ((DBG_DUP_MASK >> p) & 1) ? 2 : 1;
        for (int rep = 0; rep < nrep; ++rep) { a.flags = (nrep == 2 && rep == 0) ? DBG_DUP_FLAGS : 0; if (rep == 1 && p == 6) (void)hipMemsetAsync((char*)d_ws + WS_CTL, 0, CTL_ZERO_BYTES, stream);
            hipLaunchKernelGGL(fwd_kernel, dim3(grid), dim3(NTHREADS), LDS_BYTES, stream, a); } }
#ifdef DBG_HASH_OFF
    { const unsigned* hb = DBG_HASH_OFF == 0 ? (const unsigned*)d_out : (const unsigned*)((char*)d_ws + DBG_HASH_OFF);
      hipLaunchKernelGGL(dbg_hash, dim3(1024), dim3(256), 0, stream, hb, (size_t)(DBG_HASH_BYTES) / 4, (unsigned*)d_ws + 2);
      hipLaunchKernelGGL(dbg_fill, dim3(1024), dim3(256), 0, stream, (float*)d_out, (size_t)NTOK * DM, (const unsigned*)d_ws + 2); }
#endif
#endif
}
```

```cpp
#include <hip/hip_runtime.h>
#include <cstdio>
#include <cstdint>

#ifndef MK_N_LAUNCHES
#define MK_N_LAUNCHES 1
#endif

constexpr int NB = 8, SEQ = 2048, NMETA = 16, TT = SEQ + NMETA  , DM = 1024, NTOK = NB * SEQ  , NALL = NB * TT  ;
constexpr int AW = 512, NH = 8, HD = 64, IDXD = 64, CC = 512, CW = 31, NE = 32, DFF = 1024, TOPK = 256;
constexpr int INCOLS = 5192, TP = 2176  , VOFF = 0  , MSTR = 68  ;
constexpr float EPS = 1e-6f, LOG2E = 1.4426950408889634f;
constexpr float QSCALE = 0.125f * LOG2E;
constexpr int MAXTILES = 296;
constexpr int SC_Q = 0, SC_K = 512, SC_V = 1024, SC_IQ = 1536, SC_IK = 2048, SC_IW = 2112, SC_GLU = 2120, SC_GATE = 3144;
constexpr int WR_GLU = 2048, WR_GATE = 3072, WR_IK = 5120, WR_IW = 5184, WIN_ROWS = 5376;

constexpr size_t MiB = 1u << 20;
constexpr size_t al4k(size_t x) { return (x + 4095) & ~(size_t)4095; }
constexpr size_t WS_CTL = 0, CTL_ZERO_BYTES = 1 * MiB;
constexpr size_t WS_WIN = 1 * MiB;
constexpr size_t WS_WAO = WS_WIN + al4k((size_t)WIN_ROWS * DM * 2);
constexpr size_t WS_WCO = WS_WAO + al4k((size_t)DM * AW * 2);
constexpr size_t WS_WOUT = WS_WCO + al4k((size_t)DM * CC * 2);
constexpr size_t WS_WUG = WS_WOUT + al4k((size_t)DM * DM * 2);
constexpr size_t WS_WD = WS_WUG + al4k((size_t)NE * 2 * DFF * DM * 2);
constexpr size_t WS_XN = WS_WD + al4k((size_t)NE * DM * DFF * 2);
constexpr size_t WS_XNM = WS_XN + al4k((size_t)NTOK * DM * 2);
constexpr size_t WS_Q = WS_XNM + al4k((size_t)NMETA * DM * 2);
constexpr size_t WS_IQ = WS_Q + al4k((size_t)NTOK * AW * 2);
constexpr size_t WS_KB = WS_IQ + al4k((size_t)NTOK * AW * 2);
constexpr size_t WS_VT = WS_KB + al4k((size_t)(NALL + 64) * AW * 2);
constexpr size_t WS_IK = WS_VT + al4k((size_t)NB * AW * TP * 2);
constexpr size_t WS_IW = WS_IK + al4k((size_t)NB * 65 * 2048 * 2);
constexpr size_t WS_GLU = WS_IW + al4k((size_t)NTOK * 8 * 4);
constexpr size_t WS_GA = WS_GLU + al4k((size_t)NALL * CC * 2);
constexpr size_t WS_GB = WS_GA + al4k((size_t)NTOK * DM * 2);
constexpr size_t WS_MASK = WS_GB + al4k((size_t)NTOK * DM * 2);
constexpr size_t WS_AO = WS_MASK + al4k((size_t)NTOK * MSTR * 4);
constexpr size_t WS_CO = WS_AO + al4k((size_t)NTOK * AW * 2);
constexpr size_t WS_MG = WS_CO + al4k((size_t)NTOK * CC * 2);
constexpr size_t WS_TE = WS_MG + al4k((size_t)NTOK * DM * 2);
constexpr size_t WS_TP = WS_TE + al4k((size_t)NTOK * 4 * 4);
constexpr size_t WS_LIST = WS_TP + al4k((size_t)NTOK * 4 * 4);
constexpr size_t WS_LG = WS_LIST + al4k((size_t)NE * NTOK * 4);
constexpr size_t WS_ACT = WS_LG + al4k((size_t)NE * NTOK * 4);
constexpr size_t WS_YP = WS_ACT + al4k((size_t)MAXTILES * 256 * DFF * 2);
constexpr size_t WS_H1 = WS_YP + al4k((size_t)MAXTILES * 256 * DM * 2);
constexpr size_t WS_WRT = WS_H1 + al4k((size_t)NTOK * DM * 4);
constexpr size_t WS_RG = WS_WRT + al4k((size_t)2 * NE * DM * 2);
constexpr size_t WS_DUMMY = WS_RG + al4k((size_t)NE * NTOK * 4);
constexpr size_t WS_END = WS_DUMMY + 4096;
static_assert(WS_END < ((size_t)1 << 32), "32-bit byte offsets into d_ws");
constexpr int CW_TMO = 0, CW_CODE = 1, CW_BAR = 4096, CW_ECNT = 16384;

constexpr int RING_BYTES = 131072;
constexpr int LDSX_OFF = 153600;
constexpr int MISC_OFF = 161792;
constexpr int LDS_BYTES = 163840;
constexpr int NWAVES = 8, NTHREADS = 512;

#define GAS __attribute__((address_space(1)))
#define LAS __attribute__((address_space(3)))
typedef unsigned short bf16_t;
typedef short bf16x8 __attribute__((ext_vector_type(8)));
typedef short s16x4 __attribute__((ext_vector_type(4)));
typedef float f32x4 __attribute__((ext_vector_type(4)));
typedef float f32x16 __attribute__((ext_vector_type(16)));
typedef unsigned u32x4 __attribute__((ext_vector_type(4)));
typedef unsigned u32x2 __attribute__((ext_vector_type(2)));
typedef GAS unsigned gu32;
#define RLX_AGENT __ATOMIC_RELAXED, __HIP_MEMORY_SCOPE_AGENT
#define LDS_WAIT() asm volatile("s_waitcnt lgkmcnt(0)" ::: "memory")
#define VM_WAIT() asm volatile("s_waitcnt vmcnt(0)" ::: "memory")

typedef float f32x2_t __attribute__((ext_vector_type(2))); typedef __bf16 bf16x2_t __attribute__((ext_vector_type(2)));
__device__ __forceinline__ unsigned cvt_pk_bf16(float lo, float hi) { const f32x2_t v = {lo, hi}; const bf16x2_t b = __builtin_convertvector(v, bf16x2_t); return __builtin_bit_cast(unsigned, b); }
__device__ __forceinline__ float bf2f(unsigned short b) { return __uint_as_float((unsigned)b << 16); }
__device__ __forceinline__ float bflo(unsigned w) { return __uint_as_float(w << 16); }
__device__ __forceinline__ float bfhi(unsigned w) { return __uint_as_float(w & 0xffff0000u); }
__device__ __forceinline__ float sigmoidf_(float x) { return __builtin_amdgcn_rcpf(1.0f + __builtin_amdgcn_exp2f(-LOG2E * x)); }
__device__ __forceinline__ float wave_sum(float v) {
#pragma unroll
    for (int o = 1; o < 64; o <<= 1) v += __shfl_xor(v, o);
    return v;
}

namespace pg8 {
constexpr int BM = 256, BK = 64, HALF = 128, HTB = HALF * BK * 2, STAGE_BYTES = 8 * HTB;
__host__ __device__ __forceinline__ int lds_byte(int r, int c) { const int st = (r >> 4) * 2 + (c >> 5), rr = r & 15, cc = c & 31, ob = rr * 64 + cc * 2; return st * 1024 + (ob ^ (((ob >> 9) & 1) << 5)); }
__host__ __device__ __forceinline__ void stage_rc(int b, int& R, int& C) { const int st = b / 1024, sb = b % 1024, swz = sb ^ (((sb >> 9) & 1) << 5); R = (st >> 1) * 16 + swz / 64; C = (st & 1) * 32 + (swz % 64) / 2; }

struct Unit { int pm, pn, z; };

template <class Epi, class Sched>
__device__ __forceinline__ void gemm_phase(LAS unsigned char* lds, const int K, const Sched& S, const Epi& E) {
    const int tid = threadIdx.x, wid = __builtin_amdgcn_readfirstlane(tid >> 6), lane = tid & 63, wr = wid >> 2, wc = wid & 3, fr = lane & 15, fq = lane >> 4;
    const int nt = K / BK;
    unsigned voffB[2];
#pragma unroll
    for (int i = 0; i < 2; ++i) { int R_, C_; stage_rc(tid * 16 + i * 8192, R_, C_); const int rho = R_ & 31, Rp = (R_ & ~31) + 8 * ((rho & 15) >> 2) + 4 * (rho >> 4) + (rho & 3);
                                  voffB[i] = (unsigned)(Rp * K + C_) * 2u; }
    const size_t kstep = (size_t)(BK * 2);
    const size_t hstep = (size_t)HALF * K * 2;
    const unsigned ldsw = (unsigned)wid * 1024u;
    const int aoff = lds_byte(wr * 64 + fr, fq * 8), boff = lds_byte(wc * 32 + fr, fq * 8);
    const char* const abase = S.a_base();
#define PG8_SA(b, h) (((b) * 2 + (h)) * HTB)
#define PG8_SB(b, h) ((4 + (b) * 2 + (h)) * HTB)
#define PG8_STAGE(bufoff, gbase, voff) do { _Pragma("unroll") for (int _i = 0; _i < 2; ++_i) \
        __builtin_amdgcn_global_load_lds((const unsigned*)((const char*)(gbase) + (voff)[_i]), (LAS unsigned*)(lds + (bufoff) + ldsw + _i * 8192), 16, 0, 0); } while (0)
#define PG8_LDA(dst, b, h) do { _Pragma("unroll") for (int m = 0; m < 4; ++m) _Pragma("unroll") for (int k = 0; k < 2; ++k) dst[m][k] = *(const LAS bf16x8*)(lds + PG8_SA(b, h) + aoff + m * 2048 + k * 1024); } while (0)
#define PG8_LDB(dst, b, h) do { _Pragma("unroll") for (int n = 0; n < 2; ++n) _Pragma("unroll") for (int k = 0; k < 2; ++k) dst[n][k] = *(const LAS bf16x8*)(lds + PG8_SB(b, h) + boff + n * 2048 + k * 1024); } while (0)
#define PG8_MMA(ai, bj, At, Bt) do { __builtin_amdgcn_s_setprio(1); _Pragma("unroll") for (int m = 0; m < 4; ++m) _Pragma("unroll") for (int n = 0; n < 2; ++n) _Pragma("unroll") for (int k = 0; k < 2; ++k) \
        acc[ai][bj][m][n] = __builtin_amdgcn_mfma_f32_16x16x32_bf16(Bt[n][k], At[m][k], acc[ai][bj][m][n], 0, 0, 0); __builtin_amdgcn_s_setprio(0); } while (0)
#define PG8_WAIT_V(n) asm volatile("s_waitcnt vmcnt(" #n ")" ::: "memory")
#define PG8_WAIT_L(n) asm volatile("s_waitcnt lgkmcnt(" #n ")" ::: "memory")
#define PG8_BAR __builtin_amdgcn_s_barrier()
#define PG8_SCHED __builtin_amdgcn_sched_barrier(0)
    Unit cur, nxt; int ui = 0;
    if (!S.next(0, cur)) return;
    f32x4 acc[2][2][4][2];
#pragma unroll
    for (int a = 0; a < 2; ++a)
#pragma unroll
        for (int b = 0; b < 2; ++b)
#pragma unroll
            for (int m = 0; m < 4; ++m)
#pragma unroll
                for (int n = 0; n < 2; ++n) acc[a][b][m][n] = (f32x4){0.f, 0.f, 0.f, 0.f};
    bf16x8 At[4][2], B0[2][2], B1[2][2];
    unsigned ca[2][2], na[2][2];
    S.a_offs(cur, tid, ca);
    const char* cB = S.b_base(cur);
    PG8_STAGE(PG8_SB(0, 0), cB, voffB); PG8_STAGE(PG8_SB(0, 1), cB + hstep, voffB); PG8_STAGE(PG8_SA(0, 0), abase, ca[0]); PG8_STAGE(PG8_SA(0, 1), abase, ca[1]);
    if (wr == 1) PG8_BAR;
    PG8_WAIT_V(2); PG8_BAR;
    PG8_STAGE(PG8_SB(1, 0), cB + kstep, voffB); PG8_STAGE(PG8_SA(1, 0), abase + kstep, ca[0]); PG8_STAGE(PG8_SB(1, 1), cB + hstep + kstep, voffB);
    PG8_WAIT_V(6); PG8_BAR;
    for (;;) {
        const bool has_next = S.next(ui + 1, nxt);
        const char* nB = cB;
#pragma unroll
        for (int h = 0; h < 2; ++h)
#pragma unroll
            for (int i = 0; i < 2; ++i) na[h][i] = ca[h][i];
        if (has_next) { S.a_offs(nxt, tid, na); nB = S.b_base(nxt); }
        for (int t = 0; t < nt; t += 2) {
            const bool last = (t == nt - 2);
            const char* a1 = abase + (size_t)(t + 1) * kstep;
            const char* a2 = last ? abase : abase + (size_t)(t + 2) * kstep; const char* b2 = last ? nB : cB + (size_t)(t + 2) * kstep;
            const char* a3 = a2 + kstep; const char* b3 = b2 + kstep;
            PG8_LDB(B0, 0, 0); PG8_LDB(B1, 0, 1); PG8_SCHED; PG8_LDA(At, 0, 0); PG8_STAGE(PG8_SA(1, 1), a1, ca[1]);
            PG8_WAIT_V(8); PG8_WAIT_L(0); PG8_BAR; PG8_MMA(0, 0, At, B0); PG8_MMA(0, 1, At, B1); PG8_BAR; PG8_SCHED;
            if (last) {
#pragma unroll
                for (int h = 0; h < 2; ++h)
#pragma unroll
                    for (int i = 0; i < 2; ++i) ca[h][i] = na[h][i];
            }
            PG8_LDA(At, 0, 1); PG8_STAGE(PG8_SB(0, 0), b2, voffB); PG8_STAGE(PG8_SB(0, 1), b2 + hstep, voffB); PG8_STAGE(PG8_SA(0, 0), a2, ca[0]);
            PG8_WAIT_V(8); PG8_WAIT_L(0); PG8_BAR; PG8_MMA(1, 0, At, B0); PG8_MMA(1, 1, At, B1); PG8_BAR; PG8_SCHED;
            PG8_LDB(B0, 1, 0); PG8_LDB(B1, 1, 1); PG8_SCHED; PG8_LDA(At, 1, 0); PG8_STAGE(PG8_SA(0, 1), a2, ca[1]);
            PG8_WAIT_V(8); PG8_WAIT_L(0); PG8_BAR; PG8_MMA(0, 0, At, B0); PG8_MMA(0, 1, At, B1); PG8_BAR; PG8_SCHED;
            PG8_LDA(At, 1, 1); PG8_STAGE(PG8_SB(1, 0), b3, voffB); PG8_STAGE(PG8_SB(1, 1), b3 + hstep, voffB); PG8_STAGE(PG8_SA(1, 0), a3, ca[0]);
            PG8_WAIT_V(8); PG8_WAIT_L(0); PG8_BAR; PG8_MMA(1, 0, At, B0); PG8_MMA(1, 1, At, B1); PG8_BAR; PG8_SCHED;
        }
        if (wr == 0) PG8_BAR;
        { int tz = tid; asm volatile("" : "+v"(tz));
          const int l2 = tz & 63, w2 = __builtin_amdgcn_readfirstlane(tz >> 6); E(acc, cur, w2 >> 2, w2 & 3, l2 & 15, l2 >> 4); }
        if (!has_next) break;
#pragma unroll
        for (int a = 0; a < 2; ++a)
#pragma unroll
            for (int b = 0; b < 2; ++b)
#pragma unroll
                for (int m = 0; m < 4; ++m)
#pragma unroll
                    for (int n = 0; n < 2; ++n) acc[a][b][m][n] = (f32x4){0.f, 0.f, 0.f, 0.f};
        cur = nxt; cB = nB; ++ui;
        if (wr == 1) PG8_BAR;
    }
    PG8_WAIT_V(0);
    PG8_BAR;
#undef PG8_SA
#undef PG8_SB
#undef PG8_STAGE
#undef PG8_LDA
#undef PG8_LDB
#undef PG8_MMA
#undef PG8_WAIT_V
#undef PG8_WAIT_L
#undef PG8_BAR
#undef PG8_SCHED
}
}

#define XB_TMO      128
#define XB_XCNT(j)  (256  + 64 * (j))
#define XB_XSUB(j)  (1280 + 64 * (j))
#define XB_XGEN(j)  (2304 + 64 * (j))
#define XB_TOP      3328
#define XB_TOPGEN   3392
#define XCD_BAR_WORDS 3456
#define XB_SPIN_CAP (1u << 18)
__device__ __forceinline__ unsigned xb_ld(unsigned* p)              { return __hip_atomic_load(p, __ATOMIC_RELAXED, __HIP_MEMORY_SCOPE_AGENT); }
__device__ __forceinline__ unsigned xb_add(unsigned* p, unsigned v) { return __hip_atomic_fetch_add(p, v, __ATOMIC_RELAXED, __HIP_MEMORY_SCOPE_AGENT); }
__device__ __forceinline__ unsigned xb_xcc_id() { return (unsigned)__builtin_amdgcn_s_getreg((3 << 11) | 20) & 0xFu; }
#define XB_SPIN(cond, bar) do { unsigned _sp = 0; while (cond) { __builtin_amdgcn_s_sleep(1); \
    if ((++_sp & 255u) == 0u) { if (xb_ld(&(bar)[XB_TMO])) break; if (_sp > XB_SPIN_CAP) { atomicAdd(&(bar)[XB_TMO], 1u); break; } } } } while (0)
struct XcdBarrier { unsigned* bar; unsigned x; volatile LAS unsigned* st; };
__device__ __forceinline__ XcdBarrier xcd_barrier_post(unsigned* bar, volatile LAS unsigned* st) {
    XcdBarrier b; b.bar = bar; b.x = xb_xcc_id(); b.st = st;
    if (threadIdx.x == 0) (void)xb_add(&bar[XB_XCNT(b.x)], 1u);
    return b;
}
__device__ __forceinline__ void xcd_barrier_complete(unsigned* bar, unsigned x, unsigned& nloc, unsigned& nx) {
    const unsigned G = gridDim.x * gridDim.y * gridDim.z;
    unsigned sum, cnt, mine, sp = 0u;
    for (;;) {
        sum = 0u; cnt = 0u; mine = 0u;
#pragma unroll
        for (unsigned j = 0; j < 16; ++j) { const unsigned c = xb_ld(&bar[XB_XCNT(j)]); sum += c; cnt += (c > 0u) ? 1u : 0u; mine = (j == x) ? c : mine; }
        if (sum == G) break;
        __builtin_amdgcn_s_sleep(1);
        if ((++sp & 255u) == 0u) { if (xb_ld(&bar[XB_TMO])) break; if (sp > XB_SPIN_CAP) { atomicAdd(&bar[XB_TMO], 1u); break; } }
    }
    nloc = mine > 0u ? mine : 1u; nx = cnt > 0u ? cnt : 1u;
}
__device__ __forceinline__ void xcd_barrier(const XcdBarrier& b) {
    asm volatile("s_waitcnt vmcnt(0)" ::: "memory");
    __syncthreads();
    if (threadIdx.x == 0) {
        unsigned* bar = b.bar;
        __builtin_amdgcn_s_waitcnt(0);
        unsigned nloc = b.st[0], nx = b.st[1];
        if (nloc == 0u) { xcd_barrier_complete(bar, b.x, nloc, nx); b.st[0] = nloc; b.st[1] = nx; }
        const unsigned old = xb_add(&bar[XB_XSUB(b.x)], 1u);
        const unsigned gen = old / nloc;
        if (old + 1u == (gen + 1u) * nloc) {
            __builtin_amdgcn_fence(__ATOMIC_RELEASE, "agent");
            asm volatile("s_waitcnt vmcnt(0)" ::: "memory");
            const unsigned og = xb_add(&bar[XB_TOP], 1u);
            const unsigned tg = og / nx;
            if (og + 1u == (tg + 1u) * nx) xb_add(&bar[XB_TOPGEN], 1u);
            else XB_SPIN(xb_ld(&bar[XB_TOPGEN]) == tg, bar);
            __builtin_amdgcn_fence(__ATOMIC_ACQUIRE, "agent");
            xb_add(&bar[XB_XGEN(b.x)], 1u);
            asm volatile("s_waitcnt vmcnt(0)" ::: "memory");
        } else {
            XB_SPIN(xb_ld(&bar[XB_XGEN(b.x)]) == gen, bar);
            __builtin_amdgcn_fence(__ATOMIC_ACQUIRE, "agent");
            asm volatile("s_waitcnt vmcnt(0)" ::: "memory");
        }
    }
    __syncthreads();
}

struct Args {
    const float* in[21];
    float* out; unsigned char* ws;
    int ph_lo, ph_hi, flags, pad;
};
enum { I_X = 0, I_META, I_RELB, I_NMIX, I_WIN, I_BGATE, I_WAO, I_CONVW, I_CONVB, I_LNG, I_LNB, I_WCO, I_WOUT, I_NFFN, I_WR, I_BR, I_WUG, I_BUG, I_WD, I_BD, I_NFIN };

struct Frame {
    LAS unsigned char* lds;
    unsigned char* ws;
    int tid, lane, wave;
    int G, bid;
};
template <class T> __device__ __forceinline__ T* wsp(unsigned char* ws, size_t off) { return (T*)(ws + off); }

struct P0Desc { const float* src; bf16_t* dst; int ldn, ldk; };
__device__ __forceinline__ void p0_load(const P0Desc& d, f32x4 (&v)[16], int lane) {
    const float* p = d.src + (size_t)(lane >> 4) * d.ldn + (lane & 15) * 4;
#pragma unroll
    for (int i = 0; i < 16; ++i) v[i] = *(const f32x4*)(p + (size_t)(4 * i) * d.ldn);
}
__device__ __forceinline__ void p0_store(const P0Desc& d, const f32x4 (&v)[16], LAS float* scr, int lane) {
    const int n4 = (lane & 15) * 4, kr = lane >> 4;
#pragma unroll
    for (int i = 0; i < 16; ++i) { LAS float* p = scr + (4 * i + kr) * 65 + n4; p[0] = v[i][0]; p[1] = v[i][1]; p[2] = v[i][2]; p[3] = v[i][3]; }
    LDS_WAIT(); asm volatile("" ::: "memory");
    const int c = lane & 7;
#pragma unroll
    for (int j = 0; j < 8; ++j) { const int n = (lane >> 3) + 8 * j; const LAS float* s = scr + (8 * c) * 65 + n;
        u32x4 o; o.x = cvt_pk_bf16(s[0 * 65], s[1 * 65]); o.y = cvt_pk_bf16(s[2 * 65], s[3 * 65]); o.z = cvt_pk_bf16(s[4 * 65], s[5 * 65]); o.w = cvt_pk_bf16(s[6 * 65], s[7 * 65]);
        *(u32x4*)(d.dst + (size_t)n * d.ldk + 8 * c) = o; }
    LDS_WAIT(); asm volatile("" ::: "memory");
}
__device__ __forceinline__ void rms_row_to_bf16(const float* __restrict__ xrow, const float* __restrict__ g, bf16_t* __restrict__ orow, int lane) {
    const f32x4* xr = (const f32x4*)xrow + lane; const f32x4* gr = (const f32x4*)g + lane;
    f32x4 v[4]; float s = 0.f;
#pragma unroll
    for (int j = 0; j < 4; ++j) { v[j] = xr[64 * j]; s += (v[j].x * v[j].x + v[j].y * v[j].y) + (v[j].z * v[j].z + v[j].w * v[j].w); }
    const float r = 1.0f / sqrtf(wave_sum(s) * (1.f / DM) + EPS);
    unsigned long long* o8 = (unsigned long long*)orow + lane;
#pragma unroll
    for (int j = 0; j < 4; ++j) { const f32x4 gg = gr[64 * j];
        o8[64 * j] = (unsigned long long)cvt_pk_bf16(v[j].x * r * gg.x, v[j].y * r * gg.y) | ((unsigned long long)cvt_pk_bf16(v[j].z * r * gg.z, v[j].w * r * gg.w) << 32); }
}
__device__ __forceinline__ void p0_prologue(Frame& F, const Args& a, const int part) {
    LAS float* scr = (LAS float*)(F.lds + F.wave * 16896);
    const int gw = F.bid * NWAVES + F.wave, NGW = F.G * NWAVES;
    unsigned char* ws = F.ws;
    constexpr int T_IN = 81 * 16, T_AO = 16 * 8, T_CO = 16 * 8, T_OUT = 16 * 16, T_SMALL = T_IN + T_AO + T_CO + T_OUT;
    constexpr int T_UG = NE * 32 * 16, T_D = NE * 16 * 16, T_ALL = T_SMALL + T_UG + T_D;
    auto desc = [&](int it) -> P0Desc {
        int r = it; P0Desc d;
        if (r < T_IN) { const int g = r / 16, kb = r % 16; const int dr = g * 64; int sc;
            if (dr < WR_GLU) sc = dr;
            else if (dr < WR_GATE) { const int q = dr - WR_GLU, tile = q >> 8, hf = (q >> 7) & 1, w = q & 127; sc = SC_GLU + 512 * hf + 128 * tile + w; }
            else if (dr < WR_IK) sc = SC_GATE + (dr - WR_GATE);
            else sc = SC_IK + (dr - WR_IK);
            d.src = a.in[I_WIN] + (size_t)(kb * 64) * INCOLS + sc; d.ldn = INCOLS; d.dst = wsp<bf16_t>(ws, WS_WIN) + (size_t)dr * DM + kb * 64; d.ldk = DM; return d; }
        r -= T_IN;
        if (r < T_AO) { const int g = r / 8, kb = r % 8; d.src = a.in[I_WAO] + (size_t)(kb * 64) * DM + g * 64; d.ldn = DM; d.dst = wsp<bf16_t>(ws, WS_WAO) + (size_t)(g * 64) * AW + kb * 64; d.ldk = AW; return d; }
        r -= T_AO;
        if (r < T_CO) { const int g = r / 8, kb = r % 8; d.src = a.in[I_WCO] + (size_t)(kb * 64) * DM + g * 64; d.ldn = DM; d.dst = wsp<bf16_t>(ws, WS_WCO) + (size_t)(g * 64) * CC + kb * 64; d.ldk = CC; return d; }
        r -= T_CO;
        if (r < T_OUT) { const int g = r / 16, kb = r % 16; d.src = a.in[I_WOUT] + (size_t)(kb * 64) * DM + g * 64; d.ldn = DM; d.dst = wsp<bf16_t>(ws, WS_WOUT) + (size_t)(g * 64) * DM + kb * 64; d.ldk = DM; return d; }
        r -= T_OUT;
        if (r < T_UG) { const int e = r / 512, q = r % 512, g = q % 32, kb = q / 32; const int dr = g * 64, tile = dr >> 8, hf = (dr >> 7) & 1, w = dr & 127;
            d.src = a.in[I_WUG] + (size_t)e * DM * 2 * DFF + (size_t)(kb * 64) * (2 * DFF) + DFF * hf + 128 * tile + w; d.ldn = 2 * DFF;
            d.dst = wsp<bf16_t>(ws, WS_WUG) + (size_t)e * 2 * DFF * DM + (size_t)dr * DM + kb * 64; d.ldk = DM; return d; }
        r -= T_UG;
        { const int e = r / 256, q = r % 256, g = q % 16, kb = q / 16;
            d.src = a.in[I_WD] + (size_t)e * DFF * DM + (size_t)(kb * 64) * DM + g * 64; d.ldn = DM; d.dst = wsp<bf16_t>(ws, WS_WD) + (size_t)e * DM * DFF + (size_t)(g * 64) * DFF + kb * 64; d.ldk = DFF; return d; }
    };
    const int T_LO = part ? T_SMALL : 0, T_HI = part ? T_ALL : T_SMALL;
    if (T_LO + gw < T_HI) {
        f32x4 va[16], vb[16];
        P0Desc da = desc(T_LO + gw), db = da;
        p0_load(da, va, F.lane);
        for (int it = T_LO + gw; it < T_HI; it += 2 * NGW) {
            const int i1 = it + NGW, i2 = it + 2 * NGW;
            db = desc(i1 < T_HI ? i1 : it); p0_load(db, vb, F.lane);
            p0_store(da, va, scr, F.lane);
            da = desc(i2 < T_HI ? i2 : it); p0_load(da, va, F.lane);
            if (i1 < T_HI) p0_store(db, vb, scr, F.lane);
        }
    }
    if (part) return;
    { const int gt = F.bid * NTHREADS + F.tid;
      if (gt < 8 * DM / 2) { const int n = gt >> 9, k = (gt & 511) * 2; const float v0 = a.in[I_WIN][(size_t)k * INCOLS + SC_IW + n], v1 = a.in[I_WIN][(size_t)(k + 1) * INCOLS + SC_IW + n];
          *(unsigned*)(wsp<bf16_t>(ws, WS_WIN) + (size_t)(WR_IW + n) * DM + k) = cvt_pk_bf16(v0, v1); } }
    { const int gt = F.bid * NTHREADS + F.tid;
      if (gt < NE * DM / 2) { const int e = gt >> 9, d = (gt & 511) * 2; const float v0 = a.in[I_NFFN][d] * a.in[I_WR][(size_t)d * NE + e], v1 = a.in[I_NFFN][d + 1] * a.in[I_WR][(size_t)(d + 1) * NE + e];
          const unsigned hi = cvt_pk_bf16(v0, v1); const unsigned lo = cvt_pk_bf16(v0 - bflo(hi), v1 - bfhi(hi));
          *(unsigned*)(wsp<bf16_t>(ws, WS_WRT) + (size_t)e * DM + d) = hi; *(unsigned*)(wsp<bf16_t>(ws, WS_WRT) + (size_t)(NE + e) * DM + d) = lo; } }
    for (int m = gw; m < NTOK + NMETA; m += NGW) {
        if (m < NTOK) rms_row_to_bf16(a.in[I_X] + (size_t)m * DM, a.in[I_NMIX], wsp<bf16_t>(ws, WS_XN) + (size_t)m * DM, F.lane);
        else rms_row_to_bf16(a.in[I_META] + (size_t)(m - NTOK) * DM, a.in[I_NMIX], wsp<bf16_t>(ws, WS_XNM) + (size_t)(m - NTOK) * DM, F.lane);
    }
}

struct PlainSched {
    const char* ws; unsigned a_off, b_off; int K, nM, nN, nwg, G, c;
    __device__ __forceinline__ void init(const unsigned char* ws_, size_t a, size_t b, int M, int N, int K_, int G_, int c_) { ws = (const char*)ws_; a_off = (unsigned)a; b_off = (unsigned)b; K = K_; nM = M / 256; nN = N / 256; nwg = nM * nN; G = G_; c = c_; }
    __device__ __forceinline__ bool next(int i, pg8::Unit& u) const {
        const long L = (long)i * G + c; if (L >= nwg) return false;
        int wgid = (int)L; { const int q = nwg / 8, r = nwg % 8, xcd = wgid % 8, off = wgid / 8; wgid = (xcd < r ? xcd * (q + 1) : r * (q + 1) + (xcd - r) * q) + off; }
        const int nig = 8 * nN, gid = wgid / nig, fm = gid * 8, gsz = (nM - fm) < 8 ? (nM - fm) : 8;
        u.pm = fm + ((wgid % nig) % gsz); u.pn = (wgid % nig) / gsz; u.z = 0; return true;
    }
    __device__ __forceinline__ const char* a_base() const { return ws; }
    __device__ __forceinline__ void a_offs(const pg8::Unit& u, int tid, unsigned (&o)[2][2]) const {
        int R[2], C[2]; pg8::stage_rc(tid * 16, R[0], C[0]); pg8::stage_rc(tid * 16 + 8192, R[1], C[1]);
#pragma unroll
        for (int h = 0; h < 2; ++h)
#pragma unroll
            for (int i = 0; i < 2; ++i) o[h][i] = a_off + (unsigned)(((u.pm * 256 + h * 128 + R[i]) * K + C[i]) * 2);
    }
    __device__ __forceinline__ const char* b_base(const pg8::Unit& u) const { return ws + b_off + (size_t)u.pn * 256 * K * 2; }
};
struct MergeSched {
    const char* ws; int G, c;
    __device__ __forceinline__ bool next(int i, pg8::Unit& u) const {
        const int t = c + (i >> 1) * G;
        if (t >= 256) return false;
        u.pm = (t & 7) + 8 * (t >> 5); u.pn = (t >> 3) & 3; u.z = i & 1; return true;
    }
    __device__ __forceinline__ const char* a_base() const { return ws; }
    __device__ __forceinline__ void a_offs(const pg8::Unit& u, int tid, unsigned (&o)[2][2]) const {
        int R[2], C[2]; pg8::stage_rc(tid * 16, R[0], C[0]); pg8::stage_rc(tid * 16 + 8192, R[1], C[1]);
        const unsigned base = (unsigned)(u.z ? WS_CO : WS_AO);
#pragma unroll
        for (int h = 0; h < 2; ++h)
#pragma unroll
            for (int i = 0; i < 2; ++i) o[h][i] = base + (unsigned)(((u.pm * 256 + h * 128 + R[i]) * 512 + C[i]) * 2);
    }
    __device__ __forceinline__ const char* b_base(const pg8::Unit& u) const { return ws + (u.z ? WS_WCO : WS_WAO) + (size_t)u.pn * 256 * 512 * 2; }
};
struct MoeTables { const LAS int* cnt; const LAS int* tbase; };
template <int NC, bool GATHER>
struct MoeSched {
    const char* ws; MoeTables T; int G, c, total;
    __device__ __forceinline__ bool next(int i, pg8::Unit& u) const {
        const long L = (long)i * G + c; if (L >= total) return false;
        int wgid = (int)L; { const int q = total / 8, r = total % 8, xcd = wgid % 8, off = wgid / 8; wgid = (xcd < r ? xcd * (q + 1) : r * (q + 1) + (xcd - r) * q) + off; }
        int e = 0;
        for (int j = 1; j < NE; ++j) e += (wgid >= __builtin_amdgcn_readfirstlane(T.tbase[j]) * NC) ? 1 : 0;
        e = __builtin_amdgcn_readfirstlane(e);
        const int tb0 = __builtin_amdgcn_readfirstlane(T.tbase[e]), tb1 = __builtin_amdgcn_readfirstlane(T.tbase[e + 1]);
        const int loc = wgid - tb0 * NC, nt_e = tb1 - tb0;
        u.z = e;
        u.pn = loc % NC; u.pm = loc / NC;
        return true;
    }
    __device__ __forceinline__ const char* a_base() const { return ws; }
    __device__ __forceinline__ void a_offs(const pg8::Unit& u, int tid, unsigned (&o)[2][2]) const {
        int R[2], C[2]; pg8::stage_rc(tid * 16, R[0], C[0]); pg8::stage_rc(tid * 16 + 8192, R[1], C[1]);
        if (GATHER) {
            const int* list = (const int*)(ws + WS_LIST) + (size_t)u.z * NTOK; const int n = __builtin_amdgcn_readfirstlane(T.cnt[u.z]);
#pragma unroll
            for (int h = 0; h < 2; ++h)
#pragma unroll
                for (int i = 0; i < 2; ++i) { const int p = u.pm * 256 + h * 128 + R[i]; const int tok = list[p < n ? p : 0];
                    o[h][i] = (unsigned)WS_XN + (unsigned)((tok * DM + C[i]) * 2); }
        } else {
            const int row0 = (__builtin_amdgcn_readfirstlane(T.tbase[u.z]) + u.pm) * 256;
#pragma unroll
            for (int h = 0; h < 2; ++h)
#pragma unroll
                for (int i = 0; i < 2; ++i) o[h][i] = (unsigned)WS_ACT + (unsigned)(((row0 + h * 128 + R[i]) * DFF + C[i]) * 2);
        }
    }
    __device__ __forceinline__ const char* b_base(const pg8::Unit& u) const {
        if (GATHER) return ws + WS_WUG + ((size_t)u.z * 2 * DFF + (size_t)u.pn * 256) * DM * 2;
        else return ws + WS_WD + ((size_t)u.z * DM + (size_t)u.pn * 256) * DFF * 2;
    }
};

#define EPI_ROWS(ai, m) for (int ai = 0; ai < 2; ++ai) _Pragma("unroll") for (int m = 0; m < 4; ++m)
#define EPI_COLS(bj, n) for (int bj = 0; bj < 2; ++bj) _Pragma("unroll") for (int n = 0; n < 2; ++n)
__device__ __forceinline__ void st_bf16x4(bf16_t* p, f32x4 v) { u32x2 w; w.x = cvt_pk_bf16(v[0], v[1]); w.y = cvt_pk_bf16(v[2], v[3]); *(u32x2*)p = w; }
__device__ __forceinline__ void st_bf16x8(bf16_t* p, f32x4 a, f32x4 b) { u32x4 w; w.x = cvt_pk_bf16(a[0], a[1]); w.y = cvt_pk_bf16(a[2], a[3]); w.z = cvt_pk_bf16(b[0], b[1]); w.w = cvt_pk_bf16(b[2], b[3]); *(u32x4*)p = w; }

struct EpiInProj {
    unsigned char* ws; const float* bgate;
    __device__ __forceinline__ void operator()(const f32x4 (&acc)[2][2][4][2], const pg8::Unit& u, int wr, int wc, int fr, int fq) const {
        const int pn = u.pn, row0 = u.pm * 256 + wr * 64 + fr, col0 = wc * 32 + 8 * fq;
        const int bidx = u.pm >> 3;
        const int rowk0 = row0 + NMETA * (bidx + 1);
        if (pn < 2 || (pn >= 6 && pn < 8)) {
            bf16_t* O = wsp<bf16_t>(ws, pn < 2 ? WS_Q : WS_IQ); const int cb = (pn & 1) * 256; const float sc = pn < 2 ? QSCALE : 1.0f;
#pragma unroll
            EPI_ROWS(ai, m) { bf16_t* rp = O + (size_t)(row0 + ai * 128 + m * 16) * AW + cb + col0;
#pragma unroll
                for (int bj = 0; bj < 2; ++bj) st_bf16x8(rp + bj * 128, acc[ai][bj][m][0] * sc, acc[ai][bj][m][1] * sc); }
        } else if (pn < 4) {
            bf16_t* O = wsp<bf16_t>(ws, WS_KB); const int cb = (pn & 1) * 256;
#pragma unroll
            EPI_ROWS(ai, m) { bf16_t* rp = O + (size_t)(rowk0 + ai * 128 + m * 16) * AW + cb + col0;
#pragma unroll
                for (int bj = 0; bj < 2; ++bj) st_bf16x8(rp + bj * 128, acc[ai][bj][m][0], acc[ai][bj][m][1]); }
        } else if (pn < 6) {
            bf16_t* O = wsp<bf16_t>(ws, WS_VT) + (size_t)bidx * AW * TP; const int cb = (pn & 1) * 256;
            const int t0 = (row0 & (SEQ - 1)) + NMETA + VOFF;
#pragma unroll
            EPI_ROWS(ai, m) { const int t = t0 + ai * 128 + m * 16;
#pragma unroll
                EPI_COLS(bj, n) { const f32x4 v = acc[ai][bj][m][n]; bf16_t* cp = O + (size_t)(cb + col0 + bj * 128 + n * 4) * TP + (t & ~1);
                    const float p0 = __shfl_xor(v[0], 1), p1 = __shfl_xor(v[1], 1), p2 = __shfl_xor(v[2], 1), p3 = __shfl_xor(v[3], 1);
                    if ((fr & 1) == 0) { *(unsigned*)(cp) = cvt_pk_bf16(v[0], p0); *(unsigned*)(cp + TP) = cvt_pk_bf16(v[1], p1); }
                    else { *(unsigned*)(cp + 2 * TP) = cvt_pk_bf16(p2, v[2]); *(unsigned*)(cp + 3 * TP) = cvt_pk_bf16(p3, v[3]); } } }
        } else if (pn < 12) {
            bf16_t* O = wsp<bf16_t>(ws, WS_GLU); const int cb = (pn - 8) * 128;
#pragma unroll
            EPI_ROWS(ai, m) { bf16_t* rp = O + (size_t)(rowk0 + ai * 128 + m * 16) * CC + cb + col0;
                f32x4 y[2];
#pragma unroll
                for (int n = 0; n < 2; ++n) { const f32x4 av = acc[ai][0][m][n], gv = acc[ai][1][m][n];
#pragma unroll
                    for (int j = 0; j < 4; ++j) y[n][j] = av[j] * sigmoidf_(gv[j]); }
                st_bf16x8(rp, y[0], y[1]); }
        } else {
            const int gt = pn - 12; bf16_t* O = wsp<bf16_t>(ws, gt < 4 ? WS_GA : WS_GB); const int cb = (gt & 3) * 256; const float* bp = bgate + gt * 256 + col0;
            f32x4 bv[2][2];
#pragma unroll
            EPI_COLS(bj, n) bv[bj][n] = *(const f32x4*)(bp + bj * 128 + n * 4);
#pragma unroll
            EPI_ROWS(ai, m) { bf16_t* rp = O + (size_t)(row0 + ai * 128 + m * 16) * DM + cb + col0;
#pragma unroll
                for (int bj = 0; bj < 2; ++bj) { f32x4 y[2];
#pragma unroll
                    for (int n = 0; n < 2; ++n) { const f32x4 x = acc[ai][bj][m][n] + bv[bj][n];
#pragma unroll
                        for (int j = 0; j < 4; ++j) y[n][j] = sigmoidf_(x[j]); }
                    st_bf16x8(rp + bj * 128, y[0], y[1]); } }
        }
    }
};
struct EpiMerge {
    unsigned char* ws;
    __device__ __forceinline__ void operator()(const f32x4 (&acc)[2][2][4][2], const pg8::Unit& u, int wr, int wc, int fr, int fq) const {
        const int row0 = u.pm * 256 + wr * 64 + fr, col0 = u.pn * 256 + wc * 32 + 8 * fq;
        const bf16_t* Gt = wsp<bf16_t>(ws, u.z ? WS_GB : WS_GA); bf16_t* O = wsp<bf16_t>(ws, WS_MG);
#pragma unroll
        for (int ai = 0; ai < 2; ++ai) {
            u32x4 g[4][2], p[4][2];
#pragma unroll
            for (int m = 0; m < 4; ++m)
#pragma unroll
                for (int bj = 0; bj < 2; ++bj) { const size_t o = (size_t)(row0 + ai * 128 + m * 16) * DM + col0 + bj * 128; g[m][bj] = *(const u32x4*)(Gt + o); p[m][bj] = u.z ? *(const u32x4*)(O + o) : (u32x4){0u, 0u, 0u, 0u}; }
#pragma unroll
            for (int m = 0; m < 4; ++m)
#pragma unroll
                for (int bj = 0; bj < 2; ++bj) { const size_t o = (size_t)(row0 + ai * 128 + m * 16) * DM + col0 + bj * 128; const u32x4 gg = g[m][bj], pp = p[m][bj]; const f32x4 a0 = acc[ai][bj][m][0], a1 = acc[ai][bj][m][1];
                    const f32x4 y0 = (f32x4){bflo(gg.x) * a0[0] + bflo(pp.x), bfhi(gg.x) * a0[1] + bfhi(pp.x), bflo(gg.y) * a0[2] + bflo(pp.y), bfhi(gg.y) * a0[3] + bfhi(pp.y)};
                    const f32x4 y1 = (f32x4){bflo(gg.z) * a1[0] + bflo(pp.z), bfhi(gg.z) * a1[1] + bfhi(pp.z), bflo(gg.w) * a1[2] + bflo(pp.w), bfhi(gg.w) * a1[3] + bfhi(pp.w)};
                    st_bf16x8(O + o, y0, y1); }
        }
    }
};
struct EpiResid {
    const float* x; float* out;
    __device__ __forceinline__ void operator()(const f32x4 (&acc)[2][2][4][2], const pg8::Unit& u, int wr, int wc, int fr, int fq) const {
        const int row0 = u.pm * 256 + wr * 64 + fr, col0 = u.pn * 256 + wc * 32 + 8 * fq;
#pragma unroll
        for (int ai = 0; ai < 2; ++ai)
#pragma unroll
            for (int mh = 0; mh < 2; ++mh) {
                f32x4 xv[2][2][2];
#pragma unroll
                for (int mm = 0; mm < 2; ++mm)
#pragma unroll
                    EPI_COLS(bj, n) xv[mm][bj][n] = *(const f32x4*)(x + (size_t)(row0 + ai * 128 + (2 * mh + mm) * 16) * DM + col0 + bj * 128 + n * 4);
#pragma unroll
                for (int mm = 0; mm < 2; ++mm)
#pragma unroll
                    EPI_COLS(bj, n) *(f32x4*)(out + (size_t)(row0 + ai * 128 + (2 * mh + mm) * 16) * DM + col0 + bj * 128 + n * 4) = xv[mm][bj][n] + acc[ai][bj][2 * mh + mm][n];
            }
    }
};
struct EpiSwiglu {
    unsigned char* ws; const float* bug; MoeTables T;
    __device__ __forceinline__ void operator()(const f32x4 (&acc)[2][2][4][2], const pg8::Unit& u, int wr, int wc, int fr, int fq) const {
        const int e = u.z, n_e = __builtin_amdgcn_readfirstlane(T.cnt[e]), rloc0 = u.pm * 256 + wr * 64 + fr, row0 = __builtin_amdgcn_readfirstlane(T.tbase[e]) * 256 + rloc0, col0 = u.pn * 128 + wc * 32 + 8 * fq;
        const float* bp = bug + (size_t)e * 2 * DFF + col0; bf16_t* O = wsp<bf16_t>(ws, WS_ACT); const float* rg = wsp<float>(ws, WS_RG) + (size_t)e * NTOK;
        f32x4 bg[2], bu[2];
#pragma unroll
        for (int n = 0; n < 2; ++n) { bg[n] = *(const f32x4*)(bp + n * 4); bu[n] = *(const f32x4*)(bp + DFF + n * 4); }
        float rvs[2][4];
#pragma unroll
        EPI_ROWS(ai, m) { const int rl = rloc0 + ai * 128 + m * 16; rvs[ai][m] = rg[rl < n_e ? rl : 0]; }
        bf16_t* const sink = wsp<bf16_t>(ws, WS_DUMMY) + col0;
#pragma unroll
        EPI_ROWS(ai, m) { const int rl = rloc0 + ai * 128 + m * 16; bf16_t* rp = (rl < n_e) ? O + (size_t)(row0 + ai * 128 + m * 16) * DFF + col0 : sink; const float rv = rvs[ai][m];
                f32x4 y[2];
#pragma unroll
                for (int n = 0; n < 2; ++n) { const f32x4 gv = acc[ai][0][m][n] * rv + bg[n], uv = acc[ai][1][m][n] * rv + bu[n];
#pragma unroll
                    for (int j = 0; j < 4; ++j) { const float g = fminf(gv[j], 7.0f), up = fminf(fmaxf(uv[j], -7.0f), 7.0f); y[n][j] = (up + 1.0f) * g * sigmoidf_(1.702f * g); } }
                st_bf16x8(rp, y[0], y[1]); }
    }
};
struct EpiDown {
    unsigned char* ws; const float* bd; MoeTables T;
    __device__ __forceinline__ void operator()(const f32x4 (&acc)[2][2][4][2], const pg8::Unit& u, int wr, int wc, int fr, int fq) const {
        const int e = u.z, n_e = __builtin_amdgcn_readfirstlane(T.cnt[e]), rloc0 = u.pm * 256 + wr * 64 + fr, row0 = __builtin_amdgcn_readfirstlane(T.tbase[e]) * 256 + rloc0, col0 = u.pn * 256 + wc * 32 + 8 * fq;
        const float* bp = bd + (size_t)e * DM + col0; bf16_t* O = wsp<bf16_t>(ws, WS_YP); const float* lg = wsp<float>(ws, WS_LG) + (size_t)e * NTOK;
        f32x4 bv[2][2];
#pragma unroll
        EPI_COLS(bj, n) bv[bj][n] = *(const f32x4*)(bp + bj * 128 + n * 4);
        float gts[2][4];
#pragma unroll
        EPI_ROWS(ai, m) { const int rl = rloc0 + ai * 128 + m * 16; gts[ai][m] = lg[rl < n_e ? rl : 0]; }
        bf16_t* const sink = wsp<bf16_t>(ws, WS_DUMMY) + col0;
#pragma unroll
        EPI_ROWS(ai, m) { const int rl = rloc0 + ai * 128 + m * 16; const float gt = gts[ai][m]; bf16_t* rp = (rl < n_e) ? O + (size_t)(row0 + ai * 128 + m * 16) * DM + col0 : sink;
#pragma unroll
                for (int bj = 0; bj < 2; ++bj) st_bf16x8(rp + bj * 128, (acc[ai][bj][m][0] + bv[bj][0]) * gt, (acc[ai][bj][m][1] + bv[bj][1]) * gt); }
    }
};

constexpr int IKBLK = 65;
__device__ __forceinline__ size_t ikf_off(int b, int p, int dim) { return ((((size_t)(b * IKBLK + (p >> 5)) * 4 + (dim >> 4)) * 64 + (((dim >> 3) & 1) * 32 + (p & 31))) * 8 + (dim & 7)); }
template <int NT>
__device__ __forceinline__ void wave_mm16(const bf16_t* __restrict__ A, int lda, const bf16_t* const (&Bt)[NT], int K, int lane, f32x4 (&acc)[NT]) {
    const bf16_t* ap = A + (size_t)(lane & 15) * lda + 8 * (lane >> 4);
    const bf16_t* bp[NT];
#pragma unroll
    for (int t = 0; t < NT; ++t) { bp[t] = Bt[t] + (size_t)(lane & 15) * K + 8 * (lane >> 4); acc[t] = (f32x4){0.f, 0.f, 0.f, 0.f}; }
#pragma unroll (NT == 1 ? 16 : 8)
    for (int k0 = 0; k0 < K; k0 += 32) {
        const bf16x8 a = *(const bf16x8*)(ap + k0);
#pragma unroll
        for (int t = 0; t < NT; ++t) { const bf16x8 b = *(const bf16x8*)(bp[t] + k0); acc[t] = __builtin_amdgcn_mfma_f32_16x16x32_bf16(b, a, acc[t], 0, 0, 0); }
    }
}
__device__ __forceinline__ void p1_thin(Frame& F, int dbgflags) {
    unsigned char* ws = F.ws;
    const bf16_t* WIN = wsp<bf16_t>(ws, WS_WIN); const bf16_t* XN = wsp<bf16_t>(ws, WS_XN); const bf16_t* XNM = wsp<bf16_t>(ws, WS_XNM);
    bf16_t* KB = wsp<bf16_t>(ws, WS_KB); bf16_t* VT = wsp<bf16_t>(ws, WS_VT); bf16_t* IK = wsp<bf16_t>(ws, WS_IK); bf16_t* GLU = wsp<bf16_t>(ws, WS_GLU); float* IW = wsp<float>(ws, WS_IW);
    const int gw = F.bid * NWAVES + F.wave, NGW = F.G * NWAVES, lane = F.lane, tk = lane & 15, nq = lane >> 4;
    {
        constexpr int WBP = 2064;
        LAS unsigned char* lds = F.lds;
        __syncthreads();
        { const unsigned char* src = (const unsigned char*)(WIN + (size_t)WR_IK * DM);
          for (int p = F.tid; p < 72 * 128; p += NTHREADS) { const int row = p >> 7, c16 = p & 127; *(LAS u32x4*)(lds + row * WBP + c16 * 16) = *(const u32x4*)(src + (size_t)row * DM * 2 + c16 * 16); } }
        __syncthreads();
        const int tg = F.wave & 3, hf = F.wave >> 2, kq = nq;
        for (int tb = F.bid; tb < NTOK / 64; tb += F.G) {
            const int m = tb * 64 + 16 * tg + tk, rowk = m + NMETA * ((m >> 11) + 1);
            const bf16_t* xr = XN + (size_t)m * DM + 16 * kq;
            bf16x8 xa[16], xb[16];
#pragma unroll
            for (int sblk = 0; sblk < 16; ++sblk) { xa[sblk] = *(const bf16x8*)(xr + 64 * sblk); xb[sblk] = *(const bf16x8*)(xr + 64 * sblk + 8); }
            const LAS unsigned char* wb = lds + tk * WBP + 32 * kq;
            if (hf == 0) {
                f32x4 acc[3] = {{0.f, 0.f, 0.f, 0.f}, {0.f, 0.f, 0.f, 0.f}, {0.f, 0.f, 0.f, 0.f}};
#pragma unroll
                for (int sblk = 0; sblk < 16; ++sblk)
#pragma unroll
                    for (int t = 0; t < 3; ++t) { const bf16x8 b0 = *(const LAS bf16x8*)(wb + 16 * t * WBP + 128 * sblk), b1 = *(const LAS bf16x8*)(wb + 16 * t * WBP + 128 * sblk + 16);
                        acc[t] = __builtin_amdgcn_mfma_f32_16x16x32_bf16(b0, xa[sblk], acc[t], 0, 0, 0); acc[t] = __builtin_amdgcn_mfma_f32_16x16x32_bf16(b1, xb[sblk], acc[t], 0, 0, 0); }
#pragma unroll
                for (int t = 0; t < 3; ++t) st_bf16x4(IK + ikf_off(m >> 11, NMETA + (m & (SEQ - 1)), 16 * t + 4 * nq), acc[t]);
            } else {
                f32x4 acc[2] = {{0.f, 0.f, 0.f, 0.f}, {0.f, 0.f, 0.f, 0.f}};
#pragma unroll
                for (int sblk = 0; sblk < 16; ++sblk)
#pragma unroll
                    for (int t = 0; t < 2; ++t) { const bf16x8 b0 = *(const LAS bf16x8*)(wb + 16 * (3 + t) * WBP + 128 * sblk), b1 = *(const LAS bf16x8*)(wb + 16 * (3 + t) * WBP + 128 * sblk + 16);
                        acc[t] = __builtin_amdgcn_mfma_f32_16x16x32_bf16(b0, xa[sblk], acc[t], 0, 0, 0); acc[t] = __builtin_amdgcn_mfma_f32_16x16x32_bf16(b1, xb[sblk], acc[t], 0, 0, 0); }
                st_bf16x4(IK + ikf_off(m >> 11, NMETA + (m & (SEQ - 1)), 48 + 4 * nq), acc[0]);
                if (nq < 2) *(f32x4*)(IW + (size_t)m * 8 + 4 * nq) = acc[1];
            }
        }
        __syncthreads();
    }
    if (!(dbgflags & 256)) for (int task = gw; task < 100; task += NGW) {
        if (task < 32) {
            const bf16_t* const Bt[1] = {WIN + (size_t)(SC_K + 16 * task) * DM}; f32x4 acc[1]; wave_mm16<1>(XNM, DM, Bt, DM, lane, acc);
            for (int b = 0; b < NB; ++b) st_bf16x4(KB + (size_t)(b * TT + tk) * AW + 16 * task + 4 * nq, acc[0]);
        } else if (task < 64) {
            const int t = task - 32; const bf16_t* const Bt[1] = {WIN + (size_t)(SC_V + 16 * t) * DM}; f32x4 acc[1]; wave_mm16<1>(XNM, DM, Bt, DM, lane, acc);
            const float p0 = __shfl_xor(acc[0][0], 1), p1 = __shfl_xor(acc[0][1], 1), p2 = __shfl_xor(acc[0][2], 1), p3 = __shfl_xor(acc[0][3], 1);
            const unsigned wa = (tk & 1) ? cvt_pk_bf16(p2, acc[0][2]) : cvt_pk_bf16(acc[0][0], p0), wb = (tk & 1) ? cvt_pk_bf16(p3, acc[0][3]) : cvt_pk_bf16(acc[0][1], p1);
            for (int b = 0; b < NB; ++b) { bf16_t* cp = VT + ((size_t)b * AW + 16 * t + 4 * nq + 2 * (tk & 1)) * TP + VOFF + (tk & ~1);
                *(unsigned*)cp = wa; *(unsigned*)(cp + TP) = wb; }
        } else if (task < 68) {
            const int t = task - 64; const bf16_t* const Bt[1] = {WIN + (size_t)(WR_IK + 16 * t) * DM}; f32x4 acc[1]; wave_mm16<1>(XNM, DM, Bt, DM, lane, acc);
            for (int b = 0; b < NB; ++b) st_bf16x4(IK + ikf_off(b, tk, 16 * t + 4 * nq), acc[0]);
        } else {
            const int c16 = task - 68; const int ar = WR_GLU + 256 * (c16 >> 3) + 16 * (c16 & 7);
            const bf16_t* const Bt[2] = {WIN + (size_t)ar * DM, WIN + (size_t)(ar + 128) * DM}; f32x4 acc[2]; wave_mm16<2>(XNM, DM, Bt, DM, lane, acc);
            f32x4 y;
#pragma unroll
            for (int j = 0; j < 4; ++j) y[j] = acc[0][j] * sigmoidf_(acc[1][j]);
            for (int b = 0; b < NB; ++b) st_bf16x4(GLU + (size_t)(b * TT + tk) * CC + 16 * c16 + 4 * nq, y);
        }
    }
}

__device__ __forceinline__ void p2_conv(Frame& F, const Args& a) {
    unsigned char* ws = F.ws;
    LAS unsigned char* xs = F.lds;
    LAS float* wl = (LAS float*)(F.lds + 63488);
    const bf16_t* GLU = wsp<bf16_t>(ws, WS_GLU); bf16_t* CO = wsp<bf16_t>(ws, WS_CO);
    const float* cw = a.in[I_CONVW];
    for (int idx = F.tid; idx < CW * 128; idx += NTHREADS) { const int tap = idx >> 7, c4 = idx & 127; const f32x4 v = *(const f32x4*)(cw + tap * CC + 4 * c4); *(LAS f32x4*)(wl + tap * 512 + (c4 & 1) * 256 + (c4 >> 1) * 4) = v; }
    const int lane = F.lane, c0 = 8 * lane;
    for (int tile = F.bid; tile < NTOK / 32; tile += F.G) {
        const int b = tile >> 6, s0 = (tile & 63) * 32, p0 = NMETA + s0;
        __syncthreads();
        for (int idx = F.tid; idx < 62 * 64; idx += NTHREADS) { const int r = idx >> 6, ch = idx & 63, p = p0 - 30 + r; u32x4 v = (u32x4){0u, 0u, 0u, 0u};
            if (p >= 0) v = *(const u32x4*)(GLU + (size_t)(b * TT + p) * CC + ch * 8);
            *(LAS u32x4*)(xs + r * 1024 + ch * 16) = v; }
        __syncthreads();
        const int i0 = 4 * F.wave;
        float acc[4][8];
#pragma unroll
        for (int t = 0; t < 4; ++t)
#pragma unroll
            for (int i = 0; i < 8; ++i) acc[t][i] = 0.f;
        const LAS float* wlb = wl + lane * 4; asm volatile("" : "+v"(wlb));
        const LAS unsigned char* xsb = xs + i0 * 1024 + lane * 16; asm volatile("" : "+v"(xsb));
#pragma unroll 1
        for (int tap = 0; tap < CW; ++tap) {
            const f32x4 w0 = *(const LAS f32x4*)(wlb + tap * 512), w1 = *(const LAS f32x4*)(wlb + tap * 512 + 256);
#pragma unroll
            for (int t = 0; t < 4; ++t) {
                const u32x4 xv = *(const LAS u32x4*)(xsb + (tap + t) * 1024);
                acc[t][0] += w0[0] * bflo(xv.x); acc[t][1] += w0[1] * bfhi(xv.x); acc[t][2] += w0[2] * bflo(xv.y); acc[t][3] += w0[3] * bfhi(xv.y);
                acc[t][4] += w1[0] * bflo(xv.z); acc[t][5] += w1[1] * bfhi(xv.z); acc[t][6] += w1[2] * bflo(xv.w); acc[t][7] += w1[3] * bfhi(xv.w);
            }
        }
        float cb[8], lg[8], lb[8];
        { const f32x4* p0 = (const f32x4*)(a.in[I_CONVB] + c0); const f32x4* p1 = (const f32x4*)(a.in[I_LNG] + c0); const f32x4* p2 = (const f32x4*)(a.in[I_LNB] + c0);
#pragma unroll
          for (int hh = 0; hh < 2; ++hh) { const f32x4 u0 = p0[hh], u1 = p1[hh], u2 = p2[hh];
#pragma unroll
              for (int i = 0; i < 4; ++i) { cb[4 * hh + i] = u0[i]; lg[4 * hh + i] = u1[i]; lb[4 * hh + i] = u2[i]; } } }
#pragma unroll
        for (int t = 0; t < 4; ++t) {
            float s = 0.f;
#pragma unroll
            for (int i = 0; i < 8; ++i) { acc[t][i] += cb[i]; s += acc[t][i]; }
            const float mean = wave_sum(s) * (1.f / CC); float q = 0.f;
#pragma unroll
            for (int i = 0; i < 8; ++i) { acc[t][i] -= mean; q += acc[t][i] * acc[t][i]; }
            const float rstd = 1.0f / sqrtf(wave_sum(q) * (1.f / CC) + EPS);
            float y[8];
#pragma unroll
            for (int i = 0; i < 8; ++i) { const float z = acc[t][i] * rstd * lg[i] + lb[i]; y[i] = z * sigmoidf_(z); }
            u32x4 o; o.x = cvt_pk_bf16(y[0], y[1]); o.y = cvt_pk_bf16(y[2], y[3]); o.z = cvt_pk_bf16(y[4], y[5]); o.w = cvt_pk_bf16(y[6], y[7]);
            *(u32x4*)(CO + (size_t)(b * SEQ + s0 + i0 + t) * CC + c0) = o;
        }
    }
    __syncthreads();
}

constexpr int ROWP = 2080, NJ = 33;
__device__ __forceinline__ unsigned f2ord(float f) { const unsigned b = __float_as_uint(f); return b ^ ((b >> 31) ? 0xffffffffu : 0x80000000u); }
__device__ __forceinline__ int wave_isum(int v) {
#pragma unroll
    for (int o = 1; o < 64; o <<= 1) v += __shfl_xor(v, o);
    return v;
}
__device__ __forceinline__ int wave_isum_dpp(int v) {
    v += __builtin_amdgcn_update_dpp(0, v, 0xB1, 0xF, 0xF, false);
    v += __builtin_amdgcn_update_dpp(0, v, 0x4E, 0xF, 0xF, false);
    v += __builtin_amdgcn_update_dpp(0, v, 0x141, 0xF, 0xF, false);
    v += __builtin_amdgcn_update_dpp(0, v, 0x140, 0xF, 0xF, false);
    return __builtin_amdgcn_readlane(v, 0) + __builtin_amdgcn_readlane(v, 16) + __builtin_amdgcn_readlane(v, 32) + __builtin_amdgcn_readlane(v, 48);
}
__device__ __forceinline__ void p2_indexer_unit(Frame& F, int b, int q16, int flags) {
    unsigned char* ws = F.ws;
    const bf16_t* IQ = wsp<bf16_t>(ws, WS_IQ); const bf16_t* IK = wsp<bf16_t>(ws, WS_IK); const float* IW = wsp<float>(ws, WS_IW); unsigned* MASK = wsp<unsigned>(ws, WS_MASK);
    LAS unsigned* SU = (LAS unsigned*)F.lds;
    const int lane = F.lane, c = lane & 31, hi = lane >> 5, w = F.wave;
    const int nwblk = (q16 >> 1) + 2;
    if (!(flags & 4)) {
        const int tok0 = b * SEQ + 16 * q16;
        bf16x8 af[4][4]; f32x4 wq[4][4];
#pragma unroll
        for (int g = 0; g < 4; ++g) {
            const bf16_t* ap = IQ + (size_t)(tok0 + 4 * g + (c >> 3)) * AW + (c & 7) * IDXD + 8 * hi;
#pragma unroll
            for (int ks = 0; ks < 4; ++ks) af[g][ks] = *(const bf16x8*)(ap + 16 * ks);
#pragma unroll
            for (int q = 0; q < 4; ++q) wq[g][q] = *(const f32x4*)(IW + (size_t)(tok0 + 4 * g + q) * 8 + 4 * hi);
        }
        const int rel0 = NMETA + 16 * q16 + 2 * hi - c;
        const bf16_t* kp = IK + (size_t)b * IKBLK * 2048 + lane * 8;
        LAS unsigned* srow = SU + (2 * hi) * ROWP + c;
        bf16x8 bfr[4], bnx[4];
#pragma unroll
        for (int ks = 0; ks < 4; ++ks) { bfr[ks] = *(const bf16x8*)(kp + (size_t)(w < nwblk ? w : 0) * 2048 + 512 * ks); bnx[ks] = bfr[ks]; }
#pragma unroll
        for (int g = 0; g < 4; ++g) asm volatile("" :: "v"(af[g][0]), "v"(af[g][1]), "v"(af[g][2]), "v"(af[g][3]), "v"(wq[g][0]), "v"(wq[g][1]), "v"(wq[g][2]), "v"(wq[g][3]));
        asm volatile("" :: "v"(bfr[0]), "v"(bfr[1]), "v"(bfr[2]), "v"(bfr[3]));
        for (int blk = w; blk < nwblk; blk += 8) {
            {
                const int bn_ = blk + 8 < nwblk ? blk + 8 : blk;
#pragma unroll
                for (int ks = 0; ks < 4; ++ks) bnx[ks] = *(const bf16x8*)(kp + (size_t)bn_ * 2048 + 512 * ks); }
#pragma unroll
            for (int g = 0; g < 4; ++g) {
                f32x16 acc = {};
#pragma unroll
                for (int ks = 0; ks < 4; ++ks) acc = __builtin_amdgcn_mfma_f32_32x32x16_bf16(af[g][ks], bfr[ks], acc, 0, 0, 0);
                float part[4];
#pragma unroll
                for (int q = 0; q < 4; ++q) { float s = wq[g][q][0] * __builtin_amdgcn_fmed3f(acc[4 * q], 0.f, INFINITY);
#pragma unroll
                    for (int i = 1; i < 4; ++i) s = __builtin_fmaf(wq[g][q][i], __builtin_amdgcn_fmed3f(acc[4 * q + i], 0.f, INFINITY), s);
                    part[q] = s; }
#pragma unroll
                for (int p = 0; p < 2; ++p) {
                    const auto rr = __builtin_amdgcn_permlane32_swap(__float_as_uint(part[p]), __float_as_uint(part[p + 2]), false, false);
                    const float sc = __uint_as_float(rr[0]) + __uint_as_float(rr[1]);
                    srow[(4 * g + p) * ROWP + 32 * blk] = (32 * blk <= rel0 + 4 * g + p) ? f2ord(sc) : 0u; }
            }
#pragma unroll
            for (int ks = 0; ks < 4; ++ks) bfr[ks] = bnx[ks];
        }
    }
    __syncthreads();
    if (!(flags & 8)) {
        const int nj = (nwblk + 1) >> 1, klim = 32 * nwblk;
        unsigned U[NJ][2];
#pragma unroll
        for (int j = 0; j < NJ; ++j) {
            if (j < nj) { const int key = 64 * j + lane;
#pragma unroll
                for (int p = 0; p < 2; ++p) U[j][p] = (key < klim) ? SU[(2 * w + p) * ROWP + key] : 0u; }
            else { U[j][0] = 0u; U[j][1] = 0u; }
        }
        const int tokb = b * SEQ + 16 * q16 + 2 * w;
        unsigned lo[2], hb[2], thr[2], veq[2]; int chi[2], need[2]; bool done[2];
#pragma unroll
        for (int p = 0; p < 2; ++p) { lo[p] = 1u; hb[p] = 0xffffffffu; chi[p] = 0; need[p] = 0; veq[p] = 0u; thr[p] = 1u; done[p] = (NMETA + 16 * q16 + 2 * w + p + 1 <= TOPK); }
        for (int it = 0; it < 34; ++it) {
            if (done[0] && done[1]) break;
            unsigned mid[2]; int cl[2];
#pragma unroll
            for (int p = 0; p < 2; ++p) { mid[p] = lo[p] + ((hb[p] - lo[p]) >> 1); cl[p] = 0; }
#pragma unroll
            for (int g = 0; g < 3; ++g) if (11 * g < nj) {
#pragma unroll
                for (int jj = 0; jj < 11; ++jj)
#pragma unroll
                    for (int p = 0; p < 2; ++p) cl[p] += (U[11 * g + jj][p] >= mid[p]) ? 1 : 0; }
            const int tot = wave_isum_dpp(cl[0] | (cl[1] << 16));
            int cnt[2] = {tot & 0xffff, tot >> 16};
#ifdef DBG_CHECK_DPP
            if (wave_isum(cl[0]) != cnt[0] || wave_isum(cl[1]) != cnt[1]) __hip_atomic_store(wsp<unsigned>(ws, WS_CTL) + 3, 1u, RLX_AGENT);
#endif
#pragma unroll
            for (int p = 0; p < 2; ++p) {
                const int ct = cnt[p];
                if (!done[p]) {
                    if (ct == TOPK) { done[p] = true; thr[p] = mid[p]; need[p] = 0; }
                    else if (ct > TOPK) lo[p] = mid[p];
                    else { hb[p] = mid[p]; chi[p] = ct; }
                    if (!done[p] && hb[p] - lo[p] == 1u) { done[p] = true; thr[p] = hb[p]; veq[p] = lo[p]; need[p] = TOPK - chi[p]; }
                }
            }
        }
#pragma unroll
        for (int p = 0; p < 2; ++p) {
            int run = 0, wlo = 0, whi = 0;
#ifdef DBG_CHECK_SEL
            int selcnt = 0;
#endif
            const bool tied = need[p] > 0;
#pragma unroll
            for (int j = 0; j < NJ; ++j) if (j < nj) {
                const unsigned u = U[j][p];
                bool take = (u >= thr[p]);
                if (tied) {
                    const bool eq = (u == veq[p]);
                    const unsigned long long em = __ballot(eq);
                    const int rank = run + (int)__builtin_amdgcn_mbcnt_hi((unsigned)(em >> 32), __builtin_amdgcn_mbcnt_lo((unsigned)em, 0u));
                    take = take || (eq && rank < need[p]);
                    run += __popcll(em);
                }
                const unsigned long long sm = __ballot(take);
                wlo = (lane == j) ? (int)(unsigned)sm : wlo; whi = (lane == j) ? (int)(unsigned)(sm >> 32) : whi;
#ifdef DBG_CHECK_SEL
                selcnt += __popcll(sm);
#endif
            }
            unsigned long long* mrow = (unsigned long long*)(MASK + (size_t)(tokb + p) * MSTR);
            if (lane < nj) mrow[lane] = ((unsigned long long)(unsigned)whi << 32) | (unsigned)wlo;
#ifdef DBG_CHECK_SEL
            { const int nv = NMETA + 16 * q16 + 2 * w + p + 1; if (selcnt != (nv < TOPK ? nv : TOPK)) __hip_atomic_store(wsp<unsigned>(ws, WS_CTL) + 3, 1u, RLX_AGENT); }
#endif
        }
    }
    __syncthreads();
}
__device__ __forceinline__ void p2_indexer(Frame& F, int flags, int half) {
    for (int i = F.bid; i < 256; i += F.G) { const int b = i >> 5, j = 2 * (i & 31);
        if (half == 0) { p2_indexer_unit(F, b, j, flags); p2_indexer_unit(F, b, 127 - j, flags); }
        else { p2_indexer_unit(F, b, j + 1, flags); p2_indexer_unit(F, b, 126 - j, flags); } }
}

__device__ const unsigned char T5B[128] = {0, 1, 2, 3, 4, 5, 6, 7, 8, 9, 10, 11, 12, 13, 14, 15, 16, 16, 16, 17, 17, 18, 18, 18, 19, 19, 19, 20, 20, 20, 20, 21, 21, 21, 21, 22, 22, 22, 22, 22, 23, 23, 23, 23, 23, 23, 24, 24, 24, 24, 24, 24, 25, 25, 25, 25, 25, 25, 25, 26, 26, 26, 26, 26, 26, 26, 26, 27, 27, 27, 27, 27, 27, 27, 27, 27, 27, 28, 28, 28, 28, 28, 28, 28, 28, 28, 28, 29, 29, 29, 29, 29, 29, 29, 29, 29, 29, 29, 29, 30, 30, 30, 30, 30, 30, 30, 30, 30, 30, 30, 30, 30, 30, 31, 31, 31, 31, 31, 31, 31, 31, 31, 31, 31, 31, 31, 31, 31};
constexpr int TBS = 132;
__device__ __forceinline__ int crow(int r, int hi) { return (r & 3) + 8 * (r >> 2) + 4 * hi; }
constexpr int KPITCH = 144, VPITCH = 136;
constexpr int AT_K = 0, AT_V = AT_K + 2 * 64 * KPITCH, AT_TB = AT_V + 2 * 64 * VPITCH, AT_SC = AT_TB + NH * TBS * 4, AT_END = AT_SC + NWAVES * 128;
static_assert(AT_END <= RING_BYTES, "attention LDS map");
__device__ __forceinline__ void p3_attn_unit(Frame& F, int b, int h, int Q) {
    unsigned char* ws = F.ws;
    const bf16_t* Qm = wsp<bf16_t>(ws, WS_Q); const bf16_t* KB = wsp<bf16_t>(ws, WS_KB); const bf16_t* VT = wsp<bf16_t>(ws, WS_VT); const unsigned* MASK = wsp<unsigned>(ws, WS_MASK); bf16_t* AO = wsp<bf16_t>(ws, WS_AO);
    LAS unsigned char* lds = F.lds;
    const LAS float* tbh = (const LAS float*)(lds + AT_TB) + h * TBS;
    LAS float* sc = (LAS float*)(lds + AT_SC) + F.wave * 32;
    const int tid = F.tid, lane = F.lane, c = lane & 31, hi = lane >> 5, w = F.wave;
    const int qb32 = 8 * Q + w, tokq = b * SEQ + 32 * qb32 + c, posq = NMETA + 32 * qb32 + c;
    const int ktmax = (47 + 32 * qb32) >> 6, NT = 4 * Q + 5;
    bf16x8 qf[4];
#pragma unroll
    for (int ks = 0; ks < 4; ++ks) qf[ks] = *(const bf16x8*)(Qm + (size_t)tokq * AW + h * HD + 16 * ks + 8 * hi);
    const unsigned long long* mrow = (const unsigned long long*)(MASK + (size_t)tokq * MSTR);
    const int srow = tid >> 3, piece = tid & 7;
    const bf16_t* kg = KB + (size_t)(b * TT + srow) * AW + h * HD + piece * 8;
    const bf16_t* vg = VT + ((size_t)b * AW + h * HD + srow) * TP + piece * 8;
    LAS unsigned char* kl = lds + AT_K + srow * KPITCH + piece * 16;
    LAS unsigned char* vl = lds + AT_V + srow * VPITCH + piece * 16;
    const LAS unsigned char* kfb = lds + AT_K + c * KPITCH + 16 * hi;
    const LAS unsigned char* vfb = lds + AT_V + c * VPITCH + 8 * hi;
    const unsigned NEGB = 0xff800000u;
    const float bfar = tbh[128];
    float m_abs = 0.f; bool has = false;
    f32x16 O0 = {}, O1 = {}, LS = {}, CI;
#pragma unroll
    for (int r = 0; r < 16; ++r) CI[r] = bfar;
    const bf16x8 ones = __builtin_bit_cast(bf16x8, ((u32x4){0x3f803f80u, 0x3f803f80u, 0x3f803f80u, 0x3f803f80u}));
    u32x4 kr = *(const u32x4*)kg, vr = *(const u32x4*)vg;
    unsigned long long mwn = mrow[0];
    *(LAS u32x4*)kl = kr; *(LAS u32x2*)vl = (u32x2){vr.x, vr.y}; *(LAS u32x2*)(vl + 8) = (u32x2){vr.z, vr.w};
    __syncthreads();
    for (int kt = 0; kt < NT; ++kt) {
        const int buf = kt & 1;
        const unsigned long long mw = mwn;
        if (kt + 1 < NT) { kr = *(const u32x4*)(kg + (size_t)(kt + 1) * 64 * AW); vr = *(const u32x4*)(vg + (kt + 1) * 64); if (kt + 1 <= ktmax) mwn = mrow[kt + 1]; }
        if (kt <= ktmax) {
            const LAS unsigned char* kp = kfb + buf * 64 * KPITCH;
            f32x16 S0 = CI, S1 = CI;
#pragma unroll
            for (int ks = 0; ks < 4; ++ks) {
                const bf16x8 k0 = *(const LAS bf16x8*)(kp + ks * 32), k1 = *(const LAS bf16x8*)(kp + 32 * KPITCH + ks * 32);
                S0 = __builtin_amdgcn_mfma_f32_32x32x16_bf16(k0, qf[ks], S0, 0, 0, 0);
                S1 = __builtin_amdgcn_mfma_f32_32x32x16_bf16(k1, qf[ks], S1, 0, 0, 0);
            }
            const int mw0 = (int)((unsigned)mw >> (4 * hi)), mw1 = (int)((unsigned)(mw >> 32) >> (4 * hi));
            const bool far = (256 * Q + 32 * w - 64 * kt) >= 175;
            if (!far) {
                const int d0 = posq - 64 * kt - 4 * hi;
#pragma unroll
                for (int r = 0; r < 16; ++r) { const int ko = (r & 3) + 8 * (r >> 2);
                    int da = d0 - ko, db = d0 - 32 - ko; da = da < 0 ? 0 : (da > 128 ? 128 : da); db = db < 0 ? 0 : (db > 128 ? 128 : db);
                    S0[r] += tbh[da] - bfar; S1[r] += tbh[db] - bfar; }
            }
            float tmax = -INFINITY;
#pragma unroll
            for (int r = 0; r < 16; ++r) { const int ko = (r & 3) + 8 * (r >> 2);
                const unsigned t0 = (unsigned)__builtin_amdgcn_sbfe(mw0, ko, 1), t1 = (unsigned)__builtin_amdgcn_sbfe(mw1, ko, 1);
                S0[r] = __uint_as_float((__float_as_uint(S0[r]) & t0) | (NEGB & ~t0)); S1[r] = __uint_as_float((__float_as_uint(S1[r]) & t1) | (NEGB & ~t1));
                tmax = fmaxf(tmax, fmaxf(S0[r], S1[r])); }
            tmax = fmaxf(tmax, __shfl_xor(tmax, 32));
            if (__any(tmax > 8.0f || (!has && tmax > -INFINITY))) {
                const bool upd = tmax > -INFINITY && (!has || tmax > 0.f);
                const float dl = upd ? tmax : 0.f;
                const float alpha = has ? __builtin_amdgcn_exp2f(-dl) : 1.0f;
                m_abs += dl; has = has || upd;
#pragma unroll
                for (int r = 0; r < 16; ++r) { S0[r] -= dl; S1[r] -= dl; CI[r] = bfar - m_abs; }
                if (hi == 0) sc[c] = alpha;
                LDS_WAIT(); asm volatile("" ::: "memory");
#pragma unroll
                for (int r = 0; r < 16; ++r) { const float f = sc[crow(r, hi)]; O0[r] *= f; O1[r] *= f; LS[r] *= f; }
                LDS_WAIT(); asm volatile("" ::: "memory");
            }
#pragma unroll
            for (int r = 0; r < 16; ++r) { S0[r] = __builtin_amdgcn_exp2f(S0[r]); S1[r] = __builtin_amdgcn_exp2f(S1[r]); }
            const LAS unsigned char* vp = vfb + buf * 64 * VPITCH;
#pragma unroll
            for (int s2 = 0; s2 < 4; ++s2) {
                u32x4 pw;
                if (s2 < 2) { const int o = 8 * (s2 & 1); pw.x = cvt_pk_bf16(S0[o + 0], S0[o + 1]); pw.y = cvt_pk_bf16(S0[o + 2], S0[o + 3]); pw.z = cvt_pk_bf16(S0[o + 4], S0[o + 5]); pw.w = cvt_pk_bf16(S0[o + 6], S0[o + 7]); }
                else { const int o = 8 * (s2 & 1); pw.x = cvt_pk_bf16(S1[o + 0], S1[o + 1]); pw.y = cvt_pk_bf16(S1[o + 2], S1[o + 3]); pw.z = cvt_pk_bf16(S1[o + 4], S1[o + 5]); pw.w = cvt_pk_bf16(S1[o + 6], S1[o + 7]); }
                const bf16x8 pf = __builtin_bit_cast(bf16x8, pw);
                const u32x2 a0 = *(const LAS u32x2*)(vp + s2 * 32), a1 = *(const LAS u32x2*)(vp + s2 * 32 + 16);
                const u32x2 b0 = *(const LAS u32x2*)(vp + 32 * VPITCH + s2 * 32), b1 = *(const LAS u32x2*)(vp + 32 * VPITCH + s2 * 32 + 16);
                const bf16x8 v0 = __builtin_bit_cast(bf16x8, ((u32x4){a0.x, a0.y, a1.x, a1.y})), v1 = __builtin_bit_cast(bf16x8, ((u32x4){b0.x, b0.y, b1.x, b1.y}));
                O0 = __builtin_amdgcn_mfma_f32_32x32x16_bf16(pf, v0, O0, 0, 0, 0);
                O1 = __builtin_amdgcn_mfma_f32_32x32x16_bf16(pf, v1, O1, 0, 0, 0);
                LS = __builtin_amdgcn_mfma_f32_32x32x16_bf16(pf, ones, LS, 0, 0, 0);
            }
        }
        if (kt + 1 < NT) { LAS unsigned char* k2 = kl + (buf ^ 1) * 64 * KPITCH; LAS unsigned char* v2 = vl + (buf ^ 1) * 64 * VPITCH;
            *(LAS u32x4*)k2 = kr; *(LAS u32x2*)v2 = (u32x2){vr.x, vr.y}; *(LAS u32x2*)(v2 + 8) = (u32x2){vr.z, vr.w}; }
        __syncthreads();
    }
    bf16_t* ob = AO + (size_t)(b * SEQ + 32 * qb32) * AW + h * HD + c;
#pragma unroll
    for (int r = 0; r < 16; ++r) { const int qr = crow(r, hi); const float f = __builtin_amdgcn_rcpf(LS[r]);
        const float a0 = O0[r] * f, a1 = O1[r] * f, b0 = __shfl_xor(a0, 1), b1 = __shfl_xor(a1, 1);
        if ((c & 1) == 0) { *(unsigned*)(ob + (size_t)qr * AW) = cvt_pk_bf16(a0, b0); *(unsigned*)(ob + (size_t)qr * AW + 32) = cvt_pk_bf16(a1, b1); } }
}
__device__ __forceinline__ void p3_attn(Frame& F, const Args& a) {
    LAS float* tb = (LAS float*)(F.lds + AT_TB);
    __syncthreads();
    for (int idx = F.tid; idx < NH * 129; idx += NTHREADS) { const int h = idx / 129, d = idx % 129; const int bk = d < 128 ? (int)T5B[d] : 31; tb[h * TBS + d] = a.in[I_RELB][bk * NH + h] * LOG2E; }
    __syncthreads();
    for (int i = F.bid; i < 256; i += F.G) { const int bh = i >> 2, j = i & 3; p3_attn_unit(F, bh >> 3, bh & 7, j); p3_attn_unit(F, bh >> 3, bh & 7, 7 - j); }
    __syncthreads();
}

constexpr int WLP = 2064;
constexpr int P6_WHI = 0, P6_WLO = NE * WLP, P6_PART = 2 * NE * WLP, P6_SSP = P6_PART + 2 * 64 * 33 * 4, P6_CNT = P6_SSP + 2 * 64 * 4, P6_END = P6_CNT + 256;
static_assert(P6_END <= LDSX_OFF, "router LDS map");
__device__ __forceinline__ void p6_router(Frame& F, const Args& a) {
    unsigned char* ws = F.ws;
    const float* H1 = wsp<float>(ws, WS_H1); bf16_t* HN = wsp<bf16_t>(ws, WS_XN);
    const float* gf = a.in[I_NFFN]; const float* brt = a.in[I_BR];
    int* TE = wsp<int>(ws, WS_TE); int* TPs = wsp<int>(ws, WS_TP); int* LIST = wsp<int>(ws, WS_LIST); float* LG = wsp<float>(ws, WS_LG); float* RG = wsp<float>(ws, WS_RG);
    unsigned* ecnt = wsp<unsigned>(ws, WS_CTL) + CW_ECNT;
    LAS unsigned char* lds = F.lds;
    LAS float* part = (LAS float*)(lds + P6_PART);
    LAS float* ssp = (LAS float*)(lds + P6_SSP);
    LAS int* lcnt = (LAS int*)(lds + P6_CNT);
    LAS int* lbase = lcnt + 32;
    const int lane = F.lane, w = F.wave, tk = lane & 15, kq = lane >> 4;
    __syncthreads();
    { const unsigned char* src = ws + WS_WRT;
      for (int p = F.tid; p < 2 * NE * 128; p += NTHREADS) { const int arr = p >> 12, row = (p >> 7) & 31, c16 = p & 127;
          *(LAS u32x4*)(lds + arr * (NE * WLP) + row * WLP + c16 * 16) = *(const u32x4*)(src + (size_t)arr * NE * DM * 2 + (size_t)row * DM * 2 + c16 * 16); } }
    for (int tb = F.bid; tb < NTOK / 64; tb += F.G) {
        const int t0 = tb * 64;
        __syncthreads();
        if (F.tid < 32) lcnt[F.tid] = 0;
        {
            const int tg = w & 3, kh = w >> 2, tok = t0 + 16 * tg + tk;
            const float* xr = H1 + (size_t)tok * DM + 512 * kh + 8 * kq; const float* gr = gf + 512 * kh + 8 * kq;
            bf16_t* hr = HN + (size_t)tok * DM + 512 * kh + 8 * kq;
            const LAS unsigned char* wl = lds + tk * WLP + (512 * kh + 8 * kq) * 2;
            f32x4 xa[16], xb[16];
#pragma unroll
            for (int ks = 0; ks < 16; ++ks) { xa[ks] = *(const f32x4*)(xr + 32 * ks); xb[ks] = *(const f32x4*)(xr + 32 * ks + 4); }
            f32x4 acc0 = {0.f, 0.f, 0.f, 0.f}, acc1 = acc0; float ss = 0.f;
#pragma unroll
            for (int ks = 0; ks < 16; ++ks) {
                const f32x4 g0 = *(const f32x4*)(gr + 32 * ks), g1 = *(const f32x4*)(gr + 32 * ks + 4);
                const f32x4 x0 = xa[ks], x1 = xb[ks];
                u32x4 hn; hn.x = cvt_pk_bf16(x0[0] * g0[0], x0[1] * g0[1]); hn.y = cvt_pk_bf16(x0[2] * g0[2], x0[3] * g0[3]); hn.z = cvt_pk_bf16(x1[0] * g1[0], x1[1] * g1[1]); hn.w = cvt_pk_bf16(x1[2] * g1[2], x1[3] * g1[3]);
                *(u32x4*)(hr + 32 * ks) = hn;
                ss += (x0[0] * x0[0] + x0[1] * x0[1]) + (x0[2] * x0[2] + x0[3] * x0[3]) + (x1[0] * x1[0] + x1[1] * x1[1]) + (x1[2] * x1[2] + x1[3] * x1[3]);
                u32x4 xh; xh.x = cvt_pk_bf16(x0[0], x0[1]); xh.y = cvt_pk_bf16(x0[2], x0[3]); xh.z = cvt_pk_bf16(x1[0], x1[1]); xh.w = cvt_pk_bf16(x1[2], x1[3]);
                u32x4 xl; xl.x = cvt_pk_bf16(x0[0] - bflo(xh.x), x0[1] - bfhi(xh.x)); xl.y = cvt_pk_bf16(x0[2] - bflo(xh.y), x0[3] - bfhi(xh.y));
                          xl.z = cvt_pk_bf16(x1[0] - bflo(xh.z), x1[1] - bfhi(xh.z)); xl.w = cvt_pk_bf16(x1[2] - bflo(xh.w), x1[3] - bfhi(xh.w));
                const bf16x8 fxh = __builtin_bit_cast(bf16x8, xh), fxl = __builtin_bit_cast(bf16x8, xl);
                const bf16x8 wh0 = *(const LAS bf16x8*)(wl + P6_WHI + ks * 64), wh1 = *(const LAS bf16x8*)(wl + P6_WHI + 16 * WLP + ks * 64);
                const bf16x8 wl0 = *(const LAS bf16x8*)(wl + P6_WLO + ks * 64), wl1 = *(const LAS bf16x8*)(wl + P6_WLO + 16 * WLP + ks * 64);
                acc0 = __builtin_amdgcn_mfma_f32_16x16x32_bf16(wh0, fxh, acc0, 0, 0, 0); acc1 = __builtin_amdgcn_mfma_f32_16x16x32_bf16(wh1, fxh, acc1, 0, 0, 0);
                acc0 = __builtin_amdgcn_mfma_f32_16x16x32_bf16(wl0, fxh, acc0, 0, 0, 0); acc1 = __builtin_amdgcn_mfma_f32_16x16x32_bf16(wl1, fxh, acc1, 0, 0, 0);
                acc0 = __builtin_amdgcn_mfma_f32_16x16x32_bf16(wh0, fxl, acc0, 0, 0, 0); acc1 = __builtin_amdgcn_mfma_f32_16x16x32_bf16(wh1, fxl, acc1, 0, 0, 0);
            }
            ss += __shfl_xor(ss, 16); ss += __shfl_xor(ss, 32);
            LAS float* pp = part + ((kh * 64) + 16 * tg + tk) * 33 + 4 * kq;
#pragma unroll
            for (int r = 0; r < 4; ++r) { pp[r] = acc0[r]; pp[16 + r] = acc1[r]; }
            if (kq == 0) ssp[kh * 64 + 16 * tg + tk] = ss;
        }
        __syncthreads();
        if (w == 0) {
            const float rinv = 1.0f / sqrtf((ssp[lane] + ssp[64 + lane]) * (1.f / DM) + EPS);
            float lg[NE];
#pragma unroll
            for (int e = 0; e < NE; ++e) lg[e] = (part[lane * 33 + e] + part[(64 + lane) * 33 + e]) * rinv + brt[e];
            int sel[4]; float val[4];
#pragma unroll
            for (int j = 0; j < 4; ++j) { float best = -INFINITY; int bi = 0;
#pragma unroll
                for (int e = 0; e < NE; ++e) { const bool tk_ = lg[e] > best; best = tk_ ? lg[e] : best; bi = tk_ ? e : bi; }
                sel[j] = bi; val[j] = best;
#pragma unroll
                for (int e = 0; e < NE; ++e) lg[e] = (e == bi) ? -INFINITY : lg[e]; }
            float den = 0.f, ex[4];
#pragma unroll
            for (int j = 0; j < 4; ++j) { ex[j] = __expf(val[j] - val[0]); den += ex[j]; }
            int slot[4];
#pragma unroll
            for (int j = 0; j < 4; ++j) slot[j] = __hip_atomic_fetch_add(&lcnt[sel[j]], 1, __ATOMIC_RELAXED, __HIP_MEMORY_SCOPE_WORKGROUP);
            LDS_WAIT();
            if (lane < 32) { const int n = lcnt[lane]; lbase[lane] = n ? (int)__hip_atomic_fetch_add(ecnt + 64 * lane, (unsigned)n, RLX_AGENT) : 0; }
            LDS_WAIT(); asm volatile("" ::: "memory");
            const int t = t0 + lane;
#pragma unroll
            for (int j = 0; j < 4; ++j) { const int e = sel[j], pos = lbase[e] + slot[j]; const float g = ex[j] / den;
                TE[t * 4 + j] = e; TPs[t * 4 + j] = pos; LIST[(size_t)e * NTOK + pos] = t; LG[(size_t)e * NTOK + pos] = g; RG[(size_t)e * NTOK + pos] = rinv; }
        }
    }
    __syncthreads();
}
__device__ __forceinline__ void moe_tables(Frame& F, LAS int* cnt, LAS int* tbase) {
    const unsigned* ecnt = wsp<unsigned>(F.ws, WS_CTL) + CW_ECNT;
    __syncthreads();
    if (F.tid < NE) cnt[F.tid] = (int)__hip_atomic_load(ecnt + 64 * F.tid, RLX_AGENT);
    __syncthreads();
    if (F.tid == 0) { int s = 0; for (int e = 0; e < NE; ++e) { tbase[e] = s; s += (cnt[e] + 255) >> 8; } tbase[NE] = s; }
    __syncthreads();
}

__device__ __forceinline__ void p9_final(Frame& F, const Args& a, const LAS int* tbase) {
    unsigned char* ws = F.ws;
    const float* H1 = wsp<float>(ws, WS_H1); float* OUT = a.out; const bf16_t* YP = wsp<bf16_t>(ws, WS_YP); const int* TE = wsp<int>(ws, WS_TE); const int* TPs = wsp<int>(ws, WS_TP); const float* gf = a.in[I_NFIN];
    const int gw = F.bid * NWAVES + F.wave, NGW = F.G * NWAVES, lane = F.lane;
    const f32x4* gr = (const f32x4*)gf + lane;
    f32x4 gg[4];
#pragma unroll
    for (int j = 0; j < 4; ++j) gg[j] = gr[64 * j];
#ifdef DBG_CHECK_DPP
    if (__hip_atomic_load(wsp<unsigned>(ws, WS_CTL) + 3, RLX_AGENT) != 0u) { const float qn = __builtin_nanf("");
#pragma unroll
        for (int j = 0; j < 4; ++j) gg[j] = (f32x4){qn, qn, qn, qn}; }
#endif
    for (int base = 0; base < NTOK; base += 8 * NGW) {
        int myrow = 0;
        { const int i = lane >> 2, j = lane & 3, t = base + gw + NGW * i; if (lane < 32 && t < NTOK) { const int e = TE[t * 4 + j], pos = TPs[t * 4 + j]; myrow = tbase[e] * 256 + pos; } }
        f32x4 va[4], vb[4]; u32x2 ya[4][4], yb[4][4];
#define P9_LOAD(i, V, Y) do { const int t_ = base + gw + NGW * (i); if (t_ < NTOK) { const f32x4* xr_ = (const f32x4*)(H1 + (size_t)t_ * DM) + lane; \
            _Pragma("unroll") for (int j_ = 0; j_ < 4; ++j_) V[j_] = xr_[64 * j_]; \
            _Pragma("unroll") for (int q_ = 0; q_ < 4; ++q_) { const int row_ = __builtin_amdgcn_readlane(myrow, 4 * (i) + q_); const u32x2* yr_ = (const u32x2*)(YP + (size_t)row_ * DM) + lane; \
                _Pragma("unroll") for (int j_ = 0; j_ < 4; ++j_) Y[q_][j_] = yr_[64 * j_]; } } } while (0)
#define P9_PROC(i, V, Y) do { const int t_ = base + gw + NGW * (i); if (t_ < NTOK) { \
            _Pragma("unroll") for (int q_ = 0; q_ < 4; ++q_) _Pragma("unroll") for (int j_ = 0; j_ < 4; ++j_) { const u32x2 y_ = Y[q_][j_]; V[j_].x += bflo(y_.x); V[j_].y += bfhi(y_.x); V[j_].z += bflo(y_.y); V[j_].w += bfhi(y_.y); } \
            float s_ = 0.f; _Pragma("unroll") for (int j_ = 0; j_ < 4; ++j_) s_ += (V[j_].x * V[j_].x + V[j_].y * V[j_].y) + (V[j_].z * V[j_].z + V[j_].w * V[j_].w); \
            const float r_ = 1.0f / sqrtf(wave_sum(s_) * (1.f / DM) + EPS); f32x4* xo_ = (f32x4*)(OUT + (size_t)t_ * DM) + lane; \
            _Pragma("unroll") for (int j_ = 0; j_ < 4; ++j_) xo_[64 * j_] = (f32x4){V[j_].x * r_ * gg[j_].x, V[j_].y * r_ * gg[j_].y, V[j_].z * r_ * gg[j_].z, V[j_].w * r_ * gg[j_].w}; } } while (0)
        P9_LOAD(0, va, ya);
#pragma unroll
        for (int i = 0; i < 8; i += 2) {
            P9_LOAD(i + 1, vb, yb);
            P9_PROC(i, va, ya);
            if (i + 2 < 8) P9_LOAD(i + 2, va, ya);
            P9_PROC(i + 1, vb, yb);
        }
#undef P9_LOAD
#undef P9_PROC
    }
}

constexpr int N_PHASES = 10;
__global__ void __launch_bounds__(NTHREADS, 2) fwd_kernel(Args args) {
    extern __shared__ __attribute__((aligned(16))) unsigned char lds_raw[];
    Frame F;
    F.lds = (LAS unsigned char*)lds_raw; F.ws = args.ws;
    F.tid = threadIdx.x; F.lane = F.tid & 63; F.wave = __builtin_amdgcn_readfirstlane(F.tid >> 6);
    F.G = gridDim.x; F.bid = blockIdx.x;
    volatile LAS unsigned* MISC = (volatile LAS unsigned*)(F.lds + MISC_OFF);
    if (F.tid < 32) MISC[F.tid] = 0u;
    __syncthreads();
    unsigned* ctl = wsp<unsigned>(args.ws, WS_CTL);
    const int lo = args.ph_lo, hi = args.ph_hi;
    const bool multi = (hi - lo) > 1;
    XcdBarrier bar; bar.bar = ctl + CW_BAR; bar.x = 0; bar.st = nullptr;
    if (multi) bar = xcd_barrier_post(ctl + CW_BAR, MISC + 8);
#ifndef PHASE_MASK
#define PHASE_MASK 0x3ff
#endif
#define IN(k) (((PHASE_MASK >> (k)) & 1) && lo <= (k) && (k) < hi)
#define SEAM(k) do { if (IN(k) && IN((k) + 1)) xcd_barrier(bar); } while (0)
    LAS int* l_cnt = (LAS int*)(F.lds + LDSX_OFF); LAS int* l_tbase = l_cnt + 64;
    const MoeTables MT{l_cnt, l_tbase};

    if (IN(0)) { p0_prologue(F, args, 0); } SEAM(0);
    if (IN(1)) {
        PlainSched S; S.init(args.ws, WS_XN, WS_WIN, NTOK, 5120, DM, F.G, F.bid);
        EpiInProj E{args.ws, args.in[I_BGATE]};
        if (!(args.flags & 64)) pg8::gemm_phase<EpiInProj, PlainSched>(F.lds, DM, S, E);
        if (!(args.flags & 128)) p1_thin(F, args.flags);
    } SEAM(1);
    if (IN(2)) {
        const int cvt_slot = (F.bid >> 3) % 3;
        if (cvt_slot == 0 && !(args.flags & 1024)) { p0_prologue(F, args, 1); __syncthreads(); }
        if (!(args.flags & 1)) p2_conv(F, args);
        if (!(args.flags & 2)) p2_indexer(F, args.flags, 0);
        if (cvt_slot == 1 && !(args.flags & 1024)) { __syncthreads(); p0_prologue(F, args, 1); __syncthreads(); }
        if (!(args.flags & 2)) p2_indexer(F, args.flags, 1);
        if (cvt_slot == 2 && !(args.flags & 1024)) { __syncthreads(); p0_prologue(F, args, 1); }
    } SEAM(2);
    if (IN(3)) { p3_attn(F, args); } SEAM(3);
    if (IN(4)) {
        MergeSched S{(const char*)args.ws, F.G, F.bid}; EpiMerge E{args.ws};
        pg8::gemm_phase<EpiMerge, MergeSched>(F.lds, 512, S, E);
    } SEAM(4);
    if (IN(5)) {
        PlainSched S; S.init(args.ws, WS_MG, WS_WOUT, NTOK, DM, DM, F.G, F.bid);
        EpiResid E{args.in[I_X], wsp<float>(args.ws, WS_H1)};
        pg8::gemm_phase<EpiResid, PlainSched>(F.lds, DM, S, E);
    } SEAM(5);
    if (IN(6)) { p6_router(F, args); } SEAM(6);
    if (IN(7)) {
        moe_tables(F, l_cnt, l_tbase);
        MoeSched<8, true> S{(const char*)args.ws, MT, F.G, F.bid, l_tbase[NE] * 8};
        EpiSwiglu E{args.ws, args.in[I_BUG], MT};
        pg8::gemm_phase<EpiSwiglu, MoeSched<8, true>>(F.lds, DM, S, E);
    } SEAM(7);
    if (IN(8)) {
        moe_tables(F, l_cnt, l_tbase);
        MoeSched<4, false> S{(const char*)args.ws, MT, F.G, F.bid, l_tbase[NE] * 4};
        EpiDown E{args.ws, args.in[I_BD], MT};
        pg8::gemm_phase<EpiDown, MoeSched<4, false>>(F.lds, DFF, S, E);
    } SEAM(8);
    if (IN(9)) { moe_tables(F, l_cnt, l_tbase); p9_final(F, args, l_tbase); }
#undef IN
#undef SEAM
}

#ifdef DBG_HASH_OFF
__global__ void dbg_hash(const unsigned* __restrict__ buf, size_t nwords, unsigned* acc) {
    unsigned h = 0u;
    for (size_t i = (size_t)blockIdx.x * blockDim.x + threadIdx.x; i < nwords; i += (size_t)gridDim.x * blockDim.x) h += (buf[i] ^ (unsigned)(i * 2654435761u)) * 2246822519u + (unsigned)i;
#pragma unroll
    for (int o = 1; o < 64; o <<= 1) h += __shfl_xor(h, o);
    if ((threadIdx.x & 63) == 0) atomicAdd(acc, h);
}
__global__ void dbg_fill(float* out, size_t n, const unsigned* acc) {
    const unsigned h = *acc; const float v = (float)((h >> 7) & 0xffffu) * (1.0f / 4096.0f) + 1.0f;
    for (size_t i = (size_t)blockIdx.x * blockDim.x + threadIdx.x; i < n; i += (size_t)gridDim.x * blockDim.x) out[i] = v;
}
#endif

extern "C" void kernel_launch(void* const* d_in, const int* in_sizes, int n_in, void* d_out, int out_size, void* d_ws, size_t ws_size, hipStream_t stream) {
    static int grid = 0;
    if (grid == 0) {
        if (n_in != 21 || out_size != NTOK * DM || ws_size < WS_END) { fprintf(stderr, "kernel_launch: unexpected shapes (n_in %d, out %d, ws %zu < %zu)\n", n_in, out_size, ws_size, (size_t)WS_END); grid = -1; return; }
        int dev = 0, cus = 0, per_cu = 0;
        if (hipGetDevice(&dev) != hipSuccess || hipDeviceGetAttribute(&cus, hipDeviceAttributeMultiprocessorCount, dev) != hipSuccess) { grid = -1; return; }
        if (hipFuncSetAttribute((const void*)fwd_kernel, hipFuncAttributeMaxDynamicSharedMemorySize, LDS_BYTES) != hipSuccess) { fprintf(stderr, "kernel_launch: hipFuncSetAttribute failed\n"); grid = -1; return; }
        if (hipOccupancyMaxActiveBlocksPerMultiprocessor(&per_cu, (const void*)fwd_kernel, NTHREADS, LDS_BYTES) != hipSuccess || per_cu < 1) { fprintf(stderr, "kernel_launch: occupancy query says %d\n", per_cu); }
        (void)hipGetLastError();
        grid = cus;
    }
    if (grid < 0) return;
    (void)hipMemsetAsync((char*)d_ws + WS_CTL, 0, CTL_ZERO_BYTES, stream);
    Args a{};
    for (int i = 0; i < 21; ++i) a.in[i] = (const float*)d_in[i];
    a.out = (float*)d_out; a.ws = (unsigned char*)d_ws;
#if MK_N_LAUNCHES == 1
    a.ph_lo = 0; a.ph_hi = N_PHASES;
    hipLaunchKernelGGL(fwd_kernel, dim3(grid), dim3(NTHREADS), LDS_BYTES, stream, a);
#else
#ifndef DBG_LAST_PHASE
#define DBG_LAST_PHASE (N_PHASES - 1)
#endif
#ifndef DBG_DUP_MASK
#define DBG_DUP_MASK 0
#endif
#ifndef DBG_DUP_FLAGS
#define DBG_DUP_FLAGS 0
#endif
    for (int p = 0; p <= DBG_LAST_PHASE; ++p) { a.ph_lo = p; a.ph_hi = p + 1;
        const int nrep = ((DBG_DUP_MASK >> p) & 1) ? 2 : 1;
        for (int rep = 0; rep < nrep; ++rep) { a.flags = (nrep == 2 && rep == 0) ? DBG_DUP_FLAGS : 0; if (rep == 1 && p == 6) (void)hipMemsetAsync((char*)d_ws + WS_CTL, 0, CTL_ZERO_BYTES, stream);
            hipLaunchKernelGGL(fwd_kernel, dim3(grid), dim3(NTHREADS), LDS_BYTES, stream, a); } }
#ifdef DBG_HASH_OFF
    { const unsigned* hb = DBG_HASH_OFF == 0 ? (const unsigned*)d_out : (const unsigned*)((char*)d_ws + DBG_HASH_OFF);
      hipLaunchKernelGGL(dbg_hash, dim3(1024), dim3(256), 0, stream, hb, (size_t)(DBG_HASH_BYTES) / 4, (unsigned*)d_ws + 2);
      hipLaunchKernelGGL(dbg_fill, dim3(1024), dim3(256), 0, stream, (float*)d_out, (size_t)NTOK * DM, (const unsigned*)d_ws + 2); }
#endif
#endif
}
```

```cpp
#include <hip/hip_runtime.h>
#include <cstdio>
#include <cstdint>

#ifndef MK_N_LAUNCHES
#define MK_N_LAUNCHES 1
#endif

constexpr int NB = 8, SEQ = 2048, NMETA = 16, TT = SEQ + NMETA  , DM = 1024, NTOK = NB * SEQ  , NALL = NB * TT  ;
constexpr int AW = 512, NH = 8, HD = 64, IDXD = 64, CC = 512, CW = 31, NE = 32, DFF = 1024, TOPK = 256;
constexpr int INCOLS = 5192, TP = 2176  , VOFF = 0  , MSTR = 68  ;
constexpr float EPS = 1e-6f, LOG2E = 1.4426950408889634f;
constexpr float QSCALE = 0.125f * LOG2E;
constexpr int MAXTILES = 296;
constexpr int SC_Q = 0, SC_K = 512, SC_V = 1024, SC_IQ = 1536, SC_IK = 2048, SC_IW = 2112, SC_GLU = 2120, SC_GATE = 3144;
constexpr int WR_GLU = 2048, WR_GATE = 3072, WR_IK = 5120, WR_IW = 5184, WIN_ROWS = 5376;

constexpr size_t MiB = 1u << 20;
constexpr size_t al4k(size_t x) { return (x + 4095) & ~(size_t)4095; }
constexpr size_t WS_CTL = 0, CTL_ZERO_BYTES = 1 * MiB;
constexpr size_t WS_WIN = 1 * MiB;
constexpr size_t WS_WAO = WS_WIN + al4k((size_t)WIN_ROWS * DM * 2);
constexpr size_t WS_WCO = WS_WAO + al4k((size_t)DM * AW * 2);
constexpr size_t WS_WOUT = WS_WCO + al4k((size_t)DM * CC * 2);
constexpr size_t WS_WUG = WS_WOUT + al4k((size_t)DM * DM * 2);
constexpr size_t WS_WD = WS_WUG + al4k((size_t)NE * 2 * DFF * DM * 2);
constexpr size_t WS_XN = WS_WD + al4k((size_t)NE * DM * DFF * 2);
constexpr size_t WS_XNM = WS_XN + al4k((size_t)NTOK * DM * 2);
constexpr size_t WS_Q = WS_XNM + al4k((size_t)NMETA * DM * 2);
constexpr size_t WS_IQ = WS_Q + al4k((size_t)NTOK * AW * 2);
constexpr size_t WS_KB = WS_IQ + al4k((size_t)NTOK * AW * 2);
constexpr size_t WS_VT = WS_KB + al4k((size_t)(NALL + 64) * AW * 2);
constexpr size_t WS_IK = WS_VT + al4k((size_t)NB * AW * TP * 2);
constexpr size_t WS_IW = WS_IK + al4k((size_t)NB * 65 * 2048 * 2);
constexpr size_t WS_GLU = WS_IW + al4k((size_t)NTOK * 8 * 4);
constexpr size_t WS_GA = WS_GLU + al4k((size_t)NALL * CC * 2);
constexpr size_t WS_GB = WS_GA + al4k((size_t)NTOK * DM * 2);
constexpr size_t WS_MASK = WS_GB + al4k((size_t)NTOK * DM * 2);
constexpr size_t WS_AO = WS_MASK + al4k((size_t)NTOK * MSTR * 4);
constexpr size_t WS_CO = WS_AO + al4k((size_t)NTOK * AW * 2);
constexpr size_t WS_MG = WS_CO + al4k((size_t)NTOK * CC * 2);
constexpr size_t WS_TE = WS_MG + al4k((size_t)NTOK * DM * 2);
constexpr size_t WS_TP = WS_TE + al4k((size_t)NTOK * 4 * 4);
constexpr size_t WS_LIST = WS_TP + al4k((size_t)NTOK * 4 * 4);
constexpr size_t WS_LG = WS_LIST + al4k((size_t)NE * NTOK * 4);
constexpr size_t WS_ACT = WS_LG + al4k((size_t)NE * NTOK * 4);
constexpr size_t WS_YP = WS_ACT + al4k((size_t)MAXTILES * 256 * DFF * 2);
constexpr size_t WS_H1 = WS_YP + al4k((size_t)MAXTILES * 256 * DM * 2);
constexpr size_t WS_WRT = WS_H1 + al4k((size_t)NTOK * DM * 4);
constexpr size_t WS_RG = WS_WRT + al4k((size_t)2 * NE * DM * 2);
constexpr size_t WS_DUMMY = WS_RG + al4k((size_t)NE * NTOK * 4);
constexpr size_t WS_END = WS_DUMMY + 4096;
static_assert(WS_END < ((size_t)1 << 32), "32-bit byte offsets into d_ws");
constexpr int CW_TMO = 0, CW_CODE = 1, CW_BAR = 4096, CW_ECNT = 16384;

constexpr int RING_BYTES = 131072;
constexpr int LDSX_OFF = 153600;
constexpr int MISC_OFF = 161792;
constexpr int LDS_BYTES = 163840;
constexpr int NWAVES = 8, NTHREADS = 512;

#define GAS __attribute__((address_space(1)))
#define LAS __attribute__((address_space(3)))
typedef unsigned short bf16_t;
typedef short bf16x8 __attribute__((ext_vector_type(8)));
typedef short s16x4 __attribute__((ext_vector_type(4)));
typedef float f32x4 __attribute__((ext_vector_type(4)));
typedef float f32x16 __attribute__((ext_vector_type(16)));
typedef unsigned u32x4 __attribute__((ext_vector_type(4)));
typedef unsigned u32x2 __attribute__((ext_vector_type(2)));
typedef GAS unsigned gu32;
#define RLX_AGENT __ATOMIC_RELAXED, __HIP_MEMORY_SCOPE_AGENT
#define LDS_WAIT() asm volatile("s_waitcnt lgkmcnt(0)" ::: "memory")
#define VM_WAIT() asm volatile("s_waitcnt vmcnt(0)" ::: "memory")

typedef float f32x2_t __attribute__((ext_vector_type(2))); typedef __bf16 bf16x2_t __attribute__((ext_vector_type(2)));
__device__ __forceinline__ unsigned cvt_pk_bf16(float lo, float hi) { const f32x2_t v = {lo, hi}; const bf16x2_t b = __builtin_convertvector(v, bf16x2_t); return __builtin_bit_cast(unsigned, b); }
__device__ __forceinline__ float bf2f(unsigned short b) { return __uint_as_float((unsigned)b << 16); }
__device__ __forceinline__ float bflo(unsigned w) { return __uint_as_float(w << 16); }
__device__ __forceinline__ float bfhi(unsigned w) { return __uint_as_float(w & 0xffff0000u); }
__device__ __forceinline__ float sigmoidf_(float x) { return __builtin_amdgcn_rcpf(1.0f + __builtin_amdgcn_exp2f(-LOG2E * x)); }
__device__ __forceinline__ f32x2_t rcp1pexp2_2(f32x2_t x, float k) { const f32x2_t t = x * (f32x2_t){k, k}; f32x2_t e; e.x = __builtin_amdgcn_exp2f(t.x); e.y = __builtin_amdgcn_exp2f(t.y);
    e = e + (f32x2_t){1.0f, 1.0f}; f32x2_t r; r.x = __builtin_amdgcn_rcpf(e.x); r.y = __builtin_amdgcn_rcpf(e.y); return r; }
__device__ __forceinline__ f32x2_t lo2(f32x4 v) { return __builtin_shufflevector(v, v, 0, 1); }
__device__ __forceinline__ f32x2_t hi2(f32x4 v) { return __builtin_shufflevector(v, v, 2, 3); }
__device__ __forceinline__ f32x4 cat2(f32x2_t a, f32x2_t b) { return __builtin_shufflevector(a, b, 0, 1, 2, 3); }
__device__ __forceinline__ float wave_sum(float v) {
#pragma unroll
    for (int o = 1; o < 64; o <<= 1) v += __shfl_xor(v, o);
    return v;
}

namespace pg8 {
constexpr int BM = 256, BK = 64, HALF = 128, HTB = HALF * BK * 2, STAGE_BYTES = 8 * HTB;
__host__ __device__ __forceinline__ int lds_byte(int r, int c) { const int st = (r >> 4) * 2 + (c >> 5), rr = r & 15, cc = c & 31, ob = rr * 64 + cc * 2; return st * 1024 + (ob ^ (((ob >> 9) & 1) << 5)); }
__host__ __device__ __forceinline__ void stage_rc(int b, int& R, int& C) { const int st = b / 1024, sb = b % 1024, swz = sb ^ (((sb >> 9) & 1) << 5); R = (st >> 1) * 16 + swz / 64; C = (st & 1) * 32 + (swz % 64) / 2; }

struct Unit { int pm, pn, z; };

template <class Epi, class Sched>
__device__ __forceinline__ void gemm_phase(LAS unsigned char* lds, const int K, const Sched& S, const Epi& E) {
    const int tid = threadIdx.x, wid = __builtin_amdgcn_readfirstlane(tid >> 6), lane = tid & 63, wr = wid >> 2, wc = wid & 3, fr = lane & 15, fq = lane >> 4;
    const int nt = K / BK;
    unsigned voffB[2];
#pragma unroll
    for (int i = 0; i < 2; ++i) { int R_, C_; stage_rc(tid * 16 + i * 8192, R_, C_); const int rho = R_ & 31, Rp = (R_ & ~31) + 8 * ((rho & 15) >> 2) + 4 * (rho >> 4) + (rho & 3);
                                  voffB[i] = (unsigned)(Rp * K + C_) * 2u; }
    const size_t kstep = (size_t)(BK * 2);
    const size_t hstep = (size_t)HALF * K * 2;
    const unsigned ldsw = (unsigned)wid * 1024u;
    const int aoff = lds_byte(wr * 64 + fr, fq * 8), boff = lds_byte(wc * 32 + fr, fq * 8);
    const char* const abase = S.a_base();
#define PG8_SA(b, h) (((b) * 2 + (h)) * HTB)
#define PG8_SB(b, h) ((4 + (b) * 2 + (h)) * HTB)
#define PG8_STAGE(bufoff, gbase, voff) do { _Pragma("unroll") for (int _i = 0; _i < 2; ++_i) \
        __builtin_amdgcn_global_load_lds((const unsigned*)((const char*)(gbase) + (voff)[_i]), (LAS unsigned*)(lds + (bufoff) + ldsw + _i * 8192), 16, 0, 0); } while (0)
#define PG8_LDA(dst, b, h) do { _Pragma("unroll") for (int m = 0; m < 4; ++m) _Pragma("unroll") for (int k = 0; k < 2; ++k) dst[m][k] = *(const LAS bf16x8*)(lds + PG8_SA(b, h) + aoff + m * 2048 + k * 1024); } while (0)
#define PG8_LDB(dst, b, h) do { _Pragma("unroll") for (int n = 0; n < 2; ++n) _Pragma("unroll") for (int k = 0; k < 2; ++k) dst[n][k] = *(const LAS bf16x8*)(lds + PG8_SB(b, h) + boff + n * 2048 + k * 1024); } while (0)
#define PG8_MMA(ai, bj, At, Bt) do { __builtin_amdgcn_s_setprio(1); _Pragma("unroll") for (int m = 0; m < 4; ++m) _Pragma("unroll") for (int n = 0; n < 2; ++n) _Pragma("unroll") for (int k = 0; k < 2; ++k) \
        acc[ai][bj][m][n] = __builtin_amdgcn_mfma_f32_16x16x32_bf16(Bt[n][k], At[m][k], acc[ai][bj][m][n], 0, 0, 0); __builtin_amdgcn_s_setprio(0); } while (0)
#define PG8_WAIT_V(n) asm volatile("s_waitcnt vmcnt(" #n ")" ::: "memory")
#define PG8_WAIT_L(n) asm volatile("s_waitcnt lgkmcnt(" #n ")" ::: "memory")
#define PG8_BAR __builtin_amdgcn_s_barrier()
#define PG8_SCHED __builtin_amdgcn_sched_barrier(0)
    Unit cur, nxt; int ui = 0;
    if (!S.next(0, cur)) return;
    f32x4 acc[2][2][4][2];
#pragma unroll
    for (int a = 0; a < 2; ++a)
#pragma unroll
        for (int b = 0; b < 2; ++b)
#pragma unroll
            for (int m = 0; m < 4; ++m)
#pragma unroll
                for (int n = 0; n < 2; ++n) acc[a][b][m][n] = (f32x4){0.f, 0.f, 0.f, 0.f};
    bf16x8 At[4][2], B0[2][2], B1[2][2];
    unsigned ca[2][2], na[2][2];
    S.a_offs(cur, tid, ca);
    const char* cB = S.b_base(cur);
    PG8_STAGE(PG8_SB(0, 0), cB, voffB); PG8_STAGE(PG8_SB(0, 1), cB + hstep, voffB); PG8_STAGE(PG8_SA(0, 0), abase, ca[0]); PG8_STAGE(PG8_SA(0, 1), abase, ca[1]);
    if (wr == 1) PG8_BAR;
    PG8_WAIT_V(2); PG8_BAR;
    PG8_STAGE(PG8_SB(1, 0), cB + kstep, voffB); PG8_STAGE(PG8_SA(1, 0), abase + kstep, ca[0]); PG8_STAGE(PG8_SB(1, 1), cB + hstep + kstep, voffB);
    PG8_WAIT_V(6); PG8_BAR;
    for (;;) {
        const bool has_next = S.next(ui + 1, nxt);
        const char* nB = cB;
#pragma unroll
        for (int h = 0; h < 2; ++h)
#pragma unroll
            for (int i = 0; i < 2; ++i) na[h][i] = ca[h][i];
        if (has_next) { S.a_offs(nxt, tid, na); nB = S.b_base(nxt); }
        for (int t = 0; t < nt; t += 2) {
            const bool last = (t == nt - 2);
            const char* a1 = abase + (size_t)(t + 1) * kstep;
            const char* a2 = last ? abase : abase + (size_t)(t + 2) * kstep; const char* b2 = last ? nB : cB + (size_t)(t + 2) * kstep;
            const char* a3 = a2 + kstep; const char* b3 = b2 + kstep;
            PG8_LDB(B0, 0, 0); PG8_LDB(B1, 0, 1); PG8_SCHED; PG8_LDA(At, 0, 0); PG8_STAGE(PG8_SA(1, 1), a1, ca[1]);
            PG8_WAIT_V(8); PG8_WAIT_L(0); PG8_BAR; PG8_MMA(0, 0, At, B0); PG8_MMA(0, 1, At, B1); PG8_BAR; PG8_SCHED;
            if (last) {
#pragma unroll
                for (int h = 0; h < 2; ++h)
#pragma unroll
                    for (int i = 0; i < 2; ++i) ca[h][i] = na[h][i];
            }
            PG8_LDA(At, 0, 1); PG8_STAGE(PG8_SB(0, 0), b2, voffB); PG8_STAGE(PG8_SB(0, 1), b2 + hstep, voffB); PG8_STAGE(PG8_SA(0, 0), a2, ca[0]);
            PG8_WAIT_V(8); PG8_WAIT_L(0); PG8_BAR; PG8_MMA(1, 0, At, B0); PG8_MMA(1, 1, At, B1); PG8_BAR; PG8_SCHED;
            PG8_LDB(B0, 1, 0); PG8_LDB(B1, 1, 1); PG8_SCHED; PG8_LDA(At, 1, 0); PG8_STAGE(PG8_SA(0, 1), a2, ca[1]);
            PG8_WAIT_V(8); PG8_WAIT_L(0); PG8_BAR; PG8_MMA(0, 0, At, B0); PG8_MMA(0, 1, At, B1); PG8_BAR; PG8_SCHED;
            PG8_LDA(At, 1, 1); PG8_STAGE(PG8_SB(1, 0), b3, voffB); PG8_STAGE(PG8_SB(1, 1), b3 + hstep, voffB); PG8_STAGE(PG8_SA(1, 0), a3, ca[0]);
            PG8_WAIT_V(8); PG8_WAIT_L(0); PG8_BAR; PG8_MMA(1, 0, At, B0); PG8_MMA(1, 1, At, B1); PG8_BAR; PG8_SCHED;
        }
        if (wr == 0) PG8_BAR;
        { int tz = tid; asm volatile("" : "+v"(tz));
          const int l2 = tz & 63, w2 = __builtin_amdgcn_readfirstlane(tz >> 6); E(acc, cur, w2 >> 2, w2 & 3, l2 & 15, l2 >> 4); }
        if (!has_next) break;
#pragma unroll
        for (int a = 0; a < 2; ++a)
#pragma unroll
            for (int b = 0; b < 2; ++b)
#pragma unroll
                for (int m = 0; m < 4; ++m)
#pragma unroll
                    for (int n = 0; n < 2; ++n) acc[a][b][m][n] = (f32x4){0.f, 0.f, 0.f, 0.f};
        cur = nxt; cB = nB; ++ui;
        if (wr == 1) PG8_BAR;
    }
    PG8_WAIT_V(0);
    PG8_BAR;
#undef PG8_SA
#undef PG8_SB
#undef PG8_STAGE
#undef PG8_LDA
#undef PG8_LDB
#undef PG8_MMA
#undef PG8_WAIT_V
#undef PG8_WAIT_L
#undef PG8_BAR
#undef PG8_SCHED
}
}

#define XB_TMO      128
#define XB_XCNT(j)  (256  + 64 * (j))
#define XB_XSUB(j)  (1280 + 64 * (j))
#define XB_XGEN(j)  (2304 + 64 * (j))
#define XB_TOP      3328
#define XB_TOPGEN   3392
#define XCD_BAR_WORDS 3456
#define XB_SPIN_CAP (1u << 18)
__device__ __forceinline__ unsigned xb_ld(unsigned* p)              { return __hip_atomic_load(p, __ATOMIC_RELAXED, __HIP_MEMORY_SCOPE_AGENT); }
__device__ __forceinline__ unsigned xb_add(unsigned* p, unsigned v) { return __hip_atomic_fetch_add(p, v, __ATOMIC_RELAXED, __HIP_MEMORY_SCOPE_AGENT); }
__device__ __forceinline__ unsigned xb_xcc_id() { return (unsigned)__builtin_amdgcn_s_getreg((3 << 11) | 20) & 0xFu; }
#define XB_SPIN(cond, bar) do { unsigned _sp = 0; while (cond) { __builtin_amdgcn_s_sleep(1); \
    if ((++_sp & 255u) == 0u) { if (xb_ld(&(bar)[XB_TMO])) break; if (_sp > XB_SPIN_CAP) { atomicAdd(&(bar)[XB_TMO], 1u); break; } } } } while (0)
struct XcdBarrier { unsigned* bar; unsigned x; volatile LAS unsigned* st; };
__device__ __forceinline__ XcdBarrier xcd_barrier_post(unsigned* bar, volatile LAS unsigned* st) {
    XcdBarrier b; b.bar = bar; b.x = xb_xcc_id(); b.st = st;
    if (threadIdx.x == 0) (void)xb_add(&bar[XB_XCNT(b.x)], 1u);
    return b;
}
__device__ __forceinline__ void xcd_barrier_complete(unsigned* bar, unsigned x, unsigned& nloc, unsigned& nx) {
    const unsigned G = gridDim.x * gridDim.y * gridDim.z;
    unsigned sum, cnt, mine, sp = 0u;
    for (;;) {
        sum = 0u; cnt = 0u; mine = 0u;
#pragma unroll
        for (unsigned j = 0; j < 16; ++j) { const unsigned c = xb_ld(&bar[XB_XCNT(j)]); sum += c; cnt += (c > 0u) ? 1u : 0u; mine = (j == x) ? c : mine; }
        if (sum == G) break;
        __builtin_amdgcn_s_sleep(1);
        if ((++sp & 255u) == 0u) { if (xb_ld(&bar[XB_TMO])) break; if (sp > XB_SPIN_CAP) { atomicAdd(&bar[XB_TMO], 1u); break; } }
    }
    nloc = mine > 0u ? mine : 1u; nx = cnt > 0u ? cnt : 1u;
}
__device__ __forceinline__ void xcd_barrier(const XcdBarrier& b) {
    asm volatile("s_waitcnt vmcnt(0)" ::: "memory");
    __syncthreads();
    if (threadIdx.x == 0) {
        unsigned* bar = b.bar;
        __builtin_amdgcn_s_waitcnt(0);
        unsigned nloc = b.st[0], nx = b.st[1];
        if (nloc == 0u) { xcd_barrier_complete(bar, b.x, nloc, nx); b.st[0] = nloc; b.st[1] = nx; }
        const unsigned old = xb_add(&bar[XB_XSUB(b.x)], 1u);
        const unsigned gen = old / nloc;
        if (old + 1u == (gen + 1u) * nloc) {
            __builtin_amdgcn_fence(__ATOMIC_RELEASE, "agent");
            asm volatile("s_waitcnt vmcnt(0)" ::: "memory");
            const unsigned og = xb_add(&bar[XB_TOP], 1u);
            const unsigned tg = og / nx;
            if (og + 1u == (tg + 1u) * nx) xb_add(&bar[XB_TOPGEN], 1u);
            else XB_SPIN(xb_ld(&bar[XB_TOPGEN]) == tg, bar);
            __builtin_amdgcn_fence(__ATOMIC_ACQUIRE, "agent");
            xb_add(&bar[XB_XGEN(b.x)], 1u);
            asm volatile("s_waitcnt vmcnt(0)" ::: "memory");
        } else {
            XB_SPIN(xb_ld(&bar[XB_XGEN(b.x)]) == gen, bar);
            __builtin_amdgcn_fence(__ATOMIC_ACQUIRE, "agent");
            asm volatile("s_waitcnt vmcnt(0)" ::: "memory");
        }
    }
    __syncthreads();
}

struct Args {
    const float* in[21];
    float* out; unsigned char* ws;
    int ph_lo, ph_hi, flags, pad;
};
enum { I_X = 0, I_META, I_RELB, I_NMIX, I_WIN, I_BGATE, I_WAO, I_CONVW, I_CONVB, I_LNG, I_LNB, I_WCO, I_WOUT, I_NFFN, I_WR, I_BR, I_WUG, I_BUG, I_WD, I_BD, I_NFIN };

struct Frame {
    LAS unsigned char* lds;
    unsigned char* ws;
    int tid, lane, wave;
    int G, bid;
};
template <class T> __device__ __forceinline__ T* wsp(unsigned char* ws, size_t off) { return (T*)(ws + off); }

struct P0Desc { const float* src; bf16_t* dst; int ldn, ldk; };
__device__ __forceinline__ void p0_load(const P0Desc& d, f32x4 (&v)[16], int lane) {
    const float* p = d.src + (size_t)(lane >> 4) * d.ldn + (lane & 15) * 4;
#pragma unroll
    for (int i = 0; i < 16; ++i) v[i] = *(const f32x4*)(p + (size_t)(4 * i) * d.ldn);
}
__device__ __forceinline__ void p0_store(const P0Desc& d, const f32x4 (&v)[16], LAS float* scr, int lane) {
    const int n4 = (lane & 15) * 4, kr = lane >> 4;
#pragma unroll
    for (int i = 0; i < 16; ++i) { LAS float* p = scr + (4 * i + kr) * 65 + n4; p[0] = v[i][0]; p[1] = v[i][1]; p[2] = v[i][2]; p[3] = v[i][3]; }
    LDS_WAIT(); asm volatile("" ::: "memory");
    const int c = lane & 7;
#pragma unroll
    for (int j = 0; j < 8; ++j) { const int n = (lane >> 3) + 8 * j; const LAS float* s = scr + (8 * c) * 65 + n;
        u32x4 o; o.x = cvt_pk_bf16(s[0 * 65], s[1 * 65]); o.y = cvt_pk_bf16(s[2 * 65], s[3 * 65]); o.z = cvt_pk_bf16(s[4 * 65], s[5 * 65]); o.w = cvt_pk_bf16(s[6 * 65], s[7 * 65]);
        *(u32x4*)(d.dst + (size_t)n * d.ldk + 8 * c) = o; }
    LDS_WAIT(); asm volatile("" ::: "memory");
}
__device__ __forceinline__ void rms_row_to_bf16(const float* __restrict__ xrow, const float* __restrict__ g, bf16_t* __restrict__ orow, int lane) {
    const f32x4* xr = (const f32x4*)xrow + lane; const f32x4* gr = (const f32x4*)g + lane;
    f32x4 v[4]; float s = 0.f;
#pragma unroll
    for (int j = 0; j < 4; ++j) { v[j] = xr[64 * j]; s += (v[j].x * v[j].x + v[j].y * v[j].y) + (v[j].z * v[j].z + v[j].w * v[j].w); }
    const float r = 1.0f / sqrtf(wave_sum(s) * (1.f / DM) + EPS);
    unsigned long long* o8 = (unsigned long long*)orow + lane;
#pragma unroll
    for (int j = 0; j < 4; ++j) { const f32x4 gg = gr[64 * j];
        o8[64 * j] = (unsigned long long)cvt_pk_bf16(v[j].x * r * gg.x, v[j].y * r * gg.y) | ((unsigned long long)cvt_pk_bf16(v[j].z * r * gg.z, v[j].w * r * gg.w) << 32); }
}
__device__ __forceinline__ void p0_prologue(Frame& F, const Args& a, const int part) {
    LAS float* scr = (LAS float*)(F.lds + F.wave * 16896);
    const int gw = F.bid * NWAVES + F.wave, NGW = F.G * NWAVES;
    unsigned char* ws = F.ws;
    constexpr int T_IN = 81 * 16, T_AO = 16 * 8, T_CO = 16 * 8, T_OUT = 16 * 16, T_SMALL = T_IN + T_AO + T_CO + T_OUT;
    constexpr int T_UG = NE * 32 * 16, T_D = NE * 16 * 16, T_ALL = T_SMALL + T_UG + T_D;
    auto desc = [&](int it) -> P0Desc {
        int r = it; P0Desc d;
        if (r < T_IN) { const int g = r / 16, kb = r % 16; const int dr = g * 64; int sc;
            if (dr < WR_GLU) sc = dr;
            else if (dr < WR_GATE) { const int q = dr - WR_GLU, tile = q >> 8, hf = (q >> 7) & 1, w = q & 127; sc = SC_GLU + 512 * hf + 128 * tile + w; }
            else if (dr < WR_IK) sc = SC_GATE + (dr - WR_GATE);
            else sc = SC_IK + (dr - WR_IK);
            d.src = a.in[I_WIN] + (size_t)(kb * 64) * INCOLS + sc; d.ldn = INCOLS; d.dst = wsp<bf16_t>(ws, WS_WIN) + (size_t)dr * DM + kb * 64; d.ldk = DM; return d; }
        r -= T_IN;
        if (r < T_AO) { const int g = r / 8, kb = r % 8; d.src = a.in[I_WAO] + (size_t)(kb * 64) * DM + g * 64; d.ldn = DM; d.dst = wsp<bf16_t>(ws, WS_WAO) + (size_t)(g * 64) * AW + kb * 64; d.ldk = AW; return d; }
        r -= T_AO;
        if (r < T_CO) { const int g = r / 8, kb = r % 8; d.src = a.in[I_WCO] + (size_t)(kb * 64) * DM + g * 64; d.ldn = DM; d.dst = wsp<bf16_t>(ws, WS_WCO) + (size_t)(g * 64) * CC + kb * 64; d.ldk = CC; return d; }
        r -= T_CO;
        if (r < T_OUT) { const int g = r / 16, kb = r % 16; d.src = a.in[I_WOUT] + (size_t)(kb * 64) * DM + g * 64; d.ldn = DM; d.dst = wsp<bf16_t>(ws, WS_WOUT) + (size_t)(g * 64) * DM + kb * 64; d.ldk = DM; return d; }
        r -= T_OUT;
        if (r < T_UG) { const int e = r / 512, q = r % 512, g = q % 32, kb = q / 32; const int dr = g * 64, tile = dr >> 8, hf = (dr >> 7) & 1, w = dr & 127;
            d.src = a.in[I_WUG] + (size_t)e * DM * 2 * DFF + (size_t)(kb * 64) * (2 * DFF) + DFF * hf + 128 * tile + w; d.ldn = 2 * DFF;
            d.dst = wsp<bf16_t>(ws, WS_WUG) + (size_t)e * 2 * DFF * DM + (size_t)dr * DM + kb * 64; d.ldk = DM; return d; }
        r -= T_UG;
        { const int e = r / 256, q = r % 256, g = q % 16, kb = q / 16;
            d.src = a.in[I_WD] + (size_t)e * DFF * DM + (size_t)(kb * 64) * DM + g * 64; d.ldn = DM; d.dst = wsp<bf16_t>(ws, WS_WD) + (size_t)e * DM * DFF + (size_t)(g * 64) * DFF + kb * 64; d.ldk = DFF; return d; }
    };
    const int T_LO = part ? T_SMALL : 0, T_HI = part ? T_ALL : T_SMALL;
    if (T_LO + gw < T_HI) {
        f32x4 va[16], vb[16];
        P0Desc da = desc(T_LO + gw), db = da;
        p0_load(da, va, F.lane);
        for (int it = T_LO + gw; it < T_HI; it += 2 * NGW) {
            const int i1 = it + NGW, i2 = it + 2 * NGW;
            db = desc(i1 < T_HI ? i1 : it); p0_load(db, vb, F.lane);
            p0_store(da, va, scr, F.lane);
            da = desc(i2 < T_HI ? i2 : it); p0_load(da, va, F.lane);
            if (i1 < T_HI) p0_store(db, vb, scr, F.lane);
        }
    }
    if (part) return;
    { const int gt = F.bid * NTHREADS + F.tid;
      if (gt < 8 * DM / 2) { const int n = gt >> 9, k = (gt & 511) * 2; const float v0 = a.in[I_WIN][(size_t)k * INCOLS + SC_IW + n], v1 = a.in[I_WIN][(size_t)(k + 1) * INCOLS + SC_IW + n];
          *(unsigned*)(wsp<bf16_t>(ws, WS_WIN) + (size_t)(WR_IW + n) * DM + k) = cvt_pk_bf16(v0, v1); } }
    { const int gt = F.bid * NTHREADS + F.tid;
      if (gt < NE * DM / 2) { const int e = gt >> 9, d = (gt & 511) * 2; const float v0 = a.in[I_NFFN][d] * a.in[I_WR][(size_t)d * NE + e], v1 = a.in[I_NFFN][d + 1] * a.in[I_WR][(size_t)(d + 1) * NE + e];
          const unsigned hi = cvt_pk_bf16(v0, v1); const unsigned lo = cvt_pk_bf16(v0 - bflo(hi), v1 - bfhi(hi));
          *(unsigned*)(wsp<bf16_t>(ws, WS_WRT) + (size_t)e * DM + d) = hi; *(unsigned*)(wsp<bf16_t>(ws, WS_WRT) + (size_t)(NE + e) * DM + d) = lo; } }
    for (int m = gw; m < NTOK + NMETA; m += NGW) {
        if (m < NTOK) rms_row_to_bf16(a.in[I_X] + (size_t)m * DM, a.in[I_NMIX], wsp<bf16_t>(ws, WS_XN) + (size_t)m * DM, F.lane);
        else rms_row_to_bf16(a.in[I_META] + (size_t)(m - NTOK) * DM, a.in[I_NMIX], wsp<bf16_t>(ws, WS_XNM) + (size_t)(m - NTOK) * DM, F.lane);
    }
}

struct PlainSched {
    const char* ws; unsigned a_off, b_off; int K, nM, nN, nwg, G, c;
    __device__ __forceinline__ void init(const unsigned char* ws_, size_t a, size_t b, int M, int N, int K_, int G_, int c_) { ws = (const char*)ws_; a_off = (unsigned)a; b_off = (unsigned)b; K = K_; nM = M / 256; nN = N / 256; nwg = nM * nN; G = G_; c = c_; }
    __device__ __forceinline__ bool next(int i, pg8::Unit& u) const {
        const long L = (long)i * G + c; if (L >= nwg) return false;
        int wgid = (int)L; { const int q = nwg / 8, r = nwg % 8, xcd = wgid % 8, off = wgid / 8; wgid = (xcd < r ? xcd * (q + 1) : r * (q + 1) + (xcd - r) * q) + off; }
        const int nig = 8 * nN, gid = wgid / nig, fm = gid * 8, gsz = (nM - fm) < 8 ? (nM - fm) : 8;
        u.pm = fm + ((wgid % nig) % gsz); u.pn = (wgid % nig) / gsz; u.z = 0; return true;
    }
    __device__ __forceinline__ const char* a_base() const { return ws; }
    __device__ __forceinline__ void a_offs(const pg8::Unit& u, int tid, unsigned (&o)[2][2]) const {
        int R[2], C[2]; pg8::stage_rc(tid * 16, R[0], C[0]); pg8::stage_rc(tid * 16 + 8192, R[1], C[1]);
#pragma unroll
        for (int h = 0; h < 2; ++h)
#pragma unroll
            for (int i = 0; i < 2; ++i) o[h][i] = a_off + (unsigned)(((u.pm * 256 + h * 128 + R[i]) * K + C[i]) * 2);
    }
    __device__ __forceinline__ const char* b_base(const pg8::Unit& u) const { return ws + b_off + (size_t)u.pn * 256 * K * 2; }
};
struct MergeSched {
    const char* ws; int G, c;
    __device__ __forceinline__ bool next(int i, pg8::Unit& u) const {
        const int t = c + (i >> 1) * G;
        if (t >= 256) return false;
        u.pm = (t & 7) + 8 * (t >> 5); u.pn = (t >> 3) & 3; u.z = i & 1; return true;
    }
    __device__ __forceinline__ const char* a_base() const { return ws; }
    __device__ __forceinline__ void a_offs(const pg8::Unit& u, int tid, unsigned (&o)[2][2]) const {
        int R[2], C[2]; pg8::stage_rc(tid * 16, R[0], C[0]); pg8::stage_rc(tid * 16 + 8192, R[1], C[1]);
        const unsigned base = (unsigned)(u.z ? WS_CO : WS_AO);
#pragma unroll
        for (int h = 0; h < 2; ++h)
#pragma unroll
            for (int i = 0; i < 2; ++i) o[h][i] = base + (unsigned)(((u.pm * 256 + h * 128 + R[i]) * 512 + C[i]) * 2);
    }
    __device__ __forceinline__ const char* b_base(const pg8::Unit& u) const { return ws + (u.z ? WS_WCO : WS_WAO) + (size_t)u.pn * 256 * 512 * 2; }
};
struct MoeTables { const LAS int* cnt; const LAS int* tbase; };
template <int NC, bool GATHER>
struct MoeSched {
    const char* ws; MoeTables T; int G, c, total;
    __device__ __forceinline__ bool next(int i, pg8::Unit& u) const {
        const long L = (long)i * G + c; if (L >= total) return false;
        int wgid = (int)L; { const int q = total / 8, r = total % 8, xcd = wgid % 8, off = wgid / 8; wgid = (xcd < r ? xcd * (q + 1) : r * (q + 1) + (xcd - r) * q) + off; }
        int e = 0;
        for (int j = 1; j < NE; ++j) e += (wgid >= __builtin_amdgcn_readfirstlane(T.tbase[j]) * NC) ? 1 : 0;
        e = __builtin_amdgcn_readfirstlane(e);
        const int tb0 = __builtin_amdgcn_readfirstlane(T.tbase[e]), tb1 = __builtin_amdgcn_readfirstlane(T.tbase[e + 1]);
        const int loc = wgid - tb0 * NC, nt_e = tb1 - tb0;
        u.z = e;
        u.pn = loc % NC; u.pm = loc / NC;
        return true;
    }
    __device__ __forceinline__ const char* a_base() const { return ws; }
    __device__ __forceinline__ void a_offs(const pg8::Unit& u, int tid, unsigned (&o)[2][2]) const {
        int R[2], C[2]; pg8::stage_rc(tid * 16, R[0], C[0]); pg8::stage_rc(tid * 16 + 8192, R[1], C[1]);
        if (GATHER) {
            const int* list = (const int*)(ws + WS_LIST) + (size_t)u.z * NTOK; const int n = __builtin_amdgcn_readfirstlane(T.cnt[u.z]);
#pragma unroll
            for (int h = 0; h < 2; ++h)
#pragma unroll
                for (int i = 0; i < 2; ++i) { const int p = u.pm * 256 + h * 128 + R[i]; const int tok = list[p < n ? p : 0];
                    o[h][i] = (unsigned)WS_XN + (unsigned)((tok * DM + C[i]) * 2); }
        } else {
            const int row0 = (__builtin_amdgcn_readfirstlane(T.tbase[u.z]) + u.pm) * 256;
#pragma unroll
            for (int h = 0; h < 2; ++h)
#pragma unroll
                for (int i = 0; i < 2; ++i) o[h][i] = (unsigned)WS_ACT + (unsigned)(((row0 + h * 128 + R[i]) * DFF + C[i]) * 2);
        }
    }
    __device__ __forceinline__ const char* b_base(const pg8::Unit& u) const {
        if (GATHER) return ws + WS_WUG + ((size_t)u.z * 2 * DFF + (size_t)u.pn * 256) * DM * 2;
        else return ws + WS_WD + ((size_t)u.z * DM + (size_t)u.pn * 256) * DFF * 2;
    }
};

#define EPI_ROWS(ai, m) for (int ai = 0; ai < 2; ++ai) _Pragma("unroll") for (int m = 0; m < 4; ++m)
#define EPI_COLS(bj, n) for (int bj = 0; bj < 2; ++bj) _Pragma("unroll") for (int n = 0; n < 2; ++n)
__device__ __forceinline__ void st_bf16x4(bf16_t* p, f32x4 v) { u32x2 w; w.x = cvt_pk_bf16(v[0], v[1]); w.y = cvt_pk_bf16(v[2], v[3]); *(u32x2*)p = w; }
__device__ __forceinline__ void st_bf16x8(bf16_t* p, f32x4 a, f32x4 b) { u32x4 w; w.x = cvt_pk_bf16(a[0], a[1]); w.y = cvt_pk_bf16(a[2], a[3]); w.z = cvt_pk_bf16(b[0], b[1]); w.w = cvt_pk_bf16(b[2], b[3]); *(u32x4*)p = w; }

struct EpiInProj {
    unsigned char* ws; const float* bgate;
    __device__ __forceinline__ void operator()(const f32x4 (&acc)[2][2][4][2], const pg8::Unit& u, int wr, int wc, int fr, int fq) const {
        const int pn = u.pn, row0 = u.pm * 256 + wr * 64 + fr, col0 = wc * 32 + 8 * fq;
        const int bidx = u.pm >> 3;
        const int rowk0 = row0 + NMETA * (bidx + 1);
        if (pn < 2 || (pn >= 6 && pn < 8)) {
            bf16_t* O = wsp<bf16_t>(ws, pn < 2 ? WS_Q : WS_IQ); const int cb = (pn & 1) * 256; const float sc = pn < 2 ? QSCALE : 1.0f;
#pragma unroll
            EPI_ROWS(ai, m) { bf16_t* rp = O + (size_t)(row0 + ai * 128 + m * 16) * AW + cb + col0;
#pragma unroll
                for (int bj = 0; bj < 2; ++bj) st_bf16x8(rp + bj * 128, acc[ai][bj][m][0] * sc, acc[ai][bj][m][1] * sc); }
        } else if (pn < 4) {
            bf16_t* O = wsp<bf16_t>(ws, WS_KB); const int cb = (pn & 1) * 256;
#pragma unroll
            EPI_ROWS(ai, m) { bf16_t* rp = O + (size_t)(rowk0 + ai * 128 + m * 16) * AW + cb + col0;
#pragma unroll
                for (int bj = 0; bj < 2; ++bj) st_bf16x8(rp + bj * 128, acc[ai][bj][m][0], acc[ai][bj][m][1]); }
        } else if (pn < 6) {
            bf16_t* O = wsp<bf16_t>(ws, WS_VT) + (size_t)bidx * AW * TP; const int cb = (pn & 1) * 256;
            const int t0 = (row0 & (SEQ - 1)) + NMETA + VOFF;
#pragma unroll
            EPI_ROWS(ai, m) { const int t = t0 + ai * 128 + m * 16;
#pragma unroll
                EPI_COLS(bj, n) { const f32x4 v = acc[ai][bj][m][n]; bf16_t* cp = O + (size_t)(cb + col0 + bj * 128 + n * 4) * TP + (t & ~1);
                    const float p0 = __shfl_xor(v[0], 1), p1 = __shfl_xor(v[1], 1), p2 = __shfl_xor(v[2], 1), p3 = __shfl_xor(v[3], 1);
                    if ((fr & 1) == 0) { *(unsigned*)(cp) = cvt_pk_bf16(v[0], p0); *(unsigned*)(cp + TP) = cvt_pk_bf16(v[1], p1); }
                    else { *(unsigned*)(cp + 2 * TP) = cvt_pk_bf16(p2, v[2]); *(unsigned*)(cp + 3 * TP) = cvt_pk_bf16(p3, v[3]); } } }
        } else if (pn < 12) {
            bf16_t* O = wsp<bf16_t>(ws, WS_GLU); const int cb = (pn - 8) * 128;
#pragma unroll
            EPI_ROWS(ai, m) { bf16_t* rp = O + (size_t)(rowk0 + ai * 128 + m * 16) * CC + cb + col0;
                f32x4 y[2];
#pragma unroll
                for (int n = 0; n < 2; ++n) { const f32x4 av = acc[ai][0][m][n], gv = acc[ai][1][m][n];
                    y[n] = cat2(lo2(av) * rcp1pexp2_2(lo2(gv), -LOG2E), hi2(av) * rcp1pexp2_2(hi2(gv), -LOG2E)); }
                st_bf16x8(rp, y[0], y[1]); }
        } else {
            const int gt = pn - 12; bf16_t* O = wsp<bf16_t>(ws, gt < 4 ? WS_GA : WS_GB); const int cb = (gt & 3) * 256; const float* bp = bgate + gt * 256 + col0;
            f32x4 bv[2][2];
#pragma unroll
            EPI_COLS(bj, n) bv[bj][n] = *(const f32x4*)(bp + bj * 128 + n * 4);
#pragma unroll
            EPI_ROWS(ai, m) { bf16_t* rp = O + (size_t)(row0 + ai * 128 + m * 16) * DM + cb + col0;
#pragma unroll
                for (int bj = 0; bj < 2; ++bj) { f32x4 y[2];
#pragma unroll
                    for (int n = 0; n < 2; ++n) { const f32x4 x = acc[ai][bj][m][n] + bv[bj][n]; y[n] = cat2(rcp1pexp2_2(lo2(x), -LOG2E), rcp1pexp2_2(hi2(x), -LOG2E)); }
                    st_bf16x8(rp + bj * 128, y[0], y[1]); } }
        }
    }
};
struct EpiMerge {
    unsigned char* ws;
    __device__ __forceinline__ void operator()(const f32x4 (&acc)[2][2][4][2], const pg8::Unit& u, int wr, int wc, int fr, int fq) const {
        const int row0 = u.pm * 256 + wr * 64 + fr, col0 = u.pn * 256 + wc * 32 + 8 * fq;
        const bf16_t* Gt = wsp<bf16_t>(ws, u.z ? WS_GB : WS_GA); bf16_t* O = wsp<bf16_t>(ws, WS_MG);
#pragma unroll
        for (int ai = 0; ai < 2; ++ai) {
            u32x4 g[4][2], p[4][2];
#pragma unroll
            for (int m = 0; m < 4; ++m)
#pragma unroll
                for (int bj = 0; bj < 2; ++bj) { const size_t o = (size_t)(row0 + ai * 128 + m * 16) * DM + col0 + bj * 128; g[m][bj] = *(const u32x4*)(Gt + o); p[m][bj] = u.z ? *(const u32x4*)(O + o) : (u32x4){0u, 0u, 0u, 0u}; }
#pragma unroll
            for (int m = 0; m < 4; ++m)
#pragma unroll
                for (int bj = 0; bj < 2; ++bj) { const size_t o = (size_t)(row0 + ai * 128 + m * 16) * DM + col0 + bj * 128; const u32x4 gg = g[m][bj], pp = p[m][bj]; const f32x4 a0 = acc[ai][bj][m][0], a1 = acc[ai][bj][m][1];
                    const f32x4 y0 = (f32x4){bflo(gg.x) * a0[0] + bflo(pp.x), bfhi(gg.x) * a0[1] + bfhi(pp.x), bflo(gg.y) * a0[2] + bflo(pp.y), bfhi(gg.y) * a0[3] + bfhi(pp.y)};
                    const f32x4 y1 = (f32x4){bflo(gg.z) * a1[0] + bflo(pp.z), bfhi(gg.z) * a1[1] + bfhi(pp.z), bflo(gg.w) * a1[2] + bflo(pp.w), bfhi(gg.w) * a1[3] + bfhi(pp.w)};
                    st_bf16x8(O + o, y0, y1); }
        }
    }
};
struct EpiResid {
    const float* x; float* out;
    __device__ __forceinline__ void operator()(const f32x4 (&acc)[2][2][4][2], const pg8::Unit& u, int wr, int wc, int fr, int fq) const {
        const int row0 = u.pm * 256 + wr * 64 + fr, col0 = u.pn * 256 + wc * 32 + 8 * fq;
#pragma unroll
        for (int ai = 0; ai < 2; ++ai)
#pragma unroll
            for (int mh = 0; mh < 2; ++mh) {
                f32x4 xv[2][2][2];
#pragma unroll
                for (int mm = 0; mm < 2; ++mm)
#pragma unroll
                    EPI_COLS(bj, n) xv[mm][bj][n] = *(const f32x4*)(x + (size_t)(row0 + ai * 128 + (2 * mh + mm) * 16) * DM + col0 + bj * 128 + n * 4);
#pragma unroll
                for (int mm = 0; mm < 2; ++mm)
#pragma unroll
                    EPI_COLS(bj, n) *(f32x4*)(out + (size_t)(row0 + ai * 128 + (2 * mh + mm) * 16) * DM + col0 + bj * 128 + n * 4) = xv[mm][bj][n] + acc[ai][bj][2 * mh + mm][n];
            }
    }
};
struct EpiSwiglu {
    unsigned char* ws; const float* bug; MoeTables T;
    __device__ __forceinline__ void operator()(const f32x4 (&acc)[2][2][4][2], const pg8::Unit& u, int wr, int wc, int fr, int fq) const {
        const int e = u.z, n_e = __builtin_amdgcn_readfirstlane(T.cnt[e]), rloc0 = u.pm * 256 + wr * 64 + fr, row0 = __builtin_amdgcn_readfirstlane(T.tbase[e]) * 256 + rloc0, col0 = u.pn * 128 + wc * 32 + 8 * fq;
        const float* bp = bug + (size_t)e * 2 * DFF + col0; bf16_t* O = wsp<bf16_t>(ws, WS_ACT); const float* rg = wsp<float>(ws, WS_RG) + (size_t)e * NTOK;
        f32x4 bg[2], bu[2];
#pragma unroll
        for (int n = 0; n < 2; ++n) { bg[n] = *(const f32x4*)(bp + n * 4); bu[n] = *(const f32x4*)(bp + DFF + n * 4) + 1.0f; }
        float rvs[2][4];
#pragma unroll
        EPI_ROWS(ai, m) { const int rl = rloc0 + ai * 128 + m * 16; rvs[ai][m] = rg[rl < n_e ? rl : 0]; }
        bf16_t* const sink = wsp<bf16_t>(ws, WS_DUMMY) + col0;
#pragma unroll
        EPI_ROWS(ai, m) { const int rl = rloc0 + ai * 128 + m * 16; bf16_t* rp = (rl < n_e) ? O + (size_t)(row0 + ai * 128 + m * 16) * DFF + col0 : sink; const float rv = rvs[ai][m];
                f32x4 y[2];
#pragma unroll
                for (int n = 0; n < 2; ++n) { const f32x2_t rv2 = {rv, rv}; f32x2_t yh[2];
#pragma unroll
                    for (int hh = 0; hh < 2; ++hh) { const f32x4 ag = acc[ai][0][m][n], au = acc[ai][1][m][n];
                        f32x2_t g = (hh ? hi2(ag) : lo2(ag)) * rv2 + (hh ? hi2(bg[n]) : lo2(bg[n])), u1 = (hh ? hi2(au) : lo2(au)) * rv2 + (hh ? hi2(bu[n]) : lo2(bu[n]));
                        g.x = fminf(g.x, 7.0f); g.y = fminf(g.y, 7.0f); u1.x = __builtin_amdgcn_fmed3f(u1.x, -6.0f, 8.0f); u1.y = __builtin_amdgcn_fmed3f(u1.y, -6.0f, 8.0f);
                        yh[hh] = (u1 * g) * rcp1pexp2_2(g, -1.702f * LOG2E); }
                    y[n] = cat2(yh[0], yh[1]); }
                st_bf16x8(rp, y[0], y[1]); }
    }
};
struct EpiDown {
    unsigned char* ws; const float* bd; MoeTables T;
    __device__ __forceinline__ void operator()(const f32x4 (&acc)[2][2][4][2], const pg8::Unit& u, int wr, int wc, int fr, int fq) const {
        const int e = u.z, n_e = __builtin_amdgcn_readfirstlane(T.cnt[e]), rloc0 = u.pm * 256 + wr * 64 + fr, row0 = __builtin_amdgcn_readfirstlane(T.tbase[e]) * 256 + rloc0, col0 = u.pn * 256 + wc * 32 + 8 * fq;
        const float* bp = bd + (size_t)e * DM + col0; bf16_t* O = wsp<bf16_t>(ws, WS_YP); const float* lg = wsp<float>(ws, WS_LG) + (size_t)e * NTOK;
        f32x4 bv[2][2];
#pragma unroll
        EPI_COLS(bj, n) bv[bj][n] = *(const f32x4*)(bp + bj * 128 + n * 4);
        float gts[2][4];
#pragma unroll
        EPI_ROWS(ai, m) { const int rl = rloc0 + ai * 128 + m * 16; gts[ai][m] = lg[rl < n_e ? rl : 0]; }
        bf16_t* const sink = wsp<bf16_t>(ws, WS_DUMMY) + col0;
#pragma unroll
        EPI_ROWS(ai, m) { const int rl = rloc0 + ai * 128 + m * 16; const float gt = gts[ai][m]; bf16_t* rp = (rl < n_e) ? O + (size_t)(row0 + ai * 128 + m * 16) * DM + col0 : sink;
#pragma unroll
                for (int bj = 0; bj < 2; ++bj) st_bf16x8(rp + bj * 128, (acc[ai][bj][m][0] + bv[bj][0]) * gt, (acc[ai][bj][m][1] + bv[bj][1]) * gt); }
    }
};

constexpr int IKBLK = 65;
__device__ __forceinline__ size_t ikf_off(int b, int p, int dim) { return ((((size_t)(b * IKBLK + (p >> 5)) * 4 + (dim >> 4)) * 64 + (((dim >> 3) & 1) * 32 + (p & 31))) * 8 + (dim & 7)); }
template <int NT>
__device__ __forceinline__ void wave_mm16(const bf16_t* __restrict__ A, int lda, const bf16_t* const (&Bt)[NT], int K, int lane, f32x4 (&acc)[NT]) {
    const bf16_t* ap = A + (size_t)(lane & 15) * lda + 8 * (lane >> 4);
    const bf16_t* bp[NT];
#pragma unroll
    for (int t = 0; t < NT; ++t) { bp[t] = Bt[t] + (size_t)(lane & 15) * K + 8 * (lane >> 4); acc[t] = (f32x4){0.f, 0.f, 0.f, 0.f}; }
#pragma unroll (NT == 1 ? 16 : 8)
    for (int k0 = 0; k0 < K; k0 += 32) {
        const bf16x8 a = *(const bf16x8*)(ap + k0);
#pragma unroll
        for (int t = 0; t < NT; ++t) { const bf16x8 b = *(const bf16x8*)(bp[t] + k0); acc[t] = __builtin_amdgcn_mfma_f32_16x16x32_bf16(b, a, acc[t], 0, 0, 0); }
    }
}
__device__ __forceinline__ void p1_thin(Frame& F, int dbgflags) {
    unsigned char* ws = F.ws;
    const bf16_t* WIN = wsp<bf16_t>(ws, WS_WIN); const bf16_t* XN = wsp<bf16_t>(ws, WS_XN); const bf16_t* XNM = wsp<bf16_t>(ws, WS_XNM);
    bf16_t* KB = wsp<bf16_t>(ws, WS_KB); bf16_t* VT = wsp<bf16_t>(ws, WS_VT); bf16_t* IK = wsp<bf16_t>(ws, WS_IK); bf16_t* GLU = wsp<bf16_t>(ws, WS_GLU); float* IW = wsp<float>(ws, WS_IW);
    const int gw = F.bid * NWAVES + F.wave, NGW = F.G * NWAVES, lane = F.lane, tk = lane & 15, nq = lane >> 4;
    {
        constexpr int WBP = 2064;
        LAS unsigned char* lds = F.lds;
        __syncthreads();
        { const unsigned char* src = (const unsigned char*)(WIN + (size_t)WR_IK * DM);
          for (int p = F.tid; p < 72 * 128; p += NTHREADS) { const int row = p >> 7, c16 = p & 127; *(LAS u32x4*)(lds + row * WBP + c16 * 16) = *(const u32x4*)(src + (size_t)row * DM * 2 + c16 * 16); } }
        __syncthreads();
        const int tg = F.wave & 3, hf = F.wave >> 2, kq = nq;
        for (int tb = F.bid; tb < NTOK / 64; tb += F.G) {
            const int m = tb * 64 + 16 * tg + tk, rowk = m + NMETA * ((m >> 11) + 1);
            const bf16_t* xr = XN + (size_t)m * DM + 16 * kq;
            bf16x8 xa[16], xb[16];
#pragma unroll
            for (int sblk = 0; sblk < 16; ++sblk) { xa[sblk] = *(const bf16x8*)(xr + 64 * sblk); xb[sblk] = *(const bf16x8*)(xr + 64 * sblk + 8); }
            const LAS unsigned char* wb = lds + tk * WBP + 32 * kq;
            if (hf == 0) {
                f32x4 acc[3] = {{0.f, 0.f, 0.f, 0.f}, {0.f, 0.f, 0.f, 0.f}, {0.f, 0.f, 0.f, 0.f}};
#pragma unroll
                for (int sblk = 0; sblk < 16; ++sblk)
#pragma unroll
                    for (int t = 0; t < 3; ++t) { const bf16x8 b0 = *(const LAS bf16x8*)(wb + 16 * t * WBP + 128 * sblk), b1 = *(const LAS bf16x8*)(wb + 16 * t * WBP + 128 * sblk + 16);
                        acc[t] = __builtin_amdgcn_mfma_f32_16x16x32_bf16(b0, xa[sblk], acc[t], 0, 0, 0); acc[t] = __builtin_amdgcn_mfma_f32_16x16x32_bf16(b1, xb[sblk], acc[t], 0, 0, 0); }
#pragma unroll
                for (int t = 0; t < 3; ++t) st_bf16x4(IK + ikf_off(m >> 11, NMETA + (m & (SEQ - 1)), 16 * t + 4 * nq), acc[t]);
            } else {
                f32x4 acc[2] = {{0.f, 0.f, 0.f, 0.f}, {0.f, 0.f, 0.f, 0.f}};
#pragma unroll
                for (int sblk = 0; sblk < 16; ++sblk)
#pragma unroll
                    for (int t = 0; t < 2; ++t) { const bf16x8 b0 = *(const LAS bf16x8*)(wb + 16 * (3 + t) * WBP + 128 * sblk), b1 = *(const LAS bf16x8*)(wb + 16 * (3 + t) * WBP + 128 * sblk + 16);
                        acc[t] = __builtin_amdgcn_mfma_f32_16x16x32_bf16(b0, xa[sblk], acc[t], 0, 0, 0); acc[t] = __builtin_amdgcn_mfma_f32_16x16x32_bf16(b1, xb[sblk], acc[t], 0, 0, 0); }
                st_bf16x4(IK + ikf_off(m >> 11, NMETA + (m & (SEQ - 1)), 48 + 4 * nq), acc[0]);
                if (nq < 2) *(f32x4*)(IW + (size_t)m * 8 + 4 * nq) = acc[1];
            }
        }
        __syncthreads();
    }
    if (!(dbgflags & 256)) for (int task = gw; task < 100; task += NGW) {
        if (task < 32) {
            const bf16_t* const Bt[1] = {WIN + (size_t)(SC_K + 16 * task) * DM}; f32x4 acc[1]; wave_mm16<1>(XNM, DM, Bt, DM, lane, acc);
            for (int b = 0; b < NB; ++b) st_bf16x4(KB + (size_t)(b * TT + tk) * AW + 16 * task + 4 * nq, acc[0]);
        } else if (task < 64) {
            const int t = task - 32; const bf16_t* const Bt[1] = {WIN + (size_t)(SC_V + 16 * t) * DM}; f32x4 acc[1]; wave_mm16<1>(XNM, DM, Bt, DM, lane, acc);
            const float p0 = __shfl_xor(acc[0][0], 1), p1 = __shfl_xor(acc[0][1], 1), p2 = __shfl_xor(acc[0][2], 1), p3 = __shfl_xor(acc[0][3], 1);
            const unsigned wa = (tk & 1) ? cvt_pk_bf16(p2, acc[0][2]) : cvt_pk_bf16(acc[0][0], p0), wb = (tk & 1) ? cvt_pk_bf16(p3, acc[0][3]) : cvt_pk_bf16(acc[0][1], p1);
            for (int b = 0; b < NB; ++b) { bf16_t* cp = VT + ((size_t)b * AW + 16 * t + 4 * nq + 2 * (tk & 1)) * TP + VOFF + (tk & ~1);
                *(unsigned*)cp = wa; *(unsigned*)(cp + TP) = wb; }
        } else if (task < 68) {
            const int t = task - 64; const bf16_t* const Bt[1] = {WIN + (size_t)(WR_IK + 16 * t) * DM}; f32x4 acc[1]; wave_mm16<1>(XNM, DM, Bt, DM, lane, acc);
            for (int b = 0; b < NB; ++b) st_bf16x4(IK + ikf_off(b, tk, 16 * t + 4 * nq), acc[0]);
        } else {
            const int c16 = task - 68; const int ar = WR_GLU + 256 * (c16 >> 3) + 16 * (c16 & 7);
            const bf16_t* const Bt[2] = {WIN + (size_t)ar * DM, WIN + (size_t)(ar + 128) * DM}; f32x4 acc[2]; wave_mm16<2>(XNM, DM, Bt, DM, lane, acc);
            f32x4 y;
#pragma unroll
            for (int j = 0; j < 4; ++j) y[j] = acc[0][j] * sigmoidf_(acc[1][j]);
            for (int b = 0; b < NB; ++b) st_bf16x4(GLU + (size_t)(b * TT + tk) * CC + 16 * c16 + 4 * nq, y);
        }
    }
}

__device__ __forceinline__ void p2_conv(Frame& F, const Args& a) {
    unsigned char* ws = F.ws;
    LAS unsigned char* xs = F.lds;
    LAS float* wl = (LAS float*)(F.lds + 63488);
    const bf16_t* GLU = wsp<bf16_t>(ws, WS_GLU); bf16_t* CO = wsp<bf16_t>(ws, WS_CO);
    const float* cw = a.in[I_CONVW];
    for (int idx = F.tid; idx < CW * 128; idx += NTHREADS) { const int tap = idx >> 7, c4 = idx & 127; const f32x4 v = *(const f32x4*)(cw + tap * CC + 4 * c4); *(LAS f32x4*)(wl + tap * 512 + (c4 & 1) * 256 + (c4 >> 1) * 4) = v; }
    const int lane = F.lane, c0 = 8 * lane;
    for (int tile = F.bid; tile < NTOK / 32; tile += F.G) {
        const int b = tile >> 6, s0 = (tile & 63) * 32, p0 = NMETA + s0;
        __syncthreads();
        for (int idx = F.tid; idx < 62 * 64; idx += NTHREADS) { const int r = idx >> 6, ch = idx & 63, p = p0 - 30 + r; u32x4 v = (u32x4){0u, 0u, 0u, 0u};
            if (p >= 0) v = *(const u32x4*)(GLU + (size_t)(b * TT + p) * CC + ch * 8);
            *(LAS u32x4*)(xs + r * 1024 + ch * 16) = v; }
        __syncthreads();
        const int i0 = 4 * F.wave;
        float acc[4][8];
#pragma unroll
        for (int t = 0; t < 4; ++t)
#pragma unroll
            for (int i = 0; i < 8; ++i) acc[t][i] = 0.f;
        const LAS float* wlb = wl + lane * 4; asm volatile("" : "+v"(wlb));
        const LAS unsigned char* xsb = xs + i0 * 1024 + lane * 16; asm volatile("" : "+v"(xsb));
#pragma unroll 1
        for (int tap = 0; tap < CW; ++tap) {
            const f32x4 w0 = *(const LAS f32x4*)(wlb + tap * 512), w1 = *(const LAS f32x4*)(wlb + tap * 512 + 256);
#pragma unroll
            for (int t = 0; t < 4; ++t) {
                const u32x4 xv = *(const LAS u32x4*)(xsb + (tap + t) * 1024);
                acc[t][0] += w0[0] * bflo(xv.x); acc[t][1] += w0[1] * bfhi(xv.x); acc[t][2] += w0[2] * bflo(xv.y); acc[t][3] += w0[3] * bfhi(xv.y);
                acc[t][4] += w1[0] * bflo(xv.z); acc[t][5] += w1[1] * bfhi(xv.z); acc[t][6] += w1[2] * bflo(xv.w); acc[t][7] += w1[3] * bfhi(xv.w);
            }
        }
        float cb[8], lg[8], lb[8];
        { const f32x4* p0 = (const f32x4*)(a.in[I_CONVB] + c0); const f32x4* p1 = (const f32x4*)(a.in[I_LNG] + c0); const f32x4* p2 = (const f32x4*)(a.in[I_LNB] + c0);
#pragma unroll
          for (int hh = 0; hh < 2; ++hh) { const f32x4 u0 = p0[hh], u1 = p1[hh], u2 = p2[hh];
#pragma unroll
              for (int i = 0; i < 4; ++i) { cb[4 * hh + i] = u0[i]; lg[4 * hh + i] = u1[i]; lb[4 * hh + i] = u2[i]; } } }
#pragma unroll
        for (int t = 0; t < 4; ++t) {
            float s = 0.f;
#pragma unroll
            for (int i = 0; i < 8; ++i) { acc[t][i] += cb[i]; s += acc[t][i]; }
            const float mean = wave_sum(s) * (1.f / CC); float q = 0.f;
#pragma unroll
            for (int i = 0; i < 8; ++i) { acc[t][i] -= mean; q += acc[t][i] * acc[t][i]; }
            const float rstd = 1.0f / sqrtf(wave_sum(q) * (1.f / CC) + EPS);
            float y[8];
#pragma unroll
            for (int i = 0; i < 8; ++i) { const float z = acc[t][i] * rstd * lg[i] + lb[i]; y[i] = z * sigmoidf_(z); }
            u32x4 o; o.x = cvt_pk_bf16(y[0], y[1]); o.y = cvt_pk_bf16(y[2], y[3]); o.z = cvt_pk_bf16(y[4], y[5]); o.w = cvt_pk_bf16(y[6], y[7]);
            *(u32x4*)(CO + (size_t)(b * SEQ + s0 + i0 + t) * CC + c0) = o;
        }
    }
    __syncthreads();
}

constexpr int ROWP = 2080, NJ = 33;
__device__ __forceinline__ unsigned f2ord(float f) { const unsigned b = __float_as_uint(f); return b ^ ((b >> 31) ? 0xffffffffu : 0x80000000u); }
__device__ __forceinline__ int wave_isum(int v) {
#pragma unroll
    for (int o = 1; o < 64; o <<= 1) v += __shfl_xor(v, o);
    return v;
}
__device__ __forceinline__ int wave_isum_dpp(int v) {
    v += __builtin_amdgcn_update_dpp(0, v, 0xB1, 0xF, 0xF, false);
    v += __builtin_amdgcn_update_dpp(0, v, 0x4E, 0xF, 0xF, false);
    v += __builtin_amdgcn_update_dpp(0, v, 0x141, 0xF, 0xF, false);
    v += __builtin_amdgcn_update_dpp(0, v, 0x140, 0xF, 0xF, false);
    return __builtin_amdgcn_readlane(v, 0) + __builtin_amdgcn_readlane(v, 16) + __builtin_amdgcn_readlane(v, 32) + __builtin_amdgcn_readlane(v, 48);
}
__device__ __forceinline__ void p2_indexer_unit(Frame& F, int b, int q16, int flags) {
    unsigned char* ws = F.ws;
    const bf16_t* IQ = wsp<bf16_t>(ws, WS_IQ); const bf16_t* IK = wsp<bf16_t>(ws, WS_IK); const float* IW = wsp<float>(ws, WS_IW); unsigned* MASK = wsp<unsigned>(ws, WS_MASK);
    LAS unsigned* SU = (LAS unsigned*)F.lds;
    const int lane = F.lane, c = lane & 31, hi = lane >> 5, w = F.wave;
    const int nwblk = (q16 >> 1) + 2;
    if (!(flags & 4)) {
        const int tok0 = b * SEQ + 16 * q16;
        bf16x8 af[4][4]; f32x4 wq[4][4];
#pragma unroll
        for (int g = 0; g < 4; ++g) {
            const bf16_t* ap = IQ + (size_t)(tok0 + 4 * g + (c >> 3)) * AW + (c & 7) * IDXD + 8 * hi;
#pragma unroll
            for (int ks = 0; ks < 4; ++ks) af[g][ks] = *(const bf16x8*)(ap + 16 * ks);
#pragma unroll
            for (int q = 0; q < 4; ++q) wq[g][q] = *(const f32x4*)(IW + (size_t)(tok0 + 4 * g + q) * 8 + 4 * hi);
        }
        const int rel0 = NMETA + 16 * q16 + 2 * hi - c;
        const bf16_t* kp = IK + (size_t)b * IKBLK * 2048 + lane * 8;
        LAS unsigned* srow = SU + (2 * hi) * ROWP + c;
        bf16x8 bfr[4], bnx[4];
#pragma unroll
        for (int ks = 0; ks < 4; ++ks) { bfr[ks] = *(const bf16x8*)(kp + (size_t)(w < nwblk ? w : 0) * 2048 + 512 * ks); bnx[ks] = bfr[ks]; }
#pragma unroll
        for (int g = 0; g < 4; ++g) asm volatile("" :: "v"(af[g][0]), "v"(af[g][1]), "v"(af[g][2]), "v"(af[g][3]), "v"(wq[g][0]), "v"(wq[g][1]), "v"(wq[g][2]), "v"(wq[g][3]));
        asm volatile("" :: "v"(bfr[0]), "v"(bfr[1]), "v"(bfr[2]), "v"(bfr[3]));
        for (int blk = w; blk < nwblk; blk += 8) {
            {
                const int bn_ = blk + 8 < nwblk ? blk + 8 : blk;
#pragma unroll
                for (int ks = 0; ks < 4; ++ks) bnx[ks] = *(const bf16x8*)(kp + (size_t)bn_ * 2048 + 512 * ks); }
#pragma unroll
            for (int g = 0; g < 4; ++g) {
                f32x16 acc = {};
#pragma unroll
                for (int ks = 0; ks < 4; ++ks) acc = __builtin_amdgcn_mfma_f32_32x32x16_bf16(af[g][ks], bfr[ks], acc, 0, 0, 0);
                float part[4];
#pragma unroll
                for (int q = 0; q < 4; ++q) { float s = wq[g][q][0] * __builtin_amdgcn_fmed3f(acc[4 * q], 0.f, INFINITY);
#pragma unroll
                    for (int i = 1; i < 4; ++i) s = __builtin_fmaf(wq[g][q][i], __builtin_amdgcn_fmed3f(acc[4 * q + i], 0.f, INFINITY), s);
                    part[q] = s; }
#pragma unroll
                for (int p = 0; p < 2; ++p) {
                    const auto rr = __builtin_amdgcn_permlane32_swap(__float_as_uint(part[p]), __float_as_uint(part[p + 2]), false, false);
                    const float sc = __uint_as_float(rr[0]) + __uint_as_float(rr[1]);
                    srow[(4 * g + p) * ROWP + 32 * blk] = (32 * blk <= rel0 + 4 * g + p) ? f2ord(sc) : 0u; }
            }
#pragma unroll
            for (int ks = 0; ks < 4; ++ks) bfr[ks] = bnx[ks];
        }
    }
    __syncthreads();
    if (!(flags & 8)) {
        const int nj = (nwblk + 1) >> 1, klim = 32 * nwblk;
        unsigned U[NJ][2];
#pragma unroll
        for (int j = 0; j < NJ; ++j) {
            if (j < nj) { const int key = 64 * j + lane;
#pragma unroll
                for (int p = 0; p < 2; ++p) U[j][p] = (key < klim) ? SU[(2 * w + p) * ROWP + key] : 0u; }
            else { U[j][0] = 0u; U[j][1] = 0u; }
        }
        const int tokb = b * SEQ + 16 * q16 + 2 * w;
        unsigned lo[2], hb[2], thr[2], veq[2]; int chi[2], need[2]; bool done[2];
#pragma unroll
        for (int p = 0; p < 2; ++p) { lo[p] = 1u; hb[p] = 0xffffffffu; chi[p] = 0; need[p] = 0; veq[p] = 0u; thr[p] = 1u; done[p] = (NMETA + 16 * q16 + 2 * w + p + 1 <= TOPK); }
        for (int it = 0; it < 34; ++it) {
            if (done[0] && done[1]) break;
            unsigned mid[2]; int cl[2];
#pragma unroll
            for (int p = 0; p < 2; ++p) { mid[p] = lo[p] + ((hb[p] - lo[p]) >> 1); cl[p] = 0; }
#pragma unroll
            for (int g = 0; g < 3; ++g) if (11 * g < nj) {
#pragma unroll
                for (int jj = 0; jj < 11; ++jj)
#pragma unroll
                    for (int p = 0; p < 2; ++p) cl[p] += (U[11 * g + jj][p] >= mid[p]) ? 1 : 0; }
            const int tot = wave_isum_dpp(cl[0] | (cl[1] << 16));
            int cnt[2] = {tot & 0xffff, tot >> 16};
#ifdef DBG_CHECK_DPP
            if (wave_isum(cl[0]) != cnt[0] || wave_isum(cl[1]) != cnt[1]) __hip_atomic_store(wsp<unsigned>(ws, WS_CTL) + 3, 1u, RLX_AGENT);
#endif
#pragma unroll
            for (int p = 0; p < 2; ++p) {
                const int ct = cnt[p];
                if (!done[p]) {
                    if (ct == TOPK) { done[p] = true; thr[p] = mid[p]; need[p] = 0; }
                    else if (ct > TOPK) lo[p] = mid[p];
                    else { hb[p] = mid[p]; chi[p] = ct; }
                    if (!done[p] && hb[p] - lo[p] == 1u) { done[p] = true; thr[p] = hb[p]; veq[p] = lo[p]; need[p] = TOPK - chi[p]; }
                }
            }
        }
#pragma unroll
        for (int p = 0; p < 2; ++p) {
            int run = 0, wlo = 0, whi = 0;
#ifdef DBG_CHECK_SEL
            int selcnt = 0;
#endif
            const bool tied = need[p] > 0;
#pragma unroll
            for (int j = 0; j < NJ; ++j) if (j < nj) {
                const unsigned u = U[j][p];
                bool take = (u >= thr[p]);
                if (tied) {
                    const bool eq = (u == veq[p]);
                    const unsigned long long em = __ballot(eq);
                    const int rank = run + (int)__builtin_amdgcn_mbcnt_hi((unsigned)(em >> 32), __builtin_amdgcn_mbcnt_lo((unsigned)em, 0u));
                    take = take || (eq && rank < need[p]);
                    run += __popcll(em);
                }
                const unsigned long long sm = __ballot(take);
                wlo = (lane == j) ? (int)(unsigned)sm : wlo; whi = (lane == j) ? (int)(unsigned)(sm >> 32) : whi;
#ifdef DBG_CHECK_SEL
                selcnt += __popcll(sm);
#endif
            }
            unsigned long long* mrow = (unsigned long long*)(MASK + (size_t)(tokb + p) * MSTR);
            if (lane < nj) mrow[lane] = ((unsigned long long)(unsigned)whi << 32) | (unsigned)wlo;
#ifdef DBG_CHECK_SEL
            { const int nv = NMETA + 16 * q16 + 2 * w + p + 1; if (selcnt != (nv < TOPK ? nv : TOPK)) __hip_atomic_store(wsp<unsigned>(ws, WS_CTL) + 3, 1u, RLX_AGENT); }
#endif
        }
    }
    __syncthreads();
}
__device__ __forceinline__ void p2_indexer(Frame& F, int flags, int half) {
    for (int i = F.bid; i < 256; i += F.G) { const int b = i >> 5, j = 2 * (i & 31);
        if (half == 0) { p2_indexer_unit(F, b, j, flags); p2_indexer_unit(F, b, 127 - j, flags); }
        else { p2_indexer_unit(F, b, j + 1, flags); p2_indexer_unit(F, b, 126 - j, flags); } }
}

__device__ const unsigned char T5B[128] = {0, 1, 2, 3, 4, 5, 6, 7, 8, 9, 10, 11, 12, 13, 14, 15, 16, 16, 16, 17, 17, 18, 18, 18, 19, 19, 19, 20, 20, 20, 20, 21, 21, 21, 21, 22, 22, 22, 22, 22, 23, 23, 23, 23, 23, 23, 24, 24, 24, 24, 24, 24, 25, 25, 25, 25, 25, 25, 25, 26, 26, 26, 26, 26, 26, 26, 26, 27, 27, 27, 27, 27, 27, 27, 27, 27, 27, 28, 28, 28, 28, 28, 28, 28, 28, 28, 28, 29, 29, 29, 29, 29, 29, 29, 29, 29, 29, 29, 29, 30, 30, 30, 30, 30, 30, 30, 30, 30, 30, 30, 30, 30, 30, 31, 31, 31, 31, 31, 31, 31, 31, 31, 31, 31, 31, 31, 31, 31};
constexpr int TBS = 132;
__device__ __forceinline__ int crow(int r, int hi) { return (r & 3) + 8 * (r >> 2) + 4 * hi; }
constexpr int KPITCH = 144, VPITCH = 136;
constexpr int AT_K = 0, AT_V = AT_K + 2 * 64 * KPITCH, AT_TB = AT_V + 2 * 64 * VPITCH, AT_SC = AT_TB + NH * TBS * 4, AT_END = AT_SC + NWAVES * 128;
static_assert(AT_END <= RING_BYTES, "attention LDS map");
__device__ __forceinline__ void p3_attn_unit(Frame& F, int b, int h, int Q) {
    unsigned char* ws = F.ws;
    const bf16_t* Qm = wsp<bf16_t>(ws, WS_Q); const bf16_t* KB = wsp<bf16_t>(ws, WS_KB); const bf16_t* VT = wsp<bf16_t>(ws, WS_VT); const unsigned* MASK = wsp<unsigned>(ws, WS_MASK); bf16_t* AO = wsp<bf16_t>(ws, WS_AO);
    LAS unsigned char* lds = F.lds;
    const LAS float* tbh = (const LAS float*)(lds + AT_TB) + h * TBS;
    LAS float* sc = (LAS float*)(lds + AT_SC) + F.wave * 32;
    const int tid = F.tid, lane = F.lane, c = lane & 31, hi = lane >> 5, w = F.wave;
    const int qb32 = 8 * Q + w, tokq = b * SEQ + 32 * qb32 + c, posq = NMETA + 32 * qb32 + c;
    const int ktmax = (47 + 32 * qb32) >> 6, NT = 4 * Q + 5;
    bf16x8 qf[4];
#pragma unroll
    for (int ks = 0; ks < 4; ++ks) qf[ks] = *(const bf16x8*)(Qm + (size_t)tokq * AW + h * HD + 16 * ks + 8 * hi);
    const unsigned long long* mrow = (const unsigned long long*)(MASK + (size_t)tokq * MSTR);
    const int srow = tid >> 3, piece = tid & 7;
    const bf16_t* kg = KB + (size_t)(b * TT + srow) * AW + h * HD + piece * 8;
    const bf16_t* vg = VT + ((size_t)b * AW + h * HD + srow) * TP + piece * 8;
    LAS unsigned char* kl = lds + AT_K + srow * KPITCH + piece * 16;
    LAS unsigned char* vl = lds + AT_V + srow * VPITCH + piece * 16;
    const LAS unsigned char* kfb = lds + AT_K + c * KPITCH + 16 * hi;
    const LAS unsigned char* vfb = lds + AT_V + c * VPITCH + 8 * hi;
    const unsigned NEGB = 0xff800000u;
    const float bfar = tbh[128];
    float m_abs = 0.f; bool has = false;
    f32x16 O0 = {}, O1 = {}, LS = {}, CI;
#pragma unroll
    for (int r = 0; r < 16; ++r) CI[r] = bfar;
    const bf16x8 ones = __builtin_bit_cast(bf16x8, ((u32x4){0x3f803f80u, 0x3f803f80u, 0x3f803f80u, 0x3f803f80u}));
    u32x4 kr = *(const u32x4*)kg, vr = *(const u32x4*)vg;
    unsigned long long mwn = mrow[0];
    *(LAS u32x4*)kl = kr; *(LAS u32x2*)vl = (u32x2){vr.x, vr.y}; *(LAS u32x2*)(vl + 8) = (u32x2){vr.z, vr.w};
    __syncthreads();
    for (int kt = 0; kt < NT; ++kt) {
        const int buf = kt & 1;
        const unsigned long long mw = mwn;
        if (kt + 1 < NT) { kr = *(const u32x4*)(kg + (size_t)(kt + 1) * 64 * AW); vr = *(const u32x4*)(vg + (kt + 1) * 64); if (kt + 1 <= ktmax) mwn = mrow[kt + 1]; }
        if (kt <= ktmax) {
            const LAS unsigned char* kp = kfb + buf * 64 * KPITCH;
            f32x16 S0 = CI, S1 = CI;
#pragma unroll
            for (int ks = 0; ks < 4; ++ks) {
                const bf16x8 k0 = *(const LAS bf16x8*)(kp + ks * 32), k1 = *(const LAS bf16x8*)(kp + 32 * KPITCH + ks * 32);
                S0 = __builtin_amdgcn_mfma_f32_32x32x16_bf16(k0, qf[ks], S0, 0, 0, 0);
                S1 = __builtin_amdgcn_mfma_f32_32x32x16_bf16(k1, qf[ks], S1, 0, 0, 0);
            }
            const int mw0 = (int)((unsigned)mw >> (4 * hi)), mw1 = (int)((unsigned)(mw >> 32) >> (4 * hi));
            const bool far = (256 * Q + 32 * w - 64 * kt) >= 175;
            if (!far) {
                const int d0 = posq - 64 * kt - 4 * hi;
#pragma unroll
                for (int r = 0; r < 16; ++r) { const int ko = (r & 3) + 8 * (r >> 2);
                    int da = d0 - ko, db = d0 - 32 - ko; da = da < 0 ? 0 : (da > 128 ? 128 : da); db = db < 0 ? 0 : (db > 128 ? 128 : db);
                    S0[r] += tbh[da] - bfar; S1[r] += tbh[db] - bfar; }
            }
            float tmax = -INFINITY;
#pragma unroll
            for (int r = 0; r < 16; ++r) { const int ko = (r & 3) + 8 * (r >> 2);
                const unsigned t0 = (unsigned)__builtin_amdgcn_sbfe(mw0, ko, 1), t1 = (unsigned)__builtin_amdgcn_sbfe(mw1, ko, 1);
                S0[r] = __uint_as_float((__float_as_uint(S0[r]) & t0) | (NEGB & ~t0)); S1[r] = __uint_as_float((__float_as_uint(S1[r]) & t1) | (NEGB & ~t1));
                tmax = fmaxf(tmax, fmaxf(S0[r], S1[r])); }
            tmax = fmaxf(tmax, __shfl_xor(tmax, 32));
            if (__any(tmax > 8.0f || (!has && tmax > -INFINITY))) {
                const bool upd = tmax > -INFINITY && (!has || tmax > 0.f);
                const float dl = upd ? tmax : 0.f;
                const float alpha = has ? __builtin_amdgcn_exp2f(-dl) : 1.0f;
                m_abs += dl; has = has || upd;
#pragma unroll
                for (int r = 0; r < 16; ++r) { S0[r] -= dl; S1[r] -= dl; CI[r] = bfar - m_abs; }
                if (hi == 0) sc[c] = alpha;
                LDS_WAIT(); asm volatile("" ::: "memory");
#pragma unroll
                for (int r = 0; r < 16; ++r) { const float f = sc[crow(r, hi)]; O0[r] *= f; O1[r] *= f; LS[r] *= f; }
                LDS_WAIT(); asm volatile("" ::: "memory");
            }
#pragma unroll
            for (int r = 0; r < 16; ++r) { S0[r] = __builtin_amdgcn_exp2f(S0[r]); S1[r] = __builtin_amdgcn_exp2f(S1[r]); }
            const LAS unsigned char* vp = vfb + buf * 64 * VPITCH;
#pragma unroll
            for (int s2 = 0; s2 < 4; ++s2) {
                u32x4 pw;
                if (s2 < 2) { const int o = 8 * (s2 & 1); pw.x = cvt_pk_bf16(S0[o + 0], S0[o + 1]); pw.y = cvt_pk_bf16(S0[o + 2], S0[o + 3]); pw.z = cvt_pk_bf16(S0[o + 4], S0[o + 5]); pw.w = cvt_pk_bf16(S0[o + 6], S0[o + 7]); }
                else { const int o = 8 * (s2 & 1); pw.x = cvt_pk_bf16(S1[o + 0], S1[o + 1]); pw.y = cvt_pk_bf16(S1[o + 2], S1[o + 3]); pw.z = cvt_pk_bf16(S1[o + 4], S1[o + 5]); pw.w = cvt_pk_bf16(S1[o + 6], S1[o + 7]); }
                const bf16x8 pf = __builtin_bit_cast(bf16x8, pw);
                const u32x2 a0 = *(const LAS u32x2*)(vp + s2 * 32), a1 = *(const LAS u32x2*)(vp + s2 * 32 + 16);
                const u32x2 b0 = *(const LAS u32x2*)(vp + 32 * VPITCH + s2 * 32), b1 = *(const LAS u32x2*)(vp + 32 * VPITCH + s2 * 32 + 16);
                const bf16x8 v0 = __builtin_bit_cast(bf16x8, ((u32x4){a0.x, a0.y, a1.x, a1.y})), v1 = __builtin_bit_cast(bf16x8, ((u32x4){b0.x, b0.y, b1.x, b1.y}));
                O0 = __builtin_amdgcn_mfma_f32_32x32x16_bf16(pf, v0, O0, 0, 0, 0);
                O1 = __builtin_amdgcn_mfma_f32_32x32x16_bf16(pf, v1, O1, 0, 0, 0);
                LS = __builtin_amdgcn_mfma_f32_32x32x16_bf16(pf, ones, LS, 0, 0, 0);
            }
        }
        if (kt + 1 < NT) { LAS unsigned char* k2 = kl + (buf ^ 1) * 64 * KPITCH; LAS unsigned char* v2 = vl + (buf ^ 1) * 64 * VPITCH;
            *(LAS u32x4*)k2 = kr; *(LAS u32x2*)v2 = (u32x2){vr.x, vr.y}; *(LAS u32x2*)(v2 + 8) = (u32x2){vr.z, vr.w}; }
        __syncthreads();
    }
    bf16_t* ob = AO + (size_t)(b * SEQ + 32 * qb32) * AW + h * HD + c;
#pragma unroll
    for (int r = 0; r < 16; ++r) { const int qr = crow(r, hi); const float f = __builtin_amdgcn_rcpf(LS[r]);
        const float a0 = O0[r] * f, a1 = O1[r] * f, b0 = __shfl_xor(a0, 1), b1 = __shfl_xor(a1, 1);
        if ((c & 1) == 0) { *(unsigned*)(ob + (size_t)qr * AW) = cvt_pk_bf16(a0, b0); *(unsigned*)(ob + (size_t)qr * AW + 32) = cvt_pk_bf16(a1, b1); } }
}
__device__ __forceinline__ void p3_attn(Frame& F, const Args& a) {
    LAS float* tb = (LAS float*)(F.lds + AT_TB);
    __syncthreads();
    for (int idx = F.tid; idx < NH * 129; idx += NTHREADS) { const int h = idx / 129, d = idx % 129; const int bk = d < 128 ? (int)T5B[d] : 31; tb[h * TBS + d] = a.in[I_RELB][bk * NH + h] * LOG2E; }
    __syncthreads();
    for (int i = F.bid; i < 256; i += F.G) { const int bh = i >> 2, j = i & 3; p3_attn_unit(F, bh >> 3, bh & 7, j); p3_attn_unit(F, bh >> 3, bh & 7, 7 - j); }
    __syncthreads();
}

constexpr int WLP = 2064;
constexpr int P6_WHI = 0, P6_WLO = NE * WLP, P6_PART = 2 * NE * WLP, P6_SSP = P6_PART + 2 * 64 * 33 * 4, P6_CNT = P6_SSP + 2 * 64 * 4, P6_END = P6_CNT + 256;
static_assert(P6_END <= LDSX_OFF, "router LDS map");
__device__ __forceinline__ void p6_router(Frame& F, const Args& a) {
    unsigned char* ws = F.ws;
    const float* H1 = wsp<float>(ws, WS_H1); bf16_t* HN = wsp<bf16_t>(ws, WS_XN);
    const float* gf = a.in[I_NFFN]; const float* brt = a.in[I_BR];
    int* TE = wsp<int>(ws, WS_TE); int* TPs = wsp<int>(ws, WS_TP); int* LIST = wsp<int>(ws, WS_LIST); float* LG = wsp<float>(ws, WS_LG); float* RG = wsp<float>(ws, WS_RG);
    unsigned* ecnt = wsp<unsigned>(ws, WS_CTL) + CW_ECNT;
    LAS unsigned char* lds = F.lds;
    LAS float* part = (LAS float*)(lds + P6_PART);
    LAS float* ssp = (LAS float*)(lds + P6_SSP);
    LAS int* lcnt = (LAS int*)(lds + P6_CNT);
    LAS int* lbase = lcnt + 32;
    const int lane = F.lane, w = F.wave, tk = lane & 15, kq = lane >> 4;
    __syncthreads();
    { const unsigned char* src = ws + WS_WRT;
      for (int p = F.tid; p < 2 * NE * 128; p += NTHREADS) { const int arr = p >> 12, row = (p >> 7) & 31, c16 = p & 127;
          *(LAS u32x4*)(lds + arr * (NE * WLP) + row * WLP + c16 * 16) = *(const u32x4*)(src + (size_t)arr * NE * DM * 2 + (size_t)row * DM * 2 + c16 * 16); } }
    for (int tb = F.bid; tb < NTOK / 64; tb += F.G) {
        const int t0 = tb * 64;
        __syncthreads();
        if (F.tid < 32) lcnt[F.tid] = 0;
        {
            const int tg = w & 3, kh = w >> 2, tok = t0 + 16 * tg + tk;
            const float* xr = H1 + (size_t)tok * DM + 512 * kh + 8 * kq; const float* gr = gf + 512 * kh + 8 * kq;
            bf16_t* hr = HN + (size_t)tok * DM + 512 * kh + 8 * kq;
            const LAS unsigned char* wl = lds + tk * WLP + (512 * kh + 8 * kq) * 2;
            f32x4 xa[16], xb[16];
#pragma unroll
            for (int ks = 0; ks < 16; ++ks) { xa[ks] = *(const f32x4*)(xr + 32 * ks); xb[ks] = *(const f32x4*)(xr + 32 * ks + 4); }
            f32x4 acc0 = {0.f, 0.f, 0.f, 0.f}, acc1 = acc0; float ss = 0.f;
#pragma unroll
            for (int ks = 0; ks < 16; ++ks) {
                const f32x4 g0 = *(const f32x4*)(gr + 32 * ks), g1 = *(const f32x4*)(gr + 32 * ks + 4);
                const f32x4 x0 = xa[ks], x1 = xb[ks];
                u32x4 hn; hn.x = cvt_pk_bf16(x0[0] * g0[0], x0[1] * g0[1]); hn.y = cvt_pk_bf16(x0[2] * g0[2], x0[3] * g0[3]); hn.z = cvt_pk_bf16(x1[0] * g1[0], x1[1] * g1[1]); hn.w = cvt_pk_bf16(x1[2] * g1[2], x1[3] * g1[3]);
                *(u32x4*)(hr + 32 * ks) = hn;
                ss += (x0[0] * x0[0] + x0[1] * x0[1]) + (x0[2] * x0[2] + x0[3] * x0[3]) + (x1[0] * x1[0] + x1[1] * x1[1]) + (x1[2] * x1[2] + x1[3] * x1[3]);
                u32x4 xh; xh.x = cvt_pk_bf16(x0[0], x0[1]); xh.y = cvt_pk_bf16(x0[2], x0[3]); xh.z = cvt_pk_bf16(x1[0], x1[1]); xh.w = cvt_pk_bf16(x1[2], x1[3]);
                u32x4 xl; xl.x = cvt_pk_bf16(x0[0] - bflo(xh.x), x0[1] - bfhi(xh.x)); xl.y = cvt_pk_bf16(x0[2] - bflo(xh.y), x0[3] - bfhi(xh.y));
                          xl.z = cvt_pk_bf16(x1[0] - bflo(xh.z), x1[1] - bfhi(xh.z)); xl.w = cvt_pk_bf16(x1[2] - bflo(xh.w), x1[3] - bfhi(xh.w));
                const bf16x8 fxh = __builtin_bit_cast(bf16x8, xh), fxl = __builtin_bit_cast(bf16x8, xl);
                const bf16x8 wh0 = *(const LAS bf16x8*)(wl + P6_WHI + ks * 64), wh1 = *(const LAS bf16x8*)(wl + P6_WHI + 16 * WLP + ks * 64);
                const bf16x8 wl0 = *(const LAS bf16x8*)(wl + P6_WLO + ks * 64), wl1 = *(const LAS bf16x8*)(wl + P6_WLO + 16 * WLP + ks * 64);
                acc0 = __builtin_amdgcn_mfma_f32_16x16x32_bf16(wh0, fxh, acc0, 0, 0, 0); acc1 = __builtin_amdgcn_mfma_f32_16x16x32_bf16(wh1, fxh, acc1, 0, 0, 0);
                acc0 = __builtin_amdgcn_mfma_f32_16x16x32_bf16(wl0, fxh, acc0, 0, 0, 0); acc1 = __builtin_amdgcn_mfma_f32_16x16x32_bf16(wl1, fxh, acc1, 0, 0, 0);
                acc0 = __builtin_amdgcn_mfma_f32_16x16x32_bf16(wh0, fxl, acc0, 0, 0, 0); acc1 = __builtin_amdgcn_mfma_f32_16x16x32_bf16(wh1, fxl, acc1, 0, 0, 0);
            }
            ss += __shfl_xor(ss, 16); ss += __shfl_xor(ss, 32);
            LAS float* pp = part + ((kh * 64) + 16 * tg + tk) * 33 + 4 * kq;
#pragma unroll
            for (int r = 0; r < 4; ++r) { pp[r] = acc0[r]; pp[16 + r] = acc1[r]; }
            if (kq == 0) ssp[kh * 64 + 16 * tg + tk] = ss;
        }
        __syncthreads();
        if (w == 0) {
            const float rinv = 1.0f / sqrtf((ssp[lane] + ssp[64 + lane]) * (1.f / DM) + EPS);
            float lg[NE];
#pragma unroll
            for (int e = 0; e < NE; ++e) lg[e] = (part[lane * 33 + e] + part[(64 + lane) * 33 + e]) * rinv + brt[e];
            int sel[4]; float val[4];
#pragma unroll
            for (int j = 0; j < 4; ++j) { float best = -INFINITY; int bi = 0;
#pragma unroll
                for (int e = 0; e < NE; ++e) { const bool tk_ = lg[e] > best; best = tk_ ? lg[e] : best; bi = tk_ ? e : bi; }
                sel[j] = bi; val[j] = best;
#pragma unroll
                for (int e = 0; e < NE; ++e) lg[e] = (e == bi) ? -INFINITY : lg[e]; }
            float den = 0.f, ex[4];
#pragma unroll
            for (int j = 0; j < 4; ++j) { ex[j] = __expf(val[j] - val[0]); den += ex[j]; }
            int slot[4];
#pragma unroll
            for (int j = 0; j < 4; ++j) slot[j] = __hip_atomic_fetch_add(&lcnt[sel[j]], 1, __ATOMIC_RELAXED, __HIP_MEMORY_SCOPE_WORKGROUP);
            LDS_WAIT();
            if (lane < 32) { const int n = lcnt[lane]; lbase[lane] = n ? (int)__hip_atomic_fetch_add(ecnt + 64 * lane, (unsigned)n, RLX_AGENT) : 0; }
            LDS_WAIT(); asm volatile("" ::: "memory");
            const int t = t0 + lane;
#pragma unroll
            for (int j = 0; j < 4; ++j) { const int e = sel[j], pos = lbase[e] + slot[j]; const float g = ex[j] / den;
                TE[t * 4 + j] = e; TPs[t * 4 + j] = pos; LIST[(size_t)e * NTOK + pos] = t; LG[(size_t)e * NTOK + pos] = g; RG[(size_t)e * NTOK + pos] = rinv; }
        }
    }
    __syncthreads();
}
__device__ __forceinline__ void moe_tables(Frame& F, LAS int* cnt, LAS int* tbase) {
    const unsigned* ecnt = wsp<unsigned>(F.ws, WS_CTL) + CW_ECNT;
    __syncthreads();
    if (F.tid < NE) cnt[F.tid] = (int)__hip_atomic_load(ecnt + 64 * F.tid, RLX_AGENT);
    __syncthreads();
    if (F.tid == 0) { int s = 0; for (int e = 0; e < NE; ++e) { tbase[e] = s; s += (cnt[e] + 255) >> 8; } tbase[NE] = s; }
    __syncthreads();
}

__device__ __forceinline__ void p9_final(Frame& F, const Args& a, const LAS int* tbase) {
    unsigned char* ws = F.ws;
    const float* H1 = wsp<float>(ws, WS_H1); float* OUT = a.out; const bf16_t* YP = wsp<bf16_t>(ws, WS_YP); const int* TE = wsp<int>(ws, WS_TE); const int* TPs = wsp<int>(ws, WS_TP); const float* gf = a.in[I_NFIN];
    const int gw = F.bid * NWAVES + F.wave, NGW = F.G * NWAVES, lane = F.lane;
    const f32x4* gr = (const f32x4*)gf + lane;
    f32x4 gg[4];
#pragma unroll
    for (int j = 0; j < 4; ++j) gg[j] = gr[64 * j];
#ifdef DBG_CHECK_DPP
    if (__hip_atomic_load(wsp<unsigned>(ws, WS_CTL) + 3, RLX_AGENT) != 0u) { const float qn = __builtin_nanf("");
#pragma unroll
        for (int j = 0; j < 4; ++j) gg[j] = (f32x4){qn, qn, qn, qn}; }
#endif
    for (int base = 0; base < NTOK; base += 8 * NGW) {
        int myrow = 0;
        { const int i = lane >> 2, j = lane & 3, t = base + gw + NGW * i; if (lane < 32 && t < NTOK) { const int e = TE[t * 4 + j], pos = TPs[t * 4 + j]; myrow = tbase[e] * 256 + pos; } }
        f32x4 va[4], vb[4]; u32x2 ya[4][4], yb[4][4];
#define P9_LOAD(i, V, Y) do { const int t_ = base + gw + NGW * (i); if (t_ < NTOK) { const f32x4* xr_ = (const f32x4*)(H1 + (size_t)t_ * DM) + lane; \
            _Pragma("unroll") for (int j_ = 0; j_ < 4; ++j_) V[j_] = xr_[64 * j_]; \
            _Pragma("unroll") for (int q_ = 0; q_ < 4; ++q_) { const int row_ = __builtin_amdgcn_readlane(myrow, 4 * (i) + q_); const u32x2* yr_ = (const u32x2*)(YP + (size_t)row_ * DM) + lane; \
                _Pragma("unroll") for (int j_ = 0; j_ < 4; ++j_) Y[q_][j_] = yr_[64 * j_]; } } } while (0)
#define P9_PROC(i, V, Y) do { const int t_ = base + gw + NGW * (i); if (t_ < NTOK) { \
            _Pragma("unroll") for (int q_ = 0; q_ < 4; ++q_) _Pragma("unroll") for (int j_ = 0; j_ < 4; ++j_) { const u32x2 y_ = Y[q_][j_]; V[j_].x += bflo(y_.x); V[j_].y += bfhi(y_.x); V[j_].z += bflo(y_.y); V[j_].w += bfhi(y_.y); } \
            float s_ = 0.f; _Pragma("unroll") for (int j_ = 0; j_ < 4; ++j_) s_ += (V[j_].x * V[j_].x + V[j_].y * V[j_].y) + (V[j_].z * V[j_].z + V[j_].w * V[j_].w); \
            const float r_ = 1.0f / sqrtf(wave_sum(s_) * (1.f / DM) + EPS); f32x4* xo_ = (f32x4*)(OUT + (size_t)t_ * DM) + lane; \
            _Pragma("unroll") for (int j_ = 0; j_ < 4; ++j_) xo_[64 * j_] = (f32x4){V[j_].x * r_ * gg[j_].x, V[j_].y * r_ * gg[j_].y, V[j_].z * r_ * gg[j_].z, V[j_].w * r_ * gg[j_].w}; } } while (0)
        P9_LOAD(0, va, ya);
#pragma unroll
        for (int i = 0; i < 8; i += 2) {
            P9_LOAD(i + 1, vb, yb);
            P9_PROC(i, va, ya);
            if (i + 2 < 8) P9_LOAD(i + 2, va, ya);
            P9_PROC(i + 1, vb, yb);
        }
#undef P9_LOAD
#undef P9_PROC
    }
}

constexpr int N_PHASES = 10;
__global__ void __launch_bounds__(NTHREADS, 2) fwd_kernel(Args args) {
    extern __shared__ __attribute__((aligned(16))) unsigned char lds_raw[];
    Frame F;
    F.lds = (LAS unsigned char*)lds_raw; F.ws = args.ws;
    F.tid = threadIdx.x; F.lane = F.tid & 63; F.wave = __builtin_amdgcn_readfirstlane(F.tid >> 6);
    F.G = gridDim.x; F.bid = blockIdx.x;
    volatile LAS unsigned* MISC = (volatile LAS unsigned*)(F.lds + MISC_OFF);
    if (F.tid < 32) MISC[F.tid] = 0u;
    __syncthreads();
    unsigned* ctl = wsp<unsigned>(args.ws, WS_CTL);
    const int lo = args.ph_lo, hi = args.ph_hi;
    const bool multi = (hi - lo) > 1;
    XcdBarrier bar; bar.bar = ctl + CW_BAR; bar.x = 0; bar.st = nullptr;
    if (multi) bar = xcd_barrier_post(ctl + CW_BAR, MISC + 8);
#ifndef PHASE_MASK
#define PHASE_MASK 0x3ff
#endif
#define IN(k) (((PHASE_MASK >> (k)) & 1) && lo <= (k) && (k) < hi)
#define SEAM(k) do { if (IN(k) && IN((k) + 1)) xcd_barrier(bar); } while (0)
    LAS int* l_cnt = (LAS int*)(F.lds + LDSX_OFF); LAS int* l_tbase = l_cnt + 64;
    const MoeTables MT{l_cnt, l_tbase};

    if (IN(0)) { p0_prologue(F, args, 0); } SEAM(0);
    if (IN(1)) {
        PlainSched S; S.init(args.ws, WS_XN, WS_WIN, NTOK, 5120, DM, F.G, F.bid);
        EpiInProj E{args.ws, args.in[I_BGATE]};
        if (!(args.flags & 64)) pg8::gemm_phase<EpiInProj, PlainSched>(F.lds, DM, S, E);
        if (!(args.flags & 128)) p1_thin(F, args.flags);
    } SEAM(1);
    if (IN(2)) {
        const int cvt_slot = (F.bid >> 3) % 3;
        if (cvt_slot == 0 && !(args.flags & 1024)) { p0_prologue(F, args, 1); __syncthreads(); }
        if (!(args.flags & 1)) p2_conv(F, args);
        if (!(args.flags & 2)) p2_indexer(F, args.flags, 0);
        if (cvt_slot == 1 && !(args.flags & 1024)) { __syncthreads(); p0_prologue(F, args, 1); __syncthreads(); }
        if (!(args.flags & 2)) p2_indexer(F, args.flags, 1);
        if (cvt_slot == 2 && !(args.flags & 1024)) { __syncthreads(); p0_prologue(F, args, 1); }
    } SEAM(2);
    if (IN(3)) { p3_attn(F, args); } SEAM(3);
    if (IN(4)) {
        MergeSched S{(const char*)args.ws, F.G, F.bid}; EpiMerge E{args.ws};
        pg8::gemm_phase<EpiMerge, MergeSched>(F.lds, 512, S, E);
    } SEAM(4);
    if (IN(5)) {
        PlainSched S; S.init(args.ws, WS_MG, WS_WOUT, NTOK, DM, DM, F.G, F.bid);
        EpiResid E{args.in[I_X], wsp<float>(args.ws, WS_H1)};
        pg8::gemm_phase<EpiResid, PlainSched>(F.lds, DM, S, E);
    } SEAM(5);
    if (IN(6)) { p6_router(F, args); } SEAM(6);
    if (IN(7)) {
        moe_tables(F, l_cnt, l_tbase);
        MoeSched<8, true> S{(const char*)args.ws, MT, F.G, F.bid, l_tbase[NE] * 8};
        EpiSwiglu E{args.ws, args.in[I_BUG], MT};
        pg8::gemm_phase<EpiSwiglu, MoeSched<8, true>>(F.lds, DM, S, E);
    } SEAM(7);
    if (IN(8)) {
        moe_tables(F, l_cnt, l_tbase);
        MoeSched<4, false> S{(const char*)args.ws, MT, F.G, F.bid, l_tbase[NE] * 4};
        EpiDown E{args.ws, args.in[I_BD], MT};
        pg8::gemm_phase<EpiDown, MoeSched<4, false>>(F.lds, DFF, S, E);
    } SEAM(8);
    if (IN(9)) { moe_tables(F, l_cnt, l_tbase); p9_final(F, args, l_tbase); }
#undef IN
#undef SEAM
}

#ifdef DBG_HASH_OFF
__global__ void dbg_hash(const unsigned* __restrict__ buf, size_t nwords, unsigned* acc) {
    unsigned h = 0u;
    for (size_t i = (size_t)blockIdx.x * blockDim.x + threadIdx.x; i < nwords; i += (size_t)gridDim.x * blockDim.x) h += (buf[i] ^ (unsigned)(i * 2654435761u)) * 2246822519u + (unsigned)i;
#pragma unroll
    for (int o = 1; o < 64; o <<= 1) h += __shfl_xor(h, o);
    if ((threadIdx.x & 63) == 0) atomicAdd(acc, h);
}
__global__ void dbg_fill(float* out, size_t n, const unsigned* acc) {
    const unsigned h = *acc; const float v = (float)((h >> 7) & 0xffffu) * (1.0f / 4096.0f) + 1.0f;
    for (size_t i = (size_t)blockIdx.x * blockDim.x + threadIdx.x; i < n; i += (size_t)gridDim.x * blockDim.x) out[i] = v;
}
#endif

extern "C" void kernel_launch(void* const* d_in, const int* in_sizes, int n_in, void* d_out, int out_size, void* d_ws, size_t ws_size, hipStream_t stream) {
    static int grid = 0;
    if (grid == 0) {
        if (n_in != 21 || out_size != NTOK * DM || ws_size < WS_END) { fprintf(stderr, "kernel_launch: unexpected shapes (n_in %d, out %d, ws %zu < %zu)\n", n_in, out_size, ws_size, (size_t)WS_END); grid = -1; return; }
        int dev = 0, cus = 0, per_cu = 0;
        if (hipGetDevice(&dev) != hipSuccess || hipDeviceGetAttribute(&cus, hipDeviceAttributeMultiprocessorCount, dev) != hipSuccess) { grid = -1; return; }
        if (hipFuncSetAttribute((const void*)fwd_kernel, hipFuncAttributeMaxDynamicSharedMemorySize, LDS_BYTES) != hipSuccess) { fprintf(stderr, "kernel_launch: hipFuncSetAttribute failed\n"); grid = -1; return; }
        if (hipOccupancyMaxActiveBlocksPerMultiprocessor(&per_cu, (const void*)fwd_kernel, NTHREADS, LDS_BYTES) != hipSuccess || per_cu < 1) { fprintf(stderr, "kernel_launch: occupancy query says %d\n", per_cu); }
        (void)hipGetLastError();
        grid = cus;
    }
    if (grid < 0) return;
    (void)hipMemsetAsync((char*)d_ws + WS_CTL, 0, CTL_ZERO_BYTES, stream);
    Args a{};
    for (int i = 0; i < 21; ++i) a.in[i] = (const float*)d_in[i];
    a.out = (float*)d_out; a.ws = (unsigned char*)d_ws;
#if MK_N_LAUNCHES == 1
    a.ph_lo = 0; a.ph_hi = N_PHASES;
    hipLaunchKernelGGL(fwd_kernel, dim3(grid), dim3(NTHREADS), LDS_BYTES, stream, a);
#else
#ifndef DBG_LAST_PHASE
#define DBG_LAST_PHASE (N_PHASES - 1)
#endif
#ifndef DBG_DUP_MASK
#define DBG_DUP_MASK 0
#endif
#ifndef DBG_DUP_FLAGS
#define DBG_DUP_FLAGS 0
#endif
    for (int p = 0; p <= DBG_LAST_PHASE; ++p) { a.ph_lo = p; a.ph_hi = p + 1;
        const int nrep = ((DBG_DUP_MASK >> p) & 1) ? 2 : 1;
        for (int rep = 0; rep < nrep; ++rep) { a.flags = (nrep == 2 && rep == 0) ? DBG_DUP_FLAGS : 0; if (rep == 1 && p == 6) (void)hipMemsetAsync((char*)d_ws + WS_CTL, 0, CTL_ZERO_BYTES, stream);
            hipLaunchKernelGGL(fwd_kernel, dim3(grid), dim3(NTHREADS), LDS_BYTES, stream, a); } }
#ifdef DBG_HASH_OFF
    { const unsigned* hb = DBG_HASH_OFF == 0 ? (const unsigned*)d_out : (const unsigned*)((char*)d_ws + DBG_HASH_OFF);
      hipLaunchKernelGGL(dbg_hash, dim3(1024), dim3(256), 0, stream, hb, (size_t)(DBG_HASH_BYTES) / 4, (unsigned*)d_ws + 2);
      hipLaunchKernelGGL(dbg_fill, dim3(1024), dim3(256), 0, stream, (float*)d_out, (size_t)NTOK * DM, (const unsigned*)d_ws + 2); }
#endif
#endif
}
```

```cpp
#include <hip/hip_runtime.h>
#include <cstdio>
#include <cstdint>

#ifndef MK_N_LAUNCHES
#define MK_N_LAUNCHES 1
#endif

constexpr int NB = 8, SEQ = 2048, NMETA = 16, TT = SEQ + NMETA  , DM = 1024, NTOK = NB * SEQ  , NALL = NB * TT  ;
constexpr int AW = 512, NH = 8, HD = 64, IDXD = 64, CC = 512, CW = 31, NE = 32, DFF = 1024, TOPK = 256;
constexpr int INCOLS = 5192, TP = 2176  , VOFF = 0  , MSTR = 68  ;
constexpr float EPS = 1e-6f, LOG2E = 1.4426950408889634f;
constexpr float QSCALE = 0.125f * LOG2E;
constexpr int MAXTILES = 296;
constexpr int SC_Q = 0, SC_K = 512, SC_V = 1024, SC_IQ = 1536, SC_IK = 2048, SC_IW = 2112, SC_GLU = 2120, SC_GATE = 3144;
constexpr int WR_GLU = 2048, WR_GATE = 3072, WR_IK = 5120, WR_IW = 5184, WIN_ROWS = 5376;

constexpr size_t MiB = 1u << 20;
constexpr size_t al4k(size_t x) { return (x + 4095) & ~(size_t)4095; }
constexpr size_t WS_CTL = 0, CTL_ZERO_BYTES = 1 * MiB;
constexpr size_t WS_WIN = 1 * MiB;
constexpr size_t WS_WAO = WS_WIN + al4k((size_t)WIN_ROWS * DM * 2);
constexpr size_t WS_WCO = WS_WAO + al4k((size_t)DM * AW * 2);
constexpr size_t WS_WOUT = WS_WCO + al4k((size_t)DM * CC * 2);
constexpr size_t WS_WUG = WS_WOUT + al4k((size_t)DM * DM * 2);
constexpr size_t WS_WD = WS_WUG + al4k((size_t)NE * 2 * DFF * DM * 2);
constexpr size_t WS_XN = WS_WD + al4k((size_t)NE * DM * DFF * 2);
constexpr size_t WS_XNM = WS_XN + al4k((size_t)NTOK * DM * 2);
constexpr size_t WS_Q = WS_XNM + al4k((size_t)NMETA * DM * 2);
constexpr size_t WS_IQ = WS_Q + al4k((size_t)NTOK * AW * 2);
constexpr size_t WS_KB = WS_IQ + al4k((size_t)NTOK * AW * 2);
constexpr size_t WS_VT = WS_KB + al4k((size_t)(NALL + 64) * AW * 2);
constexpr size_t WS_IK = WS_VT + al4k((size_t)NB * AW * TP * 2);
constexpr size_t WS_IW = WS_IK + al4k((size_t)NB * 65 * 2048 * 2);
constexpr size_t WS_GLU = WS_IW + al4k((size_t)NTOK * 8 * 4);
constexpr size_t WS_GA = WS_GLU + al4k((size_t)NALL * CC * 2);
constexpr size_t WS_GB = WS_GA + al4k((size_t)NTOK * DM * 2);
constexpr size_t WS_MASK = WS_GB + al4k((size_t)NTOK * DM * 2);
constexpr size_t WS_AO = WS_MASK + al4k((size_t)NTOK * MSTR * 4);
constexpr size_t WS_CO = WS_AO + al4k((size_t)NTOK * AW * 2);
constexpr size_t WS_MG = WS_CO + al4k((size_t)NTOK * CC * 2);
constexpr size_t WS_TE = WS_MG + al4k((size_t)NTOK * DM * 2);
constexpr size_t WS_TP = WS_TE + al4k((size_t)NTOK * 4 * 4);
constexpr size_t WS_LIST = WS_TP + al4k((size_t)NTOK * 4 * 4);
constexpr size_t WS_LG = WS_LIST + al4k((size_t)NE * NTOK * 4);
constexpr size_t WS_ACT = WS_LG + al4k((size_t)NE * NTOK * 4);
constexpr size_t WS_YP = WS_ACT + al4k((size_t)MAXTILES * 256 * DFF * 2);
constexpr size_t WS_H1 = WS_YP + al4k((size_t)MAXTILES * 256 * DM * 2);
constexpr size_t WS_WRT = WS_H1 + al4k((size_t)NTOK * DM * 4);
constexpr size_t WS_RG = WS_WRT + al4k((size_t)2 * NE * DM * 2);
constexpr size_t WS_DUMMY = WS_RG + al4k((size_t)NE * NTOK * 4);
constexpr size_t WS_END = WS_DUMMY + 4096;
static_assert(WS_END < ((size_t)1 << 32), "32-bit byte offsets into d_ws");
constexpr int CW_TMO = 0, CW_CODE = 1, CW_BAR = 4096, CW_ECNT = 16384;

constexpr int RING_BYTES = 131072;
constexpr int LDSX_OFF = 153600;
constexpr int MISC_OFF = 161792;
constexpr int LDS_BYTES = 163840;
constexpr int NWAVES = 8, NTHREADS = 512;

#define GAS __attribute__((address_space(1)))
#define LAS __attribute__((address_space(3)))
typedef unsigned short bf16_t;
typedef short bf16x8 __attribute__((ext_vector_type(8)));
typedef short s16x4 __attribute__((ext_vector_type(4)));
typedef float f32x4 __attribute__((ext_vector_type(4)));
typedef float f32x16 __attribute__((ext_vector_type(16)));
typedef unsigned u32x4 __attribute__((ext_vector_type(4)));
typedef unsigned u32x2 __attribute__((ext_vector_type(2)));
typedef GAS unsigned gu32;
#define RLX_AGENT __ATOMIC_RELAXED, __HIP_MEMORY_SCOPE_AGENT
#define LDS_WAIT() asm volatile("s_waitcnt lgkmcnt(0)" ::: "memory")
#define VM_WAIT() asm volatile("s_waitcnt vmcnt(0)" ::: "memory")

typedef float f32x2_t __attribute__((ext_vector_type(2))); typedef __bf16 bf16x2_t __attribute__((ext_vector_type(2)));
__device__ __forceinline__ unsigned cvt_pk_bf16(float lo, float hi) { const f32x2_t v = {lo, hi}; const bf16x2_t b = __builtin_convertvector(v, bf16x2_t); return __builtin_bit_cast(unsigned, b); }
__device__ __forceinline__ float bf2f(unsigned short b) { return __uint_as_float((unsigned)b << 16); }
__device__ __forceinline__ float bflo(unsigned w) { return __uint_as_float(w << 16); }
__device__ __forceinline__ float bfhi(unsigned w) { return __uint_as_float(w & 0xffff0000u); }
__device__ __forceinline__ float sigmoidf_(float x) { return __builtin_amdgcn_rcpf(1.0f + __builtin_amdgcn_exp2f(-LOG2E * x)); }
__device__ __forceinline__ f32x2_t rcp1pexp2_2(f32x2_t x, float k) { const f32x2_t t = x * (f32x2_t){k, k}; f32x2_t e; e.x = __builtin_amdgcn_exp2f(t.x); e.y = __builtin_amdgcn_exp2f(t.y);
    e = e + (f32x2_t){1.0f, 1.0f}; f32x2_t r; r.x = __builtin_amdgcn_rcpf(e.x); r.y = __builtin_amdgcn_rcpf(e.y); return r; }
__device__ __forceinline__ f32x2_t lo2(f32x4 v) { return __builtin_shufflevector(v, v, 0, 1); }
__device__ __forceinline__ f32x2_t hi2(f32x4 v) { return __builtin_shufflevector(v, v, 2, 3); }
__device__ __forceinline__ f32x4 cat2(f32x2_t a, f32x2_t b) { return __builtin_shufflevector(a, b, 0, 1, 2, 3); }
__device__ __forceinline__ float wave_sum(float v) {
#pragma unroll
    for (int o = 1; o < 64; o <<= 1) v += __shfl_xor(v, o);
    return v;
}

namespace pg8 {
constexpr int BM = 256, BK = 64, HALF = 128, HTB = HALF * BK * 2, STAGE_BYTES = 8 * HTB;
__host__ __device__ __forceinline__ int lds_byte(int r, int c) { const int st = (r >> 4) * 2 + (c >> 5), rr = r & 15, cc = c & 31, ob = rr * 64 + cc * 2; return st * 1024 + (ob ^ (((ob >> 9) & 1) << 5)); }
__host__ __device__ __forceinline__ void stage_rc(int b, int& R, int& C) { const int st = b / 1024, sb = b % 1024, swz = sb ^ (((sb >> 9) & 1) << 5); R = (st >> 1) * 16 + swz / 64; C = (st & 1) * 32 + (swz % 64) / 2; }

struct Unit { int pm, pn, z, ord; };

template <class Epi, class Sched>
__device__ __forceinline__ void gemm_phase(LAS unsigned char* lds, const int K, const Sched& S, const Epi& E) {
    const int tid = threadIdx.x, wid = __builtin_amdgcn_readfirstlane(tid >> 6), lane = tid & 63, wr = wid >> 2, wc = wid & 3, fr = lane & 15, fq = lane >> 4;
    const int nt = K / BK;
    unsigned voffB[2];
#pragma unroll
    for (int i = 0; i < 2; ++i) { int R_, C_; stage_rc(tid * 16 + i * 8192, R_, C_); const int rho = R_ & 31, Rp = (R_ & ~31) + 8 * ((rho & 15) >> 2) + 4 * (rho >> 4) + (rho & 3);
                                  voffB[i] = (unsigned)(Rp * K + C_) * 2u; }
    const size_t kstep = (size_t)(BK * 2);
    const size_t hstep = (size_t)HALF * K * 2;
    const unsigned ldsw = (unsigned)wid * 1024u;
    const int aoff = lds_byte(wr * 64 + fr, fq * 8), boff = lds_byte(wc * 32 + fr, fq * 8);
    const char* const abase = S.a_base();
#define PG8_SA(b, h) (((b) * 2 + (h)) * HTB)
#define PG8_SB(b, h) ((4 + (b) * 2 + (h)) * HTB)
#define PG8_STAGE(bufoff, gbase, voff) do { _Pragma("unroll") for (int _i = 0; _i < 2; ++_i) \
        __builtin_amdgcn_global_load_lds((const unsigned*)((const char*)(gbase) + (voff)[_i]), (LAS unsigned*)(lds + (bufoff) + ldsw + _i * 8192), 16, 0, 0); } while (0)
#define PG8_LDA(dst, b, h) do { _Pragma("unroll") for (int m = 0; m < 4; ++m) _Pragma("unroll") for (int k = 0; k < 2; ++k) dst[m][k] = *(const LAS bf16x8*)(lds + PG8_SA(b, h) + aoff + m * 2048 + k * 1024); } while (0)
#define PG8_LDB(dst, b, h) do { _Pragma("unroll") for (int n = 0; n < 2; ++n) _Pragma("unroll") for (int k = 0; k < 2; ++k) dst[n][k] = *(const LAS bf16x8*)(lds + PG8_SB(b, h) + boff + n * 2048 + k * 1024); } while (0)
#define PG8_MMA(ai, bj, At, Bt) do { __builtin_amdgcn_s_setprio(1); _Pragma("unroll") for (int m = 0; m < 4; ++m) _Pragma("unroll") for (int n = 0; n < 2; ++n) _Pragma("unroll") for (int k = 0; k < 2; ++k) \
        acc[ai][bj][m][n] = __builtin_amdgcn_mfma_f32_16x16x32_bf16(Bt[n][k], At[m][k], acc[ai][bj][m][n], 0, 0, 0); __builtin_amdgcn_s_setprio(0); } while (0)
#define PG8_WAIT_V(n) asm volatile("s_waitcnt vmcnt(" #n ")" ::: "memory")
#define PG8_WAIT_L(n) asm volatile("s_waitcnt lgkmcnt(" #n ")" ::: "memory")
#define PG8_BAR __builtin_amdgcn_s_barrier()
#define PG8_SCHED __builtin_amdgcn_sched_barrier(0)
    Unit cur, nxt; int ui = 0;
    if (!S.next(0, cur)) return;
    f32x4 acc[2][2][4][2];
#pragma unroll
    for (int a = 0; a < 2; ++a)
#pragma unroll
        for (int b = 0; b < 2; ++b)
#pragma unroll
            for (int m = 0; m < 4; ++m)
#pragma unroll
                for (int n = 0; n < 2; ++n) acc[a][b][m][n] = (f32x4){0.f, 0.f, 0.f, 0.f};
    bf16x8 At[4][2], B0[2][2], B1[2][2];
    unsigned ca[2][2], na[2][2];
    S.a_offs(cur, tid, ca);
    const char* cB = S.b_base(cur);
    PG8_STAGE(PG8_SB(0, 0), cB, voffB); PG8_STAGE(PG8_SB(0, 1), cB + hstep, voffB); PG8_STAGE(PG8_SA(0, 0), abase, ca[0]); PG8_STAGE(PG8_SA(0, 1), abase, ca[1]);
    if (wr == 1) PG8_BAR;
    PG8_WAIT_V(2); PG8_BAR;
    PG8_STAGE(PG8_SB(1, 0), cB + kstep, voffB); PG8_STAGE(PG8_SA(1, 0), abase + kstep, ca[0]); PG8_STAGE(PG8_SB(1, 1), cB + hstep + kstep, voffB);
    PG8_WAIT_V(6); PG8_BAR;
    for (;;) {
        const bool has_next = S.next(ui + 1, nxt);
        const char* nB = cB;
#pragma unroll
        for (int h = 0; h < 2; ++h)
#pragma unroll
            for (int i = 0; i < 2; ++i) na[h][i] = ca[h][i];
        if (has_next) { S.a_offs(nxt, tid, na); nB = S.b_base(nxt); }
        for (int t = 0; t < nt; t += 2) {
            const bool last = (t == nt - 2);
            const char* a1 = abase + (size_t)(t + 1) * kstep;
            const char* a2 = last ? abase : abase + (size_t)(t + 2) * kstep; const char* b2 = last ? nB : cB + (size_t)(t + 2) * kstep;
            const char* a3 = a2 + kstep; const char* b3 = b2 + kstep;
            PG8_LDB(B0, 0, 0); PG8_LDB(B1, 0, 1); PG8_SCHED; PG8_LDA(At, 0, 0); PG8_STAGE(PG8_SA(1, 1), a1, ca[1]);
            PG8_WAIT_V(8); PG8_WAIT_L(0); PG8_BAR; PG8_MMA(0, 0, At, B0); PG8_MMA(0, 1, At, B1); PG8_BAR; PG8_SCHED;
            if (last) {
#pragma unroll
                for (int h = 0; h < 2; ++h)
#pragma unroll
                    for (int i = 0; i < 2; ++i) ca[h][i] = na[h][i];
            }
            PG8_LDA(At, 0, 1); PG8_STAGE(PG8_SB(0, 0), b2, voffB); PG8_STAGE(PG8_SB(0, 1), b2 + hstep, voffB); PG8_STAGE(PG8_SA(0, 0), a2, ca[0]);
            PG8_WAIT_V(8); PG8_WAIT_L(0); PG8_BAR; PG8_MMA(1, 0, At, B0); PG8_MMA(1, 1, At, B1); PG8_BAR; PG8_SCHED;
            PG8_LDB(B0, 1, 0); PG8_LDB(B1, 1, 1); PG8_SCHED; PG8_LDA(At, 1, 0); PG8_STAGE(PG8_SA(0, 1), a2, ca[1]);
            PG8_WAIT_V(8); PG8_WAIT_L(0); PG8_BAR; PG8_MMA(0, 0, At, B0); PG8_MMA(0, 1, At, B1); PG8_BAR; PG8_SCHED;
            PG8_LDA(At, 1, 1); PG8_STAGE(PG8_SB(1, 0), b3, voffB); PG8_STAGE(PG8_SB(1, 1), b3 + hstep, voffB); PG8_STAGE(PG8_SA(1, 0), a3, ca[0]);
            PG8_WAIT_V(8); PG8_WAIT_L(0); PG8_BAR; PG8_MMA(1, 0, At, B0); PG8_MMA(1, 1, At, B1); PG8_BAR; PG8_SCHED;
        }
        if (wr == 0) PG8_BAR;
        { int tz = tid; asm volatile("" : "+v"(tz));
          const int l2 = tz & 63, w2 = __builtin_amdgcn_readfirstlane(tz >> 6); E(acc, cur, w2 >> 2, w2 & 3, l2 & 15, l2 >> 4); }
        if (!has_next) break;
#pragma unroll
        for (int a = 0; a < 2; ++a)
#pragma unroll
            for (int b = 0; b < 2; ++b)
#pragma unroll
                for (int m = 0; m < 4; ++m)
#pragma unroll
                    for (int n = 0; n < 2; ++n) acc[a][b][m][n] = (f32x4){0.f, 0.f, 0.f, 0.f};
        cur = nxt; cB = nB; ++ui;
        if (wr == 1) PG8_BAR;
    }
    PG8_WAIT_V(0);
    PG8_BAR;
#undef PG8_SA
#undef PG8_SB
#undef PG8_STAGE
#undef PG8_LDA
#undef PG8_LDB
#undef PG8_MMA
#undef PG8_WAIT_V
#undef PG8_WAIT_L
#undef PG8_BAR
#undef PG8_SCHED
}
}

#define XB_TMO      128
#define XB_XCNT(j)  (256  + 64 * (j))
#define XB_XSUB(j)  (1280 + 64 * (j))
#define XB_XGEN(j)  (2304 + 64 * (j))
#define XB_TOP      3328
#define XB_TOPGEN   3392
#define XCD_BAR_WORDS 3456
#define XB_SPIN_CAP (1u << 18)
__device__ __forceinline__ unsigned xb_ld(unsigned* p)              { return __hip_atomic_load(p, __ATOMIC_RELAXED, __HIP_MEMORY_SCOPE_AGENT); }
__device__ __forceinline__ unsigned xb_add(unsigned* p, unsigned v) { return __hip_atomic_fetch_add(p, v, __ATOMIC_RELAXED, __HIP_MEMORY_SCOPE_AGENT); }
__device__ __forceinline__ unsigned xb_xcc_id() { return (unsigned)__builtin_amdgcn_s_getreg((3 << 11) | 20) & 0xFu; }
#define XB_SPIN(cond, bar) do { unsigned _sp = 0; while (cond) { __builtin_amdgcn_s_sleep(1); \
    if ((++_sp & 255u) == 0u) { if (xb_ld(&(bar)[XB_TMO])) break; if (_sp > XB_SPIN_CAP) { atomicAdd(&(bar)[XB_TMO], 1u); break; } } } } while (0)
struct XcdBarrier { unsigned* bar; unsigned x; volatile LAS unsigned* st; };
__device__ __forceinline__ XcdBarrier xcd_barrier_post(unsigned* bar, volatile LAS unsigned* st) {
    XcdBarrier b; b.bar = bar; b.x = xb_xcc_id(); b.st = st;
    if (threadIdx.x == 0) (void)xb_add(&bar[XB_XCNT(b.x)], 1u);
    return b;
}
__device__ __forceinline__ void xcd_barrier_complete(unsigned* bar, unsigned x, unsigned& nloc, unsigned& nx) {
    const unsigned G = gridDim.x * gridDim.y * gridDim.z;
    unsigned sum, cnt, mine, sp = 0u;
    for (;;) {
        sum = 0u; cnt = 0u; mine = 0u;
#pragma unroll
        for (unsigned j = 0; j < 16; ++j) { const unsigned c = xb_ld(&bar[XB_XCNT(j)]); sum += c; cnt += (c > 0u) ? 1u : 0u; mine = (j == x) ? c : mine; }
        if (sum == G) break;
        __builtin_amdgcn_s_sleep(1);
        if ((++sp & 255u) == 0u) { if (xb_ld(&bar[XB_TMO])) break; if (sp > XB_SPIN_CAP) { atomicAdd(&bar[XB_TMO], 1u); break; } }
    }
    nloc = mine > 0u ? mine : 1u; nx = cnt > 0u ? cnt : 1u;
}
__device__ __forceinline__ void xcd_barrier(const XcdBarrier& b) {
    asm volatile("s_waitcnt vmcnt(0)" ::: "memory");
    __syncthreads();
    if (threadIdx.x == 0) {
        unsigned* bar = b.bar;
        __builtin_amdgcn_s_waitcnt(0);
        unsigned nloc = b.st[0], nx = b.st[1];
        if (nloc == 0u) { xcd_barrier_complete(bar, b.x, nloc, nx); b.st[0] = nloc; b.st[1] = nx; }
        const unsigned old = xb_add(&bar[XB_XSUB(b.x)], 1u);
        const unsigned gen = old / nloc;
        if (old + 1u == (gen + 1u) * nloc) {
            __builtin_amdgcn_fence(__ATOMIC_RELEASE, "agent");
            asm volatile("s_waitcnt vmcnt(0)" ::: "memory");
            const unsigned og = xb_add(&bar[XB_TOP], 1u);
            const unsigned tg = og / nx;
            if (og + 1u == (tg + 1u) * nx) xb_add(&bar[XB_TOPGEN], 1u);
            else XB_SPIN(xb_ld(&bar[XB_TOPGEN]) == tg, bar);
            __builtin_amdgcn_fence(__ATOMIC_ACQUIRE, "agent");
            xb_add(&bar[XB_XGEN(b.x)], 1u);
            asm volatile("s_waitcnt vmcnt(0)" ::: "memory");
        } else {
            XB_SPIN(xb_ld(&bar[XB_XGEN(b.x)]) == gen, bar);
            __builtin_amdgcn_fence(__ATOMIC_ACQUIRE, "agent");
            asm volatile("s_waitcnt vmcnt(0)" ::: "memory");
        }
    }
    __syncthreads();
}

struct Args {
    const float* in[21];
    float* out; unsigned char* ws;
    int ph_lo, ph_hi, flags, pad;
};
enum { I_X = 0, I_META, I_RELB, I_NMIX, I_WIN, I_BGATE, I_WAO, I_CONVW, I_CONVB, I_LNG, I_LNB, I_WCO, I_WOUT, I_NFFN, I_WR, I_BR, I_WUG, I_BUG, I_WD, I_BD, I_NFIN };

struct Frame {
    LAS unsigned char* lds;
    unsigned char* ws;
    int tid, lane, wave;
    int G, bid;
};
template <class T> __device__ __forceinline__ T* wsp(unsigned char* ws, size_t off) { return (T*)(ws + off); }

struct P0Desc { const float* src; bf16_t* dst; int ldn, ldk; };
__device__ __forceinline__ void p0_load(const P0Desc& d, f32x4 (&v)[16], int lane) {
    const float* p = d.src + (size_t)(lane >> 4) * d.ldn + (lane & 15) * 4;
#pragma unroll
    for (int i = 0; i < 16; ++i) v[i] = *(const f32x4*)(p + (size_t)(4 * i) * d.ldn);
}
__device__ __forceinline__ void p0_store(const P0Desc& d, const f32x4 (&v)[16], LAS float* scr, int lane) {
    const int n4 = (lane & 15) * 4, kr = lane >> 4;
#pragma unroll
    for (int i = 0; i < 16; ++i) { LAS float* p = scr + (4 * i + kr) * 65 + n4; p[0] = v[i][0]; p[1] = v[i][1]; p[2] = v[i][2]; p[3] = v[i][3]; }
    LDS_WAIT(); asm volatile("" ::: "memory");
    const int c = lane & 7;
#pragma unroll
    for (int j = 0; j < 8; ++j) { const int n = (lane >> 3) + 8 * j; const LAS float* s = scr + (8 * c) * 65 + n;
        u32x4 o; o.x = cvt_pk_bf16(s[0 * 65], s[1 * 65]); o.y = cvt_pk_bf16(s[2 * 65], s[3 * 65]); o.z = cvt_pk_bf16(s[4 * 65], s[5 * 65]); o.w = cvt_pk_bf16(s[6 * 65], s[7 * 65]);
        *(u32x4*)(d.dst + (size_t)n * d.ldk + 8 * c) = o; }
    LDS_WAIT(); asm volatile("" ::: "memory");
}
__device__ __forceinline__ void rms_row_to_bf16(const float* __restrict__ xrow, const float* __restrict__ g, bf16_t* __restrict__ orow, int lane) {
    const f32x4* xr = (const f32x4*)xrow + lane; const f32x4* gr = (const f32x4*)g + lane;
    f32x4 v[4]; float s = 0.f;
#pragma unroll
    for (int j = 0; j < 4; ++j) { v[j] = xr[64 * j]; s += (v[j].x * v[j].x + v[j].y * v[j].y) + (v[j].z * v[j].z + v[j].w * v[j].w); }
    const float r = 1.0f / sqrtf(wave_sum(s) * (1.f / DM) + EPS);
    unsigned long long* o8 = (unsigned long long*)orow + lane;
#pragma unroll
    for (int j = 0; j < 4; ++j) { const f32x4 gg = gr[64 * j];
        o8[64 * j] = (unsigned long long)cvt_pk_bf16(v[j].x * r * gg.x, v[j].y * r * gg.y) | ((unsigned long long)cvt_pk_bf16(v[j].z * r * gg.z, v[j].w * r * gg.w) << 32); }
}
__device__ __forceinline__ void p0_prologue(Frame& F, const Args& a, const int part) {
    LAS float* scr = (LAS float*)(F.lds + F.wave * 16896);
    const int gw = F.bid * NWAVES + F.wave, NGW = F.G * NWAVES;
    unsigned char* ws = F.ws;
    constexpr int T_IN = 81 * 16, T_AO = 16 * 8, T_CO = 16 * 8, T_OUT = 16 * 16, T_SMALL = T_IN + T_AO + T_CO + T_OUT;
    constexpr int T_UG = NE * 32 * 16, T_D = NE * 16 * 16, T_ALL = T_SMALL + T_UG + T_D;
    auto desc = [&](int it) -> P0Desc {
        int r = it; P0Desc d;
        if (r < T_IN) { const int g = r / 16, kb = r % 16; const int dr = g * 64; int sc;
            if (dr < WR_GLU) sc = dr;
            else if (dr < WR_GATE) { const int q = dr - WR_GLU, tile = q >> 8, hf = (q >> 7) & 1, w = q & 127; sc = SC_GLU + 512 * hf + 128 * tile + w; }
            else if (dr < WR_IK) sc = SC_GATE + (dr - WR_GATE);
            else sc = SC_IK + (dr - WR_IK);
            d.src = a.in[I_WIN] + (size_t)(kb * 64) * INCOLS + sc; d.ldn = INCOLS; d.dst = wsp<bf16_t>(ws, WS_WIN) + (size_t)dr * DM + kb * 64; d.ldk = DM; return d; }
        r -= T_IN;
        if (r < T_AO) { const int g = r / 8, kb = r % 8; d.src = a.in[I_WAO] + (size_t)(kb * 64) * DM + g * 64; d.ldn = DM; d.dst = wsp<bf16_t>(ws, WS_WAO) + (size_t)(g * 64) * AW + kb * 64; d.ldk = AW; return d; }
        r -= T_AO;
        if (r < T_CO) { const int g = r / 8, kb = r % 8; d.src = a.in[I_WCO] + (size_t)(kb * 64) * DM + g * 64; d.ldn = DM; d.dst = wsp<bf16_t>(ws, WS_WCO) + (size_t)(g * 64) * CC + kb * 64; d.ldk = CC; return d; }
        r -= T_CO;
        if (r < T_OUT) { const int g = r / 16, kb = r % 16; d.src = a.in[I_WOUT] + (size_t)(kb * 64) * DM + g * 64; d.ldn = DM; d.dst = wsp<bf16_t>(ws, WS_WOUT) + (size_t)(g * 64) * DM + kb * 64; d.ldk = DM; return d; }
        r -= T_OUT;
        if (r < T_UG) { const int e = r / 512, q = r % 512, g = q % 32, kb = q / 32; const int dr = g * 64, tile = dr >> 8, hf = (dr >> 7) & 1, w = dr & 127;
            d.src = a.in[I_WUG] + (size_t)e * DM * 2 * DFF + (size_t)(kb * 64) * (2 * DFF) + DFF * hf + 128 * tile + w; d.ldn = 2 * DFF;
            d.dst = wsp<bf16_t>(ws, WS_WUG) + (size_t)e * 2 * DFF * DM + (size_t)dr * DM + kb * 64; d.ldk = DM; return d; }
        r -= T_UG;
        { const int e = r / 256, q = r % 256, g = q % 16, kb = q / 16;
            d.src = a.in[I_WD] + (size_t)e * DFF * DM + (size_t)(kb * 64) * DM + g * 64; d.ldn = DM; d.dst = wsp<bf16_t>(ws, WS_WD) + (size_t)e * DM * DFF + (size_t)(g * 64) * DFF + kb * 64; d.ldk = DFF; return d; }
    };
    const int T_LO = part ? T_SMALL : 0, T_HI = part ? T_ALL : T_SMALL;
    if (T_LO + gw < T_HI) {
        f32x4 va[16], vb[16];
        P0Desc da = desc(T_LO + gw), db = da;
        p0_load(da, va, F.lane);
        for (int it = T_LO + gw; it < T_HI; it += 2 * NGW) {
            const int i1 = it + NGW, i2 = it + 2 * NGW;
            db = desc(i1 < T_HI ? i1 : it); p0_load(db, vb, F.lane);
            p0_store(da, va, scr, F.lane);
            da = desc(i2 < T_HI ? i2 : it); p0_load(da, va, F.lane);
            if (i1 < T_HI) p0_store(db, vb, scr, F.lane);
        }
    }
    if (part) return;
    { const int gt = F.bid * NTHREADS + F.tid;
      if (gt < 8 * DM / 2) { const int n = gt >> 9, k = (gt & 511) * 2; const float v0 = a.in[I_WIN][(size_t)k * INCOLS + SC_IW + n], v1 = a.in[I_WIN][(size_t)(k + 1) * INCOLS + SC_IW + n];
          *(unsigned*)(wsp<bf16_t>(ws, WS_WIN) + (size_t)(WR_IW + n) * DM + k) = cvt_pk_bf16(v0, v1); } }
    { const int gt = F.bid * NTHREADS + F.tid;
      if (gt < NE * DM / 2) { const int e = gt >> 9, d = (gt & 511) * 2; const float v0 = a.in[I_NFFN][d] * a.in[I_WR][(size_t)d * NE + e], v1 = a.in[I_NFFN][d + 1] * a.in[I_WR][(size_t)(d + 1) * NE + e];
          const unsigned hi = cvt_pk_bf16(v0, v1); const unsigned lo = cvt_pk_bf16(v0 - bflo(hi), v1 - bfhi(hi));
          *(unsigned*)(wsp<bf16_t>(ws, WS_WRT) + (size_t)e * DM + d) = hi; *(unsigned*)(wsp<bf16_t>(ws, WS_WRT) + (size_t)(NE + e) * DM + d) = lo; } }
    for (int m = gw; m < NTOK + NMETA; m += NGW) {
        if (m < NTOK) rms_row_to_bf16(a.in[I_X] + (size_t)m * DM, a.in[I_NMIX], wsp<bf16_t>(ws, WS_XN) + (size_t)m * DM, F.lane);
        else rms_row_to_bf16(a.in[I_META] + (size_t)(m - NTOK) * DM, a.in[I_NMIX], wsp<bf16_t>(ws, WS_XNM) + (size_t)(m - NTOK) * DM, F.lane);
    }
}

struct PlainSched {
    const char* ws; unsigned a_off, b_off; int K, nM, nN, nwg, G, c;
    __device__ __forceinline__ void init(const unsigned char* ws_, size_t a, size_t b, int M, int N, int K_, int G_, int c_) { ws = (const char*)ws_; a_off = (unsigned)a; b_off = (unsigned)b; K = K_; nM = M / 256; nN = N / 256; nwg = nM * nN; G = G_; c = c_; }
    __device__ __forceinline__ bool next(int i, pg8::Unit& u) const {
        const long L = (long)i * G + c; if (L >= nwg) return false;
        int wgid = (int)L; { const int q = nwg / 8, r = nwg % 8, xcd = wgid % 8, off = wgid / 8; wgid = (xcd < r ? xcd * (q + 1) : r * (q + 1) + (xcd - r) * q) + off; }
        const int nig = 8 * nN, gid = wgid / nig, fm = gid * 8, gsz = (nM - fm) < 8 ? (nM - fm) : 8;
        u.pm = fm + ((wgid % nig) % gsz); u.pn = (wgid % nig) / gsz; u.z = 0; u.ord = i; return true;
    }
    __device__ __forceinline__ const char* a_base() const { return ws; }
    __device__ __forceinline__ void a_offs(const pg8::Unit& u, int tid, unsigned (&o)[2][2]) const {
        int R[2], C[2]; pg8::stage_rc(tid * 16, R[0], C[0]); pg8::stage_rc(tid * 16 + 8192, R[1], C[1]);
#pragma unroll
        for (int h = 0; h < 2; ++h)
#pragma unroll
            for (int i = 0; i < 2; ++i) o[h][i] = a_off + (unsigned)(((u.pm * 256 + h * 128 + R[i]) * K + C[i]) * 2);
    }
    __device__ __forceinline__ const char* b_base(const pg8::Unit& u) const { return ws + b_off + (size_t)u.pn * 256 * K * 2; }
};
struct MergeSched {
    const char* ws; int G, c;
    __device__ __forceinline__ bool next(int i, pg8::Unit& u) const {
        const int t = c + (i >> 1) * G;
        if (t >= 256) return false;
        u.pm = (t & 7) + 8 * (t >> 5); u.pn = (t >> 3) & 3; u.z = i & 1; u.ord = i; return true;
    }
    __device__ __forceinline__ const char* a_base() const { return ws; }
    __device__ __forceinline__ void a_offs(const pg8::Unit& u, int tid, unsigned (&o)[2][2]) const {
        int R[2], C[2]; pg8::stage_rc(tid * 16, R[0], C[0]); pg8::stage_rc(tid * 16 + 8192, R[1], C[1]);
        const unsigned base = (unsigned)(u.z ? WS_CO : WS_AO);
#pragma unroll
        for (int h = 0; h < 2; ++h)
#pragma unroll
            for (int i = 0; i < 2; ++i) o[h][i] = base + (unsigned)(((u.pm * 256 + h * 128 + R[i]) * 512 + C[i]) * 2);
    }
    __device__ __forceinline__ const char* b_base(const pg8::Unit& u) const { return ws + (u.z ? WS_WCO : WS_WAO) + (size_t)u.pn * 256 * 512 * 2; }
};
struct MoeTables { const LAS int* cnt; const LAS int* tbase; };
constexpr int MOE_MAXU = 10;
constexpr int MOEL_DESC = RING_BYTES;
constexpr int MOEL_TOK = MOEL_DESC + 256;
constexpr int MOEL_ROWV = MOEL_TOK + MOE_MAXU * 1024;
static_assert(MOEL_ROWV + MOE_MAXU * 1024 <= LDSX_OFF, "moe LDS map");
template <int NC, bool GATHER>
struct MoeSched {
    const char* ws; MoeTables T; int G, c, total; LAS unsigned char* lds;
    __device__ __forceinline__ int next_lane(int i, int& pm, int& pn, int& z) const {
        pm = 0; pn = 0; z = 0;
        const long L = (long)i * G + c; if (L >= total) return 0;
        int wgid = (int)L; { const int q = total / 8, r = total % 8, xcd = wgid % 8, off = wgid / 8; wgid = (xcd < r ? xcd * (q + 1) : r * (q + 1) + (xcd - r) * q) + off; }
        int e = 0;
        for (int j = 1; j < NE; ++j) e += (wgid >= T.tbase[j] * NC) ? 1 : 0;
        const int loc = wgid - T.tbase[e] * NC;
        z = e; pn = loc % NC; pm = loc / NC;
        return 1;
    }
    __device__ __forceinline__ bool next(int i, pg8::Unit& u) const {
        const u32x4 d = *(const LAS u32x4*)(lds + MOEL_DESC + 16 * i);
        if (__builtin_amdgcn_readfirstlane((int)d.w) == 0) return false;
        u.pm = __builtin_amdgcn_readfirstlane((int)d.x); u.pn = __builtin_amdgcn_readfirstlane((int)d.y); u.z = __builtin_amdgcn_readfirstlane((int)d.z); u.ord = i;
        return true;
    }
    __device__ __forceinline__ const char* a_base() const { return ws; }
    __device__ __forceinline__ void a_offs(const pg8::Unit& u, int tid, unsigned (&o)[2][2]) const {
        int R[2], C[2]; pg8::stage_rc(tid * 16, R[0], C[0]); pg8::stage_rc(tid * 16 + 8192, R[1], C[1]);
        if (GATHER) {
            const LAS int* tokl = (const LAS int*)(lds + MOEL_TOK) + u.ord * 256;
#pragma unroll
            for (int h = 0; h < 2; ++h)
#pragma unroll
                for (int i = 0; i < 2; ++i) { const int tok = tokl[h * 128 + R[i]]; o[h][i] = (unsigned)WS_XN + (unsigned)((tok * DM + C[i]) * 2); }
        } else {
            const int row0 = (__builtin_amdgcn_readfirstlane(T.tbase[u.z]) + u.pm) * 256;
#pragma unroll
            for (int h = 0; h < 2; ++h)
#pragma unroll
                for (int i = 0; i < 2; ++i) o[h][i] = (unsigned)WS_ACT + (unsigned)(((row0 + h * 128 + R[i]) * DFF + C[i]) * 2);
        }
    }
    __device__ __forceinline__ const char* b_base(const pg8::Unit& u) const {
        if (GATHER) return ws + WS_WUG + ((size_t)u.z * 2 * DFF + (size_t)u.pn * 256) * DM * 2;
        else return ws + WS_WD + ((size_t)u.z * DM + (size_t)u.pn * 256) * DFF * 2;
    }
};
template <int NC, bool GATHER>
__device__ __forceinline__ void moe_prepare(Frame& F, const MoeSched<NC, GATHER>& S, const float* rowv_src) {
    LAS int* desc = (LAS int*)(F.lds + MOEL_DESC); LAS int* tokl = (LAS int*)(F.lds + MOEL_TOK); LAS float* rowv = (LAS float*)(F.lds + MOEL_ROWV);
    if (F.tid < 16) { int pm = 0, pn = 0, z = 0, valid = 0; if (F.tid < MOE_MAXU) valid = S.next_lane(F.tid, pm, pn, z);
        desc[4 * F.tid + 0] = pm; desc[4 * F.tid + 1] = pn; desc[4 * F.tid + 2] = z; desc[4 * F.tid + 3] = valid; }
    __syncthreads();
    const int* LIST = (const int*)(S.ws + WS_LIST);
    constexpr int NIT = MOE_MAXU * 256 / NTHREADS;
    int tk[NIT]; float rv[NIT];
#pragma unroll
    for (int k = 0; k < NIT; ++k) { const int idx = F.tid + k * NTHREADS, i = idx >> 8, r = idx & 255;
        const int pm = desc[4 * i], z = desc[4 * i + 2], n = S.T.cnt[z], p = pm * 256 + r, pc = p < n ? p : 0;
        tk[k] = GATHER ? LIST[(size_t)z * NTOK + pc] : 0; rv[k] = rowv_src[(size_t)z * NTOK + pc]; }
#pragma unroll
    for (int k = 0; k < NIT; ++k) { const int idx = F.tid + k * NTHREADS; if (GATHER) tokl[idx] = tk[k]; rowv[idx] = rv[k]; }
    __syncthreads();
}

#define EPI_ROWS(ai, m) for (int ai = 0; ai < 2; ++ai) _Pragma("unroll") for (int m = 0; m < 4; ++m)
#define EPI_COLS(bj, n) for (int bj = 0; bj < 2; ++bj) _Pragma("unroll") for (int n = 0; n < 2; ++n)
__device__ __forceinline__ void st_bf16x4(bf16_t* p, f32x4 v) { u32x2 w; w.x = cvt_pk_bf16(v[0], v[1]); w.y = cvt_pk_bf16(v[2], v[3]); *(u32x2*)p = w; }
__device__ __forceinline__ void st_bf16x8(bf16_t* p, f32x4 a, f32x4 b) { u32x4 w; w.x = cvt_pk_bf16(a[0], a[1]); w.y = cvt_pk_bf16(a[2], a[3]); w.z = cvt_pk_bf16(b[0], b[1]); w.w = cvt_pk_bf16(b[2], b[3]); *(u32x4*)p = w; }

struct EpiInProj {
    unsigned char* ws; const float* bgate;
    __device__ __forceinline__ void operator()(const f32x4 (&acc)[2][2][4][2], const pg8::Unit& u, int wr, int wc, int fr, int fq) const {
        const int pn = u.pn, row0 = u.pm * 256 + wr * 64 + fr, col0 = wc * 32 + 8 * fq;
        const int bidx = u.pm >> 3;
        const int rowk0 = row0 + NMETA * (bidx + 1);
        if (pn < 2 || (pn >= 6 && pn < 8)) {
            bf16_t* O = wsp<bf16_t>(ws, pn < 2 ? WS_Q : WS_IQ); const int cb = (pn & 1) * 256; const float sc = pn < 2 ? QSCALE : 1.0f;
#pragma unroll
            EPI_ROWS(ai, m) { bf16_t* rp = O + (size_t)(row0 + ai * 128 + m * 16) * AW + cb + col0;
#pragma unroll
                for (int bj = 0; bj < 2; ++bj) st_bf16x8(rp + bj * 128, acc[ai][bj][m][0] * sc, acc[ai][bj][m][1] * sc); }
        } else if (pn < 4) {
            bf16_t* O = wsp<bf16_t>(ws, WS_KB); const int cb = (pn & 1) * 256;
#pragma unroll
            EPI_ROWS(ai, m) { bf16_t* rp = O + (size_t)(rowk0 + ai * 128 + m * 16) * AW + cb + col0;
#pragma unroll
                for (int bj = 0; bj < 2; ++bj) st_bf16x8(rp + bj * 128, acc[ai][bj][m][0], acc[ai][bj][m][1]); }
        } else if (pn < 6) {
            bf16_t* O = wsp<bf16_t>(ws, WS_VT) + (size_t)bidx * AW * TP; const int cb = (pn & 1) * 256;
            const int t0 = (row0 & (SEQ - 1)) + NMETA + VOFF;
#pragma unroll
            EPI_ROWS(ai, m) { const int t = t0 + ai * 128 + m * 16;
#pragma unroll
                EPI_COLS(bj, n) { const f32x4 v = acc[ai][bj][m][n]; bf16_t* cp = O + (size_t)(cb + col0 + bj * 128 + n * 4) * TP + (t & ~1);
                    const float p0 = __shfl_xor(v[0], 1), p1 = __shfl_xor(v[1], 1), p2 = __shfl_xor(v[2], 1), p3 = __shfl_xor(v[3], 1);
                    if ((fr & 1) == 0) { *(unsigned*)(cp) = cvt_pk_bf16(v[0], p0); *(unsigned*)(cp + TP) = cvt_pk_bf16(v[1], p1); }
                    else { *(unsigned*)(cp + 2 * TP) = cvt_pk_bf16(p2, v[2]); *(unsigned*)(cp + 3 * TP) = cvt_pk_bf16(p3, v[3]); } } }
        } else if (pn < 12) {
            bf16_t* O = wsp<bf16_t>(ws, WS_GLU); const int cb = (pn - 8) * 128;
#pragma unroll
            EPI_ROWS(ai, m) { bf16_t* rp = O + (size_t)(rowk0 + ai * 128 + m * 16) * CC + cb + col0;
                f32x4 y[2];
#pragma unroll
                for (int n = 0; n < 2; ++n) { const f32x4 av = acc[ai][0][m][n], gv = acc[ai][1][m][n];
                    y[n] = cat2(lo2(av) * rcp1pexp2_2(lo2(gv), -LOG2E), hi2(av) * rcp1pexp2_2(hi2(gv), -LOG2E)); }
                st_bf16x8(rp, y[0], y[1]); }
        } else {
            const int gt = pn - 12; bf16_t* O = wsp<bf16_t>(ws, gt < 4 ? WS_GA : WS_GB); const int cb = (gt & 3) * 256; const float* bp = bgate + gt * 256 + col0;
            f32x4 bv[2][2];
#pragma unroll
            EPI_COLS(bj, n) bv[bj][n] = *(const f32x4*)(bp + bj * 128 + n * 4);
#pragma unroll
            EPI_ROWS(ai, m) { bf16_t* rp = O + (size_t)(row0 + ai * 128 + m * 16) * DM + cb + col0;
#pragma unroll
                for (int bj = 0; bj < 2; ++bj) { f32x4 y[2];
#pragma unroll
                    for (int n = 0; n < 2; ++n) { const f32x4 x = acc[ai][bj][m][n] + bv[bj][n]; y[n] = cat2(rcp1pexp2_2(lo2(x), -LOG2E), rcp1pexp2_2(hi2(x), -LOG2E)); }
                    st_bf16x8(rp + bj * 128, y[0], y[1]); } }
        }
    }
};
struct EpiMerge {
    unsigned char* ws;
    __device__ __forceinline__ void operator()(const f32x4 (&acc)[2][2][4][2], const pg8::Unit& u, int wr, int wc, int fr, int fq) const {
        const int row0 = u.pm * 256 + wr * 64 + fr, col0 = u.pn * 256 + wc * 32 + 8 * fq;
        const bf16_t* Gt = wsp<bf16_t>(ws, u.z ? WS_GB : WS_GA); bf16_t* O = wsp<bf16_t>(ws, WS_MG);
#pragma unroll
        for (int ai = 0; ai < 2; ++ai) {
            u32x4 g[4][2], p[4][2];
#pragma unroll
            for (int m = 0; m < 4; ++m)
#pragma unroll
                for (int bj = 0; bj < 2; ++bj) { const size_t o = (size_t)(row0 + ai * 128 + m * 16) * DM + col0 + bj * 128; g[m][bj] = *(const u32x4*)(Gt + o); p[m][bj] = u.z ? *(const u32x4*)(O + o) : (u32x4){0u, 0u, 0u, 0u}; }
#pragma unroll
            for (int m = 0; m < 4; ++m)
#pragma unroll
                for (int bj = 0; bj < 2; ++bj) { const size_t o = (size_t)(row0 + ai * 128 + m * 16) * DM + col0 + bj * 128; const u32x4 gg = g[m][bj], pp = p[m][bj]; const f32x4 a0 = acc[ai][bj][m][0], a1 = acc[ai][bj][m][1];
                    const f32x4 y0 = (f32x4){bflo(gg.x) * a0[0] + bflo(pp.x), bfhi(gg.x) * a0[1] + bfhi(pp.x), bflo(gg.y) * a0[2] + bflo(pp.y), bfhi(gg.y) * a0[3] + bfhi(pp.y)};
                    const f32x4 y1 = (f32x4){bflo(gg.z) * a1[0] + bflo(pp.z), bfhi(gg.z) * a1[1] + bfhi(pp.z), bflo(gg.w) * a1[2] + bflo(pp.w), bfhi(gg.w) * a1[3] + bfhi(pp.w)};
                    st_bf16x8(O + o, y0, y1); }
        }
    }
};
struct EpiResid {
    const float* x; float* out;
    __device__ __forceinline__ void operator()(const f32x4 (&acc)[2][2][4][2], const pg8::Unit& u, int wr, int wc, int fr, int fq) const {
        const int row0 = u.pm * 256 + wr * 64 + fr, col0 = u.pn * 256 + wc * 32 + 8 * fq;
#pragma unroll
        for (int ai = 0; ai < 2; ++ai)
#pragma unroll
            for (int mh = 0; mh < 2; ++mh) {
                f32x4 xv[2][2][2];
#pragma unroll
                for (int mm = 0; mm < 2; ++mm)
#pragma unroll
                    EPI_COLS(bj, n) xv[mm][bj][n] = *(const f32x4*)(x + (size_t)(row0 + ai * 128 + (2 * mh + mm) * 16) * DM + col0 + bj * 128 + n * 4);
#pragma unroll
                for (int mm = 0; mm < 2; ++mm)
#pragma unroll
                    EPI_COLS(bj, n) *(f32x4*)(out + (size_t)(row0 + ai * 128 + (2 * mh + mm) * 16) * DM + col0 + bj * 128 + n * 4) = xv[mm][bj][n] + acc[ai][bj][2 * mh + mm][n];
            }
    }
};
struct EpiSwiglu {
    unsigned char* ws; const float* bug; MoeTables T; const LAS float* rowv;
    __device__ __forceinline__ void operator()(const f32x4 (&acc)[2][2][4][2], const pg8::Unit& u, int wr, int wc, int fr, int fq) const {
        const int e = u.z, n_e = __builtin_amdgcn_readfirstlane(T.cnt[e]), rloc0 = u.pm * 256 + wr * 64 + fr, row0 = __builtin_amdgcn_readfirstlane(T.tbase[e]) * 256 + rloc0, col0 = u.pn * 128 + wc * 32 + 8 * fq;
        const float* bp = bug + (size_t)e * 2 * DFF + col0; bf16_t* O = wsp<bf16_t>(ws, WS_ACT); const LAS float* rg = rowv + u.ord * 256 + wr * 64 + fr;
        f32x4 bg[2], bu[2];
#pragma unroll
        for (int n = 0; n < 2; ++n) { bg[n] = *(const f32x4*)(bp + n * 4); bu[n] = *(const f32x4*)(bp + DFF + n * 4) + 1.0f; }
        float rvs[2][4];
#pragma unroll
        EPI_ROWS(ai, m) rvs[ai][m] = rg[ai * 128 + m * 16];
        bf16_t* const sink = wsp<bf16_t>(ws, WS_DUMMY) + col0;
#pragma unroll
        EPI_ROWS(ai, m) { const int rl = rloc0 + ai * 128 + m * 16; bf16_t* rp = (rl < n_e) ? O + (size_t)(row0 + ai * 128 + m * 16) * DFF + col0 : sink; const float rv = rvs[ai][m];
                f32x4 y[2];
#pragma unroll
                for (int n = 0; n < 2; ++n) { const f32x2_t rv2 = {rv, rv}; f32x2_t yh[2];
#pragma unroll
                    for (int hh = 0; hh < 2; ++hh) { const f32x4 ag = acc[ai][0][m][n], au = acc[ai][1][m][n];
                        f32x2_t g = (hh ? hi2(ag) : lo2(ag)) * rv2 + (hh ? hi2(bg[n]) : lo2(bg[n])), u1 = (hh ? hi2(au) : lo2(au)) * rv2 + (hh ? hi2(bu[n]) : lo2(bu[n]));
                        g.x = fminf(g.x, 7.0f); g.y = fminf(g.y, 7.0f); u1.x = __builtin_amdgcn_fmed3f(u1.x, -6.0f, 8.0f); u1.y = __builtin_amdgcn_fmed3f(u1.y, -6.0f, 8.0f);
                        yh[hh] = (u1 * g) * rcp1pexp2_2(g, -1.702f * LOG2E); }
                    y[n] = cat2(yh[0], yh[1]); }
                st_bf16x8(rp, y[0], y[1]); }
    }
};
struct EpiDown {
    unsigned char* ws; const float* bd; MoeTables T; const LAS float* rowv;
    __device__ __forceinline__ void operator()(const f32x4 (&acc)[2][2][4][2], const pg8::Unit& u, int wr, int wc, int fr, int fq) const {
        const int e = u.z, n_e = __builtin_amdgcn_readfirstlane(T.cnt[e]), rloc0 = u.pm * 256 + wr * 64 + fr, row0 = __builtin_amdgcn_readfirstlane(T.tbase[e]) * 256 + rloc0, col0 = u.pn * 256 + wc * 32 + 8 * fq;
        const float* bp = bd + (size_t)e * DM + col0; bf16_t* O = wsp<bf16_t>(ws, WS_YP); const LAS float* lg = rowv + u.ord * 256 + wr * 64 + fr;
        f32x4 bv[2][2];
#pragma unroll
        EPI_COLS(bj, n) bv[bj][n] = *(const f32x4*)(bp + bj * 128 + n * 4);
        float gts[2][4];
#pragma unroll
        EPI_ROWS(ai, m) gts[ai][m] = lg[ai * 128 + m * 16];
        bf16_t* const sink = wsp<bf16_t>(ws, WS_DUMMY) + col0;
#pragma unroll
        EPI_ROWS(ai, m) { const int rl = rloc0 + ai * 128 + m * 16; const float gt = gts[ai][m]; bf16_t* rp = (rl < n_e) ? O + (size_t)(row0 + ai * 128 + m * 16) * DM + col0 : sink;
#pragma unroll
                for (int bj = 0; bj < 2; ++bj) st_bf16x8(rp + bj * 128, (acc[ai][bj][m][0] + bv[bj][0]) * gt, (acc[ai][bj][m][1] + bv[bj][1]) * gt); }
    }
};

constexpr int IKBLK = 65;
__device__ __forceinline__ size_t ikf_off(int b, int p, int dim) { return ((((size_t)(b * IKBLK + (p >> 5)) * 4 + (dim >> 4)) * 64 + (((dim >> 3) & 1) * 32 + (p & 31))) * 8 + (dim & 7)); }
template <int NT>
__device__ __forceinline__ void wave_mm16(const bf16_t* __restrict__ A, int lda, const bf16_t* const (&Bt)[NT], int K, int lane, f32x4 (&acc)[NT]) {
    const bf16_t* ap = A + (size_t)(lane & 15) * lda + 8 * (lane >> 4);
    const bf16_t* bp[NT];
#pragma unroll
    for (int t = 0; t < NT; ++t) { bp[t] = Bt[t] + (size_t)(lane & 15) * K + 8 * (lane >> 4); acc[t] = (f32x4){0.f, 0.f, 0.f, 0.f}; }
#pragma unroll (NT == 1 ? 16 : 8)
    for (int k0 = 0; k0 < K; k0 += 32) {
        const bf16x8 a = *(const bf16x8*)(ap + k0);
#pragma unroll
        for (int t = 0; t < NT; ++t) { const bf16x8 b = *(const bf16x8*)(bp[t] + k0); acc[t] = __builtin_amdgcn_mfma_f32_16x16x32_bf16(b, a, acc[t], 0, 0, 0); }
    }
}
__device__ __forceinline__ void p1_thin(Frame& F, int dbgflags) {
    unsigned char* ws = F.ws;
    const bf16_t* WIN = wsp<bf16_t>(ws, WS_WIN); const bf16_t* XN = wsp<bf16_t>(ws, WS_XN); const bf16_t* XNM = wsp<bf16_t>(ws, WS_XNM);
    bf16_t* KB = wsp<bf16_t>(ws, WS_KB); bf16_t* VT = wsp<bf16_t>(ws, WS_VT); bf16_t* IK = wsp<bf16_t>(ws, WS_IK); bf16_t* GLU = wsp<bf16_t>(ws, WS_GLU); float* IW = wsp<float>(ws, WS_IW);
    const int gw = F.bid * NWAVES + F.wave, NGW = F.G * NWAVES, lane = F.lane, tk = lane & 15, nq = lane >> 4;
    {
        constexpr int WBP = 2064;
        LAS unsigned char* lds = F.lds;
        __syncthreads();
        { const unsigned char* src = (const unsigned char*)(WIN + (size_t)WR_IK * DM);
          for (int p = F.tid; p < 72 * 128; p += NTHREADS) { const int row = p >> 7, c16 = p & 127; *(LAS u32x4*)(lds + row * WBP + c16 * 16) = *(const u32x4*)(src + (size_t)row * DM * 2 + c16 * 16); } }
        __syncthreads();
        const int tg = F.wave & 3, hf = F.wave >> 2, kq = nq;
        for (int tb = F.bid; tb < NTOK / 64; tb += F.G) {
            const int m = tb * 64 + 16 * tg + tk, rowk = m + NMETA * ((m >> 11) + 1);
            const bf16_t* xr = XN + (size_t)m * DM + 16 * kq;
            bf16x8 xa[16], xb[16];
#pragma unroll
            for (int sblk = 0; sblk < 16; ++sblk) { xa[sblk] = *(const bf16x8*)(xr + 64 * sblk); xb[sblk] = *(const bf16x8*)(xr + 64 * sblk + 8); }
            const LAS unsigned char* wb = lds + tk * WBP + 32 * kq;
            if (hf == 0) {
                f32x4 acc[3] = {{0.f, 0.f, 0.f, 0.f}, {0.f, 0.f, 0.f, 0.f}, {0.f, 0.f, 0.f, 0.f}};
#pragma unroll
                for (int sblk = 0; sblk < 16; ++sblk)
#pragma unroll
                    for (int t = 0; t < 3; ++t) { const bf16x8 b0 = *(const LAS bf16x8*)(wb + 16 * t * WBP + 128 * sblk), b1 = *(const LAS bf16x8*)(wb + 16 * t * WBP + 128 * sblk + 16);
                        acc[t] = __builtin_amdgcn_mfma_f32_16x16x32_bf16(b0, xa[sblk], acc[t], 0, 0, 0); acc[t] = __builtin_amdgcn_mfma_f32_16x16x32_bf16(b1, xb[sblk], acc[t], 0, 0, 0); }
#pragma unroll
                for (int t = 0; t < 3; ++t) st_bf16x4(IK + ikf_off(m >> 11, NMETA + (m & (SEQ - 1)), 16 * t + 4 * nq), acc[t]);
            } else {
                f32x4 acc[2] = {{0.f, 0.f, 0.f, 0.f}, {0.f, 0.f, 0.f, 0.f}};
#pragma unroll
                for (int sblk = 0; sblk < 16; ++sblk)
#pragma unroll
                    for (int t = 0; t < 2; ++t) { const bf16x8 b0 = *(const LAS bf16x8*)(wb + 16 * (3 + t) * WBP + 128 * sblk), b1 = *(const LAS bf16x8*)(wb + 16 * (3 + t) * WBP + 128 * sblk + 16);
                        acc[t] = __builtin_amdgcn_mfma_f32_16x16x32_bf16(b0, xa[sblk], acc[t], 0, 0, 0); acc[t] = __builtin_amdgcn_mfma_f32_16x16x32_bf16(b1, xb[sblk], acc[t], 0, 0, 0); }
                st_bf16x4(IK + ikf_off(m >> 11, NMETA + (m & (SEQ - 1)), 48 + 4 * nq), acc[0]);
                if (nq < 2) *(f32x4*)(IW + (size_t)m * 8 + 4 * nq) = acc[1];
            }
        }
        __syncthreads();
    }
    if (!(dbgflags & 256)) for (int task = gw; task < 100; task += NGW) {
        if (task < 32) {
            const bf16_t* const Bt[1] = {WIN + (size_t)(SC_K + 16 * task) * DM}; f32x4 acc[1]; wave_mm16<1>(XNM, DM, Bt, DM, lane, acc);
            for (int b = 0; b < NB; ++b) st_bf16x4(KB + (size_t)(b * TT + tk) * AW + 16 * task + 4 * nq, acc[0]);
        } else if (task < 64) {
            const int t = task - 32; const bf16_t* const Bt[1] = {WIN + (size_t)(SC_V + 16 * t) * DM}; f32x4 acc[1]; wave_mm16<1>(XNM, DM, Bt, DM, lane, acc);
            const float p0 = __shfl_xor(acc[0][0], 1), p1 = __shfl_xor(acc[0][1], 1), p2 = __shfl_xor(acc[0][2], 1), p3 = __shfl_xor(acc[0][3], 1);
            const unsigned wa = (tk & 1) ? cvt_pk_bf16(p2, acc[0][2]) : cvt_pk_bf16(acc[0][0], p0), wb = (tk & 1) ? cvt_pk_bf16(p3, acc[0][3]) : cvt_pk_bf16(acc[0][1], p1);
            for (int b = 0; b < NB; ++b) { bf16_t* cp = VT + ((size_t)b * AW + 16 * t + 4 * nq + 2 * (tk & 1)) * TP + VOFF + (tk & ~1);
                *(unsigned*)cp = wa; *(unsigned*)(cp + TP) = wb; }
        } else if (task < 68) {
            const int t = task - 64; const bf16_t* const Bt[1] = {WIN + (size_t)(WR_IK + 16 * t) * DM}; f32x4 acc[1]; wave_mm16<1>(XNM, DM, Bt, DM, lane, acc);
            for (int b = 0; b < NB; ++b) st_bf16x4(IK + ikf_off(b, tk, 16 * t + 4 * nq), acc[0]);
        } else {
            const int c16 = task - 68; const int ar = WR_GLU + 256 * (c16 >> 3) + 16 * (c16 & 7);
            const bf16_t* const Bt[2] = {WIN + (size_t)ar * DM, WIN + (size_t)(ar + 128) * DM}; f32x4 acc[2]; wave_mm16<2>(XNM, DM, Bt, DM, lane, acc);
            f32x4 y;
#pragma unroll
            for (int j = 0; j < 4; ++j) y[j] = acc[0][j] * sigmoidf_(acc[1][j]);
            for (int b = 0; b < NB; ++b) st_bf16x4(GLU + (size_t)(b * TT + tk) * CC + 16 * c16 + 4 * nq, y);
        }
    }
}

__device__ __forceinline__ void p2_conv(Frame& F, const Args& a) {
    unsigned char* ws = F.ws;
    LAS unsigned char* xs = F.lds;
    LAS float* wl = (LAS float*)(F.lds + 63488);
    const bf16_t* GLU = wsp<bf16_t>(ws, WS_GLU); bf16_t* CO = wsp<bf16_t>(ws, WS_CO);
    const float* cw = a.in[I_CONVW];
    for (int idx = F.tid; idx < CW * 128; idx += NTHREADS) { const int tap = idx >> 7, c4 = idx & 127; const f32x4 v = *(const f32x4*)(cw + tap * CC + 4 * c4); *(LAS f32x4*)(wl + tap * 512 + (c4 & 1) * 256 + (c4 >> 1) * 4) = v; }
    const int lane = F.lane, c0 = 8 * lane;
    for (int tile = F.bid; tile < NTOK / 32; tile += F.G) {
        const int b = tile >> 6, s0 = (tile & 63) * 32, p0 = NMETA + s0;
        __syncthreads();
        for (int idx = F.tid; idx < 62 * 64; idx += NTHREADS) { const int r = idx >> 6, ch = idx & 63, p = p0 - 30 + r; u32x4 v = (u32x4){0u, 0u, 0u, 0u};
            if (p >= 0) v = *(const u32x4*)(GLU + (size_t)(b * TT + p) * CC + ch * 8);
            *(LAS u32x4*)(xs + r * 1024 + ch * 16) = v; }
        __syncthreads();
        const int i0 = 4 * F.wave;
        float acc[4][8];
#pragma unroll
        for (int t = 0; t < 4; ++t)
#pragma unroll
            for (int i = 0; i < 8; ++i) acc[t][i] = 0.f;
        const LAS float* wlb = wl + lane * 4; asm volatile("" : "+v"(wlb));
        const LAS unsigned char* xsb = xs + i0 * 1024 + lane * 16; asm volatile("" : "+v"(xsb));
#pragma unroll 1
        for (int tap = 0; tap < CW; ++tap) {
            const f32x4 w0 = *(const LAS f32x4*)(wlb + tap * 512), w1 = *(const LAS f32x4*)(wlb + tap * 512 + 256);
#pragma unroll
            for (int t = 0; t < 4; ++t) {
                const u32x4 xv = *(const LAS u32x4*)(xsb + (tap + t) * 1024);
                acc[t][0] += w0[0] * bflo(xv.x); acc[t][1] += w0[1] * bfhi(xv.x); acc[t][2] += w0[2] * bflo(xv.y); acc[t][3] += w0[3] * bfhi(xv.y);
                acc[t][4] += w1[0] * bflo(xv.z); acc[t][5] += w1[1] * bfhi(xv.z); acc[t][6] += w1[2] * bflo(xv.w); acc[t][7] += w1[3] * bfhi(xv.w);
            }
        }
        float cb[8], lg[8], lb[8];
        { const f32x4* p0 = (const f32x4*)(a.in[I_CONVB] + c0); const f32x4* p1 = (const f32x4*)(a.in[I_LNG] + c0); const f32x4* p2 = (const f32x4*)(a.in[I_LNB] + c0);
#pragma unroll
          for (int hh = 0; hh < 2; ++hh) { const f32x4 u0 = p0[hh], u1 = p1[hh], u2 = p2[hh];
#pragma unroll
              for (int i = 0; i < 4; ++i) { cb[4 * hh + i] = u0[i]; lg[4 * hh + i] = u1[i]; lb[4 * hh + i] = u2[i]; } } }
#pragma unroll
        for (int t = 0; t < 4; ++t) {
            float s = 0.f;
#pragma unroll
            for (int i = 0; i < 8; ++i) { acc[t][i] += cb[i]; s += acc[t][i]; }
            const float mean = wave_sum(s) * (1.f / CC); float q = 0.f;
#pragma unroll
            for (int i = 0; i < 8; ++i) { acc[t][i] -= mean; q += acc[t][i] * acc[t][i]; }
            const float rstd = 1.0f / sqrtf(wave_sum(q) * (1.f / CC) + EPS);
            float y[8];
#pragma unroll
            for (int i = 0; i < 8; ++i) { const float z = acc[t][i] * rstd * lg[i] + lb[i]; y[i] = z * sigmoidf_(z); }
            u32x4 o; o.x = cvt_pk_bf16(y[0], y[1]); o.y = cvt_pk_bf16(y[2], y[3]); o.z = cvt_pk_bf16(y[4], y[5]); o.w = cvt_pk_bf16(y[6], y[7]);
            *(u32x4*)(CO + (size_t)(b * SEQ + s0 + i0 + t) * CC + c0) = o;
        }
    }
    __syncthreads();
}

constexpr int ROWP = 2080, NJ = 33;
__device__ __forceinline__ unsigned f2ord(float f) { const unsigned b = __float_as_uint(f); return b ^ ((b >> 31) ? 0xffffffffu : 0x80000000u); }
__device__ __forceinline__ int wave_isum(int v) {
#pragma unroll
    for (int o = 1; o < 64; o <<= 1) v += __shfl_xor(v, o);
    return v;
}
__device__ __forceinline__ int wave_isum_dpp(int v) {
    v += __builtin_amdgcn_update_dpp(0, v, 0xB1, 0xF, 0xF, false);
    v += __builtin_amdgcn_update_dpp(0, v, 0x4E, 0xF, 0xF, false);
    v += __builtin_amdgcn_update_dpp(0, v, 0x141, 0xF, 0xF, false);
    v += __builtin_amdgcn_update_dpp(0, v, 0x140, 0xF, 0xF, false);
    return __builtin_amdgcn_readlane(v, 0) + __builtin_amdgcn_readlane(v, 16) + __builtin_amdgcn_readlane(v, 32) + __builtin_amdgcn_readlane(v, 48);
}
__device__ __forceinline__ void p2_indexer_unit(Frame& F, int b, int q16, int flags) {
    unsigned char* ws = F.ws;
    const bf16_t* IQ = wsp<bf16_t>(ws, WS_IQ); const bf16_t* IK = wsp<bf16_t>(ws, WS_IK); const float* IW = wsp<float>(ws, WS_IW); unsigned* MASK = wsp<unsigned>(ws, WS_MASK);
    LAS unsigned* SU = (LAS unsigned*)F.lds;
    const int lane = F.lane, c = lane & 31, hi = lane >> 5, w = F.wave;
    const int nwblk = (q16 >> 1) + 2;
    if (!(flags & 4)) {
        const int tok0 = b * SEQ + 16 * q16;
        bf16x8 af[4][4]; f32x4 wq[4][4];
#pragma unroll
        for (int g = 0; g < 4; ++g) {
            const bf16_t* ap = IQ + (size_t)(tok0 + 4 * g + (c >> 3)) * AW + (c & 7) * IDXD + 8 * hi;
#pragma unroll
            for (int ks = 0; ks < 4; ++ks) af[g][ks] = *(const bf16x8*)(ap + 16 * ks);
#pragma unroll
            for (int q = 0; q < 4; ++q) wq[g][q] = *(const f32x4*)(IW + (size_t)(tok0 + 4 * g + q) * 8 + 4 * hi);
        }
        const int rel0 = NMETA + 16 * q16 + 2 * hi - c;
        const bf16_t* kp = IK + (size_t)b * IKBLK * 2048 + lane * 8;
        LAS unsigned* srow = SU + (2 * hi) * ROWP + c;
        bf16x8 bfr[4], bnx[4];
#pragma unroll
        for (int ks = 0; ks < 4; ++ks) { bfr[ks] = *(const bf16x8*)(kp + (size_t)(w < nwblk ? w : 0) * 2048 + 512 * ks); bnx[ks] = bfr[ks]; }
#pragma unroll
        for (int g = 0; g < 4; ++g) asm volatile("" :: "v"(af[g][0]), "v"(af[g][1]), "v"(af[g][2]), "v"(af[g][3]), "v"(wq[g][0]), "v"(wq[g][1]), "v"(wq[g][2]), "v"(wq[g][3]));
        asm volatile("" :: "v"(bfr[0]), "v"(bfr[1]), "v"(bfr[2]), "v"(bfr[3]));
        for (int blk = w; blk < nwblk; blk += 8) {
            {
                const int bn_ = blk + 8 < nwblk ? blk + 8 : blk;
#pragma unroll
                for (int ks = 0; ks < 4; ++ks) bnx[ks] = *(const bf16x8*)(kp + (size_t)bn_ * 2048 + 512 * ks); }
#pragma unroll
            for (int g = 0; g < 4; ++g) {
                f32x16 acc = {};
#pragma unroll
                for (int ks = 0; ks < 4; ++ks) acc = __builtin_amdgcn_mfma_f32_32x32x16_bf16(af[g][ks], bfr[ks], acc, 0, 0, 0);
                float part[4];
#pragma unroll
                for (int q = 0; q < 4; ++q) { float s = wq[g][q][0] * __builtin_amdgcn_fmed3f(acc[4 * q], 0.f, INFINITY);
#pragma unroll
                    for (int i = 1; i < 4; ++i) s = __builtin_fmaf(wq[g][q][i], __builtin_amdgcn_fmed3f(acc[4 * q + i], 0.f, INFINITY), s);
                    part[q] = s; }
#pragma unroll
                for (int p = 0; p < 2; ++p) {
                    const auto rr = __builtin_amdgcn_permlane32_swap(__float_as_uint(part[p]), __float_as_uint(part[p + 2]), false, false);
                    const float sc = __uint_as_float(rr[0]) + __uint_as_float(rr[1]);
                    srow[(4 * g + p) * ROWP + 32 * blk] = (32 * blk <= rel0 + 4 * g + p) ? f2ord(sc) : 0u; }
            }
#pragma unroll
            for (int ks = 0; ks < 4; ++ks) bfr[ks] = bnx[ks];
        }
    }
    __syncthreads();
    if (!(flags & 8)) {
        const int nj = (nwblk + 1) >> 1, klim = 32 * nwblk;
        unsigned U[NJ][2];
#pragma unroll
        for (int j = 0; j < NJ; ++j) {
            if (j < nj) { const int key = 64 * j + lane;
#pragma unroll
                for (int p = 0; p < 2; ++p) U[j][p] = (key < klim) ? SU[(2 * w + p) * ROWP + key] : 0u; }
            else { U[j][0] = 0u; U[j][1] = 0u; }
        }
        const int tokb = b * SEQ + 16 * q16 + 2 * w;
        unsigned lo[2], hb[2], thr[2], veq[2]; int chi[2], need[2]; bool done[2];
#pragma unroll
        for (int p = 0; p < 2; ++p) { lo[p] = 1u; hb[p] = 0xffffffffu; chi[p] = 0; need[p] = 0; veq[p] = 0u; thr[p] = 1u; done[p] = (NMETA + 16 * q16 + 2 * w + p + 1 <= TOPK); }
        for (int it = 0; it < 34; ++it) {
            if (done[0] && done[1]) break;
            unsigned mid[2]; int cl[2];
#pragma unroll
            for (int p = 0; p < 2; ++p) { mid[p] = lo[p] + ((hb[p] - lo[p]) >> 1); cl[p] = 0; }
#pragma unroll
            for (int g = 0; g < 3; ++g) if (11 * g < nj) {
#pragma unroll
                for (int jj = 0; jj < 11; ++jj)
#pragma unroll
                    for (int p = 0; p < 2; ++p) cl[p] += (U[11 * g + jj][p] >= mid[p]) ? 1 : 0; }
            const int tot = wave_isum_dpp(cl[0] | (cl[1] << 16));
            int cnt[2] = {tot & 0xffff, tot >> 16};
#ifdef DBG_CHECK_DPP
            if (wave_isum(cl[0]) != cnt[0] || wave_isum(cl[1]) != cnt[1]) __hip_atomic_store(wsp<unsigned>(ws, WS_CTL) + 3, 1u, RLX_AGENT);
#endif
#pragma unroll
            for (int p = 0; p < 2; ++p) {
                const int ct = cnt[p];
                if (!done[p]) {
                    if (ct == TOPK) { done[p] = true; thr[p] = mid[p]; need[p] = 0; }
                    else if (ct > TOPK) lo[p] = mid[p];
                    else { hb[p] = mid[p]; chi[p] = ct; }
                    if (!done[p] && hb[p] - lo[p] == 1u) { done[p] = true; thr[p] = hb[p]; veq[p] = lo[p]; need[p] = TOPK - chi[p]; }
                }
            }
        }
#pragma unroll
        for (int p = 0; p < 2; ++p) {
            int run = 0, wlo = 0, whi = 0;
#ifdef DBG_CHECK_SEL
            int selcnt = 0;
#endif
            const bool tied = need[p] > 0;
#pragma unroll
            for (int j = 0; j < NJ; ++j) if (j < nj) {
                const unsigned u = U[j][p];
                bool take = (u >= thr[p]);
                if (tied) {
                    const bool eq = (u == veq[p]);
                    const unsigned long long em = __ballot(eq);
                    const int rank = run + (int)__builtin_amdgcn_mbcnt_hi((unsigned)(em >> 32), __builtin_amdgcn_mbcnt_lo((unsigned)em, 0u));
                    take = take || (eq && rank < need[p]);
                    run += __popcll(em);
                }
                const unsigned long long sm = __ballot(take);
                wlo = (lane == j) ? (int)(unsigned)sm : wlo; whi = (lane == j) ? (int)(unsigned)(sm >> 32) : whi;
#ifdef DBG_CHECK_SEL
                selcnt += __popcll(sm);
#endif
            }
            unsigned long long* mrow = (unsigned long long*)(MASK + (size_t)(tokb + p) * MSTR);
            if (lane < nj) mrow[lane] = ((unsigned long long)(unsigned)whi << 32) | (unsigned)wlo;
#ifdef DBG_CHECK_SEL
            { const int nv = NMETA + 16 * q16 + 2 * w + p + 1; if (selcnt != (nv < TOPK ? nv : TOPK)) __hip_atomic_store(wsp<unsigned>(ws, WS_CTL) + 3, 1u, RLX_AGENT); }
#endif
        }
    }
    __syncthreads();
}
__device__ __forceinline__ void p2_indexer(Frame& F, int flags, int half) {
    for (int i = F.bid; i < 256; i += F.G) { const int b = i >> 5, j = 2 * (i & 31);
        if (half == 0) { p2_indexer_unit(F, b, j, flags); p2_indexer_unit(F, b, 127 - j, flags); }
        else { p2_indexer_unit(F, b, j + 1, flags); p2_indexer_unit(F, b, 126 - j, flags); } }
}

__device__ const unsigned char T5B[128] = {0, 1, 2, 3, 4, 5, 6, 7, 8, 9, 10, 11, 12, 13, 14, 15, 16, 16, 16, 17, 17, 18, 18, 18, 19, 19, 19, 20, 20, 20, 20, 21, 21, 21, 21, 22, 22, 22, 22, 22, 23, 23, 23, 23, 23, 23, 24, 24, 24, 24, 24, 24, 25, 25, 25, 25, 25, 25, 25, 26, 26, 26, 26, 26, 26, 26, 26, 27, 27, 27, 27, 27, 27, 27, 27, 27, 27, 28, 28, 28, 28, 28, 28, 28, 28, 28, 28, 29, 29, 29, 29, 29, 29, 29, 29, 29, 29, 29, 29, 30, 30, 30, 30, 30, 30, 30, 30, 30, 30, 30, 30, 30, 30, 31, 31, 31, 31, 31, 31, 31, 31, 31, 31, 31, 31, 31, 31, 31};
constexpr int TBS = 132;
__device__ __forceinline__ int crow(int r, int hi) { return (r & 3) + 8 * (r >> 2) + 4 * hi; }
constexpr int KPITCH = 144, VPITCH = 136;
constexpr int AT_K = 0, AT_V = AT_K + 2 * 64 * KPITCH, AT_TB = AT_V + 2 * 64 * VPITCH, AT_SC = AT_TB + NH * TBS * 4, AT_END = AT_SC + NWAVES * 128;
static_assert(AT_END <= RING_BYTES, "attention LDS map");
__device__ __forceinline__ void p3_attn_unit(Frame& F, int b, int h, int Q) {
    unsigned char* ws = F.ws;
    const bf16_t* Qm = wsp<bf16_t>(ws, WS_Q); const bf16_t* KB = wsp<bf16_t>(ws, WS_KB); const bf16_t* VT = wsp<bf16_t>(ws, WS_VT); const unsigned* MASK = wsp<unsigned>(ws, WS_MASK); bf16_t* AO = wsp<bf16_t>(ws, WS_AO);
    LAS unsigned char* lds = F.lds;
    const LAS float* tbh = (const LAS float*)(lds + AT_TB) + h * TBS;
    LAS float* sc = (LAS float*)(lds + AT_SC) + F.wave * 32;
    const int tid = F.tid, lane = F.lane, c = lane & 31, hi = lane >> 5, w = F.wave;
    const int qb32 = 8 * Q + w, tokq = b * SEQ + 32 * qb32 + c, posq = NMETA + 32 * qb32 + c;
    const int ktmax = (47 + 32 * qb32) >> 6, NT = 4 * Q + 5;
    bf16x8 qf[4];
#pragma unroll
    for (int ks = 0; ks < 4; ++ks) qf[ks] = *(const bf16x8*)(Qm + (size_t)tokq * AW + h * HD + 16 * ks + 8 * hi);
    const unsigned long long* mrow = (const unsigned long long*)(MASK + (size_t)tokq * MSTR);
    const int srow = tid >> 3, piece = tid & 7;
    const bf16_t* kg = KB + (size_t)(b * TT + srow) * AW + h * HD + piece * 8;
    const bf16_t* vg = VT + ((size_t)b * AW + h * HD + srow) * TP + piece * 8;
    LAS unsigned char* kl = lds + AT_K + srow * KPITCH + piece * 16;
    LAS unsigned char* vl = lds + AT_V + srow * VPITCH + piece * 16;
    const LAS unsigned char* kfb = lds + AT_K + c * KPITCH + 16 * hi;
    const LAS unsigned char* vfb = lds + AT_V + c * VPITCH + 8 * hi;
    const unsigned NEGB = 0xff800000u;
    const float bfar = tbh[128];
    float m_abs = 0.f; bool has = false;
    f32x16 O0 = {}, O1 = {}, LS = {}, CI;
#pragma unroll
    for (int r = 0; r < 16; ++r) CI[r] = bfar;
    const bf16x8 ones = __builtin_bit_cast(bf16x8, ((u32x4){0x3f803f80u, 0x3f803f80u, 0x3f803f80u, 0x3f803f80u}));
    u32x4 kr = *(const u32x4*)kg, vr = *(const u32x4*)vg;
    unsigned long long mwn = mrow[0];
    *(LAS u32x4*)kl = kr; *(LAS u32x2*)vl = (u32x2){vr.x, vr.y}; *(LAS u32x2*)(vl + 8) = (u32x2){vr.z, vr.w};
    __syncthreads();
    for (int kt = 0; kt < NT; ++kt) {
        const int buf = kt & 1;
        const unsigned long long mw = mwn;
        if (kt + 1 < NT) { kr = *(const u32x4*)(kg + (size_t)(kt + 1) * 64 * AW); vr = *(const u32x4*)(vg + (kt + 1) * 64); if (kt + 1 <= ktmax) mwn = mrow[kt + 1]; }
        if (kt <= ktmax) {
            const LAS unsigned char* kp = kfb + buf * 64 * KPITCH;
            f32x16 S0 = CI, S1 = CI;
#pragma unroll
            for (int ks = 0; ks < 4; ++ks) {
                const bf16x8 k0 = *(const LAS bf16x8*)(kp + ks * 32), k1 = *(const LAS bf16x8*)(kp + 32 * KPITCH + ks * 32);
                S0 = __builtin_amdgcn_mfma_f32_32x32x16_bf16(k0, qf[ks], S0, 0, 0, 0);
                S1 = __builtin_amdgcn_mfma_f32_32x32x16_bf16(k1, qf[ks], S1, 0, 0, 0);
            }
            const int mw0 = (int)((unsigned)mw >> (4 * hi)), mw1 = (int)((unsigned)(mw >> 32) >> (4 * hi));
            const bool far = (256 * Q + 32 * w - 64 * kt) >= 175;
            if (!far) {
                const int d0 = posq - 64 * kt - 4 * hi;
#pragma unroll
                for (int r = 0; r < 16; ++r) { const int ko = (r & 3) + 8 * (r >> 2);
                    int da = d0 - ko, db = d0 - 32 - ko; da = da < 0 ? 0 : (da > 128 ? 128 : da); db = db < 0 ? 0 : (db > 128 ? 128 : db);
                    S0[r] += tbh[da] - bfar; S1[r] += tbh[db] - bfar; }
            }
            float tmax = -INFINITY;
#pragma unroll
            for (int r = 0; r < 16; ++r) { const int ko = (r & 3) + 8 * (r >> 2);
                const unsigned t0 = (unsigned)__builtin_amdgcn_sbfe(mw0, ko, 1), t1 = (unsigned)__builtin_amdgcn_sbfe(mw1, ko, 1);
                S0[r] = __uint_as_float((__float_as_uint(S0[r]) & t0) | (NEGB & ~t0)); S1[r] = __uint_as_float((__float_as_uint(S1[r]) & t1) | (NEGB & ~t1));
                tmax = fmaxf(tmax, fmaxf(S0[r], S1[r])); }
            tmax = fmaxf(tmax, __shfl_xor(tmax, 32));
            if (__any(tmax > 8.0f || (!has && tmax > -INFINITY))) {
                const bool upd = tmax > -INFINITY && (!has || tmax > 0.f);
                const float dl = upd ? tmax : 0.f;
                const float alpha = has ? __builtin_amdgcn_exp2f(-dl) : 1.0f;
                m_abs += dl; has = has || upd;
#pragma unroll
                for (int r = 0; r < 16; ++r) { S0[r] -= dl; S1[r] -= dl; CI[r] = bfar - m_abs; }
                if (hi == 0) sc[c] = alpha;
                LDS_WAIT(); asm volatile("" ::: "memory");
#pragma unroll
                for (int r = 0; r < 16; ++r) { const float f = sc[crow(r, hi)]; O0[r] *= f; O1[r] *= f; LS[r] *= f; }
                LDS_WAIT(); asm volatile("" ::: "memory");
            }
#pragma unroll
            for (int r = 0; r < 16; ++r) { S0[r] = __builtin_amdgcn_exp2f(S0[r]); S1[r] = __builtin_amdgcn_exp2f(S1[r]); }
            const LAS unsigned char* vp = vfb + buf * 64 * VPITCH;
#pragma unroll
            for (int s2 = 0; s2 < 4; ++s2) {
                u32x4 pw;
                if (s2 < 2) { const int o = 8 * (s2 & 1); pw.x = cvt_pk_bf16(S0[o + 0], S0[o + 1]); pw.y = cvt_pk_bf16(S0[o + 2], S0[o + 3]); pw.z = cvt_pk_bf16(S0[o + 4], S0[o + 5]); pw.w = cvt_pk_bf16(S0[o + 6], S0[o + 7]); }
                else { const int o = 8 * (s2 & 1); pw.x = cvt_pk_bf16(S1[o + 0], S1[o + 1]); pw.y = cvt_pk_bf16(S1[o + 2], S1[o + 3]); pw.z = cvt_pk_bf16(S1[o + 4], S1[o + 5]); pw.w = cvt_pk_bf16(S1[o + 6], S1[o + 7]); }
                const bf16x8 pf = __builtin_bit_cast(bf16x8, pw);
                const u32x2 a0 = *(const LAS u32x2*)(vp + s2 * 32), a1 = *(const LAS u32x2*)(vp + s2 * 32 + 16);
                const u32x2 b0 = *(const LAS u32x2*)(vp + 32 * VPITCH + s2 * 32), b1 = *(const LAS u32x2*)(vp + 32 * VPITCH + s2 * 32 + 16);
                const bf16x8 v0 = __builtin_bit_cast(bf16x8, ((u32x4){a0.x, a0.y, a1.x, a1.y})), v1 = __builtin_bit_cast(bf16x8, ((u32x4){b0.x, b0.y, b1.x, b1.y}));
                O0 = __builtin_amdgcn_mfma_f32_32x32x16_bf16(pf, v0, O0, 0, 0, 0);
                O1 = __builtin_amdgcn_mfma_f32_32x32x16_bf16(pf, v1, O1, 0, 0, 0);
                LS = __builtin_amdgcn_mfma_f32_32x32x16_bf16(pf, ones, LS, 0, 0, 0);
            }
        }
        if (kt + 1 < NT) { LAS unsigned char* k2 = kl + (buf ^ 1) * 64 * KPITCH; LAS unsigned char* v2 = vl + (buf ^ 1) * 64 * VPITCH;
            *(LAS u32x4*)k2 = kr; *(LAS u32x2*)v2 = (u32x2){vr.x, vr.y}; *(LAS u32x2*)(v2 + 8) = (u32x2){vr.z, vr.w}; }
        __syncthreads();
    }
    bf16_t* ob = AO + (size_t)(b * SEQ + 32 * qb32) * AW + h * HD + c;
#pragma unroll
    for (int r = 0; r < 16; ++r) { const int qr = crow(r, hi); const float f = __builtin_amdgcn_rcpf(LS[r]);
        const float a0 = O0[r] * f, a1 = O1[r] * f, b0 = __shfl_xor(a0, 1), b1 = __shfl_xor(a1, 1);
        if ((c & 1) == 0) { *(unsigned*)(ob + (size_t)qr * AW) = cvt_pk_bf16(a0, b0); *(unsigned*)(ob + (size_t)qr * AW + 32) = cvt_pk_bf16(a1, b1); } }
}
__device__ __forceinline__ void p3_attn(Frame& F, const Args& a) {
    LAS float* tb = (LAS float*)(F.lds + AT_TB);
    __syncthreads();
    for (int idx = F.tid; idx < NH * 129; idx += NTHREADS) { const int h = idx / 129, d = idx % 129; const int bk = d < 128 ? (int)T5B[d] : 31; tb[h * TBS + d] = a.in[I_RELB][bk * NH + h] * LOG2E; }
    __syncthreads();
    for (int i = F.bid; i < 256; i += F.G) { const int bh = i >> 2, j = i & 3; p3_attn_unit(F, bh >> 3, bh & 7, j); p3_attn_unit(F, bh >> 3, bh & 7, 7 - j); }
    __syncthreads();
}

constexpr int WLP = 2064;
constexpr int P6_WHI = 0, P6_WLO = NE * WLP, P6_PART = 2 * NE * WLP, P6_SSP = P6_PART + 2 * 64 * 33 * 4, P6_CNT = P6_SSP + 2 * 64 * 4, P6_END = P6_CNT + 256;
static_assert(P6_END <= LDSX_OFF, "router LDS map");
__device__ __forceinline__ void p6_router(Frame& F, const Args& a) {
    unsigned char* ws = F.ws;
    const float* H1 = wsp<float>(ws, WS_H1); bf16_t* HN = wsp<bf16_t>(ws, WS_XN);
    const float* gf = a.in[I_NFFN]; const float* brt = a.in[I_BR];
    int* TE = wsp<int>(ws, WS_TE); int* TPs = wsp<int>(ws, WS_TP); int* LIST = wsp<int>(ws, WS_LIST); float* LG = wsp<float>(ws, WS_LG); float* RG = wsp<float>(ws, WS_RG);
    unsigned* ecnt = wsp<unsigned>(ws, WS_CTL) + CW_ECNT;
    LAS unsigned char* lds = F.lds;
    LAS float* part = (LAS float*)(lds + P6_PART);
    LAS float* ssp = (LAS float*)(lds + P6_SSP);
    LAS int* lcnt = (LAS int*)(lds + P6_CNT);
    LAS int* lbase = lcnt + 32;
    const int lane = F.lane, w = F.wave, tk = lane & 15, kq = lane >> 4;
    __syncthreads();
    { const unsigned char* src = ws + WS_WRT;
      for (int p = F.tid; p < 2 * NE * 128; p += NTHREADS) { const int arr = p >> 12, row = (p >> 7) & 31, c16 = p & 127;
          *(LAS u32x4*)(lds + arr * (NE * WLP) + row * WLP + c16 * 16) = *(const u32x4*)(src + (size_t)arr * NE * DM * 2 + (size_t)row * DM * 2 + c16 * 16); } }
    for (int tb = F.bid; tb < NTOK / 64; tb += F.G) {
        const int t0 = tb * 64;
        __syncthreads();
        if (F.tid < 32) lcnt[F.tid] = 0;
        {
            const int tg = w & 3, kh = w >> 2, tok = t0 + 16 * tg + tk;
            const float* xr = H1 + (size_t)tok * DM + 512 * kh + 8 * kq; const float* gr = gf + 512 * kh + 8 * kq;
            bf16_t* hr = HN + (size_t)tok * DM + 512 * kh + 8 * kq;
            const LAS unsigned char* wl = lds + tk * WLP + (512 * kh + 8 * kq) * 2;
            f32x4 xa[16], xb[16];
#pragma unroll
            for (int ks = 0; ks < 16; ++ks) { xa[ks] = *(const f32x4*)(xr + 32 * ks); xb[ks] = *(const f32x4*)(xr + 32 * ks + 4); }
            f32x4 acc0 = {0.f, 0.f, 0.f, 0.f}, acc1 = acc0; float ss = 0.f;
#pragma unroll
            for (int ks = 0; ks < 16; ++ks) {
                const f32x4 g0 = *(const f32x4*)(gr + 32 * ks), g1 = *(const f32x4*)(gr + 32 * ks + 4);
                const f32x4 x0 = xa[ks], x1 = xb[ks];
                u32x4 hn; hn.x = cvt_pk_bf16(x0[0] * g0[0], x0[1] * g0[1]); hn.y = cvt_pk_bf16(x0[2] * g0[2], x0[3] * g0[3]); hn.z = cvt_pk_bf16(x1[0] * g1[0], x1[1] * g1[1]); hn.w = cvt_pk_bf16(x1[2] * g1[2], x1[3] * g1[3]);
                *(u32x4*)(hr + 32 * ks) = hn;
                ss += (x0[0] * x0[0] + x0[1] * x0[1]) + (x0[2] * x0[2] + x0[3] * x0[3]) + (x1[0] * x1[0] + x1[1] * x1[1]) + (x1[2] * x1[2] + x1[3] * x1[3]);
                u32x4 xh; xh.x = cvt_pk_bf16(x0[0], x0[1]); xh.y = cvt_pk_bf16(x0[2], x0[3]); xh.z = cvt_pk_bf16(x1[0], x1[1]); xh.w = cvt_pk_bf16(x1[2], x1[3]);
                u32x4 xl; xl.x = cvt_pk_bf16(x0[0] - bflo(xh.x), x0[1] - bfhi(xh.x)); xl.y = cvt_pk_bf16(x0[2] - bflo(xh.y), x0[3] - bfhi(xh.y));
                          xl.z = cvt_pk_bf16(x1[0] - bflo(xh.z), x1[1] - bfhi(xh.z)); xl.w = cvt_pk_bf16(x1[2] - bflo(xh.w), x1[3] - bfhi(xh.w));
                const bf16x8 fxh = __builtin_bit_cast(bf16x8, xh), fxl = __builtin_bit_cast(bf16x8, xl);
                const bf16x8 wh0 = *(const LAS bf16x8*)(wl + P6_WHI + ks * 64), wh1 = *(const LAS bf16x8*)(wl + P6_WHI + 16 * WLP + ks * 64);
                const bf16x8 wl0 = *(const LAS bf16x8*)(wl + P6_WLO + ks * 64), wl1 = *(const LAS bf16x8*)(wl + P6_WLO + 16 * WLP + ks * 64);
                acc0 = __builtin_amdgcn_mfma_f32_16x16x32_bf16(wh0, fxh, acc0, 0, 0, 0); acc1 = __builtin_amdgcn_mfma_f32_16x16x32_bf16(wh1, fxh, acc1, 0, 0, 0);
                acc0 = __builtin_amdgcn_mfma_f32_16x16x32_bf16(wl0, fxh, acc0, 0, 0, 0); acc1 = __builtin_amdgcn_mfma_f32_16x16x32_bf16(wl1, fxh, acc1, 0, 0, 0);
                acc0 = __builtin_amdgcn_mfma_f32_16x16x32_bf16(wh0, fxl, acc0, 0, 0, 0); acc1 = __builtin_amdgcn_mfma_f32_16x16x32_bf16(wh1, fxl, acc1, 0, 0, 0);
            }
            ss += __shfl_xor(ss, 16); ss += __shfl_xor(ss, 32);
            LAS float* pp = part + ((kh * 64) + 16 * tg + tk) * 33 + 4 * kq;
#pragma unroll
            for (int r = 0; r < 4; ++r) { pp[r] = acc0[r]; pp[16 + r] = acc1[r]; }
            if (kq == 0) ssp[kh * 64 + 16 * tg + tk] = ss;
        }
        __syncthreads();
        if (w == 0) {
            const float rinv = 1.0f / sqrtf((ssp[lane] + ssp[64 + lane]) * (1.f / DM) + EPS);
            float lg[NE];
#pragma unroll
            for (int e = 0; e < NE; ++e) lg[e] = (part[lane * 33 + e] + part[(64 + lane) * 33 + e]) * rinv + brt[e];
            int sel[4]; float val[4];
#pragma unroll
            for (int j = 0; j < 4; ++j) { float best = -INFINITY; int bi = 0;
#pragma unroll
                for (int e = 0; e < NE; ++e) { const bool tk_ = lg[e] > best; best = tk_ ? lg[e] : best; bi = tk_ ? e : bi; }
                sel[j] = bi; val[j] = best;
#pragma unroll
                for (int e = 0; e < NE; ++e) lg[e] = (e == bi) ? -INFINITY : lg[e]; }
            float den = 0.f, ex[4];
#pragma unroll
            for (int j = 0; j < 4; ++j) { ex[j] = __expf(val[j] - val[0]); den += ex[j]; }
            int slot[4];
#pragma unroll
            for (int j = 0; j < 4; ++j) slot[j] = __hip_atomic_fetch_add(&lcnt[sel[j]], 1, __ATOMIC_RELAXED, __HIP_MEMORY_SCOPE_WORKGROUP);
            LDS_WAIT();
            if (lane < 32) { const int n = lcnt[lane]; lbase[lane] = n ? (int)__hip_atomic_fetch_add(ecnt + 64 * lane, (unsigned)n, RLX_AGENT) : 0; }
            LDS_WAIT(); asm volatile("" ::: "memory");
            const int t = t0 + lane;
#pragma unroll
            for (int j = 0; j < 4; ++j) { const int e = sel[j], pos = lbase[e] + slot[j]; const float g = ex[j] / den;
                TE[t * 4 + j] = e; TPs[t * 4 + j] = pos; LIST[(size_t)e * NTOK + pos] = t; LG[(size_t)e * NTOK + pos] = g; RG[(size_t)e * NTOK + pos] = rinv; }
        }
    }
    __syncthreads();
}
__device__ __forceinline__ void moe_tables(Frame& F, LAS int* cnt, LAS int* tbase) {
    const unsigned* ecnt = wsp<unsigned>(F.ws, WS_CTL) + CW_ECNT;
    __syncthreads();
    if (F.tid < NE) cnt[F.tid] = (int)__hip_atomic_load(ecnt + 64 * F.tid, RLX_AGENT);
    __syncthreads();
    if (F.tid == 0) { int s = 0; for (int e = 0; e < NE; ++e) { tbase[e] = s; s += (cnt[e] + 255) >> 8; } tbase[NE] = s; }
    __syncthreads();
}

__device__ __forceinline__ void p9_final(Frame& F, const Args& a, const LAS int* tbase) {
    unsigned char* ws = F.ws;
    const float* H1 = wsp<float>(ws, WS_H1); float* OUT = a.out; const bf16_t* YP = wsp<bf16_t>(ws, WS_YP); const int* TE = wsp<int>(ws, WS_TE); const int* TPs = wsp<int>(ws, WS_TP); const float* gf = a.in[I_NFIN];
    const int gw = F.bid * NWAVES + F.wave, NGW = F.G * NWAVES, lane = F.lane;
    const f32x4* gr = (const f32x4*)gf + lane;
    f32x4 gg[4];
#pragma unroll
    for (int j = 0; j < 4; ++j) gg[j] = gr[64 * j];
#ifdef DBG_CHECK_DPP
    if (__hip_atomic_load(wsp<unsigned>(ws, WS_CTL) + 3, RLX_AGENT) != 0u) { const float qn = __builtin_nanf("");
#pragma unroll
        for (int j = 0; j < 4; ++j) gg[j] = (f32x4){qn, qn, qn, qn}; }
#endif
    for (int base = 0; base < NTOK; base += 8 * NGW) {
        int myrow = 0;
        { const int i = lane >> 2, j = lane & 3, t = base + gw + NGW * i; if (lane < 32 && t < NTOK) { const int e = TE[t * 4 + j], pos = TPs[t * 4 + j]; myrow = tbase[e] * 256 + pos; } }
        f32x4 va[4], vb[4]; u32x2 ya[4][4], yb[4][4];
#define P9_LOAD(i, V, Y) do { const int t_ = base + gw + NGW * (i); if (t_ < NTOK) { const f32x4* xr_ = (const f32x4*)(H1 + (size_t)t_ * DM) + lane; \
            _Pragma("unroll") for (int j_ = 0; j_ < 4; ++j_) V[j_] = xr_[64 * j_]; \
            _Pragma("unroll") for (int q_ = 0; q_ < 4; ++q_) { const int row_ = __builtin_amdgcn_readlane(myrow, 4 * (i) + q_); const u32x2* yr_ = (const u32x2*)(YP + (size_t)row_ * DM) + lane; \
                _Pragma("unroll") for (int j_ = 0; j_ < 4; ++j_) Y[q_][j_] = yr_[64 * j_]; } } } while (0)
#define P9_PROC(i, V, Y) do { const int t_ = base + gw + NGW * (i); if (t_ < NTOK) { \
            _Pragma("unroll") for (int q_ = 0; q_ < 4; ++q_) _Pragma("unroll") for (int j_ = 0; j_ < 4; ++j_) { const u32x2 y_ = Y[q_][j_]; V[j_].x += bflo(y_.x); V[j_].y += bfhi(y_.x); V[j_].z += bflo(y_.y); V[j_].w += bfhi(y_.y); } \
            float s_ = 0.f; _Pragma("unroll") for (int j_ = 0; j_ < 4; ++j_) s_ += (V[j_].x * V[j_].x + V[j_].y * V[j_].y) + (V[j_].z * V[j_].z + V[j_].w * V[j_].w); \
            const float r_ = 1.0f / sqrtf(wave_sum(s_) * (1.f / DM) + EPS); f32x4* xo_ = (f32x4*)(OUT + (size_t)t_ * DM) + lane; \
            _Pragma("unroll") for (int j_ = 0; j_ < 4; ++j_) xo_[64 * j_] = (f32x4){V[j_].x * r_ * gg[j_].x, V[j_].y * r_ * gg[j_].y, V[j_].z * r_ * gg[j_].z, V[j_].w * r_ * gg[j_].w}; } } while (0)
        P9_LOAD(0, va, ya);
#pragma unroll
        for (int i = 0; i < 8; i += 2) {
            P9_LOAD(i + 1, vb, yb);
            P9_PROC(i, va, ya);
            if (i + 2 < 8) P9_LOAD(i + 2, va, ya);
            P9_PROC(i + 1, vb, yb);
        }
#undef P9_LOAD
#undef P9_PROC
    }
}

constexpr int N_PHASES = 10;
__global__ void __launch_bounds__(NTHREADS, 2) fwd_kernel(Args args) {
    extern __shared__ __attribute__((aligned(16))) unsigned char lds_raw[];
    Frame F;
    F.lds = (LAS unsigned char*)lds_raw; F.ws = args.ws;
    F.tid = threadIdx.x; F.lane = F.tid & 63; F.wave = __builtin_amdgcn_readfirstlane(F.tid >> 6);
    F.G = gridDim.x; F.bid = blockIdx.x;
    volatile LAS unsigned* MISC = (volatile LAS unsigned*)(F.lds + MISC_OFF);
    if (F.tid < 32) MISC[F.tid] = 0u;
    __syncthreads();
    unsigned* ctl = wsp<unsigned>(args.ws, WS_CTL);
    const int lo = args.ph_lo, hi = args.ph_hi;
    const bool multi = (hi - lo) > 1;
    XcdBarrier bar; bar.bar = ctl + CW_BAR; bar.x = 0; bar.st = nullptr;
    if (multi) bar = xcd_barrier_post(ctl + CW_BAR, MISC + 8);
#ifndef PHASE_MASK
#define PHASE_MASK 0x3ff
#endif
#define IN(k) (((PHASE_MASK >> (k)) & 1) && lo <= (k) && (k) < hi)
#define SEAM(k) do { if (IN(k) && IN((k) + 1)) xcd_barrier(bar); } while (0)
    LAS int* l_cnt = (LAS int*)(F.lds + LDSX_OFF); LAS int* l_tbase = l_cnt + 64;
    const MoeTables MT{l_cnt, l_tbase};

    if (IN(0)) { p0_prologue(F, args, 0); } SEAM(0);
    if (IN(1)) {
        PlainSched S; S.init(args.ws, WS_XN, WS_WIN, NTOK, 5120, DM, F.G, F.bid);
        EpiInProj E{args.ws, args.in[I_BGATE]};
        if (!(args.flags & 64)) pg8::gemm_phase<EpiInProj, PlainSched>(F.lds, DM, S, E);
        if (!(args.flags & 128)) p1_thin(F, args.flags);
    } SEAM(1);
    if (IN(2)) {
        const int cvt_slot = (F.bid >> 3) % 3;
        if (cvt_slot == 0 && !(args.flags & 1024)) { p0_prologue(F, args, 1); __syncthreads(); }
        if (!(args.flags & 1)) p2_conv(F, args);
        if (!(args.flags & 2)) p2_indexer(F, args.flags, 0);
        if (cvt_slot == 1 && !(args.flags & 1024)) { __syncthreads(); p0_prologue(F, args, 1); __syncthreads(); }
        if (!(args.flags & 2)) p2_indexer(F, args.flags, 1);
        if (cvt_slot == 2 && !(args.flags & 1024)) { __syncthreads(); p0_prologue(F, args, 1); }
    } SEAM(2);
    if (IN(3)) { p3_attn(F, args); } SEAM(3);
    if (IN(4)) {
        MergeSched S{(const char*)args.ws, F.G, F.bid}; EpiMerge E{args.ws};
        pg8::gemm_phase<EpiMerge, MergeSched>(F.lds, 512, S, E);
    } SEAM(4);
    if (IN(5)) {
        PlainSched S; S.init(args.ws, WS_MG, WS_WOUT, NTOK, DM, DM, F.G, F.bid);
        EpiResid E{args.in[I_X], wsp<float>(args.ws, WS_H1)};
        pg8::gemm_phase<EpiResid, PlainSched>(F.lds, DM, S, E);
    } SEAM(5);
    if (IN(6)) { p6_router(F, args); } SEAM(6);
    if (IN(7)) {
        moe_tables(F, l_cnt, l_tbase);
        MoeSched<8, true> S{(const char*)args.ws, MT, F.G, F.bid, l_tbase[NE] * 8, F.lds};
        moe_prepare(F, S, wsp<float>(args.ws, WS_RG));
        EpiSwiglu E{args.ws, args.in[I_BUG], MT, (const LAS float*)(F.lds + MOEL_ROWV)};
        pg8::gemm_phase<EpiSwiglu, MoeSched<8, true>>(F.lds, DM, S, E);
    } SEAM(7);
    if (IN(8)) {
        moe_tables(F, l_cnt, l_tbase);
        MoeSched<4, false> S{(const char*)args.ws, MT, F.G, F.bid, l_tbase[NE] * 4, F.lds};
        moe_prepare(F, S, wsp<float>(args.ws, WS_LG));
        EpiDown E{args.ws, args.in[I_BD], MT, (const LAS float*)(F.lds + MOEL_ROWV)};
        pg8::gemm_phase<EpiDown, MoeSched<4, false>>(F.lds, DFF, S, E);
    } SEAM(8);
    if (IN(9)) { moe_tables(F, l_cnt, l_tbase); p9_final(F, args, l_tbase); }
#undef IN
#undef SEAM
}

#ifdef DBG_HASH_OFF
__global__ void dbg_hash(const unsigned* __restrict__ buf, size_t nwords, unsigned* acc) {
    unsigned h = 0u;
    for (size_t i = (size_t)blockIdx.x * blockDim.x + threadIdx.x; i < nwords; i += (size_t)gridDim.x * blockDim.x) h += (buf[i] ^ (unsigned)(i * 2654435761u)) * 2246822519u + (unsigned)i;
#pragma unroll
    for (int o = 1; o < 64; o <<= 1) h += __shfl_xor(h, o);
    if ((threadIdx.x & 63) == 0) atomicAdd(acc, h);
}
__global__ void dbg_fill(float* out, size_t n, const unsigned* acc) {
    const unsigned h = *acc; const float v = (float)((h >> 7) & 0xffffu) * (1.0f / 4096.0f) + 1.0f;
    for (size_t i = (size_t)blockIdx.x * blockDim.x + threadIdx.x; i < n; i += (size_t)gridDim.x * blockDim.x) out[i] = v;
}
#endif

extern "C" void kernel_launch(void* const* d_in, const int* in_sizes, int n_in, void* d_out, int out_size, void* d_ws, size_t ws_size, hipStream_t stream) {
    static int grid = 0;
    if (grid == 0) {
        if (n_in != 21 || out_size != NTOK * DM || ws_size < WS_END) { fprintf(stderr, "kernel_launch: unexpected shapes (n_in %d, out %d, ws %zu < %zu)\n", n_in, out_size, ws_size, (size_t)WS_END); grid = -1; return; }
        int dev = 0, cus = 0, per_cu = 0;
        if (hipGetDevice(&dev) != hipSuccess || hipDeviceGetAttribute(&cus, hipDeviceAttributeMultiprocessorCount, dev) != hipSuccess) { grid = -1; return; }
        if (hipFuncSetAttribute((const void*)fwd_kernel, hipFuncAttributeMaxDynamicSharedMemorySize, LDS_BYTES) != hipSuccess) { fprintf(stderr, "kernel_launch: hipFuncSetAttribute failed\n"); grid = -1; return; }
        if (hipOccupancyMaxActiveBlocksPerMultiprocessor(&per_cu, (const void*)fwd_kernel, NTHREADS, LDS_BYTES) != hipSuccess || per_cu < 1) { fprintf(stderr, "kernel_launch: occupancy query says %d\n", per_cu); }
        (void)hipGetLastError();
        grid = cus;
    }
    if (grid < 0) return;
    (void)hipMemsetAsync((char*)d_ws + WS_CTL, 0, CTL_ZERO_BYTES, stream);
    Args a{};
    for (int i = 0; i < 21; ++i) a.in[i] = (const float*)d_in[i];
    a.out = (float*)d_out; a.ws = (unsigned char*)d_ws;
#if MK_N_LAUNCHES == 1
    a.ph_lo = 0; a.ph_hi = N_PHASES;
    hipLaunchKernelGGL(fwd_kernel, dim3(grid), dim3(NTHREADS), LDS_BYTES, stream, a);
#else
#ifndef DBG_LAST_PHASE
#define DBG_LAST_PHASE (N_PHASES - 1)
#endif
#ifndef DBG_DUP_MASK
#define DBG_DUP_MASK 0
#endif
#ifndef DBG_DUP_FLAGS
#define DBG_DUP_FLAGS 0
#endif
    for (int p = 0; p <= DBG_LAST_PHASE; ++p) { a.ph_lo = p; a.ph_hi = p + 1;
        const int nrep = ((DBG_DUP_MASK >> p) & 1) ? 2 : 1;
        for (int rep = 0; rep < nrep; ++rep) { a.flags = (nrep == 2 && rep == 0) ? DBG_DUP_FLAGS : 0; if (rep == 1 && p == 6) (void)hipMemsetAsync((char*)d_ws + WS_CTL, 0, CTL_ZERO_BYTES, stream);
            hipLaunchKernelGGL(fwd_kernel, dim3(grid), dim3(NTHREADS), LDS_BYTES, stream, a); } }
#ifdef DBG_HASH_OFF
    { const unsigned* hb = DBG_HASH_OFF == 0 ? (const unsigned*)d_out : (const unsigned*)((char*)d_ws + DBG_HASH_OFF);
      hipLaunchKernelGGL(dbg_hash, dim3(1024), dim3(256), 0, stream, hb, (size_t)(DBG_HASH_BYTES) / 4, (unsigned*)d_ws + 2);
      hipLaunchKernelGGL(dbg_fill, dim3(1024), dim3(256), 0, stream, (float*)d_out, (size_t)NTOK * DM, (const unsigned*)d_ws + 2); }
#endif
#endif
}
```

```cpp
#include <hip/hip_runtime.h>
#include <cstdio>
#include <cstdint>

#ifndef MK_N_LAUNCHES
#define MK_N_LAUNCHES 1
#endif

constexpr int NB = 8, SEQ = 2048, NMETA = 16, TT = SEQ + NMETA  , DM = 1024, NTOK = NB * SEQ  , NALL = NB * TT  ;
constexpr int AW = 512, NH = 8, HD = 64, IDXD = 64, CC = 512, CW = 31, NE = 32, DFF = 1024, TOPK = 256;
constexpr int INCOLS = 5192, TP = 2176  , VOFF = 0  , MSTR = 68  ;
constexpr float EPS = 1e-6f, LOG2E = 1.4426950408889634f;
constexpr float QSCALE = 0.125f * LOG2E;
constexpr int MAXTILES = 296;
constexpr int SC_Q = 0, SC_K = 512, SC_V = 1024, SC_IQ = 1536, SC_IK = 2048, SC_IW = 2112, SC_GLU = 2120, SC_GATE = 3144;
constexpr int WR_GLU = 2048, WR_GATE = 3072, WR_IK = 5120, WR_IW = 5184, WIN_ROWS = 5376;

constexpr size_t MiB = 1u << 20;
constexpr size_t al4k(size_t x) { return (x + 4095) & ~(size_t)4095; }
constexpr size_t WS_CTL = 0, CTL_ZERO_BYTES = 1 * MiB;
constexpr size_t WS_WIN = 1 * MiB;
constexpr size_t WS_WAO = WS_WIN + al4k((size_t)WIN_ROWS * DM * 2);
constexpr size_t WS_WCO = WS_WAO + al4k((size_t)DM * AW * 2);
constexpr size_t WS_WOUT = WS_WCO + al4k((size_t)DM * CC * 2);
constexpr size_t WS_WUG = WS_WOUT + al4k((size_t)DM * DM * 2);
constexpr size_t WS_WD = WS_WUG + al4k((size_t)NE * 2 * DFF * DM * 2);
constexpr size_t WS_XN = WS_WD + al4k((size_t)NE * DM * DFF * 2);
constexpr size_t WS_XNM = WS_XN + al4k((size_t)NTOK * DM * 2);
constexpr size_t WS_Q = WS_XNM + al4k((size_t)NMETA * DM * 2);
constexpr size_t WS_IQ = WS_Q + al4k((size_t)NTOK * AW * 2);
constexpr size_t WS_KB = WS_IQ + al4k((size_t)NTOK * AW * 2);
constexpr size_t WS_VT = WS_KB + al4k((size_t)(NALL + 64) * AW * 2);
constexpr size_t WS_IK = WS_VT + al4k((size_t)NB * AW * TP * 2);
constexpr size_t WS_IW = WS_IK + al4k((size_t)NB * 65 * 2048 * 2);
constexpr size_t WS_GLU = WS_IW + al4k((size_t)NTOK * 8 * 4);
constexpr size_t WS_GA = WS_GLU + al4k((size_t)NALL * CC * 2);
constexpr size_t WS_GB = WS_GA + al4k((size_t)NTOK * DM * 2);
constexpr size_t WS_MASK = WS_GB + al4k((size_t)NTOK * DM * 2);
constexpr size_t WS_AO = WS_MASK + al4k((size_t)NTOK * MSTR * 4);
constexpr size_t WS_CO = WS_AO + al4k((size_t)NTOK * AW * 2);
constexpr size_t WS_MG = WS_CO + al4k((size_t)NTOK * CC * 2);
constexpr size_t WS_TE = WS_MG + al4k((size_t)NTOK * DM * 2);
constexpr size_t WS_TP = WS_TE + al4k((size_t)NTOK * 4 * 4);
constexpr size_t WS_LIST = WS_TP + al4k((size_t)NTOK * 4 * 4);
constexpr size_t WS_LG = WS_LIST + al4k((size_t)NE * NTOK * 4);
constexpr size_t WS_ACT = WS_LG + al4k((size_t)NE * NTOK * 4);
constexpr size_t WS_YP = WS_ACT + al4k((size_t)MAXTILES * 256 * DFF * 2);
constexpr size_t WS_H1 = WS_YP + al4k((size_t)MAXTILES * 256 * DM * 2);
constexpr size_t WS_WRT = WS_H1 + al4k((size_t)NTOK * DM * 4);
constexpr size_t WS_RG = WS_WRT + al4k((size_t)2 * NE * DM * 2);
constexpr size_t WS_DUMMY = WS_RG + al4k((size_t)NE * NTOK * 4);
constexpr size_t WS_END = WS_DUMMY + 4096;
static_assert(WS_END < ((size_t)1 << 32), "32-bit byte offsets into d_ws");
constexpr int CW_TMO = 0, CW_CODE = 1, CW_BAR = 4096, CW_ECNT = 16384;

constexpr int RING_BYTES = 131072;
constexpr int LDSX_OFF = 153600;
constexpr int MISC_OFF = 161792;
constexpr int LDS_BYTES = 163840;
constexpr int NWAVES = 8, NTHREADS = 512;

#define GAS __attribute__((address_space(1)))
#define LAS __attribute__((address_space(3)))
typedef unsigned short bf16_t;
typedef short bf16x8 __attribute__((ext_vector_type(8)));
typedef short s16x4 __attribute__((ext_vector_type(4)));
typedef float f32x4 __attribute__((ext_vector_type(4)));
typedef float f32x16 __attribute__((ext_vector_type(16)));
typedef unsigned u32x4 __attribute__((ext_vector_type(4)));
typedef unsigned u32x2 __attribute__((ext_vector_type(2)));
typedef GAS unsigned gu32;
#define RLX_AGENT __ATOMIC_RELAXED, __HIP_MEMORY_SCOPE_AGENT
#define LDS_WAIT() asm volatile("s_waitcnt lgkmcnt(0)" ::: "memory")
#define VM_WAIT() asm volatile("s_waitcnt vmcnt(0)" ::: "memory")

typedef float f32x2_t __attribute__((ext_vector_type(2))); typedef __bf16 bf16x2_t __attribute__((ext_vector_type(2)));
__device__ __forceinline__ unsigned cvt_pk_bf16(float lo, float hi) { const f32x2_t v = {lo, hi}; const bf16x2_t b = __builtin_convertvector(v, bf16x2_t); return __builtin_bit_cast(unsigned, b); }
__device__ __forceinline__ float bf2f(unsigned short b) { return __uint_as_float((unsigned)b << 16); }
__device__ __forceinline__ float bflo(unsigned w) { return __uint_as_float(w << 16); }
__device__ __forceinline__ float bfhi(unsigned w) { return __uint_as_float(w & 0xffff0000u); }
__device__ __forceinline__ float sigmoidf_(float x) { return __builtin_amdgcn_rcpf(1.0f + __builtin_amdgcn_exp2f(-LOG2E * x)); }
__device__ __forceinline__ f32x2_t rcp1pexp2_2(f32x2_t x, float k) { const f32x2_t t = x * (f32x2_t){k, k}; f32x2_t e; e.x = __builtin_amdgcn_exp2f(t.x); e.y = __builtin_amdgcn_exp2f(t.y);
    e = e + (f32x2_t){1.0f, 1.0f}; f32x2_t r; r.x = __builtin_amdgcn_rcpf(e.x); r.y = __builtin_amdgcn_rcpf(e.y); return r; }
__device__ __forceinline__ f32x2_t lo2(f32x4 v) { return __builtin_shufflevector(v, v, 0, 1); }
__device__ __forceinline__ f32x2_t hi2(f32x4 v) { return __builtin_shufflevector(v, v, 2, 3); }
__device__ __forceinline__ f32x4 cat2(f32x2_t a, f32x2_t b) { return __builtin_shufflevector(a, b, 0, 1, 2, 3); }
__device__ __forceinline__ float wave_sum(float v) {
#pragma unroll
    for (int o = 1; o < 64; o <<= 1) v += __shfl_xor(v, o);
    return v;
}

namespace pg8 {
constexpr int BM = 256, BK = 64, HALF = 128, HTB = HALF * BK * 2, STAGE_BYTES = 8 * HTB;
__host__ __device__ __forceinline__ int lds_byte(int r, int c) { const int st = (r >> 4) * 2 + (c >> 5), rr = r & 15, cc = c & 31, ob = rr * 64 + cc * 2; return st * 1024 + (ob ^ (((ob >> 9) & 1) << 5)); }
__host__ __device__ __forceinline__ void stage_rc(int b, int& R, int& C) { const int st = b / 1024, sb = b % 1024, swz = sb ^ (((sb >> 9) & 1) << 5); R = (st >> 1) * 16 + swz / 64; C = (st & 1) * 32 + (swz % 64) / 2; }

struct Unit { int pm, pn, z, ord; };

template <class Epi, class Sched>
__device__ __forceinline__ void gemm_phase(LAS unsigned char* lds, const int K, const Sched& S, const Epi& E) {
    const int tid = threadIdx.x, wid = __builtin_amdgcn_readfirstlane(tid >> 6), lane = tid & 63, wr = wid >> 2, wc = wid & 3, fr = lane & 15, fq = lane >> 4;
    const int nt = K / BK;
    unsigned voffB[2];
#pragma unroll
    for (int i = 0; i < 2; ++i) { int R_, C_; stage_rc(tid * 16 + i * 8192, R_, C_); const int rho = R_ & 31, Rp = (R_ & ~31) + 8 * ((rho & 15) >> 2) + 4 * (rho >> 4) + (rho & 3);
                                  voffB[i] = (unsigned)(Rp * K + C_) * 2u; }
    const size_t kstep = (size_t)(BK * 2);
    const size_t hstep = (size_t)HALF * K * 2;
    const unsigned ldsw = (unsigned)wid * 1024u;
    const int aoff = lds_byte(wr * 64 + fr, fq * 8), boff = lds_byte(wc * 32 + fr, fq * 8);
    const char* const abase = S.a_base();
#define PG8_SA(b, h) (((b) * 2 + (h)) * HTB)
#define PG8_SB(b, h) ((4 + (b) * 2 + (h)) * HTB)
#define PG8_STAGE(bufoff, gbase, voff) do { _Pragma("unroll") for (int _i = 0; _i < 2; ++_i) \
        __builtin_amdgcn_global_load_lds((const unsigned*)((const char*)(gbase) + (voff)[_i]), (LAS unsigned*)(lds + (bufoff) + ldsw + _i * 8192), 16, 0, 0); } while (0)
#define PG8_LDA(dst, b, h) do { _Pragma("unroll") for (int m = 0; m < 4; ++m) _Pragma("unroll") for (int k = 0; k < 2; ++k) dst[m][k] = *(const LAS bf16x8*)(lds + PG8_SA(b, h) + aoff + m * 2048 + k * 1024); } while (0)
#define PG8_LDB(dst, b, h) do { _Pragma("unroll") for (int n = 0; n < 2; ++n) _Pragma("unroll") for (int k = 0; k < 2; ++k) dst[n][k] = *(const LAS bf16x8*)(lds + PG8_SB(b, h) + boff + n * 2048 + k * 1024); } while (0)
#define PG8_MMA(ai, bj, At, Bt) do { __builtin_amdgcn_s_setprio(1); _Pragma("unroll") for (int m = 0; m < 4; ++m) _Pragma("unroll") for (int n = 0; n < 2; ++n) _Pragma("unroll") for (int k = 0; k < 2; ++k) \
        acc[ai][bj][m][n] = __builtin_amdgcn_mfma_f32_16x16x32_bf16(Bt[n][k], At[m][k], acc[ai][bj][m][n], 0, 0, 0); __builtin_amdgcn_s_setprio(0); } while (0)
#define PG8_WAIT_V(n) asm volatile("s_waitcnt vmcnt(" #n ")" ::: "memory")
#define PG8_WAIT_L(n) asm volatile("s_waitcnt lgkmcnt(" #n ")" ::: "memory")
#define PG8_BAR __builtin_amdgcn_s_barrier()
#define PG8_SCHED __builtin_amdgcn_sched_barrier(0)
    Unit cur, nxt; int ui = 0;
    if (!S.next(0, cur)) return;
    f32x4 acc[2][2][4][2];
#pragma unroll
    for (int a = 0; a < 2; ++a)
#pragma unroll
        for (int b = 0; b < 2; ++b)
#pragma unroll
            for (int m = 0; m < 4; ++m)
#pragma unroll
                for (int n = 0; n < 2; ++n) acc[a][b][m][n] = (f32x4){0.f, 0.f, 0.f, 0.f};
    bf16x8 At[4][2], B0[2][2], B1[2][2];
    unsigned ca[2][2], na[2][2];
    S.a_offs(cur, tid, ca);
    const char* cB = S.b_base(cur);
    PG8_STAGE(PG8_SB(0, 0), cB, voffB); PG8_STAGE(PG8_SB(0, 1), cB + hstep, voffB); PG8_STAGE(PG8_SA(0, 0), abase, ca[0]); PG8_STAGE(PG8_SA(0, 1), abase, ca[1]);
    if (wr == 1) PG8_BAR;
    PG8_WAIT_V(2); PG8_BAR;
    PG8_STAGE(PG8_SB(1, 0), cB + kstep, voffB); PG8_STAGE(PG8_SA(1, 0), abase + kstep, ca[0]); PG8_STAGE(PG8_SB(1, 1), cB + hstep + kstep, voffB);
    PG8_WAIT_V(6); PG8_BAR;
    for (;;) {
        const bool has_next = S.next(ui + 1, nxt);
        const char* nB = cB;
#pragma unroll
        for (int h = 0; h < 2; ++h)
#pragma unroll
            for (int i = 0; i < 2; ++i) na[h][i] = ca[h][i];
        if (has_next) { S.a_offs(nxt, tid, na); nB = S.b_base(nxt); }
        for (int t = 0; t < nt; t += 2) {
            const bool last = (t == nt - 2);
            const char* a1 = abase + (size_t)(t + 1) * kstep;
            const char* a2 = last ? abase : abase + (size_t)(t + 2) * kstep; const char* b2 = last ? nB : cB + (size_t)(t + 2) * kstep;
            const char* a3 = a2 + kstep; const char* b3 = b2 + kstep;
            PG8_LDB(B0, 0, 0); PG8_LDB(B1, 0, 1); PG8_SCHED; PG8_LDA(At, 0, 0); PG8_STAGE(PG8_SA(1, 1), a1, ca[1]);
            PG8_WAIT_V(8); PG8_WAIT_L(0); PG8_BAR; PG8_MMA(0, 0, At, B0); PG8_MMA(0, 1, At, B1); PG8_BAR; PG8_SCHED;
            if (last) {
#pragma unroll
                for (int h = 0; h < 2; ++h)
#pragma unroll
                    for (int i = 0; i < 2; ++i) ca[h][i] = na[h][i];
            }
            PG8_LDA(At, 0, 1); PG8_STAGE(PG8_SB(0, 0), b2, voffB); PG8_STAGE(PG8_SB(0, 1), b2 + hstep, voffB); PG8_STAGE(PG8_SA(0, 0), a2, ca[0]);
            PG8_WAIT_V(8); PG8_WAIT_L(0); PG8_BAR; PG8_MMA(1, 0, At, B0); PG8_MMA(1, 1, At, B1); PG8_BAR; PG8_SCHED;
            PG8_LDB(B0, 1, 0); PG8_LDB(B1, 1, 1); PG8_SCHED; PG8_LDA(At, 1, 0); PG8_STAGE(PG8_SA(0, 1), a2, ca[1]);
            PG8_WAIT_V(8); PG8_WAIT_L(0); PG8_BAR; PG8_MMA(0, 0, At, B0); PG8_MMA(0, 1, At, B1); PG8_BAR; PG8_SCHED;
            PG8_LDA(At, 1, 1); PG8_STAGE(PG8_SB(1, 0), b3, voffB); PG8_STAGE(PG8_SB(1, 1), b3 + hstep, voffB); PG8_STAGE(PG8_SA(1, 0), a3, ca[0]);
            PG8_WAIT_V(8); PG8_WAIT_L(0); PG8_BAR; PG8_MMA(1, 0, At, B0); PG8_MMA(1, 1, At, B1); PG8_BAR; PG8_SCHED;
        }
        if (wr == 0) PG8_BAR;
        { int tz = tid; asm volatile("" : "+v"(tz));
          const int l2 = tz & 63, w2 = __builtin_amdgcn_readfirstlane(tz >> 6); E(acc, cur, w2 >> 2, w2 & 3, l2 & 15, l2 >> 4); }
        if (!has_next) break;
#pragma unroll
        for (int a = 0; a < 2; ++a)
#pragma unroll
            for (int b = 0; b < 2; ++b)
#pragma unroll
                for (int m = 0; m < 4; ++m)
#pragma unroll
                    for (int n = 0; n < 2; ++n) acc[a][b][m][n] = (f32x4){0.f, 0.f, 0.f, 0.f};
        cur = nxt; cB = nB; ++ui;
        if (wr == 1) PG8_BAR;
    }
    PG8_WAIT_V(0);
    PG8_BAR;
#undef PG8_SA
#undef PG8_SB
#undef PG8_STAGE
#undef PG8_LDA
#undef PG8_LDB
#undef PG8_MMA
#undef PG8_WAIT_V
#undef PG8_WAIT_L
#undef PG8_BAR
#undef PG8_SCHED
}
}

#define XB_TMO      128
#define XB_XCNT(j)  (256  + 64 * (j))
#define XB_XSUB(j)  (1280 + 64 * (j))
#define XB_XGEN(j)  (2304 + 64 * (j))
#define XB_TOP      3328
#define XB_TOPGEN   3392
#define XCD_BAR_WORDS 3456
#define XB_SPIN_CAP (1u << 18)
__device__ __forceinline__ unsigned xb_ld(unsigned* p)              { return __hip_atomic_load(p, __ATOMIC_RELAXED, __HIP_MEMORY_SCOPE_AGENT); }
__device__ __forceinline__ unsigned xb_add(unsigned* p, unsigned v) { return __hip_atomic_fetch_add(p, v, __ATOMIC_RELAXED, __HIP_MEMORY_SCOPE_AGENT); }
__device__ __forceinline__ unsigned xb_xcc_id() { return (unsigned)__builtin_amdgcn_s_getreg((3 << 11) | 20) & 0xFu; }
#define XB_SPIN(cond, bar) do { unsigned _sp = 0; while (cond) { __builtin_amdgcn_s_sleep(1); \
    if ((++_sp & 255u) == 0u) { if (xb_ld(&(bar)[XB_TMO])) break; if (_sp > XB_SPIN_CAP) { atomicAdd(&(bar)[XB_TMO], 1u); break; } } } } while (0)
struct XcdBarrier { unsigned* bar; unsigned x; volatile LAS unsigned* st; };
__device__ __forceinline__ XcdBarrier xcd_barrier_post(unsigned* bar, volatile LAS unsigned* st) {
    XcdBarrier b; b.bar = bar; b.x = xb_xcc_id(); b.st = st;
    if (threadIdx.x == 0) (void)xb_add(&bar[XB_XCNT(b.x)], 1u);
    return b;
}
__device__ __forceinline__ void xcd_barrier_complete(unsigned* bar, unsigned x, unsigned& nloc, unsigned& nx) {
    const unsigned G = gridDim.x * gridDim.y * gridDim.z;
    unsigned sum, cnt, mine, sp = 0u;
    for (;;) {
        sum = 0u; cnt = 0u; mine = 0u;
#pragma unroll
        for (unsigned j = 0; j < 16; ++j) { const unsigned c = xb_ld(&bar[XB_XCNT(j)]); sum += c; cnt += (c > 0u) ? 1u : 0u; mine = (j == x) ? c : mine; }
        if (sum == G) break;
        __builtin_amdgcn_s_sleep(1);
        if ((++sp & 255u) == 0u) { if (xb_ld(&bar[XB_TMO])) break; if (sp > XB_SPIN_CAP) { atomicAdd(&bar[XB_TMO], 1u); break; } }
    }
    nloc = mine > 0u ? mine : 1u; nx = cnt > 0u ? cnt : 1u;
}
__device__ __forceinline__ void xcd_barrier(const XcdBarrier& b) {
    asm volatile("s_waitcnt vmcnt(0)" ::: "memory");
    __syncthreads();
    if (threadIdx.x == 0) {
        unsigned* bar = b.bar;
        __builtin_amdgcn_s_waitcnt(0);
        unsigned nloc = b.st[0], nx = b.st[1];
        if (nloc == 0u) { xcd_barrier_complete(bar, b.x, nloc, nx); b.st[0] = nloc; b.st[1] = nx; }
        const unsigned old = xb_add(&bar[XB_XSUB(b.x)], 1u);
        const unsigned gen = old / nloc;
        if (old + 1u == (gen + 1u) * nloc) {
            __builtin_amdgcn_fence(__ATOMIC_RELEASE, "agent");
            asm volatile("s_waitcnt vmcnt(0)" ::: "memory");
            const unsigned og = xb_add(&bar[XB_TOP], 1u);
            const unsigned tg = og / nx;
            if (og + 1u == (tg + 1u) * nx) xb_add(&bar[XB_TOPGEN], 1u);
            else XB_SPIN(xb_ld(&bar[XB_TOPGEN]) == tg, bar);
            __builtin_amdgcn_fence(__ATOMIC_ACQUIRE, "agent");
            xb_add(&bar[XB_XGEN(b.x)], 1u);
            asm volatile("s_waitcnt vmcnt(0)" ::: "memory");
        } else {
            XB_SPIN(xb_ld(&bar[XB_XGEN(b.x)]) == gen, bar);
            __builtin_amdgcn_fence(__ATOMIC_ACQUIRE, "agent");
            asm volatile("s_waitcnt vmcnt(0)" ::: "memory");
        }
    }
    __syncthreads();
}

struct Args {
    const float* in[21];
    float* out; unsigned char* ws;
    int ph_lo, ph_hi, flags, pad;
};
enum { I_X = 0, I_META, I_RELB, I_NMIX, I_WIN, I_BGATE, I_WAO, I_CONVW, I_CONVB, I_LNG, I_LNB, I_WCO, I_WOUT, I_NFFN, I_WR, I_BR, I_WUG, I_BUG, I_WD, I_BD, I_NFIN };

struct Frame {
    LAS unsigned char* lds;
    unsigned char* ws;
    int tid, lane, wave;
    int G, bid;
};
template <class T> __device__ __forceinline__ T* wsp(unsigned char* ws, size_t off) { return (T*)(ws + off); }

struct P0Desc { const float* src; bf16_t* dst; int ldn, ldk; };
__device__ __forceinline__ void p0_load(const P0Desc& d, f32x4 (&v)[16], int lane) {
    const float* p = d.src + (size_t)(lane >> 4) * d.ldn + (lane & 15) * 4;
#pragma unroll
    for (int i = 0; i < 16; ++i) v[i] = *(const f32x4*)(p + (size_t)(4 * i) * d.ldn);
}
__device__ __forceinline__ void p0_store(const P0Desc& d, const f32x4 (&v)[16], LAS float* scr, int lane) {
    const int n4 = (lane & 15) * 4, kr = lane >> 4;
#pragma unroll
    for (int i = 0; i < 16; ++i) { LAS float* p = scr + (4 * i + kr) * 65 + n4; p[0] = v[i][0]; p[1] = v[i][1]; p[2] = v[i][2]; p[3] = v[i][3]; }
    LDS_WAIT(); asm volatile("" ::: "memory");
    const int c = lane & 7;
#pragma unroll
    for (int j = 0; j < 8; ++j) { const int n = (lane >> 3) + 8 * j; const LAS float* s = scr + (8 * c) * 65 + n;
        u32x4 o; o.x = cvt_pk_bf16(s[0 * 65], s[1 * 65]); o.y = cvt_pk_bf16(s[2 * 65], s[3 * 65]); o.z = cvt_pk_bf16(s[4 * 65], s[5 * 65]); o.w = cvt_pk_bf16(s[6 * 65], s[7 * 65]);
        *(u32x4*)(d.dst + (size_t)n * d.ldk + 8 * c) = o; }
    LDS_WAIT(); asm volatile("" ::: "memory");
}
__device__ __forceinline__ void rms_row_to_bf16(const float* __restrict__ xrow, const float* __restrict__ g, bf16_t* __restrict__ orow, int lane) {
    const f32x4* xr = (const f32x4*)xrow + lane; const f32x4* gr = (const f32x4*)g + lane;
    f32x4 v[4]; float s = 0.f;
#pragma unroll
    for (int j = 0; j < 4; ++j) { v[j] = xr[64 * j]; s += (v[j].x * v[j].x + v[j].y * v[j].y) + (v[j].z * v[j].z + v[j].w * v[j].w); }
    const float r = 1.0f / sqrtf(wave_sum(s) * (1.f / DM) + EPS);
    unsigned long long* o8 = (unsigned long long*)orow + lane;
#pragma unroll
    for (int j = 0; j < 4; ++j) { const f32x4 gg = gr[64 * j];
        o8[64 * j] = (unsigned long long)cvt_pk_bf16(v[j].x * r * gg.x, v[j].y * r * gg.y) | ((unsigned long long)cvt_pk_bf16(v[j].z * r * gg.z, v[j].w * r * gg.w) << 32); }
}
__device__ __forceinline__ void p0_prologue(Frame& F, const Args& a, const int part) {
    LAS float* scr = (LAS float*)(F.lds + F.wave * 16896);
    const int gw = F.bid * NWAVES + F.wave, NGW = F.G * NWAVES;
    unsigned char* ws = F.ws;
    constexpr int T_IN = 81 * 16, T_AO = 16 * 8, T_CO = 16 * 8, T_OUT = 16 * 16, T_SMALL = T_IN + T_AO + T_CO + T_OUT;
    constexpr int T_UG = NE * 32 * 16, T_D = NE * 16 * 16, T_ALL = T_SMALL + T_UG + T_D;
    auto desc = [&](int it) -> P0Desc {
        int r = it; P0Desc d;
        if (r < T_IN) { const int g = r / 16, kb = r % 16; const int dr = g * 64; int sc;
            if (dr < WR_GLU) sc = dr;
            else if (dr < WR_GATE) { const int q = dr - WR_GLU, tile = q >> 8, hf = (q >> 7) & 1, w = q & 127; sc = SC_GLU + 512 * hf + 128 * tile + w; }
            else if (dr < WR_IK) sc = SC_GATE + (dr - WR_GATE);
            else sc = SC_IK + (dr - WR_IK);
            d.src = a.in[I_WIN] + (size_t)(kb * 64) * INCOLS + sc; d.ldn = INCOLS; d.dst = wsp<bf16_t>(ws, WS_WIN) + (size_t)dr * DM + kb * 64; d.ldk = DM; return d; }
        r -= T_IN;
        if (r < T_AO) { const int g = r / 8, kb = r % 8; d.src = a.in[I_WAO] + (size_t)(kb * 64) * DM + g * 64; d.ldn = DM; d.dst = wsp<bf16_t>(ws, WS_WAO) + (size_t)(g * 64) * AW + kb * 64; d.ldk = AW; return d; }
        r -= T_AO;
        if (r < T_CO) { const int g = r / 8, kb = r % 8; d.src = a.in[I_WCO] + (size_t)(kb * 64) * DM + g * 64; d.ldn = DM; d.dst = wsp<bf16_t>(ws, WS_WCO) + (size_t)(g * 64) * CC + kb * 64; d.ldk = CC; return d; }
        r -= T_CO;
        if (r < T_OUT) { const int g = r / 16, kb = r % 16; d.src = a.in[I_WOUT] + (size_t)(kb * 64) * DM + g * 64; d.ldn = DM; d.dst = wsp<bf16_t>(ws, WS_WOUT) + (size_t)(g * 64) * DM + kb * 64; d.ldk = DM; return d; }
        r -= T_OUT;
        if (r < T_UG) { const int e = r / 512, q = r % 512, g = q % 32, kb = q / 32; const int dr = g * 64, tile = dr >> 8, hf = (dr >> 7) & 1, w = dr & 127;
            d.src = a.in[I_WUG] + (size_t)e * DM * 2 * DFF + (size_t)(kb * 64) * (2 * DFF) + DFF * hf + 128 * tile + w; d.ldn = 2 * DFF;
            d.dst = wsp<bf16_t>(ws, WS_WUG) + (size_t)e * 2 * DFF * DM + (size_t)dr * DM + kb * 64; d.ldk = DM; return d; }
        r -= T_UG;
        { const int e = r / 256, q = r % 256, g = q % 16, kb = q / 16;
            d.src = a.in[I_WD] + (size_t)e * DFF * DM + (size_t)(kb * 64) * DM + g * 64; d.ldn = DM; d.dst = wsp<bf16_t>(ws, WS_WD) + (size_t)e * DM * DFF + (size_t)(g * 64) * DFF + kb * 64; d.ldk = DFF; return d; }
    };
    const int T_LO = part ? T_SMALL : 0, T_HI = part ? T_ALL : T_SMALL;
    if (T_LO + gw < T_HI) {
        f32x4 va[16], vb[16];
        P0Desc da = desc(T_LO + gw), db = da;
        p0_load(da, va, F.lane);
        for (int it = T_LO + gw; it < T_HI; it += 2 * NGW) {
            const int i1 = it + NGW, i2 = it + 2 * NGW;
            db = desc(i1 < T_HI ? i1 : it); p0_load(db, vb, F.lane);
            p0_store(da, va, scr, F.lane);
            da = desc(i2 < T_HI ? i2 : it); p0_load(da, va, F.lane);
            if (i1 < T_HI) p0_store(db, vb, scr, F.lane);
        }
    }
    if (part) return;
    { const int gt = F.bid * NTHREADS + F.tid;
      if (gt < 8 * DM / 2) { const int n = gt >> 9, k = (gt & 511) * 2; const float v0 = a.in[I_WIN][(size_t)k * INCOLS + SC_IW + n], v1 = a.in[I_WIN][(size_t)(k + 1) * INCOLS + SC_IW + n];
          *(unsigned*)(wsp<bf16_t>(ws, WS_WIN) + (size_t)(WR_IW + n) * DM + k) = cvt_pk_bf16(v0, v1); } }
    { const int gt = F.bid * NTHREADS + F.tid;
      if (gt < NE * DM / 2) { const int e = gt >> 9, d = (gt & 511) * 2; const float v0 = a.in[I_NFFN][d] * a.in[I_WR][(size_t)d * NE + e], v1 = a.in[I_NFFN][d + 1] * a.in[I_WR][(size_t)(d + 1) * NE + e];
          const unsigned hi = cvt_pk_bf16(v0, v1); const unsigned lo = cvt_pk_bf16(v0 - bflo(hi), v1 - bfhi(hi));
          *(unsigned*)(wsp<bf16_t>(ws, WS_WRT) + (size_t)e * DM + d) = hi; *(unsigned*)(wsp<bf16_t>(ws, WS_WRT) + (size_t)(NE + e) * DM + d) = lo; } }
    for (int m = gw; m < NTOK + NMETA; m += NGW) {
        if (m < NTOK) rms_row_to_bf16(a.in[I_X] + (size_t)m * DM, a.in[I_NMIX], wsp<bf16_t>(ws, WS_XN) + (size_t)m * DM, F.lane);
        else rms_row_to_bf16(a.in[I_META] + (size_t)(m - NTOK) * DM, a.in[I_NMIX], wsp<bf16_t>(ws, WS_XNM) + (size_t)(m - NTOK) * DM, F.lane);
    }
}

struct PlainSched {
    const char* ws; unsigned a_off, b_off; int K, nM, nN, nwg, G, c;
    __device__ __forceinline__ void init(const unsigned char* ws_, size_t a, size_t b, int M, int N, int K_, int G_, int c_) { ws = (const char*)ws_; a_off = (unsigned)a; b_off = (unsigned)b; K = K_; nM = M / 256; nN = N / 256; nwg = nM * nN; G = G_; c = c_; }
    __device__ __forceinline__ bool next(int i, pg8::Unit& u) const {
        const long L = (long)i * G + c; if (L >= nwg) return false;
        int wgid = (int)L; { const int q = nwg / 8, r = nwg % 8, xcd = wgid % 8, off = wgid / 8; wgid = (xcd < r ? xcd * (q + 1) : r * (q + 1) + (xcd - r) * q) + off; }
        const int nig = 8 * nN, gid = wgid / nig, fm = gid * 8, gsz = (nM - fm) < 8 ? (nM - fm) : 8;
        u.pm = fm + ((wgid % nig) % gsz); u.pn = (wgid % nig) / gsz; u.z = 0; u.ord = i; return true;
    }
    __device__ __forceinline__ const char* a_base() const { return ws; }
    __device__ __forceinline__ void a_offs(const pg8::Unit& u, int tid, unsigned (&o)[2][2]) const {
        int R[2], C[2]; pg8::stage_rc(tid * 16, R[0], C[0]); pg8::stage_rc(tid * 16 + 8192, R[1], C[1]);
#pragma unroll
        for (int h = 0; h < 2; ++h)
#pragma unroll
            for (int i = 0; i < 2; ++i) o[h][i] = a_off + (unsigned)(((u.pm * 256 + h * 128 + R[i]) * K + C[i]) * 2);
    }
    __device__ __forceinline__ const char* b_base(const pg8::Unit& u) const { return ws + b_off + (size_t)u.pn * 256 * K * 2; }
};
struct MergeSched {
    const char* ws; int G, c;
    __device__ __forceinline__ bool next(int i, pg8::Unit& u) const {
        const int t = c + (i >> 1) * G;
        if (t >= 256) return false;
        u.pm = (t & 7) + 8 * (t >> 5); u.pn = (t >> 3) & 3; u.z = i & 1; u.ord = i; return true;
    }
    __device__ __forceinline__ const char* a_base() const { return ws; }
    __device__ __forceinline__ void a_offs(const pg8::Unit& u, int tid, unsigned (&o)[2][2]) const {
        int R[2], C[2]; pg8::stage_rc(tid * 16, R[0], C[0]); pg8::stage_rc(tid * 16 + 8192, R[1], C[1]);
        const unsigned base = (unsigned)(u.z ? WS_CO : WS_AO);
#pragma unroll
        for (int h = 0; h < 2; ++h)
#pragma unroll
            for (int i = 0; i < 2; ++i) o[h][i] = base + (unsigned)(((u.pm * 256 + h * 128 + R[i]) * 512 + C[i]) * 2);
    }
    __device__ __forceinline__ const char* b_base(const pg8::Unit& u) const { return ws + (u.z ? WS_WCO : WS_WAO) + (size_t)u.pn * 256 * 512 * 2; }
};
struct MoeTables { const LAS int* cnt; const LAS int* tbase; };
constexpr int MOE_MAXU = 10;
constexpr int MOEL_DESC = RING_BYTES;
constexpr int MOEL_TOK = MOEL_DESC + 256;
constexpr int MOEL_ROWV = MOEL_TOK + MOE_MAXU * 512;
constexpr int MOEL_BIAS = MOEL_ROWV + MOE_MAXU * 1024;
constexpr int MOET_OFF = MOEL_BIAS + MOE_MAXU * 1024;
static_assert(MOET_OFF + 512 <= MISC_OFF, "moe LDS map");
template <int NC, bool GATHER>
struct MoeSched {
    const char* ws; MoeTables T; int G, c, total; LAS unsigned char* lds;
    __device__ __forceinline__ int next_lane(int i, int& pm, int& pn, int& z) const {
        pm = 0; pn = 0; z = 0;
        const long L = (long)i * G + c; if (L >= total) return 0;
        int wgid = (int)L; { const int q = total / 8, r = total % 8, xcd = wgid % 8, off = wgid / 8; wgid = (xcd < r ? xcd * (q + 1) : r * (q + 1) + (xcd - r) * q) + off; }
        int e = 0;
        for (int j = 1; j < NE; ++j) e += (wgid >= T.tbase[j] * NC) ? 1 : 0;
        const int loc = wgid - T.tbase[e] * NC;
        z = e; pn = loc % NC; pm = loc / NC;
        return 1;
    }
    __device__ __forceinline__ bool next(int i, pg8::Unit& u) const {
        const u32x4 d = *(const LAS u32x4*)(lds + MOEL_DESC + 16 * i);
        if (__builtin_amdgcn_readfirstlane((int)d.w) == 0) return false;
        u.pm = __builtin_amdgcn_readfirstlane((int)d.x); u.pn = __builtin_amdgcn_readfirstlane((int)d.y); u.z = __builtin_amdgcn_readfirstlane((int)d.z); u.ord = i;
        return true;
    }
    __device__ __forceinline__ const char* a_base() const { return ws; }
    __device__ __forceinline__ void a_offs(const pg8::Unit& u, int tid, unsigned (&o)[2][2]) const {
        int R[2], C[2]; pg8::stage_rc(tid * 16, R[0], C[0]); pg8::stage_rc(tid * 16 + 8192, R[1], C[1]);
        if (GATHER) {
            const LAS unsigned short* tokl = (const LAS unsigned short*)(lds + MOEL_TOK) + u.ord * 256;
#pragma unroll
            for (int h = 0; h < 2; ++h)
#pragma unroll
                for (int i = 0; i < 2; ++i) { const int tok = (int)tokl[h * 128 + R[i]]; o[h][i] = (unsigned)WS_XN + (unsigned)((tok * DM + C[i]) * 2); }
        } else {
            const int row0 = (__builtin_amdgcn_readfirstlane(T.tbase[u.z]) + u.pm) * 256;
#pragma unroll
            for (int h = 0; h < 2; ++h)
#pragma unroll
                for (int i = 0; i < 2; ++i) o[h][i] = (unsigned)WS_ACT + (unsigned)(((row0 + h * 128 + R[i]) * DFF + C[i]) * 2);
        }
    }
    __device__ __forceinline__ const char* b_base(const pg8::Unit& u) const {
        if (GATHER) return ws + WS_WUG + ((size_t)u.z * 2 * DFF + (size_t)u.pn * 256) * DM * 2;
        else return ws + WS_WD + ((size_t)u.z * DM + (size_t)u.pn * 256) * DFF * 2;
    }
};
template <int NC, bool GATHER>
__device__ __forceinline__ void moe_prepare(Frame& F, const MoeSched<NC, GATHER>& S, const float* rowv_src, const float* bias) {
    LAS int* desc = (LAS int*)(F.lds + MOEL_DESC); LAS unsigned short* tokl = (LAS unsigned short*)(F.lds + MOEL_TOK); LAS float* rowv = (LAS float*)(F.lds + MOEL_ROWV); LAS float* biasl = (LAS float*)(F.lds + MOEL_BIAS);
    if (F.tid < 16) { int pm = 0, pn = 0, z = 0, valid = 0; if (F.tid < MOE_MAXU) valid = S.next_lane(F.tid, pm, pn, z);
        desc[4 * F.tid + 0] = pm; desc[4 * F.tid + 1] = pn; desc[4 * F.tid + 2] = z; desc[4 * F.tid + 3] = valid; }
    __syncthreads();
    const int* LIST = (const int*)(S.ws + WS_LIST);
    constexpr int NIT = MOE_MAXU * 256 / NTHREADS;
    int tk[NIT]; float rv[NIT], bs[NIT];
#pragma unroll
    for (int k = 0; k < NIT; ++k) { const int idx = F.tid + k * NTHREADS, i = idx >> 8, r = idx & 255;
        const int pm = desc[4 * i], pn = desc[4 * i + 1], z = desc[4 * i + 2], n = S.T.cnt[z], p = pm * 256 + r, pc = p < n ? p : 0;
        tk[k] = GATHER ? LIST[(size_t)z * NTOK + pc] : 0; rv[k] = rowv_src[(size_t)z * NTOK + pc];
        bs[k] = GATHER ? bias[(size_t)z * 2 * DFF + (r >> 7) * DFF + pn * 128 + (r & 127)] : bias[(size_t)z * DM + pn * 256 + r]; }
#pragma unroll
    for (int k = 0; k < NIT; ++k) { const int idx = F.tid + k * NTHREADS; if (GATHER) tokl[idx] = (unsigned short)tk[k]; rowv[idx] = rv[k]; biasl[idx] = bs[k]; }
    __syncthreads();
}

#define EPI_ROWS(ai, m) for (int ai = 0; ai < 2; ++ai) _Pragma("unroll") for (int m = 0; m < 4; ++m)
#define EPI_COLS(bj, n) for (int bj = 0; bj < 2; ++bj) _Pragma("unroll") for (int n = 0; n < 2; ++n)
__device__ __forceinline__ void st_bf16x4(bf16_t* p, f32x4 v) { u32x2 w; w.x = cvt_pk_bf16(v[0], v[1]); w.y = cvt_pk_bf16(v[2], v[3]); *(u32x2*)p = w; }
__device__ __forceinline__ void st_bf16x8(bf16_t* p, f32x4 a, f32x4 b) { u32x4 w; w.x = cvt_pk_bf16(a[0], a[1]); w.y = cvt_pk_bf16(a[2], a[3]); w.z = cvt_pk_bf16(b[0], b[1]); w.w = cvt_pk_bf16(b[2], b[3]); *(u32x4*)p = w; }

struct EpiInProj {
    unsigned char* ws; const float* bgate;
    __device__ __forceinline__ void operator()(const f32x4 (&acc)[2][2][4][2], const pg8::Unit& u, int wr, int wc, int fr, int fq) const {
        const int pn = u.pn, row0 = u.pm * 256 + wr * 64 + fr, col0 = wc * 32 + 8 * fq;
        const int bidx = u.pm >> 3;
        const int rowk0 = row0 + NMETA * (bidx + 1);
        if (pn < 2 || (pn >= 6 && pn < 8)) {
            bf16_t* O = wsp<bf16_t>(ws, pn < 2 ? WS_Q : WS_IQ); const int cb = (pn & 1) * 256; const float sc = pn < 2 ? QSCALE : 1.0f;
#pragma unroll
            EPI_ROWS(ai, m) { bf16_t* rp = O + (size_t)(row0 + ai * 128 + m * 16) * AW + cb + col0;
#pragma unroll
                for (int bj = 0; bj < 2; ++bj) st_bf16x8(rp + bj * 128, acc[ai][bj][m][0] * sc, acc[ai][bj][m][1] * sc); }
        } else if (pn < 4) {
            bf16_t* O = wsp<bf16_t>(ws, WS_KB); const int cb = (pn & 1) * 256;
#pragma unroll
            EPI_ROWS(ai, m) { bf16_t* rp = O + (size_t)(rowk0 + ai * 128 + m * 16) * AW + cb + col0;
#pragma unroll
                for (int bj = 0; bj < 2; ++bj) st_bf16x8(rp + bj * 128, acc[ai][bj][m][0], acc[ai][bj][m][1]); }
        } else if (pn < 6) {
            bf16_t* O = wsp<bf16_t>(ws, WS_VT) + (size_t)bidx * AW * TP; const int cb = (pn & 1) * 256;
            const int t0 = (row0 & (SEQ - 1)) + NMETA + VOFF;
#pragma unroll
            EPI_ROWS(ai, m) { const int t = t0 + ai * 128 + m * 16;
#pragma unroll
                EPI_COLS(bj, n) { const f32x4 v = acc[ai][bj][m][n]; bf16_t* cp = O + (size_t)(cb + col0 + bj * 128 + n * 4) * TP + (t & ~1);
                    const float p0 = __shfl_xor(v[0], 1), p1 = __shfl_xor(v[1], 1), p2 = __shfl_xor(v[2], 1), p3 = __shfl_xor(v[3], 1);
                    if ((fr & 1) == 0) { *(unsigned*)(cp) = cvt_pk_bf16(v[0], p0); *(unsigned*)(cp + TP) = cvt_pk_bf16(v[1], p1); }
                    else { *(unsigned*)(cp + 2 * TP) = cvt_pk_bf16(p2, v[2]); *(unsigned*)(cp + 3 * TP) = cvt_pk_bf16(p3, v[3]); } } }
        } else if (pn < 12) {
            bf16_t* O = wsp<bf16_t>(ws, WS_GLU); const int cb = (pn - 8) * 128;
#pragma unroll
            EPI_ROWS(ai, m) { bf16_t* rp = O + (size_t)(rowk0 + ai * 128 + m * 16) * CC + cb + col0;
                f32x4 y[2];
#pragma unroll
                for (int n = 0; n < 2; ++n) { const f32x4 av = acc[ai][0][m][n], gv = acc[ai][1][m][n];
                    y[n] = cat2(lo2(av) * rcp1pexp2_2(lo2(gv), -LOG2E), hi2(av) * rcp1pexp2_2(hi2(gv), -LOG2E)); }
                st_bf16x8(rp, y[0], y[1]); }
        } else {
            const int gt = pn - 12; bf16_t* O = wsp<bf16_t>(ws, gt < 4 ? WS_GA : WS_GB); const int cb = (gt & 3) * 256; const float* bp = bgate + gt * 256 + col0;
            f32x4 bv[2][2];
#pragma unroll
            EPI_COLS(bj, n) bv[bj][n] = *(const f32x4*)(bp + bj * 128 + n * 4);
#pragma unroll
            EPI_ROWS(ai, m) { bf16_t* rp = O + (size_t)(row0 + ai * 128 + m * 16) * DM + cb + col0;
#pragma unroll
                for (int bj = 0; bj < 2; ++bj) { f32x4 y[2];
#pragma unroll
                    for (int n = 0; n < 2; ++n) { const f32x4 x = acc[ai][bj][m][n] + bv[bj][n]; y[n] = cat2(rcp1pexp2_2(lo2(x), -LOG2E), rcp1pexp2_2(hi2(x), -LOG2E)); }
                    st_bf16x8(rp + bj * 128, y[0], y[1]); } }
        }
    }
};
struct EpiMerge {
    unsigned char* ws;
    __device__ __forceinline__ void operator()(const f32x4 (&acc)[2][2][4][2], const pg8::Unit& u, int wr, int wc, int fr, int fq) const {
        const int row0 = u.pm * 256 + wr * 64 + fr, col0 = u.pn * 256 + wc * 32 + 8 * fq;
        const bf16_t* Gt = wsp<bf16_t>(ws, u.z ? WS_GB : WS_GA); bf16_t* O = wsp<bf16_t>(ws, WS_MG);
#pragma unroll
        for (int ai = 0; ai < 2; ++ai) {
            u32x4 g[4][2], p[4][2];
#pragma unroll
            for (int m = 0; m < 4; ++m)
#pragma unroll
                for (int bj = 0; bj < 2; ++bj) { const size_t o = (size_t)(row0 + ai * 128 + m * 16) * DM + col0 + bj * 128; g[m][bj] = *(const u32x4*)(Gt + o); p[m][bj] = u.z ? *(const u32x4*)(O + o) : (u32x4){0u, 0u, 0u, 0u}; }
#pragma unroll
            for (int m = 0; m < 4; ++m)
#pragma unroll
                for (int bj = 0; bj < 2; ++bj) { const size_t o = (size_t)(row0 + ai * 128 + m * 16) * DM + col0 + bj * 128; const u32x4 gg = g[m][bj], pp = p[m][bj]; const f32x4 a0 = acc[ai][bj][m][0], a1 = acc[ai][bj][m][1];
                    const f32x4 y0 = (f32x4){bflo(gg.x) * a0[0] + bflo(pp.x), bfhi(gg.x) * a0[1] + bfhi(pp.x), bflo(gg.y) * a0[2] + bflo(pp.y), bfhi(gg.y) * a0[3] + bfhi(pp.y)};
                    const f32x4 y1 = (f32x4){bflo(gg.z) * a1[0] + bflo(pp.z), bfhi(gg.z) * a1[1] + bfhi(pp.z), bflo(gg.w) * a1[2] + bflo(pp.w), bfhi(gg.w) * a1[3] + bfhi(pp.w)};
                    st_bf16x8(O + o, y0, y1); }
        }
    }
};
struct EpiResid {
    const float* x; float* out;
    __device__ __forceinline__ void operator()(const f32x4 (&acc)[2][2][4][2], const pg8::Unit& u, int wr, int wc, int fr, int fq) const {
        const int row0 = u.pm * 256 + wr * 64 + fr, col0 = u.pn * 256 + wc * 32 + 8 * fq;
#pragma unroll
        for (int ai = 0; ai < 2; ++ai)
#pragma unroll
            for (int mh = 0; mh < 2; ++mh) {
                f32x4 xv[2][2][2];
#pragma unroll
                for (int mm = 0; mm < 2; ++mm)
#pragma unroll
                    EPI_COLS(bj, n) xv[mm][bj][n] = *(const f32x4*)(x + (size_t)(row0 + ai * 128 + (2 * mh + mm) * 16) * DM + col0 + bj * 128 + n * 4);
#pragma unroll
                for (int mm = 0; mm < 2; ++mm)
#pragma unroll
                    EPI_COLS(bj, n) *(f32x4*)(out + (size_t)(row0 + ai * 128 + (2 * mh + mm) * 16) * DM + col0 + bj * 128 + n * 4) = xv[mm][bj][n] + acc[ai][bj][2 * mh + mm][n];
            }
    }
};
struct EpiSwiglu {
    unsigned char* ws; MoeTables T; const LAS float* rowv;
    __device__ __forceinline__ void operator()(const f32x4 (&acc)[2][2][4][2], const pg8::Unit& u, int wr, int wc, int fr, int fq) const {
        const int e = u.z, n_e = __builtin_amdgcn_readfirstlane(T.cnt[e]), rloc0 = u.pm * 256 + wr * 64 + fr, row0 = __builtin_amdgcn_readfirstlane(T.tbase[e]) * 256 + rloc0, col0 = u.pn * 128 + wc * 32 + 8 * fq;
        bf16_t* O = wsp<bf16_t>(ws, WS_ACT); const LAS float* rg = rowv + u.ord * 256 + wr * 64 + fr; const LAS float* bp = rowv + MOE_MAXU * 256 + u.ord * 256 + wc * 32 + 8 * fq;
        f32x4 bg[2], bu[2];
#pragma unroll
        for (int n = 0; n < 2; ++n) { bg[n] = *(const LAS f32x4*)(bp + n * 4); bu[n] = *(const LAS f32x4*)(bp + 128 + n * 4) + 1.0f; }
        float rvs[2][4];
#pragma unroll
        EPI_ROWS(ai, m) rvs[ai][m] = rg[ai * 128 + m * 16];
        bf16_t* const sink = wsp<bf16_t>(ws, WS_DUMMY) + col0;
#pragma unroll
        EPI_ROWS(ai, m) { const int rl = rloc0 + ai * 128 + m * 16; bf16_t* rp = (rl < n_e) ? O + (size_t)(row0 + ai * 128 + m * 16) * DFF + col0 : sink; const float rv = rvs[ai][m];
                f32x4 y[2];
#pragma unroll
                for (int n = 0; n < 2; ++n) { const f32x2_t rv2 = {rv, rv}; f32x2_t yh[2];
#pragma unroll
                    for (int hh = 0; hh < 2; ++hh) { const f32x4 ag = acc[ai][0][m][n], au = acc[ai][1][m][n];
                        f32x2_t g = (hh ? hi2(ag) : lo2(ag)) * rv2 + (hh ? hi2(bg[n]) : lo2(bg[n])), u1 = (hh ? hi2(au) : lo2(au)) * rv2 + (hh ? hi2(bu[n]) : lo2(bu[n]));
                        g.x = fminf(g.x, 7.0f); g.y = fminf(g.y, 7.0f); u1.x = __builtin_amdgcn_fmed3f(u1.x, -6.0f, 8.0f); u1.y = __builtin_amdgcn_fmed3f(u1.y, -6.0f, 8.0f);
                        yh[hh] = (u1 * g) * rcp1pexp2_2(g, -1.702f * LOG2E); }
                    y[n] = cat2(yh[0], yh[1]); }
                st_bf16x8(rp, y[0], y[1]); }
    }
};
struct EpiDown {
    unsigned char* ws; MoeTables T; const LAS float* rowv;
    __device__ __forceinline__ void operator()(const f32x4 (&acc)[2][2][4][2], const pg8::Unit& u, int wr, int wc, int fr, int fq) const {
        const int e = u.z, n_e = __builtin_amdgcn_readfirstlane(T.cnt[e]), rloc0 = u.pm * 256 + wr * 64 + fr, row0 = __builtin_amdgcn_readfirstlane(T.tbase[e]) * 256 + rloc0, col0 = u.pn * 256 + wc * 32 + 8 * fq;
        bf16_t* O = wsp<bf16_t>(ws, WS_YP); const LAS float* lg = rowv + u.ord * 256 + wr * 64 + fr; const LAS float* bp = rowv + MOE_MAXU * 256 + u.ord * 256 + wc * 32 + 8 * fq;
        f32x4 bv[2][2];
#pragma unroll
        EPI_COLS(bj, n) bv[bj][n] = *(const LAS f32x4*)(bp + bj * 128 + n * 4);
        float gts[2][4];
#pragma unroll
        EPI_ROWS(ai, m) gts[ai][m] = lg[ai * 128 + m * 16];
        bf16_t* const sink = wsp<bf16_t>(ws, WS_DUMMY) + col0;
#pragma unroll
        EPI_ROWS(ai, m) { const int rl = rloc0 + ai * 128 + m * 16; const float gt = gts[ai][m]; bf16_t* rp = (rl < n_e) ? O + (size_t)(row0 + ai * 128 + m * 16) * DM + col0 : sink;
#pragma unroll
                for (int bj = 0; bj < 2; ++bj) st_bf16x8(rp + bj * 128, (acc[ai][bj][m][0] + bv[bj][0]) * gt, (acc[ai][bj][m][1] + bv[bj][1]) * gt); }
    }
};

constexpr int IKBLK = 65;
__device__ __forceinline__ size_t ikf_off(int b, int p, int dim) { return ((((size_t)(b * IKBLK + (p >> 5)) * 4 + (dim >> 4)) * 64 + (((dim >> 3) & 1) * 32 + (p & 31))) * 8 + (dim & 7)); }
template <int NT>
__device__ __forceinline__ void wave_mm16(const bf16_t* __restrict__ A, int lda, const bf16_t* const (&Bt)[NT], int K, int lane, f32x4 (&acc)[NT]) {
    const bf16_t* ap = A + (size_t)(lane & 15) * lda + 8 * (lane >> 4);
    const bf16_t* bp[NT];
#pragma unroll
    for (int t = 0; t < NT; ++t) { bp[t] = Bt[t] + (size_t)(lane & 15) * K + 8 * (lane >> 4); acc[t] = (f32x4){0.f, 0.f, 0.f, 0.f}; }
#pragma unroll (NT == 1 ? 16 : 8)
    for (int k0 = 0; k0 < K; k0 += 32) {
        const bf16x8 a = *(const bf16x8*)(ap + k0);
#pragma unroll
        for (int t = 0; t < NT; ++t) { const bf16x8 b = *(const bf16x8*)(bp[t] + k0); acc[t] = __builtin_amdgcn_mfma_f32_16x16x32_bf16(b, a, acc[t], 0, 0, 0); }
    }
}
__device__ __forceinline__ void p1_thin(Frame& F, int dbgflags) {
    unsigned char* ws = F.ws;
    const bf16_t* WIN = wsp<bf16_t>(ws, WS_WIN); const bf16_t* XN = wsp<bf16_t>(ws, WS_XN); const bf16_t* XNM = wsp<bf16_t>(ws, WS_XNM);
    bf16_t* KB = wsp<bf16_t>(ws, WS_KB); bf16_t* VT = wsp<bf16_t>(ws, WS_VT); bf16_t* IK = wsp<bf16_t>(ws, WS_IK); bf16_t* GLU = wsp<bf16_t>(ws, WS_GLU); float* IW = wsp<float>(ws, WS_IW);
    const int gw = F.bid * NWAVES + F.wave, NGW = F.G * NWAVES, lane = F.lane, tk = lane & 15, nq = lane >> 4;
    {
        constexpr int WBP = 2064;
        LAS unsigned char* lds = F.lds;
        __syncthreads();
        { const unsigned char* src = (const unsigned char*)(WIN + (size_t)WR_IK * DM);
          for (int p = F.tid; p < 72 * 128; p += NTHREADS) { const int row = p >> 7, c16 = p & 127; *(LAS u32x4*)(lds + row * WBP + c16 * 16) = *(const u32x4*)(src + (size_t)row * DM * 2 + c16 * 16); } }
        __syncthreads();
        const int tg = F.wave & 3, hf = F.wave >> 2, kq = nq;
        for (int tb = F.bid; tb < NTOK / 64; tb += F.G) {
            const int m = tb * 64 + 16 * tg + tk, rowk = m + NMETA * ((m >> 11) + 1);
            const bf16_t* xr = XN + (size_t)m * DM + 16 * kq;
            bf16x8 xa[16], xb[16];
#pragma unroll
            for (int sblk = 0; sblk < 16; ++sblk) { xa[sblk] = *(const bf16x8*)(xr + 64 * sblk); xb[sblk] = *(const bf16x8*)(xr + 64 * sblk + 8); }
            const LAS unsigned char* wb = lds + tk * WBP + 32 * kq;
            if (hf == 0) {
                f32x4 acc[3] = {{0.f, 0.f, 0.f, 0.f}, {0.f, 0.f, 0.f, 0.f}, {0.f, 0.f, 0.f, 0.f}};
#pragma unroll
                for (int sblk = 0; sblk < 16; ++sblk)
#pragma unroll
                    for (int t = 0; t < 3; ++t) { const bf16x8 b0 = *(const LAS bf16x8*)(wb + 16 * t * WBP + 128 * sblk), b1 = *(const LAS bf16x8*)(wb + 16 * t * WBP + 128 * sblk + 16);
                        acc[t] = __builtin_amdgcn_mfma_f32_16x16x32_bf16(b0, xa[sblk], acc[t], 0, 0, 0); acc[t] = __builtin_amdgcn_mfma_f32_16x16x32_bf16(b1, xb[sblk], acc[t], 0, 0, 0); }
#pragma unroll
                for (int t = 0; t < 3; ++t) st_bf16x4(IK + ikf_off(m >> 11, NMETA + (m & (SEQ - 1)), 16 * t + 4 * nq), acc[t]);
            } else {
                f32x4 acc[2] = {{0.f, 0.f, 0.f, 0.f}, {0.f, 0.f, 0.f, 0.f}};
#pragma unroll
                for (int sblk = 0; sblk < 16; ++sblk)
#pragma unroll
                    for (int t = 0; t < 2; ++t) { const bf16x8 b0 = *(const LAS bf16x8*)(wb + 16 * (3 + t) * WBP + 128 * sblk), b1 = *(const LAS bf16x8*)(wb + 16 * (3 + t) * WBP + 128 * sblk + 16);
                        acc[t] = __builtin_amdgcn_mfma_f32_16x16x32_bf16(b0, xa[sblk], acc[t], 0, 0, 0); acc[t] = __builtin_amdgcn_mfma_f32_16x16x32_bf16(b1, xb[sblk], acc[t], 0, 0, 0); }
                st_bf16x4(IK + ikf_off(m >> 11, NMETA + (m & (SEQ - 1)), 48 + 4 * nq), acc[0]);
                if (nq < 2) *(f32x4*)(IW + (size_t)m * 8 + 4 * nq) = acc[1];
            }
        }
        __syncthreads();
    }
    if (!(dbgflags & 256)) for (int task = gw; task < 100; task += NGW) {
        if (task < 32) {
            const bf16_t* const Bt[1] = {WIN + (size_t)(SC_K + 16 * task) * DM}; f32x4 acc[1]; wave_mm16<1>(XNM, DM, Bt, DM, lane, acc);
            for (int b = 0; b < NB; ++b) st_bf16x4(KB + (size_t)(b * TT + tk) * AW + 16 * task + 4 * nq, acc[0]);
        } else if (task < 64) {
            const int t = task - 32; const bf16_t* const Bt[1] = {WIN + (size_t)(SC_V + 16 * t) * DM}; f32x4 acc[1]; wave_mm16<1>(XNM, DM, Bt, DM, lane, acc);
            const float p0 = __shfl_xor(acc[0][0], 1), p1 = __shfl_xor(acc[0][1], 1), p2 = __shfl_xor(acc[0][2], 1), p3 = __shfl_xor(acc[0][3], 1);
            const unsigned wa = (tk & 1) ? cvt_pk_bf16(p2, acc[0][2]) : cvt_pk_bf16(acc[0][0], p0), wb = (tk & 1) ? cvt_pk_bf16(p3, acc[0][3]) : cvt_pk_bf16(acc[0][1], p1);
            for (int b = 0; b < NB; ++b) { bf16_t* cp = VT + ((size_t)b * AW + 16 * t + 4 * nq + 2 * (tk & 1)) * TP + VOFF + (tk & ~1);
                *(unsigned*)cp = wa; *(unsigned*)(cp + TP) = wb; }
        } else if (task < 68) {
            const int t = task - 64; const bf16_t* const Bt[1] = {WIN + (size_t)(WR_IK + 16 * t) * DM}; f32x4 acc[1]; wave_mm16<1>(XNM, DM, Bt, DM, lane, acc);
            for (int b = 0; b < NB; ++b) st_bf16x4(IK + ikf_off(b, tk, 16 * t + 4 * nq), acc[0]);
        } else {
            const int c16 = task - 68; const int ar = WR_GLU + 256 * (c16 >> 3) + 16 * (c16 & 7);
            const bf16_t* const Bt[2] = {WIN + (size_t)ar * DM, WIN + (size_t)(ar + 128) * DM}; f32x4 acc[2]; wave_mm16<2>(XNM, DM, Bt, DM, lane, acc);
            f32x4 y;
#pragma unroll
            for (int j = 0; j < 4; ++j) y[j] = acc[0][j] * sigmoidf_(acc[1][j]);
            for (int b = 0; b < NB; ++b) st_bf16x4(GLU + (size_t)(b * TT + tk) * CC + 16 * c16 + 4 * nq, y);
        }
    }
}

__device__ __forceinline__ void p2_conv(Frame& F, const Args& a) {
    unsigned char* ws = F.ws;
    LAS unsigned char* xs = F.lds;
    LAS float* wl = (LAS float*)(F.lds + 63488);
    const bf16_t* GLU = wsp<bf16_t>(ws, WS_GLU); bf16_t* CO = wsp<bf16_t>(ws, WS_CO);
    const float* cw = a.in[I_CONVW];
    for (int idx = F.tid; idx < CW * 128; idx += NTHREADS) { const int tap = idx >> 7, c4 = idx & 127; const f32x4 v = *(const f32x4*)(cw + tap * CC + 4 * c4); *(LAS f32x4*)(wl + tap * 512 + (c4 & 1) * 256 + (c4 >> 1) * 4) = v; }
    const int lane = F.lane, c0 = 8 * lane;
    for (int tile = F.bid; tile < NTOK / 32; tile += F.G) {
        const int b = tile >> 6, s0 = (tile & 63) * 32, p0 = NMETA + s0;
        __syncthreads();
        for (int idx = F.tid; idx < 62 * 64; idx += NTHREADS) { const int r = idx >> 6, ch = idx & 63, p = p0 - 30 + r; u32x4 v = (u32x4){0u, 0u, 0u, 0u};
            if (p >= 0) v = *(const u32x4*)(GLU + (size_t)(b * TT + p) * CC + ch * 8);
            *(LAS u32x4*)(xs + r * 1024 + ch * 16) = v; }
        __syncthreads();
        const int i0 = 4 * F.wave;
        float acc[4][8];
#pragma unroll
        for (int t = 0; t < 4; ++t)
#pragma unroll
            for (int i = 0; i < 8; ++i) acc[t][i] = 0.f;
        const LAS float* wlb = wl + lane * 4; asm volatile("" : "+v"(wlb));
        const LAS unsigned char* xsb = xs + i0 * 1024 + lane * 16; asm volatile("" : "+v"(xsb));
#pragma unroll 1
        for (int tap = 0; tap < CW; ++tap) {
            const f32x4 w0 = *(const LAS f32x4*)(wlb + tap * 512), w1 = *(const LAS f32x4*)(wlb + tap * 512 + 256);
#pragma unroll
            for (int t = 0; t < 4; ++t) {
                const u32x4 xv = *(const LAS u32x4*)(xsb + (tap + t) * 1024);
                acc[t][0] += w0[0] * bflo(xv.x); acc[t][1] += w0[1] * bfhi(xv.x); acc[t][2] += w0[2] * bflo(xv.y); acc[t][3] += w0[3] * bfhi(xv.y);
                acc[t][4] += w1[0] * bflo(xv.z); acc[t][5] += w1[1] * bfhi(xv.z); acc[t][6] += w1[2] * bflo(xv.w); acc[t][7] += w1[3] * bfhi(xv.w);
            }
        }
        float cb[8], lg[8], lb[8];
        { const f32x4* p0 = (const f32x4*)(a.in[I_CONVB] + c0); const f32x4* p1 = (const f32x4*)(a.in[I_LNG] + c0); const f32x4* p2 = (const f32x4*)(a.in[I_LNB] + c0);
#pragma unroll
          for (int hh = 0; hh < 2; ++hh) { const f32x4 u0 = p0[hh], u1 = p1[hh], u2 = p2[hh];
#pragma unroll
              for (int i = 0; i < 4; ++i) { cb[4 * hh + i] = u0[i]; lg[4 * hh + i] = u1[i]; lb[4 * hh + i] = u2[i]; } } }
#pragma unroll
        for (int t = 0; t < 4; ++t) {
            float s = 0.f;
#pragma unroll
            for (int i = 0; i < 8; ++i) { acc[t][i] += cb[i]; s += acc[t][i]; }
            const float mean = wave_sum(s) * (1.f / CC); float q = 0.f;
#pragma unroll
            for (int i = 0; i < 8; ++i) { acc[t][i] -= mean; q += acc[t][i] * acc[t][i]; }
            const float rstd = 1.0f / sqrtf(wave_sum(q) * (1.f / CC) + EPS);
            float y[8];
#pragma unroll
            for (int i = 0; i < 8; ++i) { const float z = acc[t][i] * rstd * lg[i] + lb[i]; y[i] = z * sigmoidf_(z); }
            u32x4 o; o.x = cvt_pk_bf16(y[0], y[1]); o.y = cvt_pk_bf16(y[2], y[3]); o.z = cvt_pk_bf16(y[4], y[5]); o.w = cvt_pk_bf16(y[6], y[7]);
            *(u32x4*)(CO + (size_t)(b * SEQ + s0 + i0 + t) * CC + c0) = o;
        }
    }
    __syncthreads();
}

constexpr int ROWP = 2080, NJ = 33;
__device__ __forceinline__ unsigned f2ord(float f) { const unsigned b = __float_as_uint(f); return b ^ ((b >> 31) ? 0xffffffffu : 0x80000000u); }
__device__ __forceinline__ int wave_isum(int v) {
#pragma unroll
    for (int o = 1; o < 64; o <<= 1) v += __shfl_xor(v, o);
    return v;
}
__device__ __forceinline__ int wave_isum_dpp(int v) {
    v += __builtin_amdgcn_update_dpp(0, v, 0xB1, 0xF, 0xF, false);
    v += __builtin_amdgcn_update_dpp(0, v, 0x4E, 0xF, 0xF, false);
    v += __builtin_amdgcn_update_dpp(0, v, 0x141, 0xF, 0xF, false);
    v += __builtin_amdgcn_update_dpp(0, v, 0x140, 0xF, 0xF, false);
    return __builtin_amdgcn_readlane(v, 0) + __builtin_amdgcn_readlane(v, 16) + __builtin_amdgcn_readlane(v, 32) + __builtin_amdgcn_readlane(v, 48);
}
__device__ __forceinline__ void p2_indexer_unit(Frame& F, int b, int q16, int flags) {
    unsigned char* ws = F.ws;
    const bf16_t* IQ = wsp<bf16_t>(ws, WS_IQ); const bf16_t* IK = wsp<bf16_t>(ws, WS_IK); const float* IW = wsp<float>(ws, WS_IW); unsigned* MASK = wsp<unsigned>(ws, WS_MASK);
    LAS unsigned* SU = (LAS unsigned*)F.lds;
    const int lane = F.lane, c = lane & 31, hi = lane >> 5, w = F.wave;
    const int nwblk = (q16 >> 1) + 2;
    if (!(flags & 4)) {
        const int tok0 = b * SEQ + 16 * q16;
        bf16x8 af[4][4]; f32x4 wq[4][4];
#pragma unroll
        for (int g = 0; g < 4; ++g) {
            const bf16_t* ap = IQ + (size_t)(tok0 + 4 * g + (c >> 3)) * AW + (c & 7) * IDXD + 8 * hi;
#pragma unroll
            for (int ks = 0; ks < 4; ++ks) af[g][ks] = *(const bf16x8*)(ap + 16 * ks);
#pragma unroll
            for (int q = 0; q < 4; ++q) wq[g][q] = *(const f32x4*)(IW + (size_t)(tok0 + 4 * g + q) * 8 + 4 * hi);
        }
        const int rel0 = NMETA + 16 * q16 + 2 * hi - c;
        const bf16_t* kp = IK + (size_t)b * IKBLK * 2048 + lane * 8;
        LAS unsigned* srow = SU + (2 * hi) * ROWP + c;
        bf16x8 bfr[4], bnx[4];
#pragma unroll
        for (int ks = 0; ks < 4; ++ks) { bfr[ks] = *(const bf16x8*)(kp + (size_t)(w < nwblk ? w : 0) * 2048 + 512 * ks); bnx[ks] = bfr[ks]; }
#pragma unroll
        for (int g = 0; g < 4; ++g) asm volatile("" :: "v"(af[g][0]), "v"(af[g][1]), "v"(af[g][2]), "v"(af[g][3]), "v"(wq[g][0]), "v"(wq[g][1]), "v"(wq[g][2]), "v"(wq[g][3]));
        asm volatile("" :: "v"(bfr[0]), "v"(bfr[1]), "v"(bfr[2]), "v"(bfr[3]));
        for (int blk = w; blk < nwblk; blk += 8) {
            {
                const int bn_ = blk + 8 < nwblk ? blk + 8 : blk;
#pragma unroll
                for (int ks = 0; ks < 4; ++ks) bnx[ks] = *(const bf16x8*)(kp + (size_t)bn_ * 2048 + 512 * ks); }
#pragma unroll
            for (int g = 0; g < 4; ++g) {
                f32x16 acc = {};
#pragma unroll
                for (int ks = 0; ks < 4; ++ks) acc = __builtin_amdgcn_mfma_f32_32x32x16_bf16(af[g][ks], bfr[ks], acc, 0, 0, 0);
                float part[4];
#pragma unroll
                for (int q = 0; q < 4; ++q) { float s = wq[g][q][0] * __builtin_amdgcn_fmed3f(acc[4 * q], 0.f, INFINITY);
#pragma unroll
                    for (int i = 1; i < 4; ++i) s = __builtin_fmaf(wq[g][q][i], __builtin_amdgcn_fmed3f(acc[4 * q + i], 0.f, INFINITY), s);
                    part[q] = s; }
#pragma unroll
                for (int p = 0; p < 2; ++p) {
                    const auto rr = __builtin_amdgcn_permlane32_swap(__float_as_uint(part[p]), __float_as_uint(part[p + 2]), false, false);
                    const float sc = __uint_as_float(rr[0]) + __uint_as_float(rr[1]);
                    srow[(4 * g + p) * ROWP + 32 * blk] = (32 * blk <= rel0 + 4 * g + p) ? f2ord(sc) : 0u; }
            }
#pragma unroll
            for (int ks = 0; ks < 4; ++ks) bfr[ks] = bnx[ks];
        }
    }
    __syncthreads();
    if (!(flags & 8)) {
        const int nj = (nwblk + 1) >> 1, klim = 32 * nwblk;
        unsigned U[NJ][2];
#pragma unroll
        for (int j = 0; j < NJ; ++j) {
            if (j < nj) { const int key = 64 * j + lane;
#pragma unroll
                for (int p = 0; p < 2; ++p) U[j][p] = (key < klim) ? SU[(2 * w + p) * ROWP + key] : 0u; }
            else { U[j][0] = 0u; U[j][1] = 0u; }
        }
        const int tokb = b * SEQ + 16 * q16 + 2 * w;
        unsigned lo[2], hb[2], thr[2], veq[2]; int chi[2], need[2]; bool done[2];
#pragma unroll
        for (int p = 0; p < 2; ++p) { lo[p] = 1u; hb[p] = 0xffffffffu; chi[p] = 0; need[p] = 0; veq[p] = 0u; thr[p] = 1u; done[p] = (NMETA + 16 * q16 + 2 * w + p + 1 <= TOPK); }
        for (int it = 0; it < 34; ++it) {
            if (done[0] && done[1]) break;
            unsigned mid[2]; int cl[2];
#pragma unroll
            for (int p = 0; p < 2; ++p) { mid[p] = lo[p] + ((hb[p] - lo[p]) >> 1); cl[p] = 0; }
#pragma unroll
            for (int g = 0; g < 3; ++g) if (11 * g < nj) {
#pragma unroll
                for (int jj = 0; jj < 11; ++jj)
#pragma unroll
                    for (int p = 0; p < 2; ++p) cl[p] += (U[11 * g + jj][p] >= mid[p]) ? 1 : 0; }
            const int tot = wave_isum_dpp(cl[0] | (cl[1] << 16));
            int cnt[2] = {tot & 0xffff, tot >> 16};
#ifdef DBG_CHECK_DPP
            if (wave_isum(cl[0]) != cnt[0] || wave_isum(cl[1]) != cnt[1]) __hip_atomic_store(wsp<unsigned>(ws, WS_CTL) + 3, 1u, RLX_AGENT);
#endif
#pragma unroll
            for (int p = 0; p < 2; ++p) {
                const int ct = cnt[p];
                if (!done[p]) {
                    if (ct == TOPK) { done[p] = true; thr[p] = mid[p]; need[p] = 0; }
                    else if (ct > TOPK) lo[p] = mid[p];
                    else { hb[p] = mid[p]; chi[p] = ct; }
                    if (!done[p] && hb[p] - lo[p] == 1u) { done[p] = true; thr[p] = hb[p]; veq[p] = lo[p]; need[p] = TOPK - chi[p]; }
                }
            }
        }
#pragma unroll
        for (int p = 0; p < 2; ++p) {
            int run = 0, wlo = 0, whi = 0;
#ifdef DBG_CHECK_SEL
            int selcnt = 0;
#endif
            const bool tied = need[p] > 0;
#pragma unroll
            for (int j = 0; j < NJ; ++j) if (j < nj) {
                const unsigned u = U[j][p];
                bool take = (u >= thr[p]);
                if (tied) {
                    const bool eq = (u == veq[p]);
                    const unsigned long long em = __ballot(eq);
                    const int rank = run + (int)__builtin_amdgcn_mbcnt_hi((unsigned)(em >> 32), __builtin_amdgcn_mbcnt_lo((unsigned)em, 0u));
                    take = take || (eq && rank < need[p]);
                    run += __popcll(em);
                }
                const unsigned long long sm = __ballot(take);
                wlo = (lane == j) ? (int)(unsigned)sm : wlo; whi = (lane == j) ? (int)(unsigned)(sm >> 32) : whi;
#ifdef DBG_CHECK_SEL
                selcnt += __popcll(sm);
#endif
            }
            unsigned long long* mrow = (unsigned long long*)(MASK + (size_t)(tokb + p) * MSTR);
            if (lane < nj) mrow[lane] = ((unsigned long long)(unsigned)whi << 32) | (unsigned)wlo;
#ifdef DBG_CHECK_SEL
            { const int nv = NMETA + 16 * q16 + 2 * w + p + 1; if (selcnt != (nv < TOPK ? nv : TOPK)) __hip_atomic_store(wsp<unsigned>(ws, WS_CTL) + 3, 1u, RLX_AGENT); }
#endif
        }
    }
    __syncthreads();
}
__device__ __forceinline__ void p2_indexer(Frame& F, int flags, int half) {
    for (int i = F.bid; i < 256; i += F.G) { const int b = i >> 5, j = 2 * (i & 31);
        if (half == 0) { p2_indexer_unit(F, b, j, flags); p2_indexer_unit(F, b, 127 - j, flags); }
        else { p2_indexer_unit(F, b, j + 1, flags); p2_indexer_unit(F, b, 126 - j, flags); } }
}

__device__ const unsigned char T5B[128] = {0, 1, 2, 3, 4, 5, 6, 7, 8, 9, 10, 11, 12, 13, 14, 15, 16, 16, 16, 17, 17, 18, 18, 18, 19, 19, 19, 20, 20, 20, 20, 21, 21, 21, 21, 22, 22, 22, 22, 22, 23, 23, 23, 23, 23, 23, 24, 24, 24, 24, 24, 24, 25, 25, 25, 25, 25, 25, 25, 26, 26, 26, 26, 26, 26, 26, 26, 27, 27, 27, 27, 27, 27, 27, 27, 27, 27, 28, 28, 28, 28, 28, 28, 28, 28, 28, 28, 29, 29, 29, 29, 29, 29, 29, 29, 29, 29, 29, 29, 30, 30, 30, 30, 30, 30, 30, 30, 30, 30, 30, 30, 30, 30, 31, 31, 31, 31, 31, 31, 31, 31, 31, 31, 31, 31, 31, 31, 31};
constexpr int TBS = 132;
__device__ __forceinline__ int crow(int r, int hi) { return (r & 3) + 8 * (r >> 2) + 4 * hi; }
constexpr int KPITCH = 144, VPITCH = 136;
constexpr int AT_K = 0, AT_V = AT_K + 2 * 64 * KPITCH, AT_TB = AT_V + 2 * 64 * VPITCH, AT_SC = AT_TB + NH * TBS * 4, AT_END = AT_SC + NWAVES * 128;
static_assert(AT_END <= RING_BYTES, "attention LDS map");
__device__ __forceinline__ void p3_attn_unit(Frame& F, int b, int h, int Q) {
    unsigned char* ws = F.ws;
    const bf16_t* Qm = wsp<bf16_t>(ws, WS_Q); const bf16_t* KB = wsp<bf16_t>(ws, WS_KB); const bf16_t* VT = wsp<bf16_t>(ws, WS_VT); const unsigned* MASK = wsp<unsigned>(ws, WS_MASK); bf16_t* AO = wsp<bf16_t>(ws, WS_AO);
    LAS unsigned char* lds = F.lds;
    const LAS float* tbh = (const LAS float*)(lds + AT_TB) + h * TBS;
    LAS float* sc = (LAS float*)(lds + AT_SC) + F.wave * 32;
    const int tid = F.tid, lane = F.lane, c = lane & 31, hi = lane >> 5, w = F.wave;
    const int qb32 = 8 * Q + w, tokq = b * SEQ + 32 * qb32 + c, posq = NMETA + 32 * qb32 + c;
    const int ktmax = (47 + 32 * qb32) >> 6, NT = 4 * Q + 5;
    bf16x8 qf[4];
#pragma unroll
    for (int ks = 0; ks < 4; ++ks) qf[ks] = *(const bf16x8*)(Qm + (size_t)tokq * AW + h * HD + 16 * ks + 8 * hi);
    const unsigned long long* mrow = (const unsigned long long*)(MASK + (size_t)tokq * MSTR);
    const int srow = tid >> 3, piece = tid & 7;
    const bf16_t* kg = KB + (size_t)(b * TT + srow) * AW + h * HD + piece * 8;
    const bf16_t* vg = VT + ((size_t)b * AW + h * HD + srow) * TP + piece * 8;
    LAS unsigned char* kl = lds + AT_K + srow * KPITCH + piece * 16;
    LAS unsigned char* vl = lds + AT_V + srow * VPITCH + piece * 16;
    const LAS unsigned char* kfb = lds + AT_K + c * KPITCH + 16 * hi;
    const LAS unsigned char* vfb = lds + AT_V + c * VPITCH + 8 * hi;
    const unsigned NEGB = 0xff800000u;
    const float bfar = tbh[128];
    float m_abs = 0.f; bool has = false;
    f32x16 O0 = {}, O1 = {}, LS = {}, CI;
#pragma unroll
    for (int r = 0; r < 16; ++r) CI[r] = bfar;
    const bf16x8 ones = __builtin_bit_cast(bf16x8, ((u32x4){0x3f803f80u, 0x3f803f80u, 0x3f803f80u, 0x3f803f80u}));
    u32x4 kr = *(const u32x4*)kg, vr = *(const u32x4*)vg;
    unsigned long long mwn = mrow[0];
    *(LAS u32x4*)kl = kr; *(LAS u32x2*)vl = (u32x2){vr.x, vr.y}; *(LAS u32x2*)(vl + 8) = (u32x2){vr.z, vr.w};
    __syncthreads();
    for (int kt = 0; kt < NT; ++kt) {
        const int buf = kt & 1;
        const unsigned long long mw = mwn;
        if (kt + 1 < NT) { kr = *(const u32x4*)(kg + (size_t)(kt + 1) * 64 * AW); vr = *(const u32x4*)(vg + (kt + 1) * 64); if (kt + 1 <= ktmax) mwn = mrow[kt + 1]; }
        if (kt <= ktmax) {
            const LAS unsigned char* kp = kfb + buf * 64 * KPITCH;
            f32x16 S0 = CI, S1 = CI;
#pragma unroll
            for (int ks = 0; ks < 4; ++ks) {
                const bf16x8 k0 = *(const LAS bf16x8*)(kp + ks * 32), k1 = *(const LAS bf16x8*)(kp + 32 * KPITCH + ks * 32);
                S0 = __builtin_amdgcn_mfma_f32_32x32x16_bf16(k0, qf[ks], S0, 0, 0, 0);
                S1 = __builtin_amdgcn_mfma_f32_32x32x16_bf16(k1, qf[ks], S1, 0, 0, 0);
            }
            const int mw0 = (int)((unsigned)mw >> (4 * hi)), mw1 = (int)((unsigned)(mw >> 32) >> (4 * hi));
            const bool far = (256 * Q + 32 * w - 64 * kt) >= 175;
            if (!far) {
                const int d0 = posq - 64 * kt - 4 * hi;
#pragma unroll
                for (int r = 0; r < 16; ++r) { const int ko = (r & 3) + 8 * (r >> 2);
                    int da = d0 - ko, db = d0 - 32 - ko; da = da < 0 ? 0 : (da > 128 ? 128 : da); db = db < 0 ? 0 : (db > 128 ? 128 : db);
                    S0[r] += tbh[da] - bfar; S1[r] += tbh[db] - bfar; }
            }
            float tmax = -INFINITY;
#pragma unroll
            for (int r = 0; r < 16; ++r) { const int ko = (r & 3) + 8 * (r >> 2);
                const unsigned t0 = (unsigned)__builtin_amdgcn_sbfe(mw0, ko, 1), t1 = (unsigned)__builtin_amdgcn_sbfe(mw1, ko, 1);
                S0[r] = __uint_as_float((__float_as_uint(S0[r]) & t0) | (NEGB & ~t0)); S1[r] = __uint_as_float((__float_as_uint(S1[r]) & t1) | (NEGB & ~t1));
                tmax = fmaxf(tmax, fmaxf(S0[r], S1[r])); }
            tmax = fmaxf(tmax, __shfl_xor(tmax, 32));
            if (__any(tmax > 8.0f || (!has && tmax > -INFINITY))) {
                const bool upd = tmax > -INFINITY && (!has || tmax > 0.f);
                const float dl = upd ? tmax : 0.f;
                const float alpha = has ? __builtin_amdgcn_exp2f(-dl) : 1.0f;
                m_abs += dl; has = has || upd;
#pragma unroll
                for (int r = 0; r < 16; ++r) { S0[r] -= dl; S1[r] -= dl; CI[r] = bfar - m_abs; }
                if (hi == 0) sc[c] = alpha;
                LDS_WAIT(); asm volatile("" ::: "memory");
#pragma unroll
                for (int r = 0; r < 16; ++r) { const float f = sc[crow(r, hi)]; O0[r] *= f; O1[r] *= f; LS[r] *= f; }
                LDS_WAIT(); asm volatile("" ::: "memory");
            }
#pragma unroll
            for (int r = 0; r < 16; ++r) { S0[r] = __builtin_amdgcn_exp2f(S0[r]); S1[r] = __builtin_amdgcn_exp2f(S1[r]); }
            const LAS unsigned char* vp = vfb + buf * 64 * VPITCH;
#pragma unroll
            for (int s2 = 0; s2 < 4; ++s2) {
                u32x4 pw;
                if (s2 < 2) { const int o = 8 * (s2 & 1); pw.x = cvt_pk_bf16(S0[o + 0], S0[o + 1]); pw.y = cvt_pk_bf16(S0[o + 2], S0[o + 3]); pw.z = cvt_pk_bf16(S0[o + 4], S0[o + 5]); pw.w = cvt_pk_bf16(S0[o + 6], S0[o + 7]); }
                else { const int o = 8 * (s2 & 1); pw.x = cvt_pk_bf16(S1[o + 0], S1[o + 1]); pw.y = cvt_pk_bf16(S1[o + 2], S1[o + 3]); pw.z = cvt_pk_bf16(S1[o + 4], S1[o + 5]); pw.w = cvt_pk_bf16(S1[o + 6], S1[o + 7]); }
                const bf16x8 pf = __builtin_bit_cast(bf16x8, pw);
                const u32x2 a0 = *(const LAS u32x2*)(vp + s2 * 32), a1 = *(const LAS u32x2*)(vp + s2 * 32 + 16);
                const u32x2 b0 = *(const LAS u32x2*)(vp + 32 * VPITCH + s2 * 32), b1 = *(const LAS u32x2*)(vp + 32 * VPITCH + s2 * 32 + 16);
                const bf16x8 v0 = __builtin_bit_cast(bf16x8, ((u32x4){a0.x, a0.y, a1.x, a1.y})), v1 = __builtin_bit_cast(bf16x8, ((u32x4){b0.x, b0.y, b1.x, b1.y}));
                O0 = __builtin_amdgcn_mfma_f32_32x32x16_bf16(pf, v0, O0, 0, 0, 0);
                O1 = __builtin_amdgcn_mfma_f32_32x32x16_bf16(pf, v1, O1, 0, 0, 0);
                LS = __builtin_amdgcn_mfma_f32_32x32x16_bf16(pf, ones, LS, 0, 0, 0);
            }
        }
        if (kt + 1 < NT) { LAS unsigned char* k2 = kl + (buf ^ 1) * 64 * KPITCH; LAS unsigned char* v2 = vl + (buf ^ 1) * 64 * VPITCH;
            *(LAS u32x4*)k2 = kr; *(LAS u32x2*)v2 = (u32x2){vr.x, vr.y}; *(LAS u32x2*)(v2 + 8) = (u32x2){vr.z, vr.w}; }
        __syncthreads();
    }
    bf16_t* ob = AO + (size_t)(b * SEQ + 32 * qb32) * AW + h * HD + c;
#pragma unroll
    for (int r = 0; r < 16; ++r) { const int qr = crow(r, hi); const float f = __builtin_amdgcn_rcpf(LS[r]);
        const float a0 = O0[r] * f, a1 = O1[r] * f, b0 = __shfl_xor(a0, 1), b1 = __shfl_xor(a1, 1);
        if ((c & 1) == 0) { *(unsigned*)(ob + (size_t)qr * AW) = cvt_pk_bf16(a0, b0); *(unsigned*)(ob + (size_t)qr * AW + 32) = cvt_pk_bf16(a1, b1); } }
}
__device__ __forceinline__ void p3_attn(Frame& F, const Args& a) {
    LAS float* tb = (LAS float*)(F.lds + AT_TB);
    __syncthreads();
    for (int idx = F.tid; idx < NH * 129; idx += NTHREADS) { const int h = idx / 129, d = idx % 129; const int bk = d < 128 ? (int)T5B[d] : 31; tb[h * TBS + d] = a.in[I_RELB][bk * NH + h] * LOG2E; }
    __syncthreads();
    for (int i = F.bid; i < 256; i += F.G) { const int bh = i >> 2, j = i & 3; p3_attn_unit(F, bh >> 3, bh & 7, j); p3_attn_unit(F, bh >> 3, bh & 7, 7 - j); }
    __syncthreads();
}

constexpr int WLP = 2064;
constexpr int P6_WHI = 0, P6_WLO = NE * WLP, P6_PART = 2 * NE * WLP, P6_SSP = P6_PART + 2 * 64 * 33 * 4, P6_CNT = P6_SSP + 2 * 64 * 4, P6_END = P6_CNT + 256;
static_assert(P6_END <= LDSX_OFF, "router LDS map");
__device__ __forceinline__ void p6_router(Frame& F, const Args& a) {
    unsigned char* ws = F.ws;
    const float* H1 = wsp<float>(ws, WS_H1); bf16_t* HN = wsp<bf16_t>(ws, WS_XN);
    const float* gf = a.in[I_NFFN]; const float* brt = a.in[I_BR];
    int* TE = wsp<int>(ws, WS_TE); int* TPs = wsp<int>(ws, WS_TP); int* LIST = wsp<int>(ws, WS_LIST); float* LG = wsp<float>(ws, WS_LG); float* RG = wsp<float>(ws, WS_RG);
    unsigned* ecnt = wsp<unsigned>(ws, WS_CTL) + CW_ECNT;
    LAS unsigned char* lds = F.lds;
    LAS float* part = (LAS float*)(lds + P6_PART);
    LAS float* ssp = (LAS float*)(lds + P6_SSP);
    LAS int* lcnt = (LAS int*)(lds + P6_CNT);
    LAS int* lbase = lcnt + 32;
    const int lane = F.lane, w = F.wave, tk = lane & 15, kq = lane >> 4;
    __syncthreads();
    { const unsigned char* src = ws + WS_WRT;
      for (int p = F.tid; p < 2 * NE * 128; p += NTHREADS) { const int arr = p >> 12, row = (p >> 7) & 31, c16 = p & 127;
          *(LAS u32x4*)(lds + arr * (NE * WLP) + row * WLP + c16 * 16) = *(const u32x4*)(src + (size_t)arr * NE * DM * 2 + (size_t)row * DM * 2 + c16 * 16); } }
    for (int tb = F.bid; tb < NTOK / 64; tb += F.G) {
        const int t0 = tb * 64;
        __syncthreads();
        if (F.tid < 32) lcnt[F.tid] = 0;
        {
            const int tg = w & 3, kh = w >> 2, tok = t0 + 16 * tg + tk;
            const float* xr = H1 + (size_t)tok * DM + 512 * kh + 8 * kq; const float* gr = gf + 512 * kh + 8 * kq;
            bf16_t* hr = HN + (size_t)tok * DM + 512 * kh + 8 * kq;
            const LAS unsigned char* wl = lds + tk * WLP + (512 * kh + 8 * kq) * 2;
            f32x4 xa[16], xb[16];
#pragma unroll
            for (int ks = 0; ks < 16; ++ks) { xa[ks] = *(const f32x4*)(xr + 32 * ks); xb[ks] = *(const f32x4*)(xr + 32 * ks + 4); }
            f32x4 acc0 = {0.f, 0.f, 0.f, 0.f}, acc1 = acc0; float ss = 0.f;
#pragma unroll
            for (int ks = 0; ks < 16; ++ks) {
                const f32x4 g0 = *(const f32x4*)(gr + 32 * ks), g1 = *(const f32x4*)(gr + 32 * ks + 4);
                const f32x4 x0 = xa[ks], x1 = xb[ks];
                u32x4 hn; hn.x = cvt_pk_bf16(x0[0] * g0[0], x0[1] * g0[1]); hn.y = cvt_pk_bf16(x0[2] * g0[2], x0[3] * g0[3]); hn.z = cvt_pk_bf16(x1[0] * g1[0], x1[1] * g1[1]); hn.w = cvt_pk_bf16(x1[2] * g1[2], x1[3] * g1[3]);
                *(u32x4*)(hr + 32 * ks) = hn;
                ss += (x0[0] * x0[0] + x0[1] * x0[1]) + (x0[2] * x0[2] + x0[3] * x0[3]) + (x1[0] * x1[0] + x1[1] * x1[1]) + (x1[2] * x1[2] + x1[3] * x1[3]);
                u32x4 xh; xh.x = cvt_pk_bf16(x0[0], x0[1]); xh.y = cvt_pk_bf16(x0[2], x0[3]); xh.z = cvt_pk_bf16(x1[0], x1[1]); xh.w = cvt_pk_bf16(x1[2], x1[3]);
                u32x4 xl; xl.x = cvt_pk_bf16(x0[0] - bflo(xh.x), x0[1] - bfhi(xh.x)); xl.y = cvt_pk_bf16(x0[2] - bflo(xh.y), x0[3] - bfhi(xh.y));
                          xl.z = cvt_pk_bf16(x1[0] - bflo(xh.z), x1[1] - bfhi(xh.z)); xl.w = cvt_pk_bf16(x1[2] - bflo(xh.w), x1[3] - bfhi(xh.w));
                const bf16x8 fxh = __builtin_bit_cast(bf16x8, xh), fxl = __builtin_bit_cast(bf16x8, xl);
                const bf16x8 wh0 = *(const LAS bf16x8*)(wl + P6_WHI + ks * 64), wh1 = *(const LAS bf16x8*)(wl + P6_WHI + 16 * WLP + ks * 64);
                const bf16x8 wl0 = *(const LAS bf16x8*)(wl + P6_WLO + ks * 64), wl1 = *(const LAS bf16x8*)(wl + P6_WLO + 16 * WLP + ks * 64);
                acc0 = __builtin_amdgcn_mfma_f32_16x16x32_bf16(wh0, fxh, acc0, 0, 0, 0); acc1 = __builtin_amdgcn_mfma_f32_16x16x32_bf16(wh1, fxh, acc1, 0, 0, 0);
                acc0 = __builtin_amdgcn_mfma_f32_16x16x32_bf16(wl0, fxh, acc0, 0, 0, 0); acc1 = __builtin_amdgcn_mfma_f32_16x16x32_bf16(wl1, fxh, acc1, 0, 0, 0);
                acc0 = __builtin_amdgcn_mfma_f32_16x16x32_bf16(wh0, fxl, acc0, 0, 0, 0); acc1 = __builtin_amdgcn_mfma_f32_16x16x32_bf16(wh1, fxl, acc1, 0, 0, 0);
            }
            ss += __shfl_xor(ss, 16); ss += __shfl_xor(ss, 32);
            LAS float* pp = part + ((kh * 64) + 16 * tg + tk) * 33 + 4 * kq;
#pragma unroll
            for (int r = 0; r < 4; ++r) { pp[r] = acc0[r]; pp[16 + r] = acc1[r]; }
            if (kq == 0) ssp[kh * 64 + 16 * tg + tk] = ss;
        }
        __syncthreads();
        if (w == 0) {
            const float rinv = 1.0f / sqrtf((ssp[lane] + ssp[64 + lane]) * (1.f / DM) + EPS);
            float lg[NE];
#pragma unroll
            for (int e = 0; e < NE; ++e) lg[e] = (part[lane * 33 + e] + part[(64 + lane) * 33 + e]) * rinv + brt[e];
            int sel[4]; float val[4];
#pragma unroll
            for (int j = 0; j < 4; ++j) { float best = -INFINITY; int bi = 0;
#pragma unroll
                for (int e = 0; e < NE; ++e) { const bool tk_ = lg[e] > best; best = tk_ ? lg[e] : best; bi = tk_ ? e : bi; }
                sel[j] = bi; val[j] = best;
#pragma unroll
                for (int e = 0; e < NE; ++e) lg[e] = (e == bi) ? -INFINITY : lg[e]; }
            float den = 0.f, ex[4];
#pragma unroll
            for (int j = 0; j < 4; ++j) { ex[j] = __expf(val[j] - val[0]); den += ex[j]; }
            int slot[4];
#pragma unroll
            for (int j = 0; j < 4; ++j) slot[j] = __hip_atomic_fetch_add(&lcnt[sel[j]], 1, __ATOMIC_RELAXED, __HIP_MEMORY_SCOPE_WORKGROUP);
            LDS_WAIT();
            if (lane < 32) { const int n = lcnt[lane]; lbase[lane] = n ? (int)__hip_atomic_fetch_add(ecnt + 64 * lane, (unsigned)n, RLX_AGENT) : 0; }
            LDS_WAIT(); asm volatile("" ::: "memory");
            const int t = t0 + lane;
#pragma unroll
            for (int j = 0; j < 4; ++j) { const int e = sel[j], pos = lbase[e] + slot[j]; const float g = ex[j] / den;
                TE[t * 4 + j] = e; TPs[t * 4 + j] = pos; LIST[(size_t)e * NTOK + pos] = t; LG[(size_t)e * NTOK + pos] = g; RG[(size_t)e * NTOK + pos] = rinv; }
        }
    }
    __syncthreads();
}
__device__ __forceinline__ void moe_tables(Frame& F, LAS int* cnt, LAS int* tbase) {
    const unsigned* ecnt = wsp<unsigned>(F.ws, WS_CTL) + CW_ECNT;
    __syncthreads();
    if (F.tid < NE) cnt[F.tid] = (int)__hip_atomic_load(ecnt + 64 * F.tid, RLX_AGENT);
    __syncthreads();
    if (F.tid == 0) { int s = 0; for (int e = 0; e < NE; ++e) { tbase[e] = s; s += (cnt[e] + 255) >> 8; } tbase[NE] = s; }
    __syncthreads();
}

__device__ __forceinline__ void p9_final(Frame& F, const Args& a, const LAS int* tbase) {
    unsigned char* ws = F.ws;
    const float* H1 = wsp<float>(ws, WS_H1); float* OUT = a.out; const bf16_t* YP = wsp<bf16_t>(ws, WS_YP); const int* TE = wsp<int>(ws, WS_TE); const int* TPs = wsp<int>(ws, WS_TP); const float* gf = a.in[I_NFIN];
    const int gw = F.bid * NWAVES + F.wave, NGW = F.G * NWAVES, lane = F.lane;
    const f32x4* gr = (const f32x4*)gf + lane;
    f32x4 gg[4];
#pragma unroll
    for (int j = 0; j < 4; ++j) gg[j] = gr[64 * j];
#ifdef DBG_CHECK_DPP
    if (__hip_atomic_load(wsp<unsigned>(ws, WS_CTL) + 3, RLX_AGENT) != 0u) { const float qn = __builtin_nanf("");
#pragma unroll
        for (int j = 0; j < 4; ++j) gg[j] = (f32x4){qn, qn, qn, qn}; }
#endif
    for (int base = 0; base < NTOK; base += 8 * NGW) {
        int myrow = 0;
        { const int i = lane >> 2, j = lane & 3, t = base + gw + NGW * i; if (lane < 32 && t < NTOK) { const int e = TE[t * 4 + j], pos = TPs[t * 4 + j]; myrow = tbase[e] * 256 + pos; } }
        f32x4 va[4], vb[4]; u32x2 ya[4][4], yb[4][4];
#define P9_LOAD(i, V, Y) do { const int t_ = base + gw + NGW * (i); if (t_ < NTOK) { const f32x4* xr_ = (const f32x4*)(H1 + (size_t)t_ * DM) + lane; \
            _Pragma("unroll") for (int j_ = 0; j_ < 4; ++j_) V[j_] = xr_[64 * j_]; \
            _Pragma("unroll") for (int q_ = 0; q_ < 4; ++q_) { const int row_ = __builtin_amdgcn_readlane(myrow, 4 * (i) + q_); const u32x2* yr_ = (const u32x2*)(YP + (size_t)row_ * DM) + lane; \
                _Pragma("unroll") for (int j_ = 0; j_ < 4; ++j_) Y[q_][j_] = yr_[64 * j_]; } } } while (0)
#define P9_PROC(i, V, Y) do { const int t_ = base + gw + NGW * (i); if (t_ < NTOK) { \
            _Pragma("unroll") for (int q_ = 0; q_ < 4; ++q_) _Pragma("unroll") for (int j_ = 0; j_ < 4; ++j_) { const u32x2 y_ = Y[q_][j_]; V[j_].x += bflo(y_.x); V[j_].y += bfhi(y_.x); V[j_].z += bflo(y_.y); V[j_].w += bfhi(y_.y); } \
            float s_ = 0.f; _Pragma("unroll") for (int j_ = 0; j_ < 4; ++j_) s_ += (V[j_].x * V[j_].x + V[j_].y * V[j_].y) + (V[j_].z * V[j_].z + V[j_].w * V[j_].w); \
            const float r_ = 1.0f / sqrtf(wave_sum(s_) * (1.f / DM) + EPS); f32x4* xo_ = (f32x4*)(OUT + (size_t)t_ * DM) + lane; \
            _Pragma("unroll") for (int j_ = 0; j_ < 4; ++j_) xo_[64 * j_] = (f32x4){V[j_].x * r_ * gg[j_].x, V[j_].y * r_ * gg[j_].y, V[j_].z * r_ * gg[j_].z, V[j_].w * r_ * gg[j_].w}; } } while (0)
        P9_LOAD(0, va, ya);
#pragma unroll
        for (int i = 0; i < 8; i += 2) {
            P9_LOAD(i + 1, vb, yb);
            P9_PROC(i, va, ya);
            if (i + 2 < 8) P9_LOAD(i + 2, va, ya);
            P9_PROC(i + 1, vb, yb);
        }
#undef P9_LOAD
#undef P9_PROC
    }
}

constexpr int N_PHASES = 10;
__global__ void __launch_bounds__(NTHREADS, 2) fwd_kernel(Args args) {
    extern __shared__ __attribute__((aligned(16))) unsigned char lds_raw[];
    Frame F;
    F.lds = (LAS unsigned char*)lds_raw; F.ws = args.ws;
    F.tid = threadIdx.x; F.lane = F.tid & 63; F.wave = __builtin_amdgcn_readfirstlane(F.tid >> 6);
    F.G = gridDim.x; F.bid = blockIdx.x;
    volatile LAS unsigned* MISC = (volatile LAS unsigned*)(F.lds + MISC_OFF);
    if (F.tid < 32) MISC[F.tid] = 0u;
    __syncthreads();
    unsigned* ctl = wsp<unsigned>(args.ws, WS_CTL);
    const int lo = args.ph_lo, hi = args.ph_hi;
    const bool multi = (hi - lo) > 1;
    XcdBarrier bar; bar.bar = ctl + CW_BAR; bar.x = 0; bar.st = nullptr;
    if (multi) bar = xcd_barrier_post(ctl + CW_BAR, MISC + 8);
#ifndef PHASE_MASK
#define PHASE_MASK 0x3ff
#endif
#define IN(k) (((PHASE_MASK >> (k)) & 1) && lo <= (k) && (k) < hi)
#define SEAM(k) do { if (IN(k) && IN((k) + 1)) xcd_barrier(bar); } while (0)
    LAS int* l_cnt = (LAS int*)(F.lds + MOET_OFF); LAS int* l_tbase = l_cnt + 64;
    const MoeTables MT{l_cnt, l_tbase};

    if (IN(0)) { p0_prologue(F, args, 0); } SEAM(0);
    if (IN(1)) {
        PlainSched S; S.init(args.ws, WS_XN, WS_WIN, NTOK, 5120, DM, F.G, F.bid);
        EpiInProj E{args.ws, args.in[I_BGATE]};
        if (!(args.flags & 64)) pg8::gemm_phase<EpiInProj, PlainSched>(F.lds, DM, S, E);
        if (!(args.flags & 128)) p1_thin(F, args.flags);
    } SEAM(1);
    if (IN(2)) {
        const int cvt_slot = (F.bid >> 3) % 3;
        if (cvt_slot == 0 && !(args.flags & 1024)) { p0_prologue(F, args, 1); __syncthreads(); }
        if (!(args.flags & 1)) p2_conv(F, args);
        if (!(args.flags & 2)) p2_indexer(F, args.flags, 0);
        if (cvt_slot == 1 && !(args.flags & 1024)) { __syncthreads(); p0_prologue(F, args, 1); __syncthreads(); }
        if (!(args.flags & 2)) p2_indexer(F, args.flags, 1);
        if (cvt_slot == 2 && !(args.flags & 1024)) { __syncthreads(); p0_prologue(F, args, 1); }
    } SEAM(2);
    if (IN(3)) { p3_attn(F, args); } SEAM(3);
    if (IN(4)) {
        MergeSched S{(const char*)args.ws, F.G, F.bid}; EpiMerge E{args.ws};
        pg8::gemm_phase<EpiMerge, MergeSched>(F.lds, 512, S, E);
    } SEAM(4);
    if (IN(5)) {
        PlainSched S; S.init(args.ws, WS_MG, WS_WOUT, NTOK, DM, DM, F.G, F.bid);
        EpiResid E{args.in[I_X], wsp<float>(args.ws, WS_H1)};
        pg8::gemm_phase<EpiResid, PlainSched>(F.lds, DM, S, E);
    } SEAM(5);
    if (IN(6)) { p6_router(F, args); } SEAM(6);
    if (IN(7)) {
        moe_tables(F, l_cnt, l_tbase);
        MoeSched<8, true> S{(const char*)args.ws, MT, F.G, F.bid, l_tbase[NE] * 8, F.lds};
        moe_prepare(F, S, wsp<float>(args.ws, WS_RG), args.in[I_BUG]);
        EpiSwiglu E{args.ws, MT, (const LAS float*)(F.lds + MOEL_ROWV)};
        pg8::gemm_phase<EpiSwiglu, MoeSched<8, true>>(F.lds, DM, S, E);
    } SEAM(7);
    if (IN(8)) {
        moe_tables(F, l_cnt, l_tbase);
        MoeSched<4, false> S{(const char*)args.ws, MT, F.G, F.bid, l_tbase[NE] * 4, F.lds};
        moe_prepare(F, S, wsp<float>(args.ws, WS_LG), args.in[I_BD]);
        EpiDown E{args.ws, MT, (const LAS float*)(F.lds + MOEL_ROWV)};
        pg8::gemm_phase<EpiDown, MoeSched<4, false>>(F.lds, DFF, S, E);
    } SEAM(8);
    if (IN(9)) { moe_tables(F, l_cnt, l_tbase); p9_final(F, args, l_tbase); }
#undef IN
#undef SEAM
}

#ifdef DBG_HASH_OFF
__global__ void dbg_hash(const unsigned* __restrict__ buf, size_t nwords, unsigned* acc) {
    unsigned h = 0u;
    for (size_t i = (size_t)blockIdx.x * blockDim.x + threadIdx.x; i < nwords; i += (size_t)gridDim.x * blockDim.x) h += (buf[i] ^ (unsigned)(i * 2654435761u)) * 2246822519u + (unsigned)i;
#pragma unroll
    for (int o = 1; o < 64; o <<= 1) h += __shfl_xor(h, o);
    if ((threadIdx.x & 63) == 0) atomicAdd(acc, h);
}
__global__ void dbg_fill(float* out, size_t n, const unsigned* acc) {
    const unsigned h = *acc; const float v = (float)((h >> 7) & 0xffffu) * (1.0f / 4096.0f) + 1.0f;
    for (size_t i = (size_t)blockIdx.x * blockDim.x + threadIdx.x; i < n; i += (size_t)gridDim.x * blockDim.x) out[i] = v;
}
#endif

extern "C" void kernel_launch(void* const* d_in, const int* in_sizes, int n_in, void* d_out, int out_size, void* d_ws, size_t ws_size, hipStream_t stream) {
    static int grid = 0;
    if (grid == 0) {
        if (n_in != 21 || out_size != NTOK * DM || ws_size < WS_END) { fprintf(stderr, "kernel_launch: unexpected shapes (n_in %d, out %d, ws %zu < %zu)\n", n_in, out_size, ws_size, (size_t)WS_END); grid = -1; return; }
        int dev = 0, cus = 0, per_cu = 0;
        if (hipGetDevice(&dev) != hipSuccess || hipDeviceGetAttribute(&cus, hipDeviceAttributeMultiprocessorCount, dev) != hipSuccess) { grid = -1; return; }
        if (hipFuncSetAttribute((const void*)fwd_kernel, hipFuncAttributeMaxDynamicSharedMemorySize, LDS_BYTES) != hipSuccess) { fprintf(stderr, "kernel_launch: hipFuncSetAttribute failed\n"); grid = -1; return; }
        if (hipOccupancyMaxActiveBlocksPerMultiprocessor(&per_cu, (const void*)fwd_kernel, NTHREADS, LDS_BYTES) != hipSuccess || per_cu < 1) { fprintf(stderr, "kernel_launch: occupancy query says %d\n", per_cu); }
        (void)hipGetLastError();
        grid = cus;
    }
    if (grid < 0) return;
    (void)hipMemsetAsync((char*)d_ws + WS_CTL, 0, CTL_ZERO_BYTES, stream);
    Args a{};
    for (int i = 0; i < 21; ++i) a.in[i] = (const float*)d_in[i];
    a.out = (float*)d_out; a.ws = (unsigned char*)d_ws;
#if MK_N_LAUNCHES == 1
    a.ph_lo = 0; a.ph_hi = N_PHASES;
    hipLaunchKernelGGL(fwd_kernel, dim3(grid), dim3(NTHREADS), LDS_BYTES, stream, a);
#else
#ifndef DBG_LAST_PHASE
#define DBG_LAST_PHASE (N_PHASES - 1)
#endif
#ifndef DBG_DUP_MASK
#define DBG_DUP_MASK 0
#endif
#ifndef DBG_DUP_FLAGS
#define DBG_DUP_FLAGS 0
#endif
    for (int p = 0; p <= DBG_LAST_PHASE; ++p) { a.ph_lo = p; a.ph_hi = p + 1;
        const int nrep = ((DBG_DUP_MASK >> p) & 1) ? 2 : 1;
        for (int rep = 0; rep < nrep; ++rep) { a.flags = (nrep == 2 && rep == 0) ? DBG_DUP_FLAGS : 0; if (rep == 1 && p == 6) (void)hipMemsetAsync((char*)d_ws + WS_CTL, 0, CTL_ZERO_BYTES, stream);
            hipLaunchKernelGGL(fwd_kernel, dim3(grid), dim3(NTHREADS), LDS_BYTES, stream, a); } }
#ifdef DBG_HASH_OFF
    { const unsigned* hb = DBG_HASH_OFF == 0 ? (const unsigned*)d_out : (const unsigned*)((char*)d_ws + DBG_HASH_OFF);
      hipLaunchKernelGGL(dbg_hash, dim3(1024), dim3(256), 0, stream, hb, (size_t)(DBG_HASH_BYTES) / 4, (unsigned*)d_ws + 2);
      hipLaunchKernelGGL(dbg_fill, dim3(1024), dim3(256), 0, stream, (float*)d_out, (size_t)NTOK * DM, (const unsigned*)d_ws + 2); }
#endif
#endif
}
```

```cpp
#include <hip/hip_runtime.h>
#include <cstdio>
#include <cstdint>

#ifndef MK_N_LAUNCHES
#define MK_N_LAUNCHES 1
#endif

constexpr int NB = 8, SEQ = 2048, NMETA = 16, TT = SEQ + NMETA  , DM = 1024, NTOK = NB * SEQ  , NALL = NB * TT  ;
constexpr int AW = 512, NH = 8, HD = 64, IDXD = 64, CC = 512, CW = 31, NE = 32, DFF = 1024, TOPK = 256;
constexpr int INCOLS = 5192, TP = 2176  , VOFF = 0  , MSTR = 68  ;
constexpr float EPS = 1e-6f, LOG2E = 1.4426950408889634f;
constexpr float QSCALE = 0.125f * LOG2E;
constexpr int MAXTILES = 296;
constexpr int SC_Q = 0, SC_K = 512, SC_V = 1024, SC_IQ = 1536, SC_IK = 2048, SC_IW = 2112, SC_GLU = 2120, SC_GATE = 3144;
constexpr int WR_GLU = 2048, WR_GATE = 3072, WR_IK = 5120, WR_IW = 5184, WIN_ROWS = 5376;

constexpr size_t MiB = 1u << 20;
constexpr size_t al4k(size_t x) { return (x + 4095) & ~(size_t)4095; }
constexpr size_t WS_CTL = 0, CTL_ZERO_BYTES = 1 * MiB;
constexpr size_t WS_WIN = 1 * MiB;
constexpr size_t WS_WAO = WS_WIN + al4k((size_t)WIN_ROWS * DM * 2);
constexpr size_t WS_WCO = WS_WAO + al4k((size_t)DM * AW * 2);
constexpr size_t WS_WOUT = WS_WCO + al4k((size_t)DM * CC * 2);
constexpr size_t WS_WUG = WS_WOUT + al4k((size_t)DM * DM * 2);
constexpr size_t WS_WD = WS_WUG + al4k((size_t)NE * 2 * DFF * DM * 2);
constexpr size_t WS_XN = WS_WD + al4k((size_t)NE * DM * DFF * 2);
constexpr size_t WS_XNM = WS_XN + al4k((size_t)NTOK * DM * 2);
constexpr size_t WS_Q = WS_XNM + al4k((size_t)NMETA * DM * 2);
constexpr size_t WS_IQ = WS_Q + al4k((size_t)NTOK * AW * 2);
constexpr size_t WS_KB = WS_IQ + al4k((size_t)NTOK * AW * 2);
constexpr size_t WS_VT = WS_KB + al4k((size_t)(NALL + 64) * AW * 2);
constexpr size_t WS_IK = WS_VT + al4k((size_t)NB * AW * TP * 2);
constexpr size_t WS_IW = WS_IK + al4k((size_t)NB * 65 * 2048 * 2);
constexpr size_t WS_GLU = WS_IW + al4k((size_t)NTOK * 8 * 4);
constexpr size_t WS_GA = WS_GLU + al4k((size_t)NALL * CC * 2);
constexpr size_t WS_GB = WS_GA + al4k((size_t)NTOK * DM * 2);
constexpr size_t WS_MASK = WS_GB + al4k((size_t)NTOK * DM * 2);
constexpr size_t WS_AO = WS_MASK + al4k((size_t)NTOK * MSTR * 4);
constexpr size_t WS_CO = WS_AO + al4k((size_t)NTOK * AW * 2);
constexpr size_t WS_MG = WS_CO + al4k((size_t)NTOK * CC * 2);
constexpr size_t WS_TE = WS_MG + al4k((size_t)NTOK * DM * 2);
constexpr size_t WS_TP = WS_TE + al4k((size_t)NTOK * 4 * 4);
constexpr size_t WS_LIST = WS_TP + al4k((size_t)NTOK * 4 * 4);
constexpr size_t WS_LG = WS_LIST + al4k((size_t)NE * NTOK * 4);
constexpr size_t WS_ACT = WS_LG + al4k((size_t)NE * NTOK * 4);
constexpr size_t WS_YP = WS_ACT + al4k((size_t)MAXTILES * 256 * DFF * 2);
constexpr size_t WS_H1 = WS_YP + al4k((size_t)MAXTILES * 256 * DM * 2);
constexpr size_t WS_WRT = WS_H1 + al4k((size_t)NTOK * DM * 4);
constexpr size_t WS_RG = WS_WRT + al4k((size_t)2 * NE * DM * 2);
constexpr size_t WS_DUMMY = WS_RG + al4k((size_t)NE * NTOK * 4);
constexpr size_t WS_END = WS_DUMMY + 16384;
static_assert(WS_END < ((size_t)1 << 32), "32-bit byte offsets into d_ws");
constexpr int CW_TMO = 0, CW_CODE = 1, CW_BAR = 4096, CW_ECNT = 16384;

constexpr int RING_BYTES = 131072;
constexpr int LDSX_OFF = 153600;
constexpr int MISC_OFF = 161792;
constexpr int LDS_BYTES = 163840;
constexpr int NWAVES = 8, NTHREADS = 512;

#define GAS __attribute__((address_space(1)))
#define LAS __attribute__((address_space(3)))
typedef unsigned short bf16_t;
typedef short bf16x8 __attribute__((ext_vector_type(8)));
typedef short s16x4 __attribute__((ext_vector_type(4)));
typedef float f32x4 __attribute__((ext_vector_type(4)));
typedef float f32x16 __attribute__((ext_vector_type(16)));
typedef unsigned u32x4 __attribute__((ext_vector_type(4)));
typedef unsigned u32x2 __attribute__((ext_vector_type(2)));
typedef GAS unsigned gu32;
#define RLX_AGENT __ATOMIC_RELAXED, __HIP_MEMORY_SCOPE_AGENT
#define LDS_WAIT() asm volatile("s_waitcnt lgkmcnt(0)" ::: "memory")
#define VM_WAIT() asm volatile("s_waitcnt vmcnt(0)" ::: "memory")

typedef float f32x2_t __attribute__((ext_vector_type(2))); typedef __bf16 bf16x2_t __attribute__((ext_vector_type(2)));
__device__ __forceinline__ unsigned cvt_pk_bf16(float lo, float hi) { const f32x2_t v = {lo, hi}; const bf16x2_t b = __builtin_convertvector(v, bf16x2_t); return __builtin_bit_cast(unsigned, b); }
__device__ __forceinline__ float bf2f(unsigned short b) { return __uint_as_float((unsigned)b << 16); }
__device__ __forceinline__ float bflo(unsigned w) { return __uint_as_float(w << 16); }
__device__ __forceinline__ float bfhi(unsigned w) { return __uint_as_float(w & 0xffff0000u); }
__device__ __forceinline__ float sigmoidf_(float x) { return __builtin_amdgcn_rcpf(1.0f + __builtin_amdgcn_exp2f(-LOG2E * x)); }
__device__ __forceinline__ f32x2_t rcp1pexp2_2(f32x2_t x, float k) { const f32x2_t t = x * (f32x2_t){k, k}; f32x2_t e; e.x = __builtin_amdgcn_exp2f(t.x); e.y = __builtin_amdgcn_exp2f(t.y);
    e = e + (f32x2_t){1.0f, 1.0f}; f32x2_t r; r.x = __builtin_amdgcn_rcpf(e.x); r.y = __builtin_amdgcn_rcpf(e.y); return r; }
__device__ __forceinline__ f32x2_t lo2(f32x4 v) { return __builtin_shufflevector(v, v, 0, 1); }
__device__ __forceinline__ f32x2_t hi2(f32x4 v) { return __builtin_shufflevector(v, v, 2, 3); }
__device__ __forceinline__ f32x4 cat2(f32x2_t a, f32x2_t b) { return __builtin_shufflevector(a, b, 0, 1, 2, 3); }
__device__ __forceinline__ float wave_sum(float v) {
#pragma unroll
    for (int o = 1; o < 64; o <<= 1) v += __shfl_xor(v, o);
    return v;
}

namespace pg8 {
constexpr int BM = 256, BK = 64, HALF = 128, HTB = HALF * BK * 2, STAGE_BYTES = 8 * HTB;
__host__ __device__ __forceinline__ int lds_byte(int r, int c) { const int st = (r >> 4) * 2 + (c >> 5), rr = r & 15, cc = c & 31, ob = rr * 64 + cc * 2; return st * 1024 + (ob ^ (((ob >> 9) & 1) << 5)); }
__host__ __device__ __forceinline__ void stage_rc(int b, int& R, int& C) { const int st = b / 1024, sb = b % 1024, swz = sb ^ (((sb >> 9) & 1) << 5); R = (st >> 1) * 16 + swz / 64; C = (st & 1) * 32 + (swz % 64) / 2; }

struct Unit { int pm, pn, z, ord; };

template <class Epi, class Sched>
__device__ __forceinline__ void gemm_phase(LAS unsigned char* lds, const int K, const Sched& S, const Epi& E) {
    const int tid = threadIdx.x, wid = __builtin_amdgcn_readfirstlane(tid >> 6), lane = tid & 63, wr = wid >> 2, wc = wid & 3, fr = lane & 15, fq = lane >> 4;
    const int nt = K / BK;
    unsigned voffB[2];
#pragma unroll
    for (int i = 0; i < 2; ++i) { int R_, C_; stage_rc(tid * 16 + i * 8192, R_, C_); const int rho = R_ & 31, Rp = (R_ & ~31) + 8 * ((rho & 15) >> 2) + 4 * (rho >> 4) + (rho & 3);
                                  voffB[i] = (unsigned)(Rp * K + C_) * 2u; }
    const size_t kstep = (size_t)(BK * 2);
    const size_t hstep = (size_t)HALF * K * 2;
    const unsigned ldsw = (unsigned)wid * 1024u;
    const int aoff = lds_byte(wr * 64 + fr, fq * 8), boff = lds_byte(wc * 32 + fr, fq * 8);
    const char* const abase = S.a_base();
#define PG8_SA(b, h) (((b) * 2 + (h)) * HTB)
#define PG8_SB(b, h) ((4 + (b) * 2 + (h)) * HTB)
#define PG8_STAGE(bufoff, gbase, voff) do { _Pragma("unroll") for (int _i = 0; _i < 2; ++_i) \
        __builtin_amdgcn_global_load_lds((const unsigned*)((const char*)(gbase) + (voff)[_i]), (LAS unsigned*)(lds + (bufoff) + ldsw + _i * 8192), 16, 0, 0); } while (0)
#define PG8_LDA(dst, b, h) do { _Pragma("unroll") for (int m = 0; m < 4; ++m) _Pragma("unroll") for (int k = 0; k < 2; ++k) dst[m][k] = *(const LAS bf16x8*)(lds + PG8_SA(b, h) + aoff + m * 2048 + k * 1024); } while (0)
#define PG8_LDB(dst, b, h) do { _Pragma("unroll") for (int n = 0; n < 2; ++n) _Pragma("unroll") for (int k = 0; k < 2; ++k) dst[n][k] = *(const LAS bf16x8*)(lds + PG8_SB(b, h) + boff + n * 2048 + k * 1024); } while (0)
#define PG8_MMA(ai, bj, At, Bt) do { __builtin_amdgcn_s_setprio(1); _Pragma("unroll") for (int m = 0; m < 4; ++m) _Pragma("unroll") for (int n = 0; n < 2; ++n) _Pragma("unroll") for (int k = 0; k < 2; ++k) \
        acc[ai][bj][m][n] = __builtin_amdgcn_mfma_f32_16x16x32_bf16(Bt[n][k], At[m][k], acc[ai][bj][m][n], 0, 0, 0); __builtin_amdgcn_s_setprio(0); } while (0)
#define PG8_WAIT_V(n) asm volatile("s_waitcnt vmcnt(" #n ")" ::: "memory")
#define PG8_WAIT_L(n) asm volatile("s_waitcnt lgkmcnt(" #n ")" ::: "memory")
#define PG8_BAR __builtin_amdgcn_s_barrier()
#define PG8_SCHED __builtin_amdgcn_sched_barrier(0)
    Unit cur, nxt; int ui = 0;
    if (!S.next(0, cur)) return;
    f32x4 acc[2][2][4][2];
#pragma unroll
    for (int a = 0; a < 2; ++a)
#pragma unroll
        for (int b = 0; b < 2; ++b)
#pragma unroll
            for (int m = 0; m < 4; ++m)
#pragma unroll
                for (int n = 0; n < 2; ++n) acc[a][b][m][n] = (f32x4){0.f, 0.f, 0.f, 0.f};
    bf16x8 At[4][2], B0[2][2], B1[2][2];
    unsigned ca[2][2], na[2][2];
    S.a_offs(cur, tid, ca);
    const char* cB = S.b_base(cur);
    PG8_STAGE(PG8_SB(0, 0), cB, voffB); PG8_STAGE(PG8_SB(0, 1), cB + hstep, voffB); PG8_STAGE(PG8_SA(0, 0), abase, ca[0]); PG8_STAGE(PG8_SA(0, 1), abase, ca[1]);
    if (wr == 1) PG8_BAR;
    PG8_WAIT_V(2); PG8_BAR;
    PG8_STAGE(PG8_SB(1, 0), cB + kstep, voffB); PG8_STAGE(PG8_SA(1, 0), abase + kstep, ca[0]); PG8_STAGE(PG8_SB(1, 1), cB + hstep + kstep, voffB);
    PG8_WAIT_V(6); PG8_BAR;
    for (;;) {
        const bool has_next = S.next(ui + 1, nxt);
        const char* nB = cB;
#pragma unroll
        for (int h = 0; h < 2; ++h)
#pragma unroll
            for (int i = 0; i < 2; ++i) na[h][i] = ca[h][i];
        if (has_next) { S.a_offs(nxt, tid, na); nB = S.b_base(nxt); }
        for (int t = 0; t < nt; t += 2) {
            const bool last = (t == nt - 2);
            const char* a1 = abase + (size_t)(t + 1) * kstep;
            const char* a2 = last ? abase : abase + (size_t)(t + 2) * kstep; const char* b2 = last ? nB : cB + (size_t)(t + 2) * kstep;
            const char* a3 = a2 + kstep; const char* b3 = b2 + kstep;
            PG8_LDB(B0, 0, 0); PG8_LDB(B1, 0, 1); PG8_SCHED; PG8_LDA(At, 0, 0); PG8_STAGE(PG8_SA(1, 1), a1, ca[1]);
            PG8_WAIT_V(8); PG8_WAIT_L(0); PG8_BAR; PG8_MMA(0, 0, At, B0); PG8_MMA(0, 1, At, B1); PG8_BAR; PG8_SCHED;
            if (last) {
#pragma unroll
                for (int h = 0; h < 2; ++h)
#pragma unroll
                    for (int i = 0; i < 2; ++i) ca[h][i] = na[h][i];
            }
            PG8_LDA(At, 0, 1); PG8_STAGE(PG8_SB(0, 0), b2, voffB); PG8_STAGE(PG8_SB(0, 1), b2 + hstep, voffB); PG8_STAGE(PG8_SA(0, 0), a2, ca[0]);
            PG8_WAIT_V(8); PG8_WAIT_L(0); PG8_BAR; PG8_MMA(1, 0, At, B0); PG8_MMA(1, 1, At, B1); PG8_BAR; PG8_SCHED;
            PG8_LDB(B0, 1, 0); PG8_LDB(B1, 1, 1); PG8_SCHED; PG8_LDA(At, 1, 0); PG8_STAGE(PG8_SA(0, 1), a2, ca[1]);
            PG8_WAIT_V(8); PG8_WAIT_L(0); PG8_BAR; PG8_MMA(0, 0, At, B0); PG8_MMA(0, 1, At, B1); PG8_BAR; PG8_SCHED;
            PG8_LDA(At, 1, 1); PG8_STAGE(PG8_SB(1, 0), b3, voffB); PG8_STAGE(PG8_SB(1, 1), b3 + hstep, voffB); PG8_STAGE(PG8_SA(1, 0), a3, ca[0]);
            PG8_WAIT_V(8); PG8_WAIT_L(0); PG8_BAR; PG8_MMA(1, 0, At, B0); PG8_MMA(1, 1, At, B1); PG8_BAR; PG8_SCHED;
        }
        if (wr == 0) PG8_BAR;
        { int tz = tid; asm volatile("" : "+v"(tz));
          const int l2 = tz & 63, w2 = __builtin_amdgcn_readfirstlane(tz >> 6); E(acc, cur, w2 >> 2, w2 & 3, l2 & 15, l2 >> 4); }
        if (!has_next) break;
#pragma unroll
        for (int a = 0; a < 2; ++a)
#pragma unroll
            for (int b = 0; b < 2; ++b)
#pragma unroll
                for (int m = 0; m < 4; ++m)
#pragma unroll
                    for (int n = 0; n < 2; ++n) acc[a][b][m][n] = (f32x4){0.f, 0.f, 0.f, 0.f};
        cur = nxt; cB = nB; ++ui;
        if (wr == 1) PG8_BAR;
    }
    PG8_WAIT_V(0);
    PG8_BAR;
#undef PG8_SA
#undef PG8_SB
#undef PG8_STAGE
#undef PG8_LDA
#undef PG8_LDB
#undef PG8_MMA
#undef PG8_WAIT_V
#undef PG8_WAIT_L
#undef PG8_BAR
#undef PG8_SCHED
}
}

#define XB_TMO      128
#define XB_XCNT(j)  (256  + 64 * (j))
#define XB_XSUB(j)  (1280 + 64 * (j))
#define XB_XGEN(j)  (2304 + 64 * (j))
#define XB_TOP      3328
#define XB_TOPGEN   3392
#define XCD_BAR_WORDS 3456
#define XB_SPIN_CAP (1u << 18)
__device__ __forceinline__ unsigned xb_ld(unsigned* p)              { return __hip_atomic_load(p, __ATOMIC_RELAXED, __HIP_MEMORY_SCOPE_AGENT); }
__device__ __forceinline__ unsigned xb_add(unsigned* p, unsigned v) { return __hip_atomic_fetch_add(p, v, __ATOMIC_RELAXED, __HIP_MEMORY_SCOPE_AGENT); }
__device__ __forceinline__ unsigned xb_xcc_id() { return (unsigned)__builtin_amdgcn_s_getreg((3 << 11) | 20) & 0xFu; }
#define XB_SPIN(cond, bar) do { unsigned _sp = 0; while (cond) { __builtin_amdgcn_s_sleep(1); \
    if ((++_sp & 255u) == 0u) { if (xb_ld(&(bar)[XB_TMO])) break; if (_sp > XB_SPIN_CAP) { atomicAdd(&(bar)[XB_TMO], 1u); break; } } } } while (0)
struct XcdBarrier { unsigned* bar; unsigned x; volatile LAS unsigned* st; };
__device__ __forceinline__ XcdBarrier xcd_barrier_post(unsigned* bar, volatile LAS unsigned* st) {
    XcdBarrier b; b.bar = bar; b.x = xb_xcc_id(); b.st = st;
    if (threadIdx.x == 0) (void)xb_add(&bar[XB_XCNT(b.x)], 1u);
    return b;
}
__device__ __forceinline__ void xcd_barrier_complete(unsigned* bar, unsigned x, unsigned& nloc, unsigned& nx) {
    const unsigned G = gridDim.x * gridDim.y * gridDim.z;
    unsigned sum, cnt, mine, sp = 0u;
    for (;;) {
        sum = 0u; cnt = 0u; mine = 0u;
#pragma unroll
        for (unsigned j = 0; j < 16; ++j) { const unsigned c = xb_ld(&bar[XB_XCNT(j)]); sum += c; cnt += (c > 0u) ? 1u : 0u; mine = (j == x) ? c : mine; }
        if (sum == G) break;
        __builtin_amdgcn_s_sleep(1);
        if ((++sp & 255u) == 0u) { if (xb_ld(&bar[XB_TMO])) break; if (sp > XB_SPIN_CAP) { atomicAdd(&bar[XB_TMO], 1u); break; } }
    }
    nloc = mine > 0u ? mine : 1u; nx = cnt > 0u ? cnt : 1u;
}
__device__ __forceinline__ void xcd_barrier(const XcdBarrier& b) {
    asm volatile("s_waitcnt vmcnt(0)" ::: "memory");
    __syncthreads();
    if (threadIdx.x == 0) {
        unsigned* bar = b.bar;
        __builtin_amdgcn_s_waitcnt(0);
        unsigned nloc = b.st[0], nx = b.st[1];
        if (nloc == 0u) { xcd_barrier_complete(bar, b.x, nloc, nx); b.st[0] = nloc; b.st[1] = nx; }
        const unsigned old = xb_add(&bar[XB_XSUB(b.x)], 1u);
        const unsigned gen = old / nloc;
        if (old + 1u == (gen + 1u) * nloc) {
            __builtin_amdgcn_fence(__ATOMIC_RELEASE, "agent");
            asm volatile("s_waitcnt vmcnt(0)" ::: "memory");
            const unsigned og = xb_add(&bar[XB_TOP], 1u);
            const unsigned tg = og / nx;
            if (og + 1u == (tg + 1u) * nx) xb_add(&bar[XB_TOPGEN], 1u);
            else XB_SPIN(xb_ld(&bar[XB_TOPGEN]) == tg, bar);
            __builtin_amdgcn_fence(__ATOMIC_ACQUIRE, "agent");
            xb_add(&bar[XB_XGEN(b.x)], 1u);
            asm volatile("s_waitcnt vmcnt(0)" ::: "memory");
        } else {
            XB_SPIN(xb_ld(&bar[XB_XGEN(b.x)]) == gen, bar);
            __builtin_amdgcn_fence(__ATOMIC_ACQUIRE, "agent");
            asm volatile("s_waitcnt vmcnt(0)" ::: "memory");
        }
    }
    __syncthreads();
}

struct Args {
    const float* in[21];
    float* out; unsigned char* ws;
    int ph_lo, ph_hi, flags, pad;
};
enum { I_X = 0, I_META, I_RELB, I_NMIX, I_WIN, I_BGATE, I_WAO, I_CONVW, I_CONVB, I_LNG, I_LNB, I_WCO, I_WOUT, I_NFFN, I_WR, I_BR, I_WUG, I_BUG, I_WD, I_BD, I_NFIN };

struct Frame {
    LAS unsigned char* lds;
    unsigned char* ws;
    int tid, lane, wave;
    int G, bid;
    int cvt_k;
};
template <class T> __device__ __forceinline__ T* wsp(unsigned char* ws, size_t off) { return (T*)(ws + off); }

struct P0Desc { const float* src; bf16_t* dst; int ldn, ldk; };
__device__ __forceinline__ void p0_load(const P0Desc& d, f32x4 (&v)[16], int lane) {
    const float* p = d.src + (size_t)(lane >> 4) * d.ldn + (lane & 15) * 4;
#pragma unroll
    for (int i = 0; i < 16; ++i) v[i] = *(const f32x4*)(p + (size_t)(4 * i) * d.ldn);
}
__device__ __forceinline__ void p0_store(const P0Desc& d, const f32x4 (&v)[16], LAS float* scr, int lane) {
    const int n4 = (lane & 15) * 4, kr = lane >> 4;
#pragma unroll
    for (int i = 0; i < 16; ++i) { LAS float* p = scr + (4 * i + kr) * 65 + n4; p[0] = v[i][0]; p[1] = v[i][1]; p[2] = v[i][2]; p[3] = v[i][3]; }
    LDS_WAIT(); asm volatile("" ::: "memory");
    const int c = lane & 7;
#pragma unroll
    for (int j = 0; j < 8; ++j) { const int n = (lane >> 3) + 8 * j; const LAS float* s = scr + (8 * c) * 65 + n;
        u32x4 o; o.x = cvt_pk_bf16(s[0 * 65], s[1 * 65]); o.y = cvt_pk_bf16(s[2 * 65], s[3 * 65]); o.z = cvt_pk_bf16(s[4 * 65], s[5 * 65]); o.w = cvt_pk_bf16(s[6 * 65], s[7 * 65]);
        *(u32x4*)(d.dst + (size_t)n * d.ldk + 8 * c) = o; }
    LDS_WAIT(); asm volatile("" ::: "memory");
}
__device__ __forceinline__ void rms_row_to_bf16(const float* __restrict__ xrow, const float* __restrict__ g, bf16_t* __restrict__ orow, int lane) {
    const f32x4* xr = (const f32x4*)xrow + lane; const f32x4* gr = (const f32x4*)g + lane;
    f32x4 v[4]; float s = 0.f;
#pragma unroll
    for (int j = 0; j < 4; ++j) { v[j] = xr[64 * j]; s += (v[j].x * v[j].x + v[j].y * v[j].y) + (v[j].z * v[j].z + v[j].w * v[j].w); }
    const float r = 1.0f / sqrtf(wave_sum(s) * (1.f / DM) + EPS);
    unsigned long long* o8 = (unsigned long long*)orow + lane;
#pragma unroll
    for (int j = 0; j < 4; ++j) { const f32x4 gg = gr[64 * j];
        o8[64 * j] = (unsigned long long)cvt_pk_bf16(v[j].x * r * gg.x, v[j].y * r * gg.y) | ((unsigned long long)cvt_pk_bf16(v[j].z * r * gg.z, v[j].w * r * gg.w) << 32); }
}
constexpr int T_UG = NE * 32 * 16, T_D = NE * 16 * 16, T_MOE = T_UG + T_D;
__device__ __forceinline__ P0Desc p0_desc_moe(const Args& a, unsigned char* ws, int r) {
    P0Desc d;
    if (r < T_UG) { const int e = r / 512, q = r % 512, g = q % 32, kb = q / 32; const int dr = g * 64, tile = dr >> 8, hf = (dr >> 7) & 1, w = dr & 127;
        d.src = a.in[I_WUG] + (size_t)e * DM * 2 * DFF + (size_t)(kb * 64) * (2 * DFF) + DFF * hf + 128 * tile + w; d.ldn = 2 * DFF;
        d.dst = wsp<bf16_t>(ws, WS_WUG) + (size_t)e * 2 * DFF * DM + (size_t)dr * DM + kb * 64; d.ldk = DM; return d; }
    r -= T_UG;
    { const int e = r / 256, q = r % 256, g = q % 16, kb = q / 16;
        d.src = a.in[I_WD] + (size_t)e * DFF * DM + (size_t)(kb * 64) * DM + g * 64; d.ldn = DM; d.dst = wsp<bf16_t>(ws, WS_WD) + (size_t)e * DM * DFF + (size_t)(g * 64) * DFF + kb * 64; d.ldk = DFF; return d; }
}
__device__ __forceinline__ void p0_prologue(Frame& F, const Args& a, const int part) {
    LAS float* scr = (LAS float*)(F.lds + F.wave * 16896);
    const int gw = F.bid * NWAVES + F.wave, NGW = F.G * NWAVES;
    unsigned char* ws = F.ws;
    constexpr int T_IN = 81 * 16, T_AO = 16 * 8, T_CO = 16 * 8, T_OUT = 16 * 16, T_SMALL = T_IN + T_AO + T_CO + T_OUT;
    constexpr int T_ALL = T_SMALL + T_MOE;
    auto desc = [&](int it) -> P0Desc {
        int r = it; P0Desc d;
        if (r < T_IN) { const int g = r / 16, kb = r % 16; const int dr = g * 64; int sc;
            if (dr < WR_GLU) sc = dr;
            else if (dr < WR_GATE) { const int q = dr - WR_GLU, tile = q >> 8, hf = (q >> 7) & 1, w = q & 127; sc = SC_GLU + 512 * hf + 128 * tile + w; }
            else if (dr < WR_IK) sc = SC_GATE + (dr - WR_GATE);
            else sc = SC_IK + (dr - WR_IK);
            d.src = a.in[I_WIN] + (size_t)(kb * 64) * INCOLS + sc; d.ldn = INCOLS; d.dst = wsp<bf16_t>(ws, WS_WIN) + (size_t)dr * DM + kb * 64; d.ldk = DM; return d; }
        r -= T_IN;
        if (r < T_AO) { const int g = r / 8, kb = r % 8; d.src = a.in[I_WAO] + (size_t)(kb * 64) * DM + g * 64; d.ldn = DM; d.dst = wsp<bf16_t>(ws, WS_WAO) + (size_t)(g * 64) * AW + kb * 64; d.ldk = AW; return d; }
        r -= T_AO;
        if (r < T_CO) { const int g = r / 8, kb = r % 8; d.src = a.in[I_WCO] + (size_t)(kb * 64) * DM + g * 64; d.ldn = DM; d.dst = wsp<bf16_t>(ws, WS_WCO) + (size_t)(g * 64) * CC + kb * 64; d.ldk = CC; return d; }
        r -= T_CO;
        if (r < T_OUT) { const int g = r / 16, kb = r % 16; d.src = a.in[I_WOUT] + (size_t)(kb * 64) * DM + g * 64; d.ldn = DM; d.dst = wsp<bf16_t>(ws, WS_WOUT) + (size_t)(g * 64) * DM + kb * 64; d.ldk = DM; return d; }
        r -= T_OUT;
        return p0_desc_moe(a, ws, r);
    };
    const int T_LO = part ? T_SMALL + F.cvt_k * NGW : 0, T_HI = part ? T_ALL : T_SMALL;
    if (T_LO + gw < T_HI) {
        f32x4 va[16], vb[16];
        P0Desc da = desc(T_LO + gw), db = da;
        p0_load(da, va, F.lane);
        for (int it = T_LO + gw; it < T_HI; it += 2 * NGW) {
            const int i1 = it + NGW, i2 = it + 2 * NGW;
            db = desc(i1 < T_HI ? i1 : it); p0_load(db, vb, F.lane);
            p0_store(da, va, scr, F.lane);
            da = desc(i2 < T_HI ? i2 : it); p0_load(da, va, F.lane);
            if (i1 < T_HI) p0_store(db, vb, scr, F.lane);
        }
    }
    if (part) return;
    { const int gt = F.bid * NTHREADS + F.tid;
      if (gt < 8 * DM / 2) { const int n = gt >> 9, k = (gt & 511) * 2; const float v0 = a.in[I_WIN][(size_t)k * INCOLS + SC_IW + n], v1 = a.in[I_WIN][(size_t)(k + 1) * INCOLS + SC_IW + n];
          *(unsigned*)(wsp<bf16_t>(ws, WS_WIN) + (size_t)(WR_IW + n) * DM + k) = cvt_pk_bf16(v0, v1); } }
    { const int gt = F.bid * NTHREADS + F.tid;
      if (gt < NE * DM / 2) { const int e = gt >> 9, d = (gt & 511) * 2; const float v0 = a.in[I_NFFN][d] * a.in[I_WR][(size_t)d * NE + e], v1 = a.in[I_NFFN][d + 1] * a.in[I_WR][(size_t)(d + 1) * NE + e];
          const unsigned hi = cvt_pk_bf16(v0, v1); const unsigned lo = cvt_pk_bf16(v0 - bflo(hi), v1 - bfhi(hi));
          *(unsigned*)(wsp<bf16_t>(ws, WS_WRT) + (size_t)e * DM + d) = hi; *(unsigned*)(wsp<bf16_t>(ws, WS_WRT) + (size_t)(NE + e) * DM + d) = lo; } }
    for (int m = gw; m < NTOK + NMETA; m += NGW) {
        if (m < NTOK) rms_row_to_bf16(a.in[I_X] + (size_t)m * DM, a.in[I_NMIX], wsp<bf16_t>(ws, WS_XN) + (size_t)m * DM, F.lane);
        else rms_row_to_bf16(a.in[I_META] + (size_t)(m - NTOK) * DM, a.in[I_NMIX], wsp<bf16_t>(ws, WS_XNM) + (size_t)(m - NTOK) * DM, F.lane);
    }
}

struct PlainSched {
    const char* ws; unsigned a_off, b_off; int K, nM, nN, nwg, G, c;
    __device__ __forceinline__ void init(const unsigned char* ws_, size_t a, size_t b, int M, int N, int K_, int G_, int c_) { ws = (const char*)ws_; a_off = (unsigned)a; b_off = (unsigned)b; K = K_; nM = M / 256; nN = N / 256; nwg = nM * nN; G = G_; c = c_; }
    __device__ __forceinline__ bool next(int i, pg8::Unit& u) const {
        const long L = (long)i * G + c; if (L >= nwg) return false;
        int wgid = (int)L; { const int q = nwg / 8, r = nwg % 8, xcd = wgid % 8, off = wgid / 8; wgid = (xcd < r ? xcd * (q + 1) : r * (q + 1) + (xcd - r) * q) + off; }
        const int nig = 8 * nN, gid = wgid / nig, fm = gid * 8, gsz = (nM - fm) < 8 ? (nM - fm) : 8;
        u.pm = fm + ((wgid % nig) % gsz); u.pn = (wgid % nig) / gsz; u.z = 0; u.ord = i; return true;
    }
    __device__ __forceinline__ const char* a_base() const { return ws; }
    __device__ __forceinline__ void a_offs(const pg8::Unit& u, int tid, unsigned (&o)[2][2]) const {
        int R[2], C[2]; pg8::stage_rc(tid * 16, R[0], C[0]); pg8::stage_rc(tid * 16 + 8192, R[1], C[1]);
#pragma unroll
        for (int h = 0; h < 2; ++h)
#pragma unroll
            for (int i = 0; i < 2; ++i) o[h][i] = a_off + (unsigned)(((u.pm * 256 + h * 128 + R[i]) * K + C[i]) * 2);
    }
    __device__ __forceinline__ const char* b_base(const pg8::Unit& u) const { return ws + b_off + (size_t)u.pn * 256 * K * 2; }
};
struct MergeSched {
    const char* ws; int G, c;
    __device__ __forceinline__ bool next(int i, pg8::Unit& u) const {
        const int t = c + (i >> 1) * G;
        if (t >= 256) return false;
        u.pm = (t & 7) + 8 * (t >> 5); u.pn = (t >> 3) & 3; u.z = i & 1; u.ord = i; return true;
    }
    __device__ __forceinline__ const char* a_base() const { return ws; }
    __device__ __forceinline__ void a_offs(const pg8::Unit& u, int tid, unsigned (&o)[2][2]) const {
        int R[2], C[2]; pg8::stage_rc(tid * 16, R[0], C[0]); pg8::stage_rc(tid * 16 + 8192, R[1], C[1]);
        const unsigned base = (unsigned)(u.z ? WS_CO : WS_AO);
#pragma unroll
        for (int h = 0; h < 2; ++h)
#pragma unroll
            for (int i = 0; i < 2; ++i) o[h][i] = base + (unsigned)(((u.pm * 256 + h * 128 + R[i]) * 512 + C[i]) * 2);
    }
    __device__ __forceinline__ const char* b_base(const pg8::Unit& u) const { return ws + (u.z ? WS_WCO : WS_WAO) + (size_t)u.pn * 256 * 512 * 2; }
};
struct MoeTables { const LAS int* cnt; const LAS int* tbase; };
constexpr int MOE_MAXU = 10;
constexpr int MOEL_DESC = RING_BYTES;
constexpr int MOEL_TOK = MOEL_DESC + 256;
constexpr int MOEL_ROWV = MOEL_TOK + MOE_MAXU * 512;
constexpr int MOEL_BIAS = MOEL_ROWV + MOE_MAXU * 1024;
constexpr int MOET_OFF = MOEL_BIAS + MOE_MAXU * 1024;
static_assert(MOET_OFF + 512 <= MISC_OFF, "moe LDS map");
template <int NC, bool GATHER>
struct MoeSched {
    const char* ws; MoeTables T; int G, c, total; LAS unsigned char* lds;
    __device__ __forceinline__ int next_lane(int i, int& pm, int& pn, int& z) const {
        pm = 0; pn = 0; z = 0;
        const long L = (long)i * G + c; if (L >= total) return 0;
        int wgid = (int)L; { const int q = total / 8, r = total % 8, xcd = wgid % 8, off = wgid / 8; wgid = (xcd < r ? xcd * (q + 1) : r * (q + 1) + (xcd - r) * q) + off; }
        int e = 0;
        for (int j = 1; j < NE; ++j) e += (wgid >= T.tbase[j] * NC) ? 1 : 0;
        const int loc = wgid - T.tbase[e] * NC;
        z = e; pn = loc % NC; pm = loc / NC;
        return 1;
    }
    __device__ __forceinline__ bool next(int i, pg8::Unit& u) const {
        const u32x4 d = *(const LAS u32x4*)(lds + MOEL_DESC + 16 * i);
        if (__builtin_amdgcn_readfirstlane((int)d.w) == 0) return false;
        u.pm = __builtin_amdgcn_readfirstlane((int)d.x); u.pn = __builtin_amdgcn_readfirstlane((int)d.y); u.z = __builtin_amdgcn_readfirstlane((int)d.z); u.ord = i;
        return true;
    }
    __device__ __forceinline__ const char* a_base() const { return ws; }
    __device__ __forceinline__ void a_offs(const pg8::Unit& u, int tid, unsigned (&o)[2][2]) const {
        int R[2], C[2]; pg8::stage_rc(tid * 16, R[0], C[0]); pg8::stage_rc(tid * 16 + 8192, R[1], C[1]);
        if (GATHER) {
            const LAS unsigned short* tokl = (const LAS unsigned short*)(lds + MOEL_TOK) + u.ord * 256;
#pragma unroll
            for (int h = 0; h < 2; ++h)
#pragma unroll
                for (int i = 0; i < 2; ++i) { const int tok = (int)tokl[h * 128 + R[i]]; o[h][i] = (unsigned)WS_XN + (unsigned)((tok * DM + C[i]) * 2); }
        } else {
            const int row0 = (__builtin_amdgcn_readfirstlane(T.tbase[u.z]) + u.pm) * 256;
#pragma unroll
            for (int h = 0; h < 2; ++h)
#pragma unroll
                for (int i = 0; i < 2; ++i) o[h][i] = (unsigned)WS_ACT + (unsigned)(((row0 + h * 128 + R[i]) * DFF + C[i]) * 2);
        }
    }
    __device__ __forceinline__ const char* b_base(const pg8::Unit& u) const {
        if (GATHER) return ws + WS_WUG + ((size_t)u.z * 2 * DFF + (size_t)u.pn * 256) * DM * 2;
        else return ws + WS_WD + ((size_t)u.z * DM + (size_t)u.pn * 256) * DFF * 2;
    }
};
template <int NC, bool GATHER>
__device__ __forceinline__ void moe_prepare(Frame& F, const MoeSched<NC, GATHER>& S, const float* rowv_src, const float* bias) {
    LAS int* desc = (LAS int*)(F.lds + MOEL_DESC); LAS unsigned short* tokl = (LAS unsigned short*)(F.lds + MOEL_TOK); LAS float* rowv = (LAS float*)(F.lds + MOEL_ROWV); LAS float* biasl = (LAS float*)(F.lds + MOEL_BIAS);
    if (F.tid < 16) { int pm = 0, pn = 0, z = 0, valid = 0; if (F.tid < MOE_MAXU) valid = S.next_lane(F.tid, pm, pn, z);
        desc[4 * F.tid + 0] = pm; desc[4 * F.tid + 1] = pn; desc[4 * F.tid + 2] = z; desc[4 * F.tid + 3] = valid; }
    __syncthreads();
    const int* LIST = (const int*)(S.ws + WS_LIST);
    constexpr int NIT = MOE_MAXU * 256 / NTHREADS;
    int tk[NIT]; float rv[NIT], bs[NIT];
#pragma unroll
    for (int k = 0; k < NIT; ++k) { const int idx = F.tid + k * NTHREADS, i = idx >> 8, r = idx & 255;
        const int pm = desc[4 * i], pn = desc[4 * i + 1], z = desc[4 * i + 2], n = S.T.cnt[z], p = pm * 256 + r, pc = p < n ? p : 0;
        tk[k] = GATHER ? LIST[(size_t)z * NTOK + pc] : 0; rv[k] = rowv_src[(size_t)z * NTOK + pc];
        bs[k] = GATHER ? bias[(size_t)z * 2 * DFF + (r >> 7) * DFF + pn * 128 + (r & 127)] : bias[(size_t)z * DM + pn * 256 + r]; }
#pragma unroll
    for (int k = 0; k < NIT; ++k) { const int idx = F.tid + k * NTHREADS; if (GATHER) tokl[idx] = (unsigned short)tk[k]; rowv[idx] = rv[k]; biasl[idx] = bs[k]; }
    __syncthreads();
}

#define EPI_ROWS(ai, m) for (int ai = 0; ai < 2; ++ai) _Pragma("unroll") for (int m = 0; m < 4; ++m)
#define EPI_COLS(bj, n) for (int bj = 0; bj < 2; ++bj) _Pragma("unroll") for (int n = 0; n < 2; ++n)
__device__ __forceinline__ void st_bf16x4(bf16_t* p, f32x4 v) { u32x2 w; w.x = cvt_pk_bf16(v[0], v[1]); w.y = cvt_pk_bf16(v[2], v[3]); *(u32x2*)p = w; }
__device__ __forceinline__ void st_bf16x8(bf16_t* p, f32x4 a, f32x4 b) { u32x4 w; w.x = cvt_pk_bf16(a[0], a[1]); w.y = cvt_pk_bf16(a[2], a[3]); w.z = cvt_pk_bf16(b[0], b[1]); w.w = cvt_pk_bf16(b[2], b[3]); *(u32x4*)p = w; }

struct EpiInProj {
    unsigned char* ws; const float* bgate;
    __device__ __forceinline__ void operator()(const f32x4 (&acc)[2][2][4][2], const pg8::Unit& u, int wr, int wc, int fr, int fq) const {
        const int pn = u.pn, row0 = u.pm * 256 + wr * 64 + fr, col0 = wc * 32 + 8 * fq;
        const int bidx = u.pm >> 3;
        const int rowk0 = row0 + NMETA * (bidx + 1);
        if (pn < 2 || (pn >= 6 && pn < 8)) {
            bf16_t* O = wsp<bf16_t>(ws, pn < 2 ? WS_Q : WS_IQ); const int cb = (pn & 1) * 256; const float sc = pn < 2 ? QSCALE : 1.0f;
#pragma unroll
            EPI_ROWS(ai, m) { bf16_t* rp = O + (size_t)(row0 + ai * 128 + m * 16) * AW + cb + col0;
#pragma unroll
                for (int bj = 0; bj < 2; ++bj) st_bf16x8(rp + bj * 128, acc[ai][bj][m][0] * sc, acc[ai][bj][m][1] * sc); }
        } else if (pn < 4) {
            bf16_t* O = wsp<bf16_t>(ws, WS_KB); const int cb = (pn & 1) * 256;
#pragma unroll
            EPI_ROWS(ai, m) { bf16_t* rp = O + (size_t)(rowk0 + ai * 128 + m * 16) * AW + cb + col0;
#pragma unroll
                for (int bj = 0; bj < 2; ++bj) st_bf16x8(rp + bj * 128, acc[ai][bj][m][0], acc[ai][bj][m][1]); }
        } else if (pn < 6) {
            bf16_t* O = wsp<bf16_t>(ws, WS_VT) + (size_t)bidx * AW * TP; const int cb = (pn & 1) * 256;
            const int t0 = (row0 & (SEQ - 1)) + NMETA + VOFF;
#pragma unroll
            EPI_ROWS(ai, m) { const int t = t0 + ai * 128 + m * 16;
#pragma unroll
                EPI_COLS(bj, n) { const f32x4 v = acc[ai][bj][m][n]; bf16_t* cp = O + (size_t)(cb + col0 + bj * 128 + n * 4) * TP + (t & ~1);
                    const float p0 = __shfl_xor(v[0], 1), p1 = __shfl_xor(v[1], 1), p2 = __shfl_xor(v[2], 1), p3 = __shfl_xor(v[3], 1);
                    if ((fr & 1) == 0) { *(unsigned*)(cp) = cvt_pk_bf16(v[0], p0); *(unsigned*)(cp + TP) = cvt_pk_bf16(v[1], p1); }
                    else { *(unsigned*)(cp + 2 * TP) = cvt_pk_bf16(p2, v[2]); *(unsigned*)(cp + 3 * TP) = cvt_pk_bf16(p3, v[3]); } } }
        } else if (pn < 12) {
            bf16_t* O = wsp<bf16_t>(ws, WS_GLU); const int cb = (pn - 8) * 128;
#pragma unroll
            EPI_ROWS(ai, m) { bf16_t* rp = O + (size_t)(rowk0 + ai * 128 + m * 16) * CC + cb + col0;
                f32x4 y[2];
#pragma unroll
                for (int n = 0; n < 2; ++n) { const f32x4 av = acc[ai][0][m][n], gv = acc[ai][1][m][n];
                    y[n] = cat2(lo2(av) * rcp1pexp2_2(lo2(gv), -LOG2E), hi2(av) * rcp1pexp2_2(hi2(gv), -LOG2E)); }
                st_bf16x8(rp, y[0], y[1]); }
        } else {
            const int gt = pn - 12; bf16_t* O = wsp<bf16_t>(ws, gt < 4 ? WS_GA : WS_GB); const int cb = (gt & 3) * 256; const float* bp = bgate + gt * 256 + col0;
            f32x4 bv[2][2];
#pragma unroll
            EPI_COLS(bj, n) bv[bj][n] = *(const f32x4*)(bp + bj * 128 + n * 4);
#pragma unroll
            EPI_ROWS(ai, m) { bf16_t* rp = O + (size_t)(row0 + ai * 128 + m * 16) * DM + cb + col0;
#pragma unroll
                for (int bj = 0; bj < 2; ++bj) { f32x4 y[2];
#pragma unroll
                    for (int n = 0; n < 2; ++n) { const f32x4 x = acc[ai][bj][m][n] + bv[bj][n]; y[n] = cat2(rcp1pexp2_2(lo2(x), -LOG2E), rcp1pexp2_2(hi2(x), -LOG2E)); }
                    st_bf16x8(rp + bj * 128, y[0], y[1]); } }
        }
    }
};
struct EpiMerge {
    unsigned char* ws;
    __device__ __forceinline__ void operator()(const f32x4 (&acc)[2][2][4][2], const pg8::Unit& u, int wr, int wc, int fr, int fq) const {
        const int row0 = u.pm * 256 + wr * 64 + fr, col0 = u.pn * 256 + wc * 32 + 8 * fq;
        const bf16_t* Gt = wsp<bf16_t>(ws, u.z ? WS_GB : WS_GA); bf16_t* O = wsp<bf16_t>(ws, WS_MG);
#pragma unroll
        for (int ai = 0; ai < 2; ++ai) {
            u32x4 g[4][2], p[4][2];
#pragma unroll
            for (int m = 0; m < 4; ++m)
#pragma unroll
                for (int bj = 0; bj < 2; ++bj) { const size_t o = (size_t)(row0 + ai * 128 + m * 16) * DM + col0 + bj * 128; g[m][bj] = *(const u32x4*)(Gt + o); p[m][bj] = u.z ? *(const u32x4*)(O + o) : (u32x4){0u, 0u, 0u, 0u}; }
#pragma unroll
            for (int m = 0; m < 4; ++m)
#pragma unroll
                for (int bj = 0; bj < 2; ++bj) { const size_t o = (size_t)(row0 + ai * 128 + m * 16) * DM + col0 + bj * 128; const u32x4 gg = g[m][bj], pp = p[m][bj]; const f32x4 a0 = acc[ai][bj][m][0], a1 = acc[ai][bj][m][1];
                    const f32x4 y0 = (f32x4){bflo(gg.x) * a0[0] + bflo(pp.x), bfhi(gg.x) * a0[1] + bfhi(pp.x), bflo(gg.y) * a0[2] + bflo(pp.y), bfhi(gg.y) * a0[3] + bfhi(pp.y)};
                    const f32x4 y1 = (f32x4){bflo(gg.z) * a1[0] + bflo(pp.z), bfhi(gg.z) * a1[1] + bfhi(pp.z), bflo(gg.w) * a1[2] + bflo(pp.w), bfhi(gg.w) * a1[3] + bfhi(pp.w)};
                    st_bf16x8(O + o, y0, y1); }
        }
    }
};
struct EpiResid {
    const float* x; float* out;
    __device__ __forceinline__ void operator()(const f32x4 (&acc)[2][2][4][2], const pg8::Unit& u, int wr, int wc, int fr, int fq) const {
        const int row0 = u.pm * 256 + wr * 64 + fr, col0 = u.pn * 256 + wc * 32 + 8 * fq;
#pragma unroll
        for (int ai = 0; ai < 2; ++ai)
#pragma unroll
            for (int mh = 0; mh < 2; ++mh) {
                f32x4 xv[2][2][2];
#pragma unroll
                for (int mm = 0; mm < 2; ++mm)
#pragma unroll
                    EPI_COLS(bj, n) xv[mm][bj][n] = *(const f32x4*)(x + (size_t)(row0 + ai * 128 + (2 * mh + mm) * 16) * DM + col0 + bj * 128 + n * 4);
#pragma unroll
                for (int mm = 0; mm < 2; ++mm)
#pragma unroll
                    EPI_COLS(bj, n) *(f32x4*)(out + (size_t)(row0 + ai * 128 + (2 * mh + mm) * 16) * DM + col0 + bj * 128 + n * 4) = xv[mm][bj][n] + acc[ai][bj][2 * mh + mm][n];
            }
    }
};
struct EpiSwiglu {
    unsigned char* ws; MoeTables T; const LAS float* rowv;
    __device__ __forceinline__ void operator()(const f32x4 (&acc)[2][2][4][2], const pg8::Unit& u, int wr, int wc, int fr, int fq) const {
        const int e = u.z, n_e = __builtin_amdgcn_readfirstlane(T.cnt[e]), rloc0 = u.pm * 256 + wr * 64 + fr, row0 = __builtin_amdgcn_readfirstlane(T.tbase[e]) * 256 + rloc0, col0 = u.pn * 128 + wc * 32 + 8 * fq;
        bf16_t* O = wsp<bf16_t>(ws, WS_ACT); const LAS float* rg = rowv + u.ord * 256 + wr * 64 + fr; const LAS float* bp = rowv + MOE_MAXU * 256 + u.ord * 256 + wc * 32 + 8 * fq;
        f32x4 bg[2], bu[2];
#pragma unroll
        for (int n = 0; n < 2; ++n) { bg[n] = *(const LAS f32x4*)(bp + n * 4); bu[n] = *(const LAS f32x4*)(bp + 128 + n * 4) + 1.0f; }
        float rvs[2][4];
#pragma unroll
        EPI_ROWS(ai, m) rvs[ai][m] = rg[ai * 128 + m * 16];
        bf16_t* const sink = wsp<bf16_t>(ws, WS_DUMMY) + col0;
#pragma unroll
        EPI_ROWS(ai, m) { const int rl = rloc0 + ai * 128 + m * 16; bf16_t* rp = (rl < n_e) ? O + (size_t)(row0 + ai * 128 + m * 16) * DFF + col0 : sink; const float rv = rvs[ai][m];
                f32x4 y[2];
#pragma unroll
                for (int n = 0; n < 2; ++n) { const f32x2_t rv2 = {rv, rv}; f32x2_t yh[2];
#pragma unroll
                    for (int hh = 0; hh < 2; ++hh) { const f32x4 ag = acc[ai][0][m][n], au = acc[ai][1][m][n];
                        f32x2_t g = (hh ? hi2(ag) : lo2(ag)) * rv2 + (hh ? hi2(bg[n]) : lo2(bg[n])), u1 = (hh ? hi2(au) : lo2(au)) * rv2 + (hh ? hi2(bu[n]) : lo2(bu[n]));
                        g.x = fminf(g.x, 7.0f); g.y = fminf(g.y, 7.0f); u1.x = __builtin_amdgcn_fmed3f(u1.x, -6.0f, 8.0f); u1.y = __builtin_amdgcn_fmed3f(u1.y, -6.0f, 8.0f);
                        yh[hh] = (u1 * g) * rcp1pexp2_2(g, -1.702f * LOG2E); }
                    y[n] = cat2(yh[0], yh[1]); }
                st_bf16x8(rp, y[0], y[1]); }
    }
};
struct EpiDown {
    unsigned char* ws; MoeTables T; const LAS float* rowv;
    __device__ __forceinline__ void operator()(const f32x4 (&acc)[2][2][4][2], const pg8::Unit& u, int wr, int wc, int fr, int fq) const {
        const int e = u.z, n_e = __builtin_amdgcn_readfirstlane(T.cnt[e]), rloc0 = u.pm * 256 + wr * 64 + fr, row0 = __builtin_amdgcn_readfirstlane(T.tbase[e]) * 256 + rloc0, col0 = u.pn * 256 + wc * 32 + 8 * fq;
        bf16_t* O = wsp<bf16_t>(ws, WS_YP); const LAS float* lg = rowv + u.ord * 256 + wr * 64 + fr; const LAS float* bp = rowv + MOE_MAXU * 256 + u.ord * 256 + wc * 32 + 8 * fq;
        f32x4 bv[2][2];
#pragma unroll
        EPI_COLS(bj, n) bv[bj][n] = *(const LAS f32x4*)(bp + bj * 128 + n * 4);
        float gts[2][4];
#pragma unroll
        EPI_ROWS(ai, m) gts[ai][m] = lg[ai * 128 + m * 16];
        bf16_t* const sink = wsp<bf16_t>(ws, WS_DUMMY) + col0;
#pragma unroll
        EPI_ROWS(ai, m) { const int rl = rloc0 + ai * 128 + m * 16; const float gt = gts[ai][m]; bf16_t* rp = (rl < n_e) ? O + (size_t)(row0 + ai * 128 + m * 16) * DM + col0 : sink;
#pragma unroll
                for (int bj = 0; bj < 2; ++bj) st_bf16x8(rp + bj * 128, (acc[ai][bj][m][0] + bv[bj][0]) * gt, (acc[ai][bj][m][1] + bv[bj][1]) * gt); }
    }
};

constexpr int IKBLK = 65;
__device__ __forceinline__ size_t ikf_off(int b, int p, int dim) { return ((((size_t)(b * IKBLK + (p >> 5)) * 4 + (dim >> 4)) * 64 + (((dim >> 3) & 1) * 32 + (p & 31))) * 8 + (dim & 7)); }
template <int NT>
__device__ __forceinline__ void wave_mm16(const bf16_t* __restrict__ A, int lda, const bf16_t* const (&Bt)[NT], int K, int lane, f32x4 (&acc)[NT]) {
    const bf16_t* ap = A + (size_t)(lane & 15) * lda + 8 * (lane >> 4);
    const bf16_t* bp[NT];
#pragma unroll
    for (int t = 0; t < NT; ++t) { bp[t] = Bt[t] + (size_t)(lane & 15) * K + 8 * (lane >> 4); acc[t] = (f32x4){0.f, 0.f, 0.f, 0.f}; }
#pragma unroll (NT == 1 ? 16 : 8)
    for (int k0 = 0; k0 < K; k0 += 32) {
        const bf16x8 a = *(const bf16x8*)(ap + k0);
#pragma unroll
        for (int t = 0; t < NT; ++t) { const bf16x8 b = *(const bf16x8*)(bp[t] + k0); acc[t] = __builtin_amdgcn_mfma_f32_16x16x32_bf16(b, a, acc[t], 0, 0, 0); }
    }
}
__device__ __forceinline__ void p1_thin(Frame& F, int dbgflags) {
    unsigned char* ws = F.ws;
    const bf16_t* WIN = wsp<bf16_t>(ws, WS_WIN); const bf16_t* XN = wsp<bf16_t>(ws, WS_XN); const bf16_t* XNM = wsp<bf16_t>(ws, WS_XNM);
    bf16_t* KB = wsp<bf16_t>(ws, WS_KB); bf16_t* VT = wsp<bf16_t>(ws, WS_VT); bf16_t* IK = wsp<bf16_t>(ws, WS_IK); bf16_t* GLU = wsp<bf16_t>(ws, WS_GLU); float* IW = wsp<float>(ws, WS_IW);
    const int gw = F.bid * NWAVES + F.wave, NGW = F.G * NWAVES, lane = F.lane, tk = lane & 15, nq = lane >> 4;
    {
        constexpr int WBP = 2064;
        LAS unsigned char* lds = F.lds;
        __syncthreads();
        { const unsigned char* src = (const unsigned char*)(WIN + (size_t)WR_IK * DM);
          for (int p = F.tid; p < 72 * 128; p += NTHREADS) { const int row = p >> 7, c16 = p & 127; *(LAS u32x4*)(lds + row * WBP + c16 * 16) = *(const u32x4*)(src + (size_t)row * DM * 2 + c16 * 16); } }
        __syncthreads();
        const int tg = F.wave & 3, hf = F.wave >> 2, kq = nq;
        for (int tb = F.bid; tb < NTOK / 64; tb += F.G) {
            const int m = tb * 64 + 16 * tg + tk, rowk = m + NMETA * ((m >> 11) + 1);
            const bf16_t* xr = XN + (size_t)m * DM + 16 * kq;
            bf16x8 xa[16], xb[16];
#pragma unroll
            for (int sblk = 0; sblk < 16; ++sblk) { xa[sblk] = *(const bf16x8*)(xr + 64 * sblk); xb[sblk] = *(const bf16x8*)(xr + 64 * sblk + 8); }
            const LAS unsigned char* wb = lds + tk * WBP + 32 * kq;
            if (hf == 0) {
                f32x4 acc[3] = {{0.f, 0.f, 0.f, 0.f}, {0.f, 0.f, 0.f, 0.f}, {0.f, 0.f, 0.f, 0.f}};
#pragma unroll
                for (int sblk = 0; sblk < 16; ++sblk)
#pragma unroll
                    for (int t = 0; t < 3; ++t) { const bf16x8 b0 = *(const LAS bf16x8*)(wb + 16 * t * WBP + 128 * sblk), b1 = *(const LAS bf16x8*)(wb + 16 * t * WBP + 128 * sblk + 16);
                        acc[t] = __builtin_amdgcn_mfma_f32_16x16x32_bf16(b0, xa[sblk], acc[t], 0, 0, 0); acc[t] = __builtin_amdgcn_mfma_f32_16x16x32_bf16(b1, xb[sblk], acc[t], 0, 0, 0); }
#pragma unroll
                for (int t = 0; t < 3; ++t) st_bf16x4(IK + ikf_off(m >> 11, NMETA + (m & (SEQ - 1)), 16 * t + 4 * nq), acc[t]);
            } else {
                f32x4 acc[2] = {{0.f, 0.f, 0.f, 0.f}, {0.f, 0.f, 0.f, 0.f}};
#pragma unroll
                for (int sblk = 0; sblk < 16; ++sblk)
#pragma unroll
                    for (int t = 0; t < 2; ++t) { const bf16x8 b0 = *(const LAS bf16x8*)(wb + 16 * (3 + t) * WBP + 128 * sblk), b1 = *(const LAS bf16x8*)(wb + 16 * (3 + t) * WBP + 128 * sblk + 16);
                        acc[t] = __builtin_amdgcn_mfma_f32_16x16x32_bf16(b0, xa[sblk], acc[t], 0, 0, 0); acc[t] = __builtin_amdgcn_mfma_f32_16x16x32_bf16(b1, xb[sblk], acc[t], 0, 0, 0); }
                st_bf16x4(IK + ikf_off(m >> 11, NMETA + (m & (SEQ - 1)), 48 + 4 * nq), acc[0]);
                if (nq < 2) *(f32x4*)(IW + (size_t)m * 8 + 4 * nq) = acc[1];
            }
        }
        __syncthreads();
    }
    if (!(dbgflags & 256)) for (int task = gw; task < 100; task += NGW) {
        if (task < 32) {
            const bf16_t* const Bt[1] = {WIN + (size_t)(SC_K + 16 * task) * DM}; f32x4 acc[1]; wave_mm16<1>(XNM, DM, Bt, DM, lane, acc);
            for (int b = 0; b < NB; ++b) st_bf16x4(KB + (size_t)(b * TT + tk) * AW + 16 * task + 4 * nq, acc[0]);
        } else if (task < 64) {
            const int t = task - 32; const bf16_t* const Bt[1] = {WIN + (size_t)(SC_V + 16 * t) * DM}; f32x4 acc[1]; wave_mm16<1>(XNM, DM, Bt, DM, lane, acc);
            const float p0 = __shfl_xor(acc[0][0], 1), p1 = __shfl_xor(acc[0][1], 1), p2 = __shfl_xor(acc[0][2], 1), p3 = __shfl_xor(acc[0][3], 1);
            const unsigned wa = (tk & 1) ? cvt_pk_bf16(p2, acc[0][2]) : cvt_pk_bf16(acc[0][0], p0), wb = (tk & 1) ? cvt_pk_bf16(p3, acc[0][3]) : cvt_pk_bf16(acc[0][1], p1);
            for (int b = 0; b < NB; ++b) { bf16_t* cp = VT + ((size_t)b * AW + 16 * t + 4 * nq + 2 * (tk & 1)) * TP + VOFF + (tk & ~1);
                *(unsigned*)cp = wa; *(unsigned*)(cp + TP) = wb; }
        } else if (task < 68) {
            const int t = task - 64; const bf16_t* const Bt[1] = {WIN + (size_t)(WR_IK + 16 * t) * DM}; f32x4 acc[1]; wave_mm16<1>(XNM, DM, Bt, DM, lane, acc);
            for (int b = 0; b < NB; ++b) st_bf16x4(IK + ikf_off(b, tk, 16 * t + 4 * nq), acc[0]);
        } else {
            const int c16 = task - 68; const int ar = WR_GLU + 256 * (c16 >> 3) + 16 * (c16 & 7);
            const bf16_t* const Bt[2] = {WIN + (size_t)ar * DM, WIN + (size_t)(ar + 128) * DM}; f32x4 acc[2]; wave_mm16<2>(XNM, DM, Bt, DM, lane, acc);
            f32x4 y;
#pragma unroll
            for (int j = 0; j < 4; ++j) y[j] = acc[0][j] * sigmoidf_(acc[1][j]);
            for (int b = 0; b < NB; ++b) st_bf16x4(GLU + (size_t)(b * TT + tk) * CC + 16 * c16 + 4 * nq, y);
        }
    }
}

__device__ __forceinline__ void p2_conv(Frame& F, const Args& a, const int k_lo, const int k_hi) {
    unsigned char* ws = F.ws;
    LAS unsigned char* xs = F.lds;
    LAS float* wl = (LAS float*)(F.lds + 63488);
    const bf16_t* GLU = wsp<bf16_t>(ws, WS_GLU); bf16_t* CO = wsp<bf16_t>(ws, WS_CO);
    const float* cw = a.in[I_CONVW];
    for (int idx = F.tid; idx < CW * 128; idx += NTHREADS) { const int tap = idx >> 7, c4 = idx & 127; const f32x4 v = *(const f32x4*)(cw + tap * CC + 4 * c4); *(LAS f32x4*)(wl + tap * 512 + (c4 & 1) * 256 + (c4 >> 1) * 4) = v; }
    const int lane = F.lane, c0 = 8 * lane;
    for (int k = k_lo; k < k_hi; ++k) { const int tile = F.bid + k * F.G; if (tile >= NTOK / 32) break;
        const int b = tile >> 6, s0 = (tile & 63) * 32, p0 = NMETA + s0;
        __syncthreads();
        for (int idx = F.tid; idx < 62 * 64; idx += NTHREADS) { const int r = idx >> 6, ch = idx & 63, p = p0 - 30 + r; u32x4 v = (u32x4){0u, 0u, 0u, 0u};
            if (p >= 0) v = *(const u32x4*)(GLU + (size_t)(b * TT + p) * CC + ch * 8);
            *(LAS u32x4*)(xs + r * 1024 + ch * 16) = v; }
        __syncthreads();
        const int i0 = 4 * F.wave;
        float acc[4][8];
#pragma unroll
        for (int t = 0; t < 4; ++t)
#pragma unroll
            for (int i = 0; i < 8; ++i) acc[t][i] = 0.f;
        const LAS float* wlb = wl + lane * 4; asm volatile("" : "+v"(wlb));
        const LAS unsigned char* xsb = xs + i0 * 1024 + lane * 16; asm volatile("" : "+v"(xsb));
#pragma unroll 1
        for (int tap = 0; tap < CW; ++tap) {
            const f32x4 w0 = *(const LAS f32x4*)(wlb + tap * 512), w1 = *(const LAS f32x4*)(wlb + tap * 512 + 256);
#pragma unroll
            for (int t = 0; t < 4; ++t) {
                const u32x4 xv = *(const LAS u32x4*)(xsb + (tap + t) * 1024);
                acc[t][0] += w0[0] * bflo(xv.x); acc[t][1] += w0[1] * bfhi(xv.x); acc[t][2] += w0[2] * bflo(xv.y); acc[t][3] += w0[3] * bfhi(xv.y);
                acc[t][4] += w1[0] * bflo(xv.z); acc[t][5] += w1[1] * bfhi(xv.z); acc[t][6] += w1[2] * bflo(xv.w); acc[t][7] += w1[3] * bfhi(xv.w);
            }
        }
        float cb[8], lg[8], lb[8];
        { const f32x4* p0 = (const f32x4*)(a.in[I_CONVB] + c0); const f32x4* p1 = (const f32x4*)(a.in[I_LNG] + c0); const f32x4* p2 = (const f32x4*)(a.in[I_LNB] + c0);
#pragma unroll
          for (int hh = 0; hh < 2; ++hh) { const f32x4 u0 = p0[hh], u1 = p1[hh], u2 = p2[hh];
#pragma unroll
              for (int i = 0; i < 4; ++i) { cb[4 * hh + i] = u0[i]; lg[4 * hh + i] = u1[i]; lb[4 * hh + i] = u2[i]; } } }
#pragma unroll
        for (int t = 0; t < 4; ++t) {
            float s = 0.f;
#pragma unroll
            for (int i = 0; i < 8; ++i) { acc[t][i] += cb[i]; s += acc[t][i]; }
            const float mean = wave_sum(s) * (1.f / CC); float q = 0.f;
#pragma unroll
            for (int i = 0; i < 8; ++i) { acc[t][i] -= mean; q += acc[t][i] * acc[t][i]; }
            const float rstd = 1.0f / sqrtf(wave_sum(q) * (1.f / CC) + EPS);
            float y[8];
#pragma unroll
            for (int i = 0; i < 8; ++i) { const float z = acc[t][i] * rstd * lg[i] + lb[i]; y[i] = z * sigmoidf_(z); }
            u32x4 o; o.x = cvt_pk_bf16(y[0], y[1]); o.y = cvt_pk_bf16(y[2], y[3]); o.z = cvt_pk_bf16(y[4], y[5]); o.w = cvt_pk_bf16(y[6], y[7]);
            *(u32x4*)(CO + (size_t)(b * SEQ + s0 + i0 + t) * CC + c0) = o;
        }
    }
    __syncthreads();
}

constexpr int ROWP = 2080, NJ = 33;
__device__ __forceinline__ unsigned f2ord(float f) { const unsigned b = __float_as_uint(f); return b ^ ((b >> 31) ? 0xffffffffu : 0x80000000u); }
__device__ __forceinline__ int wave_isum(int v) {
#pragma unroll
    for (int o = 1; o < 64; o <<= 1) v += __shfl_xor(v, o);
    return v;
}
__device__ __forceinline__ int wave_isum_dpp(int v) {
    v += __builtin_amdgcn_update_dpp(0, v, 0xB1, 0xF, 0xF, false);
    v += __builtin_amdgcn_update_dpp(0, v, 0x4E, 0xF, 0xF, false);
    v += __builtin_amdgcn_update_dpp(0, v, 0x141, 0xF, 0xF, false);
    v += __builtin_amdgcn_update_dpp(0, v, 0x140, 0xF, 0xF, false);
    return __builtin_amdgcn_readlane(v, 0) + __builtin_amdgcn_readlane(v, 16) + __builtin_amdgcn_readlane(v, 32) + __builtin_amdgcn_readlane(v, 48);
}
__device__ __forceinline__ void p2_indexer_unit(Frame& F, const Args& a, int b, int q16, int flags) {
    unsigned char* ws = F.ws;
    const bf16_t* IQ = wsp<bf16_t>(ws, WS_IQ); const bf16_t* IK = wsp<bf16_t>(ws, WS_IK); const float* IW = wsp<float>(ws, WS_IW); unsigned* MASK = wsp<unsigned>(ws, WS_MASK);
    LAS unsigned* SU = (LAS unsigned*)F.lds;
    int lane_ = F.lane; asm volatile("" : "+v"(lane_));
    const int lane = lane_, c = lane & 31, hi = lane >> 5, w = F.wave;
    const int nwblk = (q16 >> 1) + 2;
    if (!(flags & 4)) {
        const int tok0 = b * SEQ + 16 * q16;
        bf16x8 af[4][4]; f32x4 wq[4][4];
#pragma unroll
        for (int g = 0; g < 4; ++g) {
            const bf16_t* ap = IQ + (size_t)(tok0 + 4 * g + (c >> 3)) * AW + (c & 7) * IDXD + 8 * hi;
#pragma unroll
            for (int ks = 0; ks < 4; ++ks) af[g][ks] = *(const bf16x8*)(ap + 16 * ks);
#pragma unroll
            for (int q = 0; q < 4; ++q) wq[g][q] = *(const f32x4*)(IW + (size_t)(tok0 + 4 * g + q) * 8 + 4 * hi);
        }
        const int rel0 = NMETA + 16 * q16 + 2 * hi - c;
        const bf16_t* kp = IK + (size_t)b * IKBLK * 2048 + lane * 8;
        LAS unsigned* srow = SU + (2 * hi) * ROWP + c;
        bf16x8 bfr[4], bnx[4];
#pragma unroll
        for (int ks = 0; ks < 4; ++ks) { bfr[ks] = *(const bf16x8*)(kp + (size_t)(w < nwblk ? w : 0) * 2048 + 512 * ks); bnx[ks] = bfr[ks]; }
#pragma unroll
        for (int g = 0; g < 4; ++g) asm volatile("" :: "v"(af[g][0]), "v"(af[g][1]), "v"(af[g][2]), "v"(af[g][3]), "v"(wq[g][0]), "v"(wq[g][1]), "v"(wq[g][2]), "v"(wq[g][3]));
        asm volatile("" :: "v"(bfr[0]), "v"(bfr[1]), "v"(bfr[2]), "v"(bfr[3]));
        for (int blk = w; blk < nwblk; blk += 8) {
            {
                const int bn_ = blk + 8 < nwblk ? blk + 8 : blk;
#pragma unroll
                for (int ks = 0; ks < 4; ++ks) bnx[ks] = *(const bf16x8*)(kp + (size_t)bn_ * 2048 + 512 * ks); }
#pragma unroll
            for (int g = 0; g < 4; ++g) {
                f32x16 acc = {};
#pragma unroll
                for (int ks = 0; ks < 4; ++ks) acc = __builtin_amdgcn_mfma_f32_32x32x16_bf16(af[g][ks], bfr[ks], acc, 0, 0, 0);
                float part[4];
#pragma unroll
                for (int q = 0; q < 4; ++q) { float s = wq[g][q][0] * __builtin_amdgcn_fmed3f(acc[4 * q], 0.f, INFINITY);
#pragma unroll
                    for (int i = 1; i < 4; ++i) s = __builtin_fmaf(wq[g][q][i], __builtin_amdgcn_fmed3f(acc[4 * q + i], 0.f, INFINITY), s);
                    part[q] = s; }
#pragma unroll
                for (int p = 0; p < 2; ++p) {
                    const auto rr = __builtin_amdgcn_permlane32_swap(__float_as_uint(part[p]), __float_as_uint(part[p + 2]), false, false);
                    const float sc = __uint_as_float(rr[0]) + __uint_as_float(rr[1]);
                    srow[(4 * g + p) * ROWP + 32 * blk] = (32 * blk <= rel0 + 4 * g + p) ? f2ord(sc) : 0u; }
            }
#pragma unroll
            for (int ks = 0; ks < 4; ++ks) bfr[ks] = bnx[ks];
        }
    }
    __syncthreads();
    if (!(flags & 8)) {
        const int nj = (nwblk + 1) >> 1, klim = 32 * nwblk;
        unsigned U[NJ][2];
#pragma unroll
        for (int j = 0; j < NJ; ++j) {
            if (j < nj) { const int key = 64 * j + lane;
#pragma unroll
                for (int p = 0; p < 2; ++p) U[j][p] = (key < klim) ? SU[(2 * w + p) * ROWP + key] : 0u; }
            else { U[j][0] = 0u; U[j][1] = 0u; }
        }
        const int tokb = b * SEQ + 16 * q16 + 2 * w;
        const int cgw = F.bid * NWAVES + w, CNGW = F.G * NWAVES;
        LAS float* cscr = (LAS float*)(SU + (2 * w) * ROWP);
        f32x4 cva[16], cvb[16];
        const int ct0 = cgw + F.cvt_k * CNGW, ct1 = ct0 + CNGW, ct2 = ct1 + CNGW;
        const bool cv0 = ct0 < T_MOE && !(flags & 1024), cv1 = ct1 < T_MOE && !(flags & 1024), cv2 = ct2 < T_MOE && !(flags & 1024);
        P0Desc cd0 = p0_desc_moe(a, ws, cv0 ? ct0 : cgw), cd1 = p0_desc_moe(a, ws, cv1 ? ct1 : cgw), cd2 = p0_desc_moe(a, ws, cv2 ? ct2 : cgw);
        { bf16_t* const snk = wsp<bf16_t>(ws, WS_DUMMY);
          if (!cv0) { cd0.dst = snk; cd0.ldk = 64; } if (!cv1) { cd1.dst = snk; cd1.ldk = 64; } if (!cv2) { cd2.dst = snk; cd2.ldk = 64; } }
        p0_load(cd0, cva, lane); p0_load(cd1, cvb, lane);
        F.cvt_k += (cv0 ? 1 : 0) + (cv1 ? 1 : 0) + (cv2 ? 1 : 0);
        unsigned lo[2], hb[2], thr[2], veq[2]; int chi[2], need[2]; bool done[2];
#pragma unroll
        for (int p = 0; p < 2; ++p) { lo[p] = 1u; hb[p] = 0xffffffffu; chi[p] = 0; need[p] = 0; veq[p] = 0u; thr[p] = 1u; done[p] = (NMETA + 16 * q16 + 2 * w + p + 1 <= TOPK); }
        for (int it = 0; it < 34; ++it) {
            if (done[0] && done[1]) break;
            unsigned mid[2]; int cl[2];
#pragma unroll
            for (int p = 0; p < 2; ++p) { mid[p] = lo[p] + ((hb[p] - lo[p]) >> 1); cl[p] = 0; }
#pragma unroll
            for (int g = 0; g < 3; ++g) if (11 * g < nj) {
#pragma unroll
                for (int jj = 0; jj < 11; ++jj)
#pragma unroll
                    for (int p = 0; p < 2; ++p) cl[p] += (U[11 * g + jj][p] >= mid[p]) ? 1 : 0; }
            const int tot = wave_isum_dpp(cl[0] | (cl[1] << 16));
            int cnt[2] = {tot & 0xffff, tot >> 16};
#ifdef DBG_CHECK_DPP
            if (wave_isum(cl[0]) != cnt[0] || wave_isum(cl[1]) != cnt[1]) __hip_atomic_store(wsp<unsigned>(ws, WS_CTL) + 3, 1u, RLX_AGENT);
#endif
#pragma unroll
            for (int p = 0; p < 2; ++p) {
                const int ct = cnt[p];
                if (!done[p]) {
                    if (ct == TOPK) { done[p] = true; thr[p] = mid[p]; need[p] = 0; }
                    else if (ct > TOPK) lo[p] = mid[p];
                    else { hb[p] = mid[p]; chi[p] = ct; }
                    if (!done[p] && hb[p] - lo[p] == 1u) { done[p] = true; thr[p] = hb[p]; veq[p] = lo[p]; need[p] = TOPK - chi[p]; }
                }
            }
        }
        p0_store(cd0, cva, cscr, lane);
        p0_store(cd1, cvb, cscr, lane);
        p0_load(cd2, cva, lane);
#pragma unroll
        for (int p = 0; p < 2; ++p) {
            int run = 0, wlo = 0, whi = 0;
#ifdef DBG_CHECK_SEL
            int selcnt = 0;
#endif
            const bool tied = need[p] > 0;
#pragma unroll
            for (int j = 0; j < NJ; ++j) if (j < nj) {
                const unsigned u = U[j][p];
                bool take = (u >= thr[p]);
                if (tied) {
                    const bool eq = (u == veq[p]);
                    const unsigned long long em = __ballot(eq);
                    const int rank = run + (int)__builtin_amdgcn_mbcnt_hi((unsigned)(em >> 32), __builtin_amdgcn_mbcnt_lo((unsigned)em, 0u));
                    take = take || (eq && rank < need[p]);
                    run += __popcll(em);
                }
                const unsigned long long sm = __ballot(take);
                wlo = (lane == j) ? (int)(unsigned)sm : wlo; whi = (lane == j) ? (int)(unsigned)(sm >> 32) : whi;
#ifdef DBG_CHECK_SEL
                selcnt += __popcll(sm);
#endif
            }
            unsigned long long* mrow = (unsigned long long*)(MASK + (size_t)(tokb + p) * MSTR);
            if (lane < nj) mrow[lane] = ((unsigned long long)(unsigned)whi << 32) | (unsigned)wlo;
#ifdef DBG_CHECK_SEL
            { const int nv = NMETA + 16 * q16 + 2 * w + p + 1; if (selcnt != (nv < TOPK ? nv : TOPK)) __hip_atomic_store(wsp<unsigned>(ws, WS_CTL) + 3, 1u, RLX_AGENT); }
#endif
        }
        p0_store(cd2, cva, cscr, lane);
    }
    __syncthreads();
}
__device__ __forceinline__ void p2_indexer(Frame& F, const Args& a, int flags, int half) {
    for (int i = F.bid; i < 256; i += F.G) { const int b = i >> 5, j = 2 * (i & 31);
        if (half == 0) { p2_indexer_unit(F, a, b, j, flags); p2_indexer_unit(F, a, b, 127 - j, flags); }
        else { p2_indexer_unit(F, a, b, j + 1, flags); p2_indexer_unit(F, a, b, 126 - j, flags); } }
}

__device__ const unsigned char T5B[128] = {0, 1, 2, 3, 4, 5, 6, 7, 8, 9, 10, 11, 12, 13, 14, 15, 16, 16, 16, 17, 17, 18, 18, 18, 19, 19, 19, 20, 20, 20, 20, 21, 21, 21, 21, 22, 22, 22, 22, 22, 23, 23, 23, 23, 23, 23, 24, 24, 24, 24, 24, 24, 25, 25, 25, 25, 25, 25, 25, 26, 26, 26, 26, 26, 26, 26, 26, 27, 27, 27, 27, 27, 27, 27, 27, 27, 27, 28, 28, 28, 28, 28, 28, 28, 28, 28, 28, 29, 29, 29, 29, 29, 29, 29, 29, 29, 29, 29, 29, 30, 30, 30, 30, 30, 30, 30, 30, 30, 30, 30, 30, 30, 30, 31, 31, 31, 31, 31, 31, 31, 31, 31, 31, 31, 31, 31, 31, 31};
constexpr int TBS = 132;
__device__ __forceinline__ int crow(int r, int hi) { return (r & 3) + 8 * (r >> 2) + 4 * hi; }
constexpr int KPITCH = 144, VPITCH = 136;
constexpr int AT_K = 0, AT_V = AT_K + 2 * 64 * KPITCH, AT_TB = AT_V + 2 * 64 * VPITCH, AT_SC = AT_TB + NH * TBS * 4, AT_END = AT_SC + NWAVES * 128;
static_assert(AT_END <= RING_BYTES, "attention LDS map");
__device__ __forceinline__ void p3_attn_unit(Frame& F, int b, int h, int Q) {
    unsigned char* ws = F.ws;
    const bf16_t* Qm = wsp<bf16_t>(ws, WS_Q); const bf16_t* KB = wsp<bf16_t>(ws, WS_KB); const bf16_t* VT = wsp<bf16_t>(ws, WS_VT); const unsigned* MASK = wsp<unsigned>(ws, WS_MASK); bf16_t* AO = wsp<bf16_t>(ws, WS_AO);
    LAS unsigned char* lds = F.lds;
    const LAS float* tbh = (const LAS float*)(lds + AT_TB) + h * TBS;
    LAS float* sc = (LAS float*)(lds + AT_SC) + F.wave * 32;
    const int tid = F.tid, lane = F.lane, c = lane & 31, hi = lane >> 5, w = F.wave;
    const int qb32 = 8 * Q + w, tokq = b * SEQ + 32 * qb32 + c, posq = NMETA + 32 * qb32 + c;
    const int ktmax = (47 + 32 * qb32) >> 6, NT = 4 * Q + 5;
    bf16x8 qf[4];
#pragma unroll
    for (int ks = 0; ks < 4; ++ks) qf[ks] = *(const bf16x8*)(Qm + (size_t)tokq * AW + h * HD + 16 * ks + 8 * hi);
    const unsigned long long* mrow = (const unsigned long long*)(MASK + (size_t)tokq * MSTR);
    const int srow = tid >> 3, piece = tid & 7;
    const bf16_t* kg = KB + (size_t)(b * TT + srow) * AW + h * HD + piece * 8;
    const bf16_t* vg = VT + ((size_t)b * AW + h * HD + srow) * TP + piece * 8;
    LAS unsigned char* kl = lds + AT_K + srow * KPITCH + piece * 16;
    LAS unsigned char* vl = lds + AT_V + srow * VPITCH + piece * 16;
    const LAS unsigned char* kfb = lds + AT_K + c * KPITCH + 16 * hi;
    const LAS unsigned char* vfb = lds + AT_V + c * VPITCH + 8 * hi;
    const unsigned NEGB = 0xff800000u;
    const float bfar = tbh[128];
    float m_abs = 0.f; bool has = false;
    f32x16 O0 = {}, O1 = {}, LS = {}, CI;
#pragma unroll
    for (int r = 0; r < 16; ++r) CI[r] = bfar;
    const bf16x8 ones = __builtin_bit_cast(bf16x8, ((u32x4){0x3f803f80u, 0x3f803f80u, 0x3f803f80u, 0x3f803f80u}));
    u32x4 kr = *(const u32x4*)kg, vr = *(const u32x4*)vg;
    unsigned long long mwn = mrow[0];
    *(LAS u32x4*)kl = kr; *(LAS u32x2*)vl = (u32x2){vr.x, vr.y}; *(LAS u32x2*)(vl + 8) = (u32x2){vr.z, vr.w};
    __syncthreads();
    for (int kt = 0; kt < NT; ++kt) {
        const int buf = kt & 1;
        const unsigned long long mw = mwn;
        if (kt + 1 < NT) { kr = *(const u32x4*)(kg + (size_t)(kt + 1) * 64 * AW); vr = *(const u32x4*)(vg + (kt + 1) * 64); if (kt + 1 <= ktmax) mwn = mrow[kt + 1]; }
        if (kt <= ktmax) {
            const LAS unsigned char* kp = kfb + buf * 64 * KPITCH;
            f32x16 S0 = CI, S1 = CI;
#pragma unroll
            for (int ks = 0; ks < 4; ++ks) {
                const bf16x8 k0 = *(const LAS bf16x8*)(kp + ks * 32), k1 = *(const LAS bf16x8*)(kp + 32 * KPITCH + ks * 32);
                S0 = __builtin_amdgcn_mfma_f32_32x32x16_bf16(k0, qf[ks], S0, 0, 0, 0);
                S1 = __builtin_amdgcn_mfma_f32_32x32x16_bf16(k1, qf[ks], S1, 0, 0, 0);
            }
            const int mw0 = (int)((unsigned)mw >> (4 * hi)), mw1 = (int)((unsigned)(mw >> 32) >> (4 * hi));
            const bool far = (256 * Q + 32 * w - 64 * kt) >= 175;
            if (!far) {
                const int d0 = posq - 64 * kt - 4 * hi;
#pragma unroll
                for (int r = 0; r < 16; ++r) { const int ko = (r & 3) + 8 * (r >> 2);
                    int da = d0 - ko, db = d0 - 32 - ko; da = da < 0 ? 0 : (da > 128 ? 128 : da); db = db < 0 ? 0 : (db > 128 ? 128 : db);
                    S0[r] += tbh[da] - bfar; S1[r] += tbh[db] - bfar; }
            }
            float tmax = -INFINITY;
#pragma unroll
            for (int r = 0; r < 16; ++r) { const int ko = (r & 3) + 8 * (r >> 2);
                const unsigned t0 = (unsigned)__builtin_amdgcn_sbfe(mw0, ko, 1), t1 = (unsigned)__builtin_amdgcn_sbfe(mw1, ko, 1);
                S0[r] = __uint_as_float((__float_as_uint(S0[r]) & t0) | (NEGB & ~t0)); S1[r] = __uint_as_float((__float_as_uint(S1[r]) & t1) | (NEGB & ~t1));
                tmax = fmaxf(tmax, fmaxf(S0[r], S1[r])); }
            tmax = fmaxf(tmax, __shfl_xor(tmax, 32));
            if (__any(tmax > 8.0f || (!has && tmax > -INFINITY))) {
                const bool upd = tmax > -INFINITY && (!has || tmax > 0.f);
                const float dl = upd ? tmax : 0.f;
                const float alpha = has ? __builtin_amdgcn_exp2f(-dl) : 1.0f;
                m_abs += dl; has = has || upd;
#pragma unroll
                for (int r = 0; r < 16; ++r) { S0[r] -= dl; S1[r] -= dl; CI[r] = bfar - m_abs; }
                if (hi == 0) sc[c] = alpha;
                LDS_WAIT(); asm volatile("" ::: "memory");
#pragma unroll
                for (int r = 0; r < 16; ++r) { const float f = sc[crow(r, hi)]; O0[r] *= f; O1[r] *= f; LS[r] *= f; }
                LDS_WAIT(); asm volatile("" ::: "memory");
            }
#pragma unroll
            for (int r = 0; r < 16; ++r) { S0[r] = __builtin_amdgcn_exp2f(S0[r]); S1[r] = __builtin_amdgcn_exp2f(S1[r]); }
            const LAS unsigned char* vp = vfb + buf * 64 * VPITCH;
#pragma unroll
            for (int s2 = 0; s2 < 4; ++s2) {
                u32x4 pw;
                if (s2 < 2) { const int o = 8 * (s2 & 1); pw.x = cvt_pk_bf16(S0[o + 0], S0[o + 1]); pw.y = cvt_pk_bf16(S0[o + 2], S0[o + 3]); pw.z = cvt_pk_bf16(S0[o + 4], S0[o + 5]); pw.w = cvt_pk_bf16(S0[o + 6], S0[o + 7]); }
                else { const int o = 8 * (s2 & 1); pw.x = cvt_pk_bf16(S1[o + 0], S1[o + 1]); pw.y = cvt_pk_bf16(S1[o + 2], S1[o + 3]); pw.z = cvt_pk_bf16(S1[o + 4], S1[o + 5]); pw.w = cvt_pk_bf16(S1[o + 6], S1[o + 7]); }
                const bf16x8 pf = __builtin_bit_cast(bf16x8, pw);
                const u32x2 a0 = *(const LAS u32x2*)(vp + s2 * 32), a1 = *(const LAS u32x2*)(vp + s2 * 32 + 16);
                const u32x2 b0 = *(const LAS u32x2*)(vp + 32 * VPITCH + s2 * 32), b1 = *(const LAS u32x2*)(vp + 32 * VPITCH + s2 * 32 + 16);
                const bf16x8 v0 = __builtin_bit_cast(bf16x8, ((u32x4){a0.x, a0.y, a1.x, a1.y})), v1 = __builtin_bit_cast(bf16x8, ((u32x4){b0.x, b0.y, b1.x, b1.y}));
                O0 = __builtin_amdgcn_mfma_f32_32x32x16_bf16(pf, v0, O0, 0, 0, 0);
                O1 = __builtin_amdgcn_mfma_f32_32x32x16_bf16(pf, v1, O1, 0, 0, 0);
                LS = __builtin_amdgcn_mfma_f32_32x32x16_bf16(pf, ones, LS, 0, 0, 0);
            }
        }
        if (kt + 1 < NT) { LAS unsigned char* k2 = kl + (buf ^ 1) * 64 * KPITCH; LAS unsigned char* v2 = vl + (buf ^ 1) * 64 * VPITCH;
            *(LAS u32x4*)k2 = kr; *(LAS u32x2*)v2 = (u32x2){vr.x, vr.y}; *(LAS u32x2*)(v2 + 8) = (u32x2){vr.z, vr.w}; }
        __syncthreads();
    }
    bf16_t* ob = AO + (size_t)(b * SEQ + 32 * qb32) * AW + h * HD + c;
#pragma unroll
    for (int r = 0; r < 16; ++r) { const int qr = crow(r, hi); const float f = __builtin_amdgcn_rcpf(LS[r]);
        const float a0 = O0[r] * f, a1 = O1[r] * f, b0 = __shfl_xor(a0, 1), b1 = __shfl_xor(a1, 1);
        if ((c & 1) == 0) { *(unsigned*)(ob + (size_t)qr * AW) = cvt_pk_bf16(a0, b0); *(unsigned*)(ob + (size_t)qr * AW + 32) = cvt_pk_bf16(a1, b1); } }
}
__device__ __forceinline__ void p3_attn(Frame& F, const Args& a) {
    LAS float* tb = (LAS float*)(F.lds + AT_TB);
    __syncthreads();
    for (int idx = F.tid; idx < NH * 129; idx += NTHREADS) { const int h = idx / 129, d = idx % 129; const int bk = d < 128 ? (int)T5B[d] : 31; tb[h * TBS + d] = a.in[I_RELB][bk * NH + h] * LOG2E; }
    __syncthreads();
    for (int i = F.bid; i < 256; i += F.G) { const int bh = i >> 2, j = i & 3; p3_attn_unit(F, bh >> 3, bh & 7, j); p3_attn_unit(F, bh >> 3, bh & 7, 7 - j); }
    __syncthreads();
}

constexpr int WLP = 2064;
constexpr int P6_WHI = 0, P6_WLO = NE * WLP, P6_PART = 2 * NE * WLP, P6_SSP = P6_PART + 2 * 64 * 33 * 4, P6_CNT = P6_SSP + 2 * 64 * 4, P6_END = P6_CNT + 256;
static_assert(P6_END <= LDSX_OFF, "router LDS map");
__device__ __forceinline__ void p6_router(Frame& F, const Args& a) {
    unsigned char* ws = F.ws;
    const float* H1 = wsp<float>(ws, WS_H1); bf16_t* HN = wsp<bf16_t>(ws, WS_XN);
    const float* gf = a.in[I_NFFN]; const float* brt = a.in[I_BR];
    int* TE = wsp<int>(ws, WS_TE); int* TPs = wsp<int>(ws, WS_TP); int* LIST = wsp<int>(ws, WS_LIST); float* LG = wsp<float>(ws, WS_LG); float* RG = wsp<float>(ws, WS_RG);
    unsigned* ecnt = wsp<unsigned>(ws, WS_CTL) + CW_ECNT;
    LAS unsigned char* lds = F.lds;
    LAS float* part = (LAS float*)(lds + P6_PART);
    LAS float* ssp = (LAS float*)(lds + P6_SSP);
    LAS int* lcnt = (LAS int*)(lds + P6_CNT);
    LAS int* lbase = lcnt + 32;
    const int lane = F.lane, w = F.wave, tk = lane & 15, kq = lane >> 4;
    __syncthreads();
    { const unsigned char* src = ws + WS_WRT;
      for (int p = F.tid; p < 2 * NE * 128; p += NTHREADS) { const int arr = p >> 12, row = (p >> 7) & 31, c16 = p & 127;
          *(LAS u32x4*)(lds + arr * (NE * WLP) + row * WLP + c16 * 16) = *(const u32x4*)(src + (size_t)arr * NE * DM * 2 + (size_t)row * DM * 2 + c16 * 16); } }
    for (int tb = F.bid; tb < NTOK / 64; tb += F.G) {
        const int t0 = tb * 64;
        __syncthreads();
        if (F.tid < 32) lcnt[F.tid] = 0;
        {
            const int tg = w & 3, kh = w >> 2, tok = t0 + 16 * tg + tk;
            const float* xr = H1 + (size_t)tok * DM + 512 * kh + 8 * kq; const float* gr = gf + 512 * kh + 8 * kq;
            bf16_t* hr = HN + (size_t)tok * DM + 512 * kh + 8 * kq;
            const LAS unsigned char* wl = lds + tk * WLP + (512 * kh + 8 * kq) * 2;
            f32x4 xa[16], xb[16];
#pragma unroll
            for (int ks = 0; ks < 16; ++ks) { xa[ks] = *(const f32x4*)(xr + 32 * ks); xb[ks] = *(const f32x4*)(xr + 32 * ks + 4); }
            f32x4 acc0 = {0.f, 0.f, 0.f, 0.f}, acc1 = acc0; float ss = 0.f;
#pragma unroll
            for (int ks = 0; ks < 16; ++ks) {
                const f32x4 g0 = *(const f32x4*)(gr + 32 * ks), g1 = *(const f32x4*)(gr + 32 * ks + 4);
                const f32x4 x0 = xa[ks], x1 = xb[ks];
                u32x4 hn; hn.x = cvt_pk_bf16(x0[0] * g0[0], x0[1] * g0[1]); hn.y = cvt_pk_bf16(x0[2] * g0[2], x0[3] * g0[3]); hn.z = cvt_pk_bf16(x1[0] * g1[0], x1[1] * g1[1]); hn.w = cvt_pk_bf16(x1[2] * g1[2], x1[3] * g1[3]);
                *(u32x4*)(hr + 32 * ks) = hn;
                ss += (x0[0] * x0[0] + x0[1] * x0[1]) + (x0[2] * x0[2] + x0[3] * x0[3]) + (x1[0] * x1[0] + x1[1] * x1[1]) + (x1[2] * x1[2] + x1[3] * x1[3]);
                u32x4 xh; xh.x = cvt_pk_bf16(x0[0], x0[1]); xh.y = cvt_pk_bf16(x0[2], x0[3]); xh.z = cvt_pk_bf16(x1[0], x1[1]); xh.w = cvt_pk_bf16(x1[2], x1[3]);
                u32x4 xl; xl.x = cvt_pk_bf16(x0[0] - bflo(xh.x), x0[1] - bfhi(xh.x)); xl.y = cvt_pk_bf16(x0[2] - bflo(xh.y), x0[3] - bfhi(xh.y));
                          xl.z = cvt_pk_bf16(x1[0] - bflo(xh.z), x1[1] - bfhi(xh.z)); xl.w = cvt_pk_bf16(x1[2] - bflo(xh.w), x1[3] - bfhi(xh.w));
                const bf16x8 fxh = __builtin_bit_cast(bf16x8, xh), fxl = __builtin_bit_cast(bf16x8, xl);
                const bf16x8 wh0 = *(const LAS bf16x8*)(wl + P6_WHI + ks * 64), wh1 = *(const LAS bf16x8*)(wl + P6_WHI + 16 * WLP + ks * 64);
                const bf16x8 wl0 = *(const LAS bf16x8*)(wl + P6_WLO + ks * 64), wl1 = *(const LAS bf16x8*)(wl + P6_WLO + 16 * WLP + ks * 64);
                acc0 = __builtin_amdgcn_mfma_f32_16x16x32_bf16(wh0, fxh, acc0, 0, 0, 0); acc1 = __builtin_amdgcn_mfma_f32_16x16x32_bf16(wh1, fxh, acc1, 0, 0, 0);
                acc0 = __builtin_amdgcn_mfma_f32_16x16x32_bf16(wl0, fxh, acc0, 0, 0, 0); acc1 = __builtin_amdgcn_mfma_f32_16x16x32_bf16(wl1, fxh, acc1, 0, 0, 0);
                acc0 = __builtin_amdgcn_mfma_f32_16x16x32_bf16(wh0, fxl, acc0, 0, 0, 0); acc1 = __builtin_amdgcn_mfma_f32_16x16x32_bf16(wh1, fxl, acc1, 0, 0, 0);
            }
            ss += __shfl_xor(ss, 16); ss += __shfl_xor(ss, 32);
            LAS float* pp = part + ((kh * 64) + 16 * tg + tk) * 33 + 4 * kq;
#pragma unroll
            for (int r = 0; r < 4; ++r) { pp[r] = acc0[r]; pp[16 + r] = acc1[r]; }
            if (kq == 0) ssp[kh * 64 + 16 * tg + tk] = ss;
        }
        __syncthreads();
        if (w == 0) {
            const float rinv = 1.0f / sqrtf((ssp[lane] + ssp[64 + lane]) * (1.f / DM) + EPS);
            float lg[NE];
#pragma unroll
            for (int e = 0; e < NE; ++e) lg[e] = (part[lane * 33 + e] + part[(64 + lane) * 33 + e]) * rinv + brt[e];
            int sel[4]; float val[4];
#pragma unroll
            for (int j = 0; j < 4; ++j) { float best = -INFINITY; int bi = 0;
#pragma unroll
                for (int e = 0; e < NE; ++e) { const bool tk_ = lg[e] > best; best = tk_ ? lg[e] : best; bi = tk_ ? e : bi; }
                sel[j] = bi; val[j] = best;
#pragma unroll
                for (int e = 0; e < NE; ++e) lg[e] = (e == bi) ? -INFINITY : lg[e]; }
            float den = 0.f, ex[4];
#pragma unroll
            for (int j = 0; j < 4; ++j) { ex[j] = __expf(val[j] - val[0]); den += ex[j]; }
            int slot[4];
#pragma unroll
            for (int j = 0; j < 4; ++j) slot[j] = __hip_atomic_fetch_add(&lcnt[sel[j]], 1, __ATOMIC_RELAXED, __HIP_MEMORY_SCOPE_WORKGROUP);
            LDS_WAIT();
            if (lane < 32) { const int n = lcnt[lane]; lbase[lane] = n ? (int)__hip_atomic_fetch_add(ecnt + 64 * lane, (unsigned)n, RLX_AGENT) : 0; }
            LDS_WAIT(); asm volatile("" ::: "memory");
            const int t = t0 + lane;
#pragma unroll
            for (int j = 0; j < 4; ++j) { const int e = sel[j], pos = lbase[e] + slot[j]; const float g = ex[j] / den;
                TE[t * 4 + j] = e; TPs[t * 4 + j] = pos; LIST[(size_t)e * NTOK + pos] = t; LG[(size_t)e * NTOK + pos] = g; RG[(size_t)e * NTOK + pos] = rinv; }
        }
    }
    __syncthreads();
}
__device__ __forceinline__ void moe_tables(Frame& F, LAS int* cnt, LAS int* tbase) {
    const unsigned* ecnt = wsp<unsigned>(F.ws, WS_CTL) + CW_ECNT;
    __syncthreads();
    if (F.tid < NE) cnt[F.tid] = (int)__hip_atomic_load(ecnt + 64 * F.tid, RLX_AGENT);
    __syncthreads();
    if (F.tid == 0) { int s = 0; for (int e = 0; e < NE; ++e) { tbase[e] = s; s += (cnt[e] + 255) >> 8; } tbase[NE] = s; }
    __syncthreads();
}

__device__ __forceinline__ void p9_final(Frame& F, const Args& a, const LAS int* tbase) {
    unsigned char* ws = F.ws;
    const float* H1 = wsp<float>(ws, WS_H1); float* OUT = a.out; const bf16_t* YP = wsp<bf16_t>(ws, WS_YP); const int* TE = wsp<int>(ws, WS_TE); const int* TPs = wsp<int>(ws, WS_TP); const float* gf = a.in[I_NFIN];
    const int gw = F.bid * NWAVES + F.wave, NGW = F.G * NWAVES, lane = F.lane;
    const f32x4* gr = (const f32x4*)gf + lane;
    f32x4 gg[4];
#pragma unroll
    for (int j = 0; j < 4; ++j) gg[j] = gr[64 * j];
#ifdef DBG_CHECK_DPP
    if (__hip_atomic_load(wsp<unsigned>(ws, WS_CTL) + 3, RLX_AGENT) != 0u) { const float qn = __builtin_nanf("");
#pragma unroll
        for (int j = 0; j < 4; ++j) gg[j] = (f32x4){qn, qn, qn, qn}; }
#endif
    for (int base = 0; base < NTOK; base += 8 * NGW) {
        int myrow = 0;
        { const int i = lane >> 2, j = lane & 3, t = base + gw + NGW * i; if (lane < 32 && t < NTOK) { const int e = TE[t * 4 + j], pos = TPs[t * 4 + j]; myrow = tbase[e] * 256 + pos; } }
        f32x4 va[4], vb[4]; u32x2 ya[4][4], yb[4][4];
#define P9_LOAD(i, V, Y) do { const int t_ = base + gw + NGW * (i); if (t_ < NTOK) { const f32x4* xr_ = (const f32x4*)(H1 + (size_t)t_ * DM) + lane; \
            _Pragma("unroll") for (int j_ = 0; j_ < 4; ++j_) V[j_] = xr_[64 * j_]; \
            _Pragma("unroll") for (int q_ = 0; q_ < 4; ++q_) { const int row_ = __builtin_amdgcn_readlane(myrow, 4 * (i) + q_); const u32x2* yr_ = (const u32x2*)(YP + (size_t)row_ * DM) + lane; \
                _Pragma("unroll") for (int j_ = 0; j_ < 4; ++j_) Y[q_][j_] = yr_[64 * j_]; } } } while (0)
#define P9_PROC(i, V, Y) do { const int t_ = base + gw + NGW * (i); if (t_ < NTOK) { \
            _Pragma("unroll") for (int q_ = 0; q_ < 4; ++q_) _Pragma("unroll") for (int j_ = 0; j_ < 4; ++j_) { const u32x2 y_ = Y[q_][j_]; V[j_].x += bflo(y_.x); V[j_].y += bfhi(y_.x); V[j_].z += bflo(y_.y); V[j_].w += bfhi(y_.y); } \
            float s_ = 0.f; _Pragma("unroll") for (int j_ = 0; j_ < 4; ++j_) s_ += (V[j_].x * V[j_].x + V[j_].y * V[j_].y) + (V[j_].z * V[j_].z + V[j_].w * V[j_].w); \
            const float r_ = 1.0f / sqrtf(wave_sum(s_) * (1.f / DM) + EPS); f32x4* xo_ = (f32x4*)(OUT + (size_t)t_ * DM) + lane; \
            _Pragma("unroll") for (int j_ = 0; j_ < 4; ++j_) xo_[64 * j_] = (f32x4){V[j_].x * r_ * gg[j_].x, V[j_].y * r_ * gg[j_].y, V[j_].z * r_ * gg[j_].z, V[j_].w * r_ * gg[j_].w}; } } while (0)
        P9_LOAD(0, va, ya);
#pragma unroll
        for (int i = 0; i < 8; i += 2) {
            P9_LOAD(i + 1, vb, yb);
            P9_PROC(i, va, ya);
            if (i + 2 < 8) P9_LOAD(i + 2, va, ya);
            P9_PROC(i + 1, vb, yb);
        }
#undef P9_LOAD
#undef P9_PROC
    }
}

constexpr int N_PHASES = 10;
__global__ void __launch_bounds__(NTHREADS, 2) fwd_kernel(Args args) {
    extern __shared__ __attribute__((aligned(16))) unsigned char lds_raw[];
    Frame F;
    F.lds = (LAS unsigned char*)lds_raw; F.ws = args.ws;
    F.tid = threadIdx.x; F.lane = F.tid & 63; F.wave = __builtin_amdgcn_readfirstlane(F.tid >> 6);
    F.G = gridDim.x; F.bid = blockIdx.x;
    volatile LAS unsigned* MISC = (volatile LAS unsigned*)(F.lds + MISC_OFF);
    if (F.tid < 32) MISC[F.tid] = 0u;
    __syncthreads();
    unsigned* ctl = wsp<unsigned>(args.ws, WS_CTL);
    const int lo = args.ph_lo, hi = args.ph_hi;
    const bool multi = (hi - lo) > 1;
    XcdBarrier bar; bar.bar = ctl + CW_BAR; bar.x = 0; bar.st = nullptr;
    if (multi) bar = xcd_barrier_post(ctl + CW_BAR, MISC + 8);
#ifndef PHASE_MASK
#define PHASE_MASK 0x3ff
#endif
#define IN(k) (((PHASE_MASK >> (k)) & 1) && lo <= (k) && (k) < hi)
#define SEAM(k) do { if (IN(k) && IN((k) + 1)) xcd_barrier(bar); } while (0)
    LAS int* l_cnt = (LAS int*)(F.lds + MOET_OFF); LAS int* l_tbase = l_cnt + 64;
    const MoeTables MT{l_cnt, l_tbase};

    if (IN(0)) { p0_prologue(F, args, 0); } SEAM(0);
    if (IN(1)) {
        PlainSched S; S.init(args.ws, WS_XN, WS_WIN, NTOK, 5120, DM, F.G, F.bid);
        EpiInProj E{args.ws, args.in[I_BGATE]};
        if (!(args.flags & 64)) pg8::gemm_phase<EpiInProj, PlainSched>(F.lds, DM, S, E);
        if (!(args.flags & 128)) p1_thin(F, args.flags);
    } SEAM(1);
    if (IN(2)) {
        F.cvt_k = 0;
        const int nconv = (NTOK / 32 + F.G - 1) / F.G, cslot = (F.bid >> 3) % 3, cfirst = (nconv * (2 - cslot)) / 2;
        if (!(args.flags & 1) && cfirst > 0) p2_conv(F, args, 0, cfirst);
        if (!(args.flags & 2)) p2_indexer(F, args, args.flags, 0);
        if (!(args.flags & 2)) p2_indexer(F, args, args.flags, 1);
        if (!(args.flags & 1) && cfirst < nconv) { __syncthreads(); p2_conv(F, args, cfirst, nconv); }
        if (!(args.flags & 1024)) { __syncthreads(); p0_prologue(F, args, 1); }
    } SEAM(2);
    if (IN(3)) { p3_attn(F, args); } SEAM(3);
    if (IN(4)) {
        MergeSched S{(const char*)args.ws, F.G, F.bid}; EpiMerge E{args.ws};
        pg8::gemm_phase<EpiMerge, MergeSched>(F.lds, 512, S, E);
    } SEAM(4);
    if (IN(5)) {
        PlainSched S; S.init(args.ws, WS_MG, WS_WOUT, NTOK, DM, DM, F.G, F.bid);
        EpiResid E{args.in[I_X], wsp<float>(args.ws, WS_H1)};
        pg8::gemm_phase<EpiResid, PlainSched>(F.lds, DM, S, E);
    } SEAM(5);
    if (IN(6)) { p6_router(F, args); } SEAM(6);
    if (IN(7)) {
        moe_tables(F, l_cnt, l_tbase);
        MoeSched<8, true> S{(const char*)args.ws, MT, F.G, F.bid, l_tbase[NE] * 8, F.lds};
        moe_prepare(F, S, wsp<float>(args.ws, WS_RG), args.in[I_BUG]);
        EpiSwiglu E{args.ws, MT, (const LAS float*)(F.lds + MOEL_ROWV)};
        pg8::gemm_phase<EpiSwiglu, MoeSched<8, true>>(F.lds, DM, S, E);
    } SEAM(7);
    if (IN(8)) {
        moe_tables(F, l_cnt, l_tbase);
        MoeSched<4, false> S{(const char*)args.ws, MT, F.G, F.bid, l_tbase[NE] * 4, F.lds};
        moe_prepare(F, S, wsp<float>(args.ws, WS_LG), args.in[I_BD]);
        EpiDown E{args.ws, MT, (const LAS float*)(F.lds + MOEL_ROWV)};
        pg8::gemm_phase<EpiDown, MoeSched<4, false>>(F.lds, DFF, S, E);
    } SEAM(8);
    if (IN(9)) { moe_tables(F, l_cnt, l_tbase); p9_final(F, args, l_tbase); }
#undef IN
#undef SEAM
}

#ifdef DBG_HASH_OFF
__global__ void dbg_hash(const unsigned* __restrict__ buf, size_t nwords, unsigned* acc) {
    unsigned h = 0u;
    for (size_t i = (size_t)blockIdx.x * blockDim.x + threadIdx.x; i < nwords; i += (size_t)gridDim.x * blockDim.x) h += (buf[i] ^ (unsigned)(i * 2654435761u)) * 2246822519u + (unsigned)i;
#pragma unroll
    for (int o = 1; o < 64; o <<= 1) h += __shfl_xor(h, o);
    if ((threadIdx.x & 63) == 0) atomicAdd(acc, h);
}
__global__ void dbg_fill(float* out, size_t n, const unsigned* acc) {
    const unsigned h = *acc; const float v = (float)((h >> 7) & 0xffffu) * (1.0f / 4096.0f) + 1.0f;
    for (size_t i = (size_t)blockIdx.x * blockDim.x + threadIdx.x; i < n; i += (size_t)gridDim.x * blockDim.x) out[i] = v;
}
#endif

extern "C" void kernel_launch(void* const* d_in, const int* in_sizes, int n_in, void* d_out, int out_size, void* d_ws, size_t ws_size, hipStream_t stream) {
    static int grid = 0;
    if (grid == 0) {
        if (n_in != 21 || out_size != NTOK * DM || ws_size < WS_END) { fprintf(stderr, "kernel_launch: unexpected shapes (n_in %d, out %d, ws %zu < %zu)\n", n_in, out_size, ws_size, (size_t)WS_END); grid = -1; return; }
        int dev = 0, cus = 0, per_cu = 0;
        if (hipGetDevice(&dev) != hipSuccess || hipDeviceGetAttribute(&cus, hipDeviceAttributeMultiprocessorCount, dev) != hipSuccess) { grid = -1; return; }
        if (hipFuncSetAttribute((const void*)fwd_kernel, hipFuncAttributeMaxDynamicSharedMemorySize, LDS_BYTES) != hipSuccess) { fprintf(stderr, "kernel_launch: hipFuncSetAttribute failed\n"); grid = -1; return; }
        if (hipOccupancyMaxActiveBlocksPerMultiprocessor(&per_cu, (const void*)fwd_kernel, NTHREADS, LDS_BYTES) != hipSuccess || per_cu < 1) { fprintf(stderr, "kernel_launch: occupancy query says %d\n", per_cu); }
        (void)hipGetLastError();
        grid = cus;
    }
    if (grid < 0) return;
    (void)hipMemsetAsync((char*)d_ws + WS_CTL, 0, CTL_ZERO_BYTES, stream);
    Args a{};
    for (int i = 0; i < 21; ++i) a.in[i] = (const float*)d_in[i];
    a.out = (float*)d_out; a.ws = (unsigned char*)d_ws;
#if MK_N_LAUNCHES == 1
    a.ph_lo = 0; a.ph_hi = N_PHASES;
    hipLaunchKernelGGL(fwd_kernel, dim3(grid), dim3(NTHREADS), LDS_BYTES, stream, a);
#else
#ifndef DBG_LAST_PHASE
#define DBG_LAST_PHASE (N_PHASES - 1)
#endif
#ifndef DBG_DUP_MASK
#define DBG_DUP_MASK 0
#endif
#ifndef DBG_DUP_FLAGS
#define DBG_DUP_FLAGS 0
#endif
    for (int p = 0; p <= DBG_LAST_PHASE; ++p) { a.ph_lo = p; a.ph_hi = p + 1;
        const int nrep = ((DBG_DUP_MASK >> p) & 1) ? 2 : 1;
        for (int rep = 0; rep < nrep; ++rep) { a.flags = (nrep == 2 && rep == 0) ? DBG_DUP_FLAGS : 0; if (rep == 1 && p == 6) (void)hipMemsetAsync((char*)d_ws + WS_CTL, 0, CTL_ZERO_BYTES, stream);
            hipLaunchKernelGGL(fwd_kernel, dim3(grid), dim3(NTHREADS), LDS_BYTES, stream, a); } }
#ifdef DBG_HASH_OFF
    { const unsigned* hb = DBG_HASH_OFF == 0 ? (const unsigned*)d_out : (const unsigned*)((char*)d_ws + DBG_HASH_OFF);
      hipLaunchKernelGGL(dbg_hash, dim3(1024), dim3(256), 0, stream, hb, (size_t)(DBG_HASH_BYTES) / 4, (unsigned*)d_ws + 2);
      hipLaunchKernelGGL(dbg_fill, dim3(1024), dim3(256), 0, stream, (float*)d_out, (size_t)NTOK * DM, (const unsigned*)d_ws + 2); }
#endif
#endif
}
```
